# Optimizing an MI355X kernel written in HIP

```python
import jax
import jax.numpy as jnp
from jax import lax
import numpy as np

D_MODEL = 1024
BATCH = 2
SEQ = 16384
DEPTH = 4

GRID_W = 64
CTX_LEN = 256
CHUNK = 128
ROWS_PER_CHUNK = CHUNK // GRID_W
A_GROUPS = 4
A_DIM = 128
A_WIDTH = A_GROUPS * A_DIM
B_HEADS = 4
B_DIM = 128
B_WIDTH = B_HEADS * B_DIM
MIX_WIDTH = A_WIDTH + B_WIDTH
REC_HEADS = 8
REC_DK = 128
REC_DV = 128
REC_WIDTH = REC_HEADS * REC_DV
SCAN_CHUNK = 64
D_FF = 2816
N_EXPERTS = 8
TOP_K = 2
D_EXPERT = 3584
EPS = 1e-6
F_FLOOR = 1e-30

kernel_name = 'hybrid_fourier_gmlp_hgrn2_moe_dit'


def rmsnorm(x, gain):
    xf = x.astype(jnp.float32)
    y = xf * lax.rsqrt(jnp.mean(xf * xf, axis=-1, keepdims=True) + EPS)
    return (y * gain.astype(jnp.float32)).astype(x.dtype)


def ada_mod(cond, w, b):
    m = jax.nn.silu(cond) @ w + b
    return jnp.split(m[..., None, :], 6, axis=-1)


def modulate(h, shift, scale):
    return h * (1.0 + scale) + shift


def even_mixer(h, w_in, gmlp_w, gmlp_b, w_out, n_chunks):
    bsz, t, _ = h.shape
    p = h @ w_in
    a = p[..., :A_WIDTH].reshape(bsz, t, A_GROUPS, A_DIM)
    uv = jax.nn.gelu(p[..., A_WIDTH:], approximate=False).reshape(bsz, t, 2, B_HEADS, B_DIM)
    u, v = uv[:, :, 0], uv[:, :, 1]
    ya = jnp.real(jnp.fft.fft2(a.astype(jnp.float32), axes=(1, 3), norm='ortho'))
    vf = v.astype(jnp.float32)
    vn = (vf - jnp.mean(vf, axis=-1, keepdims=True)) * lax.rsqrt(jnp.var(vf, axis=-1, keepdims=True) + EPS)
    vn = vn.reshape(bsz, n_chunks, CHUNK, B_HEADS, B_DIM)
    z = jnp.einsum('hts,bnshc->bnthc', gmlp_w.astype(jnp.float32), vn) + gmlp_b.astype(jnp.float32).T[:, :, None]
    yb = u.astype(jnp.float32) * z.reshape(bsz, t, B_HEADS, B_DIM)
    y = jnp.concatenate([ya.reshape(bsz, t, A_WIDTH), yb.reshape(bsz, t, B_WIDTH)], axis=-1)
    return y.astype(h.dtype) @ w_out


def split_heads(a):
    return a.reshape(a.shape[0], a.shape[1], REC_HEADS, -1)


def hgrn_gates(z, lb):
    lb = lb.reshape(REC_HEADS, REC_DK)
    f = lb + (1.0 - lb) * jax.nn.sigmoid(z)
    log_f = jnp.log(jnp.maximum(f, F_FLOOR))
    k = (1.0 - lb) * jax.nn.sigmoid(-z)
    return k, log_f


def rec_query_gate(p):
    q = jax.nn.silu(split_heads(p[..., :REC_WIDTH].astype(jnp.float32))) * REC_DK ** -0.5
    g = p[..., REC_WIDTH:2 * REC_WIDTH]
    return q, g


def rec_state_inputs(p_state, lb_fwd, lb_bwd):
    zf, zb, i = [split_heads(a.astype(jnp.float32)) for a in jnp.split(p_state, 3, axis=-1)]
    return i, hgrn_gates(zf, lb_fwd), hgrn_gates(zb, lb_bwd)


def gla_scan(q, k, v, log_f, s0):
    bsz, t, nh, _ = q.shape
    nc = t // SCAN_CHUNK

    def chunks(a):
        return a.reshape(bsz, nc, SCAN_CHUNK, nh, a.shape[-1]).transpose(1, 0, 3, 2, 4)

    lower = jnp.tril(jnp.ones((SCAN_CHUNK, SCAN_CHUNK), dtype=bool))[:, :, None]

    def step(s, blk):
        qc, kc, vc, gc = blk
        b = jnp.cumsum(gc, axis=2)
        diff = b[:, :, :, None, :] - b[:, :, None, :, :]
        decay = jnp.where(lower, jnp.exp(jnp.where(lower, diff, 0.0)), 0.0)
        scores = jnp.einsum('bhtd,bhsd,bhtsd->bhts', qc, kc, decay)
        o = scores @ vc + jnp.einsum('bhtd,bhde->bhte', qc * jnp.exp(b), s)
        b_end = b[:, :, -1:, :]
        s_new = jnp.exp(b_end[:, :, 0, :, None]) * s + jnp.einsum('bhsd,bhse->bhde', kc * jnp.exp(b_end - b), vc)
        return s_new, o

    s_fin, o = lax.scan(step, s0, (chunks(q), chunks(k), chunks(v), chunks(log_f)))
    return o.transpose(1, 0, 3, 2, 4).reshape(bsz, t, nh, -1), s_fin


def gla_final_state(k, v, log_f):
    b = jnp.cumsum(log_f, axis=1)
    return jnp.einsum('bthd,bthe->bhde', k * jnp.exp(b[:, -1:] - b), v)


def flip(a):
    return jnp.flip(a, axis=1)


def bidir_scan(q, i, fwd, bwd, s_fwd, s_bwd):
    o_f, sf_out = gla_scan(q, fwd[0], i, fwd[1], s_fwd)
    o_b, sb_out = gla_scan(flip(q), flip(bwd[0]), flip(i), flip(bwd[1]), s_bwd)
    return o_f + flip(o_b), sf_out, sb_out


def rec_output(o, g, gain, w_out, dtype):
    bsz, t = o.shape[:2]
    y = rmsnorm(o, gain.reshape(REC_HEADS, REC_DV)) * jax.nn.silu(split_heads(g.astype(jnp.float32)))
    return y.reshape(bsz, t, REC_WIDTH).astype(dtype) @ w_out


def swiglu(h, w1, w3, w2):
    return (jax.nn.silu(h @ w1) * (h @ w3)) @ w2


def moe_swiglu(h, router_w, w1, w3, w2):
    logits = (h @ router_w).astype(jnp.float32)
    top_v, top_i = lax.top_k(logits, TOP_K)
    top_p = jax.nn.softmax(top_v, axis=-1)
    comb = jnp.sum(jax.nn.one_hot(top_i, N_EXPERTS, dtype=jnp.float32) * top_p[..., None], axis=-2).astype(h.dtype)
    y = jnp.zeros_like(h)
    for e in range(N_EXPERTS):
        y = y + comb[..., e:e + 1] * swiglu(h, w1[e], w3[e], w2[e])
    return y


def setup_inputs(seed: int = 0) -> dict:
    key = jax.random.key(seed)
    ks = jax.random.split(key, 24)
    n_even = (DEPTH + 1) // 2
    n_odd = DEPTH // 2

    def nrm(k, shape, scale):
        return jax.random.normal(k, shape, jnp.float32) * scale

    def gain(k, shape, noise=0.02):
        return 1.0 + nrm(k, shape, noise)

    return {
        'x': nrm(ks[0], (BATCH, SEQ, D_MODEL), 1.0),
        'c': nrm(ks[1], (BATCH, D_MODEL), 1.0),
        'ctx': nrm(ks[2], (BATCH, CTX_LEN, D_MODEL), 1.0),
        'c_ctx': nrm(ks[3], (D_MODEL,), 1.0),
        'w_ada': nrm(ks[4], (DEPTH, D_MODEL, 6 * D_MODEL), 0.5 * D_MODEL ** -0.5),
        'b_ada': nrm(ks[5], (DEPTH, 6 * D_MODEL), 0.02),
        'norm_mix': gain(ks[6], (DEPTH, D_MODEL)),
        'norm_ffn': gain(ks[7], (DEPTH, D_MODEL)),
        'norm_out': gain(ks[8], (D_MODEL,)),
        'w_in_even': nrm(ks[9], (n_even, D_MODEL, A_WIDTH + 2 * B_WIDTH), D_MODEL ** -0.5),
        'gmlp_w': nrm(ks[10], (n_even, B_HEADS, CHUNK, CHUNK), 0.5 * CHUNK ** -0.5),
        'gmlp_b': gain(ks[11], (n_even, B_HEADS, CHUNK)),
        'w_out_even': nrm(ks[12], (n_even, MIX_WIDTH, D_MODEL), MIX_WIDTH ** -0.5),
        'w_in_odd': nrm(ks[13], (n_odd, D_MODEL, 5 * REC_WIDTH), D_MODEL ** -0.5),
        'rec_lb': gain(ks[14], (n_odd, 2, REC_WIDTH), 0.1),
        'rec_norm': gain(ks[15], (n_odd, REC_WIDTH)),
        'w_out_odd': nrm(ks[16], (n_odd, REC_WIDTH, D_MODEL), REC_WIDTH ** -0.5),
        'ffn_w1': nrm(ks[17], (n_even, D_MODEL, D_FF), D_MODEL ** -0.5),
        'ffn_w3': nrm(ks[18], (n_even, D_MODEL, D_FF), D_MODEL ** -0.5),
        'ffn_w2': nrm(ks[19], (n_even, D_FF, D_MODEL), D_FF ** -0.5),
        'router_w': nrm(ks[20], (n_odd, D_MODEL, N_EXPERTS), D_MODEL ** -0.5),
        'moe_w1': nrm(ks[21], (n_odd, N_EXPERTS, D_MODEL, D_EXPERT), D_MODEL ** -0.5),
        'moe_w3': nrm(ks[22], (n_odd, N_EXPERTS, D_MODEL, D_EXPERT), D_MODEL ** -0.5),
        'moe_w2': nrm(ks[23], (n_odd, N_EXPERTS, D_EXPERT, D_MODEL), D_EXPERT ** -0.5),
    }


def reference(x, c, ctx, c_ctx, w_ada, b_ada, norm_mix, norm_ffn, norm_out,
              w_in_even, gmlp_w, gmlp_b, w_out_even,
              w_in_odd, rec_lb, rec_norm, w_out_odd,
              ffn_w1, ffn_w3, ffn_w2, router_w, moe_w1, moe_w3, moe_w2):
    bsz, n_lat, _ = x.shape
    rows = n_lat // GRID_W
    lat_chunks = rows // ROWS_PER_CHUNK
    ctx_chunks = ctx.shape[1] // CHUNK
    lb_soft = jax.nn.softmax(rec_lb.astype(jnp.float32), axis=0)
    lower_bounds = jnp.clip(jnp.cumsum(lb_soft, axis=0) - lb_soft[:1], 0.0, 1.0)
    zero_state = jnp.zeros((bsz, REC_HEADS, REC_DK, REC_DV), jnp.float32)
    xc = ctx
    for layer in range(DEPTH):
        last = layer == DEPTH - 1
        j = layer // 2
        sh_m, sc_m, g_m, sh_f, sc_f, g_f = ada_mod(c, w_ada[layer], b_ada[layer])
        sh_mc, sc_mc, g_mc, sh_fc, sc_fc, g_fc = ada_mod(c_ctx, w_ada[layer], b_ada[layer])
        h = modulate(rmsnorm(x, norm_mix[layer]), sh_m, sc_m)
        if layer % 2 == 0:
            y = even_mixer(h, w_in_even[j], gmlp_w[j], gmlp_b[j], w_out_even[j], lat_chunks)
            if not last:
                hc = modulate(rmsnorm(xc, norm_mix[layer]), sh_mc, sc_mc)
                xc = xc + g_mc * even_mixer(hc, w_in_even[j], gmlp_w[j], gmlp_b[j], w_out_even[j], ctx_chunks)
            x = x + g_m * y
        else:
            lb_f, lb_b = lower_bounds[j, 0], lower_bounds[j, 1]
            w_in = w_in_odd[j]
            hc = modulate(rmsnorm(xc, norm_mix[layer]), sh_mc, sc_mc)
            if last:
                ic, fwc, bwc = rec_state_inputs(hc @ w_in[:, 2 * REC_WIDTH:], lb_f, lb_b)
                s_f = gla_final_state(fwc[0], ic, fwc[1])
                s_b = gla_final_state(flip(bwc[0]), flip(ic), flip(bwc[1]))
            else:
                pc = hc @ w_in
                qc, gc = rec_query_gate(pc)
                ic, fwc, bwc = rec_state_inputs(pc[..., 2 * REC_WIDTH:], lb_f, lb_b)
                oc, s_f, s_b = bidir_scan(qc, ic, fwc, bwc, zero_state, zero_state)
                xc = xc + g_mc * rec_output(oc, gc, rec_norm[j], w_out_odd[j], xc.dtype)
            p = h @ w_in
            q, g = rec_query_gate(p)
            i, fw, bw = rec_state_inputs(p[..., 2 * REC_WIDTH:], lb_f, lb_b)
            o, _, _ = bidir_scan(q, i, fw, bw, s_f, s_b)
            x = x + g_m * rec_output(o, g, rec_norm[j], w_out_odd[j], x.dtype)
        hf = modulate(rmsnorm(x, norm_ffn[layer]), sh_f, sc_f)
        if layer % 2 == 0:
            x = x + g_f * swiglu(hf, ffn_w1[j], ffn_w3[j], ffn_w2[j])
            if not last:
                hfc = modulate(rmsnorm(xc, norm_ffn[layer]), sh_fc, sc_fc)
                xc = xc + g_fc * swiglu(hfc, ffn_w1[j], ffn_w3[j], ffn_w2[j])
        else:
            x = x + g_f * moe_swiglu(hf, router_w[j], moe_w1[j], moe_w3[j], moe_w2[j])
            if not last:
                hfc = modulate(rmsnorm(xc, norm_ffn[layer]), sh_fc, sc_fc)
                xc = xc + g_fc * moe_swiglu(hfc, router_w[j], moe_w1[j], moe_w3[j], moe_w2[j])
    return rmsnorm(x, norm_out)
```

```cpp
#include <hip/hip_runtime.h>
#include <cstdio>
#include <cstdint>

#ifndef PER_PHASE_LAUNCH
#define PER_PHASE_LAUNCH 1
#endif
#ifndef PHASE_LIMIT
#define PHASE_LIMIT 100
#endif
#ifndef P0_MASK
#define P0_MASK 63
#endif
#ifndef P0_T
#define P0_T 127
#endif

#define LAS __attribute__((address_space(3)))
typedef unsigned short bf16_t;
typedef short bf16x8 __attribute__((ext_vector_type(8)));
typedef short s16x4 __attribute__((ext_vector_type(4)));
typedef float f32x4 __attribute__((ext_vector_type(4)));
typedef float f32x2 __attribute__((ext_vector_type(2)));
typedef unsigned u32x4 __attribute__((ext_vector_type(4)));
typedef unsigned u32x2 __attribute__((ext_vector_type(2)));

constexpr int D = 1024, TL = 16384, ML = 32768, TCX = 256, MC = 512, MT = 33280;
constexpr int NEIN = 2048, DFF = 2816, NFF2 = 5632, NREC = 5120, DEX = 3584, NEX2 = 7168, NE = 8;
constexpr int NSEG = 64, SEGL = 256, CH = 32, NCHAIN = 32;
constexpr int MAXTILES = 268, NITEM16 = MT / 16;
constexpr float EPS = 1e-6f;

constexpr size_t MiB = 1u << 20, KiB = 1u << 10;
constexpr size_t WS_CTL = 0, CTL_BYTES = 1 * MiB;
constexpr size_t WS_MODS = 1 * MiB, WS_LB = 1 * MiB + 512 * KiB;
constexpr size_t WS_FA = 2 * MiB, WS_FC = 2 * MiB + 128 * KiB, WS_FX = 2 * MiB + 256 * KiB, WS_GW = 2 * MiB + 512 * KiB;
constexpr size_t WS_XC = 3 * MiB;
constexpr size_t WS_TOPE = 5 * MiB, WS_TOPP = 5 * MiB + 512 * KiB, WS_RANK = 6 * MiB, WS_CNT = 6 * MiB + 512 * KiB, WS_TILEX = 6 * MiB + 768 * KiB, WS_SLOTROW = 7 * MiB, WS_SLOTDST = 7 * MiB + 512 * KiB;
constexpr size_t WS_WINE = 8 * MiB, WS_WOUTE = 16 * MiB, WS_WINO = 20 * MiB, WS_WOUTO = 40 * MiB, WS_W13 = 44 * MiB, WS_W2 = 66 * MiB;
constexpr size_t WS_W13M = 80 * MiB, WS_W2M = 192 * MiB;
constexpr size_t WS_H = 248 * MiB, WS_YE = 314 * MiB, WS_BIG = 444 * MiB;
constexpr size_t WS_PZUV = WS_BIG, WS_UP = WS_BIG + 130 * MiB, WS_HID = WS_BIG, WS_P5 = WS_BIG, WS_SST = WS_BIG + 325 * MiB, WS_EG = WS_BIG + 453 * MiB, WS_S0 = WS_BIG + 454 * MiB, WS_HIDM = WS_BIG;
constexpr size_t WS_END = WS_BIG + 469 * MiB;
static_assert(WS_W2 + (size_t)2 * D * DFF * 2 <= WS_W13M, "static weights");
static_assert(WS_W2M + (size_t)NE * D * DEX * 2 <= WS_H && WS_H + (size_t)MT * D * 2 <= WS_YE && WS_YE + (size_t)MT * 2 * D * 2 <= WS_BIG, "ws map");
static_assert((size_t)MAXTILES * 256 * DEX * 2 <= 469 * MiB && (size_t)MT * NREC * 2 <= 325 * MiB && (size_t)MT * NEIN * 2 <= 130 * MiB, "big region");

constexpr int LDS_BYTES = 147456, MISC_OFF = 147456 - 256;
constexpr int XRS = 288;

__device__ __forceinline__ unsigned f2bf(float f) { unsigned u = __builtin_bit_cast(unsigned, f); return (u + 0x7fffu + ((u >> 16) & 1u)) >> 16; }
__device__ __forceinline__ unsigned pk2(float lo, float hi) { return f2bf(lo) | (f2bf(hi) << 16); }
__device__ __forceinline__ float bf2f(unsigned short b) { return __builtin_bit_cast(float, (unsigned)b << 16); }
__device__ __forceinline__ float bflo(unsigned w) { return __builtin_bit_cast(float, w << 16); }
__device__ __forceinline__ float bfhi(unsigned w) { return __builtin_bit_cast(float, w & 0xffff0000u); }
__device__ __forceinline__ float wave_sum(float v) {
#pragma unroll
    for (int o = 1; o < 64; o <<= 1) v += __shfl_xor(v, o);
    return v;
}
__device__ __forceinline__ float siluf(float a) { return a * __builtin_amdgcn_rcpf(1.0f + __expf(-a)); }
#define LDS_WAIT() asm volatile("s_waitcnt lgkmcnt(0)" ::: "memory")
#define VM_WAIT() asm volatile("s_waitcnt vmcnt(0)" ::: "memory")

#define XB_TMO      128
#define XB_XCNT(j)  (256  + 64 * (j))
#define XB_XSUB(j)  (1280 + 64 * (j))
#define XB_XGEN(j)  (2304 + 64 * (j))
#define XB_TOP      3328
#define XB_TOPGEN   3392
#define XCD_BAR_WORDS 3456
#define XB_SPIN_CAP (1u << 18)
__device__ __forceinline__ unsigned xb_ld(unsigned* p)              { return __hip_atomic_load(p, __ATOMIC_RELAXED, __HIP_MEMORY_SCOPE_AGENT); }
__device__ __forceinline__ unsigned xb_add(unsigned* p, unsigned v) { return __hip_atomic_fetch_add(p, v, __ATOMIC_RELAXED, __HIP_MEMORY_SCOPE_AGENT); }
__device__ __forceinline__ unsigned xb_xcc_id() { return (unsigned)__builtin_amdgcn_s_getreg((3 << 11) | 20) & 0xFu; }
#define XB_SPIN(cond, bar) do { unsigned _sp = 0; while (cond) { __builtin_amdgcn_s_sleep(1); \
    if ((++_sp & 255u) == 0u) { if (xb_ld(&(bar)[XB_TMO])) break; if (_sp > XB_SPIN_CAP) { atomicAdd(&(bar)[XB_TMO], 1u); break; } } } } while (0)
struct XcdBarrier { unsigned* bar; unsigned x; volatile LAS unsigned* st; };
__device__ __forceinline__ XcdBarrier xcd_barrier_post(unsigned* bar, volatile LAS unsigned* st) {
    XcdBarrier b; b.bar = bar; b.x = xb_xcc_id(); b.st = st;
    if (threadIdx.x == 0) (void)xb_add(&bar[XB_XCNT(b.x)], 1u);
    return b;
}
__device__ __forceinline__ void xcd_barrier_complete(unsigned* bar, unsigned x, unsigned& nloc, unsigned& nx) {
    const unsigned G = gridDim.x * gridDim.y * gridDim.z;
    unsigned sum, cnt, mine, sp = 0u;
    for (;;) {
        sum = 0u; cnt = 0u; mine = 0u;
#pragma unroll
        for (unsigned j = 0; j < 16; ++j) { const unsigned c = xb_ld(&bar[XB_XCNT(j)]); sum += c; cnt += (c > 0u) ? 1u : 0u; mine = (j == x) ? c : mine; }
        if (sum == G) break;
        __builtin_amdgcn_s_sleep(1);
        if ((++sp & 255u) == 0u) { if (xb_ld(&bar[XB_TMO])) break; if (sp > XB_SPIN_CAP) { atomicAdd(&bar[XB_TMO], 1u); break; } }
    }
    nloc = mine > 0u ? mine : 1u; nx = cnt > 0u ? cnt : 1u;
}
__device__ __forceinline__ void xcd_barrier(const XcdBarrier& b) {
    asm volatile("s_waitcnt vmcnt(0)" ::: "memory");
    __syncthreads();
    if (threadIdx.x == 0) {
        unsigned* bar = b.bar;
        __builtin_amdgcn_s_waitcnt(0);
        unsigned nloc = b.st[0], nx = b.st[1];
        if (nloc == 0u) { xcd_barrier_complete(bar, b.x, nloc, nx); b.st[0] = nloc; b.st[1] = nx; }
        const unsigned old = xb_add(&bar[XB_XSUB(b.x)], 1u);
        const unsigned gen = old / nloc;
        if (old + 1u == (gen + 1u) * nloc) {
            __builtin_amdgcn_fence(__ATOMIC_RELEASE, "agent");
            asm volatile("s_waitcnt vmcnt(0)" ::: "memory");
            const unsigned og = xb_add(&bar[XB_TOP], 1u);
            const unsigned tg = og / nx;
            if (og + 1u == (tg + 1u) * nx) xb_add(&bar[XB_TOPGEN], 1u);
            else XB_SPIN(xb_ld(&bar[XB_TOPGEN]) == tg, bar);
            __builtin_amdgcn_fence(__ATOMIC_ACQUIRE, "agent");
            xb_add(&bar[XB_XGEN(b.x)], 1u);
            asm volatile("s_waitcnt vmcnt(0)" ::: "memory");
        } else {
            XB_SPIN(xb_ld(&bar[XB_XGEN(b.x)]) == gen, bar);
            __builtin_amdgcn_fence(__ATOMIC_ACQUIRE, "agent");
            asm volatile("s_waitcnt vmcnt(0)" ::: "memory");
        }
    }
    __syncthreads();
}

namespace pg8 {
constexpr int BM = 256, BK = 64, HALF = 128, HTB = HALF * BK * 2, STAGE_BYTES = 8 * HTB, NXCD = 8, WGM = 8;
__host__ __device__ __forceinline__ int lds_byte(int r, int c) { const int st = (r >> 4) * 2 + (c >> 5), rr = r & 15, cc = c & 31, ob = rr * 64 + cc * 2; return st * 1024 + (ob ^ (((ob >> 9) & 1) << 5)); }
__host__ __device__ __forceinline__ void stage_rc(int b, int& R, int& C) { const int st = b / 1024, sb = b % 1024, swz = sb ^ (((sb >> 9) & 1) << 5); R = (st >> 1) * 16 + swz / 64; C = (st & 1) * 32 + (swz % 64) / 2; }
__host__ __device__ __forceinline__ int perm32(int rho) { const int n = rho >> 4, i = rho & 15; return 8 * (i >> 2) + 4 * n + (i & 3); }
struct Unit { int pm, pn; };
struct Gemm { const bf16_t* A; const bf16_t* Bt; int M, N, K; const int* arow; const int* grp; size_t gstride; };
struct StaticOrder {
    int nM, nN, nwg, G, c;
    __host__ __device__ void init(int M, int N, int G_, int c_) { nM = M / BM; nN = N / BM; nwg = nM * nN; G = G_; c = c_; }
    __host__ __device__ bool next(int i, Unit& u) const {
        const long L = (long)i * G + c; if (L >= nwg) return false;
        int wgid = (int)L; { const int q = nwg / NXCD, r = nwg % NXCD, xcd = wgid % NXCD, off = wgid / NXCD; wgid = (xcd < r ? xcd * (q + 1) : r * (q + 1) + (xcd - r) * q) + off; }
        const int nig = WGM * nN, gid = wgid / nig, fm = gid * WGM, gsz = (nM - fm) < WGM ? (nM - fm) : WGM;
        u.pm = fm + ((wgid % nig) % gsz); u.pn = (wgid % nig) / gsz; return true;
    }
};
__device__ __forceinline__ unsigned cvt_pk_bf16(float lo, float hi) { unsigned r; asm volatile("v_cvt_pk_bf16_f32 %0, %1, %2" : "=v"(r) : "v"(lo), "v"(hi)); return r; }
__device__ __forceinline__ f32x2 gelu_pk(f32x2 v) {
    const f32x2 av = __builtin_elementwise_abs(v), d = av * 0.2316418882f + 1.0f;
    f32x2 t; t.x = __builtin_amdgcn_rcpf(d.x); t.y = __builtin_amdgcn_rcpf(d.y);
    f32x2 q = t * 0.5307027145f + (-0.7265760135f); q = q * t + 0.7107068705f; q = q * t + (-0.142248368f); q = q * t + 0.127414796f; q = q * t;
    const f32x2 s = (v * v) * (-0.72134752044f);
    f32x2 e; e.x = __builtin_amdgcn_exp2f(s.x); e.y = __builtin_amdgcn_exp2f(s.y);
    const f32x2 m = v * (q * e), r = v - m;
    f32x2 o; o.x = v.x < 0.f ? m.x : r.x; o.y = v.y < 0.f ? m.y : r.y; return o;
}
template <class Epi, class Sched, bool ALIGN_EPI, bool GATHER>
__device__ __forceinline__ void gemm_phase(LAS unsigned char* lds, const Gemm g, const Sched& S, const Epi& E, const int tid) {
    const int wid = __builtin_amdgcn_readfirstlane(tid >> 6), lane = tid & 63, wr = wid >> 2, wc = wid & 3, fr = lane & 15, fq = lane >> 4;
    const int K = g.K, nt = K / BK;
    unsigned voffA[2], voffB[2];
    unsigned voffA1[2];
#pragma unroll
    for (int i = 0; i < 2; ++i) { int R, C; stage_rc(tid * 16 + i * 8192, R, C); const int Rb = Epi::PERM ? ((R & ~31) + perm32(R & 31)) : R;
        voffA[i] = (unsigned)(R * K + C) * 2u; voffA1[i] = voffA[i]; voffB[i] = (unsigned)(Rb * K + C) * 2u; }
    const size_t kstep = (size_t)(BK * 2);
    const size_t hstep = (size_t)HALF * K * 2;
    const size_t tstep = 2 * hstep;
    const unsigned ldsw = (unsigned)wid * 1024u;
    const int aoff = lds_byte(wr * 64 + fr, fq * 8), boff = lds_byte(wc * 32 + fr, fq * 8);
#define PG8_SA(b, h) (((b) * 2 + (h)) * HTB)
#define PG8_SB(b, h) ((4 + (b) * 2 + (h)) * HTB)
#define PG8_STAGE(bufoff, gbase, voff) do { _Pragma("unroll") for (int _i = 0; _i < 2; ++_i) \
        __builtin_amdgcn_global_load_lds((const unsigned*)((const char*)(gbase) + (voff)[_i]), (LAS unsigned*)(lds + (bufoff) + ldsw + _i * 8192), 16, 0, 0); } while (0)
#define PG8_LDA(dst, b, h) do { _Pragma("unroll") for (int m = 0; m < 4; ++m) _Pragma("unroll") for (int k = 0; k < 2; ++k) dst[m][k] = *(const LAS bf16x8*)(lds + PG8_SA(b, h) + aoff + m * 2048 + k * 1024); } while (0)
#define PG8_LDB(dst, b, h) do { _Pragma("unroll") for (int n = 0; n < 2; ++n) _Pragma("unroll") for (int k = 0; k < 2; ++k) dst[n][k] = *(const LAS bf16x8*)(lds + PG8_SB(b, h) + boff + n * 2048 + k * 1024); } while (0)
#define PG8_MMA(ai, bj, At, Bt) do { __builtin_amdgcn_s_setprio(1); _Pragma("unroll") for (int m = 0; m < 4; ++m) _Pragma("unroll") for (int n = 0; n < 2; ++n) _Pragma("unroll") for (int k = 0; k < 2; ++k) \
        acc[ai][bj][m][n] = __builtin_amdgcn_mfma_f32_16x16x32_bf16(Bt[n][k], At[m][k], acc[ai][bj][m][n], 0, 0, 0); __builtin_amdgcn_s_setprio(0); } while (0)
#define PG8_WAIT_V(n) asm volatile("s_waitcnt vmcnt(" #n ")" ::: "memory")
#define PG8_WAIT_L(n) asm volatile("s_waitcnt lgkmcnt(" #n ")" ::: "memory")
#define PG8_BAR __builtin_amdgcn_s_barrier()
#define PG8_SCHED __builtin_amdgcn_sched_barrier(0)
#define PG8_GOFF(u, v0, v1) do { _Pragma("unroll") for (int _i = 0; _i < 2; ++_i) { int R_, C_; stage_rc(tid * 16 + _i * 8192, R_, C_); \
        const int r0_ = g.arow[(u).pm * BM + R_], r1_ = g.arow[(u).pm * BM + HALF + R_]; v0[_i] = (unsigned)(r0_ * K + C_) * 2u; v1[_i] = (unsigned)(r1_ * K + C_) * 2u; } } while (0)
#define PG8_BBASE(u) ((const char*)g.Bt + (g.grp ? (size_t)g.grp[(u).pm] * g.gstride * 2 : (size_t)0) + (size_t)(u).pn * tstep)
    Unit cur, nxt; int ui = 0;
    if (!S.next(0, cur)) return;
    f32x4 acc[2][2][4][2];
#pragma unroll
    for (int a = 0; a < 2; ++a)
#pragma unroll
        for (int b = 0; b < 2; ++b)
#pragma unroll
            for (int m = 0; m < 4; ++m)
#pragma unroll
                for (int n = 0; n < 2; ++n) acc[a][b][m][n] = (f32x4){0.f, 0.f, 0.f, 0.f};
    bf16x8 At[4][2], B0[2][2], B1[2][2];
    const char* cA = GATHER ? (const char*)g.A : (const char*)g.A + (size_t)cur.pm * tstep;
    const size_t ah = GATHER ? (size_t)0 : hstep;
    if constexpr (GATHER) PG8_GOFF(cur, voffA, voffA1);
    const char* cB = PG8_BBASE(cur);
    PG8_STAGE(PG8_SB(0, 0), cB, voffB); PG8_STAGE(PG8_SA(0, 0), cA, voffA); PG8_STAGE(PG8_SB(0, 1), cB + hstep, voffB); PG8_STAGE(PG8_SA(0, 1), cA + ah, voffA1);
    if (wr == 1) PG8_BAR;
    PG8_WAIT_V(4); PG8_BAR;
    PG8_STAGE(PG8_SB(1, 0), cB + kstep, voffB); PG8_STAGE(PG8_SA(1, 0), cA + kstep, voffA); PG8_STAGE(PG8_SB(1, 1), cB + hstep + kstep, voffB);
    PG8_WAIT_V(6); PG8_BAR;
    for (;;) {
        const bool has_next = S.next(ui + 1, nxt);
        const char* nA = (GATHER || !has_next) ? cA : (const char*)g.A + (size_t)nxt.pm * tstep; const char* nB = has_next ? PG8_BBASE(nxt) : cB;
        for (int t = 0; t < nt; t += 2) {
            const bool last = (t == nt - 2);
            const char* a1 = cA + (size_t)(t + 1) * kstep;
            const char* a2 = last ? nA : cA + (size_t)(t + 2) * kstep; const char* b2 = last ? nB : cB + (size_t)(t + 2) * kstep;
            const char* a3 = a2 + kstep; const char* b3 = b2 + kstep;
            PG8_LDB(B0, 0, 0); PG8_SCHED; PG8_LDA(At, 0, 0); PG8_STAGE(PG8_SA(1, 1), a1 + ah, voffA1);
            if constexpr (GATHER) { if (last && has_next) PG8_GOFF(nxt, voffA, voffA1); }
            PG8_WAIT_L(8); PG8_BAR; PG8_WAIT_L(0); PG8_MMA(0, 0, At, B0); PG8_BAR; PG8_SCHED;
            PG8_LDB(B1, 0, 1); PG8_STAGE(PG8_SB(0, 0), b2, voffB);
            PG8_BAR; PG8_WAIT_L(0); PG8_MMA(0, 1, At, B1); PG8_BAR;
            PG8_LDA(At, 0, 1); PG8_STAGE(PG8_SA(0, 0), a2, voffA);
            PG8_BAR; PG8_WAIT_L(0); PG8_MMA(1, 0, At, B0); PG8_BAR; PG8_SCHED;
            PG8_STAGE(PG8_SB(0, 1), b2 + hstep, voffB);
            PG8_WAIT_V(6); PG8_BAR; PG8_MMA(1, 1, At, B1); PG8_BAR;
            PG8_LDB(B0, 1, 0); PG8_SCHED; PG8_LDA(At, 1, 0); PG8_STAGE(PG8_SA(0, 1), a2 + ah, voffA1);
            PG8_WAIT_L(8); PG8_BAR; PG8_WAIT_L(0); PG8_MMA(0, 0, At, B0); PG8_BAR; PG8_SCHED;
            PG8_LDB(B1, 1, 1); PG8_STAGE(PG8_SB(1, 0), b3, voffB);
            PG8_BAR; PG8_WAIT_L(0); PG8_MMA(0, 1, At, B1); PG8_BAR;
            PG8_LDA(At, 1, 1); PG8_STAGE(PG8_SA(1, 0), a3, voffA);
            PG8_BAR; PG8_WAIT_L(0); PG8_MMA(1, 0, At, B0); PG8_BAR; PG8_SCHED;
            PG8_STAGE(PG8_SB(1, 1), b3 + hstep, voffB);
            PG8_WAIT_V(6); PG8_BAR; PG8_MMA(1, 1, At, B1); PG8_BAR;
        }
        if constexpr (ALIGN_EPI) { if (wr == 0) PG8_BAR; }
        E(acc, cur, wr, wc, fr, fq);
        if (!has_next) break;
#pragma unroll
        for (int a = 0; a < 2; ++a)
#pragma unroll
            for (int b = 0; b < 2; ++b)
#pragma unroll
                for (int m = 0; m < 4; ++m)
#pragma unroll
                    for (int n = 0; n < 2; ++n) acc[a][b][m][n] = (f32x4){0.f, 0.f, 0.f, 0.f};
        cur = nxt; cA = nA; cB = nB; ++ui;
        if constexpr (ALIGN_EPI) { if (wr == 1) PG8_BAR; }
    }
    PG8_WAIT_V(0);
    if constexpr (!ALIGN_EPI) { if (wr == 0) PG8_BAR; }
    PG8_BAR;
#undef PG8_SA
#undef PG8_SB
#undef PG8_STAGE
#undef PG8_LDA
#undef PG8_LDB
#undef PG8_MMA
#undef PG8_WAIT_V
#undef PG8_WAIT_L
#undef PG8_BAR
#undef PG8_SCHED
#undef PG8_GOFF
#undef PG8_BBASE
}

struct EpiEvenIn {
    static constexpr bool PERM = true;
    bf16_t* O;
    __device__ __forceinline__ void operator()(const f32x4 (&acc)[2][2][4][2], const Unit& u, int wr, int wc, int fr, int fq) const {
        const int row0 = u.pm * BM + wr * 64 + fr, col0 = u.pn * BM + wc * 32 + 8 * fq; const bool act = u.pn >= 4;
#pragma unroll
        for (int ai = 0; ai < 2; ++ai)
#pragma unroll
            for (int m = 0; m < 4; ++m) { bf16_t* rowp = O + (size_t)(row0 + ai * HALF + m * 16) * NEIN + col0;
#pragma unroll
                for (int bj = 0; bj < 2; ++bj) { f32x4 v0 = acc[ai][bj][m][0], v1 = acc[ai][bj][m][1];
                    if (act) { f32x2 a = gelu_pk((f32x2){v0[0], v0[1]}), b = gelu_pk((f32x2){v0[2], v0[3]}), c = gelu_pk((f32x2){v1[0], v1[1]}), d = gelu_pk((f32x2){v1[2], v1[3]});
                        v0 = (f32x4){a.x, a.y, b.x, b.y}; v1 = (f32x4){c.x, c.y, d.x, d.y}; }
                    u32x4 w; w.x = cvt_pk_bf16(v0[0], v0[1]); w.y = cvt_pk_bf16(v0[2], v0[3]); w.z = cvt_pk_bf16(v1[0], v1[1]); w.w = cvt_pk_bf16(v1[2], v1[3]);
                    *(u32x4*)(rowp + bj * HALF) = w; } }
    }
};
struct EpiRes {
    static constexpr bool PERM = false;
    const float* sl; const float* sc; float* dl; float* dc; const float* gate;
    __device__ __forceinline__ void operator()(const f32x4 (&acc)[2][2][4][2], const Unit& u, int wr, int wc, int fr, int fq) const {
        const int col0 = u.pn * BM + wc * 32 + 4 * fq;
        const bool isc = u.pm >= 128; const int ms = isc ? 2 : (u.pm >= 64 ? 1 : 0);
        const size_t rbase = isc ? (size_t)(u.pm - 128) * BM : (size_t)u.pm * BM;
        const float* src = (isc ? sc : sl) + rbase * D; float* dst = (isc ? dc : dl) + rbase * D;
        f32x4 gv[2][2];
#pragma unroll
        for (int bj = 0; bj < 2; ++bj)
#pragma unroll
            for (int n = 0; n < 2; ++n) gv[bj][n] = *(const f32x4*)(gate + ms * 6144 + col0 + bj * HALF + n * 16);
#pragma unroll
        for (int ai = 0; ai < 2; ++ai)
#pragma unroll
            for (int m = 0; m < 4; ++m) { const size_t off = (size_t)(ai * HALF + wr * 64 + m * 16 + fr) * D + col0;
#pragma unroll
                for (int bj = 0; bj < 2; ++bj)
#pragma unroll
                    for (int n = 0; n < 2; ++n) { const f32x4 xs = *(const f32x4*)(src + off + bj * HALF + n * 16); *(f32x4*)(dst + off + bj * HALF + n * 16) = xs + gv[bj][n] * acc[ai][bj][m][n]; } }
    }
};
struct EpiSwiglu {
    static constexpr bool PERM = true;
    bf16_t* O; int ldc;
    __device__ __forceinline__ void operator()(const f32x4 (&acc)[2][2][4][2], const Unit& u, int wr, int wc, int fr, int fq) const {
        const int row0 = u.pm * BM + wr * 64 + fr, col0 = u.pn * 128 + wc * 16 + 4 * fq;
#pragma unroll
        for (int ai = 0; ai < 2; ++ai)
#pragma unroll
            for (int m = 0; m < 4; ++m) { bf16_t* rowp = O + (size_t)(row0 + ai * HALF + m * 16) * ldc + col0;
#pragma unroll
                for (int bj = 0; bj < 2; ++bj) { const f32x4 a = acc[ai][bj][m][0], b = acc[ai][bj][m][1];
                    u32x2 w; w.x = cvt_pk_bf16(siluf(a[0]) * b[0], siluf(a[1]) * b[1]); w.y = cvt_pk_bf16(siluf(a[2]) * b[2], siluf(a[3]) * b[3]);
                    *(u32x2*)(rowp + bj * 64) = w; } }
    }
};
struct EpiOddIn {
    static constexpr bool PERM = true;
    bf16_t* O; const float* lb;
    __device__ __forceinline__ void operator()(const f32x4 (&acc)[2][2][4][2], const Unit& u, int wr, int wc, int fr, int fq) const {
        const int row0 = u.pm * BM + wr * 64 + fr, col0 = u.pn * BM + wc * 32 + 8 * fq; const int seg = u.pn >> 2;
        f32x4 lbv[2][2];
#pragma unroll
        for (int bj = 0; bj < 2; ++bj)
#pragma unroll
            for (int n = 0; n < 2; ++n) lbv[bj][n] = (seg == 2 || seg == 3) ? *(const f32x4*)(lb + (col0 - 2048) + bj * HALF + 4 * n) : (f32x4){0.f, 0.f, 0.f, 0.f};
#pragma unroll
        for (int ai = 0; ai < 2; ++ai)
#pragma unroll
            for (int m = 0; m < 4; ++m) { bf16_t* rowp = O + (size_t)(row0 + ai * HALF + m * 16) * NREC + col0;
#pragma unroll
                for (int bj = 0; bj < 2; ++bj) { f32x4 v[2] = {acc[ai][bj][m][0], acc[ai][bj][m][1]};
#pragma unroll
                    for (int n = 0; n < 2; ++n)
#pragma unroll
                        for (int i = 0; i < 4; ++i) { float x = v[n][i];
                            if (seg == 0) x = siluf(x) * 0.08838834764831845f;
                            else if (seg == 1) x = siluf(x);
                            else if (seg == 2 || seg == 3) { const float l = lbv[bj][n][i]; const float s = __builtin_amdgcn_rcpf(1.0f + __expf(-x)); const float f = l + (1.0f - l) * s; x = __logf(fmaxf(f, 1e-30f)); }
                            v[n][i] = x; }
                    u32x4 w; w.x = cvt_pk_bf16(v[0][0], v[0][1]); w.y = cvt_pk_bf16(v[0][2], v[0][3]); w.z = cvt_pk_bf16(v[1][0], v[1][1]); w.w = cvt_pk_bf16(v[1][2], v[1][3]);
                    *(u32x4*)(rowp + bj * HALF) = w; } }
    }
};
struct EpiMoeDown {
    static constexpr bool PERM = true;
    bf16_t* O; const int* dst;
    __device__ __forceinline__ void operator()(const f32x4 (&acc)[2][2][4][2], const Unit& u, int wr, int wc, int fr, int fq) const {
        const int row0 = u.pm * BM + wr * 64 + fr, col0 = u.pn * BM + wc * 32 + 8 * fq;
        int dd[2][4];
#pragma unroll
        for (int ai = 0; ai < 2; ++ai)
#pragma unroll
            for (int m = 0; m < 4; ++m) dd[ai][m] = dst[row0 + ai * HALF + m * 16];
#pragma unroll
        for (int ai = 0; ai < 2; ++ai)
#pragma unroll
            for (int m = 0; m < 4; ++m) { if (dd[ai][m] >= 0) { bf16_t* rowp = O + (size_t)dd[ai][m] * D + col0;
#pragma unroll
                for (int bj = 0; bj < 2; ++bj) { const f32x4 v0 = acc[ai][bj][m][0], v1 = acc[ai][bj][m][1];
                    u32x4 w; w.x = cvt_pk_bf16(v0[0], v0[1]); w.y = cvt_pk_bf16(v0[2], v0[3]); w.z = cvt_pk_bf16(v1[0], v1[1]); w.w = cvt_pk_bf16(v1[2], v1[3]);
                    *(u32x4*)(rowp + bj * HALF) = w; } } }
    }
};
}

struct Args { const float* in[24]; float* out; unsigned char* ws; int ph_lo, ph_hi; };
enum { I_X = 0, I_C, I_CTX, I_CCTX, I_WADA, I_BADA, I_NMIX, I_NFFN, I_NOUT, I_WINE, I_GW, I_GB, I_WOUTE, I_WINO, I_RLB, I_RNORM, I_WOUTO, I_F1, I_F3, I_F2, I_RW, I_M1, I_M3, I_M2 };
enum { PH_P0 = 0, PH_PAIR0 = 1, NPL = 18, PH_FINAL = 1 + 2 * NPL, NPHASE = PH_FINAL + 1 };
enum { E1_NORM = 0, E2_GIN, E3_FFTA, E3_FFTC, E4_GOUT, E5_NORM, E6_UP, E7_DOWN, O1_NORM, O2_GIN, O3_SCAN1, O4_CARRY, O5_SCAN3, O6_GOUT, O7_NORM, O8_SLOTS, O9_MUP, O10_MDOWN };

struct Ctx {
    LAS unsigned char* lds; int tid, lane, wave, G, bid, gw, NGW;
    const float* const* in; float* out; unsigned char* ws;
};

__device__ __forceinline__ void transpose_item(const float* W, int ld, int K, int N, bf16_t* WT, int mode, int roff, LAS float* scr, int item, int lane) {
    const int nblk = N / 32, kb = item / nblk, nb = item % nblk, k0 = 64 * kb, n0 = 32 * nb;
#pragma unroll 8
    for (int i = 0; i < 32; ++i) { const int kk = 2 * i + (lane >> 5); scr[kk * 33 + (lane & 31)] = W[(size_t)(k0 + kk) * ld + n0 + (lane & 31)]; }
    LDS_WAIT(); asm volatile("" ::: "memory");
    const int c = lane & 7;
#pragma unroll
    for (int j = 0; j < 4; ++j) { const int n = (lane >> 3) + 8 * j; const LAS float* s = scr + (8 * c) * 33 + n;
        u32x4 o; o.x = pk2(s[0 * 33], s[1 * 33]); o.y = pk2(s[2 * 33], s[3 * 33]); o.z = pk2(s[4 * 33], s[5 * 33]); o.w = pk2(s[6 * 33], s[7 * 33]);
        const int ng = n0 + n; const int drow = mode == 0 ? (roff + ng) : (((ng >> 2) << 3) + (ng & 3) + roff);
        *(u32x4*)(WT + (size_t)drow * K + k0 + 8 * c) = o; }
    LDS_WAIT(); asm volatile("" ::: "memory");
}

__device__ __forceinline__ void p0_prologue(const Ctx& F) {
    const int tid = F.tid, lane = F.lane, wave = F.wave;
    unsigned char* ws = F.ws;
    LAS float* scond = (LAS float*)(F.lds);
    LAS float* part = (LAS float*)(F.lds + 16384);
    LAS float* ctab = (LAS float*)(F.lds + 32768);
    for (int i = tid; i < 3 * D; i += 512) { const int v = i / D, k = i % D; const float c = v < 2 ? F.in[I_C][v * D + k] : F.in[I_CCTX][k]; scond[i] = c / (1.0f + expf(-c)); }
    if (tid < 128) ctab[tid] = cosf(6.283185307179586f * (float)tid / 128.0f);
    __syncthreads();
    float* mods = (float*)(ws + WS_MODS);
    if (P0_MASK & 1)
    for (int it = F.bid; it < 4 * 96; it += F.G) {
        const int l = it / 96, cg = it % 96; const float* W = F.in[I_WADA] + (size_t)l * D * 6144 + cg * 64 + lane;
        float a0 = 0.f, a1 = 0.f, a2 = 0.f;
#pragma unroll 8
        for (int kk = 0; kk < 128; ++kk) { const int k = wave * 128 + kk; const float w = W[(size_t)k * 6144]; a0 += scond[k] * w; a1 += scond[D + k] * w; a2 += scond[2 * D + k] * w; }
        part[(wave * 3 + 0) * 64 + lane] = a0; part[(wave * 3 + 1) * 64 + lane] = a1; part[(wave * 3 + 2) * 64 + lane] = a2;
        __syncthreads();
        if (tid < 192) { const int v = tid / 64, c = tid % 64; float s = 0.f;
#pragma unroll
            for (int w = 0; w < 8; ++w) s += part[(w * 3 + v) * 64 + c];
            mods[((size_t)l * 3 + v) * 6144 + cg * 64 + c] = s + F.in[I_BADA][l * 6144 + cg * 64 + c]; }
        __syncthreads();
    }
    const int gt = F.bid * 512 + tid, NGT = F.G * 512;
    float* LB = (float*)(ws + WS_LB);
    if (P0_MASK & 2)
    for (int i = gt; i < 4096; i += NGT) { const int j = i >> 11, r = i & 2047; float v = 0.f; if (j == 1) { const float r0 = F.in[I_RLB][r], r1 = F.in[I_RLB][2048 + r]; v = 1.0f / (1.0f + expf(r0 - r1)); v = fminf(fmaxf(v, 0.f), 1.f); } LB[i] = v; }
    bf16_t* FA = (bf16_t*)(ws + WS_FA); bf16_t* FC = (bf16_t*)(ws + WS_FC); bf16_t* FX = (bf16_t*)(ws + WS_FX); bf16_t* GW = (bf16_t*)(ws + WS_GW);
    if (P0_MASK & 4)
    for (int i = gt; i < 256 * 256; i += NGT) { const int r = i >> 8, c = i & 255, k1 = r & 127, t1 = c & 127; const float ang = 6.283185307179586f * (float)((k1 * t1) & 127) / 128.0f; float sn, cs; sincosf(ang, &sn, &cs);
        const int rr = r >> 7, cc = c >> 7; const float v = (rr == cc) ? cs : (rr == 0 ? -sn : sn); FA[i] = (bf16_t)f2bf(v); }
    if (P0_MASK & 4)
    for (int i = gt; i < 128 * 256; i += NGT) { const int k2 = i >> 8, c = i & 255, t2 = c & 127; const float ang = 6.283185307179586f * (float)((k2 * t2) & 127) / 128.0f; float sn, cs; sincosf(ang, &sn, &cs); FC[i] = (bf16_t)f2bf(c < 128 ? cs : -sn); }
    if (P0_MASK & 4)
    for (int i = gt; i < 256 * 512; i += NGT) { const int k = i >> 9, c = i & 511, t = c & 255; const float ang = 6.283185307179586f * (float)((k * t) & 255) / 256.0f; float sn, cs; sincosf(ang, &sn, &cs); FX[i] = (bf16_t)f2bf(c < 256 ? cs : -sn); }
    if (P0_MASK & 8)
    for (int i = gt; i < 2 * 4 * 128 * 128; i += NGT) GW[i] = (bf16_t)f2bf(F.in[I_GW][i]);
    bf16_t* WinE = (bf16_t*)(ws + WS_WINE);
    if (P0_MASK & 16)
    for (int it = F.gw; it < 2 * 4 * 16 * 32; it += F.NGW) {
        const int mg = it & 31, kb = (it >> 5) & 15, g = (it >> 9) & 3, j = it >> 11; const int k = kb * 64 + lane, m0 = mg * 4;
        const float* Wr = F.in[I_WINE] + (size_t)j * D * 1536 + (size_t)k * 1536 + g * 128;
        float aP[4] = {0.f, 0.f, 0.f, 0.f}, aQ[4] = {0.f, 0.f, 0.f, 0.f};
        for (int c4 = 0; c4 < 32; ++c4) { const f32x4 w = *(const f32x4*)(Wr + 4 * c4);
#pragma unroll
            for (int ci = 0; ci < 4; ++ci) { const int c = 4 * c4 + ci;
#pragma unroll
                for (int mm = 0; mm < 4; ++mm) { const int idx = (c * (m0 + mm)) & 127; aP[mm] += w[ci] * ctab[idx]; aQ[mm] += w[ci] * ctab[(idx - 32) & 127]; } } }
#pragma unroll
        for (int mm = 0; mm < 4; ++mm) { bf16_t* o = WinE + (size_t)j * NEIN * D; o[(size_t)(g * 128 + m0 + mm) * D + k] = (bf16_t)f2bf(aP[mm]); o[(size_t)(512 + g * 128 + m0 + mm) * D + k] = (bf16_t)f2bf(aQ[mm]); }
    }
    LAS float* scr = (LAS float*)(F.lds + 40960 + wave * 8704);
    constexpr int NI_UV = 16 * 32, NI_SQ = 16 * 32, NI_INO = 16 * 160, NI_F13 = 16 * 88, NI_F2 = 44 * 32;
    constexpr int PER_J = NI_UV + NI_SQ + NI_INO + NI_SQ + 2 * NI_F13 + NI_F2;
    if (P0_MASK & 32)
    for (int it = F.gw; it < 2 * PER_J; it += F.NGW) {
        const int j = it / PER_J; int r = it % PER_J;
        const float* W; int ld, K, N, mode = 0, roff = 0, tsel = 0; bf16_t* WT;
        if (r < NI_UV) { W = F.in[I_WINE] + (size_t)j * D * 1536 + 512; ld = 1536; K = D; N = 1024; WT = WinE + (size_t)j * NEIN * D; roff = 1024; }
        else if ((r -= NI_UV) < NI_SQ) { W = F.in[I_WOUTE] + (size_t)j * D * D; ld = D; K = D; N = D; WT = (bf16_t*)(ws + WS_WOUTE) + (size_t)j * D * D; tsel = 1; }
        else if ((r -= NI_SQ) < NI_INO) { W = F.in[I_WINO] + (size_t)j * D * NREC; ld = NREC; K = D; N = NREC; WT = (bf16_t*)(ws + WS_WINO) + (size_t)j * NREC * D; tsel = 2; }
        else if ((r -= NI_INO) < NI_SQ) { W = F.in[I_WOUTO] + (size_t)j * D * D; ld = D; K = D; N = D; WT = (bf16_t*)(ws + WS_WOUTO) + (size_t)j * D * D; tsel = 3; }
        else if ((r -= NI_SQ) < NI_F13) { W = F.in[I_F1] + (size_t)j * D * DFF; ld = DFF; K = D; N = DFF; WT = (bf16_t*)(ws + WS_W13) + (size_t)j * NFF2 * D; mode = 1; tsel = 4; }
        else if ((r -= NI_F13) < NI_F13) { W = F.in[I_F3] + (size_t)j * D * DFF; ld = DFF; K = D; N = DFF; WT = (bf16_t*)(ws + WS_W13) + (size_t)j * NFF2 * D; mode = 1; roff = 4; tsel = 5; }
        else { r -= NI_F13; W = F.in[I_F2] + (size_t)j * DFF * D; ld = D; K = DFF; N = D; WT = (bf16_t*)(ws + WS_W2) + (size_t)j * D * DFF; tsel = 6; }
        if ((P0_T >> tsel) & 1) transpose_item(W, ld, K, N, WT, mode, roff, scr, r, lane);
    }
}
__device__ __forceinline__ void moe_convert(const Ctx& F, int j) {
    LAS float* scr = (LAS float*)(F.lds + 40960 + F.wave * 8704);
    constexpr int I_13 = 16 * 112, I_2 = 56 * 32, PER_E = 2 * I_13 + I_2;
    for (int it = F.gw; it < NE * PER_E; it += F.NGW) {
        const int e = it / PER_E; int r = it % PER_E; const size_t eo = (size_t)(j * NE + e);
        const float* W; int ld, K, N, mode = 0, roff = 0; bf16_t* WT;
        if (r < I_13) { W = F.in[I_M1] + eo * D * DEX; ld = DEX; K = D; N = DEX; WT = (bf16_t*)(F.ws + WS_W13M) + (size_t)e * NEX2 * D; mode = 1; }
        else if ((r -= I_13) < I_13) { W = F.in[I_M3] + eo * D * DEX; ld = DEX; K = D; N = DEX; WT = (bf16_t*)(F.ws + WS_W13M) + (size_t)e * NEX2 * D; mode = 1; roff = 4; }
        else { r -= I_13; W = F.in[I_M2] + eo * DEX * D; ld = D; K = DEX; N = D; WT = (bf16_t*)(F.ws + WS_W2M) + (size_t)e * D * DEX; }
        transpose_item(W, ld, K, N, WT, mode, roff, scr, r, F.lane);
    }
}

struct RowPass {
    const float* sl; const float* sc;
    float* dl; float* dc;
    const float* gain;
    const float* shift; const float* scale;
    bf16_t* H;
    int nrows;
    const bf16_t* YE; const float* topp; const float* gatef;
    const float* rw; int* tope; float* toppo; int* rank; int* cnt;
    float* fout;
};
template <bool COMBINE, bool ROUTER, bool FINAL>
__device__ __forceinline__ void row_pass(const Ctx& F, const RowPass& P) {
    const int lane = F.lane;
    LAS float* rwl = (LAS float*)F.lds;
    if (ROUTER) { for (int i = F.tid; i < D * NE; i += 512) rwl[i] = P.rw[i]; __syncthreads(); }
    f32x4 gn[4];
#pragma unroll
    for (int j = 0; j < 4; ++j) gn[j] = *(const f32x4*)(P.gain + 4 * lane + 256 * j);
    const int nitems = P.nrows / 16;
    for (int it = F.gw; it < nitems; it += F.NGW) {
        int rc0 = 0, rc1 = 0, rc2 = 0, rc3 = 0, rc4 = 0, rc5 = 0, rc6 = 0, rc7 = 0;
        for (int rr = 0; rr < 16; ++rr) {
            const int r = it * 16 + rr; const bool isc = r >= ML; const int ms = isc ? 2 : (r >= TL ? 1 : 0);
            const float* xs = isc ? P.sc + (size_t)(r - ML) * D : P.sl + (size_t)r * D;
            f32x4 v[4];
#pragma unroll
            for (int j = 0; j < 4; ++j) v[j] = *(const f32x4*)(xs + 4 * lane + 256 * j);
            if (COMBINE) {
                const float p0 = P.topp[2 * r], p1 = P.topp[2 * r + 1];
                const bf16_t* y0 = P.YE + (size_t)(2 * r) * D; const bf16_t* y1 = y0 + D;
                float* xd = isc ? P.dc + (size_t)(r - ML) * D : P.dl + (size_t)r * D;
#pragma unroll
                for (int j = 0; j < 4; ++j) { const u32x2 a = *(const u32x2*)(y0 + 4 * lane + 256 * j), b = *(const u32x2*)(y1 + 4 * lane + 256 * j);
                    const f32x4 gf = *(const f32x4*)(P.gatef + ms * 6144 + 4 * lane + 256 * j);
                    f32x4 y; y[0] = p0 * bflo(a.x) + p1 * bflo(b.x); y[1] = p0 * bfhi(a.x) + p1 * bfhi(b.x); y[2] = p0 * bflo(a.y) + p1 * bflo(b.y); y[3] = p0 * bfhi(a.y) + p1 * bfhi(b.y);
                    v[j] = v[j] + gf * y;
                    if (!FINAL) *(f32x4*)(xd + 4 * lane + 256 * j) = v[j]; }
            }
            float ss = 0.f;
#pragma unroll
            for (int j = 0; j < 4; ++j) ss += (v[j][0] * v[j][0] + v[j][1] * v[j][1]) + (v[j][2] * v[j][2] + v[j][3] * v[j][3]);
            const float rstd = rsqrtf(wave_sum(ss) * (1.0f / D) + EPS);
            if (FINAL) {
#pragma unroll
                for (int j = 0; j < 4; ++j) *(f32x4*)(P.fout + (size_t)r * D + 4 * lane + 256 * j) = v[j] * rstd * gn[j];
            } else {
                f32x4 h[4];
#pragma unroll
                for (int j = 0; j < 4; ++j) { const f32x4 sh = *(const f32x4*)(P.shift + ms * 6144 + 4 * lane + 256 * j), scl = *(const f32x4*)(P.scale + ms * 6144 + 4 * lane + 256 * j);
                    h[j] = (v[j] * rstd * gn[j]) * (scl + 1.0f) + sh;
                    u32x2 w; w.x = pk2(h[j][0], h[j][1]); w.y = pk2(h[j][2], h[j][3]);
                    *(u32x2*)(P.H + (size_t)r * D + 4 * lane + 256 * j) = w; }
                if (ROUTER) {
                    float lg[8] = {0.f, 0.f, 0.f, 0.f, 0.f, 0.f, 0.f, 0.f};
#pragma unroll
                    for (int j = 0; j < 4; ++j)
#pragma unroll
                        for (int i = 0; i < 4; ++i) { const int col = 4 * lane + 256 * j + i; const f32x4 w0 = *(const LAS f32x4*)(rwl + col * 8), w1 = *(const LAS f32x4*)(rwl + col * 8 + 4); const float hv = h[j][i];
                            lg[0] += hv * w0[0]; lg[1] += hv * w0[1]; lg[2] += hv * w0[2]; lg[3] += hv * w0[3]; lg[4] += hv * w1[0]; lg[5] += hv * w1[1]; lg[6] += hv * w1[2]; lg[7] += hv * w1[3]; }
#pragma unroll
                    for (int e = 0; e < 8; ++e) lg[e] = wave_sum(lg[e]);
                    int e0 = 0; float v0 = lg[0];
#pragma unroll
                    for (int e = 1; e < 8; ++e) if (lg[e] > v0) { v0 = lg[e]; e0 = e; }
                    int e1 = -1; float v1 = -3.0e38f;
#pragma unroll
                    for (int e = 0; e < 8; ++e) if (e != e0 && lg[e] > v1) { v1 = lg[e]; e1 = e; }
                    const float ex = expf(v1 - v0); const float p0 = 1.0f / (1.0f + ex), p1 = ex / (1.0f + ex);
                    const int rk0 = e0 == 0 ? rc0 : e0 == 1 ? rc1 : e0 == 2 ? rc2 : e0 == 3 ? rc3 : e0 == 4 ? rc4 : e0 == 5 ? rc5 : e0 == 6 ? rc6 : rc7;
                    const int rk1 = e1 == 0 ? rc0 : e1 == 1 ? rc1 : e1 == 2 ? rc2 : e1 == 3 ? rc3 : e1 == 4 ? rc4 : e1 == 5 ? rc5 : e1 == 6 ? rc6 : rc7;
                    rc0 += (e0 == 0) + (e1 == 0); rc1 += (e0 == 1) + (e1 == 1); rc2 += (e0 == 2) + (e1 == 2); rc3 += (e0 == 3) + (e1 == 3);
                    rc4 += (e0 == 4) + (e1 == 4); rc5 += (e0 == 5) + (e1 == 5); rc6 += (e0 == 6) + (e1 == 6); rc7 += (e0 == 7) + (e1 == 7);
                    if (lane == 0) { P.tope[2 * r] = e0; P.tope[2 * r + 1] = e1; P.toppo[2 * r] = p0; P.toppo[2 * r + 1] = p1; P.rank[2 * r] = rk0; P.rank[2 * r + 1] = rk1; }
                }
            }
        }
        if (ROUTER && lane == 0) { int* c = P.cnt + it * 8; c[0] = rc0; c[1] = rc1; c[2] = rc2; c[3] = rc3; c[4] = rc4; c[5] = rc5; c[6] = rc6; c[7] = rc7; }
    }
}

template <int NB>
__device__ __forceinline__ void lm_core(const bf16_t* A, int lda, const int (&i0)[NB], int kc0, int nks, LAS unsigned char* X, f32x4 (&acc)[NB][8], int lane) {
    const int i16 = lane & 15, q = lane >> 4;
    const int xoff = (8 * q + (i16 >> 2)) * XRS + 8 * (i16 & 3);
    for (int ks = 0; ks < nks; ++ks) {
        bf16x8 af[NB];
#pragma unroll
        for (int b = 0; b < NB; ++b) af[b] = *(const bf16x8*)(A + (size_t)(i0[b] + i16) * lda + kc0 + ks * 32 + 8 * q);
#pragma unroll
        for (int nt = 0; nt < 8; ++nt) {
            const s16x4 lo = __builtin_amdgcn_ds_read_tr16_b64_v4i16((LAS s16x4*)(X + ks * 32 * XRS + xoff + nt * 32));
            const s16x4 hi = __builtin_amdgcn_ds_read_tr16_b64_v4i16((LAS s16x4*)(X + ks * 32 * XRS + xoff + nt * 32 + 4 * XRS));
            const bf16x8 xf = __builtin_shufflevector(lo, hi, 0, 1, 2, 3, 4, 5, 6, 7);
#pragma unroll
            for (int b = 0; b < NB; ++b) acc[b][nt] = __builtin_amdgcn_mfma_f32_16x16x32_bf16(xf, af[b], acc[b][nt], 0, 0, 0);
        }
    }
}
template <int NB> __device__ __forceinline__ void zero_acc(f32x4 (&acc)[NB][8]) {
#pragma unroll
    for (int b = 0; b < NB; ++b)
#pragma unroll
        for (int nt = 0; nt < 8; ++nt) acc[b][nt] = (f32x4){0.f, 0.f, 0.f, 0.f};
}
__device__ __forceinline__ void stage_rows(const bf16_t* src, size_t sstride, int nrows, LAS unsigned char* X, int xr0, int tid) {
    for (int i = tid; i < nrows * 16; i += 512) { const int r = i >> 4, ch = i & 15; *(LAS u32x4*)(X + (xr0 + r) * XRS + ch * 16) = *(const u32x4*)(src + (size_t)r * sstride + ch * 8); }
}

__device__ __forceinline__ void fft_stage_a(const Ctx& F) {
    const bf16_t* PZ = (const bf16_t*)(F.ws + WS_PZUV); bf16_t* UP = (bf16_t*)(F.ws + WS_UP); bf16_t* Y = (bf16_t*)(F.ws + WS_H);
    const bf16_t* FA = (const bf16_t*)(F.ws + WS_FA); const bf16_t* FX = (const bf16_t*)(F.ws + WS_FX);
    LAS unsigned char* X = F.lds; const int lane = F.lane, w = F.wave, i16 = lane & 15, q = lane >> 4;
    for (int it = F.bid; it < 1024 + 16; it += F.G) {
        if (it < 1024) {
            const int t2 = it & 127, g = (it >> 7) & 3, b = it >> 9;
            const bf16_t* src = PZ + ((size_t)b * TL + t2) * NEIN + g * 128;
            stage_rows(src, (size_t)128 * NEIN, 128, X, 0, F.tid);
            stage_rows(src + 512, (size_t)128 * NEIN, 128, X, 128, F.tid);
            __syncthreads();
            f32x4 acc[2][8]; zero_acc<2>(acc); const int i0[2] = {16 * w, 128 + 16 * w};
            lm_core<2>(FA, 256, i0, 0, 8, X, acc, lane);
            const int k1 = 16 * w + i16; float sw, cw; sincosf(6.283185307179586f * (float)((k1 * t2) & 16383) / 16384.0f, &sw, &cw);
            bf16_t* orow = UP + ((size_t)((b * 4 + g) * 128 + k1) * 128 + t2) * 256;
#pragma unroll
            for (int nt = 0; nt < 8; ++nt) { const f32x4 ur = acc[0][nt], ui = acc[1][nt]; const int n = 16 * nt + 4 * q;
                u32x2 wr_, wi_; wr_.x = pk2(ur[0] * cw - ui[0] * sw, ur[1] * cw - ui[1] * sw); wr_.y = pk2(ur[2] * cw - ui[2] * sw, ur[3] * cw - ui[3] * sw);
                wi_.x = pk2(ur[0] * sw + ui[0] * cw, ur[1] * sw + ui[1] * cw); wi_.y = pk2(ur[2] * sw + ui[2] * cw, ur[3] * sw + ui[3] * cw);
                *(u32x2*)(orow + n) = wr_; *(u32x2*)(orow + 128 + n) = wi_; }
            __syncthreads();
        } else {
            const int ci = it - 1024, kh = ci & 1, g = (ci >> 1) & 3, b = ci >> 3;
            f32x4 acc[1][8]; zero_acc<1>(acc); const int i0[1] = {128 * kh + 16 * w};
            for (int c = 0; c < 2; ++c) {
                stage_rows(PZ + ((size_t)ML + b * TCX) * NEIN + c * 512 + g * 128, NEIN, 256, X, 0, F.tid);
                __syncthreads();
                lm_core<1>(FX, 512, i0, c * 256, 8, X, acc, lane);
                __syncthreads();
            }
            const int k = 128 * kh + 16 * w + i16; bf16_t* orow = Y + ((size_t)ML + b * TCX + k) * D + g * 128; const float nrm = 0.005524271728019903f;
#pragma unroll
            for (int nt = 0; nt < 8; ++nt) { const f32x4 a = acc[0][nt] * nrm; u32x2 o; o.x = pk2(a[0], a[1]); o.y = pk2(a[2], a[3]); *(u32x2*)(orow + 16 * nt + 4 * q) = o; }
        }
    }
}
__device__ __forceinline__ void fft_stage_c_gmlp(const Ctx& F, int j) {
    const bf16_t* PZ = (const bf16_t*)(F.ws + WS_PZUV); const bf16_t* UP = (const bf16_t*)(F.ws + WS_UP); bf16_t* Y = (bf16_t*)(F.ws + WS_H);
    const bf16_t* FC = (const bf16_t*)(F.ws + WS_FC); const bf16_t* GW = (const bf16_t*)(F.ws + WS_GW) + (size_t)j * 4 * 128 * 128;
    const float* gb = F.in[I_GB] + j * 512;
    LAS unsigned char* X = F.lds; const int lane = F.lane, w = F.wave, i16 = lane & 15, q = lane >> 4, tid = F.tid;
    for (int it = F.bid; it < 1024 + 1040; it += F.G) {
        if (it < 1024) {
            const int k1 = it & 127, g = (it >> 7) & 3, b = it >> 9;
            const bf16_t* src = UP + (size_t)((b * 4 + g) * 128 + k1) * 128 * 256;
            stage_rows(src, 256, 128, X, 0, tid);
            stage_rows(src + 128, 256, 128, X, 128, tid);
            __syncthreads();
            f32x4 acc[1][8]; zero_acc<1>(acc); const int i0[1] = {16 * w};
            lm_core<1>(FC, 256, i0, 0, 8, X, acc, lane);
            const int k2 = 16 * w + i16; bf16_t* orow = Y + ((size_t)b * TL + k1 + 128 * k2) * D + g * 128; const float nrm = 0.0006905339660024878f;
#pragma unroll
            for (int nt = 0; nt < 8; ++nt) { const f32x4 a = acc[0][nt] * nrm; u32x2 o; o.x = pk2(a[0], a[1]); o.y = pk2(a[2], a[3]); *(u32x2*)(orow + 16 * nt + 4 * q) = o; }
            __syncthreads();
        } else {
            const int gi = it - 1024, h = gi & 3, ck = gi >> 2; const size_t r0 = (size_t)ck * 128;
            for (int i = tid; i < 128 * 16; i += 512) { const int r = i >> 4, ch = i & 15; const u32x4 raw = *(const u32x4*)(PZ + (r0 + r) * NEIN + 1536 + h * 128 + ch * 8);
                float x[8] = {bflo(raw.x), bfhi(raw.x), bflo(raw.y), bfhi(raw.y), bflo(raw.z), bfhi(raw.z), bflo(raw.w), bfhi(raw.w)};
                float s = 0.f;
#pragma unroll
                for (int e = 0; e < 8; ++e) s += x[e];
                s += __shfl_xor(s, 1); s += __shfl_xor(s, 2); s += __shfl_xor(s, 4); s += __shfl_xor(s, 8);
                const float mean = s * (1.0f / 128.0f); float qq = 0.f;
#pragma unroll
                for (int e = 0; e < 8; ++e) { x[e] -= mean; qq += x[e] * x[e]; }
                qq += __shfl_xor(qq, 1); qq += __shfl_xor(qq, 2); qq += __shfl_xor(qq, 4); qq += __shfl_xor(qq, 8);
                const float rs = rsqrtf(qq * (1.0f / 128.0f) + EPS);
                u32x4 o; o.x = pk2(x[0] * rs, x[1] * rs); o.y = pk2(x[2] * rs, x[3] * rs); o.z = pk2(x[4] * rs, x[5] * rs); o.w = pk2(x[6] * rs, x[7] * rs);
                *(LAS u32x4*)(X + r * XRS + ch * 16) = o; }
            __syncthreads();
            f32x4 acc[1][8]; zero_acc<1>(acc); const int i0[1] = {16 * w};
            lm_core<1>(GW + (size_t)h * 128 * 128, 128, i0, 0, 4, X, acc, lane);
            const int t = 16 * w + i16; const float bias = gb[h * 128 + t];
            const bf16_t* urow = PZ + (r0 + t) * NEIN + 1024 + h * 128; bf16_t* orow = Y + (r0 + t) * D + 512 + h * 128;
#pragma unroll
            for (int nt = 0; nt < 8; ++nt) { const int n = 16 * nt + 4 * q; const u32x2 uu = *(const u32x2*)(urow + n); const f32x4 a = acc[0][nt];
                u32x2 o; o.x = pk2(bflo(uu.x) * (a[0] + bias), bfhi(uu.x) * (a[1] + bias)); o.y = pk2(bflo(uu.y) * (a[2] + bias), bfhi(uu.y) * (a[3] + bias)); *(u32x2*)(orow + n) = o; }
            __syncthreads();
        }
    }
}

constexpr int SC_QT = 0, SC_KT = 9216, SC_V = 18432, SC_S16 = 27648, SC_SC = 64512, SC_EB = 67072, SC_PT = 67584, SC_RED = 69632, SC_OF = 70656, SC_OFRS = 264;
static_assert(SC_OF + 256 * SC_OFRS <= MISC_OFF, "scan LDS");
constexpr int SCRS = 80;
template <bool NEEDQ>
__device__ __forceinline__ float chunk_prep(const Ctx& F, const bf16_t* P5, size_t row0, bool rev, int h, int dir) {
    const int tid = F.tid, dk = tid & 127, part = tid >> 7;
    LAS unsigned char* L = F.lds;
    float lf[8], cs[8]; float run = 0.f;
#pragma unroll
    for (int i = 0; i < 8; ++i) { const int p = 8 * part + i; const size_t r = row0 + (rev ? 31 - p : p); lf[i] = bf2f(P5[r * NREC + 2048 + dir * 1024 + h * 128 + dk]); run += lf[i]; cs[i] = run; }
    LAS float* PT = (LAS float*)(L + SC_PT);
    PT[part * 128 + dk] = run;
    { const int p = tid >> 4, ch = tid & 15; const size_t r = row0 + (rev ? 31 - p : p); *(LAS u32x4*)(L + SC_V + p * XRS + ch * 16) = *(const u32x4*)(P5 + r * NREC + 4096 + h * 128 + ch * 8); }
    __syncthreads();
    const float t0 = PT[dk], t1 = PT[128 + dk], t2 = PT[256 + dk], t3 = PT[384 + dk];
    const float off = part == 0 ? 0.f : part == 1 ? t0 : part == 2 ? t0 + t1 : t0 + t1 + t2;
    const float bend = (t0 + t1) + (t2 + t3);
#pragma unroll
    for (int i = 0; i < 8; ++i) { const int p = 8 * part + i; const float b = off + cs[i];
        const float kk = (1.0f - __expf(lf[i])) * __expf(fminf(-b, 80.0f));
        *(LAS bf16_t*)(L + SC_KT + p * XRS + dk * 2) = (bf16_t)f2bf(kk);
        if (NEEDQ) { const size_t r = row0 + (rev ? 31 - p : p); const float qv = bf2f(P5[r * NREC + h * 128 + dk]); *(LAS bf16_t*)(L + SC_QT + p * XRS + dk * 2) = (bf16_t)f2bf(qv * __expf(b)); } }
    if (part == 0) ((LAS float*)(L + SC_EB))[dk] = __expf(bend);
    return bend;
}
__device__ __forceinline__ void state_update(const Ctx& F, f32x4 (&st)[8]) {
    LAS unsigned char* L = F.lds; const int lane = F.lane, i16 = lane & 15, q = lane >> 4, w = F.wave;
    const int roff = (8 * q + (i16 >> 2)) * XRS + 8 * (i16 & 3);
    const s16x4 vlo = __builtin_amdgcn_ds_read_tr16_b64_v4i16((LAS s16x4*)(L + SC_V + roff + w * 32));
    const s16x4 vhi = __builtin_amdgcn_ds_read_tr16_b64_v4i16((LAS s16x4*)(L + SC_V + roff + w * 32 + 4 * XRS));
    const bf16x8 vf = __builtin_shufflevector(vlo, vhi, 0, 1, 2, 3, 4, 5, 6, 7);
#pragma unroll
    for (int kb = 0; kb < 8; ++kb) {
        const s16x4 klo = __builtin_amdgcn_ds_read_tr16_b64_v4i16((LAS s16x4*)(L + SC_KT + roff + kb * 32));
        const s16x4 khi = __builtin_amdgcn_ds_read_tr16_b64_v4i16((LAS s16x4*)(L + SC_KT + roff + kb * 32 + 4 * XRS));
        const bf16x8 kf = __builtin_shufflevector(klo, khi, 0, 1, 2, 3, 4, 5, 6, 7);
        st[kb] = __builtin_amdgcn_mfma_f32_16x16x32_bf16(kf, vf, st[kb], 0, 0, 0);
        const f32x4 eb = *(const LAS f32x4*)(L + SC_EB + (16 * kb + 4 * q) * 4);
        st[kb] = st[kb] * eb;
    }
}
__device__ __forceinline__ void state_load(const float* src, f32x4 (&st)[8], int w, int lane) {
#pragma unroll
    for (int kb = 0; kb < 8; ++kb)
#pragma unroll
        for (int rg = 0; rg < 4; ++rg) st[kb][rg] = src ? src[((w * 8 + kb) * 4 + rg) * 64 + lane] : 0.f;
}
__device__ __forceinline__ void state_store(float* dst, const f32x4 (&st)[8], int w, int lane) {
#pragma unroll
    for (int kb = 0; kb < 8; ++kb)
#pragma unroll
        for (int rg = 0; rg < 4; ++rg) dst[((w * 8 + kb) * 4 + rg) * 64 + lane] = st[kb][rg];
}
__device__ __forceinline__ void scan_pass1_item(const Ctx& F, const bf16_t* P5, int b, int h, int dir, int seg, float* SST, float* EG) {
    const int chain = (b * 8 + h) * 2 + dir; const size_t rowb = (size_t)b * TL + (size_t)seg * SEGL;
    f32x4 st[8]; state_load(nullptr, st, F.wave, F.lane);
    float gacc = 0.f;
    for (int c = 0; c < 8; ++c) {
        const int cc = dir ? 7 - c : c;
        gacc += chunk_prep<false>(F, P5, rowb + cc * CH, dir != 0, h, dir);
        __syncthreads();
        state_update(F, st);
        __syncthreads();
    }
    state_store(SST + ((size_t)chain * NSEG + seg) * 16384, st, F.wave, F.lane);
    if (F.tid < 128) EG[((size_t)chain * NSEG + seg) * 128 + F.tid] = __expf(gacc);
}
template <int DIR>
__device__ __forceinline__ void scan_sweep(const Ctx& F, const bf16_t* P5, size_t rowb, int h, f32x4 (&st)[8], const float* gain, bf16_t* Y, bool writey) {
    LAS unsigned char* L = F.lds; const int lane = F.lane, i16 = lane & 15, q = lane >> 4, w = F.wave;
    const int roff = (8 * q + (i16 >> 2)) * XRS + 8 * (i16 & 3);
    for (int c = 0; c < 8; ++c) {
        const int cc = DIR ? 7 - c : c; const size_t row0 = rowb + cc * CH;
        (void)chunk_prep<true>(F, P5, row0, DIR != 0, h, DIR);
#pragma unroll
        for (int kb = 0; kb < 8; ++kb)
#pragma unroll
            for (int rg = 0; rg < 4; ++rg) *(LAS bf16_t*)(L + SC_S16 + (16 * kb + 4 * q + rg) * XRS + (16 * w + i16) * 2) = (bf16_t)f2bf(st[kb][rg]);
        __syncthreads();
        if (w < 4) {
            const int ti = w >> 1, si = w & 1; f32x4 sc = (f32x4){0.f, 0.f, 0.f, 0.f};
            if (si <= ti) {
#pragma unroll
                for (int ks = 0; ks < 4; ++ks) { const bf16x8 a = *(const LAS bf16x8*)(L + SC_QT + (16 * ti + i16) * XRS + (32 * ks + 8 * q) * 2); const bf16x8 bb = *(const LAS bf16x8*)(L + SC_KT + (16 * si + i16) * XRS + (32 * ks + 8 * q) * 2);
                    sc = __builtin_amdgcn_mfma_f32_16x16x32_bf16(a, bb, sc, 0, 0, 0); }
            }
#pragma unroll
            for (int rg = 0; rg < 4; ++rg) { const int t = 16 * ti + 4 * q + rg, s = 16 * si + i16; *(LAS bf16_t*)(L + SC_SC + t * SCRS + s * 2) = (bf16_t)f2bf(s <= t ? sc[rg] : 0.f); }
        }
        __syncthreads();
        f32x4 o[2] = {(f32x4){0.f, 0.f, 0.f, 0.f}, (f32x4){0.f, 0.f, 0.f, 0.f}};
#pragma unroll
        for (int ks = 0; ks < 4; ++ks) {
            const s16x4 slo = __builtin_amdgcn_ds_read_tr16_b64_v4i16((LAS s16x4*)(L + SC_S16 + ks * 32 * XRS + roff + w * 32));
            const s16x4 shi = __builtin_amdgcn_ds_read_tr16_b64_v4i16((LAS s16x4*)(L + SC_S16 + ks * 32 * XRS + roff + w * 32 + 4 * XRS));
            const bf16x8 sf = __builtin_shufflevector(slo, shi, 0, 1, 2, 3, 4, 5, 6, 7);
#pragma unroll
            for (int ti = 0; ti < 2; ++ti) { const bf16x8 qf = *(const LAS bf16x8*)(L + SC_QT + (16 * ti + i16) * XRS + (32 * ks + 8 * q) * 2); o[ti] = __builtin_amdgcn_mfma_f32_16x16x32_bf16(sf, qf, o[ti], 0, 0, 0); }
        }
        { const s16x4 vlo = __builtin_amdgcn_ds_read_tr16_b64_v4i16((LAS s16x4*)(L + SC_V + roff + w * 32));
          const s16x4 vhi = __builtin_amdgcn_ds_read_tr16_b64_v4i16((LAS s16x4*)(L + SC_V + roff + w * 32 + 4 * XRS));
          const bf16x8 vf = __builtin_shufflevector(vlo, vhi, 0, 1, 2, 3, 4, 5, 6, 7);
#pragma unroll
          for (int ti = 0; ti < 2; ++ti) { const bf16x8 pf = *(const LAS bf16x8*)(L + SC_SC + (16 * ti + i16) * SCRS + (8 * q) * 2); o[ti] = __builtin_amdgcn_mfma_f32_16x16x32_bf16(vf, pf, o[ti], 0, 0, 0); } }
        if (DIR == 0) {
#pragma unroll
            for (int ti = 0; ti < 2; ++ti) { const int tl = cc * CH + 16 * ti + i16; u32x2 pkd; pkd.x = pk2(o[ti][0], o[ti][1]); pkd.y = pk2(o[ti][2], o[ti][3]); *(LAS u32x2*)(L + SC_OF + tl * SC_OFRS + (16 * w + 4 * q) * 2) = pkd; }
            state_update(F, st);
            __syncthreads();
        } else {
            LAS float* RED = (LAS float*)(L + SC_RED);
#pragma unroll
            for (int ti = 0; ti < 2; ++ti) { const int tl = cc * CH + 31 - (16 * ti + i16); const u32x2 f = *(const LAS u32x2*)(L + SC_OF + tl * SC_OFRS + (16 * w + 4 * q) * 2);
                o[ti][0] += bflo(f.x); o[ti][1] += bfhi(f.x); o[ti][2] += bflo(f.y); o[ti][3] += bfhi(f.y);
                float ss = (o[ti][0] * o[ti][0] + o[ti][1] * o[ti][1]) + (o[ti][2] * o[ti][2] + o[ti][3] * o[ti][3]);
                ss += __shfl_xor(ss, 16); ss += __shfl_xor(ss, 32);
                if (q == 0) RED[w * 32 + 16 * ti + i16] = ss; }
            state_update(F, st);
            __syncthreads();
            if (writey) {
                const f32x4 gv = *(const f32x4*)(gain + h * 128 + 16 * w + 4 * q);
#pragma unroll
                for (int ti = 0; ti < 2; ++ti) { const int p = 16 * ti + i16; float tot = 0.f;
#pragma unroll
                    for (int ww = 0; ww < 8; ++ww) tot += RED[ww * 32 + p];
                    const float rs = rsqrtf(tot * (1.0f / 128.0f) + EPS); const size_t r = row0 + 31 - p;
                    const u32x2 sg = *(const u32x2*)(P5 + r * NREC + 1024 + h * 128 + 16 * w + 4 * q);
                    u32x2 y; y.x = pk2(o[ti][0] * rs * gv[0] * bflo(sg.x), o[ti][1] * rs * gv[1] * bfhi(sg.x)); y.y = pk2(o[ti][2] * rs * gv[2] * bflo(sg.y), o[ti][3] * rs * gv[3] * bfhi(sg.y));
                    *(u32x2*)(Y + r * D + h * 128 + 16 * w + 4 * q) = y; }
            }
            __syncthreads();
        }
    }
}
__device__ __forceinline__ void scan_pass3_item(const Ctx& F, const bf16_t* P5, size_t rowb, int h, const float* sin_f, const float* sin_b, float* fin_f, float* fin_b, const float* gain, bf16_t* Y, bool writey) {
    f32x4 st[8];
    state_load(sin_f, st, F.wave, F.lane);
    scan_sweep<0>(F, P5, rowb, h, st, gain, Y, writey);
    if (fin_f) state_store(fin_f, st, F.wave, F.lane);
    state_load(sin_b, st, F.wave, F.lane);
    scan_sweep<1>(F, P5, rowb, h, st, gain, Y, writey);
    if (fin_b) state_store(fin_b, st, F.wave, F.lane);
}
__device__ __forceinline__ void scan_carry(const Ctx& F) {
    float* SST = (float*)(F.ws + WS_SST); const float* EG = (const float*)(F.ws + WS_EG); const float* S0 = (const float*)(F.ws + WS_S0);
    const int gt = F.bid * 512 + F.tid, NGT = F.G * 512;
    for (int idx = gt; idx < NCHAIN * 16384; idx += NGT) {
        const int chain = idx >> 14, e = idx & 16383, dir = chain & 1;
        const int lanee = e & 63, rg = (e >> 6) & 3, kb = (e >> 8) & 7; const int dk = 16 * kb + 4 * (lanee >> 4) + rg;
        float cur = S0[(size_t)chain * 16384 + e];
        float* base = SST + (size_t)chain * NSEG * 16384 + e; const float* eg = EG + (size_t)chain * NSEG * 128 + dk;
        for (int s0 = 0; s0 < NSEG; s0 += 8) {
            float tmp[8], gg[8];
#pragma unroll
            for (int i = 0; i < 8; ++i) { const int seg = dir ? NSEG - 1 - (s0 + i) : s0 + i; tmp[i] = base[(size_t)seg * 16384]; gg[i] = eg[seg * 128]; }
#pragma unroll
            for (int i = 0; i < 8; ++i) { const int seg = dir ? NSEG - 1 - (s0 + i) : s0 + i; base[(size_t)seg * 16384] = cur; cur = gg[i] * cur + tmp[i]; }
        }
    }
}

__device__ __forceinline__ void moe_slots(const Ctx& F, int nrows) {
    const int tid = F.tid; const int nitems = nrows / 16;
    const int* cnt = (const int*)(F.ws + WS_CNT); const int* tope = (const int*)(F.ws + WS_TOPE); const int* rank = (const int*)(F.ws + WS_RANK);
    int* slotrow = (int*)(F.ws + WS_SLOTROW); int* slotdst = (int*)(F.ws + WS_SLOTDST); int* tilex = (int*)(F.ws + WS_TILEX);
    LAS int* pre = (LAS int*)F.lds;
    LAS int* tsum = (LAS int*)(F.lds + 69632);
    LAS int* ebase = (LAS int*)(F.lds + 69632 + 16384);
    constexpr int IPT = (NITEM16 + 511) / 512;
    int loc[8] = {0, 0, 0, 0, 0, 0, 0, 0};
    for (int i = 0; i < IPT; ++i) { const int it = tid * IPT + i; if (it < nitems) {
#pragma unroll
        for (int e = 0; e < 8; ++e) loc[e] += cnt[it * 8 + e]; } }
#pragma unroll
    for (int e = 0; e < 8; ++e) tsum[tid * 8 + e] = loc[e];
    __syncthreads();
    if (tid < 8) { int run = 0; for (int t = 0; t < 512; ++t) { const int v = tsum[t * 8 + tid]; tsum[t * 8 + tid] = run; run += v; } ebase[8 + tid] = run; }
    __syncthreads();
    if (tid == 0) { int b = 0; for (int e = 0; e < 8; ++e) { ebase[e] = b; b += (ebase[8 + e] + 255) & ~255; } ebase[16] = b / 256; }
    { int run[8];
#pragma unroll
      for (int e = 0; e < 8; ++e) run[e] = tsum[tid * 8 + e];
      for (int i = 0; i < IPT; ++i) { const int it = tid * IPT + i; if (it < nitems) {
#pragma unroll
          for (int e = 0; e < 8; ++e) { pre[it * 8 + e] = run[e]; run[e] += cnt[it * 8 + e]; } } } }
    __syncthreads();
    for (int r = F.bid * 512 + tid; r < nrows; r += F.G * 512) {
#pragma unroll
        for (int kk = 0; kk < 2; ++kk) { const int e = tope[2 * r + kk]; const int slot = ebase[e] + pre[(r >> 4) * 8 + e] + rank[2 * r + kk]; slotrow[slot] = r; slotdst[slot] = 2 * r + kk; }
    }
    if (F.bid == 0) {
        const int ntiles = ebase[16];
        if (tid == 0) tilex[0] = ntiles;
        for (int e = 0; e < 8; ++e) { const int b0 = ebase[e], tot = ebase[8 + e], pad = (tot + 255) & ~255;
            for (int s = b0 + tot + tid; s < b0 + pad; s += 512) { slotrow[s] = 0; slotdst[s] = -1; }
            for (int t = b0 / 256 + tid; t < (b0 + pad) / 256; t += 512) tilex[16 + t] = e; }
    }
}

__global__ void __launch_bounds__(512, 2) fwd_kernel(Args args) {
    extern __shared__ __attribute__((aligned(16))) unsigned char lds_raw[];
    Ctx F;
    F.lds = (LAS unsigned char*)lds_raw; F.tid = threadIdx.x; F.lane = F.tid & 63; F.wave = __builtin_amdgcn_readfirstlane(F.tid >> 6);
    F.G = gridDim.x; F.bid = blockIdx.x; F.gw = F.bid * 8 + F.wave; F.NGW = F.G * 8;
    F.in = args.in; F.out = args.out; F.ws = args.ws;
    unsigned char* ws = args.ws;
    volatile LAS unsigned* MISC = (volatile LAS unsigned*)(F.lds + MISC_OFF);
    if (F.tid < 64) MISC[F.tid] = 0u;
    __syncthreads();
    const int lo = args.ph_lo, hi = args.ph_hi;
    XcdBarrier bar; bar.bar = (unsigned*)(ws + WS_CTL) + 4096; bar.x = 0; bar.st = nullptr;
    const bool multi = (hi - lo) > 1;
    if (multi) bar = xcd_barrier_post((unsigned*)(ws + WS_CTL) + 4096, MISC + 8);
#define IN(k) (lo <= (k) && (k) < hi)
#define SEAM(k) do { if (IN(k) && IN((k) + 1)) xcd_barrier(bar); asm volatile("" : "+v"(F.tid)); F.lane = F.tid & 63; F.wave = __builtin_amdgcn_readfirstlane(F.tid >> 6); F.gw = F.bid * 8 + F.wave; } while (0)

    float* mods = (float*)(ws + WS_MODS);
    float* XC = (float*)(ws + WS_XC);
    bf16_t* H = (bf16_t*)(ws + WS_H);
    bf16_t* YE = (bf16_t*)(ws + WS_YE);

    if (IN(PH_P0)) { p0_prologue(F); }
    SEAM(PH_P0);

    for (int lp = 0; lp < 2; ++lp) {
        const int pb = PH_PAIR0 + lp * NPL;
        const int le = 2 * lp, lo_ = 2 * lp + 1;
        const float* modE = mods + (size_t)le * 3 * 6144; const float* modO = mods + (size_t)lo_ * 3 * 6144;
        const float* xsl = lp == 0 ? F.in[I_X] : F.out; const float* xsc = lp == 0 ? F.in[I_CTX] : XC;
        if (IN(pb + E1_NORM)) {
            RowPass P{}; P.sl = xsl; P.sc = xsc; P.dl = F.out; P.dc = XC; P.gain = F.in[I_NMIX] + le * D; P.shift = modE + 0 * D; P.scale = modE + 1 * D; P.H = H; P.nrows = MT;
            if (lp == 0) row_pass<false, false, false>(F, P);
            else { P.YE = YE; P.topp = (const float*)(ws + WS_TOPP); P.gatef = mods + (size_t)(le - 1) * 3 * 6144 + 5 * D; row_pass<true, false, false>(F, P); }
        }
        SEAM(pb + E1_NORM);
        if (IN(pb + E2_GIN)) {
            pg8::Gemm g{H, (const bf16_t*)(ws + WS_WINE) + (size_t)lp * NEIN * D, MT, NEIN, D, nullptr, nullptr, 0}; pg8::StaticOrder S; S.init(MT, NEIN, F.G, F.bid);
            pg8::EpiEvenIn E{(bf16_t*)(ws + WS_PZUV)};
            pg8::gemm_phase<pg8::EpiEvenIn, pg8::StaticOrder, true, false>(F.lds, g, S, E, F.tid);
        }
        SEAM(pb + E2_GIN);
        if (IN(pb + E3_FFTA)) fft_stage_a(F);
        SEAM(pb + E3_FFTA);
        if (IN(pb + E3_FFTC)) fft_stage_c_gmlp(F, lp);
        SEAM(pb + E3_FFTC);
        if (IN(pb + E4_GOUT)) {
            pg8::Gemm g{H, (const bf16_t*)(ws + WS_WOUTE) + (size_t)lp * D * D, MT, D, D, nullptr, nullptr, 0}; pg8::StaticOrder S; S.init(MT, D, F.G, F.bid);
            pg8::EpiRes E{lp == 0 ? xsl : (const float*)F.out, lp == 0 ? xsc : (const float*)XC, F.out, XC, modE + 2 * D};
            pg8::gemm_phase<pg8::EpiRes, pg8::StaticOrder, false, false>(F.lds, g, S, E, F.tid);
        }
        SEAM(pb + E4_GOUT);
        if (IN(pb + E5_NORM)) {
            RowPass P{}; P.sl = F.out; P.sc = XC; P.gain = F.in[I_NFFN] + le * D; P.shift = modE + 3 * D; P.scale = modE + 4 * D; P.H = H; P.nrows = MT;
            row_pass<false, false, false>(F, P);
        }
        SEAM(pb + E5_NORM);
        if (IN(pb + E6_UP)) {
            pg8::Gemm g{H, (const bf16_t*)(ws + WS_W13) + (size_t)lp * NFF2 * D, MT, NFF2, D, nullptr, nullptr, 0}; pg8::StaticOrder S; S.init(MT, NFF2, F.G, F.bid);
            pg8::EpiSwiglu E{(bf16_t*)(ws + WS_HID), DFF};
            pg8::gemm_phase<pg8::EpiSwiglu, pg8::StaticOrder, true, false>(F.lds, g, S, E, F.tid);
        }
        SEAM(pb + E6_UP);
        if (IN(pb + E7_DOWN)) {
            pg8::Gemm g{(const bf16_t*)(ws + WS_HID), (const bf16_t*)(ws + WS_W2) + (size_t)lp * D * DFF, MT, D, DFF, nullptr, nullptr, 0}; pg8::StaticOrder S; S.init(MT, D, F.G, F.bid);
            pg8::EpiRes E{F.out, XC, F.out, XC, modE + 5 * D};
            pg8::gemm_phase<pg8::EpiRes, pg8::StaticOrder, false, false>(F.lds, g, S, E, F.tid);
        }
        SEAM(pb + E7_DOWN);
        const bool lastl = lp == 1;
        if (IN(pb + O1_NORM)) {
            RowPass P{}; P.sl = F.out; P.sc = XC; P.gain = F.in[I_NMIX] + lo_ * D; P.shift = modO + 0 * D; P.scale = modO + 1 * D; P.H = H; P.nrows = MT;
            row_pass<false, false, false>(F, P);
        }
        SEAM(pb + O1_NORM);
        if (IN(pb + O2_GIN)) {
            pg8::Gemm g{H, (const bf16_t*)(ws + WS_WINO) + (size_t)lp * NREC * D, MT, NREC, D, nullptr, nullptr, 0}; pg8::StaticOrder S; S.init(MT, NREC, F.G, F.bid);
            pg8::EpiOddIn E{(bf16_t*)(ws + WS_P5), (const float*)(ws + WS_LB) + lp * 2048};
            pg8::gemm_phase<pg8::EpiOddIn, pg8::StaticOrder, true, false>(F.lds, g, S, E, F.tid);
        }
        SEAM(pb + O2_GIN);
        if (IN(pb + O3_SCAN1)) {
            const bf16_t* P5 = (const bf16_t*)(ws + WS_P5); float* SST = (float*)(ws + WS_SST); float* EG = (float*)(ws + WS_EG); float* S0 = (float*)(ws + WS_S0);
            const float* gain = F.in[I_RNORM] + lp * D;
            for (int it = F.bid; it < 16 + 2048; it += F.G) {
                if (it < 16) { const int b = it >> 3, h = it & 7;
                    scan_pass3_item(F, P5, (size_t)ML + b * TCX, h, nullptr, nullptr, S0 + (size_t)((b * 8 + h) * 2 + 0) * 16384, S0 + (size_t)((b * 8 + h) * 2 + 1) * 16384, gain, H, !lastl);
                } else { const int i2 = it - 16, seg = i2 & 63, dir = (i2 >> 6) & 1, h = (i2 >> 7) & 7, b = i2 >> 10;
                    scan_pass1_item(F, P5, b, h, dir, seg, SST, EG); }
            }
        }
        SEAM(pb + O3_SCAN1);
        if (IN(pb + O4_CARRY)) { scan_carry(F); moe_convert(F, lp); }
        SEAM(pb + O4_CARRY);
        if (IN(pb + O5_SCAN3)) {
            const bf16_t* P5 = (const bf16_t*)(ws + WS_P5); const float* SST = (const float*)(ws + WS_SST);
            const float* gain = F.in[I_RNORM] + lp * D;
            for (int it = F.bid; it < 1024; it += F.G) { const int seg = it & 63, h = (it >> 6) & 7, b = it >> 9; const int ch0 = (b * 8 + h) * 2;
                scan_pass3_item(F, P5, (size_t)b * TL + (size_t)seg * SEGL, h, SST + ((size_t)ch0 * NSEG + seg) * 16384, SST + ((size_t)(ch0 + 1) * NSEG + seg) * 16384, nullptr, nullptr, gain, H, true); }
        }
        SEAM(pb + O5_SCAN3);
        if (IN(pb + O6_GOUT)) {
            pg8::Gemm g{H, (const bf16_t*)(ws + WS_WOUTO) + (size_t)lp * D * D, MT, D, D, nullptr, nullptr, 0}; pg8::StaticOrder S; S.init(MT, D, F.G, F.bid);
            pg8::EpiRes E{F.out, XC, F.out, XC, modO + 2 * D};
            pg8::gemm_phase<pg8::EpiRes, pg8::StaticOrder, false, false>(F.lds, g, S, E, F.tid);
        }
        SEAM(pb + O6_GOUT);
        const int nrm = lastl ? ML : MT;
        if (IN(pb + O7_NORM)) {
            RowPass P{}; P.sl = F.out; P.sc = XC; P.gain = F.in[I_NFFN] + lo_ * D; P.shift = modO + 3 * D; P.scale = modO + 4 * D; P.H = H; P.nrows = nrm;
            P.rw = F.in[I_RW] + (size_t)lp * D * NE; P.tope = (int*)(ws + WS_TOPE); P.toppo = (float*)(ws + WS_TOPP); P.rank = (int*)(ws + WS_RANK); P.cnt = (int*)(ws + WS_CNT);
            row_pass<false, true, false>(F, P);
        }
        SEAM(pb + O7_NORM);
        if (IN(pb + O8_SLOTS)) moe_slots(F, nrm);
        SEAM(pb + O8_SLOTS);
        if (IN(pb + O9_MUP)) {
            const int* tilex = (const int*)(ws + WS_TILEX); const int ntiles = tilex[0];
            pg8::Gemm g{H, (const bf16_t*)(ws + WS_W13M), ntiles * 256, NEX2, D, (const int*)(ws + WS_SLOTROW), tilex + 16, (size_t)NEX2 * D}; pg8::StaticOrder S; S.init(ntiles * 256, NEX2, F.G, F.bid);
            pg8::EpiSwiglu E{(bf16_t*)(ws + WS_HIDM), DEX};
            pg8::gemm_phase<pg8::EpiSwiglu, pg8::StaticOrder, true, true>(F.lds, g, S, E, F.tid);
        }
        SEAM(pb + O9_MUP);
        if (IN(pb + O10_MDOWN)) {
            const int* tilex = (const int*)(ws + WS_TILEX); const int ntiles = tilex[0];
            pg8::Gemm g{(const bf16_t*)(ws + WS_HIDM), (const bf16_t*)(ws + WS_W2M), ntiles * 256, D, DEX, nullptr, tilex + 16, (size_t)D * DEX}; pg8::StaticOrder S; S.init(ntiles * 256, D, F.G, F.bid);
            pg8::EpiMoeDown E{YE, (const int*)(ws + WS_SLOTDST)};
            pg8::gemm_phase<pg8::EpiMoeDown, pg8::StaticOrder, true, false>(F.lds, g, S, E, F.tid);
        }
        SEAM(pb + O10_MDOWN);
    }
    if (IN(PH_FINAL)) {
        RowPass P{}; P.sl = F.out; P.sc = XC; P.dl = F.out; P.dc = XC; P.gain = F.in[I_NOUT]; P.nrows = ML; P.YE = YE; P.topp = (const float*)(ws + WS_TOPP); P.gatef = mods + (size_t)3 * 3 * 6144 + 5 * D; P.fout = F.out;
        row_pass<true, false, true>(F, P);
    }
#undef IN
#undef SEAM
}

extern "C" void kernel_launch(void* const* d_in, const int* in_sizes, int n_in, void* d_out, int out_size, void* d_ws, size_t ws_size, hipStream_t stream) {
    static int grid = 0;
    if (grid == 0) {
        if (n_in != 24 || out_size != ML * D || ws_size < WS_END) { fprintf(stderr, "kernel_launch: unexpected problem (n_in %d, out %d, ws %zu < %zu)\n", n_in, out_size, ws_size, (size_t)WS_END); grid = -1; return; }
        int dev = 0, cus = 0, per_cu = 0;
        if (hipGetDevice(&dev) != hipSuccess || hipDeviceGetAttribute(&cus, hipDeviceAttributeMultiprocessorCount, dev) != hipSuccess) { grid = -1; return; }
        if (hipFuncSetAttribute((const void*)fwd_kernel, hipFuncAttributeMaxDynamicSharedMemorySize, LDS_BYTES) != hipSuccess) { fprintf(stderr, "kernel_launch: hipFuncSetAttribute failed\n"); grid = -1; return; }
        if (hipOccupancyMaxActiveBlocksPerMultiprocessor(&per_cu, (const void*)fwd_kernel, 512, LDS_BYTES) != hipSuccess || per_cu < 1) fprintf(stderr, "kernel_launch: occupancy query says %d\n", per_cu);
        (void)hipGetLastError();
        grid = cus;
    }
    if (grid < 0) return;
    (void)hipMemsetAsync((char*)d_ws + WS_CTL, 0, CTL_BYTES, stream);
    Args a{};
    for (int i = 0; i < 24; ++i) a.in[i] = (const float*)d_in[i];
    a.out = (float*)d_out; a.ws = (unsigned char*)d_ws;
#if PER_PHASE_LAUNCH
    for (int p = 0; p < NPHASE && p < PHASE_LIMIT; ++p) { a.ph_lo = p; a.ph_hi = p + 1; hipLaunchKernelGGL(fwd_kernel, dim3(grid), dim3(512), LDS_BYTES, stream, a); }
#else
    a.ph_lo = 0; a.ph_hi = NPHASE; hipLaunchKernelGGL(fwd_kernel, dim3(grid), dim3(512), LDS_BYTES, stream, a);
#endif
}
```

```cpp
#include <hip/hip_runtime.h>
#include <cstdio>
#include <cstdint>

#ifndef PER_PHASE_LAUNCH
#define PER_PHASE_LAUNCH 0
#endif
#ifndef PHASE_LIMIT
#define PHASE_LIMIT 100
#endif
#ifndef P0_MASK
#define P0_MASK 63
#endif
#ifndef P0_T
#define P0_T 127
#endif

#define LAS __attribute__((address_space(3)))
typedef unsigned short bf16_t;
typedef short bf16x8 __attribute__((ext_vector_type(8)));
typedef short s16x4 __attribute__((ext_vector_type(4)));
typedef float f32x4 __attribute__((ext_vector_type(4)));
typedef float f32x2 __attribute__((ext_vector_type(2)));
typedef unsigned u32x4 __attribute__((ext_vector_type(4)));
typedef unsigned u32x2 __attribute__((ext_vector_type(2)));

constexpr int D = 1024, TL = 16384, ML = 32768, TCX = 256, MC = 512, MT = 33280;
constexpr int NEIN = 2048, DFF = 2816, NFF2 = 5632, NREC = 5120, DEX = 3584, NEX2 = 7168, NE = 8;
constexpr int NSEG = 64, SEGL = 256, CH = 32, NCHAIN = 32;
constexpr int MAXTILES = 268, NITEM16 = MT / 16;
constexpr float EPS = 1e-6f;

constexpr size_t MiB = 1u << 20, KiB = 1u << 10;
constexpr size_t WS_CTL = 0, CTL_BYTES = 1 * MiB;
constexpr size_t WS_MODS = 1 * MiB, WS_LB = 1 * MiB + 512 * KiB;
constexpr size_t WS_FA = 2 * MiB, WS_FC = 2 * MiB + 128 * KiB, WS_FX = 2 * MiB + 256 * KiB, WS_GW = 2 * MiB + 512 * KiB;
constexpr size_t WS_XC = 3 * MiB;
constexpr size_t WS_TOPE = 5 * MiB, WS_TOPP = 5 * MiB + 512 * KiB, WS_RANK = 6 * MiB, WS_CNT = 6 * MiB + 512 * KiB, WS_TILEX = 6 * MiB + 768 * KiB, WS_SLOTROW = 7 * MiB, WS_SLOTDST = 7 * MiB + 512 * KiB;
constexpr size_t WS_WINE = 8 * MiB, WS_WOUTE = 16 * MiB, WS_WINO = 20 * MiB, WS_WOUTO = 40 * MiB, WS_W13 = 44 * MiB, WS_W2 = 66 * MiB;
constexpr size_t WS_W13M = 80 * MiB, WS_W2M = 192 * MiB;
constexpr size_t WS_H = 248 * MiB, WS_YE = 314 * MiB, WS_BIG = 444 * MiB;
constexpr size_t WS_PZUV = WS_BIG, WS_UP = WS_BIG + 130 * MiB, WS_HID = WS_BIG, WS_P5 = WS_BIG, WS_SST = WS_BIG + 325 * MiB, WS_EG = WS_BIG + 453 * MiB, WS_S0 = WS_BIG + 454 * MiB, WS_HIDM = WS_BIG;
constexpr size_t WS_END = WS_BIG + 469 * MiB;
static_assert(WS_W2 + (size_t)2 * D * DFF * 2 <= WS_W13M, "static weights");
static_assert(WS_W2M + (size_t)NE * D * DEX * 2 <= WS_H && WS_H + (size_t)MT * D * 2 <= WS_YE && WS_YE + (size_t)MT * 2 * D * 2 <= WS_BIG, "ws map");
static_assert((size_t)MAXTILES * 256 * DEX * 2 <= 469 * MiB && (size_t)MT * NREC * 2 <= 325 * MiB && (size_t)MT * NEIN * 2 <= 130 * MiB, "big region");

constexpr int LDS_BYTES = 147456, MISC_OFF = 147456 - 256;
constexpr int XRS = 288;

__device__ __forceinline__ unsigned f2bf(float f) { unsigned u = __builtin_bit_cast(unsigned, f); return (u + 0x7fffu + ((u >> 16) & 1u)) >> 16; }
__device__ __forceinline__ unsigned pk2(float lo, float hi) { return f2bf(lo) | (f2bf(hi) << 16); }
__device__ __forceinline__ float bf2f(unsigned short b) { return __builtin_bit_cast(float, (unsigned)b << 16); }
__device__ __forceinline__ float bflo(unsigned w) { return __builtin_bit_cast(float, w << 16); }
__device__ __forceinline__ float bfhi(unsigned w) { return __builtin_bit_cast(float, w & 0xffff0000u); }
__device__ __forceinline__ float wave_sum(float v) {
#pragma unroll
    for (int o = 1; o < 64; o <<= 1) v += __shfl_xor(v, o);
    return v;
}
__device__ __forceinline__ float siluf(float a) { return a * __builtin_amdgcn_rcpf(1.0f + __expf(-a)); }
#define LDS_WAIT() asm volatile("s_waitcnt lgkmcnt(0)" ::: "memory")
#define VM_WAIT() asm volatile("s_waitcnt vmcnt(0)" ::: "memory")

#define XB_TMO      128
#define XB_XCNT(j)  (256  + 64 * (j))
#define XB_XSUB(j)  (1280 + 64 * (j))
#define XB_XGEN(j)  (2304 + 64 * (j))
#define XB_TOP      3328
#define XB_TOPGEN   3392
#define XCD_BAR_WORDS 3456
#define XB_SPIN_CAP (1u << 18)
__device__ __forceinline__ unsigned xb_ld(unsigned* p)              { return __hip_atomic_load(p, __ATOMIC_RELAXED, __HIP_MEMORY_SCOPE_AGENT); }
__device__ __forceinline__ unsigned xb_add(unsigned* p, unsigned v) { return __hip_atomic_fetch_add(p, v, __ATOMIC_RELAXED, __HIP_MEMORY_SCOPE_AGENT); }
__device__ __forceinline__ unsigned xb_xcc_id() { return (unsigned)__builtin_amdgcn_s_getreg((3 << 11) | 20) & 0xFu; }
#define XB_SPIN(cond, bar) do { unsigned _sp = 0; while (cond) { __builtin_amdgcn_s_sleep(1); \
    if ((++_sp & 255u) == 0u) { if (xb_ld(&(bar)[XB_TMO])) break; if (_sp > XB_SPIN_CAP) { atomicAdd(&(bar)[XB_TMO], 1u); break; } } } } while (0)
struct XcdBarrier { unsigned* bar; unsigned x; volatile LAS unsigned* st; };
__device__ __forceinline__ XcdBarrier xcd_barrier_post(unsigned* bar, volatile LAS unsigned* st) {
    XcdBarrier b; b.bar = bar; b.x = xb_xcc_id(); b.st = st;
    if (threadIdx.x == 0) (void)xb_add(&bar[XB_XCNT(b.x)], 1u);
    return b;
}
__device__ __forceinline__ void xcd_barrier_complete(unsigned* bar, unsigned x, unsigned& nloc, unsigned& nx) {
    const unsigned G = gridDim.x * gridDim.y * gridDim.z;
    unsigned sum, cnt, mine, sp = 0u;
    for (;;) {
        sum = 0u; cnt = 0u; mine = 0u;
#pragma unroll
        for (unsigned j = 0; j < 16; ++j) { const unsigned c = xb_ld(&bar[XB_XCNT(j)]); sum += c; cnt += (c > 0u) ? 1u : 0u; mine = (j == x) ? c : mine; }
        if (sum == G) break;
        __builtin_amdgcn_s_sleep(1);
        if ((++sp & 255u) == 0u) { if (xb_ld(&bar[XB_TMO])) break; if (sp > XB_SPIN_CAP) { atomicAdd(&bar[XB_TMO], 1u); break; } }
    }
    nloc = mine > 0u ? mine : 1u; nx = cnt > 0u ? cnt : 1u;
}
__device__ __forceinline__ void xcd_barrier(const XcdBarrier& b) {
    asm volatile("s_waitcnt vmcnt(0)" ::: "memory");
    __syncthreads();
    if (threadIdx.x == 0) {
        unsigned* bar = b.bar;
        __builtin_amdgcn_s_waitcnt(0);
        unsigned nloc = b.st[0], nx = b.st[1];
        if (nloc == 0u) { xcd_barrier_complete(bar, b.x, nloc, nx); b.st[0] = nloc; b.st[1] = nx; }
        const unsigned old = xb_add(&bar[XB_XSUB(b.x)], 1u);
        const unsigned gen = old / nloc;
        if (old + 1u == (gen + 1u) * nloc) {
            __builtin_amdgcn_fence(__ATOMIC_RELEASE, "agent");
            asm volatile("s_waitcnt vmcnt(0)" ::: "memory");
            const unsigned og = xb_add(&bar[XB_TOP], 1u);
            const unsigned tg = og / nx;
            if (og + 1u == (tg + 1u) * nx) xb_add(&bar[XB_TOPGEN], 1u);
            else XB_SPIN(xb_ld(&bar[XB_TOPGEN]) == tg, bar);
            __builtin_amdgcn_fence(__ATOMIC_ACQUIRE, "agent");
            xb_add(&bar[XB_XGEN(b.x)], 1u);
            asm volatile("s_waitcnt vmcnt(0)" ::: "memory");
        } else {
            XB_SPIN(xb_ld(&bar[XB_XGEN(b.x)]) == gen, bar);
            __builtin_amdgcn_fence(__ATOMIC_ACQUIRE, "agent");
            asm volatile("s_waitcnt vmcnt(0)" ::: "memory");
        }
    }
    __syncthreads();
}

namespace pg8 {
constexpr int BM = 256, BK = 64, HALF = 128, HTB = HALF * BK * 2, STAGE_BYTES = 8 * HTB, NXCD = 8, WGM = 8;
__host__ __device__ __forceinline__ int lds_byte(int r, int c) { const int st = (r >> 4) * 2 + (c >> 5), rr = r & 15, cc = c & 31, ob = rr * 64 + cc * 2; return st * 1024 + (ob ^ (((ob >> 9) & 1) << 5)); }
__host__ __device__ __forceinline__ void stage_rc(int b, int& R, int& C) { const int st = b / 1024, sb = b % 1024, swz = sb ^ (((sb >> 9) & 1) << 5); R = (st >> 1) * 16 + swz / 64; C = (st & 1) * 32 + (swz % 64) / 2; }
__host__ __device__ __forceinline__ int perm32(int rho) { const int n = rho >> 4, i = rho & 15; return 8 * (i >> 2) + 4 * n + (i & 3); }
struct Unit { int pm, pn; };
struct Gemm { const bf16_t* A; const bf16_t* Bt; int M, N, K; const int* arow; const int* grp; size_t gstride; };
struct StaticOrder {
    int nM, nN, nwg, G, c;
    __host__ __device__ void init(int M, int N, int G_, int c_) { nM = M / BM; nN = N / BM; nwg = nM * nN; G = G_; c = c_; }
    __host__ __device__ bool next(int i, Unit& u) const {
        const long L = (long)i * G + c; if (L >= nwg) return false;
        int wgid = (int)L; { const int q = nwg / NXCD, r = nwg % NXCD, xcd = wgid % NXCD, off = wgid / NXCD; wgid = (xcd < r ? xcd * (q + 1) : r * (q + 1) + (xcd - r) * q) + off; }
        const int nig = WGM * nN, gid = wgid / nig, fm = gid * WGM, gsz = (nM - fm) < WGM ? (nM - fm) : WGM;
        u.pm = fm + ((wgid % nig) % gsz); u.pn = (wgid % nig) / gsz; return true;
    }
};
__device__ __forceinline__ unsigned cvt_pk_bf16(float lo, float hi) { unsigned r; asm volatile("v_cvt_pk_bf16_f32 %0, %1, %2" : "=v"(r) : "v"(lo), "v"(hi)); return r; }
__device__ __forceinline__ f32x2 gelu_pk(f32x2 v) {
    const f32x2 av = __builtin_elementwise_abs(v), d = av * 0.2316418882f + 1.0f;
    f32x2 t; t.x = __builtin_amdgcn_rcpf(d.x); t.y = __builtin_amdgcn_rcpf(d.y);
    f32x2 q = t * 0.5307027145f + (-0.7265760135f); q = q * t + 0.7107068705f; q = q * t + (-0.142248368f); q = q * t + 0.127414796f; q = q * t;
    const f32x2 s = (v * v) * (-0.72134752044f);
    f32x2 e; e.x = __builtin_amdgcn_exp2f(s.x); e.y = __builtin_amdgcn_exp2f(s.y);
    const f32x2 m = v * (q * e), r = v - m;
    f32x2 o; o.x = v.x < 0.f ? m.x : r.x; o.y = v.y < 0.f ? m.y : r.y; return o;
}
template <class Epi, class Sched, bool ALIGN_EPI, bool GATHER>
__device__ __forceinline__ void gemm_phase(LAS unsigned char* lds, const Gemm g, const Sched& S, const Epi& E, const int tid) {
    const int wid = __builtin_amdgcn_readfirstlane(tid >> 6), lane = tid & 63, wr = wid >> 2, wc = wid & 3, fr = lane & 15, fq = lane >> 4;
    const int K = g.K, nt = K / BK;
    unsigned voffA[2], voffB[2];
    unsigned voffA1[2];
#pragma unroll
    for (int i = 0; i < 2; ++i) { int R, C; stage_rc(tid * 16 + i * 8192, R, C); const int Rb = Epi::PERM ? ((R & ~31) + perm32(R & 31)) : R;
        voffA[i] = (unsigned)(R * K + C) * 2u; voffA1[i] = voffA[i]; voffB[i] = (unsigned)(Rb * K + C) * 2u; }
    const size_t kstep = (size_t)(BK * 2);
    const size_t hstep = (size_t)HALF * K * 2;
    const size_t tstep = 2 * hstep;
    const unsigned ldsw = (unsigned)wid * 1024u;
    const int aoff = lds_byte(wr * 64 + fr, fq * 8), boff = lds_byte(wc * 32 + fr, fq * 8);
#define PG8_SA(b, h) (((b) * 2 + (h)) * HTB)
#define PG8_SB(b, h) ((4 + (b) * 2 + (h)) * HTB)
#define PG8_STAGE(bufoff, gbase, voff) do { _Pragma("unroll") for (int _i = 0; _i < 2; ++_i) \
        __builtin_amdgcn_global_load_lds((const unsigned*)((const char*)(gbase) + (voff)[_i]), (LAS unsigned*)(lds + (bufoff) + ldsw + _i * 8192), 16, 0, 0); } while (0)
#define PG8_LDA(dst, b, h) do { _Pragma("unroll") for (int m = 0; m < 4; ++m) _Pragma("unroll") for (int k = 0; k < 2; ++k) dst[m][k] = *(const LAS bf16x8*)(lds + PG8_SA(b, h) + aoff + m * 2048 + k * 1024); } while (0)
#define PG8_LDB(dst, b, h) do { _Pragma("unroll") for (int n = 0; n < 2; ++n) _Pragma("unroll") for (int k = 0; k < 2; ++k) dst[n][k] = *(const LAS bf16x8*)(lds + PG8_SB(b, h) + boff + n * 2048 + k * 1024); } while (0)
#define PG8_MMA(ai, bj, At, Bt) do { __builtin_amdgcn_s_setprio(1); _Pragma("unroll") for (int m = 0; m < 4; ++m) _Pragma("unroll") for (int n = 0; n < 2; ++n) _Pragma("unroll") for (int k = 0; k < 2; ++k) \
        acc[ai][bj][m][n] = __builtin_amdgcn_mfma_f32_16x16x32_bf16(Bt[n][k], At[m][k], acc[ai][bj][m][n], 0, 0, 0); __builtin_amdgcn_s_setprio(0); } while (0)
#define PG8_WAIT_V(n) asm volatile("s_waitcnt vmcnt(" #n ")" ::: "memory")
#define PG8_WAIT_L(n) asm volatile("s_waitcnt lgkmcnt(" #n ")" ::: "memory")
#define PG8_BAR __builtin_amdgcn_s_barrier()
#define PG8_SCHED __builtin_amdgcn_sched_barrier(0)
#define PG8_GOFF(u, v0, v1) do { _Pragma("unroll") for (int _i = 0; _i < 2; ++_i) { int R_, C_; stage_rc(tid * 16 + _i * 8192, R_, C_); \
        const int r0_ = g.arow[(u).pm * BM + R_], r1_ = g.arow[(u).pm * BM + HALF + R_]; v0[_i] = (unsigned)(r0_ * K + C_) * 2u; v1[_i] = (unsigned)(r1_ * K + C_) * 2u; } } while (0)
#define PG8_BBASE(u) ((const char*)g.Bt + (g.grp ? (size_t)g.grp[(u).pm] * g.gstride * 2 : (size_t)0) + (size_t)(u).pn * tstep)
    Unit cur, nxt; int ui = 0;
    if (!S.next(0, cur)) return;
    f32x4 acc[2][2][4][2];
#pragma unroll
    for (int a = 0; a < 2; ++a)
#pragma unroll
        for (int b = 0; b < 2; ++b)
#pragma unroll
            for (int m = 0; m < 4; ++m)
#pragma unroll
                for (int n = 0; n < 2; ++n) acc[a][b][m][n] = (f32x4){0.f, 0.f, 0.f, 0.f};
    bf16x8 At[4][2], B0[2][2], B1[2][2];
    const char* cA = GATHER ? (const char*)g.A : (const char*)g.A + (size_t)cur.pm * tstep;
    const size_t ah = GATHER ? (size_t)0 : hstep;
    if constexpr (GATHER) PG8_GOFF(cur, voffA, voffA1);
    const char* cB = PG8_BBASE(cur);
    PG8_STAGE(PG8_SB(0, 0), cB, voffB); PG8_STAGE(PG8_SA(0, 0), cA, voffA); PG8_STAGE(PG8_SB(0, 1), cB + hstep, voffB); PG8_STAGE(PG8_SA(0, 1), cA + ah, voffA1);
    if (wr == 1) PG8_BAR;
    PG8_WAIT_V(4); PG8_BAR;
    PG8_STAGE(PG8_SB(1, 0), cB + kstep, voffB); PG8_STAGE(PG8_SA(1, 0), cA + kstep, voffA); PG8_STAGE(PG8_SB(1, 1), cB + hstep + kstep, voffB);
    PG8_WAIT_V(6); PG8_BAR;
    for (;;) {
        const bool has_next = S.next(ui + 1, nxt);
        const char* nA = (GATHER || !has_next) ? cA : (const char*)g.A + (size_t)nxt.pm * tstep; const char* nB = has_next ? PG8_BBASE(nxt) : cB;
        for (int t = 0; t < nt; t += 2) {
            const bool last = (t == nt - 2);
            const char* a1 = cA + (size_t)(t + 1) * kstep;
            const char* a2 = last ? nA : cA + (size_t)(t + 2) * kstep; const char* b2 = last ? nB : cB + (size_t)(t + 2) * kstep;
            const char* a3 = a2 + kstep; const char* b3 = b2 + kstep;
            PG8_LDB(B0, 0, 0); PG8_SCHED; PG8_LDA(At, 0, 0); PG8_STAGE(PG8_SA(1, 1), a1 + ah, voffA1);
            if constexpr (GATHER) { if (last && has_next) PG8_GOFF(nxt, voffA, voffA1); }
            PG8_WAIT_L(8); PG8_BAR; PG8_WAIT_L(0); PG8_MMA(0, 0, At, B0); PG8_BAR; PG8_SCHED;
            PG8_LDB(B1, 0, 1); PG8_STAGE(PG8_SB(0, 0), b2, voffB);
            PG8_BAR; PG8_WAIT_L(0); PG8_MMA(0, 1, At, B1); PG8_BAR;
            PG8_LDA(At, 0, 1); PG8_STAGE(PG8_SA(0, 0), a2, voffA);
            PG8_BAR; PG8_WAIT_L(0); PG8_MMA(1, 0, At, B0); PG8_BAR; PG8_SCHED;
            PG8_STAGE(PG8_SB(0, 1), b2 + hstep, voffB);
            PG8_WAIT_V(6); PG8_BAR; PG8_MMA(1, 1, At, B1); PG8_BAR;
            PG8_LDB(B0, 1, 0); PG8_SCHED; PG8_LDA(At, 1, 0); PG8_STAGE(PG8_SA(0, 1), a2 + ah, voffA1);
            PG8_WAIT_L(8); PG8_BAR; PG8_WAIT_L(0); PG8_MMA(0, 0, At, B0); PG8_BAR; PG8_SCHED;
            PG8_LDB(B1, 1, 1); PG8_STAGE(PG8_SB(1, 0), b3, voffB);
            PG8_BAR; PG8_WAIT_L(0); PG8_MMA(0, 1, At, B1); PG8_BAR;
            PG8_LDA(At, 1, 1); PG8_STAGE(PG8_SA(1, 0), a3, voffA);
            PG8_BAR; PG8_WAIT_L(0); PG8_MMA(1, 0, At, B0); PG8_BAR; PG8_SCHED;
            PG8_STAGE(PG8_SB(1, 1), b3 + hstep, voffB);
            PG8_WAIT_V(6); PG8_BAR; PG8_MMA(1, 1, At, B1); PG8_BAR;
        }
        if constexpr (ALIGN_EPI) { if (wr == 0) PG8_BAR; }
        E(acc, cur, wr, wc, fr, fq);
        if (!has_next) break;
#pragma unroll
        for (int a = 0; a < 2; ++a)
#pragma unroll
            for (int b = 0; b < 2; ++b)
#pragma unroll
                for (int m = 0; m < 4; ++m)
#pragma unroll
                    for (int n = 0; n < 2; ++n) acc[a][b][m][n] = (f32x4){0.f, 0.f, 0.f, 0.f};
        cur = nxt; cA = nA; cB = nB; ++ui;
        if constexpr (ALIGN_EPI) { if (wr == 1) PG8_BAR; }
    }
    PG8_WAIT_V(0);
    if constexpr (!ALIGN_EPI) { if (wr == 0) PG8_BAR; }
    PG8_BAR;
#undef PG8_SA
#undef PG8_SB
#undef PG8_STAGE
#undef PG8_LDA
#undef PG8_LDB
#undef PG8_MMA
#undef PG8_WAIT_V
#undef PG8_WAIT_L
#undef PG8_BAR
#undef PG8_SCHED
#undef PG8_GOFF
#undef PG8_BBASE
}

struct EpiEvenIn {
    static constexpr bool PERM = true;
    bf16_t* O;
    __device__ __forceinline__ void operator()(const f32x4 (&acc)[2][2][4][2], const Unit& u, int wr, int wc, int fr, int fq) const {
        const int row0 = u.pm * BM + wr * 64 + fr, col0 = u.pn * BM + wc * 32 + 8 * fq; const bool act = u.pn >= 4;
#pragma unroll
        for (int ai = 0; ai < 2; ++ai)
#pragma unroll
            for (int m = 0; m < 4; ++m) { bf16_t* rowp = O + (size_t)(row0 + ai * HALF + m * 16) * NEIN + col0;
#pragma unroll
                for (int bj = 0; bj < 2; ++bj) { f32x4 v0 = acc[ai][bj][m][0], v1 = acc[ai][bj][m][1];
                    if (act) { f32x2 a = gelu_pk((f32x2){v0[0], v0[1]}), b = gelu_pk((f32x2){v0[2], v0[3]}), c = gelu_pk((f32x2){v1[0], v1[1]}), d = gelu_pk((f32x2){v1[2], v1[3]});
                        v0 = (f32x4){a.x, a.y, b.x, b.y}; v1 = (f32x4){c.x, c.y, d.x, d.y}; }
                    u32x4 w; w.x = cvt_pk_bf16(v0[0], v0[1]); w.y = cvt_pk_bf16(v0[2], v0[3]); w.z = cvt_pk_bf16(v1[0], v1[1]); w.w = cvt_pk_bf16(v1[2], v1[3]);
                    *(u32x4*)(rowp + bj * HALF) = w; } }
    }
};
struct EpiRes {
    static constexpr bool PERM = false;
    const float* sl; const float* sc; float* dl; float* dc; const float* gate;
    __device__ __forceinline__ void operator()(const f32x4 (&acc)[2][2][4][2], const Unit& u, int wr, int wc, int fr, int fq) const {
        const int col0 = u.pn * BM + wc * 32 + 4 * fq;
        const bool isc = u.pm >= 128; const int ms = isc ? 2 : (u.pm >= 64 ? 1 : 0);
        const size_t rbase = isc ? (size_t)(u.pm - 128) * BM : (size_t)u.pm * BM;
        const float* src = (isc ? sc : sl) + rbase * D; float* dst = (isc ? dc : dl) + rbase * D;
        f32x4 gv[2][2];
#pragma unroll
        for (int bj = 0; bj < 2; ++bj)
#pragma unroll
            for (int n = 0; n < 2; ++n) gv[bj][n] = *(const f32x4*)(gate + ms * 6144 + col0 + bj * HALF + n * 16);
#pragma unroll
        for (int ai = 0; ai < 2; ++ai)
#pragma unroll
            for (int m = 0; m < 4; ++m) { const size_t off = (size_t)(ai * HALF + wr * 64 + m * 16 + fr) * D + col0;
#pragma unroll
                for (int bj = 0; bj < 2; ++bj)
#pragma unroll
                    for (int n = 0; n < 2; ++n) { const f32x4 xs = *(const f32x4*)(src + off + bj * HALF + n * 16); *(f32x4*)(dst + off + bj * HALF + n * 16) = xs + gv[bj][n] * acc[ai][bj][m][n]; } }
    }
};
struct EpiSwiglu {
    static constexpr bool PERM = true;
    bf16_t* O; int ldc;
    __device__ __forceinline__ void operator()(const f32x4 (&acc)[2][2][4][2], const Unit& u, int wr, int wc, int fr, int fq) const {
        const int row0 = u.pm * BM + wr * 64 + fr, col0 = u.pn * 128 + wc * 16 + 4 * fq;
#pragma unroll
        for (int ai = 0; ai < 2; ++ai)
#pragma unroll
            for (int m = 0; m < 4; ++m) { bf16_t* rowp = O + (size_t)(row0 + ai * HALF + m * 16) * ldc + col0;
#pragma unroll
                for (int bj = 0; bj < 2; ++bj) { const f32x4 a = acc[ai][bj][m][0], b = acc[ai][bj][m][1];
                    u32x2 w; w.x = cvt_pk_bf16(siluf(a[0]) * b[0], siluf(a[1]) * b[1]); w.y = cvt_pk_bf16(siluf(a[2]) * b[2], siluf(a[3]) * b[3]);
                    *(u32x2*)(rowp + bj * 64) = w; } }
    }
};
struct EpiOddIn {
    static constexpr bool PERM = true;
    bf16_t* O; const float* lb;
    __device__ __forceinline__ void operator()(const f32x4 (&acc)[2][2][4][2], const Unit& u, int wr, int wc, int fr, int fq) const {
        const int row0 = u.pm * BM + wr * 64 + fr, col0 = u.pn * BM + wc * 32 + 8 * fq; const int seg = u.pn >> 2;
        f32x4 lbv[2][2];
#pragma unroll
        for (int bj = 0; bj < 2; ++bj)
#pragma unroll
            for (int n = 0; n < 2; ++n) lbv[bj][n] = (seg == 2 || seg == 3) ? *(const f32x4*)(lb + (col0 - 2048) + bj * HALF + 4 * n) : (f32x4){0.f, 0.f, 0.f, 0.f};
#pragma unroll
        for (int ai = 0; ai < 2; ++ai)
#pragma unroll
            for (int m = 0; m < 4; ++m) { bf16_t* rowp = O + (size_t)(row0 + ai * HALF + m * 16) * NREC + col0;
#pragma unroll
                for (int bj = 0; bj < 2; ++bj) { f32x4 v[2] = {acc[ai][bj][m][0], acc[ai][bj][m][1]};
#pragma unroll
                    for (int n = 0; n < 2; ++n)
#pragma unroll
                        for (int i = 0; i < 4; ++i) { float x = v[n][i];
                            if (seg == 0) x = siluf(x) * 0.08838834764831845f;
                            else if (seg == 1) x = siluf(x);
                            else if (seg == 2 || seg == 3) { const float l = lbv[bj][n][i]; const float s = __builtin_amdgcn_rcpf(1.0f + __expf(-x)); const float f = l + (1.0f - l) * s; x = __logf(fmaxf(f, 1e-30f)); }
                            v[n][i] = x; }
                    u32x4 w; w.x = cvt_pk_bf16(v[0][0], v[0][1]); w.y = cvt_pk_bf16(v[0][2], v[0][3]); w.z = cvt_pk_bf16(v[1][0], v[1][1]); w.w = cvt_pk_bf16(v[1][2], v[1][3]);
                    *(u32x4*)(rowp + bj * HALF) = w; } }
    }
};
struct EpiMoeDown {
    static constexpr bool PERM = true;
    bf16_t* O; const int* dst;
    __device__ __forceinline__ void operator()(const f32x4 (&acc)[2][2][4][2], const Unit& u, int wr, int wc, int fr, int fq) const {
        const int row0 = u.pm * BM + wr * 64 + fr, col0 = u.pn * BM + wc * 32 + 8 * fq;
        int dd[2][4];
#pragma unroll
        for (int ai = 0; ai < 2; ++ai)
#pragma unroll
            for (int m = 0; m < 4; ++m) dd[ai][m] = dst[row0 + ai * HALF + m * 16];
#pragma unroll
        for (int ai = 0; ai < 2; ++ai)
#pragma unroll
            for (int m = 0; m < 4; ++m) { if (dd[ai][m] >= 0) { bf16_t* rowp = O + (size_t)dd[ai][m] * D + col0;
#pragma unroll
                for (int bj = 0; bj < 2; ++bj) { const f32x4 v0 = acc[ai][bj][m][0], v1 = acc[ai][bj][m][1];
                    u32x4 w; w.x = cvt_pk_bf16(v0[0], v0[1]); w.y = cvt_pk_bf16(v0[2], v0[3]); w.z = cvt_pk_bf16(v1[0], v1[1]); w.w = cvt_pk_bf16(v1[2], v1[3]);
                    *(u32x4*)(rowp + bj * HALF) = w; } } }
    }
};
}

struct Args { const float* in[24]; float* out; unsigned char* ws; int ph_lo, ph_hi; };
enum { I_X = 0, I_C, I_CTX, I_CCTX, I_WADA, I_BADA, I_NMIX, I_NFFN, I_NOUT, I_WINE, I_GW, I_GB, I_WOUTE, I_WINO, I_RLB, I_RNORM, I_WOUTO, I_F1, I_F3, I_F2, I_RW, I_M1, I_M3, I_M2 };
enum { PH_P0 = 0, PH_PAIR0 = 1, NPL = 18, PH_FINAL = 1 + 2 * NPL, NPHASE = PH_FINAL + 1 };
enum { E1_NORM = 0, E2_GIN, E3_FFTA, E3_FFTC, E4_GOUT, E5_NORM, E6_UP, E7_DOWN, O1_NORM, O2_GIN, O3_SCAN1, O4_CARRY, O5_SCAN3, O6_GOUT, O7_NORM, O8_SLOTS, O9_MUP, O10_MDOWN };

struct Ctx {
    LAS unsigned char* lds; int tid, lane, wave, G, bid, gw, NGW;
    const float* const* in; float* out; unsigned char* ws;
};

__device__ __forceinline__ void transpose_item(const float* W, int ld, int K, int N, bf16_t* WT, int mode, int roff, LAS float* scr, int item, int lane) {
    const int nblk = N / 32, kb = item / nblk, nb = item % nblk, k0 = 64 * kb, n0 = 32 * nb;
#pragma unroll 8
    for (int i = 0; i < 32; ++i) { const int kk = 2 * i + (lane >> 5); scr[kk * 33 + (lane & 31)] = W[(size_t)(k0 + kk) * ld + n0 + (lane & 31)]; }
    LDS_WAIT(); asm volatile("" ::: "memory");
    const int c = lane & 7;
#pragma unroll
    for (int j = 0; j < 4; ++j) { const int n = (lane >> 3) + 8 * j; const LAS float* s = scr + (8 * c) * 33 + n;
        u32x4 o; o.x = pk2(s[0 * 33], s[1 * 33]); o.y = pk2(s[2 * 33], s[3 * 33]); o.z = pk2(s[4 * 33], s[5 * 33]); o.w = pk2(s[6 * 33], s[7 * 33]);
        const int ng = n0 + n; const int drow = mode == 0 ? (roff + ng) : (((ng >> 2) << 3) + (ng & 3) + roff);
        *(u32x4*)(WT + (size_t)drow * K + k0 + 8 * c) = o; }
    LDS_WAIT(); asm volatile("" ::: "memory");
}

__device__ __forceinline__ void p0_prologue(const Ctx& F) {
    const int tid = F.tid, lane = F.lane, wave = F.wave;
    unsigned char* ws = F.ws;
    LAS float* scond = (LAS float*)(F.lds);
    LAS float* part = (LAS float*)(F.lds + 16384);
    LAS float* ctab = (LAS float*)(F.lds + 32768);
    for (int i = tid; i < 3 * D; i += 512) { const int v = i / D, k = i % D; const float c = v < 2 ? F.in[I_C][v * D + k] : F.in[I_CCTX][k]; scond[i] = c / (1.0f + expf(-c)); }
    if (tid < 128) ctab[tid] = cosf(6.283185307179586f * (float)tid / 128.0f);
    __syncthreads();
    float* mods = (float*)(ws + WS_MODS);
    if (P0_MASK & 1)
    for (int it = F.bid; it < 4 * 96; it += F.G) {
        const int l = it / 96, cg = it % 96; const float* W = F.in[I_WADA] + (size_t)l * D * 6144 + cg * 64 + lane;
        float a0 = 0.f, a1 = 0.f, a2 = 0.f;
#pragma unroll 8
        for (int kk = 0; kk < 128; ++kk) { const int k = wave * 128 + kk; const float w = W[(size_t)k * 6144]; a0 += scond[k] * w; a1 += scond[D + k] * w; a2 += scond[2 * D + k] * w; }
        part[(wave * 3 + 0) * 64 + lane] = a0; part[(wave * 3 + 1) * 64 + lane] = a1; part[(wave * 3 + 2) * 64 + lane] = a2;
        __syncthreads();
        if (tid < 192) { const int v = tid / 64, c = tid % 64; float s = 0.f;
#pragma unroll
            for (int w = 0; w < 8; ++w) s += part[(w * 3 + v) * 64 + c];
            mods[((size_t)l * 3 + v) * 6144 + cg * 64 + c] = s + F.in[I_BADA][l * 6144 + cg * 64 + c]; }
        __syncthreads();
    }
    const int gt = F.bid * 512 + tid, NGT = F.G * 512;
    float* LB = (float*)(ws + WS_LB);
    if (P0_MASK & 2)
    for (int i = gt; i < 4096; i += NGT) { const int j = i >> 11, r = i & 2047; float v = 0.f; if (j == 1) { const float r0 = F.in[I_RLB][r], r1 = F.in[I_RLB][2048 + r]; v = 1.0f / (1.0f + expf(r0 - r1)); v = fminf(fmaxf(v, 0.f), 1.f); } LB[i] = v; }
    bf16_t* FA = (bf16_t*)(ws + WS_FA); bf16_t* FC = (bf16_t*)(ws + WS_FC); bf16_t* FX = (bf16_t*)(ws + WS_FX); bf16_t* GW = (bf16_t*)(ws + WS_GW);
    if (P0_MASK & 4)
    for (int i = gt; i < 256 * 256; i += NGT) { const int r = i >> 8, c = i & 255, k1 = r & 127, t1 = c & 127; const float ang = 6.283185307179586f * (float)((k1 * t1) & 127) / 128.0f; float sn, cs; sincosf(ang, &sn, &cs);
        const int rr = r >> 7, cc = c >> 7; const float v = (rr == cc) ? cs : (rr == 0 ? -sn : sn); FA[i] = (bf16_t)f2bf(v); }
    if (P0_MASK & 4)
    for (int i = gt; i < 128 * 256; i += NGT) { const int k2 = i >> 8, c = i & 255, t2 = c & 127; const float ang = 6.283185307179586f * (float)((k2 * t2) & 127) / 128.0f; float sn, cs; sincosf(ang, &sn, &cs); FC[i] = (bf16_t)f2bf(c < 128 ? cs : -sn); }
    if (P0_MASK & 4)
    for (int i = gt; i < 256 * 512; i += NGT) { const int k = i >> 9, c = i & 511, t = c & 255; const float ang = 6.283185307179586f * (float)((k * t) & 255) / 256.0f; float sn, cs; sincosf(ang, &sn, &cs); FX[i] = (bf16_t)f2bf(c < 256 ? cs : -sn); }
    if (P0_MASK & 8)
    for (int i = gt; i < 2 * 4 * 128 * 128; i += NGT) GW[i] = (bf16_t)f2bf(F.in[I_GW][i]);
    bf16_t* WinE = (bf16_t*)(ws + WS_WINE);
    if (P0_MASK & 16)
    for (int it = F.gw; it < 2 * 4 * 16 * 32; it += F.NGW) {
        const int mg = it & 31, kb = (it >> 5) & 15, g = (it >> 9) & 3, j = it >> 11; const int k = kb * 64 + lane, m0 = mg * 4;
        const float* Wr = F.in[I_WINE] + (size_t)j * D * 1536 + (size_t)k * 1536 + g * 128;
        float aP[4] = {0.f, 0.f, 0.f, 0.f}, aQ[4] = {0.f, 0.f, 0.f, 0.f};
        for (int c4 = 0; c4 < 32; ++c4) { const f32x4 w = *(const f32x4*)(Wr + 4 * c4);
#pragma unroll
            for (int ci = 0; ci < 4; ++ci) { const int c = 4 * c4 + ci;
#pragma unroll
                for (int mm = 0; mm < 4; ++mm) { const int idx = (c * (m0 + mm)) & 127; aP[mm] += w[ci] * ctab[idx]; aQ[mm] += w[ci] * ctab[(idx - 32) & 127]; } } }
#pragma unroll
        for (int mm = 0; mm < 4; ++mm) { bf16_t* o = WinE + (size_t)j * NEIN * D; o[(size_t)(g * 128 + m0 + mm) * D + k] = (bf16_t)f2bf(aP[mm]); o[(size_t)(512 + g * 128 + m0 + mm) * D + k] = (bf16_t)f2bf(aQ[mm]); }
    }
    LAS float* scr = (LAS float*)(F.lds + 40960 + wave * 8704);
    constexpr int NI_UV = 16 * 32, NI_SQ = 16 * 32, NI_INO = 16 * 160, NI_F13 = 16 * 88, NI_F2 = 44 * 32;
    constexpr int PER_J = NI_UV + NI_SQ + NI_INO + NI_SQ + 2 * NI_F13 + NI_F2;
    if (P0_MASK & 32)
    for (int it = F.gw; it < 2 * PER_J; it += F.NGW) {
        const int j = it / PER_J; int r = it % PER_J;
        const float* W; int ld, K, N, mode = 0, roff = 0, tsel = 0; bf16_t* WT;
        if (r < NI_UV) { W = F.in[I_WINE] + (size_t)j * D * 1536 + 512; ld = 1536; K = D; N = 1024; WT = WinE + (size_t)j * NEIN * D; roff = 1024; }
        else if ((r -= NI_UV) < NI_SQ) { W = F.in[I_WOUTE] + (size_t)j * D * D; ld = D; K = D; N = D; WT = (bf16_t*)(ws + WS_WOUTE) + (size_t)j * D * D; tsel = 1; }
        else if ((r -= NI_SQ) < NI_INO) { W = F.in[I_WINO] + (size_t)j * D * NREC; ld = NREC; K = D; N = NREC; WT = (bf16_t*)(ws + WS_WINO) + (size_t)j * NREC * D; tsel = 2; }
        else if ((r -= NI_INO) < NI_SQ) { W = F.in[I_WOUTO] + (size_t)j * D * D; ld = D; K = D; N = D; WT = (bf16_t*)(ws + WS_WOUTO) + (size_t)j * D * D; tsel = 3; }
        else if ((r -= NI_SQ) < NI_F13) { W = F.in[I_F1] + (size_t)j * D * DFF; ld = DFF; K = D; N = DFF; WT = (bf16_t*)(ws + WS_W13) + (size_t)j * NFF2 * D; mode = 1; tsel = 4; }
        else if ((r -= NI_F13) < NI_F13) { W = F.in[I_F3] + (size_t)j * D * DFF; ld = DFF; K = D; N = DFF; WT = (bf16_t*)(ws + WS_W13) + (size_t)j * NFF2 * D; mode = 1; roff = 4; tsel = 5; }
        else { r -= NI_F13; W = F.in[I_F2] + (size_t)j * DFF * D; ld = D; K = DFF; N = D; WT = (bf16_t*)(ws + WS_W2) + (size_t)j * D * DFF; tsel = 6; }
        if ((P0_T >> tsel) & 1) transpose_item(W, ld, K, N, WT, mode, roff, scr, r, lane);
    }
}
__device__ __forceinline__ void moe_convert(const Ctx& F, int j) {
    LAS float* scr = (LAS float*)(F.lds + 40960 + F.wave * 8704);
    constexpr int I_13 = 16 * 112, I_2 = 56 * 32, PER_E = 2 * I_13 + I_2;
    for (int it = F.gw; it < NE * PER_E; it += F.NGW) {
        const int e = it / PER_E; int r = it % PER_E; const size_t eo = (size_t)(j * NE + e);
        const float* W; int ld, K, N, mode = 0, roff = 0; bf16_t* WT;
        if (r < I_13) { W = F.in[I_M1] + eo * D * DEX; ld = DEX; K = D; N = DEX; WT = (bf16_t*)(F.ws + WS_W13M) + (size_t)e * NEX2 * D; mode = 1; }
        else if ((r -= I_13) < I_13) { W = F.in[I_M3] + eo * D * DEX; ld = DEX; K = D; N = DEX; WT = (bf16_t*)(F.ws + WS_W13M) + (size_t)e * NEX2 * D; mode = 1; roff = 4; }
        else { r -= I_13; W = F.in[I_M2] + eo * DEX * D; ld = D; K = DEX; N = D; WT = (bf16_t*)(F.ws + WS_W2M) + (size_t)e * D * DEX; }
        transpose_item(W, ld, K, N, WT, mode, roff, scr, r, F.lane);
    }
}

struct RowPass {
    const float* sl; const float* sc;
    float* dl; float* dc;
    const float* gain;
    const float* shift; const float* scale;
    bf16_t* H;
    int nrows;
    const bf16_t* YE; const float* topp; const float* gatef;
    const float* rw; int* tope; float* toppo; int* rank; int* cnt;
    float* fout;
};
template <bool COMBINE, bool ROUTER, bool FINAL>
__device__ __forceinline__ void row_pass(const Ctx& F, const RowPass& P) {
    const int lane = F.lane;
    LAS float* rwl = (LAS float*)F.lds;
    if (ROUTER) { for (int i = F.tid; i < D * NE; i += 512) rwl[i] = P.rw[i]; __syncthreads(); }
    f32x4 gn[4];
#pragma unroll
    for (int j = 0; j < 4; ++j) gn[j] = *(const f32x4*)(P.gain + 4 * lane + 256 * j);
    const int nitems = P.nrows / 16;
    for (int it = F.gw; it < nitems; it += F.NGW) {
        int rc0 = 0, rc1 = 0, rc2 = 0, rc3 = 0, rc4 = 0, rc5 = 0, rc6 = 0, rc7 = 0;
        for (int rr = 0; rr < 16; ++rr) {
            const int r = it * 16 + rr; const bool isc = r >= ML; const int ms = isc ? 2 : (r >= TL ? 1 : 0);
            const float* xs = isc ? P.sc + (size_t)(r - ML) * D : P.sl + (size_t)r * D;
            f32x4 v[4];
#pragma unroll
            for (int j = 0; j < 4; ++j) v[j] = *(const f32x4*)(xs + 4 * lane + 256 * j);
            if (COMBINE) {
                const float p0 = P.topp[2 * r], p1 = P.topp[2 * r + 1];
                const bf16_t* y0 = P.YE + (size_t)(2 * r) * D; const bf16_t* y1 = y0 + D;
                float* xd = isc ? P.dc + (size_t)(r - ML) * D : P.dl + (size_t)r * D;
#pragma unroll
                for (int j = 0; j < 4; ++j) { const u32x2 a = *(const u32x2*)(y0 + 4 * lane + 256 * j), b = *(const u32x2*)(y1 + 4 * lane + 256 * j);
                    const f32x4 gf = *(const f32x4*)(P.gatef + ms * 6144 + 4 * lane + 256 * j);
                    f32x4 y; y[0] = p0 * bflo(a.x) + p1 * bflo(b.x); y[1] = p0 * bfhi(a.x) + p1 * bfhi(b.x); y[2] = p0 * bflo(a.y) + p1 * bflo(b.y); y[3] = p0 * bfhi(a.y) + p1 * bfhi(b.y);
                    v[j] = v[j] + gf * y;
                    if (!FINAL) *(f32x4*)(xd + 4 * lane + 256 * j) = v[j]; }
            }
            float ss = 0.f;
#pragma unroll
            for (int j = 0; j < 4; ++j) ss += (v[j][0] * v[j][0] + v[j][1] * v[j][1]) + (v[j][2] * v[j][2] + v[j][3] * v[j][3]);
            const float rstd = rsqrtf(wave_sum(ss) * (1.0f / D) + EPS);
            if (FINAL) {
#pragma unroll
                for (int j = 0; j < 4; ++j) *(f32x4*)(P.fout + (size_t)r * D + 4 * lane + 256 * j) = v[j] * rstd * gn[j];
            } else {
                f32x4 h[4];
#pragma unroll
                for (int j = 0; j < 4; ++j) { const f32x4 sh = *(const f32x4*)(P.shift + ms * 6144 + 4 * lane + 256 * j), scl = *(const f32x4*)(P.scale + ms * 6144 + 4 * lane + 256 * j);
                    h[j] = (v[j] * rstd * gn[j]) * (scl + 1.0f) + sh;
                    u32x2 w; w.x = pk2(h[j][0], h[j][1]); w.y = pk2(h[j][2], h[j][3]);
                    *(u32x2*)(P.H + (size_t)r * D + 4 * lane + 256 * j) = w; }
                if (ROUTER) {
                    float lg[8] = {0.f, 0.f, 0.f, 0.f, 0.f, 0.f, 0.f, 0.f};
#pragma unroll
                    for (int j = 0; j < 4; ++j)
#pragma unroll
                        for (int i = 0; i < 4; ++i) { const int col = 4 * lane + 256 * j + i; const f32x4 w0 = *(const LAS f32x4*)(rwl + col * 8), w1 = *(const LAS f32x4*)(rwl + col * 8 + 4); const float hv = h[j][i];
                            lg[0] += hv * w0[0]; lg[1] += hv * w0[1]; lg[2] += hv * w0[2]; lg[3] += hv * w0[3]; lg[4] += hv * w1[0]; lg[5] += hv * w1[1]; lg[6] += hv * w1[2]; lg[7] += hv * w1[3]; }
#pragma unroll
                    for (int e = 0; e < 8; ++e) lg[e] = wave_sum(lg[e]);
                    int e0 = 0; float v0 = lg[0];
#pragma unroll
                    for (int e = 1; e < 8; ++e) if (lg[e] > v0) { v0 = lg[e]; e0 = e; }
                    int e1 = -1; float v1 = -3.0e38f;
#pragma unroll
                    for (int e = 0; e < 8; ++e) if (e != e0 && lg[e] > v1) { v1 = lg[e]; e1 = e; }
                    const float ex = expf(v1 - v0); const float p0 = 1.0f / (1.0f + ex), p1 = ex / (1.0f + ex);
                    const int rk0 = e0 == 0 ? rc0 : e0 == 1 ? rc1 : e0 == 2 ? rc2 : e0 == 3 ? rc3 : e0 == 4 ? rc4 : e0 == 5 ? rc5 : e0 == 6 ? rc6 : rc7;
                    const int rk1 = e1 == 0 ? rc0 : e1 == 1 ? rc1 : e1 == 2 ? rc2 : e1 == 3 ? rc3 : e1 == 4 ? rc4 : e1 == 5 ? rc5 : e1 == 6 ? rc6 : rc7;
                    rc0 += (e0 == 0) + (e1 == 0); rc1 += (e0 == 1) + (e1 == 1); rc2 += (e0 == 2) + (e1 == 2); rc3 += (e0 == 3) + (e1 == 3);
                    rc4 += (e0 == 4) + (e1 == 4); rc5 += (e0 == 5) + (e1 == 5); rc6 += (e0 == 6) + (e1 == 6); rc7 += (e0 == 7) + (e1 == 7);
                    if (lane == 0) { P.tope[2 * r] = e0; P.tope[2 * r + 1] = e1; P.toppo[2 * r] = p0; P.toppo[2 * r + 1] = p1; P.rank[2 * r] = rk0; P.rank[2 * r + 1] = rk1; }
                }
            }
        }
        if (ROUTER && lane == 0) { int* c = P.cnt + it * 8; c[0] = rc0; c[1] = rc1; c[2] = rc2; c[3] = rc3; c[4] = rc4; c[5] = rc5; c[6] = rc6; c[7] = rc7; }
    }
}

template <int NB>
__device__ __forceinline__ void lm_core(const bf16_t* A, int lda, const int (&i0)[NB], int kc0, int nks, LAS unsigned char* X, f32x4 (&acc)[NB][8], int lane) {
    const int i16 = lane & 15, q = lane >> 4;
    const int xoff = (8 * q + (i16 >> 2)) * XRS + 8 * (i16 & 3);
    for (int ks = 0; ks < nks; ++ks) {
        bf16x8 af[NB];
#pragma unroll
        for (int b = 0; b < NB; ++b) af[b] = *(const bf16x8*)(A + (size_t)(i0[b] + i16) * lda + kc0 + ks * 32 + 8 * q);
#pragma unroll
        for (int nt = 0; nt < 8; ++nt) {
            const s16x4 lo = __builtin_amdgcn_ds_read_tr16_b64_v4i16((LAS s16x4*)(X + ks * 32 * XRS + xoff + nt * 32));
            const s16x4 hi = __builtin_amdgcn_ds_read_tr16_b64_v4i16((LAS s16x4*)(X + ks * 32 * XRS + xoff + nt * 32 + 4 * XRS));
            const bf16x8 xf = __builtin_shufflevector(lo, hi, 0, 1, 2, 3, 4, 5, 6, 7);
#pragma unroll
            for (int b = 0; b < NB; ++b) acc[b][nt] = __builtin_amdgcn_mfma_f32_16x16x32_bf16(xf, af[b], acc[b][nt], 0, 0, 0);
        }
    }
}
template <int NB> __device__ __forceinline__ void zero_acc(f32x4 (&acc)[NB][8]) {
#pragma unroll
    for (int b = 0; b < NB; ++b)
#pragma unroll
        for (int nt = 0; nt < 8; ++nt) acc[b][nt] = (f32x4){0.f, 0.f, 0.f, 0.f};
}
__device__ __forceinline__ void stage_rows(const bf16_t* src, size_t sstride, int nrows, LAS unsigned char* X, int xr0, int tid) {
    for (int i = tid; i < nrows * 16; i += 512) { const int r = i >> 4, ch = i & 15; *(LAS u32x4*)(X + (xr0 + r) * XRS + ch * 16) = *(const u32x4*)(src + (size_t)r * sstride + ch * 8); }
}

__device__ __forceinline__ void fft_stage_a(const Ctx& F) {
    const bf16_t* PZ = (const bf16_t*)(F.ws + WS_PZUV); bf16_t* UP = (bf16_t*)(F.ws + WS_UP); bf16_t* Y = (bf16_t*)(F.ws + WS_H);
    const bf16_t* FA = (const bf16_t*)(F.ws + WS_FA); const bf16_t* FX = (const bf16_t*)(F.ws + WS_FX);
    LAS unsigned char* X = F.lds; const int lane = F.lane, w = F.wave, i16 = lane & 15, q = lane >> 4;
    for (int it = F.bid; it < 1024 + 16; it += F.G) {
        if (it < 1024) {
            const int t2 = it & 127, g = (it >> 7) & 3, b = it >> 9;
            const bf16_t* src = PZ + ((size_t)b * TL + t2) * NEIN + g * 128;
            stage_rows(src, (size_t)128 * NEIN, 128, X, 0, F.tid);
            stage_rows(src + 512, (size_t)128 * NEIN, 128, X, 128, F.tid);
            __syncthreads();
            f32x4 acc[2][8]; zero_acc<2>(acc); const int i0[2] = {16 * w, 128 + 16 * w};
            lm_core<2>(FA, 256, i0, 0, 8, X, acc, lane);
            const int k1 = 16 * w + i16; float sw, cw; sincosf(6.283185307179586f * (float)((k1 * t2) & 16383) / 16384.0f, &sw, &cw);
            bf16_t* orow = UP + ((size_t)((b * 4 + g) * 128 + k1) * 128 + t2) * 256;
#pragma unroll
            for (int nt = 0; nt < 8; ++nt) { const f32x4 ur = acc[0][nt], ui = acc[1][nt]; const int n = 16 * nt + 4 * q;
                u32x2 wr_, wi_; wr_.x = pk2(ur[0] * cw - ui[0] * sw, ur[1] * cw - ui[1] * sw); wr_.y = pk2(ur[2] * cw - ui[2] * sw, ur[3] * cw - ui[3] * sw);
                wi_.x = pk2(ur[0] * sw + ui[0] * cw, ur[1] * sw + ui[1] * cw); wi_.y = pk2(ur[2] * sw + ui[2] * cw, ur[3] * sw + ui[3] * cw);
                *(u32x2*)(orow + n) = wr_; *(u32x2*)(orow + 128 + n) = wi_; }
            __syncthreads();
        } else {
            const int ci = it - 1024, kh = ci & 1, g = (ci >> 1) & 3, b = ci >> 3;
            f32x4 acc[1][8]; zero_acc<1>(acc); const int i0[1] = {128 * kh + 16 * w};
            for (int c = 0; c < 2; ++c) {
                stage_rows(PZ + ((size_t)ML + b * TCX) * NEIN + c * 512 + g * 128, NEIN, 256, X, 0, F.tid);
                __syncthreads();
                lm_core<1>(FX, 512, i0, c * 256, 8, X, acc, lane);
                __syncthreads();
            }
            const int k = 128 * kh + 16 * w + i16; bf16_t* orow = Y + ((size_t)ML + b * TCX + k) * D + g * 128; const float nrm = 0.005524271728019903f;
#pragma unroll
            for (int nt = 0; nt < 8; ++nt) { const f32x4 a = acc[0][nt] * nrm; u32x2 o; o.x = pk2(a[0], a[1]); o.y = pk2(a[2], a[3]); *(u32x2*)(orow + 16 * nt + 4 * q) = o; }
        }
    }
}
__device__ __forceinline__ void fft_stage_c_gmlp(const Ctx& F, int j) {
    const bf16_t* PZ = (const bf16_t*)(F.ws + WS_PZUV); const bf16_t* UP = (const bf16_t*)(F.ws + WS_UP); bf16_t* Y = (bf16_t*)(F.ws + WS_H);
    const bf16_t* FC = (const bf16_t*)(F.ws + WS_FC); const bf16_t* GW = (const bf16_t*)(F.ws + WS_GW) + (size_t)j * 4 * 128 * 128;
    const float* gb = F.in[I_GB] + j * 512;
    LAS unsigned char* X = F.lds; const int lane = F.lane, w = F.wave, i16 = lane & 15, q = lane >> 4, tid = F.tid;
    for (int it = F.bid; it < 1024 + 1040; it += F.G) {
        if (it < 1024) {
            const int k1 = it & 127, g = (it >> 7) & 3, b = it >> 9;
            const bf16_t* src = UP + (size_t)((b * 4 + g) * 128 + k1) * 128 * 256;
            stage_rows(src, 256, 128, X, 0, tid);
            stage_rows(src + 128, 256, 128, X, 128, tid);
            __syncthreads();
            f32x4 acc[1][8]; zero_acc<1>(acc); const int i0[1] = {16 * w};
            lm_core<1>(FC, 256, i0, 0, 8, X, acc, lane);
            const int k2 = 16 * w + i16; bf16_t* orow = Y + ((size_t)b * TL + k1 + 128 * k2) * D + g * 128; const float nrm = 0.0006905339660024878f;
#pragma unroll
            for (int nt = 0; nt < 8; ++nt) { const f32x4 a = acc[0][nt] * nrm; u32x2 o; o.x = pk2(a[0], a[1]); o.y = pk2(a[2], a[3]); *(u32x2*)(orow + 16 * nt + 4 * q) = o; }
            __syncthreads();
        } else {
            const int gi = it - 1024, h = gi & 3, ck = gi >> 2; const size_t r0 = (size_t)ck * 128;
            for (int i = tid; i < 128 * 16; i += 512) { const int r = i >> 4, ch = i & 15; const u32x4 raw = *(const u32x4*)(PZ + (r0 + r) * NEIN + 1536 + h * 128 + ch * 8);
                float x[8] = {bflo(raw.x), bfhi(raw.x), bflo(raw.y), bfhi(raw.y), bflo(raw.z), bfhi(raw.z), bflo(raw.w), bfhi(raw.w)};
                float s = 0.f;
#pragma unroll
                for (int e = 0; e < 8; ++e) s += x[e];
                s += __shfl_xor(s, 1); s += __shfl_xor(s, 2); s += __shfl_xor(s, 4); s += __shfl_xor(s, 8);
                const float mean = s * (1.0f / 128.0f); float qq = 0.f;
#pragma unroll
                for (int e = 0; e < 8; ++e) { x[e] -= mean; qq += x[e] * x[e]; }
                qq += __shfl_xor(qq, 1); qq += __shfl_xor(qq, 2); qq += __shfl_xor(qq, 4); qq += __shfl_xor(qq, 8);
                const float rs = rsqrtf(qq * (1.0f / 128.0f) + EPS);
                u32x4 o; o.x = pk2(x[0] * rs, x[1] * rs); o.y = pk2(x[2] * rs, x[3] * rs); o.z = pk2(x[4] * rs, x[5] * rs); o.w = pk2(x[6] * rs, x[7] * rs);
                *(LAS u32x4*)(X + r * XRS + ch * 16) = o; }
            __syncthreads();
            f32x4 acc[1][8]; zero_acc<1>(acc); const int i0[1] = {16 * w};
            lm_core<1>(GW + (size_t)h * 128 * 128, 128, i0, 0, 4, X, acc, lane);
            const int t = 16 * w + i16; const float bias = gb[h * 128 + t];
            const bf16_t* urow = PZ + (r0 + t) * NEIN + 1024 + h * 128; bf16_t* orow = Y + (r0 + t) * D + 512 + h * 128;
#pragma unroll
            for (int nt = 0; nt < 8; ++nt) { const int n = 16 * nt + 4 * q; const u32x2 uu = *(const u32x2*)(urow + n); const f32x4 a = acc[0][nt];
                u32x2 o; o.x = pk2(bflo(uu.x) * (a[0] + bias), bfhi(uu.x) * (a[1] + bias)); o.y = pk2(bflo(uu.y) * (a[2] + bias), bfhi(uu.y) * (a[3] + bias)); *(u32x2*)(orow + n) = o; }
            __syncthreads();
        }
    }
}

constexpr int SC_QT = 0, SC_KT = 9216, SC_V = 18432, SC_S16 = 27648, SC_SC = 64512, SC_EB = 67072, SC_PT = 67584, SC_RED = 69632, SC_OF = 70656, SC_OFRS = 264;
static_assert(SC_OF + 256 * SC_OFRS <= MISC_OFF, "scan LDS");
constexpr int SCRS = 80;
template <bool NEEDQ>
__device__ __forceinline__ float chunk_prep(const Ctx& F, const bf16_t* P5, size_t row0, bool rev, int h, int dir) {
    const int tid = F.tid, dk = tid & 127, part = tid >> 7;
    LAS unsigned char* L = F.lds;
    float lf[8], cs[8]; float run = 0.f;
#pragma unroll
    for (int i = 0; i < 8; ++i) { const int p = 8 * part + i; const size_t r = row0 + (rev ? 31 - p : p); lf[i] = bf2f(P5[r * NREC + 2048 + dir * 1024 + h * 128 + dk]); run += lf[i]; cs[i] = run; }
    LAS float* PT = (LAS float*)(L + SC_PT);
    PT[part * 128 + dk] = run;
    { const int p = tid >> 4, ch = tid & 15; const size_t r = row0 + (rev ? 31 - p : p); *(LAS u32x4*)(L + SC_V + p * XRS + ch * 16) = *(const u32x4*)(P5 + r * NREC + 4096 + h * 128 + ch * 8); }
    __syncthreads();
    const float t0 = PT[dk], t1 = PT[128 + dk], t2 = PT[256 + dk], t3 = PT[384 + dk];
    const float off = part == 0 ? 0.f : part == 1 ? t0 : part == 2 ? t0 + t1 : t0 + t1 + t2;
    const float bend = (t0 + t1) + (t2 + t3);
#pragma unroll
    for (int i = 0; i < 8; ++i) { const int p = 8 * part + i; const float b = off + cs[i];
        const float kk = (1.0f - __expf(lf[i])) * __expf(fminf(-b, 80.0f));
        *(LAS bf16_t*)(L + SC_KT + p * XRS + dk * 2) = (bf16_t)f2bf(kk);
        if (NEEDQ) { const size_t r = row0 + (rev ? 31 - p : p); const float qv = bf2f(P5[r * NREC + h * 128 + dk]); *(LAS bf16_t*)(L + SC_QT + p * XRS + dk * 2) = (bf16_t)f2bf(qv * __expf(b)); } }
    if (part == 0) ((LAS float*)(L + SC_EB))[dk] = __expf(bend);
    return bend;
}
__device__ __forceinline__ void state_update(const Ctx& F, f32x4 (&st)[8]) {
    LAS unsigned char* L = F.lds; const int lane = F.lane, i16 = lane & 15, q = lane >> 4, w = F.wave;
    const int roff = (8 * q + (i16 >> 2)) * XRS + 8 * (i16 & 3);
    const s16x4 vlo = __builtin_amdgcn_ds_read_tr16_b64_v4i16((LAS s16x4*)(L + SC_V + roff + w * 32));
    const s16x4 vhi = __builtin_amdgcn_ds_read_tr16_b64_v4i16((LAS s16x4*)(L + SC_V + roff + w * 32 + 4 * XRS));
    const bf16x8 vf = __builtin_shufflevector(vlo, vhi, 0, 1, 2, 3, 4, 5, 6, 7);
#pragma unroll
    for (int kb = 0; kb < 8; ++kb) {
        const s16x4 klo = __builtin_amdgcn_ds_read_tr16_b64_v4i16((LAS s16x4*)(L + SC_KT + roff + kb * 32));
        const s16x4 khi = __builtin_amdgcn_ds_read_tr16_b64_v4i16((LAS s16x4*)(L + SC_KT + roff + kb * 32 + 4 * XRS));
        const bf16x8 kf = __builtin_shufflevector(klo, khi, 0, 1, 2, 3, 4, 5, 6, 7);
        st[kb] = __builtin_amdgcn_mfma_f32_16x16x32_bf16(kf, vf, st[kb], 0, 0, 0);
        const f32x4 eb = *(const LAS f32x4*)(L + SC_EB + (16 * kb + 4 * q) * 4);
        st[kb] = st[kb] * eb;
    }
}
__device__ __forceinline__ void state_load(const float* src, f32x4 (&st)[8], int w, int lane) {
#pragma unroll
    for (int kb = 0; kb < 8; ++kb)
#pragma unroll
        for (int rg = 0; rg < 4; ++rg) st[kb][rg] = src ? src[((w * 8 + kb) * 4 + rg) * 64 + lane] : 0.f;
}
__device__ __forceinline__ void state_store(float* dst, const f32x4 (&st)[8], int w, int lane) {
#pragma unroll
    for (int kb = 0; kb < 8; ++kb)
#pragma unroll
        for (int rg = 0; rg < 4; ++rg) dst[((w * 8 + kb) * 4 + rg) * 64 + lane] = st[kb][rg];
}
__device__ __forceinline__ void scan_pass1_item(const Ctx& F, const bf16_t* P5, int b, int h, int dir, int seg, float* SST, float* EG) {
    const int chain = (b * 8 + h) * 2 + dir; const size_t rowb = (size_t)b * TL + (size_t)seg * SEGL;
    f32x4 st[8]; state_load(nullptr, st, F.wave, F.lane);
    float gacc = 0.f;
    for (int c = 0; c < 8; ++c) {
        const int cc = dir ? 7 - c : c;
        gacc += chunk_prep<false>(F, P5, rowb + cc * CH, dir != 0, h, dir);
        __syncthreads();
        state_update(F, st);
        __syncthreads();
    }
    state_store(SST + ((size_t)chain * NSEG + seg) * 16384, st, F.wave, F.lane);
    if (F.tid < 128) EG[((size_t)chain * NSEG + seg) * 128 + F.tid] = __expf(gacc);
}
template <int DIR>
__device__ __forceinline__ void scan_sweep(const Ctx& F, const bf16_t* P5, size_t rowb, int h, f32x4 (&st)[8], const float* gain, bf16_t* Y, bool writey) {
    LAS unsigned char* L = F.lds; const int lane = F.lane, i16 = lane & 15, q = lane >> 4, w = F.wave;
    const int roff = (8 * q + (i16 >> 2)) * XRS + 8 * (i16 & 3);
    for (int c = 0; c < 8; ++c) {
        const int cc = DIR ? 7 - c : c; const size_t row0 = rowb + cc * CH;
        (void)chunk_prep<true>(F, P5, row0, DIR != 0, h, DIR);
#pragma unroll
        for (int kb = 0; kb < 8; ++kb)
#pragma unroll
            for (int rg = 0; rg < 4; ++rg) *(LAS bf16_t*)(L + SC_S16 + (16 * kb + 4 * q + rg) * XRS + (16 * w + i16) * 2) = (bf16_t)f2bf(st[kb][rg]);
        __syncthreads();
        if (w < 4) {
            const int ti = w >> 1, si = w & 1; f32x4 sc = (f32x4){0.f, 0.f, 0.f, 0.f};
            if (si <= ti) {
#pragma unroll
                for (int ks = 0; ks < 4; ++ks) { const bf16x8 a = *(const LAS bf16x8*)(L + SC_QT + (16 * ti + i16) * XRS + (32 * ks + 8 * q) * 2); const bf16x8 bb = *(const LAS bf16x8*)(L + SC_KT + (16 * si + i16) * XRS + (32 * ks + 8 * q) * 2);
                    sc = __builtin_amdgcn_mfma_f32_16x16x32_bf16(a, bb, sc, 0, 0, 0); }
            }
#pragma unroll
            for (int rg = 0; rg < 4; ++rg) { const int t = 16 * ti + 4 * q + rg, s = 16 * si + i16; *(LAS bf16_t*)(L + SC_SC + t * SCRS + s * 2) = (bf16_t)f2bf(s <= t ? sc[rg] : 0.f); }
        }
        __syncthreads();
        f32x4 o[2] = {(f32x4){0.f, 0.f, 0.f, 0.f}, (f32x4){0.f, 0.f, 0.f, 0.f}};
#pragma unroll
        for (int ks = 0; ks < 4; ++ks) {
            const s16x4 slo = __builtin_amdgcn_ds_read_tr16_b64_v4i16((LAS s16x4*)(L + SC_S16 + ks * 32 * XRS + roff + w * 32));
            const s16x4 shi = __builtin_amdgcn_ds_read_tr16_b64_v4i16((LAS s16x4*)(L + SC_S16 + ks * 32 * XRS + roff + w * 32 + 4 * XRS));
            const bf16x8 sf = __builtin_shufflevector(slo, shi, 0, 1, 2, 3, 4, 5, 6, 7);
#pragma unroll
            for (int ti = 0; ti < 2; ++ti) { const bf16x8 qf = *(const LAS bf16x8*)(L + SC_QT + (16 * ti + i16) * XRS + (32 * ks + 8 * q) * 2); o[ti] = __builtin_amdgcn_mfma_f32_16x16x32_bf16(sf, qf, o[ti], 0, 0, 0); }
        }
        { const s16x4 vlo = __builtin_amdgcn_ds_read_tr16_b64_v4i16((LAS s16x4*)(L + SC_V + roff + w * 32));
          const s16x4 vhi = __builtin_amdgcn_ds_read_tr16_b64_v4i16((LAS s16x4*)(L + SC_V + roff + w * 32 + 4 * XRS));
          const bf16x8 vf = __builtin_shufflevector(vlo, vhi, 0, 1, 2, 3, 4, 5, 6, 7);
#pragma unroll
          for (int ti = 0; ti < 2; ++ti) { const bf16x8 pf = *(const LAS bf16x8*)(L + SC_SC + (16 * ti + i16) * SCRS + (8 * q) * 2); o[ti] = __builtin_amdgcn_mfma_f32_16x16x32_bf16(vf, pf, o[ti], 0, 0, 0); } }
        if (DIR == 0) {
#pragma unroll
            for (int ti = 0; ti < 2; ++ti) { const int tl = cc * CH + 16 * ti + i16; u32x2 pkd; pkd.x = pk2(o[ti][0], o[ti][1]); pkd.y = pk2(o[ti][2], o[ti][3]); *(LAS u32x2*)(L + SC_OF + tl * SC_OFRS + (16 * w + 4 * q) * 2) = pkd; }
            state_update(F, st);
            __syncthreads();
        } else {
            LAS float* RED = (LAS float*)(L + SC_RED);
#pragma unroll
            for (int ti = 0; ti < 2; ++ti) { const int tl = cc * CH + 31 - (16 * ti + i16); const u32x2 f = *(const LAS u32x2*)(L + SC_OF + tl * SC_OFRS + (16 * w + 4 * q) * 2);
                o[ti][0] += bflo(f.x); o[ti][1] += bfhi(f.x); o[ti][2] += bflo(f.y); o[ti][3] += bfhi(f.y);
                float ss = (o[ti][0] * o[ti][0] + o[ti][1] * o[ti][1]) + (o[ti][2] * o[ti][2] + o[ti][3] * o[ti][3]);
                ss += __shfl_xor(ss, 16); ss += __shfl_xor(ss, 32);
                if (q == 0) RED[w * 32 + 16 * ti + i16] = ss; }
            state_update(F, st);
            __syncthreads();
            if (writey) {
                const f32x4 gv = *(const f32x4*)(gain + h * 128 + 16 * w + 4 * q);
#pragma unroll
                for (int ti = 0; ti < 2; ++ti) { const int p = 16 * ti + i16; float tot = 0.f;
#pragma unroll
                    for (int ww = 0; ww < 8; ++ww) tot += RED[ww * 32 + p];
                    const float rs = rsqrtf(tot * (1.0f / 128.0f) + EPS); const size_t r = row0 + 31 - p;
                    const u32x2 sg = *(const u32x2*)(P5 + r * NREC + 1024 + h * 128 + 16 * w + 4 * q);
                    u32x2 y; y.x = pk2(o[ti][0] * rs * gv[0] * bflo(sg.x), o[ti][1] * rs * gv[1] * bfhi(sg.x)); y.y = pk2(o[ti][2] * rs * gv[2] * bflo(sg.y), o[ti][3] * rs * gv[3] * bfhi(sg.y));
                    *(u32x2*)(Y + r * D + h * 128 + 16 * w + 4 * q) = y; }
            }
            __syncthreads();
        }
    }
}
__device__ __forceinline__ void scan_pass3_item(const Ctx& F, const bf16_t* P5, size_t rowb, int h, const float* sin_f, const float* sin_b, float* fin_f, float* fin_b, const float* gain, bf16_t* Y, bool writey) {
    f32x4 st[8];
    state_load(sin_f, st, F.wave, F.lane);
    scan_sweep<0>(F, P5, rowb, h, st, gain, Y, writey);
    if (fin_f) state_store(fin_f, st, F.wave, F.lane);
    state_load(sin_b, st, F.wave, F.lane);
    scan_sweep<1>(F, P5, rowb, h, st, gain, Y, writey);
    if (fin_b) state_store(fin_b, st, F.wave, F.lane);
}
__device__ __forceinline__ void scan_carry(const Ctx& F) {
    float* SST = (float*)(F.ws + WS_SST); const float* EG = (const float*)(F.ws + WS_EG); const float* S0 = (const float*)(F.ws + WS_S0);
    const int gt = F.bid * 512 + F.tid, NGT = F.G * 512;
    for (int idx = gt; idx < NCHAIN * 16384; idx += NGT) {
        const int chain = idx >> 14, e = idx & 16383, dir = chain & 1;
        const int lanee = e & 63, rg = (e >> 6) & 3, kb = (e >> 8) & 7; const int dk = 16 * kb + 4 * (lanee >> 4) + rg;
        float cur = S0[(size_t)chain * 16384 + e];
        float* base = SST + (size_t)chain * NSEG * 16384 + e; const float* eg = EG + (size_t)chain * NSEG * 128 + dk;
        for (int s0 = 0; s0 < NSEG; s0 += 8) {
            float tmp[8], gg[8];
#pragma unroll
            for (int i = 0; i < 8; ++i) { const int seg = dir ? NSEG - 1 - (s0 + i) : s0 + i; tmp[i] = base[(size_t)seg * 16384]; gg[i] = eg[seg * 128]; }
#pragma unroll
            for (int i = 0; i < 8; ++i) { const int seg = dir ? NSEG - 1 - (s0 + i) : s0 + i; base[(size_t)seg * 16384] = cur; cur = gg[i] * cur + tmp[i]; }
        }
    }
}

__device__ __forceinline__ void moe_slots(const Ctx& F, int nrows) {
    const int tid = F.tid; const int nitems = nrows / 16;
    const int* cnt = (const int*)(F.ws + WS_CNT); const int* tope = (const int*)(F.ws + WS_TOPE); const int* rank = (const int*)(F.ws + WS_RANK);
    int* slotrow = (int*)(F.ws + WS_SLOTROW); int* slotdst = (int*)(F.ws + WS_SLOTDST); int* tilex = (int*)(F.ws + WS_TILEX);
    LAS int* pre = (LAS int*)F.lds;
    LAS int* tsum = (LAS int*)(F.lds + 69632);
    LAS int* ebase = (LAS int*)(F.lds + 69632 + 16384);
    constexpr int IPT = (NITEM16 + 511) / 512;
    int loc[8] = {0, 0, 0, 0, 0, 0, 0, 0};
    for (int i = 0; i < IPT; ++i) { const int it = tid * IPT + i; if (it < nitems) {
#pragma unroll
        for (int e = 0; e < 8; ++e) loc[e] += cnt[it * 8 + e]; } }
#pragma unroll
    for (int e = 0; e < 8; ++e) tsum[tid * 8 + e] = loc[e];
    __syncthreads();
    if (tid < 8) { int run = 0; for (int t = 0; t < 512; ++t) { const int v = tsum[t * 8 + tid]; tsum[t * 8 + tid] = run; run += v; } ebase[8 + tid] = run; }
    __syncthreads();
    if (tid == 0) { int b = 0; for (int e = 0; e < 8; ++e) { ebase[e] = b; b += (ebase[8 + e] + 255) & ~255; } ebase[16] = b / 256; }
    { int run[8];
#pragma unroll
      for (int e = 0; e < 8; ++e) run[e] = tsum[tid * 8 + e];
      for (int i = 0; i < IPT; ++i) { const int it = tid * IPT + i; if (it < nitems) {
#pragma unroll
          for (int e = 0; e < 8; ++e) { pre[it * 8 + e] = run[e]; run[e] += cnt[it * 8 + e]; } } } }
    __syncthreads();
    for (int r = F.bid * 512 + tid; r < nrows; r += F.G * 512) {
#pragma unroll
        for (int kk = 0; kk < 2; ++kk) { const int e = tope[2 * r + kk]; const int slot = ebase[e] + pre[(r >> 4) * 8 + e] + rank[2 * r + kk]; slotrow[slot] = r; slotdst[slot] = 2 * r + kk; }
    }
    if (F.bid == 0) {
        const int ntiles = ebase[16];
        if (tid == 0) tilex[0] = ntiles;
        for (int e = 0; e < 8; ++e) { const int b0 = ebase[e], tot = ebase[8 + e], pad = (tot + 255) & ~255;
            for (int s = b0 + tot + tid; s < b0 + pad; s += 512) { slotrow[s] = 0; slotdst[s] = -1; }
            for (int t = b0 / 256 + tid; t < (b0 + pad) / 256; t += 512) tilex[16 + t] = e; }
    }
}

__global__ void __launch_bounds__(512, 2) fwd_kernel(Args args) {
    extern __shared__ __attribute__((aligned(16))) unsigned char lds_raw[];
    Ctx F;
    F.lds = (LAS unsigned char*)lds_raw; F.tid = threadIdx.x; F.lane = F.tid & 63; F.wave = __builtin_amdgcn_readfirstlane(F.tid >> 6);
    F.G = gridDim.x; F.bid = blockIdx.x; F.gw = F.bid * 8 + F.wave; F.NGW = F.G * 8;
    F.in = args.in; F.out = args.out; F.ws = args.ws;
    unsigned char* ws = args.ws;
    volatile LAS unsigned* MISC = (volatile LAS unsigned*)(F.lds + MISC_OFF);
    if (F.tid < 64) MISC[F.tid] = 0u;
    __syncthreads();
    const int lo = args.ph_lo, hi = args.ph_hi;
    XcdBarrier bar; bar.bar = (unsigned*)(ws + WS_CTL) + 4096; bar.x = 0; bar.st = nullptr;
    const bool multi = (hi - lo) > 1;
    if (multi) bar = xcd_barrier_post((unsigned*)(ws + WS_CTL) + 4096, MISC + 8);
#define IN(k) (lo <= (k) && (k) < hi)
#define SEAM(k) do { if (IN(k) && IN((k) + 1)) xcd_barrier(bar); asm volatile("" : "+v"(F.tid)); F.lane = F.tid & 63; F.wave = __builtin_amdgcn_readfirstlane(F.tid >> 6); F.gw = F.bid * 8 + F.wave; } while (0)

    float* mods = (float*)(ws + WS_MODS);
    float* XC = (float*)(ws + WS_XC);
    bf16_t* H = (bf16_t*)(ws + WS_H);
    bf16_t* YE = (bf16_t*)(ws + WS_YE);

    if (IN(PH_P0)) { p0_prologue(F); }
    SEAM(PH_P0);

    for (int lp = 0; lp < 2; ++lp) {
        const int pb = PH_PAIR0 + lp * NPL;
        const int le = 2 * lp, lo_ = 2 * lp + 1;
        const float* modE = mods + (size_t)le * 3 * 6144; const float* modO = mods + (size_t)lo_ * 3 * 6144;
        const float* xsl = lp == 0 ? F.in[I_X] : F.out; const float* xsc = lp == 0 ? F.in[I_CTX] : XC;
        if (IN(pb + E1_NORM)) {
            RowPass P{}; P.sl = xsl; P.sc = xsc; P.dl = F.out; P.dc = XC; P.gain = F.in[I_NMIX] + le * D; P.shift = modE + 0 * D; P.scale = modE + 1 * D; P.H = H; P.nrows = MT;
            if (lp == 0) row_pass<false, false, false>(F, P);
            else { P.YE = YE; P.topp = (const float*)(ws + WS_TOPP); P.gatef = mods + (size_t)(le - 1) * 3 * 6144 + 5 * D; row_pass<true, false, false>(F, P); }
        }
        SEAM(pb + E1_NORM);
        if (IN(pb + E2_GIN)) {
            pg8::Gemm g{H, (const bf16_t*)(ws + WS_WINE) + (size_t)lp * NEIN * D, MT, NEIN, D, nullptr, nullptr, 0}; pg8::StaticOrder S; S.init(MT, NEIN, F.G, F.bid);
            pg8::EpiEvenIn E{(bf16_t*)(ws + WS_PZUV)};
            pg8::gemm_phase<pg8::EpiEvenIn, pg8::StaticOrder, true, false>(F.lds, g, S, E, F.tid);
        }
        SEAM(pb + E2_GIN);
        if (IN(pb + E3_FFTA)) fft_stage_a(F);
        SEAM(pb + E3_FFTA);
        if (IN(pb + E3_FFTC)) fft_stage_c_gmlp(F, lp);
        SEAM(pb + E3_FFTC);
        if (IN(pb + E4_GOUT)) {
            pg8::Gemm g{H, (const bf16_t*)(ws + WS_WOUTE) + (size_t)lp * D * D, MT, D, D, nullptr, nullptr, 0}; pg8::StaticOrder S; S.init(MT, D, F.G, F.bid);
            pg8::EpiRes E{lp == 0 ? xsl : (const float*)F.out, lp == 0 ? xsc : (const float*)XC, F.out, XC, modE + 2 * D};
            pg8::gemm_phase<pg8::EpiRes, pg8::StaticOrder, false, false>(F.lds, g, S, E, F.tid);
        }
        SEAM(pb + E4_GOUT);
        if (IN(pb + E5_NORM)) {
            RowPass P{}; P.sl = F.out; P.sc = XC; P.gain = F.in[I_NFFN] + le * D; P.shift = modE + 3 * D; P.scale = modE + 4 * D; P.H = H; P.nrows = MT;
            row_pass<false, false, false>(F, P);
        }
        SEAM(pb + E5_NORM);
        if (IN(pb + E6_UP)) {
            pg8::Gemm g{H, (const bf16_t*)(ws + WS_W13) + (size_t)lp * NFF2 * D, MT, NFF2, D, nullptr, nullptr, 0}; pg8::StaticOrder S; S.init(MT, NFF2, F.G, F.bid);
            pg8::EpiSwiglu E{(bf16_t*)(ws + WS_HID), DFF};
            pg8::gemm_phase<pg8::EpiSwiglu, pg8::StaticOrder, true, false>(F.lds, g, S, E, F.tid);
        }
        SEAM(pb + E6_UP);
        if (IN(pb + E7_DOWN)) {
            pg8::Gemm g{(const bf16_t*)(ws + WS_HID), (const bf16_t*)(ws + WS_W2) + (size_t)lp * D * DFF, MT, D, DFF, nullptr, nullptr, 0}; pg8::StaticOrder S; S.init(MT, D, F.G, F.bid);
            pg8::EpiRes E{F.out, XC, F.out, XC, modE + 5 * D};
            pg8::gemm_phase<pg8::EpiRes, pg8::StaticOrder, false, false>(F.lds, g, S, E, F.tid);
        }
        SEAM(pb + E7_DOWN);
        const bool lastl = lp == 1;
        if (IN(pb + O1_NORM)) {
            RowPass P{}; P.sl = F.out; P.sc = XC; P.gain = F.in[I_NMIX] + lo_ * D; P.shift = modO + 0 * D; P.scale = modO + 1 * D; P.H = H; P.nrows = MT;
            row_pass<false, false, false>(F, P);
        }
        SEAM(pb + O1_NORM);
        if (IN(pb + O2_GIN)) {
            pg8::Gemm g{H, (const bf16_t*)(ws + WS_WINO) + (size_t)lp * NREC * D, MT, NREC, D, nullptr, nullptr, 0}; pg8::StaticOrder S; S.init(MT, NREC, F.G, F.bid);
            pg8::EpiOddIn E{(bf16_t*)(ws + WS_P5), (const float*)(ws + WS_LB) + lp * 2048};
            pg8::gemm_phase<pg8::EpiOddIn, pg8::StaticOrder, true, false>(F.lds, g, S, E, F.tid);
        }
        SEAM(pb + O2_GIN);
        if (IN(pb + O3_SCAN1)) {
            const bf16_t* P5 = (const bf16_t*)(ws + WS_P5); float* SST = (float*)(ws + WS_SST); float* EG = (float*)(ws + WS_EG); float* S0 = (float*)(ws + WS_S0);
            const float* gain = F.in[I_RNORM] + lp * D;
            for (int it = F.bid; it < 16 + 2048; it += F.G) {
                if (it < 16) { const int b = it >> 3, h = it & 7;
                    scan_pass3_item(F, P5, (size_t)ML + b * TCX, h, nullptr, nullptr, S0 + (size_t)((b * 8 + h) * 2 + 0) * 16384, S0 + (size_t)((b * 8 + h) * 2 + 1) * 16384, gain, H, !lastl);
                } else { const int i2 = it - 16, seg = i2 & 63, dir = (i2 >> 6) & 1, h = (i2 >> 7) & 7, b = i2 >> 10;
                    scan_pass1_item(F, P5, b, h, dir, seg, SST, EG); }
            }
        }
        SEAM(pb + O3_SCAN1);
        if (IN(pb + O4_CARRY)) { scan_carry(F); moe_convert(F, lp); }
        SEAM(pb + O4_CARRY);
        if (IN(pb + O5_SCAN3)) {
            const bf16_t* P5 = (const bf16_t*)(ws + WS_P5); const float* SST = (const float*)(ws + WS_SST);
            const float* gain = F.in[I_RNORM] + lp * D;
            for (int it = F.bid; it < 1024; it += F.G) { const int seg = it & 63, h = (it >> 6) & 7, b = it >> 9; const int ch0 = (b * 8 + h) * 2;
                scan_pass3_item(F, P5, (size_t)b * TL + (size_t)seg * SEGL, h, SST + ((size_t)ch0 * NSEG + seg) * 16384, SST + ((size_t)(ch0 + 1) * NSEG + seg) * 16384, nullptr, nullptr, gain, H, true); }
        }
        SEAM(pb + O5_SCAN3);
        if (IN(pb + O6_GOUT)) {
            pg8::Gemm g{H, (const bf16_t*)(ws + WS_WOUTO) + (size_t)lp * D * D, MT, D, D, nullptr, nullptr, 0}; pg8::StaticOrder S; S.init(MT, D, F.G, F.bid);
            pg8::EpiRes E{F.out, XC, F.out, XC, modO + 2 * D};
            pg8::gemm_phase<pg8::EpiRes, pg8::StaticOrder, false, false>(F.lds, g, S, E, F.tid);
        }
        SEAM(pb + O6_GOUT);
        const int nrm = lastl ? ML : MT;
        if (IN(pb + O7_NORM)) {
            RowPass P{}; P.sl = F.out; P.sc = XC; P.gain = F.in[I_NFFN] + lo_ * D; P.shift = modO + 3 * D; P.scale = modO + 4 * D; P.H = H; P.nrows = nrm;
            P.rw = F.in[I_RW] + (size_t)lp * D * NE; P.tope = (int*)(ws + WS_TOPE); P.toppo = (float*)(ws + WS_TOPP); P.rank = (int*)(ws + WS_RANK); P.cnt = (int*)(ws + WS_CNT);
            row_pass<false, true, false>(F, P);
        }
        SEAM(pb + O7_NORM);
        if (IN(pb + O8_SLOTS)) moe_slots(F, nrm);
        SEAM(pb + O8_SLOTS);
        if (IN(pb + O9_MUP)) {
            const int* tilex = (const int*)(ws + WS_TILEX); const int ntiles = tilex[0];
            pg8::Gemm g{H, (const bf16_t*)(ws + WS_W13M), ntiles * 256, NEX2, D, (const int*)(ws + WS_SLOTROW), tilex + 16, (size_t)NEX2 * D}; pg8::StaticOrder S; S.init(ntiles * 256, NEX2, F.G, F.bid);
            pg8::EpiSwiglu E{(bf16_t*)(ws + WS_HIDM), DEX};
            pg8::gemm_phase<pg8::EpiSwiglu, pg8::StaticOrder, true, true>(F.lds, g, S, E, F.tid);
        }
        SEAM(pb + O9_MUP);
        if (IN(pb + O10_MDOWN)) {
            const int* tilex = (const int*)(ws + WS_TILEX); const int ntiles = tilex[0];
            pg8::Gemm g{(const bf16_t*)(ws + WS_HIDM), (const bf16_t*)(ws + WS_W2M), ntiles * 256, D, DEX, nullptr, tilex + 16, (size_t)D * DEX}; pg8::StaticOrder S; S.init(ntiles * 256, D, F.G, F.bid);
            pg8::EpiMoeDown E{YE, (const int*)(ws + WS_SLOTDST)};
            pg8::gemm_phase<pg8::EpiMoeDown, pg8::StaticOrder, true, false>(F.lds, g, S, E, F.tid);
        }
        SEAM(pb + O10_MDOWN);
    }
    if (IN(PH_FINAL)) {
        RowPass P{}; P.sl = F.out; P.sc = XC; P.dl = F.out; P.dc = XC; P.gain = F.in[I_NOUT]; P.nrows = ML; P.YE = YE; P.topp = (const float*)(ws + WS_TOPP); P.gatef = mods + (size_t)3 * 3 * 6144 + 5 * D; P.fout = F.out;
        row_pass<true, false, true>(F, P);
    }
#undef IN
#undef SEAM
}

extern "C" void kernel_launch(void* const* d_in, const int* in_sizes, int n_in, void* d_out, int out_size, void* d_ws, size_t ws_size, hipStream_t stream) {
    static int grid = 0;
    if (grid == 0) {
        if (n_in != 24 || out_size != ML * D || ws_size < WS_END) { fprintf(stderr, "kernel_launch: unexpected problem (n_in %d, out %d, ws %zu < %zu)\n", n_in, out_size, ws_size, (size_t)WS_END); grid = -1; return; }
        int dev = 0, cus = 0, per_cu = 0;
        if (hipGetDevice(&dev) != hipSuccess || hipDeviceGetAttribute(&cus, hipDeviceAttributeMultiprocessorCount, dev) != hipSuccess) { grid = -1; return; }
        if (hipFuncSetAttribute((const void*)fwd_kernel, hipFuncAttributeMaxDynamicSharedMemorySize, LDS_BYTES) != hipSuccess) { fprintf(stderr, "kernel_launch: hipFuncSetAttribute failed\n"); grid = -1; return; }
        if (hipOccupancyMaxActiveBlocksPerMultiprocessor(&per_cu, (const void*)fwd_kernel, 512, LDS_BYTES) != hipSuccess || per_cu < 1) fprintf(stderr, "kernel_launch: occupancy query says %d\n", per_cu);
        (void)hipGetLastError();
        grid = cus;
    }
    if (grid < 0) return;
    (void)hipMemsetAsync((char*)d_ws + WS_CTL, 0, CTL_BYTES, stream);
    Args a{};
    for (int i = 0; i < 24; ++i) a.in[i] = (const float*)d_in[i];
    a.out = (float*)d_out; a.ws = (unsigned char*)d_ws;
#if PER_PHASE_LAUNCH
    for (int p = 0; p < NPHASE && p < PHASE_LIMIT; ++p) { a.ph_lo = p; a.ph_hi = p + 1; hipLaunchKernelGGL(fwd_kernel, dim3(grid), dim3(512), LDS_BYTES, stream, a); }
#else
    a.ph_lo = 0; a.ph_hi = NPHASE; hipLaunchKernelGGL(fwd_kernel, dim3(grid), dim3(512), LDS_BYTES, stream, a);
#endif
}
```

```cpp
#include <hip/hip_runtime.h>
#include <cstdio>
#include <cstdint>

#ifndef PER_PHASE_LAUNCH
#define PER_PHASE_LAUNCH 0
#endif
#ifndef REP_MASK
#define REP_MASK 0
#endif
#define NREP(x) (((REP_MASK >> (x)) & 1) ? 2 : 1)
#ifndef PHASE_LIMIT
#define PHASE_LIMIT 100
#endif
#ifndef P0_MASK
#define P0_MASK 63
#endif
#ifndef P0_T
#define P0_T 127
#endif

#define LAS __attribute__((address_space(3)))
typedef unsigned short bf16_t;
typedef short bf16x8 __attribute__((ext_vector_type(8)));
typedef short s16x4 __attribute__((ext_vector_type(4)));
typedef float f32x4 __attribute__((ext_vector_type(4)));
typedef float f32x2 __attribute__((ext_vector_type(2)));
typedef unsigned u32x4 __attribute__((ext_vector_type(4)));
typedef unsigned u32x2 __attribute__((ext_vector_type(2)));

constexpr int D = 1024, TL = 16384, ML = 32768, TCX = 256, MC = 512, MT = 33280;
constexpr int NEIN = 2048, DFF = 2816, NFF2 = 5632, NREC = 5120, DEX = 3584, NEX2 = 7168, NE = 8;
constexpr int NSEG = 64, SEGL = 256, CH = 32, NCHAIN = 32;
constexpr int MAXTILES = 268, NITEM16 = MT / 16;
constexpr float EPS = 1e-6f;

constexpr size_t MiB = 1u << 20, KiB = 1u << 10;
constexpr size_t WS_CTL = 0, CTL_BYTES = 1 * MiB;
constexpr size_t WS_MODS = 1 * MiB, WS_LB = 1 * MiB + 512 * KiB;
constexpr size_t WS_FA = 2 * MiB, WS_FC = 2 * MiB + 128 * KiB, WS_FX = 2 * MiB + 256 * KiB, WS_GW = 2 * MiB + 512 * KiB;
constexpr size_t WS_XC = 3 * MiB;
constexpr size_t WS_TOPE = 5 * MiB, WS_TOPP = 5 * MiB + 512 * KiB, WS_RANK = 6 * MiB, WS_CNT = 6 * MiB + 512 * KiB, WS_TILEX = 6 * MiB + 768 * KiB, WS_SLOTROW = 7 * MiB, WS_SLOTDST = 7 * MiB + 512 * KiB;
constexpr size_t WS_WINE = 8 * MiB, WS_WOUTE = 16 * MiB, WS_WINO = 20 * MiB, WS_WOUTO = 40 * MiB, WS_W13 = 44 * MiB, WS_W2 = 66 * MiB;
constexpr size_t WS_W13M = 80 * MiB, WS_W2M = 192 * MiB;
constexpr size_t WS_H = 248 * MiB, WS_YE = 314 * MiB, WS_BIG = 444 * MiB;
constexpr size_t WS_PZUV = WS_BIG, WS_UP = WS_BIG + 130 * MiB, WS_HID = WS_BIG, WS_P5 = WS_BIG, WS_SST = WS_BIG + 325 * MiB, WS_EG = WS_BIG + 453 * MiB, WS_S0 = WS_BIG + 454 * MiB, WS_HIDM = WS_BIG;
constexpr size_t WS_END = WS_BIG + 469 * MiB;
static_assert(WS_W2 + (size_t)2 * D * DFF * 2 <= WS_W13M, "static weights");
static_assert(WS_W2M + (size_t)NE * D * DEX * 2 <= WS_H && WS_H + (size_t)MT * D * 2 <= WS_YE && WS_YE + (size_t)MT * 2 * D * 2 <= WS_BIG, "ws map");
static_assert((size_t)MAXTILES * 256 * DEX * 2 <= 469 * MiB && (size_t)MT * NREC * 2 <= 325 * MiB && (size_t)MT * NEIN * 2 <= 130 * MiB, "big region");

constexpr int LDS_BYTES = 147456, MISC_OFF = 147456 - 256;
constexpr int XRS = 288;

__device__ __forceinline__ unsigned f2bf(float f) { unsigned u = __builtin_bit_cast(unsigned, f); return (u + 0x7fffu + ((u >> 16) & 1u)) >> 16; }
__device__ __forceinline__ unsigned pk2(float lo, float hi) { return f2bf(lo) | (f2bf(hi) << 16); }
__device__ __forceinline__ float bf2f(unsigned short b) { return __builtin_bit_cast(float, (unsigned)b << 16); }
__device__ __forceinline__ float bflo(unsigned w) { return __builtin_bit_cast(float, w << 16); }
__device__ __forceinline__ float bfhi(unsigned w) { return __builtin_bit_cast(float, w & 0xffff0000u); }
__device__ __forceinline__ float wave_sum(float v) {
#pragma unroll
    for (int o = 1; o < 64; o <<= 1) v += __shfl_xor(v, o);
    return v;
}
__device__ __forceinline__ float siluf(float a) { return a * __builtin_amdgcn_rcpf(1.0f + __expf(-a)); }
#define LDS_WAIT() asm volatile("s_waitcnt lgkmcnt(0)" ::: "memory")
#define VM_WAIT() asm volatile("s_waitcnt vmcnt(0)" ::: "memory")

#define XB_TMO      128
#define XB_XCNT(j)  (256  + 64 * (j))
#define XB_XSUB(j)  (1280 + 64 * (j))
#define XB_XGEN(j)  (2304 + 64 * (j))
#define XB_TOP      3328
#define XB_TOPGEN   3392
#define XCD_BAR_WORDS 3456
#define XB_SPIN_CAP (1u << 18)
__device__ __forceinline__ unsigned xb_ld(unsigned* p)              { return __hip_atomic_load(p, __ATOMIC_RELAXED, __HIP_MEMORY_SCOPE_AGENT); }
__device__ __forceinline__ unsigned xb_add(unsigned* p, unsigned v) { return __hip_atomic_fetch_add(p, v, __ATOMIC_RELAXED, __HIP_MEMORY_SCOPE_AGENT); }
__device__ __forceinline__ unsigned xb_xcc_id() { return (unsigned)__builtin_amdgcn_s_getreg((3 << 11) | 20) & 0xFu; }
#define XB_SPIN(cond, bar) do { unsigned _sp = 0; while (cond) { __builtin_amdgcn_s_sleep(1); \
    if ((++_sp & 255u) == 0u) { if (xb_ld(&(bar)[XB_TMO])) break; if (_sp > XB_SPIN_CAP) { atomicAdd(&(bar)[XB_TMO], 1u); break; } } } } while (0)
struct XcdBarrier { unsigned* bar; unsigned x; volatile LAS unsigned* st; };
__device__ __forceinline__ XcdBarrier xcd_barrier_post(unsigned* bar, volatile LAS unsigned* st) {
    XcdBarrier b; b.bar = bar; b.x = xb_xcc_id(); b.st = st;
    if (threadIdx.x == 0) (void)xb_add(&bar[XB_XCNT(b.x)], 1u);
    return b;
}
__device__ __forceinline__ void xcd_barrier_complete(unsigned* bar, unsigned x, unsigned& nloc, unsigned& nx) {
    const unsigned G = gridDim.x * gridDim.y * gridDim.z;
    unsigned sum, cnt, mine, sp = 0u;
    for (;;) {
        sum = 0u; cnt = 0u; mine = 0u;
#pragma unroll
        for (unsigned j = 0; j < 16; ++j) { const unsigned c = xb_ld(&bar[XB_XCNT(j)]); sum += c; cnt += (c > 0u) ? 1u : 0u; mine = (j == x) ? c : mine; }
        if (sum == G) break;
        __builtin_amdgcn_s_sleep(1);
        if ((++sp & 255u) == 0u) { if (xb_ld(&bar[XB_TMO])) break; if (sp > XB_SPIN_CAP) { atomicAdd(&bar[XB_TMO], 1u); break; } }
    }
    nloc = mine > 0u ? mine : 1u; nx = cnt > 0u ? cnt : 1u;
}
__device__ __forceinline__ void xcd_barrier(const XcdBarrier& b) {
    asm volatile("s_waitcnt vmcnt(0)" ::: "memory");
    __syncthreads();
    if (threadIdx.x == 0) {
        unsigned* bar = b.bar;
        __builtin_amdgcn_s_waitcnt(0);
        unsigned nloc = b.st[0], nx = b.st[1];
        if (nloc == 0u) { xcd_barrier_complete(bar, b.x, nloc, nx); b.st[0] = nloc; b.st[1] = nx; }
        const unsigned old = xb_add(&bar[XB_XSUB(b.x)], 1u);
        const unsigned gen = old / nloc;
        if (old + 1u == (gen + 1u) * nloc) {
            __builtin_amdgcn_fence(__ATOMIC_RELEASE, "agent");
            asm volatile("s_waitcnt vmcnt(0)" ::: "memory");
            const unsigned og = xb_add(&bar[XB_TOP], 1u);
            const unsigned tg = og / nx;
            if (og + 1u == (tg + 1u) * nx) xb_add(&bar[XB_TOPGEN], 1u);
            else XB_SPIN(xb_ld(&bar[XB_TOPGEN]) == tg, bar);
            __builtin_amdgcn_fence(__ATOMIC_ACQUIRE, "agent");
            xb_add(&bar[XB_XGEN(b.x)], 1u);
            asm volatile("s_waitcnt vmcnt(0)" ::: "memory");
        } else {
            XB_SPIN(xb_ld(&bar[XB_XGEN(b.x)]) == gen, bar);
            __builtin_amdgcn_fence(__ATOMIC_ACQUIRE, "agent");
            asm volatile("s_waitcnt vmcnt(0)" ::: "memory");
        }
    }
    __syncthreads();
}

namespace pg8 {
constexpr int BM = 256, BK = 64, HALF = 128, HTB = HALF * BK * 2, STAGE_BYTES = 8 * HTB, NXCD = 8, WGM = 8;
__host__ __device__ __forceinline__ int lds_byte(int r, int c) { const int st = (r >> 4) * 2 + (c >> 5), rr = r & 15, cc = c & 31, ob = rr * 64 + cc * 2; return st * 1024 + (ob ^ (((ob >> 9) & 1) << 5)); }
__host__ __device__ __forceinline__ void stage_rc(int b, int& R, int& C) { const int st = b / 1024, sb = b % 1024, swz = sb ^ (((sb >> 9) & 1) << 5); R = (st >> 1) * 16 + swz / 64; C = (st & 1) * 32 + (swz % 64) / 2; }
__host__ __device__ __forceinline__ int perm32(int rho) { const int n = rho >> 4, i = rho & 15; return 8 * (i >> 2) + 4 * n + (i & 3); }
struct Unit { int pm, pn; };
struct Gemm { const bf16_t* A; const bf16_t* Bt; int M, N, K; const int* arow; const int* grp; size_t gstride; };
struct StaticOrder {
    int nM, nN, nwg, G, c;
    __host__ __device__ void init(int M, int N, int G_, int c_) { nM = M / BM; nN = N / BM; nwg = nM * nN; G = G_; c = c_; }
    __host__ __device__ bool next(int i, Unit& u) const {
        const long L = (long)i * G + c; if (L >= nwg) return false;
        int wgid = (int)L; { const int q = nwg / NXCD, r = nwg % NXCD, xcd = wgid % NXCD, off = wgid / NXCD; wgid = (xcd < r ? xcd * (q + 1) : r * (q + 1) + (xcd - r) * q) + off; }
        const int nig = WGM * nN, gid = wgid / nig, fm = gid * WGM, gsz = (nM - fm) < WGM ? (nM - fm) : WGM;
        u.pm = fm + ((wgid % nig) % gsz); u.pn = (wgid % nig) / gsz; return true;
    }
};
__device__ __forceinline__ unsigned cvt_pk_bf16(float lo, float hi) { unsigned r; asm volatile("v_cvt_pk_bf16_f32 %0, %1, %2" : "=v"(r) : "v"(lo), "v"(hi)); return r; }
__device__ __forceinline__ f32x2 gelu_pk(f32x2 v) {
    const f32x2 av = __builtin_elementwise_abs(v), d = av * 0.2316418882f + 1.0f;
    f32x2 t; t.x = __builtin_amdgcn_rcpf(d.x); t.y = __builtin_amdgcn_rcpf(d.y);
    f32x2 q = t * 0.5307027145f + (-0.7265760135f); q = q * t + 0.7107068705f; q = q * t + (-0.142248368f); q = q * t + 0.127414796f; q = q * t;
    const f32x2 s = (v * v) * (-0.72134752044f);
    f32x2 e; e.x = __builtin_amdgcn_exp2f(s.x); e.y = __builtin_amdgcn_exp2f(s.y);
    const f32x2 m = v * (q * e), r = v - m;
    f32x2 o; o.x = v.x < 0.f ? m.x : r.x; o.y = v.y < 0.f ? m.y : r.y; return o;
}
template <class Epi, class Sched, bool ALIGN_EPI, bool GATHER>
__device__ __forceinline__ void gemm_phase(LAS unsigned char* lds, const Gemm g, const Sched& S, const Epi& E, const int tid) {
    const int wid = __builtin_amdgcn_readfirstlane(tid >> 6), lane = tid & 63, wr = wid >> 2, wc = wid & 3, fr = lane & 15, fq = lane >> 4;
    const int K = g.K, nt = K / BK;
    unsigned voffA[2], voffB[2];
    unsigned voffA1[2];
#pragma unroll
    for (int i = 0; i < 2; ++i) { int R, C; stage_rc(tid * 16 + i * 8192, R, C); const int Rb = Epi::PERM ? ((R & ~31) + perm32(R & 31)) : R;
        voffA[i] = (unsigned)(R * K + C) * 2u; voffA1[i] = voffA[i]; voffB[i] = (unsigned)(Rb * K + C) * 2u; }
    const size_t kstep = (size_t)(BK * 2);
    const size_t hstep = (size_t)HALF * K * 2;
    const size_t tstep = 2 * hstep;
    const unsigned ldsw = (unsigned)wid * 1024u;
    const int aoff = lds_byte(wr * 64 + fr, fq * 8), boff = lds_byte(wc * 32 + fr, fq * 8);
#define PG8_SA(b, h) (((b) * 2 + (h)) * HTB)
#define PG8_SB(b, h) ((4 + (b) * 2 + (h)) * HTB)
#define PG8_STAGE(bufoff, gbase, voff) do { _Pragma("unroll") for (int _i = 0; _i < 2; ++_i) \
        __builtin_amdgcn_global_load_lds((const unsigned*)((const char*)(gbase) + (voff)[_i]), (LAS unsigned*)(lds + (bufoff) + ldsw + _i * 8192), 16, 0, 0); } while (0)
#define PG8_LDA(dst, b, h) do { _Pragma("unroll") for (int m = 0; m < 4; ++m) _Pragma("unroll") for (int k = 0; k < 2; ++k) dst[m][k] = *(const LAS bf16x8*)(lds + PG8_SA(b, h) + aoff + m * 2048 + k * 1024); } while (0)
#define PG8_LDB(dst, b, h) do { _Pragma("unroll") for (int n = 0; n < 2; ++n) _Pragma("unroll") for (int k = 0; k < 2; ++k) dst[n][k] = *(const LAS bf16x8*)(lds + PG8_SB(b, h) + boff + n * 2048 + k * 1024); } while (0)
#define PG8_MMA(ai, bj, At, Bt) do { __builtin_amdgcn_s_setprio(1); _Pragma("unroll") for (int m = 0; m < 4; ++m) _Pragma("unroll") for (int n = 0; n < 2; ++n) _Pragma("unroll") for (int k = 0; k < 2; ++k) \
        acc[ai][bj][m][n] = __builtin_amdgcn_mfma_f32_16x16x32_bf16(Bt[n][k], At[m][k], acc[ai][bj][m][n], 0, 0, 0); __builtin_amdgcn_s_setprio(0); } while (0)
#define PG8_WAIT_V(n) asm volatile("s_waitcnt vmcnt(" #n ")" ::: "memory")
#define PG8_WAIT_L(n) asm volatile("s_waitcnt lgkmcnt(" #n ")" ::: "memory")
#define PG8_BAR __builtin_amdgcn_s_barrier()
#define PG8_SCHED __builtin_amdgcn_sched_barrier(0)
#define PG8_GOFF(u, v0, v1) do { _Pragma("unroll") for (int _i = 0; _i < 2; ++_i) { int R_, C_; stage_rc(tid * 16 + _i * 8192, R_, C_); \
        const int r0_ = g.arow[(u).pm * BM + R_], r1_ = g.arow[(u).pm * BM + HALF + R_]; v0[_i] = (unsigned)(r0_ * K + C_) * 2u; v1[_i] = (unsigned)(r1_ * K + C_) * 2u; } } while (0)
#define PG8_BBASE(u) ((const char*)g.Bt + (g.grp ? (size_t)g.grp[(u).pm] * g.gstride * 2 : (size_t)0) + (size_t)(u).pn * tstep)
    Unit cur, nxt; int ui = 0;
    if (!S.next(0, cur)) return;
    f32x4 acc[2][2][4][2];
#pragma unroll
    for (int a = 0; a < 2; ++a)
#pragma unroll
        for (int b = 0; b < 2; ++b)
#pragma unroll
            for (int m = 0; m < 4; ++m)
#pragma unroll
                for (int n = 0; n < 2; ++n) acc[a][b][m][n] = (f32x4){0.f, 0.f, 0.f, 0.f};
    bf16x8 At[4][2], B0[2][2], B1[2][2];
    const char* cA = GATHER ? (const char*)g.A : (const char*)g.A + (size_t)cur.pm * tstep;
    const size_t ah = GATHER ? (size_t)0 : hstep;
    if constexpr (GATHER) PG8_GOFF(cur, voffA, voffA1);
    const char* cB = PG8_BBASE(cur);
    PG8_STAGE(PG8_SB(0, 0), cB, voffB); PG8_STAGE(PG8_SA(0, 0), cA, voffA); PG8_STAGE(PG8_SB(0, 1), cB + hstep, voffB); PG8_STAGE(PG8_SA(0, 1), cA + ah, voffA1);
    if (wr == 1) PG8_BAR;
    PG8_WAIT_V(4); PG8_BAR;
    PG8_STAGE(PG8_SB(1, 0), cB + kstep, voffB); PG8_STAGE(PG8_SA(1, 0), cA + kstep, voffA); PG8_STAGE(PG8_SB(1, 1), cB + hstep + kstep, voffB);
    PG8_WAIT_V(6); PG8_BAR;
    for (;;) {
        const bool has_next = S.next(ui + 1, nxt);
        const char* nA = (GATHER || !has_next) ? cA : (const char*)g.A + (size_t)nxt.pm * tstep; const char* nB = has_next ? PG8_BBASE(nxt) : cB;
        for (int t = 0; t < nt; t += 2) {
            const bool last = (t == nt - 2);
            const char* a1 = cA + (size_t)(t + 1) * kstep;
            const char* a2 = last ? nA : cA + (size_t)(t + 2) * kstep; const char* b2 = last ? nB : cB + (size_t)(t + 2) * kstep;
            const char* a3 = a2 + kstep; const char* b3 = b2 + kstep;
            PG8_LDB(B0, 0, 0); PG8_SCHED; PG8_LDA(At, 0, 0); PG8_STAGE(PG8_SA(1, 1), a1 + ah, voffA1);
            if constexpr (GATHER) { if (last && has_next) PG8_GOFF(nxt, voffA, voffA1); }
            PG8_WAIT_L(8); PG8_BAR; PG8_WAIT_L(0); PG8_MMA(0, 0, At, B0); PG8_BAR; PG8_SCHED;
            PG8_LDB(B1, 0, 1); PG8_STAGE(PG8_SB(0, 0), b2, voffB);
            PG8_BAR; PG8_WAIT_L(0); PG8_MMA(0, 1, At, B1); PG8_BAR;
            PG8_LDA(At, 0, 1); PG8_STAGE(PG8_SA(0, 0), a2, voffA);
            PG8_BAR; PG8_WAIT_L(0); PG8_MMA(1, 0, At, B0); PG8_BAR; PG8_SCHED;
            PG8_STAGE(PG8_SB(0, 1), b2 + hstep, voffB);
            PG8_WAIT_V(6); PG8_BAR; PG8_MMA(1, 1, At, B1); PG8_BAR;
            PG8_LDB(B0, 1, 0); PG8_SCHED; PG8_LDA(At, 1, 0); PG8_STAGE(PG8_SA(0, 1), a2 + ah, voffA1);
            PG8_WAIT_L(8); PG8_BAR; PG8_WAIT_L(0); PG8_MMA(0, 0, At, B0); PG8_BAR; PG8_SCHED;
            PG8_LDB(B1, 1, 1); PG8_STAGE(PG8_SB(1, 0), b3, voffB);
            PG8_BAR; PG8_WAIT_L(0); PG8_MMA(0, 1, At, B1); PG8_BAR;
            PG8_LDA(At, 1, 1); PG8_STAGE(PG8_SA(1, 0), a3, voffA);
            PG8_BAR; PG8_WAIT_L(0); PG8_MMA(1, 0, At, B0); PG8_BAR; PG8_SCHED;
            PG8_STAGE(PG8_SB(1, 1), b3 + hstep, voffB);
            PG8_WAIT_V(6); PG8_BAR; PG8_MMA(1, 1, At, B1); PG8_BAR;
        }
        if constexpr (ALIGN_EPI) { if (wr == 0) PG8_BAR; }
        E(acc, cur, wr, wc, fr, fq);
        if (!has_next) break;
#pragma unroll
        for (int a = 0; a < 2; ++a)
#pragma unroll
            for (int b = 0; b < 2; ++b)
#pragma unroll
                for (int m = 0; m < 4; ++m)
#pragma unroll
                    for (int n = 0; n < 2; ++n) acc[a][b][m][n] = (f32x4){0.f, 0.f, 0.f, 0.f};
        cur = nxt; cA = nA; cB = nB; ++ui;
        if constexpr (ALIGN_EPI) { if (wr == 1) PG8_BAR; }
    }
    PG8_WAIT_V(0);
    if constexpr (!ALIGN_EPI) { if (wr == 0) PG8_BAR; }
    PG8_BAR;
#undef PG8_SA
#undef PG8_SB
#undef PG8_STAGE
#undef PG8_LDA
#undef PG8_LDB
#undef PG8_MMA
#undef PG8_WAIT_V
#undef PG8_WAIT_L
#undef PG8_BAR
#undef PG8_SCHED
#undef PG8_GOFF
#undef PG8_BBASE
}

struct EpiEvenIn {
    static constexpr bool PERM = true;
    bf16_t* O;
    __device__ __forceinline__ void operator()(const f32x4 (&acc)[2][2][4][2], const Unit& u, int wr, int wc, int fr, int fq) const {
        const int row0 = u.pm * BM + wr * 64 + fr, col0 = u.pn * BM + wc * 32 + 8 * fq; const bool act = u.pn >= 4;
#pragma unroll
        for (int ai = 0; ai < 2; ++ai)
#pragma unroll
            for (int m = 0; m < 4; ++m) { bf16_t* rowp = O + (size_t)(row0 + ai * HALF + m * 16) * NEIN + col0;
#pragma unroll
                for (int bj = 0; bj < 2; ++bj) { f32x4 v0 = acc[ai][bj][m][0], v1 = acc[ai][bj][m][1];
                    if (act) { f32x2 a = gelu_pk((f32x2){v0[0], v0[1]}), b = gelu_pk((f32x2){v0[2], v0[3]}), c = gelu_pk((f32x2){v1[0], v1[1]}), d = gelu_pk((f32x2){v1[2], v1[3]});
                        v0 = (f32x4){a.x, a.y, b.x, b.y}; v1 = (f32x4){c.x, c.y, d.x, d.y}; }
                    u32x4 w; w.x = cvt_pk_bf16(v0[0], v0[1]); w.y = cvt_pk_bf16(v0[2], v0[3]); w.z = cvt_pk_bf16(v1[0], v1[1]); w.w = cvt_pk_bf16(v1[2], v1[3]);
                    *(u32x4*)(rowp + bj * HALF) = w; } }
    }
};
struct EpiRes {
    static constexpr bool PERM = false;
    const float* sl; const float* sc; float* dl; float* dc; const float* gate;
    __device__ __forceinline__ void operator()(const f32x4 (&acc)[2][2][4][2], const Unit& u, int wr, int wc, int fr, int fq) const {
        const int col0 = u.pn * BM + wc * 32 + 4 * fq;
        const bool isc = u.pm >= 128; const int ms = isc ? 2 : (u.pm >= 64 ? 1 : 0);
        const size_t rbase = isc ? (size_t)(u.pm - 128) * BM : (size_t)u.pm * BM;
        const float* src = (isc ? sc : sl) + rbase * D; float* dst = (isc ? dc : dl) + rbase * D;
        f32x4 gv[2][2];
#pragma unroll
        for (int bj = 0; bj < 2; ++bj)
#pragma unroll
            for (int n = 0; n < 2; ++n) gv[bj][n] = *(const f32x4*)(gate + ms * 6144 + col0 + bj * HALF + n * 16);
#pragma unroll
        for (int ai = 0; ai < 2; ++ai)
#pragma unroll
            for (int m = 0; m < 4; ++m) { const size_t off = (size_t)(ai * HALF + wr * 64 + m * 16 + fr) * D + col0;
#pragma unroll
                for (int bj = 0; bj < 2; ++bj)
#pragma unroll
                    for (int n = 0; n < 2; ++n) { const f32x4 xs = *(const f32x4*)(src + off + bj * HALF + n * 16); *(f32x4*)(dst + off + bj * HALF + n * 16) = xs + gv[bj][n] * acc[ai][bj][m][n]; } }
    }
};
struct EpiSwiglu {
    static constexpr bool PERM = true;
    bf16_t* O; int ldc;
    __device__ __forceinline__ void operator()(const f32x4 (&acc)[2][2][4][2], const Unit& u, int wr, int wc, int fr, int fq) const {
        const int row0 = u.pm * BM + wr * 64 + fr, col0 = u.pn * 128 + wc * 16 + 4 * fq;
#pragma unroll
        for (int ai = 0; ai < 2; ++ai)
#pragma unroll
            for (int m = 0; m < 4; ++m) { bf16_t* rowp = O + (size_t)(row0 + ai * HALF + m * 16) * ldc + col0;
#pragma unroll
                for (int bj = 0; bj < 2; ++bj) { const f32x4 a = acc[ai][bj][m][0], b = acc[ai][bj][m][1];
                    u32x2 w; w.x = cvt_pk_bf16(siluf(a[0]) * b[0], siluf(a[1]) * b[1]); w.y = cvt_pk_bf16(siluf(a[2]) * b[2], siluf(a[3]) * b[3]);
                    *(u32x2*)(rowp + bj * 64) = w; } }
    }
};
struct EpiOddIn {
    static constexpr bool PERM = true;
    bf16_t* O; const float* lb;
    __device__ __forceinline__ void operator()(const f32x4 (&acc)[2][2][4][2], const Unit& u, int wr, int wc, int fr, int fq) const {
        const int row0 = u.pm * BM + wr * 64 + fr, col0 = u.pn * BM + wc * 32 + 8 * fq; const int seg = u.pn >> 2;
        f32x4 lbv[2][2];
#pragma unroll
        for (int bj = 0; bj < 2; ++bj)
#pragma unroll
            for (int n = 0; n < 2; ++n) lbv[bj][n] = (seg == 2 || seg == 3) ? *(const f32x4*)(lb + (col0 - 2048) + bj * HALF + 4 * n) : (f32x4){0.f, 0.f, 0.f, 0.f};
#pragma unroll
        for (int ai = 0; ai < 2; ++ai)
#pragma unroll
            for (int m = 0; m < 4; ++m) { bf16_t* rowp = O + (size_t)(row0 + ai * HALF + m * 16) * NREC + col0;
#pragma unroll
                for (int bj = 0; bj < 2; ++bj) { f32x4 v[2] = {acc[ai][bj][m][0], acc[ai][bj][m][1]};
#pragma unroll
                    for (int n = 0; n < 2; ++n)
#pragma unroll
                        for (int i = 0; i < 4; ++i) { float x = v[n][i];
                            if (seg == 0) x = siluf(x) * 0.08838834764831845f;
                            else if (seg == 1) x = siluf(x);
                            else if (seg == 2 || seg == 3) { const float l = lbv[bj][n][i]; const float s = __builtin_amdgcn_rcpf(1.0f + __expf(-x)); const float f = l + (1.0f - l) * s; x = __logf(fmaxf(f, 1e-30f)); }
                            v[n][i] = x; }
                    u32x4 w; w.x = cvt_pk_bf16(v[0][0], v[0][1]); w.y = cvt_pk_bf16(v[0][2], v[0][3]); w.z = cvt_pk_bf16(v[1][0], v[1][1]); w.w = cvt_pk_bf16(v[1][2], v[1][3]);
                    *(u32x4*)(rowp + bj * HALF) = w; } }
    }
};
struct EpiMoeDown {
    static constexpr bool PERM = true;
    bf16_t* O; const int* dst;
    __device__ __forceinline__ void operator()(const f32x4 (&acc)[2][2][4][2], const Unit& u, int wr, int wc, int fr, int fq) const {
        const int row0 = u.pm * BM + wr * 64 + fr, col0 = u.pn * BM + wc * 32 + 8 * fq;
        int dd[2][4];
#pragma unroll
        for (int ai = 0; ai < 2; ++ai)
#pragma unroll
            for (int m = 0; m < 4; ++m) dd[ai][m] = dst[row0 + ai * HALF + m * 16];
#pragma unroll
        for (int ai = 0; ai < 2; ++ai)
#pragma unroll
            for (int m = 0; m < 4; ++m) { if (dd[ai][m] >= 0) { bf16_t* rowp = O + (size_t)dd[ai][m] * D + col0;
#pragma unroll
                for (int bj = 0; bj < 2; ++bj) { const f32x4 v0 = acc[ai][bj][m][0], v1 = acc[ai][bj][m][1];
                    u32x4 w; w.x = cvt_pk_bf16(v0[0], v0[1]); w.y = cvt_pk_bf16(v0[2], v0[3]); w.z = cvt_pk_bf16(v1[0], v1[1]); w.w = cvt_pk_bf16(v1[2], v1[3]);
                    *(u32x4*)(rowp + bj * HALF) = w; } } }
    }
};
}

struct Args { const float* in[24]; float* out; unsigned char* ws; int ph_lo, ph_hi; };
enum { I_X = 0, I_C, I_CTX, I_CCTX, I_WADA, I_BADA, I_NMIX, I_NFFN, I_NOUT, I_WINE, I_GW, I_GB, I_WOUTE, I_WINO, I_RLB, I_RNORM, I_WOUTO, I_F1, I_F3, I_F2, I_RW, I_M1, I_M3, I_M2 };
enum { PH_P0 = 0, PH_PAIR0 = 1, NPL = 18, PH_FINAL = 1 + 2 * NPL, NPHASE = PH_FINAL + 1 };
enum { E1_NORM = 0, E2_GIN, E3_FFTA, E3_FFTC, E4_GOUT, E5_NORM, E6_UP, E7_DOWN, O1_NORM, O2_GIN, O3_SCAN1, O4_CARRY, O5_SCAN3, O6_GOUT, O7_NORM, O8_SLOTS, O9_MUP, O10_MDOWN };

struct Ctx {
    LAS unsigned char* lds; int tid, lane, wave, G, bid, gw, NGW;
    const float* const* in; float* out; unsigned char* ws;
};

__device__ __forceinline__ void transpose_item(const float* W, int ld, int K, int N, bf16_t* WT, int mode, int roff, int item, int lane) {
    const int nblk = N / 64, kb = item / nblk, nb = item % nblk, k0 = 64 * kb, n0 = 64 * nb;
    const int c = lane & 15, kg = lane >> 4;
    const float* src = W + (size_t)(k0 + 8 * kg) * ld + n0 + 4 * c;
    f32x4 v[2][8];
#pragma unroll
    for (int hf = 0; hf < 2; ++hf)
#pragma unroll
        for (int i = 0; i < 8; ++i) v[hf][i] = __builtin_nontemporal_load((const f32x4*)(src + (size_t)(32 * hf + i) * ld));
#pragma unroll
    for (int i = 0; i < 4; ++i) { const int ng = n0 + 4 * c + i; const int drow = mode == 0 ? (roff + ng) : (((ng >> 2) << 3) + (ng & 3) + roff);
#pragma unroll
        for (int hf = 0; hf < 2; ++hf) { u32x4 o; o.x = pk2(v[hf][0][i], v[hf][1][i]); o.y = pk2(v[hf][2][i], v[hf][3][i]); o.z = pk2(v[hf][4][i], v[hf][5][i]); o.w = pk2(v[hf][6][i], v[hf][7][i]);
            *(u32x4*)(WT + (size_t)drow * K + k0 + 32 * hf + 8 * kg) = o; } }
}

__device__ __forceinline__ void p0_prologue(const Ctx& F) {
    const int tid = F.tid, lane = F.lane, wave = F.wave;
    unsigned char* ws = F.ws;
    LAS float* scond = (LAS float*)(F.lds);
    LAS float* part = (LAS float*)(F.lds + 16384);
    LAS float* ctab = (LAS float*)(F.lds + 32768);
    for (int i = tid; i < 3 * D; i += 512) { const int v = i / D, k = i % D; const float c = v < 2 ? F.in[I_C][v * D + k] : F.in[I_CCTX][k]; scond[i] = c / (1.0f + expf(-c)); }
    if (tid < 128) ctab[tid] = cosf(6.283185307179586f * (float)tid / 128.0f);
    __syncthreads();
    float* mods = (float*)(ws + WS_MODS);
    if (P0_MASK & 1)
    for (int it = F.bid; it < 4 * 48; it += F.G) {
        const int l = it / 48, cg = it % 48; const float* W = F.in[I_WADA] + (size_t)l * D * 6144 + cg * 128 + 2 * lane;
        float a0[2] = {0.f, 0.f}, a1[2] = {0.f, 0.f}, a2[2] = {0.f, 0.f};
#pragma unroll 16
        for (int kk = 0; kk < 128; ++kk) { const int k = wave * 128 + kk; const f32x2 w = __builtin_nontemporal_load((const f32x2*)(W + (size_t)k * 6144)); const float s0 = scond[k], s1 = scond[D + k], s2 = scond[2 * D + k];
            a0[0] += s0 * w.x; a0[1] += s0 * w.y; a1[0] += s1 * w.x; a1[1] += s1 * w.y; a2[0] += s2 * w.x; a2[1] += s2 * w.y; }
        part[(wave * 3 + 0) * 128 + 2 * lane] = a0[0]; part[(wave * 3 + 0) * 128 + 2 * lane + 1] = a0[1];
        part[(wave * 3 + 1) * 128 + 2 * lane] = a1[0]; part[(wave * 3 + 1) * 128 + 2 * lane + 1] = a1[1];
        part[(wave * 3 + 2) * 128 + 2 * lane] = a2[0]; part[(wave * 3 + 2) * 128 + 2 * lane + 1] = a2[1];
        __syncthreads();
        if (tid < 384) { const int v = tid / 128, c = tid % 128; float sum = 0.f;
#pragma unroll
            for (int w = 0; w < 8; ++w) sum += part[(w * 3 + v) * 128 + c];
            mods[((size_t)l * 3 + v) * 6144 + cg * 128 + c] = sum + F.in[I_BADA][l * 6144 + cg * 128 + c]; }
        __syncthreads();
    }
    const int gt = F.bid * 512 + tid, NGT = F.G * 512;
    float* LB = (float*)(ws + WS_LB);
    if (P0_MASK & 2)
    for (int i = gt; i < 4096; i += NGT) { const int j = i >> 11, r = i & 2047; float v = 0.f; if (j == 1) { const float r0 = F.in[I_RLB][r], r1 = F.in[I_RLB][2048 + r]; v = 1.0f / (1.0f + expf(r0 - r1)); v = fminf(fmaxf(v, 0.f), 1.f); } LB[i] = v; }
    bf16_t* FA = (bf16_t*)(ws + WS_FA); bf16_t* FC = (bf16_t*)(ws + WS_FC); bf16_t* FX = (bf16_t*)(ws + WS_FX); bf16_t* GW = (bf16_t*)(ws + WS_GW);
    if (P0_MASK & 4)
    for (int i = gt; i < 256 * 256; i += NGT) { const int r = i >> 8, c = i & 255, k1 = r & 127, t1 = c & 127; const float ang = 6.283185307179586f * (float)((k1 * t1) & 127) / 128.0f; float sn, cs; sincosf(ang, &sn, &cs);
        const int rr = r >> 7, cc = c >> 7; const float v = (rr == cc) ? cs : (rr == 0 ? -sn : sn); FA[i] = (bf16_t)f2bf(v); }
    if (P0_MASK & 4)
    for (int i = gt; i < 128 * 256; i += NGT) { const int k2 = i >> 8, c = i & 255, t2 = c & 127; const float ang = 6.283185307179586f * (float)((k2 * t2) & 127) / 128.0f; float sn, cs; sincosf(ang, &sn, &cs); FC[i] = (bf16_t)f2bf(c < 128 ? cs : -sn); }
    if (P0_MASK & 4)
    for (int i = gt; i < 256 * 512; i += NGT) { const int k = i >> 9, c = i & 511, t = c & 255; const float ang = 6.283185307179586f * (float)((k * t) & 255) / 256.0f; float sn, cs; sincosf(ang, &sn, &cs); FX[i] = (bf16_t)f2bf(c < 256 ? cs : -sn); }
    if (P0_MASK & 8)
    for (int i = gt; i < 2 * 4 * 128 * 128; i += NGT) GW[i] = (bf16_t)f2bf(F.in[I_GW][i]);
    bf16_t* WinE = (bf16_t*)(ws + WS_WINE);
    if (P0_MASK & 16)
    for (int it = F.gw; it < 2 * 4 * 16 * 32; it += F.NGW) {
        const int mg = it & 31, kb = (it >> 5) & 15, g = (it >> 9) & 3, j = it >> 11; const int k = kb * 64 + lane, m0 = mg * 4;
        const float* Wr = F.in[I_WINE] + (size_t)j * D * 1536 + (size_t)k * 1536 + g * 128;
        float aP[4] = {0.f, 0.f, 0.f, 0.f}, aQ[4] = {0.f, 0.f, 0.f, 0.f};
        for (int c4 = 0; c4 < 32; ++c4) { const f32x4 w = *(const f32x4*)(Wr + 4 * c4);
#pragma unroll
            for (int ci = 0; ci < 4; ++ci) { const int c = 4 * c4 + ci;
#pragma unroll
                for (int mm = 0; mm < 4; ++mm) { const int idx = (c * (m0 + mm)) & 127; aP[mm] += w[ci] * ctab[idx]; aQ[mm] += w[ci] * ctab[(idx - 32) & 127]; } } }
#pragma unroll
        for (int mm = 0; mm < 4; ++mm) { bf16_t* o = WinE + (size_t)j * NEIN * D; o[(size_t)(g * 128 + m0 + mm) * D + k] = (bf16_t)f2bf(aP[mm]); o[(size_t)(512 + g * 128 + m0 + mm) * D + k] = (bf16_t)f2bf(aQ[mm]); }
    }
    constexpr int NI_UV = 16 * 16, NI_SQ = 16 * 16, NI_INO = 16 * 80, NI_F13 = 16 * 44, NI_F2 = 44 * 16;
    constexpr int PER_J = NI_UV + NI_SQ + NI_INO + NI_SQ + 2 * NI_F13 + NI_F2;
    if (P0_MASK & 32)
    for (int it = F.gw; it < 2 * PER_J; it += F.NGW) {
        const int j = it / PER_J; int r = it % PER_J;
        const float* W; int ld, K, N, mode = 0, roff = 0; bf16_t* WT;
        if (r < NI_UV) { W = F.in[I_WINE] + (size_t)j * D * 1536 + 512; ld = 1536; K = D; N = 1024; WT = WinE + (size_t)j * NEIN * D; roff = 1024; }
        else if ((r -= NI_UV) < NI_SQ) { W = F.in[I_WOUTE] + (size_t)j * D * D; ld = D; K = D; N = D; WT = (bf16_t*)(ws + WS_WOUTE) + (size_t)j * D * D; }
        else if ((r -= NI_SQ) < NI_INO) { W = F.in[I_WINO] + (size_t)j * D * NREC; ld = NREC; K = D; N = NREC; WT = (bf16_t*)(ws + WS_WINO) + (size_t)j * NREC * D; }
        else if ((r -= NI_INO) < NI_SQ) { W = F.in[I_WOUTO] + (size_t)j * D * D; ld = D; K = D; N = D; WT = (bf16_t*)(ws + WS_WOUTO) + (size_t)j * D * D; }
        else if ((r -= NI_SQ) < NI_F13) { W = F.in[I_F1] + (size_t)j * D * DFF; ld = DFF; K = D; N = DFF; WT = (bf16_t*)(ws + WS_W13) + (size_t)j * NFF2 * D; mode = 1; }
        else if ((r -= NI_F13) < NI_F13) { W = F.in[I_F3] + (size_t)j * D * DFF; ld = DFF; K = D; N = DFF; WT = (bf16_t*)(ws + WS_W13) + (size_t)j * NFF2 * D; mode = 1; roff = 4; }
        else { r -= NI_F13; W = F.in[I_F2] + (size_t)j * DFF * D; ld = D; K = DFF; N = D; WT = (bf16_t*)(ws + WS_W2) + (size_t)j * D * DFF; }
        transpose_item(W, ld, K, N, WT, mode, roff, r, lane);
    }
}
__device__ __forceinline__ void moe_convert(const Ctx& F, int j) {
    constexpr int I_13 = 16 * 56, I_2 = 56 * 16, PER_E = 2 * I_13 + I_2;
    for (int it = F.gw; it < NE * PER_E; it += F.NGW) {
        const int e = it / PER_E; int r = it % PER_E; const size_t eo = (size_t)(j * NE + e);
        const float* W; int ld, K, N, mode = 0, roff = 0; bf16_t* WT;
        if (r < I_13) { W = F.in[I_M1] + eo * D * DEX; ld = DEX; K = D; N = DEX; WT = (bf16_t*)(F.ws + WS_W13M) + (size_t)e * NEX2 * D; mode = 1; }
        else if ((r -= I_13) < I_13) { W = F.in[I_M3] + eo * D * DEX; ld = DEX; K = D; N = DEX; WT = (bf16_t*)(F.ws + WS_W13M) + (size_t)e * NEX2 * D; mode = 1; roff = 4; }
        else { r -= I_13; W = F.in[I_M2] + eo * DEX * D; ld = D; K = DEX; N = D; WT = (bf16_t*)(F.ws + WS_W2M) + (size_t)e * D * DEX; }
        transpose_item(W, ld, K, N, WT, mode, roff, r, F.lane);
    }
}

struct RowPass {
    const float* sl; const float* sc;
    float* dl; float* dc;
    const float* gain;
    const float* shift; const float* scale;
    bf16_t* H;
    int nrows;
    const bf16_t* YE; const float* topp; const float* gatef;
    const float* rw; int* tope; float* toppo; int* rank; int* cnt;
    float* fout;
};
template <bool COMBINE, bool ROUTER, bool FINAL>
__device__ __forceinline__ void row_pass(const Ctx& F, const RowPass& P) {
    const int lane = F.lane;
    LAS float* rwl = (LAS float*)F.lds;
    if (ROUTER) { for (int i = F.tid; i < D * NE; i += 512) rwl[i] = P.rw[i]; __syncthreads(); }
    f32x4 gn[4];
#pragma unroll
    for (int j = 0; j < 4; ++j) gn[j] = *(const f32x4*)(P.gain + 4 * lane + 256 * j);
    const int nitems = P.nrows / 16;
    for (int it = F.gw; it < nitems; it += F.NGW) {
        int rc0 = 0, rc1 = 0, rc2 = 0, rc3 = 0, rc4 = 0, rc5 = 0, rc6 = 0, rc7 = 0;
        const int rbase = it * 16; const bool isc = rbase >= ML; const int ms = isc ? 2 : (rbase >= TL ? 1 : 0);
        const float* xs0 = isc ? P.sc + (size_t)(rbase - ML) * D : P.sl + (size_t)rbase * D;
        float* xd0 = nullptr; if (COMBINE && !FINAL) xd0 = isc ? P.dc + (size_t)(rbase - ML) * D : P.dl + (size_t)rbase * D;
        f32x4 sh[4], scl[4], gf[4];
#pragma unroll
        for (int j = 0; j < 4; ++j) {
            if (!FINAL) { sh[j] = *(const f32x4*)(P.shift + ms * 6144 + 4 * lane + 256 * j); scl[j] = *(const f32x4*)(P.scale + ms * 6144 + 4 * lane + 256 * j) + 1.0f; }
            if (COMBINE) gf[j] = *(const f32x4*)(P.gatef + ms * 6144 + 4 * lane + 256 * j); }
        f32x4 v[4]; u32x2 ya[4], yb[4]; float p0 = 0.f, p1 = 0.f;
#pragma unroll
        for (int j = 0; j < 4; ++j) v[j] = *(const f32x4*)(xs0 + 4 * lane + 256 * j);
        if (COMBINE) { p0 = P.topp[2 * rbase]; p1 = P.topp[2 * rbase + 1];
#pragma unroll
            for (int j = 0; j < 4; ++j) { ya[j] = *(const u32x2*)(P.YE + (size_t)(2 * rbase) * D + 4 * lane + 256 * j); yb[j] = *(const u32x2*)(P.YE + (size_t)(2 * rbase + 1) * D + 4 * lane + 256 * j); } }
        for (int rr = 0; rr < 16; ++rr) {
            const int r = rbase + rr;
            f32x4 vn[4]; u32x2 yan[4], ybn[4]; float p0n = 0.f, p1n = 0.f;
            if (rr < 15) {
#pragma unroll
                for (int j = 0; j < 4; ++j) vn[j] = *(const f32x4*)(xs0 + (size_t)(rr + 1) * D + 4 * lane + 256 * j);
                if (COMBINE) { p0n = P.topp[2 * r + 2]; p1n = P.topp[2 * r + 3];
#pragma unroll
                    for (int j = 0; j < 4; ++j) { yan[j] = *(const u32x2*)(P.YE + (size_t)(2 * r + 2) * D + 4 * lane + 256 * j); ybn[j] = *(const u32x2*)(P.YE + (size_t)(2 * r + 3) * D + 4 * lane + 256 * j); } }
            }
            if (COMBINE) {
#pragma unroll
                for (int j = 0; j < 4; ++j) { const u32x2 a = ya[j], b = yb[j];
                    f32x4 y; y[0] = p0 * bflo(a.x) + p1 * bflo(b.x); y[1] = p0 * bfhi(a.x) + p1 * bfhi(b.x); y[2] = p0 * bflo(a.y) + p1 * bflo(b.y); y[3] = p0 * bfhi(a.y) + p1 * bfhi(b.y);
                    v[j] = v[j] + gf[j] * y;
                    if (!FINAL) *(f32x4*)(xd0 + (size_t)rr * D + 4 * lane + 256 * j) = v[j]; }
            }
            float ss = 0.f;
#pragma unroll
            for (int j = 0; j < 4; ++j) ss += (v[j][0] * v[j][0] + v[j][1] * v[j][1]) + (v[j][2] * v[j][2] + v[j][3] * v[j][3]);
            const float rstd = rsqrtf(wave_sum(ss) * (1.0f / D) + EPS);
            if (FINAL) {
#pragma unroll
                for (int j = 0; j < 4; ++j) *(f32x4*)(P.fout + (size_t)r * D + 4 * lane + 256 * j) = v[j] * rstd * gn[j];
            } else {
                f32x4 h[4];
#pragma unroll
                for (int j = 0; j < 4; ++j) { h[j] = (v[j] * rstd * gn[j]) * scl[j] + sh[j];
                    u32x2 w; w.x = pk2(h[j][0], h[j][1]); w.y = pk2(h[j][2], h[j][3]);
                    *(u32x2*)(P.H + (size_t)r * D + 4 * lane + 256 * j) = w; }
                if (ROUTER) {
                    float lg[8] = {0.f, 0.f, 0.f, 0.f, 0.f, 0.f, 0.f, 0.f};
#pragma unroll
                    for (int j = 0; j < 4; ++j)
#pragma unroll
                        for (int i = 0; i < 4; ++i) { const int col = 4 * lane + 256 * j + i; const f32x4 w0 = *(const LAS f32x4*)(rwl + col * 8), w1 = *(const LAS f32x4*)(rwl + col * 8 + 4); const float hv = h[j][i];
                            lg[0] += hv * w0[0]; lg[1] += hv * w0[1]; lg[2] += hv * w0[2]; lg[3] += hv * w0[3]; lg[4] += hv * w1[0]; lg[5] += hv * w1[1]; lg[6] += hv * w1[2]; lg[7] += hv * w1[3]; }
#pragma unroll
                    for (int e = 0; e < 8; ++e) lg[e] = wave_sum(lg[e]);
                    int e0 = 0; float v0 = lg[0];
#pragma unroll
                    for (int e = 1; e < 8; ++e) if (lg[e] > v0) { v0 = lg[e]; e0 = e; }
                    int e1 = -1; float v1 = -3.0e38f;
#pragma unroll
                    for (int e = 0; e < 8; ++e) if (e != e0 && lg[e] > v1) { v1 = lg[e]; e1 = e; }
                    const float ex = expf(v1 - v0); const float q0 = 1.0f / (1.0f + ex), q1 = ex / (1.0f + ex);
                    const int rk0 = e0 == 0 ? rc0 : e0 == 1 ? rc1 : e0 == 2 ? rc2 : e0 == 3 ? rc3 : e0 == 4 ? rc4 : e0 == 5 ? rc5 : e0 == 6 ? rc6 : rc7;
                    const int rk1 = e1 == 0 ? rc0 : e1 == 1 ? rc1 : e1 == 2 ? rc2 : e1 == 3 ? rc3 : e1 == 4 ? rc4 : e1 == 5 ? rc5 : e1 == 6 ? rc6 : rc7;
                    rc0 += (e0 == 0) + (e1 == 0); rc1 += (e0 == 1) + (e1 == 1); rc2 += (e0 == 2) + (e1 == 2); rc3 += (e0 == 3) + (e1 == 3);
                    rc4 += (e0 == 4) + (e1 == 4); rc5 += (e0 == 5) + (e1 == 5); rc6 += (e0 == 6) + (e1 == 6); rc7 += (e0 == 7) + (e1 == 7);
                    if (lane == 0) { P.tope[2 * r] = e0; P.tope[2 * r + 1] = e1; P.toppo[2 * r] = q0; P.toppo[2 * r + 1] = q1; P.rank[2 * r] = rk0; P.rank[2 * r + 1] = rk1; }
                }
            }
            if (rr < 15) {
#pragma unroll
                for (int j = 0; j < 4; ++j) { v[j] = vn[j]; if (COMBINE) { ya[j] = yan[j]; yb[j] = ybn[j]; } }
                if (COMBINE) { p0 = p0n; p1 = p1n; }
            }
        }
        if (ROUTER && lane == 0) { int* c = P.cnt + it * 8; c[0] = rc0; c[1] = rc1; c[2] = rc2; c[3] = rc3; c[4] = rc4; c[5] = rc5; c[6] = rc6; c[7] = rc7; }
    }
}

template <int NB>
__device__ __forceinline__ void lm_core(const bf16_t* A, int lda, const int (&i0)[NB], int kc0, int nks, LAS unsigned char* X, f32x4 (&acc)[NB][8], int lane) {
    const int i16 = lane & 15, q = lane >> 4;
    const int xoff = (8 * q + (i16 >> 2)) * XRS + 8 * (i16 & 3);
    for (int ks = 0; ks < nks; ++ks) {
        bf16x8 af[NB];
#pragma unroll
        for (int b = 0; b < NB; ++b) af[b] = *(const bf16x8*)(A + (size_t)(i0[b] + i16) * lda + kc0 + ks * 32 + 8 * q);
#pragma unroll
        for (int nt = 0; nt < 8; ++nt) {
            const s16x4 lo = __builtin_amdgcn_ds_read_tr16_b64_v4i16((LAS s16x4*)(X + ks * 32 * XRS + xoff + nt * 32));
            const s16x4 hi = __builtin_amdgcn_ds_read_tr16_b64_v4i16((LAS s16x4*)(X + ks * 32 * XRS + xoff + nt * 32 + 4 * XRS));
            const bf16x8 xf = __builtin_shufflevector(lo, hi, 0, 1, 2, 3, 4, 5, 6, 7);
#pragma unroll
            for (int b = 0; b < NB; ++b) acc[b][nt] = __builtin_amdgcn_mfma_f32_16x16x32_bf16(xf, af[b], acc[b][nt], 0, 0, 0);
        }
    }
}
template <int NB> __device__ __forceinline__ void zero_acc(f32x4 (&acc)[NB][8]) {
#pragma unroll
    for (int b = 0; b < NB; ++b)
#pragma unroll
        for (int nt = 0; nt < 8; ++nt) acc[b][nt] = (f32x4){0.f, 0.f, 0.f, 0.f};
}
__device__ __forceinline__ void stage_rows(const bf16_t* src, size_t sstride, int nrows, LAS unsigned char* X, int xr0, int tid) {
    for (int i = tid; i < nrows * 16; i += 512) { const int r = i >> 4, ch = i & 15; *(LAS u32x4*)(X + (xr0 + r) * XRS + ch * 16) = *(const u32x4*)(src + (size_t)r * sstride + ch * 8); }
}

__device__ __forceinline__ void fft_stage_a(const Ctx& F) {
    const bf16_t* PZ = (const bf16_t*)(F.ws + WS_PZUV); bf16_t* UP = (bf16_t*)(F.ws + WS_UP); bf16_t* Y = (bf16_t*)(F.ws + WS_H);
    const bf16_t* FA = (const bf16_t*)(F.ws + WS_FA); const bf16_t* FX = (const bf16_t*)(F.ws + WS_FX);
    LAS unsigned char* X = F.lds; const int lane = F.lane, w = F.wave, i16 = lane & 15, q = lane >> 4;
    for (int it = F.bid; it < 1024 + 16; it += F.G) {
        if (it < 1024) {
            const int t2 = it & 127, g = (it >> 7) & 3, b = it >> 9;
            const bf16_t* src = PZ + ((size_t)b * TL + t2) * NEIN + g * 128;
            stage_rows(src, (size_t)128 * NEIN, 128, X, 0, F.tid);
            stage_rows(src + 512, (size_t)128 * NEIN, 128, X, 128, F.tid);
            __syncthreads();
            f32x4 acc[2][8]; zero_acc<2>(acc); const int i0[2] = {16 * w, 128 + 16 * w};
            lm_core<2>(FA, 256, i0, 0, 8, X, acc, lane);
            const int k1 = 16 * w + i16; float sw, cw; sincosf(6.283185307179586f * (float)((k1 * t2) & 16383) / 16384.0f, &sw, &cw);
            bf16_t* orow = UP + ((size_t)((b * 4 + g) * 128 + k1) * 128 + t2) * 256;
#pragma unroll
            for (int nt = 0; nt < 8; ++nt) { const f32x4 ur = acc[0][nt], ui = acc[1][nt]; const int n = 16 * nt + 4 * q;
                u32x2 wr_, wi_; wr_.x = pk2(ur[0] * cw - ui[0] * sw, ur[1] * cw - ui[1] * sw); wr_.y = pk2(ur[2] * cw - ui[2] * sw, ur[3] * cw - ui[3] * sw);
                wi_.x = pk2(ur[0] * sw + ui[0] * cw, ur[1] * sw + ui[1] * cw); wi_.y = pk2(ur[2] * sw + ui[2] * cw, ur[3] * sw + ui[3] * cw);
                *(u32x2*)(orow + n) = wr_; *(u32x2*)(orow + 128 + n) = wi_; }
            __syncthreads();
        } else {
            const int ci = it - 1024, kh = ci & 1, g = (ci >> 1) & 3, b = ci >> 3;
            f32x4 acc[1][8]; zero_acc<1>(acc); const int i0[1] = {128 * kh + 16 * w};
            for (int c = 0; c < 2; ++c) {
                stage_rows(PZ + ((size_t)ML + b * TCX) * NEIN + c * 512 + g * 128, NEIN, 256, X, 0, F.tid);
                __syncthreads();
                lm_core<1>(FX, 512, i0, c * 256, 8, X, acc, lane);
                __syncthreads();
            }
            const int k = 128 * kh + 16 * w + i16; bf16_t* orow = Y + ((size_t)ML + b * TCX + k) * D + g * 128; const float nrm = 0.005524271728019903f;
#pragma unroll
            for (int nt = 0; nt < 8; ++nt) { const f32x4 a = acc[0][nt] * nrm; u32x2 o; o.x = pk2(a[0], a[1]); o.y = pk2(a[2], a[3]); *(u32x2*)(orow + 16 * nt + 4 * q) = o; }
        }
    }
}
__device__ __forceinline__ void fft_stage_c_gmlp(const Ctx& F, int j) {
    const bf16_t* PZ = (const bf16_t*)(F.ws + WS_PZUV); const bf16_t* UP = (const bf16_t*)(F.ws + WS_UP); bf16_t* Y = (bf16_t*)(F.ws + WS_H);
    const bf16_t* FC = (const bf16_t*)(F.ws + WS_FC); const bf16_t* GW = (const bf16_t*)(F.ws + WS_GW) + (size_t)j * 4 * 128 * 128;
    const float* gb = F.in[I_GB] + j * 512;
    LAS unsigned char* X = F.lds; const int lane = F.lane, w = F.wave, i16 = lane & 15, q = lane >> 4, tid = F.tid;
    for (int it = F.bid; it < 1024 + 1040; it += F.G) {
        if (it < 1024) {
            const int k1 = it & 127, g = (it >> 7) & 3, b = it >> 9;
            const bf16_t* src = UP + (size_t)((b * 4 + g) * 128 + k1) * 128 * 256;
            stage_rows(src, 256, 128, X, 0, tid);
            stage_rows(src + 128, 256, 128, X, 128, tid);
            __syncthreads();
            f32x4 acc[1][8]; zero_acc<1>(acc); const int i0[1] = {16 * w};
            lm_core<1>(FC, 256, i0, 0, 8, X, acc, lane);
            const int k2 = 16 * w + i16; bf16_t* orow = Y + ((size_t)b * TL + k1 + 128 * k2) * D + g * 128; const float nrm = 0.0006905339660024878f;
#pragma unroll
            for (int nt = 0; nt < 8; ++nt) { const f32x4 a = acc[0][nt] * nrm; u32x2 o; o.x = pk2(a[0], a[1]); o.y = pk2(a[2], a[3]); *(u32x2*)(orow + 16 * nt + 4 * q) = o; }
            __syncthreads();
        } else {
            const int gi = it - 1024, h = gi & 3, ck = gi >> 2; const size_t r0 = (size_t)ck * 128;
            for (int i = tid; i < 128 * 16; i += 512) { const int r = i >> 4, ch = i & 15; const u32x4 raw = *(const u32x4*)(PZ + (r0 + r) * NEIN + 1536 + h * 128 + ch * 8);
                float x[8] = {bflo(raw.x), bfhi(raw.x), bflo(raw.y), bfhi(raw.y), bflo(raw.z), bfhi(raw.z), bflo(raw.w), bfhi(raw.w)};
                float s = 0.f;
#pragma unroll
                for (int e = 0; e < 8; ++e) s += x[e];
                s += __shfl_xor(s, 1); s += __shfl_xor(s, 2); s += __shfl_xor(s, 4); s += __shfl_xor(s, 8);
                const float mean = s * (1.0f / 128.0f); float qq = 0.f;
#pragma unroll
                for (int e = 0; e < 8; ++e) { x[e] -= mean; qq += x[e] * x[e]; }
                qq += __shfl_xor(qq, 1); qq += __shfl_xor(qq, 2); qq += __shfl_xor(qq, 4); qq += __shfl_xor(qq, 8);
                const float rs = rsqrtf(qq * (1.0f / 128.0f) + EPS);
                u32x4 o; o.x = pk2(x[0] * rs, x[1] * rs); o.y = pk2(x[2] * rs, x[3] * rs); o.z = pk2(x[4] * rs, x[5] * rs); o.w = pk2(x[6] * rs, x[7] * rs);
                *(LAS u32x4*)(X + r * XRS + ch * 16) = o; }
            __syncthreads();
            f32x4 acc[1][8]; zero_acc<1>(acc); const int i0[1] = {16 * w};
            lm_core<1>(GW + (size_t)h * 128 * 128, 128, i0, 0, 4, X, acc, lane);
            const int t = 16 * w + i16; const float bias = gb[h * 128 + t];
            const bf16_t* urow = PZ + (r0 + t) * NEIN + 1024 + h * 128; bf16_t* orow = Y + (r0 + t) * D + 512 + h * 128;
#pragma unroll
            for (int nt = 0; nt < 8; ++nt) { const int n = 16 * nt + 4 * q; const u32x2 uu = *(const u32x2*)(urow + n); const f32x4 a = acc[0][nt];
                u32x2 o; o.x = pk2(bflo(uu.x) * (a[0] + bias), bfhi(uu.x) * (a[1] + bias)); o.y = pk2(bflo(uu.y) * (a[2] + bias), bfhi(uu.y) * (a[3] + bias)); *(u32x2*)(orow + n) = o; }
            __syncthreads();
        }
    }
}

constexpr int SC_QT = 0, SC_KT = 9216, SC_V = 18432, SC_S16 = 27648, SC_SC = 64512, SC_EB = 67072, SC_PT = 67584, SC_RED = 69632, SC_OF = 70656, SC_OFRS = 264;
static_assert(SC_OF + 256 * SC_OFRS <= MISC_OFF, "scan LDS");
constexpr int SCRS = 80;
template <bool NEEDQ>
__device__ __forceinline__ float chunk_prep(const Ctx& F, const bf16_t* P5, size_t row0, bool rev, int h, int dir) {
    const int tid = F.tid, dk = tid & 127, part = tid >> 7;
    LAS unsigned char* L = F.lds;
    float lf[8], cs[8]; float run = 0.f;
#pragma unroll
    for (int i = 0; i < 8; ++i) { const int p = 8 * part + i; const size_t r = row0 + (rev ? 31 - p : p); lf[i] = bf2f(P5[r * NREC + 2048 + dir * 1024 + h * 128 + dk]); run += lf[i]; cs[i] = run; }
    LAS float* PT = (LAS float*)(L + SC_PT);
    PT[part * 128 + dk] = run;
    { const int p = tid >> 4, ch = tid & 15; const size_t r = row0 + (rev ? 31 - p : p); *(LAS u32x4*)(L + SC_V + p * XRS + ch * 16) = *(const u32x4*)(P5 + r * NREC + 4096 + h * 128 + ch * 8); }
    __syncthreads();
    const float t0 = PT[dk], t1 = PT[128 + dk], t2 = PT[256 + dk], t3 = PT[384 + dk];
    const float off = part == 0 ? 0.f : part == 1 ? t0 : part == 2 ? t0 + t1 : t0 + t1 + t2;
    const float bend = (t0 + t1) + (t2 + t3);
#pragma unroll
    for (int i = 0; i < 8; ++i) { const int p = 8 * part + i; const float b = off + cs[i];
        const float kk = (1.0f - __expf(lf[i])) * __expf(fminf(-b, 80.0f));
        *(LAS bf16_t*)(L + SC_KT + p * XRS + dk * 2) = (bf16_t)f2bf(kk);
        if (NEEDQ) { const size_t r = row0 + (rev ? 31 - p : p); const float qv = bf2f(P5[r * NREC + h * 128 + dk]); *(LAS bf16_t*)(L + SC_QT + p * XRS + dk * 2) = (bf16_t)f2bf(qv * __expf(b)); } }
    if (part == 0) ((LAS float*)(L + SC_EB))[dk] = __expf(bend);
    return bend;
}
__device__ __forceinline__ void state_update(const Ctx& F, f32x4 (&st)[8]) {
    LAS unsigned char* L = F.lds; const int lane = F.lane, i16 = lane & 15, q = lane >> 4, w = F.wave;
    const int roff = (8 * q + (i16 >> 2)) * XRS + 8 * (i16 & 3);
    const s16x4 vlo = __builtin_amdgcn_ds_read_tr16_b64_v4i16((LAS s16x4*)(L + SC_V + roff + w * 32));
    const s16x4 vhi = __builtin_amdgcn_ds_read_tr16_b64_v4i16((LAS s16x4*)(L + SC_V + roff + w * 32 + 4 * XRS));
    const bf16x8 vf = __builtin_shufflevector(vlo, vhi, 0, 1, 2, 3, 4, 5, 6, 7);
#pragma unroll
    for (int kb = 0; kb < 8; ++kb) {
        const s16x4 klo = __builtin_amdgcn_ds_read_tr16_b64_v4i16((LAS s16x4*)(L + SC_KT + roff + kb * 32));
        const s16x4 khi = __builtin_amdgcn_ds_read_tr16_b64_v4i16((LAS s16x4*)(L + SC_KT + roff + kb * 32 + 4 * XRS));
        const bf16x8 kf = __builtin_shufflevector(klo, khi, 0, 1, 2, 3, 4, 5, 6, 7);
        st[kb] = __builtin_amdgcn_mfma_f32_16x16x32_bf16(kf, vf, st[kb], 0, 0, 0);
        const f32x4 eb = *(const LAS f32x4*)(L + SC_EB + (16 * kb + 4 * q) * 4);
        st[kb] = st[kb] * eb;
    }
}
__device__ __forceinline__ void state_load(const float* src, f32x4 (&st)[8], int w, int lane) {
#pragma unroll
    for (int kb = 0; kb < 8; ++kb)
#pragma unroll
        for (int rg = 0; rg < 4; ++rg) st[kb][rg] = src ? src[((w * 8 + kb) * 4 + rg) * 64 + lane] : 0.f;
}
__device__ __forceinline__ void state_store(float* dst, const f32x4 (&st)[8], int w, int lane) {
#pragma unroll
    for (int kb = 0; kb < 8; ++kb)
#pragma unroll
        for (int rg = 0; rg < 4; ++rg) dst[((w * 8 + kb) * 4 + rg) * 64 + lane] = st[kb][rg];
}
__device__ __forceinline__ void scan_pass1_item(const Ctx& F, const bf16_t* P5, int b, int h, int dir, int seg, float* SST, float* EG) {
    const int chain = (b * 8 + h) * 2 + dir; const size_t rowb = (size_t)b * TL + (size_t)seg * SEGL;
    f32x4 st[8]; state_load(nullptr, st, F.wave, F.lane);
    float gacc = 0.f;
    for (int c = 0; c < 8; ++c) {
        const int cc = dir ? 7 - c : c;
        gacc += chunk_prep<false>(F, P5, rowb + cc * CH, dir != 0, h, dir);
        __syncthreads();
        state_update(F, st);
        __syncthreads();
    }
    state_store(SST + ((size_t)chain * NSEG + seg) * 16384, st, F.wave, F.lane);
    if (F.tid < 128) EG[((size_t)chain * NSEG + seg) * 128 + F.tid] = __expf(gacc);
}
template <int DIR>
__device__ __forceinline__ void scan_sweep(const Ctx& F, const bf16_t* P5, size_t rowb, int h, f32x4 (&st)[8], const float* gain, bf16_t* Y, bool writey) {
    LAS unsigned char* L = F.lds; const int lane = F.lane, i16 = lane & 15, q = lane >> 4, w = F.wave;
    const int roff = (8 * q + (i16 >> 2)) * XRS + 8 * (i16 & 3);
    for (int c = 0; c < 8; ++c) {
        const int cc = DIR ? 7 - c : c; const size_t row0 = rowb + cc * CH;
        (void)chunk_prep<true>(F, P5, row0, DIR != 0, h, DIR);
#pragma unroll
        for (int kb = 0; kb < 8; ++kb)
#pragma unroll
            for (int rg = 0; rg < 4; ++rg) *(LAS bf16_t*)(L + SC_S16 + (16 * kb + 4 * q + rg) * XRS + (16 * w + i16) * 2) = (bf16_t)f2bf(st[kb][rg]);
        __syncthreads();
        if (w < 4) {
            const int ti = w >> 1, si = w & 1; f32x4 sc = (f32x4){0.f, 0.f, 0.f, 0.f};
            if (si <= ti) {
#pragma unroll
                for (int ks = 0; ks < 4; ++ks) { const bf16x8 a = *(const LAS bf16x8*)(L + SC_QT + (16 * ti + i16) * XRS + (32 * ks + 8 * q) * 2); const bf16x8 bb = *(const LAS bf16x8*)(L + SC_KT + (16 * si + i16) * XRS + (32 * ks + 8 * q) * 2);
                    sc = __builtin_amdgcn_mfma_f32_16x16x32_bf16(a, bb, sc, 0, 0, 0); }
            }
#pragma unroll
            for (int rg = 0; rg < 4; ++rg) { const int t = 16 * ti + 4 * q + rg, s = 16 * si + i16; *(LAS bf16_t*)(L + SC_SC + t * SCRS + s * 2) = (bf16_t)f2bf(s <= t ? sc[rg] : 0.f); }
        }
        __syncthreads();
        f32x4 o[2] = {(f32x4){0.f, 0.f, 0.f, 0.f}, (f32x4){0.f, 0.f, 0.f, 0.f}};
#pragma unroll
        for (int ks = 0; ks < 4; ++ks) {
            const s16x4 slo = __builtin_amdgcn_ds_read_tr16_b64_v4i16((LAS s16x4*)(L + SC_S16 + ks * 32 * XRS + roff + w * 32));
            const s16x4 shi = __builtin_amdgcn_ds_read_tr16_b64_v4i16((LAS s16x4*)(L + SC_S16 + ks * 32 * XRS + roff + w * 32 + 4 * XRS));
            const bf16x8 sf = __builtin_shufflevector(slo, shi, 0, 1, 2, 3, 4, 5, 6, 7);
#pragma unroll
            for (int ti = 0; ti < 2; ++ti) { const bf16x8 qf = *(const LAS bf16x8*)(L + SC_QT + (16 * ti + i16) * XRS + (32 * ks + 8 * q) * 2); o[ti] = __builtin_amdgcn_mfma_f32_16x16x32_bf16(sf, qf, o[ti], 0, 0, 0); }
        }
        { const s16x4 vlo = __builtin_amdgcn_ds_read_tr16_b64_v4i16((LAS s16x4*)(L + SC_V + roff + w * 32));
          const s16x4 vhi = __builtin_amdgcn_ds_read_tr16_b64_v4i16((LAS s16x4*)(L + SC_V + roff + w * 32 + 4 * XRS));
          const bf16x8 vf = __builtin_shufflevector(vlo, vhi, 0, 1, 2, 3, 4, 5, 6, 7);
#pragma unroll
          for (int ti = 0; ti < 2; ++ti) { const bf16x8 pf = *(const LAS bf16x8*)(L + SC_SC + (16 * ti + i16) * SCRS + (8 * q) * 2); o[ti] = __builtin_amdgcn_mfma_f32_16x16x32_bf16(vf, pf, o[ti], 0, 0, 0); } }
        if (DIR == 0) {
#pragma unroll
            for (int ti = 0; ti < 2; ++ti) { const int tl = cc * CH + 16 * ti + i16; u32x2 pkd; pkd.x = pk2(o[ti][0], o[ti][1]); pkd.y = pk2(o[ti][2], o[ti][3]); *(LAS u32x2*)(L + SC_OF + tl * SC_OFRS + (16 * w + 4 * q) * 2) = pkd; }
            state_update(F, st);
            __syncthreads();
        } else {
            LAS float* RED = (LAS float*)(L + SC_RED);
#pragma unroll
            for (int ti = 0; ti < 2; ++ti) { const int tl = cc * CH + 31 - (16 * ti + i16); const u32x2 f = *(const LAS u32x2*)(L + SC_OF + tl * SC_OFRS + (16 * w + 4 * q) * 2);
                o[ti][0] += bflo(f.x); o[ti][1] += bfhi(f.x); o[ti][2] += bflo(f.y); o[ti][3] += bfhi(f.y);
                float ss = (o[ti][0] * o[ti][0] + o[ti][1] * o[ti][1]) + (o[ti][2] * o[ti][2] + o[ti][3] * o[ti][3]);
                ss += __shfl_xor(ss, 16); ss += __shfl_xor(ss, 32);
                if (q == 0) RED[w * 32 + 16 * ti + i16] = ss; }
            state_update(F, st);
            __syncthreads();
            if (writey) {
                const f32x4 gv = *(const f32x4*)(gain + h * 128 + 16 * w + 4 * q);
#pragma unroll
                for (int ti = 0; ti < 2; ++ti) { const int p = 16 * ti + i16; float tot = 0.f;
#pragma unroll
                    for (int ww = 0; ww < 8; ++ww) tot += RED[ww * 32 + p];
                    const float rs = rsqrtf(tot * (1.0f / 128.0f) + EPS); const size_t r = row0 + 31 - p;
                    const u32x2 sg = *(const u32x2*)(P5 + r * NREC + 1024 + h * 128 + 16 * w + 4 * q);
                    u32x2 y; y.x = pk2(o[ti][0] * rs * gv[0] * bflo(sg.x), o[ti][1] * rs * gv[1] * bfhi(sg.x)); y.y = pk2(o[ti][2] * rs * gv[2] * bflo(sg.y), o[ti][3] * rs * gv[3] * bfhi(sg.y));
                    *(u32x2*)(Y + r * D + h * 128 + 16 * w + 4 * q) = y; }
            }
            __syncthreads();
        }
    }
}
__device__ __forceinline__ void scan_pass3_item(const Ctx& F, const bf16_t* P5, size_t rowb, int h, const float* sin_f, const float* sin_b, float* fin_f, float* fin_b, const float* gain, bf16_t* Y, bool writey) {
    f32x4 st[8];
    state_load(sin_f, st, F.wave, F.lane);
    scan_sweep<0>(F, P5, rowb, h, st, gain, Y, writey);
    if (fin_f) state_store(fin_f, st, F.wave, F.lane);
    state_load(sin_b, st, F.wave, F.lane);
    scan_sweep<1>(F, P5, rowb, h, st, gain, Y, writey);
    if (fin_b) state_store(fin_b, st, F.wave, F.lane);
}
__device__ __forceinline__ void scan_carry(const Ctx& F) {
    float* SST = (float*)(F.ws + WS_SST); const float* EG = (const float*)(F.ws + WS_EG); const float* S0 = (const float*)(F.ws + WS_S0);
    const int gt = F.bid * 512 + F.tid, NGT = F.G * 512;
    for (int idx = gt; idx < NCHAIN * 16384; idx += NGT) {
        const int chain = idx >> 14, e = idx & 16383, dir = chain & 1;
        const int lanee = e & 63, rg = (e >> 6) & 3, kb = (e >> 8) & 7; const int dk = 16 * kb + 4 * (lanee >> 4) + rg;
        float cur = S0[(size_t)chain * 16384 + e];
        float* base = SST + (size_t)chain * NSEG * 16384 + e; const float* eg = EG + (size_t)chain * NSEG * 128 + dk;
        for (int s0 = 0; s0 < NSEG; s0 += 8) {
            float tmp[8], gg[8];
#pragma unroll
            for (int i = 0; i < 8; ++i) { const int seg = dir ? NSEG - 1 - (s0 + i) : s0 + i; tmp[i] = base[(size_t)seg * 16384]; gg[i] = eg[seg * 128]; }
#pragma unroll
            for (int i = 0; i < 8; ++i) { const int seg = dir ? NSEG - 1 - (s0 + i) : s0 + i; base[(size_t)seg * 16384] = cur; cur = gg[i] * cur + tmp[i]; }
        }
    }
}

__device__ __forceinline__ void moe_slots(const Ctx& F, int nrows) {
    const int tid = F.tid; const int nitems = nrows / 16;
    const int* cnt = (const int*)(F.ws + WS_CNT); const int* tope = (const int*)(F.ws + WS_TOPE); const int* rank = (const int*)(F.ws + WS_RANK);
    int* slotrow = (int*)(F.ws + WS_SLOTROW); int* slotdst = (int*)(F.ws + WS_SLOTDST); int* tilex = (int*)(F.ws + WS_TILEX);
    LAS int* pre = (LAS int*)F.lds;
    LAS int* tsum = (LAS int*)(F.lds + 69632);
    LAS int* ebase = (LAS int*)(F.lds + 69632 + 16384);
    constexpr int IPT = (NITEM16 + 511) / 512;
    int loc[8] = {0, 0, 0, 0, 0, 0, 0, 0};
    for (int i = 0; i < IPT; ++i) { const int it = tid * IPT + i; if (it < nitems) {
#pragma unroll
        for (int e = 0; e < 8; ++e) loc[e] += cnt[it * 8 + e]; } }
#pragma unroll
    for (int e = 0; e < 8; ++e) tsum[tid * 8 + e] = loc[e];
    __syncthreads();
    if (tid < 8) { int run = 0; for (int t = 0; t < 512; ++t) { const int v = tsum[t * 8 + tid]; tsum[t * 8 + tid] = run; run += v; } ebase[8 + tid] = run; }
    __syncthreads();
    if (tid == 0) { int b = 0; for (int e = 0; e < 8; ++e) { ebase[e] = b; b += (ebase[8 + e] + 255) & ~255; } ebase[16] = b / 256; }
    { int run[8];
#pragma unroll
      for (int e = 0; e < 8; ++e) run[e] = tsum[tid * 8 + e];
      for (int i = 0; i < IPT; ++i) { const int it = tid * IPT + i; if (it < nitems) {
#pragma unroll
          for (int e = 0; e < 8; ++e) { pre[it * 8 + e] = run[e]; run[e] += cnt[it * 8 + e]; } } } }
    __syncthreads();
    for (int r = F.bid * 512 + tid; r < nrows; r += F.G * 512) {
#pragma unroll
        for (int kk = 0; kk < 2; ++kk) { const int e = tope[2 * r + kk]; const int slot = ebase[e] + pre[(r >> 4) * 8 + e] + rank[2 * r + kk]; slotrow[slot] = r; slotdst[slot] = 2 * r + kk; }
    }
    if (F.bid == 0) {
        const int ntiles = ebase[16];
        if (tid == 0) tilex[0] = ntiles;
        for (int e = 0; e < 8; ++e) { const int b0 = ebase[e], tot = ebase[8 + e], pad = (tot + 255) & ~255;
            for (int s = b0 + tot + tid; s < b0 + pad; s += 512) { slotrow[s] = 0; slotdst[s] = -1; }
            for (int t = b0 / 256 + tid; t < (b0 + pad) / 256; t += 512) tilex[16 + t] = e; }
    }
}

__global__ void __launch_bounds__(512, 2) fwd_kernel(Args args) {
    extern __shared__ __attribute__((aligned(16))) unsigned char lds_raw[];
    Ctx F;
    F.lds = (LAS unsigned char*)lds_raw; F.tid = threadIdx.x; F.lane = F.tid & 63; F.wave = __builtin_amdgcn_readfirstlane(F.tid >> 6);
    F.G = gridDim.x; F.bid = blockIdx.x; F.gw = F.bid * 8 + F.wave; F.NGW = F.G * 8;
    F.in = args.in; F.out = args.out; F.ws = args.ws;
    unsigned char* ws = args.ws;
    volatile LAS unsigned* MISC = (volatile LAS unsigned*)(F.lds + MISC_OFF);
    if (F.tid < 64) MISC[F.tid] = 0u;
    __syncthreads();
    const int lo = args.ph_lo, hi = args.ph_hi;
    XcdBarrier bar; bar.bar = (unsigned*)(ws + WS_CTL) + 4096; bar.x = 0; bar.st = nullptr;
    const bool multi = (hi - lo) > 1;
    if (multi) bar = xcd_barrier_post((unsigned*)(ws + WS_CTL) + 4096, MISC + 8);
#define IN(k) (lo <= (k) && (k) < hi)
#define SEAM(k) do { if (IN(k) && IN((k) + 1)) xcd_barrier(bar); asm volatile("" : "+v"(F.tid)); F.lane = F.tid & 63; F.wave = __builtin_amdgcn_readfirstlane(F.tid >> 6); F.gw = F.bid * 8 + F.wave; } while (0)

    float* mods = (float*)(ws + WS_MODS);
    float* XC = (float*)(ws + WS_XC);
    bf16_t* H = (bf16_t*)(ws + WS_H);
    bf16_t* YE = (bf16_t*)(ws + WS_YE);

    if (IN(PH_P0)) { p0_prologue(F); }
    SEAM(PH_P0);

    for (int lp = 0; lp < 2; ++lp) {
        const int pb = PH_PAIR0 + lp * NPL;
        const int le = 2 * lp, lo_ = 2 * lp + 1;
        const float* modE = mods + (size_t)le * 3 * 6144; const float* modO = mods + (size_t)lo_ * 3 * 6144;
        const float* xsl = lp == 0 ? F.in[I_X] : F.out; const float* xsc = lp == 0 ? F.in[I_CTX] : XC;
        if (IN(pb + E1_NORM)) for (int rep_ = 0; rep_ < NREP(E1_NORM); ++rep_) {
            RowPass P{}; P.sl = xsl; P.sc = xsc; P.dl = F.out; P.dc = XC; P.gain = F.in[I_NMIX] + le * D; P.shift = modE + 0 * D; P.scale = modE + 1 * D; P.H = H; P.nrows = MT;
            if (lp == 0) row_pass<false, false, false>(F, P);
            else { P.YE = YE; P.topp = (const float*)(ws + WS_TOPP); P.gatef = mods + (size_t)(le - 1) * 3 * 6144 + 5 * D; row_pass<true, false, false>(F, P); }
        }
        SEAM(pb + E1_NORM);
        if (IN(pb + E2_GIN)) for (int rep_ = 0; rep_ < NREP(E2_GIN); ++rep_) {
            pg8::Gemm g{H, (const bf16_t*)(ws + WS_WINE) + (size_t)lp * NEIN * D, MT, NEIN, D, nullptr, nullptr, 0}; pg8::StaticOrder S; S.init(MT, NEIN, F.G, F.bid);
            pg8::EpiEvenIn E{(bf16_t*)(ws + WS_PZUV)};
            pg8::gemm_phase<pg8::EpiEvenIn, pg8::StaticOrder, true, false>(F.lds, g, S, E, F.tid);
        }
        SEAM(pb + E2_GIN);
        if (IN(pb + E3_FFTA)) for (int rep_ = 0; rep_ < NREP(E3_FFTA); ++rep_) fft_stage_a(F);
        SEAM(pb + E3_FFTA);
        if (IN(pb + E3_FFTC)) for (int rep_ = 0; rep_ < NREP(E3_FFTC); ++rep_) fft_stage_c_gmlp(F, lp);
        SEAM(pb + E3_FFTC);
        if (IN(pb + E4_GOUT)) for (int rep_ = 0; rep_ < NREP(E4_GOUT); ++rep_) {
            pg8::Gemm g{H, (const bf16_t*)(ws + WS_WOUTE) + (size_t)lp * D * D, MT, D, D, nullptr, nullptr, 0}; pg8::StaticOrder S; S.init(MT, D, F.G, F.bid);
            pg8::EpiRes E{lp == 0 ? xsl : (const float*)F.out, lp == 0 ? xsc : (const float*)XC, F.out, XC, modE + 2 * D};
            pg8::gemm_phase<pg8::EpiRes, pg8::StaticOrder, false, false>(F.lds, g, S, E, F.tid);
        }
        SEAM(pb + E4_GOUT);
        if (IN(pb + E5_NORM)) for (int rep_ = 0; rep_ < NREP(E5_NORM); ++rep_) {
            RowPass P{}; P.sl = F.out; P.sc = XC; P.gain = F.in[I_NFFN] + le * D; P.shift = modE + 3 * D; P.scale = modE + 4 * D; P.H = H; P.nrows = MT;
            row_pass<false, false, false>(F, P);
        }
        SEAM(pb + E5_NORM);
        if (IN(pb + E6_UP)) for (int rep_ = 0; rep_ < NREP(E6_UP); ++rep_) {
            pg8::Gemm g{H, (const bf16_t*)(ws + WS_W13) + (size_t)lp * NFF2 * D, MT, NFF2, D, nullptr, nullptr, 0}; pg8::StaticOrder S; S.init(MT, NFF2, F.G, F.bid);
            pg8::EpiSwiglu E{(bf16_t*)(ws + WS_HID), DFF};
            pg8::gemm_phase<pg8::EpiSwiglu, pg8::StaticOrder, true, false>(F.lds, g, S, E, F.tid);
        }
        SEAM(pb + E6_UP);
        if (IN(pb + E7_DOWN)) for (int rep_ = 0; rep_ < NREP(E7_DOWN); ++rep_) {
            pg8::Gemm g{(const bf16_t*)(ws + WS_HID), (const bf16_t*)(ws + WS_W2) + (size_t)lp * D * DFF, MT, D, DFF, nullptr, nullptr, 0}; pg8::StaticOrder S; S.init(MT, D, F.G, F.bid);
            pg8::EpiRes E{F.out, XC, F.out, XC, modE + 5 * D};
            pg8::gemm_phase<pg8::EpiRes, pg8::StaticOrder, false, false>(F.lds, g, S, E, F.tid);
        }
        SEAM(pb + E7_DOWN);
        const bool lastl = lp == 1;
        if (IN(pb + O1_NORM)) for (int rep_ = 0; rep_ < NREP(O1_NORM); ++rep_) {
            RowPass P{}; P.sl = F.out; P.sc = XC; P.gain = F.in[I_NMIX] + lo_ * D; P.shift = modO + 0 * D; P.scale = modO + 1 * D; P.H = H; P.nrows = MT;
            row_pass<false, false, false>(F, P);
        }
        SEAM(pb + O1_NORM);
        if (IN(pb + O2_GIN)) for (int rep_ = 0; rep_ < NREP(O2_GIN); ++rep_) {
            pg8::Gemm g{H, (const bf16_t*)(ws + WS_WINO) + (size_t)lp * NREC * D, MT, NREC, D, nullptr, nullptr, 0}; pg8::StaticOrder S; S.init(MT, NREC, F.G, F.bid);
            pg8::EpiOddIn E{(bf16_t*)(ws + WS_P5), (const float*)(ws + WS_LB) + lp * 2048};
            pg8::gemm_phase<pg8::EpiOddIn, pg8::StaticOrder, true, false>(F.lds, g, S, E, F.tid);
        }
        SEAM(pb + O2_GIN);
        if (IN(pb + O3_SCAN1)) for (int rep_ = 0; rep_ < NREP(O3_SCAN1); ++rep_) {
            const bf16_t* P5 = (const bf16_t*)(ws + WS_P5); float* SST = (float*)(ws + WS_SST); float* EG = (float*)(ws + WS_EG); float* S0 = (float*)(ws + WS_S0);
            const float* gain = F.in[I_RNORM] + lp * D;
            for (int it = F.bid; it < 16 + 2048; it += F.G) {
                if (it < 16) { const int b = it >> 3, h = it & 7;
                    scan_pass3_item(F, P5, (size_t)ML + b * TCX, h, nullptr, nullptr, S0 + (size_t)((b * 8 + h) * 2 + 0) * 16384, S0 + (size_t)((b * 8 + h) * 2 + 1) * 16384, gain, H, !lastl);
                } else { const int i2 = it - 16, seg = i2 & 63, dir = (i2 >> 6) & 1, h = (i2 >> 7) & 7, b = i2 >> 10;
                    scan_pass1_item(F, P5, b, h, dir, seg, SST, EG); }
            }
        }
        SEAM(pb + O3_SCAN1);
        if (IN(pb + O4_CARRY)) for (int rep_ = 0; rep_ < NREP(O4_CARRY); ++rep_) { scan_carry(F); moe_convert(F, lp); }
        SEAM(pb + O4_CARRY);
        if (IN(pb + O5_SCAN3)) for (int rep_ = 0; rep_ < NREP(O5_SCAN3); ++rep_) {
            const bf16_t* P5 = (const bf16_t*)(ws + WS_P5); const float* SST = (const float*)(ws + WS_SST);
            const float* gain = F.in[I_RNORM] + lp * D;
            for (int it = F.bid; it < 1024; it += F.G) { const int seg = it & 63, h = (it >> 6) & 7, b = it >> 9; const int ch0 = (b * 8 + h) * 2;
                scan_pass3_item(F, P5, (size_t)b * TL + (size_t)seg * SEGL, h, SST + ((size_t)ch0 * NSEG + seg) * 16384, SST + ((size_t)(ch0 + 1) * NSEG + seg) * 16384, nullptr, nullptr, gain, H, true); }
        }
        SEAM(pb + O5_SCAN3);
        if (IN(pb + O6_GOUT)) for (int rep_ = 0; rep_ < NREP(O6_GOUT); ++rep_) {
            pg8::Gemm g{H, (const bf16_t*)(ws + WS_WOUTO) + (size_t)lp * D * D, MT, D, D, nullptr, nullptr, 0}; pg8::StaticOrder S; S.init(MT, D, F.G, F.bid);
            pg8::EpiRes E{F.out, XC, F.out, XC, modO + 2 * D};
            pg8::gemm_phase<pg8::EpiRes, pg8::StaticOrder, false, false>(F.lds, g, S, E, F.tid);
        }
        SEAM(pb + O6_GOUT);
        const int nrm = lastl ? ML : MT;
        if (IN(pb + O7_NORM)) for (int rep_ = 0; rep_ < NREP(O7_NORM); ++rep_) {
            RowPass P{}; P.sl = F.out; P.sc = XC; P.gain = F.in[I_NFFN] + lo_ * D; P.shift = modO + 3 * D; P.scale = modO + 4 * D; P.H = H; P.nrows = nrm;
            P.rw = F.in[I_RW] + (size_t)lp * D * NE; P.tope = (int*)(ws + WS_TOPE); P.toppo = (float*)(ws + WS_TOPP); P.rank = (int*)(ws + WS_RANK); P.cnt = (int*)(ws + WS_CNT);
            row_pass<false, true, false>(F, P);
        }
        SEAM(pb + O7_NORM);
        if (IN(pb + O8_SLOTS)) for (int rep_ = 0; rep_ < NREP(O8_SLOTS); ++rep_) moe_slots(F, nrm);
        SEAM(pb + O8_SLOTS);
        if (IN(pb + O9_MUP)) for (int rep_ = 0; rep_ < NREP(O9_MUP); ++rep_) {
            const int* tilex = (const int*)(ws + WS_TILEX); const int ntiles = tilex[0];
            pg8::Gemm g{H, (const bf16_t*)(ws + WS_W13M), ntiles * 256, NEX2, D, (const int*)(ws + WS_SLOTROW), tilex + 16, (size_t)NEX2 * D}; pg8::StaticOrder S; S.init(ntiles * 256, NEX2, F.G, F.bid);
            pg8::EpiSwiglu E{(bf16_t*)(ws + WS_HIDM), DEX};
            pg8::gemm_phase<pg8::EpiSwiglu, pg8::StaticOrder, true, true>(F.lds, g, S, E, F.tid);
        }
        SEAM(pb + O9_MUP);
        if (IN(pb + O10_MDOWN)) for (int rep_ = 0; rep_ < NREP(O10_MDOWN); ++rep_) {
            const int* tilex = (const int*)(ws + WS_TILEX); const int ntiles = tilex[0];
            pg8::Gemm g{(const bf16_t*)(ws + WS_HIDM), (const bf16_t*)(ws + WS_W2M), ntiles * 256, D, DEX, nullptr, tilex + 16, (size_t)D * DEX}; pg8::StaticOrder S; S.init(ntiles * 256, D, F.G, F.bid);
            pg8::EpiMoeDown E{YE, (const int*)(ws + WS_SLOTDST)};
            pg8::gemm_phase<pg8::EpiMoeDown, pg8::StaticOrder, true, false>(F.lds, g, S, E, F.tid);
        }
        SEAM(pb + O10_MDOWN);
    }
    if (IN(PH_FINAL)) {
        RowPass P{}; P.sl = F.out; P.sc = XC; P.dl = F.out; P.dc = XC; P.gain = F.in[I_NOUT]; P.nrows = ML; P.YE = YE; P.topp = (const float*)(ws + WS_TOPP); P.gatef = mods + (size_t)3 * 3 * 6144 + 5 * D; P.fout = F.out;
        row_pass<true, false, true>(F, P);
    }
#undef IN
#undef SEAM
}

extern "C" void kernel_launch(void* const* d_in, const int* in_sizes, int n_in, void* d_out, int out_size, void* d_ws, size_t ws_size, hipStream_t stream) {
    static int grid = 0;
    if (grid == 0) {
        if (n_in != 24 || out_size != ML * D || ws_size < WS_END) { fprintf(stderr, "kernel_launch: unexpected problem (n_in %d, out %d, ws %zu < %zu)\n", n_in, out_size, ws_size, (size_t)WS_END); grid = -1; return; }
        int dev = 0, cus = 0, per_cu = 0;
        if (hipGetDevice(&dev) != hipSuccess || hipDeviceGetAttribute(&cus, hipDeviceAttributeMultiprocessorCount, dev) != hipSuccess) { grid = -1; return; }
        if (hipFuncSetAttribute((const void*)fwd_kernel, hipFuncAttributeMaxDynamicSharedMemorySize, LDS_BYTES) != hipSuccess) { fprintf(stderr, "kernel_launch: hipFuncSetAttribute failed\n"); grid = -1; return; }
        if (hipOccupancyMaxActiveBlocksPerMultiprocessor(&per_cu, (const void*)fwd_kernel, 512, LDS_BYTES) != hipSuccess || per_cu < 1) fprintf(stderr, "kernel_launch: occupancy query says %d\n", per_cu);
        (void)hipGetLastError();
        grid = cus;
    }
    if (grid < 0) return;
    (void)hipMemsetAsync((char*)d_ws + WS_CTL, 0, CTL_BYTES, stream);
    Args a{};
    for (int i = 0; i < 24; ++i) a.in[i] = (const float*)d_in[i];
    a.out = (float*)d_out; a.ws = (unsigned char*)d_ws;
#if PER_PHASE_LAUNCH
    for (int p = 0; p < NPHASE && p < PHASE_LIMIT; ++p) { a.ph_lo = p; a.ph_hi = p + 1; hipLaunchKernelGGL(fwd_kernel, dim3(grid), dim3(512), LDS_BYTES, stream, a); }
#else
    a.ph_lo = 0; a.ph_hi = NPHASE; hipLaunchKernelGGL(fwd_kernel, dim3(grid), dim3(512), LDS_BYTES, stream, a);
#endif
}
```

```cpp
#include <hip/hip_runtime.h>
#include <cstdio>
#include <cstdint>

#ifndef PER_PHASE_LAUNCH
#define PER_PHASE_LAUNCH 0
#endif
#ifndef REP_MASK
#define REP_MASK 0
#endif
#define NREP(x) (((REP_MASK >> (x)) & 1) ? 2 : 1)
#ifndef PHASE_LIMIT
#define PHASE_LIMIT 100
#endif
#ifndef P0_MASK
#define P0_MASK 63
#endif
#ifndef P0_T
#define P0_T 127
#endif

#define LAS __attribute__((address_space(3)))
typedef unsigned short bf16_t;
typedef short bf16x8 __attribute__((ext_vector_type(8)));
typedef short s16x4 __attribute__((ext_vector_type(4)));
typedef float f32x4 __attribute__((ext_vector_type(4)));
typedef float f32x2 __attribute__((ext_vector_type(2)));
typedef unsigned u32x4 __attribute__((ext_vector_type(4)));
typedef unsigned u32x2 __attribute__((ext_vector_type(2)));

constexpr int D = 1024, TL = 16384, ML = 32768, TCX = 256, MC = 512, MT = 33280;
constexpr int NEIN = 2048, DFF = 2816, NFF2 = 5632, NREC = 5120, DEX = 3584, NEX2 = 7168, NE = 8;
constexpr int NSEG = 64, SEGL = 256, CH = 32, NCHAIN = 32;
constexpr int MAXTILES = 268, NITEM16 = MT / 16;
constexpr float EPS = 1e-6f;

constexpr size_t MiB = 1u << 20, KiB = 1u << 10;
constexpr size_t WS_CTL = 0, CTL_BYTES = 1 * MiB;
constexpr size_t WS_MODS = 1 * MiB, WS_LB = 1 * MiB + 512 * KiB;
constexpr size_t WS_FA = 2 * MiB, WS_FC = 2 * MiB + 128 * KiB, WS_FX = 2 * MiB + 256 * KiB, WS_GW = 2 * MiB + 512 * KiB;
constexpr size_t WS_XC = 3 * MiB;
constexpr size_t WS_TOPE = 5 * MiB, WS_TOPP = 5 * MiB + 512 * KiB, WS_RANK = 6 * MiB, WS_CNT = 6 * MiB + 512 * KiB, WS_TILEX = 6 * MiB + 768 * KiB, WS_SLOTROW = 7 * MiB, WS_SLOTDST = 7 * MiB + 512 * KiB;
constexpr size_t WS_WINE = 8 * MiB, WS_WOUTE = 16 * MiB, WS_WINO = 20 * MiB, WS_WOUTO = 40 * MiB, WS_W13 = 44 * MiB, WS_W2 = 66 * MiB;
constexpr size_t WS_W13M = 80 * MiB, WS_W2M = 192 * MiB;
constexpr size_t WS_H = 248 * MiB, WS_YE = 314 * MiB, WS_BIG = 444 * MiB;
constexpr size_t WS_PZUV = WS_BIG, WS_UP = WS_BIG + 130 * MiB, WS_HID = WS_BIG, WS_P5 = WS_BIG, WS_SST = WS_BIG + 325 * MiB, WS_EG = WS_BIG + 453 * MiB, WS_S0 = WS_BIG + 454 * MiB, WS_HIDM = WS_BIG;
constexpr size_t WS_END = WS_BIG + 469 * MiB;
static_assert(WS_W2 + (size_t)2 * D * DFF * 2 <= WS_W13M, "static weights");
static_assert(WS_W2M + (size_t)NE * D * DEX * 2 <= WS_H && WS_H + (size_t)MT * D * 2 <= WS_YE && WS_YE + (size_t)MT * 2 * D * 2 <= WS_BIG, "ws map");
static_assert((size_t)MAXTILES * 256 * DEX * 2 <= 469 * MiB && (size_t)MT * NREC * 2 <= 325 * MiB && (size_t)MT * NEIN * 2 <= 130 * MiB, "big region");

constexpr int LDS_BYTES = 147456, MISC_OFF = 147456 - 256;
constexpr int XRS = 288;

__device__ __forceinline__ unsigned f2bf(float f) { unsigned u = __builtin_bit_cast(unsigned, f); return (u + 0x7fffu + ((u >> 16) & 1u)) >> 16; }
__device__ __forceinline__ unsigned pk2(float lo, float hi) { return f2bf(lo) | (f2bf(hi) << 16); }
__device__ __forceinline__ float bf2f(unsigned short b) { return __builtin_bit_cast(float, (unsigned)b << 16); }
__device__ __forceinline__ float bflo(unsigned w) { return __builtin_bit_cast(float, w << 16); }
__device__ __forceinline__ float bfhi(unsigned w) { return __builtin_bit_cast(float, w & 0xffff0000u); }
__device__ __forceinline__ float wave_sum(float v) {
#pragma unroll
    for (int o = 1; o < 64; o <<= 1) v += __shfl_xor(v, o);
    return v;
}
__device__ __forceinline__ float siluf(float a) { return a * __builtin_amdgcn_rcpf(1.0f + __expf(-a)); }
#define LDS_WAIT() asm volatile("s_waitcnt lgkmcnt(0)" ::: "memory")
#define VM_WAIT() asm volatile("s_waitcnt vmcnt(0)" ::: "memory")

#define XB_TMO      128
#define XB_XCNT(j)  (256  + 64 * (j))
#define XB_XSUB(j)  (1280 + 64 * (j))
#define XB_XGEN(j)  (2304 + 64 * (j))
#define XB_TOP      3328
#define XB_TOPGEN   3392
#define XCD_BAR_WORDS 3456
#define XB_SPIN_CAP (1u << 18)
__device__ __forceinline__ unsigned xb_ld(unsigned* p)              { return __hip_atomic_load(p, __ATOMIC_RELAXED, __HIP_MEMORY_SCOPE_AGENT); }
__device__ __forceinline__ unsigned xb_add(unsigned* p, unsigned v) { return __hip_atomic_fetch_add(p, v, __ATOMIC_RELAXED, __HIP_MEMORY_SCOPE_AGENT); }
__device__ __forceinline__ unsigned xb_xcc_id() { return (unsigned)__builtin_amdgcn_s_getreg((3 << 11) | 20) & 0xFu; }
#define XB_SPIN(cond, bar) do { unsigned _sp = 0; while (cond) { __builtin_amdgcn_s_sleep(1); \
    if ((++_sp & 255u) == 0u) { if (xb_ld(&(bar)[XB_TMO])) break; if (_sp > XB_SPIN_CAP) { atomicAdd(&(bar)[XB_TMO], 1u); break; } } } } while (0)
struct XcdBarrier { unsigned* bar; unsigned x; volatile LAS unsigned* st; };
__device__ __forceinline__ XcdBarrier xcd_barrier_post(unsigned* bar, volatile LAS unsigned* st) {
    XcdBarrier b; b.bar = bar; b.x = xb_xcc_id(); b.st = st;
    if (threadIdx.x == 0) (void)xb_add(&bar[XB_XCNT(b.x)], 1u);
    return b;
}
__device__ __forceinline__ void xcd_barrier_complete(unsigned* bar, unsigned x, unsigned& nloc, unsigned& nx) {
    const unsigned G = gridDim.x * gridDim.y * gridDim.z;
    unsigned sum, cnt, mine, sp = 0u;
    for (;;) {
        sum = 0u; cnt = 0u; mine = 0u;
#pragma unroll
        for (unsigned j = 0; j < 16; ++j) { const unsigned c = xb_ld(&bar[XB_XCNT(j)]); sum += c; cnt += (c > 0u) ? 1u : 0u; mine = (j == x) ? c : mine; }
        if (sum == G) break;
        __builtin_amdgcn_s_sleep(1);
        if ((++sp & 255u) == 0u) { if (xb_ld(&bar[XB_TMO])) break; if (sp > XB_SPIN_CAP) { atomicAdd(&bar[XB_TMO], 1u); break; } }
    }
    nloc = mine > 0u ? mine : 1u; nx = cnt > 0u ? cnt : 1u;
}
__device__ __forceinline__ void xcd_barrier(const XcdBarrier& b) {
    asm volatile("s_waitcnt vmcnt(0)" ::: "memory");
    __syncthreads();
    if (threadIdx.x == 0) {
        unsigned* bar = b.bar;
        __builtin_amdgcn_s_waitcnt(0);
        unsigned nloc = b.st[0], nx = b.st[1];
        if (nloc == 0u) { xcd_barrier_complete(bar, b.x, nloc, nx); b.st[0] = nloc; b.st[1] = nx; }
        const unsigned old = xb_add(&bar[XB_XSUB(b.x)], 1u);
        const unsigned gen = old / nloc;
        if (old + 1u == (gen + 1u) * nloc) {
            __builtin_amdgcn_fence(__ATOMIC_RELEASE, "agent");
            asm volatile("s_waitcnt vmcnt(0)" ::: "memory");
            const unsigned og = xb_add(&bar[XB_TOP], 1u);
            const unsigned tg = og / nx;
            if (og + 1u == (tg + 1u) * nx) xb_add(&bar[XB_TOPGEN], 1u);
            else XB_SPIN(xb_ld(&bar[XB_TOPGEN]) == tg, bar);
            __builtin_amdgcn_fence(__ATOMIC_ACQUIRE, "agent");
            xb_add(&bar[XB_XGEN(b.x)], 1u);
            asm volatile("s_waitcnt vmcnt(0)" ::: "memory");
        } else {
            XB_SPIN(xb_ld(&bar[XB_XGEN(b.x)]) == gen, bar);
            __builtin_amdgcn_fence(__ATOMIC_ACQUIRE, "agent");
            asm volatile("s_waitcnt vmcnt(0)" ::: "memory");
        }
    }
    __syncthreads();
}

namespace pg8 {
constexpr int BM = 256, BK = 64, HALF = 128, HTB = HALF * BK * 2, STAGE_BYTES = 8 * HTB, NXCD = 8, WGM = 8;
__host__ __device__ __forceinline__ int lds_byte(int r, int c) { const int st = (r >> 4) * 2 + (c >> 5), rr = r & 15, cc = c & 31, ob = rr * 64 + cc * 2; return st * 1024 + (ob ^ (((ob >> 9) & 1) << 5)); }
__host__ __device__ __forceinline__ void stage_rc(int b, int& R, int& C) { const int st = b / 1024, sb = b % 1024, swz = sb ^ (((sb >> 9) & 1) << 5); R = (st >> 1) * 16 + swz / 64; C = (st & 1) * 32 + (swz % 64) / 2; }
__host__ __device__ __forceinline__ int perm32(int rho) { const int n = rho >> 4, i = rho & 15; return 8 * (i >> 2) + 4 * n + (i & 3); }
struct Unit { int pm, pn; };
struct Gemm { const bf16_t* A; const bf16_t* Bt; int M, N, K; const int* arow; const int* grp; size_t gstride; };
struct StaticOrder {
    int nM, nN, nwg, G, c;
    __host__ __device__ void init(int M, int N, int G_, int c_) { nM = M / BM; nN = N / BM; nwg = nM * nN; G = G_; c = c_; }
    __host__ __device__ bool next(int i, Unit& u) const {
        const long L = (long)i * G + c; if (L >= nwg) return false;
        int wgid = (int)L; { const int q = nwg / NXCD, r = nwg % NXCD, xcd = wgid % NXCD, off = wgid / NXCD; wgid = (xcd < r ? xcd * (q + 1) : r * (q + 1) + (xcd - r) * q) + off; }
        const int nig = WGM * nN, gid = wgid / nig, fm = gid * WGM, gsz = (nM - fm) < WGM ? (nM - fm) : WGM;
        u.pm = fm + ((wgid % nig) % gsz); u.pn = (wgid % nig) / gsz; return true;
    }
};
__device__ __forceinline__ unsigned cvt_pk_bf16(float lo, float hi) { unsigned r; asm volatile("v_cvt_pk_bf16_f32 %0, %1, %2" : "=v"(r) : "v"(lo), "v"(hi)); return r; }
__device__ __forceinline__ f32x2 gelu_pk(f32x2 v) {
    const f32x2 av = __builtin_elementwise_abs(v), d = av * 0.2316418882f + 1.0f;
    f32x2 t; t.x = __builtin_amdgcn_rcpf(d.x); t.y = __builtin_amdgcn_rcpf(d.y);
    f32x2 q = t * 0.5307027145f + (-0.7265760135f); q = q * t + 0.7107068705f; q = q * t + (-0.142248368f); q = q * t + 0.127414796f; q = q * t;
    const f32x2 s = (v * v) * (-0.72134752044f);
    f32x2 e; e.x = __builtin_amdgcn_exp2f(s.x); e.y = __builtin_amdgcn_exp2f(s.y);
    const f32x2 m = v * (q * e), r = v - m;
    f32x2 o; o.x = v.x < 0.f ? m.x : r.x; o.y = v.y < 0.f ? m.y : r.y; return o;
}
template <class Epi, class Sched, bool ALIGN_EPI, bool GATHER>
__device__ __forceinline__ void gemm_phase(LAS unsigned char* lds, const Gemm g, const Sched& S, const Epi& E, const int tid) {
    const int wid = __builtin_amdgcn_readfirstlane(tid >> 6), lane = tid & 63, wr = wid >> 2, wc = wid & 3, fr = lane & 15, fq = lane >> 4;
    const int K = g.K, nt = K / BK;
    unsigned voffA[2], voffB[2];
    unsigned voffA1[2];
#pragma unroll
    for (int i = 0; i < 2; ++i) { int R, C; stage_rc(tid * 16 + i * 8192, R, C); const int Rb = Epi::PERM ? ((R & ~31) + perm32(R & 31)) : R;
        voffA[i] = (unsigned)(R * K + C) * 2u; voffA1[i] = voffA[i]; voffB[i] = (unsigned)(Rb * K + C) * 2u; }
    const size_t kstep = (size_t)(BK * 2);
    const size_t hstep = (size_t)HALF * K * 2;
    const size_t tstep = 2 * hstep;
    const unsigned ldsw = (unsigned)wid * 1024u;
    const int aoff = lds_byte(wr * 64 + fr, fq * 8), boff = lds_byte(wc * 32 + fr, fq * 8);
#define PG8_SA(b, h) (((b) * 2 + (h)) * HTB)
#define PG8_SB(b, h) ((4 + (b) * 2 + (h)) * HTB)
#define PG8_STAGE(bufoff, gbase, voff) do { _Pragma("unroll") for (int _i = 0; _i < 2; ++_i) \
        __builtin_amdgcn_global_load_lds((const unsigned*)((const char*)(gbase) + (voff)[_i]), (LAS unsigned*)(lds + (bufoff) + ldsw + _i * 8192), 16, 0, 0); } while (0)
#define PG8_LDA(dst, b, h) do { _Pragma("unroll") for (int m = 0; m < 4; ++m) _Pragma("unroll") for (int k = 0; k < 2; ++k) dst[m][k] = *(const LAS bf16x8*)(lds + PG8_SA(b, h) + aoff + m * 2048 + k * 1024); } while (0)
#define PG8_LDB(dst, b, h) do { _Pragma("unroll") for (int n = 0; n < 2; ++n) _Pragma("unroll") for (int k = 0; k < 2; ++k) dst[n][k] = *(const LAS bf16x8*)(lds + PG8_SB(b, h) + boff + n * 2048 + k * 1024); } while (0)
#define PG8_MMA(ai, bj, At, Bt) do { __builtin_amdgcn_s_setprio(1); _Pragma("unroll") for (int m = 0; m < 4; ++m) _Pragma("unroll") for (int n = 0; n < 2; ++n) _Pragma("unroll") for (int k = 0; k < 2; ++k) \
        acc[ai][bj][m][n] = __builtin_amdgcn_mfma_f32_16x16x32_bf16(Bt[n][k], At[m][k], acc[ai][bj][m][n], 0, 0, 0); __builtin_amdgcn_s_setprio(0); } while (0)
#define PG8_WAIT_V(n) asm volatile("s_waitcnt vmcnt(" #n ")" ::: "memory")
#define PG8_WAIT_L(n) asm volatile("s_waitcnt lgkmcnt(" #n ")" ::: "memory")
#define PG8_BAR __builtin_amdgcn_s_barrier()
#define PG8_SCHED __builtin_amdgcn_sched_barrier(0)
#define PG8_GOFF(u, v0, v1) do { _Pragma("unroll") for (int _i = 0; _i < 2; ++_i) { int R_, C_; stage_rc(tid * 16 + _i * 8192, R_, C_); \
        const int r0_ = g.arow[(u).pm * BM + R_], r1_ = g.arow[(u).pm * BM + HALF + R_]; v0[_i] = (unsigned)(r0_ * K + C_) * 2u; v1[_i] = (unsigned)(r1_ * K + C_) * 2u; } } while (0)
#define PG8_BBASE(u) ((const char*)g.Bt + (g.grp ? (size_t)g.grp[(u).pm] * g.gstride * 2 : (size_t)0) + (size_t)(u).pn * tstep)
    Unit cur, nxt; int ui = 0;
    if (!S.next(0, cur)) return;
    f32x4 acc[2][2][4][2];
#pragma unroll
    for (int a = 0; a < 2; ++a)
#pragma unroll
        for (int b = 0; b < 2; ++b)
#pragma unroll
            for (int m = 0; m < 4; ++m)
#pragma unroll
                for (int n = 0; n < 2; ++n) acc[a][b][m][n] = (f32x4){0.f, 0.f, 0.f, 0.f};
    bf16x8 At[4][2], B0[2][2], B1[2][2];
    const char* cA = GATHER ? (const char*)g.A : (const char*)g.A + (size_t)cur.pm * tstep;
    const size_t ah = GATHER ? (size_t)0 : hstep;
    if constexpr (GATHER) PG8_GOFF(cur, voffA, voffA1);
    const char* cB = PG8_BBASE(cur);
    PG8_STAGE(PG8_SB(0, 0), cB, voffB); PG8_STAGE(PG8_SA(0, 0), cA, voffA); PG8_STAGE(PG8_SB(0, 1), cB + hstep, voffB); PG8_STAGE(PG8_SA(0, 1), cA + ah, voffA1);
    if (wr == 1) PG8_BAR;
    PG8_WAIT_V(4); PG8_BAR;
    PG8_STAGE(PG8_SB(1, 0), cB + kstep, voffB); PG8_STAGE(PG8_SA(1, 0), cA + kstep, voffA); PG8_STAGE(PG8_SB(1, 1), cB + hstep + kstep, voffB);
    PG8_WAIT_V(6); PG8_BAR;
    for (;;) {
        const bool has_next = S.next(ui + 1, nxt);
        const char* nA = (GATHER || !has_next) ? cA : (const char*)g.A + (size_t)nxt.pm * tstep; const char* nB = has_next ? PG8_BBASE(nxt) : cB;
        for (int t = 0; t < nt; t += 2) {
            const bool last = (t == nt - 2);
            const char* a1 = cA + (size_t)(t + 1) * kstep;
            const char* a2 = last ? nA : cA + (size_t)(t + 2) * kstep; const char* b2 = last ? nB : cB + (size_t)(t + 2) * kstep;
            const char* a3 = a2 + kstep; const char* b3 = b2 + kstep;
            PG8_LDB(B0, 0, 0); PG8_SCHED; PG8_LDA(At, 0, 0); PG8_STAGE(PG8_SA(1, 1), a1 + ah, voffA1);
            if constexpr (GATHER) { if (last && has_next) PG8_GOFF(nxt, voffA, voffA1); }
            PG8_WAIT_L(8); PG8_BAR; PG8_WAIT_L(0); PG8_MMA(0, 0, At, B0); PG8_BAR; PG8_SCHED;
            PG8_LDB(B1, 0, 1); PG8_STAGE(PG8_SB(0, 0), b2, voffB);
            PG8_BAR; PG8_WAIT_L(0); PG8_MMA(0, 1, At, B1); PG8_BAR;
            PG8_LDA(At, 0, 1); PG8_STAGE(PG8_SA(0, 0), a2, voffA);
            PG8_BAR; PG8_WAIT_L(0); PG8_MMA(1, 0, At, B0); PG8_BAR; PG8_SCHED;
            PG8_STAGE(PG8_SB(0, 1), b2 + hstep, voffB);
            PG8_WAIT_V(6); PG8_BAR; PG8_MMA(1, 1, At, B1); PG8_BAR;
            PG8_LDB(B0, 1, 0); PG8_SCHED; PG8_LDA(At, 1, 0); PG8_STAGE(PG8_SA(0, 1), a2 + ah, voffA1);
            PG8_WAIT_L(8); PG8_BAR; PG8_WAIT_L(0); PG8_MMA(0, 0, At, B0); PG8_BAR; PG8_SCHED;
            PG8_LDB(B1, 1, 1); PG8_STAGE(PG8_SB(1, 0), b3, voffB);
            PG8_BAR; PG8_WAIT_L(0); PG8_MMA(0, 1, At, B1); PG8_BAR;
            PG8_LDA(At, 1, 1); PG8_STAGE(PG8_SA(1, 0), a3, voffA);
            PG8_BAR; PG8_WAIT_L(0); PG8_MMA(1, 0, At, B0); PG8_BAR; PG8_SCHED;
            PG8_STAGE(PG8_SB(1, 1), b3 + hstep, voffB);
            PG8_WAIT_V(6); PG8_BAR; PG8_MMA(1, 1, At, B1); PG8_BAR;
        }
        if constexpr (ALIGN_EPI) { if (wr == 0) PG8_BAR; }
        E(acc, cur, wr, wc, fr, fq);
        if (!has_next) break;
#pragma unroll
        for (int a = 0; a < 2; ++a)
#pragma unroll
            for (int b = 0; b < 2; ++b)
#pragma unroll
                for (int m = 0; m < 4; ++m)
#pragma unroll
                    for (int n = 0; n < 2; ++n) acc[a][b][m][n] = (f32x4){0.f, 0.f, 0.f, 0.f};
        cur = nxt; cA = nA; cB = nB; ++ui;
        if constexpr (ALIGN_EPI) { if (wr == 1) PG8_BAR; }
    }
    PG8_WAIT_V(0);
    if constexpr (!ALIGN_EPI) { if (wr == 0) PG8_BAR; }
    PG8_BAR;
#undef PG8_SA
#undef PG8_SB
#undef PG8_STAGE
#undef PG8_LDA
#undef PG8_LDB
#undef PG8_MMA
#undef PG8_WAIT_V
#undef PG8_WAIT_L
#undef PG8_BAR
#undef PG8_SCHED
#undef PG8_GOFF
#undef PG8_BBASE
}

struct EpiEvenIn {
    static constexpr bool PERM = true;
    bf16_t* O;
    __device__ __forceinline__ void operator()(const f32x4 (&acc)[2][2][4][2], const Unit& u, int wr, int wc, int fr, int fq) const {
        const int row0 = u.pm * BM + wr * 64 + fr, col0 = u.pn * BM + wc * 32 + 8 * fq; const bool act = u.pn >= 4;
#pragma unroll
        for (int ai = 0; ai < 2; ++ai)
#pragma unroll
            for (int m = 0; m < 4; ++m) { bf16_t* rowp = O + (size_t)(row0 + ai * HALF + m * 16) * NEIN + col0;
#pragma unroll
                for (int bj = 0; bj < 2; ++bj) { f32x4 v0 = acc[ai][bj][m][0], v1 = acc[ai][bj][m][1];
                    if (act) { f32x2 a = gelu_pk((f32x2){v0[0], v0[1]}), b = gelu_pk((f32x2){v0[2], v0[3]}), c = gelu_pk((f32x2){v1[0], v1[1]}), d = gelu_pk((f32x2){v1[2], v1[3]});
                        v0 = (f32x4){a.x, a.y, b.x, b.y}; v1 = (f32x4){c.x, c.y, d.x, d.y}; }
                    u32x4 w; w.x = cvt_pk_bf16(v0[0], v0[1]); w.y = cvt_pk_bf16(v0[2], v0[3]); w.z = cvt_pk_bf16(v1[0], v1[1]); w.w = cvt_pk_bf16(v1[2], v1[3]);
                    *(u32x4*)(rowp + bj * HALF) = w; } }
    }
};
struct EpiRes {
    static constexpr bool PERM = false;
    const float* sl; const float* sc; float* dl; float* dc; const float* gate;
    __device__ __forceinline__ void operator()(const f32x4 (&acc)[2][2][4][2], const Unit& u, int wr, int wc, int fr, int fq) const {
        const int col0 = u.pn * BM + wc * 32 + 4 * fq;
        const bool isc = u.pm >= 128; const int ms = isc ? 2 : (u.pm >= 64 ? 1 : 0);
        const size_t rbase = isc ? (size_t)(u.pm - 128) * BM : (size_t)u.pm * BM;
        const float* src = (isc ? sc : sl) + rbase * D; float* dst = (isc ? dc : dl) + rbase * D;
        f32x4 gv[2][2];
#pragma unroll
        for (int bj = 0; bj < 2; ++bj)
#pragma unroll
            for (int n = 0; n < 2; ++n) gv[bj][n] = *(const f32x4*)(gate + ms * 6144 + col0 + bj * HALF + n * 16);
#pragma unroll
        for (int ai = 0; ai < 2; ++ai)
#pragma unroll
            for (int m = 0; m < 4; ++m) { const size_t off = (size_t)(ai * HALF + wr * 64 + m * 16 + fr) * D + col0;
#pragma unroll
                for (int bj = 0; bj < 2; ++bj)
#pragma unroll
                    for (int n = 0; n < 2; ++n) { const f32x4 xs = *(const f32x4*)(src + off + bj * HALF + n * 16); *(f32x4*)(dst + off + bj * HALF + n * 16) = xs + gv[bj][n] * acc[ai][bj][m][n]; } }
    }
};
struct EpiSwiglu {
    static constexpr bool PERM = true;
    bf16_t* O; int ldc;
    __device__ __forceinline__ void operator()(const f32x4 (&acc)[2][2][4][2], const Unit& u, int wr, int wc, int fr, int fq) const {
        const int row0 = u.pm * BM + wr * 64 + fr, col0 = u.pn * 128 + wc * 16 + 4 * fq;
#pragma unroll
        for (int ai = 0; ai < 2; ++ai)
#pragma unroll
            for (int m = 0; m < 4; ++m) { bf16_t* rowp = O + (size_t)(row0 + ai * HALF + m * 16) * ldc + col0;
#pragma unroll
                for (int bj = 0; bj < 2; ++bj) { const f32x4 a = acc[ai][bj][m][0], b = acc[ai][bj][m][1];
                    u32x2 w; w.x = cvt_pk_bf16(siluf(a[0]) * b[0], siluf(a[1]) * b[1]); w.y = cvt_pk_bf16(siluf(a[2]) * b[2], siluf(a[3]) * b[3]);
                    *(u32x2*)(rowp + bj * 64) = w; } }
    }
};
struct EpiOddIn {
    static constexpr bool PERM = true;
    bf16_t* O; const float* lb;
    __device__ __forceinline__ void operator()(const f32x4 (&acc)[2][2][4][2], const Unit& u, int wr, int wc, int fr, int fq) const {
        const int row0 = u.pm * BM + wr * 64 + fr, col0 = u.pn * BM + wc * 32 + 8 * fq; const int seg = u.pn >> 2;
        f32x4 lbv[2][2];
#pragma unroll
        for (int bj = 0; bj < 2; ++bj)
#pragma unroll
            for (int n = 0; n < 2; ++n) lbv[bj][n] = (seg == 2 || seg == 3) ? *(const f32x4*)(lb + (col0 - 2048) + bj * HALF + 4 * n) : (f32x4){0.f, 0.f, 0.f, 0.f};
#pragma unroll
        for (int ai = 0; ai < 2; ++ai)
#pragma unroll
            for (int m = 0; m < 4; ++m) { bf16_t* rowp = O + (size_t)(row0 + ai * HALF + m * 16) * NREC + col0;
#pragma unroll
                for (int bj = 0; bj < 2; ++bj) { f32x4 v[2] = {acc[ai][bj][m][0], acc[ai][bj][m][1]};
#pragma unroll
                    for (int n = 0; n < 2; ++n)
#pragma unroll
                        for (int i = 0; i < 4; ++i) { float x = v[n][i];
                            if (seg == 0) x = siluf(x) * 0.08838834764831845f;
                            else if (seg == 1) x = siluf(x);
                            else if (seg == 2 || seg == 3) { const float l = lbv[bj][n][i]; const float s = __builtin_amdgcn_rcpf(1.0f + __expf(-x)); const float f = l + (1.0f - l) * s; x = __logf(fmaxf(f, 1e-30f)); }
                            v[n][i] = x; }
                    u32x4 w; w.x = cvt_pk_bf16(v[0][0], v[0][1]); w.y = cvt_pk_bf16(v[0][2], v[0][3]); w.z = cvt_pk_bf16(v[1][0], v[1][1]); w.w = cvt_pk_bf16(v[1][2], v[1][3]);
                    *(u32x4*)(rowp + bj * HALF) = w; } }
    }
};
struct EpiMoeDown {
    static constexpr bool PERM = true;
    bf16_t* O; const int* dst;
    __device__ __forceinline__ void operator()(const f32x4 (&acc)[2][2][4][2], const Unit& u, int wr, int wc, int fr, int fq) const {
        const int row0 = u.pm * BM + wr * 64 + fr, col0 = u.pn * BM + wc * 32 + 8 * fq;
        int dd[2][4];
#pragma unroll
        for (int ai = 0; ai < 2; ++ai)
#pragma unroll
            for (int m = 0; m < 4; ++m) dd[ai][m] = dst[row0 + ai * HALF + m * 16];
#pragma unroll
        for (int ai = 0; ai < 2; ++ai)
#pragma unroll
            for (int m = 0; m < 4; ++m) { if (dd[ai][m] >= 0) { bf16_t* rowp = O + (size_t)dd[ai][m] * D + col0;
#pragma unroll
                for (int bj = 0; bj < 2; ++bj) { const f32x4 v0 = acc[ai][bj][m][0], v1 = acc[ai][bj][m][1];
                    u32x4 w; w.x = cvt_pk_bf16(v0[0], v0[1]); w.y = cvt_pk_bf16(v0[2], v0[3]); w.z = cvt_pk_bf16(v1[0], v1[1]); w.w = cvt_pk_bf16(v1[2], v1[3]);
                    *(u32x4*)(rowp + bj * HALF) = w; } } }
    }
};
}

struct Args { const float* in[24]; float* out; unsigned char* ws; int ph_lo, ph_hi; };
enum { I_X = 0, I_C, I_CTX, I_CCTX, I_WADA, I_BADA, I_NMIX, I_NFFN, I_NOUT, I_WINE, I_GW, I_GB, I_WOUTE, I_WINO, I_RLB, I_RNORM, I_WOUTO, I_F1, I_F3, I_F2, I_RW, I_M1, I_M3, I_M2 };
enum { PH_P0 = 0, PH_PAIR0 = 1, NPL = 18, PH_FINAL = 1 + 2 * NPL, NPHASE = PH_FINAL + 1 };
enum { E1_NORM = 0, E2_GIN, E3_FFTA, E3_FFTC, E4_GOUT, E5_NORM, E6_UP, E7_DOWN, O1_NORM, O2_GIN, O3_SCAN1, O4_CARRY, O5_SCAN3, O6_GOUT, O7_NORM, O8_SLOTS, O9_MUP, O10_MDOWN };

struct Ctx {
    LAS unsigned char* lds; int tid, lane, wave, G, bid, gw, NGW;
    const float* const* in; float* out; unsigned char* ws;
};

__device__ __forceinline__ void transpose_item(const float* W, int ld, int K, int N, bf16_t* WT, int mode, int roff, int item, int lane) {
    const int nblk = N / 64, kb = item / nblk, nb = item % nblk, k0 = 64 * kb, n0 = 64 * nb;
    const int c = lane & 15, kg = lane >> 4;
    const float* src = W + (size_t)(k0 + 8 * kg) * ld + n0 + 4 * c;
    f32x4 v[2][8];
#pragma unroll
    for (int hf = 0; hf < 2; ++hf)
#pragma unroll
        for (int i = 0; i < 8; ++i) v[hf][i] = __builtin_nontemporal_load((const f32x4*)(src + (size_t)(32 * hf + i) * ld));
#pragma unroll
    for (int i = 0; i < 4; ++i) { const int ng = n0 + 4 * c + i; const int drow = mode == 0 ? (roff + ng) : (((ng >> 2) << 3) + (ng & 3) + roff);
#pragma unroll
        for (int hf = 0; hf < 2; ++hf) { u32x4 o; o.x = pk2(v[hf][0][i], v[hf][1][i]); o.y = pk2(v[hf][2][i], v[hf][3][i]); o.z = pk2(v[hf][4][i], v[hf][5][i]); o.w = pk2(v[hf][6][i], v[hf][7][i]);
            *(u32x4*)(WT + (size_t)drow * K + k0 + 32 * hf + 8 * kg) = o; } }
}

__device__ __forceinline__ void p0_prologue(const Ctx& F) {
    const int tid = F.tid, lane = F.lane, wave = F.wave;
    unsigned char* ws = F.ws;
    LAS float* scond = (LAS float*)(F.lds);
    LAS float* part = (LAS float*)(F.lds + 16384);
    LAS float* ctab = (LAS float*)(F.lds + 32768);
    for (int i = tid; i < 3 * D; i += 512) { const int v = i / D, k = i % D; const float c = v < 2 ? F.in[I_C][v * D + k] : F.in[I_CCTX][k]; scond[i] = c / (1.0f + expf(-c)); }
    if (tid < 128) ctab[tid] = cosf(6.283185307179586f * (float)tid / 128.0f);
    __syncthreads();
    float* mods = (float*)(ws + WS_MODS);
    if (P0_MASK & 1)
    for (int it = F.bid; it < 4 * 48; it += F.G) {
        const int l = it / 48, cg = it % 48; const float* W = F.in[I_WADA] + (size_t)l * D * 6144 + cg * 128 + 2 * lane;
        float a0[2] = {0.f, 0.f}, a1[2] = {0.f, 0.f}, a2[2] = {0.f, 0.f};
#pragma unroll 16
        for (int kk = 0; kk < 128; ++kk) { const int k = wave * 128 + kk; const f32x2 w = __builtin_nontemporal_load((const f32x2*)(W + (size_t)k * 6144)); const float s0 = scond[k], s1 = scond[D + k], s2 = scond[2 * D + k];
            a0[0] += s0 * w.x; a0[1] += s0 * w.y; a1[0] += s1 * w.x; a1[1] += s1 * w.y; a2[0] += s2 * w.x; a2[1] += s2 * w.y; }
        part[(wave * 3 + 0) * 128 + 2 * lane] = a0[0]; part[(wave * 3 + 0) * 128 + 2 * lane + 1] = a0[1];
        part[(wave * 3 + 1) * 128 + 2 * lane] = a1[0]; part[(wave * 3 + 1) * 128 + 2 * lane + 1] = a1[1];
        part[(wave * 3 + 2) * 128 + 2 * lane] = a2[0]; part[(wave * 3 + 2) * 128 + 2 * lane + 1] = a2[1];
        __syncthreads();
        if (tid < 384) { const int v = tid / 128, c = tid % 128; float sum = 0.f;
#pragma unroll
            for (int w = 0; w < 8; ++w) sum += part[(w * 3 + v) * 128 + c];
            mods[((size_t)l * 3 + v) * 6144 + cg * 128 + c] = sum + F.in[I_BADA][l * 6144 + cg * 128 + c]; }
        __syncthreads();
    }
    const int gt = F.bid * 512 + tid, NGT = F.G * 512;
    float* LB = (float*)(ws + WS_LB);
    if (P0_MASK & 2)
    for (int i = gt; i < 4096; i += NGT) { const int j = i >> 11, r = i & 2047; float v = 0.f; if (j == 1) { const float r0 = F.in[I_RLB][r], r1 = F.in[I_RLB][2048 + r]; v = 1.0f / (1.0f + expf(r0 - r1)); v = fminf(fmaxf(v, 0.f), 1.f); } LB[i] = v; }
    bf16_t* FA = (bf16_t*)(ws + WS_FA); bf16_t* FC = (bf16_t*)(ws + WS_FC); bf16_t* FX = (bf16_t*)(ws + WS_FX); bf16_t* GW = (bf16_t*)(ws + WS_GW);
    if (P0_MASK & 4)
    for (int i = gt; i < 256 * 256; i += NGT) { const int r = i >> 8, c = i & 255, k1 = r & 127, t1 = c & 127; const float ang = 6.283185307179586f * (float)((k1 * t1) & 127) / 128.0f; float sn, cs; sincosf(ang, &sn, &cs);
        const int rr = r >> 7, cc = c >> 7; const float v = (rr == cc) ? cs : (rr == 0 ? -sn : sn); FA[i] = (bf16_t)f2bf(v); }
    if (P0_MASK & 4)
    for (int i = gt; i < 128 * 256; i += NGT) { const int k2 = i >> 8, c = i & 255, t2 = c & 127; const float ang = 6.283185307179586f * (float)((k2 * t2) & 127) / 128.0f; float sn, cs; sincosf(ang, &sn, &cs); FC[i] = (bf16_t)f2bf(c < 128 ? cs : -sn); }
    if (P0_MASK & 4)
    for (int i = gt; i < 256 * 512; i += NGT) { const int k = i >> 9, c = i & 511, t = c & 255; const float ang = 6.283185307179586f * (float)((k * t) & 255) / 256.0f; float sn, cs; sincosf(ang, &sn, &cs); FX[i] = (bf16_t)f2bf(c < 256 ? cs : -sn); }
    if (P0_MASK & 8)
    for (int i = gt; i < 2 * 4 * 128 * 128; i += NGT) GW[i] = (bf16_t)f2bf(F.in[I_GW][i]);
    bf16_t* WinE = (bf16_t*)(ws + WS_WINE);
    if (P0_MASK & 16)
    for (int it = F.gw; it < 2 * 4 * 16 * 32; it += F.NGW) {
        const int mg = it & 31, kb = (it >> 5) & 15, g = (it >> 9) & 3, j = it >> 11; const int k = kb * 64 + lane, m0 = mg * 4;
        const float* Wr = F.in[I_WINE] + (size_t)j * D * 1536 + (size_t)k * 1536 + g * 128;
        float aP[4] = {0.f, 0.f, 0.f, 0.f}, aQ[4] = {0.f, 0.f, 0.f, 0.f};
        for (int c4 = 0; c4 < 32; ++c4) { const f32x4 w = *(const f32x4*)(Wr + 4 * c4);
#pragma unroll
            for (int ci = 0; ci < 4; ++ci) { const int c = 4 * c4 + ci;
#pragma unroll
                for (int mm = 0; mm < 4; ++mm) { const int idx = (c * (m0 + mm)) & 127; aP[mm] += w[ci] * ctab[idx]; aQ[mm] += w[ci] * ctab[(idx - 32) & 127]; } } }
#pragma unroll
        for (int mm = 0; mm < 4; ++mm) { bf16_t* o = WinE + (size_t)j * NEIN * D; o[(size_t)(g * 128 + m0 + mm) * D + k] = (bf16_t)f2bf(aP[mm]); o[(size_t)(512 + g * 128 + m0 + mm) * D + k] = (bf16_t)f2bf(aQ[mm]); }
    }
    constexpr int NI_UV = 16 * 16, NI_SQ = 16 * 16, NI_INO = 16 * 80, NI_F13 = 16 * 44, NI_F2 = 44 * 16;
    constexpr int PER_J = NI_UV + NI_SQ + NI_INO + NI_SQ + 2 * NI_F13 + NI_F2;
    if (P0_MASK & 32)
    for (int it = F.gw; it < 2 * PER_J; it += F.NGW) {
        const int j = it / PER_J; int r = it % PER_J;
        const float* W; int ld, K, N, mode = 0, roff = 0; bf16_t* WT;
        if (r < NI_UV) { W = F.in[I_WINE] + (size_t)j * D * 1536 + 512; ld = 1536; K = D; N = 1024; WT = WinE + (size_t)j * NEIN * D; roff = 1024; }
        else if ((r -= NI_UV) < NI_SQ) { W = F.in[I_WOUTE] + (size_t)j * D * D; ld = D; K = D; N = D; WT = (bf16_t*)(ws + WS_WOUTE) + (size_t)j * D * D; }
        else if ((r -= NI_SQ) < NI_INO) { W = F.in[I_WINO] + (size_t)j * D * NREC; ld = NREC; K = D; N = NREC; WT = (bf16_t*)(ws + WS_WINO) + (size_t)j * NREC * D; }
        else if ((r -= NI_INO) < NI_SQ) { W = F.in[I_WOUTO] + (size_t)j * D * D; ld = D; K = D; N = D; WT = (bf16_t*)(ws + WS_WOUTO) + (size_t)j * D * D; }
        else if ((r -= NI_SQ) < NI_F13) { W = F.in[I_F1] + (size_t)j * D * DFF; ld = DFF; K = D; N = DFF; WT = (bf16_t*)(ws + WS_W13) + (size_t)j * NFF2 * D; mode = 1; }
        else if ((r -= NI_F13) < NI_F13) { W = F.in[I_F3] + (size_t)j * D * DFF; ld = DFF; K = D; N = DFF; WT = (bf16_t*)(ws + WS_W13) + (size_t)j * NFF2 * D; mode = 1; roff = 4; }
        else { r -= NI_F13; W = F.in[I_F2] + (size_t)j * DFF * D; ld = D; K = DFF; N = D; WT = (bf16_t*)(ws + WS_W2) + (size_t)j * D * DFF; }
        transpose_item(W, ld, K, N, WT, mode, roff, r, lane);
    }
}
__device__ __forceinline__ void moe_convert(const Ctx& F, int j) {
    constexpr int I_13 = 16 * 56, I_2 = 56 * 16, PER_E = 2 * I_13 + I_2;
    for (int it = F.gw; it < NE * PER_E; it += F.NGW) {
        const int e = it / PER_E; int r = it % PER_E; const size_t eo = (size_t)(j * NE + e);
        const float* W; int ld, K, N, mode = 0, roff = 0; bf16_t* WT;
        if (r < I_13) { W = F.in[I_M1] + eo * D * DEX; ld = DEX; K = D; N = DEX; WT = (bf16_t*)(F.ws + WS_W13M) + (size_t)e * NEX2 * D; mode = 1; }
        else if ((r -= I_13) < I_13) { W = F.in[I_M3] + eo * D * DEX; ld = DEX; K = D; N = DEX; WT = (bf16_t*)(F.ws + WS_W13M) + (size_t)e * NEX2 * D; mode = 1; roff = 4; }
        else { r -= I_13; W = F.in[I_M2] + eo * DEX * D; ld = D; K = DEX; N = D; WT = (bf16_t*)(F.ws + WS_W2M) + (size_t)e * D * DEX; }
        transpose_item(W, ld, K, N, WT, mode, roff, r, F.lane);
    }
}

struct RowPass {
    const float* sl; const float* sc;
    float* dl; float* dc;
    const float* gain;
    const float* shift; const float* scale;
    bf16_t* H;
    int nrows;
    const bf16_t* YE; const float* topp; const float* gatef;
    const float* rw; int* tope; float* toppo; int* rank; int* cnt;
    float* fout;
};
template <bool COMBINE, bool ROUTER, bool FINAL>
__device__ __forceinline__ void row_pass(const Ctx& F, const RowPass& P) {
    const int lane = F.lane;
    LAS float* rwl = (LAS float*)F.lds;
    if (ROUTER) { for (int i = F.tid; i < D * NE; i += 512) rwl[i] = P.rw[i]; __syncthreads(); }
    f32x4 gn[4];
#pragma unroll
    for (int j = 0; j < 4; ++j) gn[j] = *(const f32x4*)(P.gain + 4 * lane + 256 * j);
    const int nitems = P.nrows / 16;
    for (int it = F.gw; it < nitems; it += F.NGW) {
        int rc0 = 0, rc1 = 0, rc2 = 0, rc3 = 0, rc4 = 0, rc5 = 0, rc6 = 0, rc7 = 0;
        const int rbase = it * 16; const bool isc = rbase >= ML; const int ms = isc ? 2 : (rbase >= TL ? 1 : 0);
        const float* xs0 = isc ? P.sc + (size_t)(rbase - ML) * D : P.sl + (size_t)rbase * D;
        float* xd0 = nullptr; if (COMBINE && !FINAL) xd0 = isc ? P.dc + (size_t)(rbase - ML) * D : P.dl + (size_t)rbase * D;
        f32x4 sh[4], scl[4], gf[4];
#pragma unroll
        for (int j = 0; j < 4; ++j) {
            if (!FINAL) { sh[j] = *(const f32x4*)(P.shift + ms * 6144 + 4 * lane + 256 * j); scl[j] = *(const f32x4*)(P.scale + ms * 6144 + 4 * lane + 256 * j) + 1.0f; }
            if (COMBINE) gf[j] = *(const f32x4*)(P.gatef + ms * 6144 + 4 * lane + 256 * j); }
        f32x4 v[4]; u32x2 ya[4], yb[4]; float p0 = 0.f, p1 = 0.f;
#pragma unroll
        for (int j = 0; j < 4; ++j) v[j] = *(const f32x4*)(xs0 + 4 * lane + 256 * j);
        if (COMBINE) { p0 = P.topp[2 * rbase]; p1 = P.topp[2 * rbase + 1];
#pragma unroll
            for (int j = 0; j < 4; ++j) { ya[j] = *(const u32x2*)(P.YE + (size_t)(2 * rbase) * D + 4 * lane + 256 * j); yb[j] = *(const u32x2*)(P.YE + (size_t)(2 * rbase + 1) * D + 4 * lane + 256 * j); } }
        for (int rr = 0; rr < 16; ++rr) {
            const int r = rbase + rr;
            f32x4 vn[4]; u32x2 yan[4], ybn[4]; float p0n = 0.f, p1n = 0.f;
            if (rr < 15) {
#pragma unroll
                for (int j = 0; j < 4; ++j) vn[j] = *(const f32x4*)(xs0 + (size_t)(rr + 1) * D + 4 * lane + 256 * j);
                if (COMBINE) { p0n = P.topp[2 * r + 2]; p1n = P.topp[2 * r + 3];
#pragma unroll
                    for (int j = 0; j < 4; ++j) { yan[j] = *(const u32x2*)(P.YE + (size_t)(2 * r + 2) * D + 4 * lane + 256 * j); ybn[j] = *(const u32x2*)(P.YE + (size_t)(2 * r + 3) * D + 4 * lane + 256 * j); } }
            }
            if (COMBINE) {
#pragma unroll
                for (int j = 0; j < 4; ++j) { const u32x2 a = ya[j], b = yb[j];
                    f32x4 y; y[0] = p0 * bflo(a.x) + p1 * bflo(b.x); y[1] = p0 * bfhi(a.x) + p1 * bfhi(b.x); y[2] = p0 * bflo(a.y) + p1 * bflo(b.y); y[3] = p0 * bfhi(a.y) + p1 * bfhi(b.y);
                    v[j] = v[j] + gf[j] * y;
                    if (!FINAL) *(f32x4*)(xd0 + (size_t)rr * D + 4 * lane + 256 * j) = v[j]; }
            }
            float ss = 0.f;
#pragma unroll
            for (int j = 0; j < 4; ++j) ss += (v[j][0] * v[j][0] + v[j][1] * v[j][1]) + (v[j][2] * v[j][2] + v[j][3] * v[j][3]);
            const float rstd = rsqrtf(wave_sum(ss) * (1.0f / D) + EPS);
            if (FINAL) {
#pragma unroll
                for (int j = 0; j < 4; ++j) *(f32x4*)(P.fout + (size_t)r * D + 4 * lane + 256 * j) = v[j] * rstd * gn[j];
            } else {
                f32x4 h[4];
#pragma unroll
                for (int j = 0; j < 4; ++j) { h[j] = (v[j] * rstd * gn[j]) * scl[j] + sh[j];
                    u32x2 w; w.x = pk2(h[j][0], h[j][1]); w.y = pk2(h[j][2], h[j][3]);
                    *(u32x2*)(P.H + (size_t)r * D + 4 * lane + 256 * j) = w; }
                if (ROUTER) {
                    float lg[8] = {0.f, 0.f, 0.f, 0.f, 0.f, 0.f, 0.f, 0.f};
#pragma unroll
                    for (int j = 0; j < 4; ++j)
#pragma unroll
                        for (int i = 0; i < 4; ++i) { const int col = 4 * lane + 256 * j + i; const f32x4 w0 = *(const LAS f32x4*)(rwl + col * 8), w1 = *(const LAS f32x4*)(rwl + col * 8 + 4); const float hv = h[j][i];
                            lg[0] += hv * w0[0]; lg[1] += hv * w0[1]; lg[2] += hv * w0[2]; lg[3] += hv * w0[3]; lg[4] += hv * w1[0]; lg[5] += hv * w1[1]; lg[6] += hv * w1[2]; lg[7] += hv * w1[3]; }
#pragma unroll
                    for (int e = 0; e < 8; ++e) lg[e] = wave_sum(lg[e]);
                    int e0 = 0; float v0 = lg[0];
#pragma unroll
                    for (int e = 1; e < 8; ++e) if (lg[e] > v0) { v0 = lg[e]; e0 = e; }
                    int e1 = -1; float v1 = -3.0e38f;
#pragma unroll
                    for (int e = 0; e < 8; ++e) if (e != e0 && lg[e] > v1) { v1 = lg[e]; e1 = e; }
                    const float ex = expf(v1 - v0); const float q0 = 1.0f / (1.0f + ex), q1 = ex / (1.0f + ex);
                    const int rk0 = e0 == 0 ? rc0 : e0 == 1 ? rc1 : e0 == 2 ? rc2 : e0 == 3 ? rc3 : e0 == 4 ? rc4 : e0 == 5 ? rc5 : e0 == 6 ? rc6 : rc7;
                    const int rk1 = e1 == 0 ? rc0 : e1 == 1 ? rc1 : e1 == 2 ? rc2 : e1 == 3 ? rc3 : e1 == 4 ? rc4 : e1 == 5 ? rc5 : e1 == 6 ? rc6 : rc7;
                    rc0 += (e0 == 0) + (e1 == 0); rc1 += (e0 == 1) + (e1 == 1); rc2 += (e0 == 2) + (e1 == 2); rc3 += (e0 == 3) + (e1 == 3);
                    rc4 += (e0 == 4) + (e1 == 4); rc5 += (e0 == 5) + (e1 == 5); rc6 += (e0 == 6) + (e1 == 6); rc7 += (e0 == 7) + (e1 == 7);
                    if (lane == 0) { P.tope[2 * r] = e0; P.tope[2 * r + 1] = e1; P.toppo[2 * r] = q0; P.toppo[2 * r + 1] = q1; P.rank[2 * r] = rk0; P.rank[2 * r + 1] = rk1; }
                }
            }
            if (rr < 15) {
#pragma unroll
                for (int j = 0; j < 4; ++j) { v[j] = vn[j]; if (COMBINE) { ya[j] = yan[j]; yb[j] = ybn[j]; } }
                if (COMBINE) { p0 = p0n; p1 = p1n; }
            }
        }
        if (ROUTER && lane == 0) { int* c = P.cnt + it * 8; c[0] = rc0; c[1] = rc1; c[2] = rc2; c[3] = rc3; c[4] = rc4; c[5] = rc5; c[6] = rc6; c[7] = rc7; }
    }
}

template <int NB>
__device__ __forceinline__ void lm_core(const bf16_t* A, int lda, const int (&i0)[NB], int kc0, int nks, LAS unsigned char* X, f32x4 (&acc)[NB][8], int lane) {
    const int i16 = lane & 15, q = lane >> 4;
    const int xoff = (8 * q + (i16 >> 2)) * XRS + 8 * (i16 & 3);
    for (int ks = 0; ks < nks; ++ks) {
        bf16x8 af[NB];
#pragma unroll
        for (int b = 0; b < NB; ++b) af[b] = *(const bf16x8*)(A + (size_t)(i0[b] + i16) * lda + kc0 + ks * 32 + 8 * q);
#pragma unroll
        for (int nt = 0; nt < 8; ++nt) {
            const s16x4 lo = __builtin_amdgcn_ds_read_tr16_b64_v4i16((LAS s16x4*)(X + ks * 32 * XRS + xoff + nt * 32));
            const s16x4 hi = __builtin_amdgcn_ds_read_tr16_b64_v4i16((LAS s16x4*)(X + ks * 32 * XRS + xoff + nt * 32 + 4 * XRS));
            const bf16x8 xf = __builtin_shufflevector(lo, hi, 0, 1, 2, 3, 4, 5, 6, 7);
#pragma unroll
            for (int b = 0; b < NB; ++b) acc[b][nt] = __builtin_amdgcn_mfma_f32_16x16x32_bf16(xf, af[b], acc[b][nt], 0, 0, 0);
        }
    }
}
template <int NB> __device__ __forceinline__ void zero_acc(f32x4 (&acc)[NB][8]) {
#pragma unroll
    for (int b = 0; b < NB; ++b)
#pragma unroll
        for (int nt = 0; nt < 8; ++nt) acc[b][nt] = (f32x4){0.f, 0.f, 0.f, 0.f};
}
__device__ __forceinline__ void stage_rows(const bf16_t* src, size_t sstride, int nrows, LAS unsigned char* X, int xr0, int tid) {
    for (int i = tid; i < nrows * 16; i += 512) { const int r = i >> 4, ch = i & 15; *(LAS u32x4*)(X + (xr0 + r) * XRS + ch * 16) = *(const u32x4*)(src + (size_t)r * sstride + ch * 8); }
}

__device__ __forceinline__ void fft_stage_a(const Ctx& F) {
    const bf16_t* PZ = (const bf16_t*)(F.ws + WS_PZUV); bf16_t* UP = (bf16_t*)(F.ws + WS_UP); bf16_t* Y = (bf16_t*)(F.ws + WS_H);
    const bf16_t* FA = (const bf16_t*)(F.ws + WS_FA); const bf16_t* FX = (const bf16_t*)(F.ws + WS_FX);
    LAS unsigned char* X = F.lds; const int lane = F.lane, w = F.wave, i16 = lane & 15, q = lane >> 4;
    for (int it = F.bid; it < 1024 + 16; it += F.G) {
        if (it < 1024) {
            const int t2 = it & 127, g = (it >> 7) & 3, b = it >> 9;
            const bf16_t* src = PZ + ((size_t)b * TL + t2) * NEIN + g * 128;
            stage_rows(src, (size_t)128 * NEIN, 128, X, 0, F.tid);
            stage_rows(src + 512, (size_t)128 * NEIN, 128, X, 128, F.tid);
            __syncthreads();
            f32x4 acc[2][8]; zero_acc<2>(acc); const int i0[2] = {16 * w, 128 + 16 * w};
            lm_core<2>(FA, 256, i0, 0, 8, X, acc, lane);
            const int k1 = 16 * w + i16; float sw, cw; sincosf(6.283185307179586f * (float)((k1 * t2) & 16383) / 16384.0f, &sw, &cw);
            bf16_t* orow = UP + ((size_t)((b * 4 + g) * 128 + k1) * 128 + t2) * 256;
#pragma unroll
            for (int nt = 0; nt < 8; ++nt) { const f32x4 ur = acc[0][nt], ui = acc[1][nt]; const int n = 16 * nt + 4 * q;
                u32x2 wr_, wi_; wr_.x = pk2(ur[0] * cw - ui[0] * sw, ur[1] * cw - ui[1] * sw); wr_.y = pk2(ur[2] * cw - ui[2] * sw, ur[3] * cw - ui[3] * sw);
                wi_.x = pk2(ur[0] * sw + ui[0] * cw, ur[1] * sw + ui[1] * cw); wi_.y = pk2(ur[2] * sw + ui[2] * cw, ur[3] * sw + ui[3] * cw);
                *(u32x2*)(orow + n) = wr_; *(u32x2*)(orow + 128 + n) = wi_; }
            __syncthreads();
        } else {
            const int ci = it - 1024, kh = ci & 1, g = (ci >> 1) & 3, b = ci >> 3;
            f32x4 acc[1][8]; zero_acc<1>(acc); const int i0[1] = {128 * kh + 16 * w};
            for (int c = 0; c < 2; ++c) {
                stage_rows(PZ + ((size_t)ML + b * TCX) * NEIN + c * 512 + g * 128, NEIN, 256, X, 0, F.tid);
                __syncthreads();
                lm_core<1>(FX, 512, i0, c * 256, 8, X, acc, lane);
                __syncthreads();
            }
            const int k = 128 * kh + 16 * w + i16; bf16_t* orow = Y + ((size_t)ML + b * TCX + k) * D + g * 128; const float nrm = 0.005524271728019903f;
#pragma unroll
            for (int nt = 0; nt < 8; ++nt) { const f32x4 a = acc[0][nt] * nrm; u32x2 o; o.x = pk2(a[0], a[1]); o.y = pk2(a[2], a[3]); *(u32x2*)(orow + 16 * nt + 4 * q) = o; }
        }
    }
}
__device__ __forceinline__ void fft_stage_c_gmlp(const Ctx& F, int j) {
    const bf16_t* PZ = (const bf16_t*)(F.ws + WS_PZUV); const bf16_t* UP = (const bf16_t*)(F.ws + WS_UP); bf16_t* Y = (bf16_t*)(F.ws + WS_H);
    const bf16_t* FC = (const bf16_t*)(F.ws + WS_FC); const bf16_t* GW = (const bf16_t*)(F.ws + WS_GW) + (size_t)j * 4 * 128 * 128;
    const float* gb = F.in[I_GB] + j * 512;
    LAS unsigned char* X = F.lds; const int lane = F.lane, w = F.wave, i16 = lane & 15, q = lane >> 4, tid = F.tid;
    for (int it = F.bid; it < 1024 + 1040; it += F.G) {
        if (it < 1024) {
            const int k1 = it & 127, g = (it >> 7) & 3, b = it >> 9;
            const bf16_t* src = UP + (size_t)((b * 4 + g) * 128 + k1) * 128 * 256;
            stage_rows(src, 256, 128, X, 0, tid);
            stage_rows(src + 128, 256, 128, X, 128, tid);
            __syncthreads();
            f32x4 acc[1][8]; zero_acc<1>(acc); const int i0[1] = {16 * w};
            lm_core<1>(FC, 256, i0, 0, 8, X, acc, lane);
            const int k2 = 16 * w + i16; bf16_t* orow = Y + ((size_t)b * TL + k1 + 128 * k2) * D + g * 128; const float nrm = 0.0006905339660024878f;
#pragma unroll
            for (int nt = 0; nt < 8; ++nt) { const f32x4 a = acc[0][nt] * nrm; u32x2 o; o.x = pk2(a[0], a[1]); o.y = pk2(a[2], a[3]); *(u32x2*)(orow + 16 * nt + 4 * q) = o; }
            __syncthreads();
        } else {
            const int gi = it - 1024, h = gi & 3, ck = gi >> 2; const size_t r0 = (size_t)ck * 128;
            for (int i = tid; i < 128 * 16; i += 512) { const int r = i >> 4, ch = i & 15; const u32x4 raw = *(const u32x4*)(PZ + (r0 + r) * NEIN + 1536 + h * 128 + ch * 8);
                float x[8] = {bflo(raw.x), bfhi(raw.x), bflo(raw.y), bfhi(raw.y), bflo(raw.z), bfhi(raw.z), bflo(raw.w), bfhi(raw.w)};
                float s = 0.f;
#pragma unroll
                for (int e = 0; e < 8; ++e) s += x[e];
                s += __shfl_xor(s, 1); s += __shfl_xor(s, 2); s += __shfl_xor(s, 4); s += __shfl_xor(s, 8);
                const float mean = s * (1.0f / 128.0f); float qq = 0.f;
#pragma unroll
                for (int e = 0; e < 8; ++e) { x[e] -= mean; qq += x[e] * x[e]; }
                qq += __shfl_xor(qq, 1); qq += __shfl_xor(qq, 2); qq += __shfl_xor(qq, 4); qq += __shfl_xor(qq, 8);
                const float rs = rsqrtf(qq * (1.0f / 128.0f) + EPS);
                u32x4 o; o.x = pk2(x[0] * rs, x[1] * rs); o.y = pk2(x[2] * rs, x[3] * rs); o.z = pk2(x[4] * rs, x[5] * rs); o.w = pk2(x[6] * rs, x[7] * rs);
                *(LAS u32x4*)(X + r * XRS + ch * 16) = o; }
            __syncthreads();
            f32x4 acc[1][8]; zero_acc<1>(acc); const int i0[1] = {16 * w};
            lm_core<1>(GW + (size_t)h * 128 * 128, 128, i0, 0, 4, X, acc, lane);
            const int t = 16 * w + i16; const float bias = gb[h * 128 + t];
            const bf16_t* urow = PZ + (r0 + t) * NEIN + 1024 + h * 128; bf16_t* orow = Y + (r0 + t) * D + 512 + h * 128;
#pragma unroll
            for (int nt = 0; nt < 8; ++nt) { const int n = 16 * nt + 4 * q; const u32x2 uu = *(const u32x2*)(urow + n); const f32x4 a = acc[0][nt];
                u32x2 o; o.x = pk2(bflo(uu.x) * (a[0] + bias), bfhi(uu.x) * (a[1] + bias)); o.y = pk2(bflo(uu.y) * (a[2] + bias), bfhi(uu.y) * (a[3] + bias)); *(u32x2*)(orow + n) = o; }
            __syncthreads();
        }
    }
}

constexpr int S2_KT = 0, S2_QT = 36864, S2_V = 73728, S2_SC = 110592, S2_EB = 120832, S2_EBL = 122880, S2_RED = 124928, S2_END = 129024;
static_assert(S2_END <= MISC_OFF, "scan LDS");
constexpr int SCRS = 80;
template <bool NEEDQ>
__device__ __forceinline__ void half_prep(const Ctx& F, const bf16_t* P5, size_t hrow, bool rev, int h, int dir) {
    const int tid = F.tid, ck = F.wave >> 1, dk = ((F.wave & 1) << 6) + F.lane; LAS unsigned char* L = F.lds;
#pragma unroll
    for (int it = 0; it < 4; ++it) { const int idx = tid + 512 * it, p = idx >> 4, ch = idx & 15; const size_t r = hrow + (rev ? 127 - p : p); const bf16_t* rp = P5 + r * NREC + h * 128 + ch * 8;
        *(LAS u32x4*)(L + S2_KT + p * XRS + ch * 16) = *(const u32x4*)(rp + 2048 + dir * 1024);
        if (NEEDQ) *(LAS u32x4*)(L + S2_QT + p * XRS + ch * 16) = *(const u32x4*)(rp);
        *(LAS u32x4*)(L + S2_V + p * XRS + ch * 16) = *(const u32x4*)(rp + 4096); }
    __syncthreads();
    float b = 0.f; LAS unsigned char* kt = L + S2_KT + (32 * ck) * XRS + dk * 2; LAS unsigned char* qt = L + S2_QT + (32 * ck) * XRS + dk * 2;
#pragma unroll 8
    for (int i = 0; i < 32; ++i) { const float lf = bf2f(*(const LAS bf16_t*)(kt + i * XRS)); b += lf;
        const float kk = (1.0f - __expf(lf)) * __expf(fminf(-b, 80.0f));
        *(LAS bf16_t*)(kt + i * XRS) = (bf16_t)f2bf(kk);
        if (NEEDQ) { const float qv = bf2f(*(const LAS bf16_t*)(qt + i * XRS)); *(LAS bf16_t*)(qt + i * XRS) = (bf16_t)f2bf(qv * __expf(b)); } }
    ((LAS float*)(L + S2_EB))[ck * 128 + dk] = __expf(b);
    ((LAS float*)(L + S2_EBL))[ck * 128 + dk] = b;
}
__device__ __forceinline__ void state_update(const Ctx& F, f32x4 (&st)[8], int ck) {
    LAS unsigned char* L = F.lds; const int lane = F.lane, i16 = lane & 15, q = lane >> 4, w = F.wave;
    const int roff = (32 * ck + 8 * q + (i16 >> 2)) * XRS + 8 * (i16 & 3);
    const s16x4 vlo = __builtin_amdgcn_ds_read_tr16_b64_v4i16((LAS s16x4*)(L + S2_V + roff + w * 32));
    const s16x4 vhi = __builtin_amdgcn_ds_read_tr16_b64_v4i16((LAS s16x4*)(L + S2_V + roff + w * 32 + 4 * XRS));
    const bf16x8 vf = __builtin_shufflevector(vlo, vhi, 0, 1, 2, 3, 4, 5, 6, 7);
#pragma unroll
    for (int kb = 0; kb < 8; ++kb) {
        const s16x4 klo = __builtin_amdgcn_ds_read_tr16_b64_v4i16((LAS s16x4*)(L + S2_KT + roff + kb * 32));
        const s16x4 khi = __builtin_amdgcn_ds_read_tr16_b64_v4i16((LAS s16x4*)(L + S2_KT + roff + kb * 32 + 4 * XRS));
        const bf16x8 kf = __builtin_shufflevector(klo, khi, 0, 1, 2, 3, 4, 5, 6, 7);
        st[kb] = __builtin_amdgcn_mfma_f32_16x16x32_bf16(kf, vf, st[kb], 0, 0, 0);
        const f32x4 eb = *(const LAS f32x4*)(L + S2_EB + (ck * 128 + 16 * kb + 4 * q) * 4);
        st[kb] = st[kb] * eb;
    }
}
__device__ __forceinline__ void state_load(const float* src, f32x4 (&st)[8], int w, int lane) {
#pragma unroll
    for (int kb = 0; kb < 8; ++kb)
#pragma unroll
        for (int rg = 0; rg < 4; ++rg) st[kb][rg] = src ? src[((w * 8 + kb) * 4 + rg) * 64 + lane] : 0.f;
}
__device__ __forceinline__ void state_store(float* dst, const f32x4 (&st)[8], int w, int lane) {
#pragma unroll
    for (int kb = 0; kb < 8; ++kb)
#pragma unroll
        for (int rg = 0; rg < 4; ++rg) dst[((w * 8 + kb) * 4 + rg) * 64 + lane] = st[kb][rg];
}
__device__ __forceinline__ void scan_pass1_item(const Ctx& F, const bf16_t* P5, int b, int h, int dir, int seg, float* SST, float* EG) {
    const int chain = (b * 8 + h) * 2 + dir; const size_t rowb = (size_t)b * TL + (size_t)seg * SEGL;
    f32x4 st[8]; state_load(nullptr, st, F.wave, F.lane);
    float gacc = 0.f;
    for (int hs = 0; hs < 2; ++hs) {
        const size_t hrow = rowb + 128 * (dir ? 1 - hs : hs);
        half_prep<false>(F, P5, hrow, dir != 0, h, dir);
        __syncthreads();
        if (F.tid < 128) { const LAS float* ebl = (const LAS float*)(F.lds + S2_EBL); gacc += (ebl[F.tid] + ebl[128 + F.tid]) + (ebl[256 + F.tid] + ebl[384 + F.tid]); }
#pragma unroll 1
        for (int ck = 0; ck < 4; ++ck) { state_update(F, st, ck); __builtin_amdgcn_sched_barrier(0); }
        __syncthreads();
    }
    state_store(SST + ((size_t)chain * NSEG + seg) * 16384, st, F.wave, F.lane);
    if (F.tid < 128) EG[((size_t)chain * NSEG + seg) * 128 + F.tid] = __expf(gacc);
}
__device__ __forceinline__ void half_scores(const Ctx& F) {
    LAS unsigned char* L = F.lds; const int lane = F.lane, i16 = lane & 15, q = lane >> 4, w = F.wave, ck = w >> 1, u = w & 1;
#pragma unroll
    for (int tt = 0; tt < 2; ++tt) {
        const int ti = u == 0 ? tt : 1 - tt, si = u == 0 ? tt : tt;
        f32x4 sc = (f32x4){0.f, 0.f, 0.f, 0.f};
        if (si <= ti) {
#pragma unroll
            for (int ks = 0; ks < 4; ++ks) { const bf16x8 a = *(const LAS bf16x8*)(L + S2_QT + (32 * ck + 16 * ti + i16) * XRS + (32 * ks + 8 * q) * 2); const bf16x8 bb = *(const LAS bf16x8*)(L + S2_KT + (32 * ck + 16 * si + i16) * XRS + (32 * ks + 8 * q) * 2);
                sc = __builtin_amdgcn_mfma_f32_16x16x32_bf16(a, bb, sc, 0, 0, 0); }
        }
#pragma unroll
        for (int rg = 0; rg < 4; ++rg) { const int t = 16 * ti + 4 * q + rg, sidx = 16 * si + i16; *(LAS bf16_t*)(L + S2_SC + (32 * ck + t) * SCRS + sidx * 2) = (bf16_t)f2bf(sidx <= t ? sc[rg] : 0.f); }
    }
}
__device__ __forceinline__ void chunk_out(const Ctx& F, const f32x4 (&st)[8], int ck, f32x4 (&o)[2]) {
    LAS unsigned char* L = F.lds; const int lane = F.lane, i16 = lane & 15, q = lane >> 4, w = F.wave;
    o[0] = (f32x4){0.f, 0.f, 0.f, 0.f}; o[1] = (f32x4){0.f, 0.f, 0.f, 0.f};
#pragma unroll
    for (int ks = 0; ks < 4; ++ks) {
        u32x4 sp; sp.x = pk2(st[2 * ks][0], st[2 * ks][1]); sp.y = pk2(st[2 * ks][2], st[2 * ks][3]); sp.z = pk2(st[2 * ks + 1][0], st[2 * ks + 1][1]); sp.w = pk2(st[2 * ks + 1][2], st[2 * ks + 1][3]);
        const bf16x8 sf = __builtin_bit_cast(bf16x8, sp);
#pragma unroll
        for (int ti = 0; ti < 2; ++ti) { const LAS unsigned char* qrow = L + S2_QT + (32 * ck + 16 * ti + i16) * XRS + (32 * ks + 4 * q) * 2;
            const u32x2 qlo = *(const LAS u32x2*)(qrow), qhi = *(const LAS u32x2*)(qrow + 32);
            u32x4 qp; qp.x = qlo.x; qp.y = qlo.y; qp.z = qhi.x; qp.w = qhi.y;
            o[ti] = __builtin_amdgcn_mfma_f32_16x16x32_bf16(sf, __builtin_bit_cast(bf16x8, qp), o[ti], 0, 0, 0); }
    }
    const int roff = (32 * ck + 8 * q + (i16 >> 2)) * XRS + 8 * (i16 & 3);
    const s16x4 vlo = __builtin_amdgcn_ds_read_tr16_b64_v4i16((LAS s16x4*)(L + S2_V + roff + w * 32));
    const s16x4 vhi = __builtin_amdgcn_ds_read_tr16_b64_v4i16((LAS s16x4*)(L + S2_V + roff + w * 32 + 4 * XRS));
    const bf16x8 vf = __builtin_shufflevector(vlo, vhi, 0, 1, 2, 3, 4, 5, 6, 7);
#pragma unroll
    for (int ti = 0; ti < 2; ++ti) { const bf16x8 pf = *(const LAS bf16x8*)(L + S2_SC + (32 * ck + 16 * ti + i16) * SCRS + (8 * q) * 2); o[ti] = __builtin_amdgcn_mfma_f32_16x16x32_bf16(vf, pf, o[ti], 0, 0, 0); }
}
__device__ __forceinline__ void scan_pass3_item(const Ctx& F, const bf16_t* P5, size_t rowb, int h, const float* sin_f, const float* sin_b, float* fin_f, float* fin_b, const float* gain, bf16_t* OFT, bf16_t* Y, bool writey) {
    LAS unsigned char* L = F.lds; const int lane = F.lane, i16 = lane & 15, q = lane >> 4, w = F.wave;
    const int colo = h * 128 + 16 * w + 4 * q;
    f32x4 st[8];
    state_load(sin_f, st, w, lane);
    for (int hs = 0; hs < 2; ++hs) {
        const size_t hrow = rowb + 128 * hs;
        half_prep<true>(F, P5, hrow, false, h, 0);
        __syncthreads();
        half_scores(F);
        __syncthreads();
#pragma unroll 1
        for (int ck = 0; ck < 4; ++ck) { f32x4 o[2]; chunk_out(F, st, ck, o);
#pragma unroll
            for (int ti = 0; ti < 2; ++ti) { const size_t r = hrow + 32 * ck + 16 * ti + i16; u32x2 pkd; pkd.x = pk2(o[ti][0], o[ti][1]); pkd.y = pk2(o[ti][2], o[ti][3]); *(u32x2*)(OFT + r * D + colo) = pkd; }
            __builtin_amdgcn_sched_barrier(0);
            state_update(F, st, ck);
            __builtin_amdgcn_sched_barrier(0); }
        __syncthreads();
    }
    if (fin_f) state_store(fin_f, st, w, lane);
    state_load(sin_b, st, w, lane);
    const f32x4 gv = *(const f32x4*)(gain + colo);
    for (int hs = 0; hs < 2; ++hs) {
        const size_t hrow = rowb + 128 * (1 - hs);
        half_prep<true>(F, P5, hrow, true, h, 1);
        __syncthreads();
        half_scores(F);
        __syncthreads();
        LAS float* RED = (LAS float*)(L + S2_RED);
#pragma unroll 1
        for (int ck = 0; ck < 4; ++ck) { f32x4 o[2]; chunk_out(F, st, ck, o);
#pragma unroll
            for (int ti = 0; ti < 2; ++ti) { const int p = 32 * ck + 16 * ti + i16; const size_t r = hrow + 127 - p; const u32x2 f = *(const u32x2*)(OFT + r * D + colo);
                o[ti][0] += bflo(f.x); o[ti][1] += bfhi(f.x); o[ti][2] += bflo(f.y); o[ti][3] += bfhi(f.y);
                float ss = (o[ti][0] * o[ti][0] + o[ti][1] * o[ti][1]) + (o[ti][2] * o[ti][2] + o[ti][3] * o[ti][3]);
                ss += __shfl_xor(ss, 16); ss += __shfl_xor(ss, 32);
                if (q == 0) RED[w * 128 + p] = ss;
                u32x2 pkd; pkd.x = pk2(o[ti][0], o[ti][1]); pkd.y = pk2(o[ti][2], o[ti][3]); *(u32x2*)(OFT + r * D + colo) = pkd; }
            __builtin_amdgcn_sched_barrier(0);
            state_update(F, st, ck);
            __builtin_amdgcn_sched_barrier(0); }
        __syncthreads();
        if (writey) {
#pragma unroll
            for (int ck = 0; ck < 4; ++ck)
#pragma unroll
                for (int ti = 0; ti < 2; ++ti) { const int p = 32 * ck + 16 * ti + i16; float tot = 0.f;
#pragma unroll
                    for (int ww = 0; ww < 8; ++ww) tot += RED[ww * 128 + p];
                    const float rs = rsqrtf(tot * (1.0f / 128.0f) + EPS); const size_t r = hrow + 127 - p;
                    const u32x2 f = *(const u32x2*)(OFT + r * D + colo); const u32x2 sg = *(const u32x2*)(P5 + r * NREC + 1024 + colo);
                    u32x2 y; y.x = pk2(bflo(f.x) * rs * gv[0] * bflo(sg.x), bfhi(f.x) * rs * gv[1] * bfhi(sg.x)); y.y = pk2(bflo(f.y) * rs * gv[2] * bflo(sg.y), bfhi(f.y) * rs * gv[3] * bfhi(sg.y));
                    *(u32x2*)(Y + r * D + colo) = y; }
        }
        __syncthreads();
    }
    if (fin_b) state_store(fin_b, st, w, lane);
}
__device__ __forceinline__ void scan_carry(const Ctx& F) {
    float* SST = (float*)(F.ws + WS_SST); const float* EG = (const float*)(F.ws + WS_EG); const float* S0 = (const float*)(F.ws + WS_S0);
    const int gt = F.bid * 512 + F.tid, NGT = F.G * 512;
    for (int idx = gt; idx < NCHAIN * 16384; idx += NGT) {
        const int chain = idx >> 14, e = idx & 16383, dir = chain & 1;
        const int lanee = e & 63, rg = (e >> 6) & 3, kb = (e >> 8) & 7; const int dk = 16 * kb + 4 * (lanee >> 4) + rg;
        float cur = S0[(size_t)chain * 16384 + e];
        float* base = SST + (size_t)chain * NSEG * 16384 + e; const float* eg = EG + (size_t)chain * NSEG * 128 + dk;
        for (int s0 = 0; s0 < NSEG; s0 += 8) {
            float tmp[8], gg[8];
#pragma unroll
            for (int i = 0; i < 8; ++i) { const int seg = dir ? NSEG - 1 - (s0 + i) : s0 + i; tmp[i] = base[(size_t)seg * 16384]; gg[i] = eg[seg * 128]; }
#pragma unroll
            for (int i = 0; i < 8; ++i) { const int seg = dir ? NSEG - 1 - (s0 + i) : s0 + i; base[(size_t)seg * 16384] = cur; cur = gg[i] * cur + tmp[i]; }
        }
    }
}

__device__ __forceinline__ void moe_slots(const Ctx& F, int nrows) {
    const int tid = F.tid; const int nitems = nrows / 16;
    const int* cnt = (const int*)(F.ws + WS_CNT); const int* tope = (const int*)(F.ws + WS_TOPE); const int* rank = (const int*)(F.ws + WS_RANK);
    int* slotrow = (int*)(F.ws + WS_SLOTROW); int* slotdst = (int*)(F.ws + WS_SLOTDST); int* tilex = (int*)(F.ws + WS_TILEX);
    LAS int* pre = (LAS int*)F.lds;
    LAS int* tsum = (LAS int*)(F.lds + 69632);
    LAS int* ebase = (LAS int*)(F.lds + 69632 + 16384);
    constexpr int IPT = (NITEM16 + 511) / 512;
    int loc[8] = {0, 0, 0, 0, 0, 0, 0, 0};
    for (int i = 0; i < IPT; ++i) { const int it = tid * IPT + i; if (it < nitems) {
#pragma unroll
        for (int e = 0; e < 8; ++e) loc[e] += cnt[it * 8 + e]; } }
#pragma unroll
    for (int e = 0; e < 8; ++e) tsum[tid * 8 + e] = loc[e];
    __syncthreads();
    if (tid < 8) { int run = 0; for (int t = 0; t < 512; ++t) { const int v = tsum[t * 8 + tid]; tsum[t * 8 + tid] = run; run += v; } ebase[8 + tid] = run; }
    __syncthreads();
    if (tid == 0) { int b = 0; for (int e = 0; e < 8; ++e) { ebase[e] = b; b += (ebase[8 + e] + 255) & ~255; } ebase[16] = b / 256; }
    { int run[8];
#pragma unroll
      for (int e = 0; e < 8; ++e) run[e] = tsum[tid * 8 + e];
      for (int i = 0; i < IPT; ++i) { const int it = tid * IPT + i; if (it < nitems) {
#pragma unroll
          for (int e = 0; e < 8; ++e) { pre[it * 8 + e] = run[e]; run[e] += cnt[it * 8 + e]; } } } }
    __syncthreads();
    for (int r = F.bid * 512 + tid; r < nrows; r += F.G * 512) {
#pragma unroll
        for (int kk = 0; kk < 2; ++kk) { const int e = tope[2 * r + kk]; const int slot = ebase[e] + pre[(r >> 4) * 8 + e] + rank[2 * r + kk]; slotrow[slot] = r; slotdst[slot] = 2 * r + kk; }
    }
    if (F.bid == 0) {
        const int ntiles = ebase[16];
        if (tid == 0) tilex[0] = ntiles;
        for (int e = 0; e < 8; ++e) { const int b0 = ebase[e], tot = ebase[8 + e], pad = (tot + 255) & ~255;
            for (int s = b0 + tot + tid; s < b0 + pad; s += 512) { slotrow[s] = 0; slotdst[s] = -1; }
            for (int t = b0 / 256 + tid; t < (b0 + pad) / 256; t += 512) tilex[16 + t] = e; }
    }
}

__global__ void __launch_bounds__(512, 2) fwd_kernel(Args args) {
    extern __shared__ __attribute__((aligned(16))) unsigned char lds_raw[];
    Ctx F;
    F.lds = (LAS unsigned char*)lds_raw; F.tid = threadIdx.x; F.lane = F.tid & 63; F.wave = __builtin_amdgcn_readfirstlane(F.tid >> 6);
    F.G = gridDim.x; F.bid = blockIdx.x; F.gw = F.bid * 8 + F.wave; F.NGW = F.G * 8;
    F.in = args.in; F.out = args.out; F.ws = args.ws;
    unsigned char* ws = args.ws;
    volatile LAS unsigned* MISC = (volatile LAS unsigned*)(F.lds + MISC_OFF);
    if (F.tid < 64) MISC[F.tid] = 0u;
    __syncthreads();
    const int lo = args.ph_lo, hi = args.ph_hi;
    XcdBarrier bar; bar.bar = (unsigned*)(ws + WS_CTL) + 4096; bar.x = 0; bar.st = nullptr;
    const bool multi = (hi - lo) > 1;
    if (multi) bar = xcd_barrier_post((unsigned*)(ws + WS_CTL) + 4096, MISC + 8);
#define IN(k) (lo <= (k) && (k) < hi)
#define SEAM(k) do { if (IN(k) && IN((k) + 1)) xcd_barrier(bar); asm volatile("" : "+v"(F.tid)); F.lane = F.tid & 63; F.wave = __builtin_amdgcn_readfirstlane(F.tid >> 6); F.gw = F.bid * 8 + F.wave; } while (0)

    float* mods = (float*)(ws + WS_MODS);
    float* XC = (float*)(ws + WS_XC);
    bf16_t* H = (bf16_t*)(ws + WS_H);
    bf16_t* YE = (bf16_t*)(ws + WS_YE);

    if (IN(PH_P0)) { p0_prologue(F); }
    SEAM(PH_P0);

    for (int lp = 0; lp < 2; ++lp) {
        const int pb = PH_PAIR0 + lp * NPL;
        const int le = 2 * lp, lo_ = 2 * lp + 1;
        const float* modE = mods + (size_t)le * 3 * 6144; const float* modO = mods + (size_t)lo_ * 3 * 6144;
        const float* xsl = lp == 0 ? F.in[I_X] : F.out; const float* xsc = lp == 0 ? F.in[I_CTX] : XC;
        if (IN(pb + E1_NORM)) for (int rep_ = 0; rep_ < NREP(E1_NORM); ++rep_) {
            RowPass P{}; P.sl = xsl; P.sc = xsc; P.dl = F.out; P.dc = XC; P.gain = F.in[I_NMIX] + le * D; P.shift = modE + 0 * D; P.scale = modE + 1 * D; P.H = H; P.nrows = MT;
            if (lp == 0) row_pass<false, false, false>(F, P);
            else { P.YE = YE; P.topp = (const float*)(ws + WS_TOPP); P.gatef = mods + (size_t)(le - 1) * 3 * 6144 + 5 * D; row_pass<true, false, false>(F, P); }
        }
        SEAM(pb + E1_NORM);
        if (IN(pb + E2_GIN)) for (int rep_ = 0; rep_ < NREP(E2_GIN); ++rep_) {
            pg8::Gemm g{H, (const bf16_t*)(ws + WS_WINE) + (size_t)lp * NEIN * D, MT, NEIN, D, nullptr, nullptr, 0}; pg8::StaticOrder S; S.init(MT, NEIN, F.G, F.bid);
            pg8::EpiEvenIn E{(bf16_t*)(ws + WS_PZUV)};
            pg8::gemm_phase<pg8::EpiEvenIn, pg8::StaticOrder, true, false>(F.lds, g, S, E, F.tid);
        }
        SEAM(pb + E2_GIN);
        if (IN(pb + E3_FFTA)) for (int rep_ = 0; rep_ < NREP(E3_FFTA); ++rep_) fft_stage_a(F);
        SEAM(pb + E3_FFTA);
        if (IN(pb + E3_FFTC)) for (int rep_ = 0; rep_ < NREP(E3_FFTC); ++rep_) fft_stage_c_gmlp(F, lp);
        SEAM(pb + E3_FFTC);
        if (IN(pb + E4_GOUT)) for (int rep_ = 0; rep_ < NREP(E4_GOUT); ++rep_) {
            pg8::Gemm g{H, (const bf16_t*)(ws + WS_WOUTE) + (size_t)lp * D * D, MT, D, D, nullptr, nullptr, 0}; pg8::StaticOrder S; S.init(MT, D, F.G, F.bid);
            pg8::EpiRes E{lp == 0 ? xsl : (const float*)F.out, lp == 0 ? xsc : (const float*)XC, F.out, XC, modE + 2 * D};
            pg8::gemm_phase<pg8::EpiRes, pg8::StaticOrder, false, false>(F.lds, g, S, E, F.tid);
        }
        SEAM(pb + E4_GOUT);
        if (IN(pb + E5_NORM)) for (int rep_ = 0; rep_ < NREP(E5_NORM); ++rep_) {
            RowPass P{}; P.sl = F.out; P.sc = XC; P.gain = F.in[I_NFFN] + le * D; P.shift = modE + 3 * D; P.scale = modE + 4 * D; P.H = H; P.nrows = MT;
            row_pass<false, false, false>(F, P);
        }
        SEAM(pb + E5_NORM);
        if (IN(pb + E6_UP)) for (int rep_ = 0; rep_ < NREP(E6_UP); ++rep_) {
            pg8::Gemm g{H, (const bf16_t*)(ws + WS_W13) + (size_t)lp * NFF2 * D, MT, NFF2, D, nullptr, nullptr, 0}; pg8::StaticOrder S; S.init(MT, NFF2, F.G, F.bid);
            pg8::EpiSwiglu E{(bf16_t*)(ws + WS_HID), DFF};
            pg8::gemm_phase<pg8::EpiSwiglu, pg8::StaticOrder, true, false>(F.lds, g, S, E, F.tid);
        }
        SEAM(pb + E6_UP);
        if (IN(pb + E7_DOWN)) for (int rep_ = 0; rep_ < NREP(E7_DOWN); ++rep_) {
            pg8::Gemm g{(const bf16_t*)(ws + WS_HID), (const bf16_t*)(ws + WS_W2) + (size_t)lp * D * DFF, MT, D, DFF, nullptr, nullptr, 0}; pg8::StaticOrder S; S.init(MT, D, F.G, F.bid);
            pg8::EpiRes E{F.out, XC, F.out, XC, modE + 5 * D};
            pg8::gemm_phase<pg8::EpiRes, pg8::StaticOrder, false, false>(F.lds, g, S, E, F.tid);
        }
        SEAM(pb + E7_DOWN);
        const bool lastl = lp == 1;
        if (IN(pb + O1_NORM)) for (int rep_ = 0; rep_ < NREP(O1_NORM); ++rep_) {
            RowPass P{}; P.sl = F.out; P.sc = XC; P.gain = F.in[I_NMIX] + lo_ * D; P.shift = modO + 0 * D; P.scale = modO + 1 * D; P.H = H; P.nrows = MT;
            row_pass<false, false, false>(F, P);
        }
        SEAM(pb + O1_NORM);
        if (IN(pb + O2_GIN)) for (int rep_ = 0; rep_ < NREP(O2_GIN); ++rep_) {
            pg8::Gemm g{H, (const bf16_t*)(ws + WS_WINO) + (size_t)lp * NREC * D, MT, NREC, D, nullptr, nullptr, 0}; pg8::StaticOrder S; S.init(MT, NREC, F.G, F.bid);
            pg8::EpiOddIn E{(bf16_t*)(ws + WS_P5), (const float*)(ws + WS_LB) + lp * 2048};
            pg8::gemm_phase<pg8::EpiOddIn, pg8::StaticOrder, true, false>(F.lds, g, S, E, F.tid);
        }
        SEAM(pb + O2_GIN);
        if (IN(pb + O3_SCAN1)) for (int rep_ = 0; rep_ < NREP(O3_SCAN1); ++rep_) {
            const bf16_t* P5 = (const bf16_t*)(ws + WS_P5); float* SST = (float*)(ws + WS_SST); float* EG = (float*)(ws + WS_EG); float* S0 = (float*)(ws + WS_S0);
            const float* gain = F.in[I_RNORM] + lp * D;
            for (int it = F.bid; it < 16 + 2048; it += F.G) {
                if (it < 16) { const int b = it >> 3, h = it & 7;
                    scan_pass3_item(F, P5, (size_t)ML + b * TCX, h, nullptr, nullptr, S0 + (size_t)((b * 8 + h) * 2 + 0) * 16384, S0 + (size_t)((b * 8 + h) * 2 + 1) * 16384, gain, YE, H, !lastl);
                } else { const int i2 = it - 16, seg = i2 & 63, dir = (i2 >> 6) & 1, h = (i2 >> 7) & 7, b = i2 >> 10;
                    scan_pass1_item(F, P5, b, h, dir, seg, SST, EG); }
            }
        }
        SEAM(pb + O3_SCAN1);
        if (IN(pb + O4_CARRY)) for (int rep_ = 0; rep_ < NREP(O4_CARRY); ++rep_) { scan_carry(F); moe_convert(F, lp); }
        SEAM(pb + O4_CARRY);
        if (IN(pb + O5_SCAN3)) for (int rep_ = 0; rep_ < NREP(O5_SCAN3); ++rep_) {
            const bf16_t* P5 = (const bf16_t*)(ws + WS_P5); const float* SST = (const float*)(ws + WS_SST);
            const float* gain = F.in[I_RNORM] + lp * D;
            for (int it = F.bid; it < 1024; it += F.G) { const int seg = it & 63, h = (it >> 6) & 7, b = it >> 9; const int ch0 = (b * 8 + h) * 2;
                scan_pass3_item(F, P5, (size_t)b * TL + (size_t)seg * SEGL, h, SST + ((size_t)ch0 * NSEG + seg) * 16384, SST + ((size_t)(ch0 + 1) * NSEG + seg) * 16384, nullptr, nullptr, gain, YE, H, true); }
        }
        SEAM(pb + O5_SCAN3);
        if (IN(pb + O6_GOUT)) for (int rep_ = 0; rep_ < NREP(O6_GOUT); ++rep_) {
            pg8::Gemm g{H, (const bf16_t*)(ws + WS_WOUTO) + (size_t)lp * D * D, MT, D, D, nullptr, nullptr, 0}; pg8::StaticOrder S; S.init(MT, D, F.G, F.bid);
            pg8::EpiRes E{F.out, XC, F.out, XC, modO + 2 * D};
            pg8::gemm_phase<pg8::EpiRes, pg8::StaticOrder, false, false>(F.lds, g, S, E, F.tid);
        }
        SEAM(pb + O6_GOUT);
        const int nrm = lastl ? ML : MT;
        if (IN(pb + O7_NORM)) for (int rep_ = 0; rep_ < NREP(O7_NORM); ++rep_) {
            RowPass P{}; P.sl = F.out; P.sc = XC; P.gain = F.in[I_NFFN] + lo_ * D; P.shift = modO + 3 * D; P.scale = modO + 4 * D; P.H = H; P.nrows = nrm;
            P.rw = F.in[I_RW] + (size_t)lp * D * NE; P.tope = (int*)(ws + WS_TOPE); P.toppo = (float*)(ws + WS_TOPP); P.rank = (int*)(ws + WS_RANK); P.cnt = (int*)(ws + WS_CNT);
            row_pass<false, true, false>(F, P);
        }
        SEAM(pb + O7_NORM);
        if (IN(pb + O8_SLOTS)) for (int rep_ = 0; rep_ < NREP(O8_SLOTS); ++rep_) moe_slots(F, nrm);
        SEAM(pb + O8_SLOTS);
        if (IN(pb + O9_MUP)) for (int rep_ = 0; rep_ < NREP(O9_MUP); ++rep_) {
            const int* tilex = (const int*)(ws + WS_TILEX); const int ntiles = tilex[0];
            pg8::Gemm g{H, (const bf16_t*)(ws + WS_W13M), ntiles * 256, NEX2, D, (const int*)(ws + WS_SLOTROW), tilex + 16, (size_t)NEX2 * D}; pg8::StaticOrder S; S.init(ntiles * 256, NEX2, F.G, F.bid);
            pg8::EpiSwiglu E{(bf16_t*)(ws + WS_HIDM), DEX};
            pg8::gemm_phase<pg8::EpiSwiglu, pg8::StaticOrder, true, true>(F.lds, g, S, E, F.tid);
        }
        SEAM(pb + O9_MUP);
        if (IN(pb + O10_MDOWN)) for (int rep_ = 0; rep_ < NREP(O10_MDOWN); ++rep_) {
            const int* tilex = (const int*)(ws + WS_TILEX); const int ntiles = tilex[0];
            pg8::Gemm g{(const bf16_t*)(ws + WS_HIDM), (const bf16_t*)(ws + WS_W2M), ntiles * 256, D, DEX, nullptr, tilex + 16, (size_t)D * DEX}; pg8::StaticOrder S; S.init(ntiles * 256, D, F.G, F.bid);
            pg8::EpiMoeDown E{YE, (const int*)(ws + WS_SLOTDST)};
            pg8::gemm_phase<pg8::EpiMoeDown, pg8::StaticOrder, true, false>(F.lds, g, S, E, F.tid);
        }
        SEAM(pb + O10_MDOWN);
    }
    if (IN(PH_FINAL)) {
        RowPass P{}; P.sl = F.out; P.sc = XC; P.dl = F.out; P.dc = XC; P.gain = F.in[I_NOUT]; P.nrows = ML; P.YE = YE; P.topp = (const float*)(ws + WS_TOPP); P.gatef = mods + (size_t)3 * 3 * 6144 + 5 * D; P.fout = F.out;
        row_pass<true, false, true>(F, P);
    }
#undef IN
#undef SEAM
}

extern "C" void kernel_launch(void* const* d_in, const int* in_sizes, int n_in, void* d_out, int out_size, void* d_ws, size_t ws_size, hipStream_t stream) {
    static int grid = 0;
    if (grid == 0) {
        if (n_in != 24 || out_size != ML * D || ws_size < WS_END) { fprintf(stderr, "kernel_launch: unexpected problem (n_in %d, out %d, ws %zu < %zu)\n", n_in, out_size, ws_size, (size_t)WS_END); grid = -1; return; }
        int dev = 0, cus = 0, per_cu = 0;
        if (hipGetDevice(&dev) != hipSuccess || hipDeviceGetAttribute(&cus, hipDeviceAttributeMultiprocessorCount, dev) != hipSuccess) { grid = -1; return; }
        if (hipFuncSetAttribute((const void*)fwd_kernel, hipFuncAttributeMaxDynamicSharedMemorySize, LDS_BYTES) != hipSuccess) { fprintf(stderr, "kernel_launch: hipFuncSetAttribute failed\n"); grid = -1; return; }
        if (hipOccupancyMaxActiveBlocksPerMultiprocessor(&per_cu, (const void*)fwd_kernel, 512, LDS_BYTES) != hipSuccess || per_cu < 1) fprintf(stderr, "kernel_launch: occupancy query says %d\n", per_cu);
        (void)hipGetLastError();
        grid = cus;
    }
    if (grid < 0) return;
    (void)hipMemsetAsync((char*)d_ws + WS_CTL, 0, CTL_BYTES, stream);
    Args a{};
    for (int i = 0; i < 24; ++i) a.in[i] = (const float*)d_in[i];
    a.out = (float*)d_out; a.ws = (unsigned char*)d_ws;
#if PER_PHASE_LAUNCH
    for (int p = 0; p < NPHASE && p < PHASE_LIMIT; ++p) { a.ph_lo = p; a.ph_hi = p + 1; hipLaunchKernelGGL(fwd_kernel, dim3(grid), dim3(512), LDS_BYTES, stream, a); }
#else
    a.ph_lo = 0; a.ph_hi = NPHASE; hipLaunchKernelGGL(fwd_kernel, dim3(grid), dim3(512), LDS_BYTES, stream, a);
#endif
}
```

```cpp
#include <hip/hip_runtime.h>
#include <cstdio>
#include <cstdint>

#ifndef PER_PHASE_LAUNCH
#define PER_PHASE_LAUNCH 0
#endif
#ifndef REP_MASK
#define REP_MASK 0
#endif
#define NREP(x) (((REP_MASK >> (x)) & 1) ? 2 : 1)
#ifndef PHASE_LIMIT
#define PHASE_LIMIT 100
#endif
#ifndef P0_MASK
#define P0_MASK 63
#endif
#ifndef P0_T
#define P0_T 127
#endif

#define LAS __attribute__((address_space(3)))
typedef unsigned short bf16_t;
typedef short bf16x8 __attribute__((ext_vector_type(8)));
typedef short s16x4 __attribute__((ext_vector_type(4)));
typedef float f32x4 __attribute__((ext_vector_type(4)));
typedef float f32x2 __attribute__((ext_vector_type(2)));
typedef unsigned u32x4 __attribute__((ext_vector_type(4)));
typedef unsigned u32x2 __attribute__((ext_vector_type(2)));

constexpr int D = 1024, TL = 16384, ML = 32768, TCX = 256, MC = 512, MT = 33280;
constexpr int NEIN = 2048, DFF = 2816, NFF2 = 5632, NREC = 5120, DEX = 3584, NEX2 = 7168, NE = 8;
constexpr int NSEG = 64, SEGL = 256, CH = 32, NCHAIN = 32;
constexpr int MAXTILES = 268, NITEM16 = MT / 16;
constexpr float EPS = 1e-6f;

constexpr size_t MiB = 1u << 20, KiB = 1u << 10;
constexpr size_t WS_CTL = 0, CTL_BYTES = 1 * MiB;
constexpr size_t WS_MODS = 1 * MiB, WS_LB = 1 * MiB + 512 * KiB;
constexpr size_t WS_FA = 2 * MiB, WS_FC = 2 * MiB + 128 * KiB, WS_FX = 2 * MiB + 256 * KiB, WS_GW = 2 * MiB + 512 * KiB;
constexpr size_t WS_XC = 3 * MiB;
constexpr size_t WS_TOPE = 5 * MiB, WS_TOPP = 5 * MiB + 512 * KiB, WS_RANK = 6 * MiB, WS_CNT = 6 * MiB + 512 * KiB, WS_TILEX = 6 * MiB + 768 * KiB, WS_SLOTROW = 7 * MiB, WS_SLOTDST = 7 * MiB + 512 * KiB;
constexpr size_t WS_WINE = 8 * MiB, WS_WOUTE = 16 * MiB, WS_WINO = 20 * MiB, WS_WOUTO = 40 * MiB, WS_W13 = 44 * MiB, WS_W2 = 66 * MiB;
constexpr size_t WS_W13M = 80 * MiB, WS_W2M = 192 * MiB;
constexpr size_t WS_H = 248 * MiB, WS_YE = 314 * MiB, WS_BIG = 444 * MiB;
constexpr size_t WS_PZUV = WS_BIG, WS_UP = WS_BIG + 130 * MiB, WS_HID = WS_BIG, WS_P5 = WS_BIG, WS_SST = WS_BIG + 325 * MiB, WS_EG = WS_BIG + 453 * MiB, WS_S0 = WS_BIG + 454 * MiB, WS_HIDM = WS_BIG;
constexpr size_t WS_END = WS_BIG + 469 * MiB;
static_assert(WS_W2 + (size_t)2 * D * DFF * 2 <= WS_W13M, "static weights");
static_assert(WS_W2M + (size_t)NE * D * DEX * 2 <= WS_H && WS_H + (size_t)MT * D * 2 <= WS_YE && WS_YE + (size_t)MT * 2 * D * 2 <= WS_BIG, "ws map");
static_assert((size_t)MAXTILES * 256 * DEX * 2 <= 469 * MiB && (size_t)MT * NREC * 2 <= 325 * MiB && (size_t)MT * NEIN * 2 <= 130 * MiB, "big region");

constexpr int LDS_BYTES = 147456, MISC_OFF = 147456 - 256;
constexpr int XRS = 288;

typedef __bf16 bf16x2_t __attribute__((ext_vector_type(2)));
__device__ __forceinline__ unsigned f2bf(float f) { return (unsigned)__builtin_bit_cast(unsigned short, (__bf16)f); }
__device__ __forceinline__ unsigned pk2(float lo, float hi) { return __builtin_bit_cast(unsigned, __builtin_convertvector((f32x2){lo, hi}, bf16x2_t)); }
__device__ __forceinline__ float bf2f(unsigned short b) { return __builtin_bit_cast(float, (unsigned)b << 16); }
__device__ __forceinline__ float bflo(unsigned w) { return __builtin_bit_cast(float, w << 16); }
__device__ __forceinline__ float bfhi(unsigned w) { return __builtin_bit_cast(float, w & 0xffff0000u); }
__device__ __forceinline__ float wave_sum(float v) {
#pragma unroll
    for (int o = 1; o < 64; o <<= 1) v += __shfl_xor(v, o);
    return v;
}
__device__ __forceinline__ float siluf(float a) { return a * __builtin_amdgcn_rcpf(1.0f + __expf(-a)); }
#define WQ_NEXT(it, ctr, slot, G) do { __syncthreads(); if (threadIdx.x == 0) *(slot) = (unsigned)(G) + __hip_atomic_fetch_add((ctr), 1u, __ATOMIC_RELAXED, __HIP_MEMORY_SCOPE_AGENT); __syncthreads(); (it) = (int)*(slot); } while (0)
#define LDS_WAIT() asm volatile("s_waitcnt lgkmcnt(0)" ::: "memory")
#define VM_WAIT() asm volatile("s_waitcnt vmcnt(0)" ::: "memory")

#define XB_TMO      128
#define XB_XCNT(j)  (256  + 64 * (j))
#define XB_XSUB(j)  (1280 + 64 * (j))
#define XB_XGEN(j)  (2304 + 64 * (j))
#define XB_TOP      3328
#define XB_TOPGEN   3392
#define XCD_BAR_WORDS 3456
#define XB_SPIN_CAP (1u << 18)
__device__ __forceinline__ unsigned xb_ld(unsigned* p)              { return __hip_atomic_load(p, __ATOMIC_RELAXED, __HIP_MEMORY_SCOPE_AGENT); }
__device__ __forceinline__ unsigned xb_add(unsigned* p, unsigned v) { return __hip_atomic_fetch_add(p, v, __ATOMIC_RELAXED, __HIP_MEMORY_SCOPE_AGENT); }
__device__ __forceinline__ unsigned xb_xcc_id() { return (unsigned)__builtin_amdgcn_s_getreg((3 << 11) | 20) & 0xFu; }
#define XB_SPIN(cond, bar) do { unsigned _sp = 0; while (cond) { __builtin_amdgcn_s_sleep(1); \
    if ((++_sp & 255u) == 0u) { if (xb_ld(&(bar)[XB_TMO])) break; if (_sp > XB_SPIN_CAP) { atomicAdd(&(bar)[XB_TMO], 1u); break; } } } } while (0)
struct XcdBarrier { unsigned* bar; unsigned x; volatile LAS unsigned* st; };
__device__ __forceinline__ XcdBarrier xcd_barrier_post(unsigned* bar, volatile LAS unsigned* st) {
    XcdBarrier b; b.bar = bar; b.x = xb_xcc_id(); b.st = st;
    if (threadIdx.x == 0) (void)xb_add(&bar[XB_XCNT(b.x)], 1u);
    return b;
}
__device__ __forceinline__ void xcd_barrier_complete(unsigned* bar, unsigned x, unsigned& nloc, unsigned& nx) {
    const unsigned G = gridDim.x * gridDim.y * gridDim.z;
    unsigned sum, cnt, mine, sp = 0u;
    for (;;) {
        sum = 0u; cnt = 0u; mine = 0u;
#pragma unroll
        for (unsigned j = 0; j < 16; ++j) { const unsigned c = xb_ld(&bar[XB_XCNT(j)]); sum += c; cnt += (c > 0u) ? 1u : 0u; mine = (j == x) ? c : mine; }
        if (sum == G) break;
        __builtin_amdgcn_s_sleep(1);
        if ((++sp & 255u) == 0u) { if (xb_ld(&bar[XB_TMO])) break; if (sp > XB_SPIN_CAP) { atomicAdd(&bar[XB_TMO], 1u); break; } }
    }
    nloc = mine > 0u ? mine : 1u; nx = cnt > 0u ? cnt : 1u;
}
__device__ __forceinline__ void xcd_barrier(const XcdBarrier& b) {
    asm volatile("s_waitcnt vmcnt(0)" ::: "memory");
    __syncthreads();
    if (threadIdx.x == 0) {
        unsigned* bar = b.bar;
        __builtin_amdgcn_s_waitcnt(0);
        unsigned nloc = b.st[0], nx = b.st[1];
        if (nloc == 0u) { xcd_barrier_complete(bar, b.x, nloc, nx); b.st[0] = nloc; b.st[1] = nx; }
        const unsigned old = xb_add(&bar[XB_XSUB(b.x)], 1u);
        const unsigned gen = old / nloc;
        if (old + 1u == (gen + 1u) * nloc) {
            __builtin_amdgcn_fence(__ATOMIC_RELEASE, "agent");
            asm volatile("s_waitcnt vmcnt(0)" ::: "memory");
            const unsigned og = xb_add(&bar[XB_TOP], 1u);
            const unsigned tg = og / nx;
            if (og + 1u == (tg + 1u) * nx) xb_add(&bar[XB_TOPGEN], 1u);
            else XB_SPIN(xb_ld(&bar[XB_TOPGEN]) == tg, bar);
            __builtin_amdgcn_fence(__ATOMIC_ACQUIRE, "agent");
            xb_add(&bar[XB_XGEN(b.x)], 1u);
            asm volatile("s_waitcnt vmcnt(0)" ::: "memory");
        } else {
            XB_SPIN(xb_ld(&bar[XB_XGEN(b.x)]) == gen, bar);
            __builtin_amdgcn_fence(__ATOMIC_ACQUIRE, "agent");
            asm volatile("s_waitcnt vmcnt(0)" ::: "memory");
        }
    }
    __syncthreads();
}

namespace pg8 {
constexpr int BM = 256, BK = 64, HALF = 128, HTB = HALF * BK * 2, STAGE_BYTES = 8 * HTB, NXCD = 8, WGM = 8;
__host__ __device__ __forceinline__ int lds_byte(int r, int c) { const int st = (r >> 4) * 2 + (c >> 5), rr = r & 15, cc = c & 31, ob = rr * 64 + cc * 2; return st * 1024 + (ob ^ (((ob >> 9) & 1) << 5)); }
__host__ __device__ __forceinline__ void stage_rc(int b, int& R, int& C) { const int st = b / 1024, sb = b % 1024, swz = sb ^ (((sb >> 9) & 1) << 5); R = (st >> 1) * 16 + swz / 64; C = (st & 1) * 32 + (swz % 64) / 2; }
__host__ __device__ __forceinline__ int perm32(int rho) { const int n = rho >> 4, i = rho & 15; return 8 * (i >> 2) + 4 * n + (i & 3); }
struct Unit { int pm, pn; };
struct Gemm { const bf16_t* A; const bf16_t* Bt; int M, N, K; const int* arow; const int* grp; size_t gstride; };
struct StaticOrder {
    int nM, nN, nwg, G, c;
    __host__ __device__ void init(int M, int N, int G_, int c_) { nM = M / BM; nN = N / BM; nwg = nM * nN; G = G_; c = c_; }
    __host__ __device__ bool next(int i, Unit& u) const {
        const long L = (long)i * G + c; if (L >= nwg) return false;
        int wgid = (int)L; { const int q = nwg / NXCD, r = nwg % NXCD, xcd = wgid % NXCD, off = wgid / NXCD; wgid = (xcd < r ? xcd * (q + 1) : r * (q + 1) + (xcd - r) * q) + off; }
        const int nig = WGM * nN, gid = wgid / nig, fm = gid * WGM, gsz = (nM - fm) < WGM ? (nM - fm) : WGM;
        u.pm = fm + ((wgid % nig) % gsz); u.pn = (wgid % nig) / gsz; return true;
    }
};
__device__ __forceinline__ unsigned cvt_pk_bf16(float lo, float hi) { unsigned r; asm volatile("v_cvt_pk_bf16_f32 %0, %1, %2" : "=v"(r) : "v"(lo), "v"(hi)); return r; }
__device__ __forceinline__ f32x2 gelu_pk(f32x2 v) {
    const f32x2 av = __builtin_elementwise_abs(v), d = av * 0.2316418882f + 1.0f;
    f32x2 t; t.x = __builtin_amdgcn_rcpf(d.x); t.y = __builtin_amdgcn_rcpf(d.y);
    f32x2 q = t * 0.5307027145f + (-0.7265760135f); q = q * t + 0.7107068705f; q = q * t + (-0.142248368f); q = q * t + 0.127414796f; q = q * t;
    const f32x2 s = (v * v) * (-0.72134752044f);
    f32x2 e; e.x = __builtin_amdgcn_exp2f(s.x); e.y = __builtin_amdgcn_exp2f(s.y);
    const f32x2 m = v * (q * e), r = v - m;
    f32x2 o; o.x = v.x < 0.f ? m.x : r.x; o.y = v.y < 0.f ? m.y : r.y; return o;
}
template <class Epi, class Sched, bool ALIGN_EPI, bool GATHER>
__device__ __forceinline__ void gemm_phase(LAS unsigned char* lds, const Gemm g, const Sched& S, const Epi& E, const int tid) {
    const int wid = __builtin_amdgcn_readfirstlane(tid >> 6), lane = tid & 63, wr = wid >> 2, wc = wid & 3, fr = lane & 15, fq = lane >> 4;
    const int K = g.K, nt = K / BK;
    unsigned voffA[2], voffB[2];
    unsigned voffA1[2];
#pragma unroll
    for (int i = 0; i < 2; ++i) { int R, C; stage_rc(tid * 16 + i * 8192, R, C); const int Rb = Epi::PERM ? ((R & ~31) + perm32(R & 31)) : R;
        voffA[i] = (unsigned)(R * K + C) * 2u; voffA1[i] = voffA[i]; voffB[i] = (unsigned)(Rb * K + C) * 2u; }
    const size_t kstep = (size_t)(BK * 2);
    const size_t hstep = (size_t)HALF * K * 2;
    const size_t tstep = 2 * hstep;
    const unsigned ldsw = (unsigned)wid * 1024u;
    const int aoff = lds_byte(wr * 64 + fr, fq * 8), boff = lds_byte(wc * 32 + fr, fq * 8);
#define PG8_SA(b, h) (((b) * 2 + (h)) * HTB)
#define PG8_SB(b, h) ((4 + (b) * 2 + (h)) * HTB)
#define PG8_STAGE(bufoff, gbase, voff) do { _Pragma("unroll") for (int _i = 0; _i < 2; ++_i) \
        __builtin_amdgcn_global_load_lds((const unsigned*)((const char*)(gbase) + (voff)[_i]), (LAS unsigned*)(lds + (bufoff) + ldsw + _i * 8192), 16, 0, 0); } while (0)
#define PG8_LDA(dst, b, h) do { _Pragma("unroll") for (int m = 0; m < 4; ++m) _Pragma("unroll") for (int k = 0; k < 2; ++k) dst[m][k] = *(const LAS bf16x8*)(lds + PG8_SA(b, h) + aoff + m * 2048 + k * 1024); } while (0)
#define PG8_LDB(dst, b, h) do { _Pragma("unroll") for (int n = 0; n < 2; ++n) _Pragma("unroll") for (int k = 0; k < 2; ++k) dst[n][k] = *(const LAS bf16x8*)(lds + PG8_SB(b, h) + boff + n * 2048 + k * 1024); } while (0)
#define PG8_MMA(ai, bj, At, Bt) do { __builtin_amdgcn_s_setprio(1); _Pragma("unroll") for (int m = 0; m < 4; ++m) _Pragma("unroll") for (int n = 0; n < 2; ++n) _Pragma("unroll") for (int k = 0; k < 2; ++k) \
        acc[ai][bj][m][n] = __builtin_amdgcn_mfma_f32_16x16x32_bf16(Bt[n][k], At[m][k], acc[ai][bj][m][n], 0, 0, 0); __builtin_amdgcn_s_setprio(0); } while (0)
#define PG8_WAIT_V(n) asm volatile("s_waitcnt vmcnt(" #n ")" ::: "memory")
#define PG8_WAIT_L(n) asm volatile("s_waitcnt lgkmcnt(" #n ")" ::: "memory")
#define PG8_BAR __builtin_amdgcn_s_barrier()
#define PG8_SCHED __builtin_amdgcn_sched_barrier(0)
#define PG8_GOFF(u, v0, v1) do { _Pragma("unroll") for (int _i = 0; _i < 2; ++_i) { int R_, C_; stage_rc(tid * 16 + _i * 8192, R_, C_); \
        const int r0_ = g.arow[(u).pm * BM + R_], r1_ = g.arow[(u).pm * BM + HALF + R_]; v0[_i] = (unsigned)(r0_ * K + C_) * 2u; v1[_i] = (unsigned)(r1_ * K + C_) * 2u; } } while (0)
#define PG8_BBASE(u) ((const char*)g.Bt + (g.grp ? (size_t)g.grp[(u).pm] * g.gstride * 2 : (size_t)0) + (size_t)(u).pn * tstep)
    Unit cur, nxt; int ui = 0;
    if (!S.next(0, cur)) return;
    f32x4 acc[2][2][4][2];
#pragma unroll
    for (int a = 0; a < 2; ++a)
#pragma unroll
        for (int b = 0; b < 2; ++b)
#pragma unroll
            for (int m = 0; m < 4; ++m)
#pragma unroll
                for (int n = 0; n < 2; ++n) acc[a][b][m][n] = (f32x4){0.f, 0.f, 0.f, 0.f};
    bf16x8 At[4][2], B0[2][2], B1[2][2];
    const char* cA = GATHER ? (const char*)g.A : (const char*)g.A + (size_t)cur.pm * tstep;
    const size_t ah = GATHER ? (size_t)0 : hstep;
    if constexpr (GATHER) PG8_GOFF(cur, voffA, voffA1);
    const char* cB = PG8_BBASE(cur);
    PG8_STAGE(PG8_SB(0, 0), cB, voffB); PG8_STAGE(PG8_SA(0, 0), cA, voffA); PG8_STAGE(PG8_SB(0, 1), cB + hstep, voffB); PG8_STAGE(PG8_SA(0, 1), cA + ah, voffA1);
    if (wr == 1) PG8_BAR;
    PG8_WAIT_V(4); PG8_BAR;
    PG8_STAGE(PG8_SB(1, 0), cB + kstep, voffB); PG8_STAGE(PG8_SA(1, 0), cA + kstep, voffA); PG8_STAGE(PG8_SB(1, 1), cB + hstep + kstep, voffB);
    PG8_WAIT_V(6); PG8_BAR;
    for (;;) {
        const bool has_next = S.next(ui + 1, nxt);
        const char* nA = (GATHER || !has_next) ? cA : (const char*)g.A + (size_t)nxt.pm * tstep; const char* nB = has_next ? PG8_BBASE(nxt) : cB;
        for (int t = 0; t < nt; t += 2) {
            const bool last = (t == nt - 2);
            const char* a1 = cA + (size_t)(t + 1) * kstep;
            const char* a2 = last ? nA : cA + (size_t)(t + 2) * kstep; const char* b2 = last ? nB : cB + (size_t)(t + 2) * kstep;
            const char* a3 = a2 + kstep; const char* b3 = b2 + kstep;
            PG8_LDB(B0, 0, 0); PG8_SCHED; PG8_LDA(At, 0, 0); PG8_STAGE(PG8_SA(1, 1), a1 + ah, voffA1);
            if constexpr (GATHER) { if (last && has_next) PG8_GOFF(nxt, voffA, voffA1); }
            PG8_WAIT_L(8); PG8_BAR; PG8_WAIT_L(0); PG8_MMA(0, 0, At, B0); PG8_BAR; PG8_SCHED;
            PG8_LDB(B1, 0, 1); PG8_STAGE(PG8_SB(0, 0), b2, voffB);
            PG8_BAR; PG8_WAIT_L(0); PG8_MMA(0, 1, At, B1); PG8_BAR;
            PG8_LDA(At, 0, 1); PG8_STAGE(PG8_SA(0, 0), a2, voffA);
            PG8_BAR; PG8_WAIT_L(0); PG8_MMA(1, 0, At, B0); PG8_BAR; PG8_SCHED;
            PG8_STAGE(PG8_SB(0, 1), b2 + hstep, voffB);
            PG8_WAIT_V(6); PG8_BAR; PG8_MMA(1, 1, At, B1); PG8_BAR;
            PG8_LDB(B0, 1, 0); PG8_SCHED; PG8_LDA(At, 1, 0); PG8_STAGE(PG8_SA(0, 1), a2 + ah, voffA1);
            PG8_WAIT_L(8); PG8_BAR; PG8_WAIT_L(0); PG8_MMA(0, 0, At, B0); PG8_BAR; PG8_SCHED;
            PG8_LDB(B1, 1, 1); PG8_STAGE(PG8_SB(1, 0), b3, voffB);
            PG8_BAR; PG8_WAIT_L(0); PG8_MMA(0, 1, At, B1); PG8_BAR;
            PG8_LDA(At, 1, 1); PG8_STAGE(PG8_SA(1, 0), a3, voffA);
            PG8_BAR; PG8_WAIT_L(0); PG8_MMA(1, 0, At, B0); PG8_BAR; PG8_SCHED;
            PG8_STAGE(PG8_SB(1, 1), b3 + hstep, voffB);
            PG8_WAIT_V(6); PG8_BAR; PG8_MMA(1, 1, At, B1); PG8_BAR;
        }
        if constexpr (ALIGN_EPI) { if (wr == 0) PG8_BAR; }
        E(acc, cur, wr, wc, fr, fq);
        if (!has_next) break;
#pragma unroll
        for (int a = 0; a < 2; ++a)
#pragma unroll
            for (int b = 0; b < 2; ++b)
#pragma unroll
                for (int m = 0; m < 4; ++m)
#pragma unroll
                    for (int n = 0; n < 2; ++n) acc[a][b][m][n] = (f32x4){0.f, 0.f, 0.f, 0.f};
        cur = nxt; cA = nA; cB = nB; ++ui;
        if constexpr (ALIGN_EPI) { if (wr == 1) PG8_BAR; }
    }
    PG8_WAIT_V(0);
    if constexpr (!ALIGN_EPI) { if (wr == 0) PG8_BAR; }
    PG8_BAR;
#undef PG8_SA
#undef PG8_SB
#undef PG8_STAGE
#undef PG8_LDA
#undef PG8_LDB
#undef PG8_MMA
#undef PG8_WAIT_V
#undef PG8_WAIT_L
#undef PG8_BAR
#undef PG8_SCHED
#undef PG8_GOFF
#undef PG8_BBASE
}

struct EpiEvenIn {
    static constexpr bool PERM = true;
    bf16_t* O;
    __device__ __forceinline__ void operator()(const f32x4 (&acc)[2][2][4][2], const Unit& u, int wr, int wc, int fr, int fq) const {
        const int row0 = u.pm * BM + wr * 64 + fr, col0 = u.pn * BM + wc * 32 + 8 * fq; const bool act = u.pn >= 4;
#pragma unroll
        for (int ai = 0; ai < 2; ++ai)
#pragma unroll
            for (int m = 0; m < 4; ++m) { bf16_t* rowp = O + (size_t)(row0 + ai * HALF + m * 16) * NEIN + col0;
#pragma unroll
                for (int bj = 0; bj < 2; ++bj) { f32x4 v0 = acc[ai][bj][m][0], v1 = acc[ai][bj][m][1];
                    if (act) { f32x2 a = gelu_pk((f32x2){v0[0], v0[1]}), b = gelu_pk((f32x2){v0[2], v0[3]}), c = gelu_pk((f32x2){v1[0], v1[1]}), d = gelu_pk((f32x2){v1[2], v1[3]});
                        v0 = (f32x4){a.x, a.y, b.x, b.y}; v1 = (f32x4){c.x, c.y, d.x, d.y}; }
                    u32x4 w; w.x = cvt_pk_bf16(v0[0], v0[1]); w.y = cvt_pk_bf16(v0[2], v0[3]); w.z = cvt_pk_bf16(v1[0], v1[1]); w.w = cvt_pk_bf16(v1[2], v1[3]);
                    *(u32x4*)(rowp + bj * HALF) = w; } }
    }
};
struct EpiRes {
    static constexpr bool PERM = false;
    const float* sl; const float* sc; float* dl; float* dc; const float* gate;
    __device__ __forceinline__ void operator()(const f32x4 (&acc)[2][2][4][2], const Unit& u, int wr, int wc, int fr, int fq) const {
        const int col0 = u.pn * BM + wc * 32 + 4 * fq;
        const bool isc = u.pm >= 128; const int ms = isc ? 2 : (u.pm >= 64 ? 1 : 0);
        const size_t rbase = isc ? (size_t)(u.pm - 128) * BM : (size_t)u.pm * BM;
        const float* src = (isc ? sc : sl) + rbase * D; float* dst = (isc ? dc : dl) + rbase * D;
        f32x4 gv[2][2];
#pragma unroll
        for (int bj = 0; bj < 2; ++bj)
#pragma unroll
            for (int n = 0; n < 2; ++n) gv[bj][n] = *(const f32x4*)(gate + ms * 6144 + col0 + bj * HALF + n * 16);
#pragma unroll
        for (int ai = 0; ai < 2; ++ai)
#pragma unroll
            for (int m = 0; m < 4; ++m) { const size_t off = (size_t)(ai * HALF + wr * 64 + m * 16 + fr) * D + col0;
#pragma unroll
                for (int bj = 0; bj < 2; ++bj)
#pragma unroll
                    for (int n = 0; n < 2; ++n) { const f32x4 xs = *(const f32x4*)(src + off + bj * HALF + n * 16); *(f32x4*)(dst + off + bj * HALF + n * 16) = xs + gv[bj][n] * acc[ai][bj][m][n]; } }
    }
};
struct EpiSwiglu {
    static constexpr bool PERM = true;
    bf16_t* O; int ldc;
    __device__ __forceinline__ void operator()(const f32x4 (&acc)[2][2][4][2], const Unit& u, int wr, int wc, int fr, int fq) const {
        const int row0 = u.pm * BM + wr * 64 + fr, col0 = u.pn * 128 + wc * 16 + 4 * fq;
#pragma unroll
        for (int ai = 0; ai < 2; ++ai)
#pragma unroll
            for (int m = 0; m < 4; ++m) { bf16_t* rowp = O + (size_t)(row0 + ai * HALF + m * 16) * ldc + col0;
#pragma unroll
                for (int bj = 0; bj < 2; ++bj) { const f32x4 a = acc[ai][bj][m][0], b = acc[ai][bj][m][1];
                    u32x2 w; w.x = cvt_pk_bf16(siluf(a[0]) * b[0], siluf(a[1]) * b[1]); w.y = cvt_pk_bf16(siluf(a[2]) * b[2], siluf(a[3]) * b[3]);
                    *(u32x2*)(rowp + bj * 64) = w; } }
    }
};
struct EpiOddIn {
    static constexpr bool PERM = true;
    bf16_t* O; const float* lb;
    __device__ __forceinline__ void operator()(const f32x4 (&acc)[2][2][4][2], const Unit& u, int wr, int wc, int fr, int fq) const {
        const int row0 = u.pm * BM + wr * 64 + fr, col0 = u.pn * BM + wc * 32 + 8 * fq; const int seg = u.pn >> 2;
        f32x4 lbv[2][2];
#pragma unroll
        for (int bj = 0; bj < 2; ++bj)
#pragma unroll
            for (int n = 0; n < 2; ++n) lbv[bj][n] = (seg == 2 || seg == 3) ? *(const f32x4*)(lb + (col0 - 2048) + bj * HALF + 4 * n) : (f32x4){0.f, 0.f, 0.f, 0.f};
#pragma unroll
        for (int ai = 0; ai < 2; ++ai)
#pragma unroll
            for (int m = 0; m < 4; ++m) { bf16_t* rowp = O + (size_t)(row0 + ai * HALF + m * 16) * NREC + col0;
#pragma unroll
                for (int bj = 0; bj < 2; ++bj) { f32x4 v[2] = {acc[ai][bj][m][0], acc[ai][bj][m][1]};
#pragma unroll
                    for (int n = 0; n < 2; ++n)
#pragma unroll
                        for (int i = 0; i < 4; ++i) { float x = v[n][i];
                            if (seg == 0) x = siluf(x) * 0.08838834764831845f;
                            else if (seg == 1) x = siluf(x);
                            else if (seg == 2 || seg == 3) { const float l = lbv[bj][n][i]; const float s = __builtin_amdgcn_rcpf(1.0f + __expf(-x)); const float f = l + (1.0f - l) * s; x = __logf(fmaxf(f, 1e-30f)); }
                            v[n][i] = x; }
                    u32x4 w; w.x = cvt_pk_bf16(v[0][0], v[0][1]); w.y = cvt_pk_bf16(v[0][2], v[0][3]); w.z = cvt_pk_bf16(v[1][0], v[1][1]); w.w = cvt_pk_bf16(v[1][2], v[1][3]);
                    *(u32x4*)(rowp + bj * HALF) = w; } }
    }
};
struct EpiMoeDown {
    static constexpr bool PERM = true;
    bf16_t* O; const int* dst;
    __device__ __forceinline__ void operator()(const f32x4 (&acc)[2][2][4][2], const Unit& u, int wr, int wc, int fr, int fq) const {
        const int row0 = u.pm * BM + wr * 64 + fr, col0 = u.pn * BM + wc * 32 + 8 * fq;
        int dd[2][4];
#pragma unroll
        for (int ai = 0; ai < 2; ++ai)
#pragma unroll
            for (int m = 0; m < 4; ++m) dd[ai][m] = dst[row0 + ai * HALF + m * 16];
#pragma unroll
        for (int ai = 0; ai < 2; ++ai)
#pragma unroll
            for (int m = 0; m < 4; ++m) { if (dd[ai][m] >= 0) { bf16_t* rowp = O + (size_t)dd[ai][m] * D + col0;
#pragma unroll
                for (int bj = 0; bj < 2; ++bj) { const f32x4 v0 = acc[ai][bj][m][0], v1 = acc[ai][bj][m][1];
                    u32x4 w; w.x = cvt_pk_bf16(v0[0], v0[1]); w.y = cvt_pk_bf16(v0[2], v0[3]); w.z = cvt_pk_bf16(v1[0], v1[1]); w.w = cvt_pk_bf16(v1[2], v1[3]);
                    *(u32x4*)(rowp + bj * HALF) = w; } } }
    }
};
}

struct Args { const float* in[24]; float* out; unsigned char* ws; int ph_lo, ph_hi; };
enum { I_X = 0, I_C, I_CTX, I_CCTX, I_WADA, I_BADA, I_NMIX, I_NFFN, I_NOUT, I_WINE, I_GW, I_GB, I_WOUTE, I_WINO, I_RLB, I_RNORM, I_WOUTO, I_F1, I_F3, I_F2, I_RW, I_M1, I_M3, I_M2 };
enum { PH_P0 = 0, PH_PAIR0 = 1, NPL = 18, PH_FINAL = 1 + 2 * NPL, NPHASE = PH_FINAL + 1 };
enum { E1_NORM = 0, E2_GIN, E3_FFTA, E3_FFTC, E4_GOUT, E5_NORM, E6_UP, E7_DOWN, O1_NORM, O2_GIN, O3_SCAN1, O4_CARRY, O5_SCAN3, O6_GOUT, O7_NORM, O8_SLOTS, O9_MUP, O10_MDOWN };

struct Ctx {
    LAS unsigned char* lds; int tid, lane, wave, G, bid, gw, NGW;
    const float* const* in; float* out; unsigned char* ws;
};

__device__ __forceinline__ void transpose_item(const float* W, int ld, int K, int N, bf16_t* WT, int mode, int roff, int item, int lane) {
    const int nblk = N / 64, kb = item / nblk, nb = item % nblk, k0 = 64 * kb, n0 = 64 * nb;
    const int c = lane & 15, kg = lane >> 4;
    const float* src = W + (size_t)(k0 + 8 * kg) * ld + n0 + 4 * c;
    f32x4 v[2][8];
#pragma unroll
    for (int hf = 0; hf < 2; ++hf)
#pragma unroll
        for (int i = 0; i < 8; ++i) v[hf][i] = __builtin_nontemporal_load((const f32x4*)(src + (size_t)(32 * hf + i) * ld));
#pragma unroll
    for (int i = 0; i < 4; ++i) { const int ng = n0 + 4 * c + i; const int drow = mode == 0 ? (roff + ng) : (((ng >> 2) << 3) + (ng & 3) + roff);
#pragma unroll
        for (int hf = 0; hf < 2; ++hf) { u32x4 o; o.x = pk2(v[hf][0][i], v[hf][1][i]); o.y = pk2(v[hf][2][i], v[hf][3][i]); o.z = pk2(v[hf][4][i], v[hf][5][i]); o.w = pk2(v[hf][6][i], v[hf][7][i]);
            *(u32x4*)(WT + (size_t)drow * K + k0 + 32 * hf + 8 * kg) = o; } }
}

__device__ __forceinline__ void p0_prologue(const Ctx& F) {
    const int tid = F.tid, lane = F.lane, wave = F.wave;
    unsigned char* ws = F.ws;
    LAS float* scond = (LAS float*)(F.lds);
    LAS float* part = (LAS float*)(F.lds + 16384);
    LAS float* ctab = (LAS float*)(F.lds + 32768);
    for (int i = tid; i < 3 * D; i += 512) { const int v = i / D, k = i % D; const float c = v < 2 ? F.in[I_C][v * D + k] : F.in[I_CCTX][k]; scond[i] = c / (1.0f + expf(-c)); }
    if (tid < 128) ctab[tid] = cosf(6.283185307179586f * (float)tid / 128.0f);
    __syncthreads();
    float* mods = (float*)(ws + WS_MODS);
    if (P0_MASK & 1)
    for (int it = F.bid; it < 4 * 48; it += F.G) {
        const int l = it / 48, cg = it % 48; const float* W = F.in[I_WADA] + (size_t)l * D * 6144 + cg * 128 + 2 * lane;
        float a0[2] = {0.f, 0.f}, a1[2] = {0.f, 0.f}, a2[2] = {0.f, 0.f};
#pragma unroll 16
        for (int kk = 0; kk < 128; ++kk) { const int k = wave * 128 + kk; const f32x2 w = __builtin_nontemporal_load((const f32x2*)(W + (size_t)k * 6144)); const float s0 = scond[k], s1 = scond[D + k], s2 = scond[2 * D + k];
            a0[0] += s0 * w.x; a0[1] += s0 * w.y; a1[0] += s1 * w.x; a1[1] += s1 * w.y; a2[0] += s2 * w.x; a2[1] += s2 * w.y; }
        part[(wave * 3 + 0) * 128 + 2 * lane] = a0[0]; part[(wave * 3 + 0) * 128 + 2 * lane + 1] = a0[1];
        part[(wave * 3 + 1) * 128 + 2 * lane] = a1[0]; part[(wave * 3 + 1) * 128 + 2 * lane + 1] = a1[1];
        part[(wave * 3 + 2) * 128 + 2 * lane] = a2[0]; part[(wave * 3 + 2) * 128 + 2 * lane + 1] = a2[1];
        __syncthreads();
        if (tid < 384) { const int v = tid / 128, c = tid % 128; float sum = 0.f;
#pragma unroll
            for (int w = 0; w < 8; ++w) sum += part[(w * 3 + v) * 128 + c];
            mods[((size_t)l * 3 + v) * 6144 + cg * 128 + c] = sum + F.in[I_BADA][l * 6144 + cg * 128 + c]; }
        __syncthreads();
    }
    const int gt = F.bid * 512 + tid, NGT = F.G * 512;
    float* LB = (float*)(ws + WS_LB);
    if (P0_MASK & 2)
    for (int i = gt; i < 4096; i += NGT) { const int j = i >> 11, r = i & 2047; float v = 0.f; if (j == 1) { const float r0 = F.in[I_RLB][r], r1 = F.in[I_RLB][2048 + r]; v = 1.0f / (1.0f + expf(r0 - r1)); v = fminf(fmaxf(v, 0.f), 1.f); } LB[i] = v; }
    bf16_t* FA = (bf16_t*)(ws + WS_FA); bf16_t* FC = (bf16_t*)(ws + WS_FC); bf16_t* FX = (bf16_t*)(ws + WS_FX); bf16_t* GW = (bf16_t*)(ws + WS_GW);
    if (P0_MASK & 4)
    for (int i = gt; i < 256 * 256; i += NGT) { const int r = i >> 8, c = i & 255, k1 = r & 127, t1 = c & 127; const float ang = 6.283185307179586f * (float)((k1 * t1) & 127) / 128.0f; float sn, cs; sincosf(ang, &sn, &cs);
        const int rr = r >> 7, cc = c >> 7; const float v = (rr == cc) ? cs : (rr == 0 ? -sn : sn); FA[i] = (bf16_t)f2bf(v); }
    if (P0_MASK & 4)
    for (int i = gt; i < 128 * 256; i += NGT) { const int k2 = i >> 8, c = i & 255, t2 = c & 127; const float ang = 6.283185307179586f * (float)((k2 * t2) & 127) / 128.0f; float sn, cs; sincosf(ang, &sn, &cs); FC[i] = (bf16_t)f2bf(c < 128 ? cs : -sn); }
    if (P0_MASK & 4)
    for (int i = gt; i < 256 * 512; i += NGT) { const int k = i >> 9, c = i & 511, t = c & 255; const float ang = 6.283185307179586f * (float)((k * t) & 255) / 256.0f; float sn, cs; sincosf(ang, &sn, &cs); FX[i] = (bf16_t)f2bf(c < 256 ? cs : -sn); }
    if (P0_MASK & 8)
    for (int i = gt; i < 2 * 4 * 128 * 128; i += NGT) GW[i] = (bf16_t)f2bf(F.in[I_GW][i]);
    bf16_t* WinE = (bf16_t*)(ws + WS_WINE);
    if (P0_MASK & 16)
    for (int it = F.gw; it < 2 * 4 * 16 * 32; it += F.NGW) {
        const int mg = it & 31, kb = (it >> 5) & 15, g = (it >> 9) & 3, j = it >> 11; const int k = kb * 64 + lane, m0 = mg * 4;
        const float* Wr = F.in[I_WINE] + (size_t)j * D * 1536 + (size_t)k * 1536 + g * 128;
        float aP[4] = {0.f, 0.f, 0.f, 0.f}, aQ[4] = {0.f, 0.f, 0.f, 0.f};
        for (int c4 = 0; c4 < 32; ++c4) { const f32x4 w = *(const f32x4*)(Wr + 4 * c4);
#pragma unroll
            for (int ci = 0; ci < 4; ++ci) { const int c = 4 * c4 + ci;
#pragma unroll
                for (int mm = 0; mm < 4; ++mm) { const int idx = (c * (m0 + mm)) & 127; aP[mm] += w[ci] * ctab[idx]; aQ[mm] += w[ci] * ctab[(idx - 32) & 127]; } } }
#pragma unroll
        for (int mm = 0; mm < 4; ++mm) { bf16_t* o = WinE + (size_t)j * NEIN * D; o[(size_t)(g * 128 + m0 + mm) * D + k] = (bf16_t)f2bf(aP[mm]); o[(size_t)(512 + g * 128 + m0 + mm) * D + k] = (bf16_t)f2bf(aQ[mm]); }
    }
    constexpr int NI_UV = 16 * 16, NI_SQ = 16 * 16, NI_INO = 16 * 80, NI_F13 = 16 * 44, NI_F2 = 44 * 16;
    constexpr int PER_J = NI_UV + NI_SQ + NI_INO + NI_SQ + 2 * NI_F13 + NI_F2;
    if (P0_MASK & 32)
    for (int it = F.gw; it < 2 * PER_J; it += F.NGW) {
        const int j = it / PER_J; int r = it % PER_J;
        const float* W; int ld, K, N, mode = 0, roff = 0; bf16_t* WT;
        if (r < NI_UV) { W = F.in[I_WINE] + (size_t)j * D * 1536 + 512; ld = 1536; K = D; N = 1024; WT = WinE + (size_t)j * NEIN * D; roff = 1024; }
        else if ((r -= NI_UV) < NI_SQ) { W = F.in[I_WOUTE] + (size_t)j * D * D; ld = D; K = D; N = D; WT = (bf16_t*)(ws + WS_WOUTE) + (size_t)j * D * D; }
        else if ((r -= NI_SQ) < NI_INO) { W = F.in[I_WINO] + (size_t)j * D * NREC; ld = NREC; K = D; N = NREC; WT = (bf16_t*)(ws + WS_WINO) + (size_t)j * NREC * D; }
        else if ((r -= NI_INO) < NI_SQ) { W = F.in[I_WOUTO] + (size_t)j * D * D; ld = D; K = D; N = D; WT = (bf16_t*)(ws + WS_WOUTO) + (size_t)j * D * D; }
        else if ((r -= NI_SQ) < NI_F13) { W = F.in[I_F1] + (size_t)j * D * DFF; ld = DFF; K = D; N = DFF; WT = (bf16_t*)(ws + WS_W13) + (size_t)j * NFF2 * D; mode = 1; }
        else if ((r -= NI_F13) < NI_F13) { W = F.in[I_F3] + (size_t)j * D * DFF; ld = DFF; K = D; N = DFF; WT = (bf16_t*)(ws + WS_W13) + (size_t)j * NFF2 * D; mode = 1; roff = 4; }
        else { r -= NI_F13; W = F.in[I_F2] + (size_t)j * DFF * D; ld = D; K = DFF; N = D; WT = (bf16_t*)(ws + WS_W2) + (size_t)j * D * DFF; }
        transpose_item(W, ld, K, N, WT, mode, roff, r, lane);
    }
}
__device__ __forceinline__ void moe_convert(const Ctx& F, int j) {
    constexpr int I_13 = 16 * 56, I_2 = 56 * 16, PER_E = 2 * I_13 + I_2;
    for (int it = F.gw; it < NE * PER_E; it += F.NGW) {
        const int e = it / PER_E; int r = it % PER_E; const size_t eo = (size_t)(j * NE + e);
        const float* W; int ld, K, N, mode = 0, roff = 0; bf16_t* WT;
        if (r < I_13) { W = F.in[I_M1] + eo * D * DEX; ld = DEX; K = D; N = DEX; WT = (bf16_t*)(F.ws + WS_W13M) + (size_t)e * NEX2 * D; mode = 1; }
        else if ((r -= I_13) < I_13) { W = F.in[I_M3] + eo * D * DEX; ld = DEX; K = D; N = DEX; WT = (bf16_t*)(F.ws + WS_W13M) + (size_t)e * NEX2 * D; mode = 1; roff = 4; }
        else { r -= I_13; W = F.in[I_M2] + eo * DEX * D; ld = D; K = DEX; N = D; WT = (bf16_t*)(F.ws + WS_W2M) + (size_t)e * D * DEX; }
        transpose_item(W, ld, K, N, WT, mode, roff, r, F.lane);
    }
}

struct RowPass {
    const float* sl; const float* sc;
    float* dl; float* dc;
    const float* gain;
    const float* shift; const float* scale;
    bf16_t* H;
    int nrows;
    const bf16_t* YE; const float* topp; const float* gatef;
    const float* rw; int* tope; float* toppo; int* rank; int* cnt;
    float* fout;
};
template <bool COMBINE, bool ROUTER, bool FINAL>
__device__ __forceinline__ void row_pass(const Ctx& F, const RowPass& P) {
    const int lane = F.lane;
    LAS float* rwl = (LAS float*)F.lds;
    if (ROUTER) { for (int i = F.tid; i < D * NE; i += 512) rwl[i] = P.rw[i]; __syncthreads(); }
    f32x4 gn[4];
#pragma unroll
    for (int j = 0; j < 4; ++j) gn[j] = *(const f32x4*)(P.gain + 4 * lane + 256 * j);
    const int nitems = P.nrows / 16;
    for (int it = F.gw; it < nitems; it += F.NGW) {
        int rc0 = 0, rc1 = 0, rc2 = 0, rc3 = 0, rc4 = 0, rc5 = 0, rc6 = 0, rc7 = 0;
        const int rbase = it * 16; const bool isc = rbase >= ML; const int ms = isc ? 2 : (rbase >= TL ? 1 : 0);
        const float* xs0 = isc ? P.sc + (size_t)(rbase - ML) * D : P.sl + (size_t)rbase * D;
        float* xd0 = nullptr; if (COMBINE && !FINAL) xd0 = isc ? P.dc + (size_t)(rbase - ML) * D : P.dl + (size_t)rbase * D;
        f32x4 sh[4], scl[4], gf[4];
#pragma unroll
        for (int j = 0; j < 4; ++j) {
            if (!FINAL) { sh[j] = *(const f32x4*)(P.shift + ms * 6144 + 4 * lane + 256 * j); scl[j] = *(const f32x4*)(P.scale + ms * 6144 + 4 * lane + 256 * j) + 1.0f; }
            if (COMBINE) gf[j] = *(const f32x4*)(P.gatef + ms * 6144 + 4 * lane + 256 * j); }
        f32x4 v[4]; u32x2 ya[4], yb[4]; float p0 = 0.f, p1 = 0.f;
#pragma unroll
        for (int j = 0; j < 4; ++j) v[j] = *(const f32x4*)(xs0 + 4 * lane + 256 * j);
        if (COMBINE) { p0 = P.topp[2 * rbase]; p1 = P.topp[2 * rbase + 1];
#pragma unroll
            for (int j = 0; j < 4; ++j) { ya[j] = *(const u32x2*)(P.YE + (size_t)(2 * rbase) * D + 4 * lane + 256 * j); yb[j] = *(const u32x2*)(P.YE + (size_t)(2 * rbase + 1) * D + 4 * lane + 256 * j); } }
        for (int rr = 0; rr < 16; ++rr) {
            const int r = rbase + rr;
            f32x4 vn[4]; u32x2 yan[4], ybn[4]; float p0n = 0.f, p1n = 0.f;
            if (rr < 15) {
#pragma unroll
                for (int j = 0; j < 4; ++j) vn[j] = *(const f32x4*)(xs0 + (size_t)(rr + 1) * D + 4 * lane + 256 * j);
                if (COMBINE) { p0n = P.topp[2 * r + 2]; p1n = P.topp[2 * r + 3];
#pragma unroll
                    for (int j = 0; j < 4; ++j) { yan[j] = *(const u32x2*)(P.YE + (size_t)(2 * r + 2) * D + 4 * lane + 256 * j); ybn[j] = *(const u32x2*)(P.YE + (size_t)(2 * r + 3) * D + 4 * lane + 256 * j); } }
            }
            if (COMBINE) {
#pragma unroll
                for (int j = 0; j < 4; ++j) { const u32x2 a = ya[j], b = yb[j];
                    f32x4 y; y[0] = p0 * bflo(a.x) + p1 * bflo(b.x); y[1] = p0 * bfhi(a.x) + p1 * bfhi(b.x); y[2] = p0 * bflo(a.y) + p1 * bflo(b.y); y[3] = p0 * bfhi(a.y) + p1 * bfhi(b.y);
                    v[j] = v[j] + gf[j] * y;
                    if (!FINAL) *(f32x4*)(xd0 + (size_t)rr * D + 4 * lane + 256 * j) = v[j]; }
            }
            float ss = 0.f;
#pragma unroll
            for (int j = 0; j < 4; ++j) ss += (v[j][0] * v[j][0] + v[j][1] * v[j][1]) + (v[j][2] * v[j][2] + v[j][3] * v[j][3]);
            const float rstd = rsqrtf(wave_sum(ss) * (1.0f / D) + EPS);
            if (FINAL) {
#pragma unroll
                for (int j = 0; j < 4; ++j) *(f32x4*)(P.fout + (size_t)r * D + 4 * lane + 256 * j) = v[j] * rstd * gn[j];
            } else {
                f32x4 h[4];
#pragma unroll
                for (int j = 0; j < 4; ++j) { h[j] = (v[j] * rstd * gn[j]) * scl[j] + sh[j];
                    u32x2 w; w.x = pk2(h[j][0], h[j][1]); w.y = pk2(h[j][2], h[j][3]);
                    *(u32x2*)(P.H + (size_t)r * D + 4 * lane + 256 * j) = w; }
                if (ROUTER) {
                    float lg[8] = {0.f, 0.f, 0.f, 0.f, 0.f, 0.f, 0.f, 0.f};
#pragma unroll
                    for (int j = 0; j < 4; ++j)
#pragma unroll
                        for (int i = 0; i < 4; ++i) { const int col = 4 * lane + 256 * j + i; const f32x4 w0 = *(const LAS f32x4*)(rwl + col * 8), w1 = *(const LAS f32x4*)(rwl + col * 8 + 4); const float hv = h[j][i];
                            lg[0] += hv * w0[0]; lg[1] += hv * w0[1]; lg[2] += hv * w0[2]; lg[3] += hv * w0[3]; lg[4] += hv * w1[0]; lg[5] += hv * w1[1]; lg[6] += hv * w1[2]; lg[7] += hv * w1[3]; }
#pragma unroll
                    for (int e = 0; e < 8; ++e) lg[e] = wave_sum(lg[e]);
                    int e0 = 0; float v0 = lg[0];
#pragma unroll
                    for (int e = 1; e < 8; ++e) if (lg[e] > v0) { v0 = lg[e]; e0 = e; }
                    int e1 = -1; float v1 = -3.0e38f;
#pragma unroll
                    for (int e = 0; e < 8; ++e) if (e != e0 && lg[e] > v1) { v1 = lg[e]; e1 = e; }
                    const float ex = expf(v1 - v0); const float q0 = 1.0f / (1.0f + ex), q1 = ex / (1.0f + ex);
                    const int rk0 = e0 == 0 ? rc0 : e0 == 1 ? rc1 : e0 == 2 ? rc2 : e0 == 3 ? rc3 : e0 == 4 ? rc4 : e0 == 5 ? rc5 : e0 == 6 ? rc6 : rc7;
                    const int rk1 = e1 == 0 ? rc0 : e1 == 1 ? rc1 : e1 == 2 ? rc2 : e1 == 3 ? rc3 : e1 == 4 ? rc4 : e1 == 5 ? rc5 : e1 == 6 ? rc6 : rc7;
                    rc0 += (e0 == 0) + (e1 == 0); rc1 += (e0 == 1) + (e1 == 1); rc2 += (e0 == 2) + (e1 == 2); rc3 += (e0 == 3) + (e1 == 3);
                    rc4 += (e0 == 4) + (e1 == 4); rc5 += (e0 == 5) + (e1 == 5); rc6 += (e0 == 6) + (e1 == 6); rc7 += (e0 == 7) + (e1 == 7);
                    if (lane == 0) { P.tope[2 * r] = e0; P.tope[2 * r + 1] = e1; P.toppo[2 * r] = q0; P.toppo[2 * r + 1] = q1; P.rank[2 * r] = rk0; P.rank[2 * r + 1] = rk1; }
                }
            }
            if (rr < 15) {
#pragma unroll
                for (int j = 0; j < 4; ++j) { v[j] = vn[j]; if (COMBINE) { ya[j] = yan[j]; yb[j] = ybn[j]; } }
                if (COMBINE) { p0 = p0n; p1 = p1n; }
            }
        }
        if (ROUTER && lane == 0) { int* c = P.cnt + it * 8; c[0] = rc0; c[1] = rc1; c[2] = rc2; c[3] = rc3; c[4] = rc4; c[5] = rc5; c[6] = rc6; c[7] = rc7; }
    }
}

template <int NB>
__device__ __forceinline__ void lm_core(const bf16_t* A, int lda, const int (&i0)[NB], int kc0, int nks, LAS unsigned char* X, f32x4 (&acc)[NB][8], int lane) {
    const int i16 = lane & 15, q = lane >> 4;
    const int xoff = (8 * q + (i16 >> 2)) * XRS + 8 * (i16 & 3);
    for (int ks = 0; ks < nks; ++ks) {
        bf16x8 af[NB];
#pragma unroll
        for (int b = 0; b < NB; ++b) af[b] = *(const bf16x8*)(A + (size_t)(i0[b] + i16) * lda + kc0 + ks * 32 + 8 * q);
#pragma unroll
        for (int nt = 0; nt < 8; ++nt) {
            const s16x4 lo = __builtin_amdgcn_ds_read_tr16_b64_v4i16((LAS s16x4*)(X + ks * 32 * XRS + xoff + nt * 32));
            const s16x4 hi = __builtin_amdgcn_ds_read_tr16_b64_v4i16((LAS s16x4*)(X + ks * 32 * XRS + xoff + nt * 32 + 4 * XRS));
            const bf16x8 xf = __builtin_shufflevector(lo, hi, 0, 1, 2, 3, 4, 5, 6, 7);
#pragma unroll
            for (int b = 0; b < NB; ++b) acc[b][nt] = __builtin_amdgcn_mfma_f32_16x16x32_bf16(xf, af[b], acc[b][nt], 0, 0, 0);
        }
    }
}
template <int NB> __device__ __forceinline__ void zero_acc(f32x4 (&acc)[NB][8]) {
#pragma unroll
    for (int b = 0; b < NB; ++b)
#pragma unroll
        for (int nt = 0; nt < 8; ++nt) acc[b][nt] = (f32x4){0.f, 0.f, 0.f, 0.f};
}
__device__ __forceinline__ void stage_rows(const bf16_t* src, size_t sstride, int nrows, LAS unsigned char* X, int xr0, int tid) {
    for (int i = tid; i < nrows * 16; i += 512) { const int r = i >> 4, ch = i & 15; *(LAS u32x4*)(X + (xr0 + r) * XRS + ch * 16) = *(const u32x4*)(src + (size_t)r * sstride + ch * 8); }
}

__device__ __forceinline__ void fft_stage_a(const Ctx& F, unsigned* wq) {
    const bf16_t* PZ = (const bf16_t*)(F.ws + WS_PZUV); bf16_t* UP = (bf16_t*)(F.ws + WS_UP); bf16_t* Y = (bf16_t*)(F.ws + WS_H);
    const bf16_t* FA = (const bf16_t*)(F.ws + WS_FA); const bf16_t* FX = (const bf16_t*)(F.ws + WS_FX);
    LAS unsigned char* X = F.lds; const int lane = F.lane, w = F.wave, i16 = lane & 15, q = lane >> 4;
    volatile LAS unsigned* slot = (volatile LAS unsigned*)(F.lds + MISC_OFF + 64);
    for (int it0 = F.bid; it0 < 1024 + 16; ) {
        const int it = it0 < 16 ? 1024 + it0 : it0 - 16;
        if (it < 1024) {
            const int t2 = it & 127, g = (it >> 7) & 3, b = it >> 9;
            const bf16_t* src = PZ + ((size_t)b * TL + t2) * NEIN + g * 128;
            stage_rows(src, (size_t)128 * NEIN, 128, X, 0, F.tid);
            stage_rows(src + 512, (size_t)128 * NEIN, 128, X, 128, F.tid);
            __syncthreads();
            f32x4 acc[2][8]; zero_acc<2>(acc); const int i0[2] = {16 * w, 128 + 16 * w};
            lm_core<2>(FA, 256, i0, 0, 8, X, acc, lane);
            const int k1 = 16 * w + i16; float sw, cw; sincosf(6.283185307179586f * (float)((k1 * t2) & 16383) / 16384.0f, &sw, &cw);
            bf16_t* orow = UP + ((size_t)((b * 4 + g) * 128 + k1) * 128 + t2) * 256;
#pragma unroll
            for (int nt = 0; nt < 8; ++nt) { const f32x4 ur = acc[0][nt], ui = acc[1][nt]; const int n = 16 * nt + 4 * q;
                u32x2 wr_, wi_; wr_.x = pk2(ur[0] * cw - ui[0] * sw, ur[1] * cw - ui[1] * sw); wr_.y = pk2(ur[2] * cw - ui[2] * sw, ur[3] * cw - ui[3] * sw);
                wi_.x = pk2(ur[0] * sw + ui[0] * cw, ur[1] * sw + ui[1] * cw); wi_.y = pk2(ur[2] * sw + ui[2] * cw, ur[3] * sw + ui[3] * cw);
                *(u32x2*)(orow + n) = wr_; *(u32x2*)(orow + 128 + n) = wi_; }
            __syncthreads();
        } else {
            const int ci = it - 1024, kh = ci & 1, g = (ci >> 1) & 3, b = ci >> 3;
            f32x4 acc[1][8]; zero_acc<1>(acc); const int i0[1] = {128 * kh + 16 * w};
            for (int c = 0; c < 2; ++c) {
                stage_rows(PZ + ((size_t)ML + b * TCX) * NEIN + c * 512 + g * 128, NEIN, 256, X, 0, F.tid);
                __syncthreads();
                lm_core<1>(FX, 512, i0, c * 256, 8, X, acc, lane);
                __syncthreads();
            }
            const int k = 128 * kh + 16 * w + i16; bf16_t* orow = Y + ((size_t)ML + b * TCX + k) * D + g * 128; const float nrm = 0.005524271728019903f;
#pragma unroll
            for (int nt = 0; nt < 8; ++nt) { const f32x4 a = acc[0][nt] * nrm; u32x2 o; o.x = pk2(a[0], a[1]); o.y = pk2(a[2], a[3]); *(u32x2*)(orow + 16 * nt + 4 * q) = o; }
        }
        WQ_NEXT(it0, wq, slot, F.G);
    }
}
__device__ __forceinline__ void fft_stage_c_gmlp(const Ctx& F, int j, unsigned* wq) {
    const bf16_t* PZ = (const bf16_t*)(F.ws + WS_PZUV); const bf16_t* UP = (const bf16_t*)(F.ws + WS_UP); bf16_t* Y = (bf16_t*)(F.ws + WS_H);
    const bf16_t* FC = (const bf16_t*)(F.ws + WS_FC); const bf16_t* GW = (const bf16_t*)(F.ws + WS_GW) + (size_t)j * 4 * 128 * 128;
    const float* gb = F.in[I_GB] + j * 512;
    LAS unsigned char* X = F.lds; const int lane = F.lane, w = F.wave, i16 = lane & 15, q = lane >> 4, tid = F.tid;
    volatile LAS unsigned* slot = (volatile LAS unsigned*)(F.lds + MISC_OFF + 64);
    for (int it = F.bid; it < 1024 + 1040; ) {
        if (it < 1024) {
            const int k1 = it & 127, g = (it >> 7) & 3, b = it >> 9;
            const bf16_t* src = UP + (size_t)((b * 4 + g) * 128 + k1) * 128 * 256;
            stage_rows(src, 256, 128, X, 0, tid);
            stage_rows(src + 128, 256, 128, X, 128, tid);
            __syncthreads();
            f32x4 acc[1][8]; zero_acc<1>(acc); const int i0[1] = {16 * w};
            lm_core<1>(FC, 256, i0, 0, 8, X, acc, lane);
            const int k2 = 16 * w + i16; bf16_t* orow = Y + ((size_t)b * TL + k1 + 128 * k2) * D + g * 128; const float nrm = 0.0006905339660024878f;
#pragma unroll
            for (int nt = 0; nt < 8; ++nt) { const f32x4 a = acc[0][nt] * nrm; u32x2 o; o.x = pk2(a[0], a[1]); o.y = pk2(a[2], a[3]); *(u32x2*)(orow + 16 * nt + 4 * q) = o; }
            __syncthreads();
        } else {
            const int gi = it - 1024, h = gi & 3, ck = gi >> 2; const size_t r0 = (size_t)ck * 128;
            for (int i = tid; i < 128 * 16; i += 512) { const int r = i >> 4, ch = i & 15; const u32x4 raw = *(const u32x4*)(PZ + (r0 + r) * NEIN + 1536 + h * 128 + ch * 8);
                float x[8] = {bflo(raw.x), bfhi(raw.x), bflo(raw.y), bfhi(raw.y), bflo(raw.z), bfhi(raw.z), bflo(raw.w), bfhi(raw.w)};
                float s = 0.f;
#pragma unroll
                for (int e = 0; e < 8; ++e) s += x[e];
                s += __shfl_xor(s, 1); s += __shfl_xor(s, 2); s += __shfl_xor(s, 4); s += __shfl_xor(s, 8);
                const float mean = s * (1.0f / 128.0f); float qq = 0.f;
#pragma unroll
                for (int e = 0; e < 8; ++e) { x[e] -= mean; qq += x[e] * x[e]; }
                qq += __shfl_xor(qq, 1); qq += __shfl_xor(qq, 2); qq += __shfl_xor(qq, 4); qq += __shfl_xor(qq, 8);
                const float rs = rsqrtf(qq * (1.0f / 128.0f) + EPS);
                u32x4 o; o.x = pk2(x[0] * rs, x[1] * rs); o.y = pk2(x[2] * rs, x[3] * rs); o.z = pk2(x[4] * rs, x[5] * rs); o.w = pk2(x[6] * rs, x[7] * rs);
                *(LAS u32x4*)(X + r * XRS + ch * 16) = o; }
            __syncthreads();
            f32x4 acc[1][8]; zero_acc<1>(acc); const int i0[1] = {16 * w};
            lm_core<1>(GW + (size_t)h * 128 * 128, 128, i0, 0, 4, X, acc, lane);
            const int t = 16 * w + i16; const float bias = gb[h * 128 + t];
            const bf16_t* urow = PZ + (r0 + t) * NEIN + 1024 + h * 128; bf16_t* orow = Y + (r0 + t) * D + 512 + h * 128;
#pragma unroll
            for (int nt = 0; nt < 8; ++nt) { const int n = 16 * nt + 4 * q; const u32x2 uu = *(const u32x2*)(urow + n); const f32x4 a = acc[0][nt];
                u32x2 o; o.x = pk2(bflo(uu.x) * (a[0] + bias), bfhi(uu.x) * (a[1] + bias)); o.y = pk2(bflo(uu.y) * (a[2] + bias), bfhi(uu.y) * (a[3] + bias)); *(u32x2*)(orow + n) = o; }
            __syncthreads();
        }
        WQ_NEXT(it, wq, slot, F.G);
    }
}

constexpr int S2_KT = 0, S2_QT = 36864, S2_V = 73728, S2_SC = 110592, S2_EB = 120832, S2_EBL = 122880, S2_RED = 124928, S2_END = 129024;
static_assert(S2_END <= MISC_OFF, "scan LDS");
constexpr int SCRS = 80;
template <bool NEEDQ>
__device__ __forceinline__ void half_prep(const Ctx& F, const bf16_t* P5, size_t hrow, bool rev, int h, int dir) {
    const int tid = F.tid, ck = F.wave >> 1, dk = ((F.wave & 1) << 6) + F.lane; LAS unsigned char* L = F.lds;
#pragma unroll
    for (int it = 0; it < 4; ++it) { const int idx = tid + 512 * it, p = idx >> 4, ch = idx & 15; const size_t r = hrow + (rev ? 127 - p : p); const bf16_t* rp = P5 + r * NREC + h * 128 + ch * 8;
        *(LAS u32x4*)(L + S2_KT + p * XRS + ch * 16) = *(const u32x4*)(rp + 2048 + dir * 1024);
        if (NEEDQ) *(LAS u32x4*)(L + S2_QT + p * XRS + ch * 16) = *(const u32x4*)(rp);
        *(LAS u32x4*)(L + S2_V + p * XRS + ch * 16) = *(const u32x4*)(rp + 4096); }
    __syncthreads();
    float b = 0.f; LAS unsigned char* kt = L + S2_KT + (32 * ck) * XRS + dk * 2; LAS unsigned char* qt = L + S2_QT + (32 * ck) * XRS + dk * 2;
#pragma unroll 8
    for (int i = 0; i < 32; ++i) { const float lf = bf2f(*(const LAS bf16_t*)(kt + i * XRS)); b += lf;
        const float kk = (1.0f - __expf(lf)) * __expf(fminf(-b, 80.0f));
        *(LAS bf16_t*)(kt + i * XRS) = (bf16_t)f2bf(kk);
        if (NEEDQ) { const float qv = bf2f(*(const LAS bf16_t*)(qt + i * XRS)); *(LAS bf16_t*)(qt + i * XRS) = (bf16_t)f2bf(qv * __expf(b)); } }
    ((LAS float*)(L + S2_EB))[ck * 128 + dk] = __expf(b);
    ((LAS float*)(L + S2_EBL))[ck * 128 + dk] = b;
}
__device__ __forceinline__ void state_update(const Ctx& F, f32x4 (&st)[8], int ck) {
    LAS unsigned char* L = F.lds; const int lane = F.lane, i16 = lane & 15, q = lane >> 4, w = F.wave;
    const int roff = (32 * ck + 8 * q + (i16 >> 2)) * XRS + 8 * (i16 & 3);
    const s16x4 vlo = __builtin_amdgcn_ds_read_tr16_b64_v4i16((LAS s16x4*)(L + S2_V + roff + w * 32));
    const s16x4 vhi = __builtin_amdgcn_ds_read_tr16_b64_v4i16((LAS s16x4*)(L + S2_V + roff + w * 32 + 4 * XRS));
    const bf16x8 vf = __builtin_shufflevector(vlo, vhi, 0, 1, 2, 3, 4, 5, 6, 7);
#pragma unroll
    for (int kb = 0; kb < 8; ++kb) {
        const s16x4 klo = __builtin_amdgcn_ds_read_tr16_b64_v4i16((LAS s16x4*)(L + S2_KT + roff + kb * 32));
        const s16x4 khi = __builtin_amdgcn_ds_read_tr16_b64_v4i16((LAS s16x4*)(L + S2_KT + roff + kb * 32 + 4 * XRS));
        const bf16x8 kf = __builtin_shufflevector(klo, khi, 0, 1, 2, 3, 4, 5, 6, 7);
        st[kb] = __builtin_amdgcn_mfma_f32_16x16x32_bf16(kf, vf, st[kb], 0, 0, 0);
        const f32x4 eb = *(const LAS f32x4*)(L + S2_EB + (ck * 128 + 16 * kb + 4 * q) * 4);
        st[kb] = st[kb] * eb;
    }
}
__device__ __forceinline__ void state_load(const float* src, f32x4 (&st)[8], int w, int lane) {
#pragma unroll
    for (int kb = 0; kb < 8; ++kb)
#pragma unroll
        for (int rg = 0; rg < 4; ++rg) st[kb][rg] = src ? src[((w * 8 + kb) * 4 + rg) * 64 + lane] : 0.f;
}
__device__ __forceinline__ void state_store(float* dst, const f32x4 (&st)[8], int w, int lane) {
#pragma unroll
    for (int kb = 0; kb < 8; ++kb)
#pragma unroll
        for (int rg = 0; rg < 4; ++rg) dst[((w * 8 + kb) * 4 + rg) * 64 + lane] = st[kb][rg];
}
__device__ __forceinline__ void scan_pass1_item(const Ctx& F, const bf16_t* P5, int b, int h, int dir, int seg, float* SST, float* EG) {
    const int chain = (b * 8 + h) * 2 + dir; const size_t rowb = (size_t)b * TL + (size_t)seg * SEGL;
    f32x4 st[8]; state_load(nullptr, st, F.wave, F.lane);
    float gacc = 0.f;
    for (int hs = 0; hs < 2; ++hs) {
        const size_t hrow = rowb + 128 * (dir ? 1 - hs : hs);
        half_prep<false>(F, P5, hrow, dir != 0, h, dir);
        __syncthreads();
        if (F.tid < 128) { const LAS float* ebl = (const LAS float*)(F.lds + S2_EBL); gacc += (ebl[F.tid] + ebl[128 + F.tid]) + (ebl[256 + F.tid] + ebl[384 + F.tid]); }
#pragma unroll 1
        for (int ck = 0; ck < 4; ++ck) { state_update(F, st, ck); __builtin_amdgcn_sched_barrier(0); }
        __syncthreads();
    }
    state_store(SST + ((size_t)chain * NSEG + seg) * 16384, st, F.wave, F.lane);
    if (F.tid < 128) EG[((size_t)chain * NSEG + seg) * 128 + F.tid] = __expf(gacc);
}
__device__ __forceinline__ void half_scores(const Ctx& F) {
    LAS unsigned char* L = F.lds; const int lane = F.lane, i16 = lane & 15, q = lane >> 4, w = F.wave, ck = w >> 1, u = w & 1;
#pragma unroll
    for (int tt = 0; tt < 2; ++tt) {
        const int ti = u == 0 ? tt : 1 - tt, si = u == 0 ? tt : tt;
        f32x4 sc = (f32x4){0.f, 0.f, 0.f, 0.f};
        if (si <= ti) {
#pragma unroll
            for (int ks = 0; ks < 4; ++ks) { const bf16x8 a = *(const LAS bf16x8*)(L + S2_QT + (32 * ck + 16 * ti + i16) * XRS + (32 * ks + 8 * q) * 2); const bf16x8 bb = *(const LAS bf16x8*)(L + S2_KT + (32 * ck + 16 * si + i16) * XRS + (32 * ks + 8 * q) * 2);
                sc = __builtin_amdgcn_mfma_f32_16x16x32_bf16(a, bb, sc, 0, 0, 0); }
        }
#pragma unroll
        for (int rg = 0; rg < 4; ++rg) { const int t = 16 * ti + 4 * q + rg, sidx = 16 * si + i16; *(LAS bf16_t*)(L + S2_SC + (32 * ck + t) * SCRS + sidx * 2) = (bf16_t)f2bf(sidx <= t ? sc[rg] : 0.f); }
    }
}
__device__ __forceinline__ void chunk_out(const Ctx& F, const f32x4 (&st)[8], int ck, f32x4 (&o)[2]) {
    LAS unsigned char* L = F.lds; const int lane = F.lane, i16 = lane & 15, q = lane >> 4, w = F.wave;
    o[0] = (f32x4){0.f, 0.f, 0.f, 0.f}; o[1] = (f32x4){0.f, 0.f, 0.f, 0.f};
#pragma unroll
    for (int ks = 0; ks < 4; ++ks) {
        u32x4 sp; sp.x = pk2(st[2 * ks][0], st[2 * ks][1]); sp.y = pk2(st[2 * ks][2], st[2 * ks][3]); sp.z = pk2(st[2 * ks + 1][0], st[2 * ks + 1][1]); sp.w = pk2(st[2 * ks + 1][2], st[2 * ks + 1][3]);
        const bf16x8 sf = __builtin_bit_cast(bf16x8, sp);
#pragma unroll
        for (int ti = 0; ti < 2; ++ti) { const LAS unsigned char* qrow = L + S2_QT + (32 * ck + 16 * ti + i16) * XRS + (32 * ks + 4 * q) * 2;
            const u32x2 qlo = *(const LAS u32x2*)(qrow), qhi = *(const LAS u32x2*)(qrow + 32);
            u32x4 qp; qp.x = qlo.x; qp.y = qlo.y; qp.z = qhi.x; qp.w = qhi.y;
            o[ti] = __builtin_amdgcn_mfma_f32_16x16x32_bf16(sf, __builtin_bit_cast(bf16x8, qp), o[ti], 0, 0, 0); }
    }
    const int roff = (32 * ck + 8 * q + (i16 >> 2)) * XRS + 8 * (i16 & 3);
    const s16x4 vlo = __builtin_amdgcn_ds_read_tr16_b64_v4i16((LAS s16x4*)(L + S2_V + roff + w * 32));
    const s16x4 vhi = __builtin_amdgcn_ds_read_tr16_b64_v4i16((LAS s16x4*)(L + S2_V + roff + w * 32 + 4 * XRS));
    const bf16x8 vf = __builtin_shufflevector(vlo, vhi, 0, 1, 2, 3, 4, 5, 6, 7);
#pragma unroll
    for (int ti = 0; ti < 2; ++ti) { const bf16x8 pf = *(const LAS bf16x8*)(L + S2_SC + (32 * ck + 16 * ti + i16) * SCRS + (8 * q) * 2); o[ti] = __builtin_amdgcn_mfma_f32_16x16x32_bf16(vf, pf, o[ti], 0, 0, 0); }
}
__device__ __forceinline__ void scan_pass3_item(const Ctx& F, const bf16_t* P5, size_t rowb, int h, const float* sin_f, const float* sin_b, float* fin_f, float* fin_b, const float* gain, bf16_t* OFT, bf16_t* Y, bool writey) {
    LAS unsigned char* L = F.lds; const int lane = F.lane, i16 = lane & 15, q = lane >> 4, w = F.wave;
    const int colo = h * 128 + 16 * w + 4 * q;
    f32x4 st[8];
    state_load(sin_f, st, w, lane);
    for (int hs = 0; hs < 2; ++hs) {
        const size_t hrow = rowb + 128 * hs;
        half_prep<true>(F, P5, hrow, false, h, 0);
        __syncthreads();
        half_scores(F);
        __syncthreads();
#pragma unroll 1
        for (int ck = 0; ck < 4; ++ck) { f32x4 o[2]; chunk_out(F, st, ck, o);
#pragma unroll
            for (int ti = 0; ti < 2; ++ti) { const size_t r = hrow + 32 * ck + 16 * ti + i16; u32x2 pkd; pkd.x = pk2(o[ti][0], o[ti][1]); pkd.y = pk2(o[ti][2], o[ti][3]); *(u32x2*)(OFT + r * D + colo) = pkd; }
            __builtin_amdgcn_sched_barrier(0);
            state_update(F, st, ck);
            __builtin_amdgcn_sched_barrier(0); }
        __syncthreads();
    }
    if (fin_f) state_store(fin_f, st, w, lane);
    state_load(sin_b, st, w, lane);
    const f32x4 gv = *(const f32x4*)(gain + colo);
    for (int hs = 0; hs < 2; ++hs) {
        const size_t hrow = rowb + 128 * (1 - hs);
        half_prep<true>(F, P5, hrow, true, h, 1);
        __syncthreads();
        half_scores(F);
        __syncthreads();
        LAS float* RED = (LAS float*)(L + S2_RED);
        u32x2 fc[2];
#pragma unroll
        for (int ti = 0; ti < 2; ++ti) fc[ti] = *(const u32x2*)(OFT + (hrow + 127 - (16 * ti + i16)) * D + colo);
#pragma unroll 1
        for (int ck = 0; ck < 4; ++ck) { u32x2 fn[2];
            const int ckn = ck < 3 ? ck + 1 : 3;
#pragma unroll
            for (int ti = 0; ti < 2; ++ti) fn[ti] = *(const u32x2*)(OFT + (hrow + 127 - (32 * ckn + 16 * ti + i16)) * D + colo);
            f32x4 o[2]; chunk_out(F, st, ck, o);
#pragma unroll
            for (int ti = 0; ti < 2; ++ti) { const int p = 32 * ck + 16 * ti + i16; const size_t r = hrow + 127 - p; const u32x2 f = fc[ti];
                o[ti][0] += bflo(f.x); o[ti][1] += bfhi(f.x); o[ti][2] += bflo(f.y); o[ti][3] += bfhi(f.y);
                float ss = (o[ti][0] * o[ti][0] + o[ti][1] * o[ti][1]) + (o[ti][2] * o[ti][2] + o[ti][3] * o[ti][3]);
                ss += __shfl_xor(ss, 16); ss += __shfl_xor(ss, 32);
                if (q == 0) RED[w * 128 + p] = ss;
                u32x2 pkd; pkd.x = pk2(o[ti][0], o[ti][1]); pkd.y = pk2(o[ti][2], o[ti][3]); *(u32x2*)(OFT + r * D + colo) = pkd; }
            fc[0] = fn[0]; fc[1] = fn[1];
            __builtin_amdgcn_sched_barrier(0);
            state_update(F, st, ck);
            __builtin_amdgcn_sched_barrier(0); }
        __syncthreads();
        if (writey) {
#pragma unroll
            for (int ck = 0; ck < 4; ++ck)
#pragma unroll
                for (int ti = 0; ti < 2; ++ti) { const int p = 32 * ck + 16 * ti + i16; float tot = 0.f;
#pragma unroll
                    for (int ww = 0; ww < 8; ++ww) tot += RED[ww * 128 + p];
                    const float rs = rsqrtf(tot * (1.0f / 128.0f) + EPS); const size_t r = hrow + 127 - p;
                    const u32x2 f = *(const u32x2*)(OFT + r * D + colo); const u32x2 sg = *(const u32x2*)(P5 + r * NREC + 1024 + colo);
                    u32x2 y; y.x = pk2(bflo(f.x) * rs * gv[0] * bflo(sg.x), bfhi(f.x) * rs * gv[1] * bfhi(sg.x)); y.y = pk2(bflo(f.y) * rs * gv[2] * bflo(sg.y), bfhi(f.y) * rs * gv[3] * bfhi(sg.y));
                    *(u32x2*)(Y + r * D + colo) = y; }
        }
        __syncthreads();
    }
    if (fin_b) state_store(fin_b, st, w, lane);
}
__device__ __forceinline__ void scan_carry(const Ctx& F) {
    float* SST = (float*)(F.ws + WS_SST); const float* EG = (const float*)(F.ws + WS_EG); const float* S0 = (const float*)(F.ws + WS_S0);
    const int gt = F.bid * 512 + F.tid, NGT = F.G * 512;
    for (int idx = gt; idx < NCHAIN * 16384; idx += NGT) {
        const int chain = idx >> 14, e = idx & 16383, dir = chain & 1;
        const int lanee = e & 63, rg = (e >> 6) & 3, kb = (e >> 8) & 7; const int dk = 16 * kb + 4 * (lanee >> 4) + rg;
        float cur = S0[(size_t)chain * 16384 + e];
        float* base = SST + (size_t)chain * NSEG * 16384 + e; const float* eg = EG + (size_t)chain * NSEG * 128 + dk;
        for (int s0 = 0; s0 < NSEG; s0 += 8) {
            float tmp[8], gg[8];
#pragma unroll
            for (int i = 0; i < 8; ++i) { const int seg = dir ? NSEG - 1 - (s0 + i) : s0 + i; tmp[i] = base[(size_t)seg * 16384]; gg[i] = eg[seg * 128]; }
#pragma unroll
            for (int i = 0; i < 8; ++i) { const int seg = dir ? NSEG - 1 - (s0 + i) : s0 + i; base[(size_t)seg * 16384] = cur; cur = gg[i] * cur + tmp[i]; }
        }
    }
}

__device__ __forceinline__ void moe_slots(const Ctx& F, int nrows) {
    const int tid = F.tid; const int nitems = nrows / 16;
    const int* cnt = (const int*)(F.ws + WS_CNT); const int* tope = (const int*)(F.ws + WS_TOPE); const int* rank = (const int*)(F.ws + WS_RANK);
    int* slotrow = (int*)(F.ws + WS_SLOTROW); int* slotdst = (int*)(F.ws + WS_SLOTDST); int* tilex = (int*)(F.ws + WS_TILEX);
    LAS int* pre = (LAS int*)F.lds;
    LAS int* tsum = (LAS int*)(F.lds + 69632);
    LAS int* ebase = (LAS int*)(F.lds + 69632 + 16384);
    constexpr int IPT = (NITEM16 + 511) / 512;
    int loc[8] = {0, 0, 0, 0, 0, 0, 0, 0};
    for (int i = 0; i < IPT; ++i) { const int it = tid * IPT + i; if (it < nitems) {
#pragma unroll
        for (int e = 0; e < 8; ++e) loc[e] += cnt[it * 8 + e]; } }
#pragma unroll
    for (int e = 0; e < 8; ++e) tsum[tid * 8 + e] = loc[e];
    __syncthreads();
    if (tid < 8) { int run = 0; for (int t = 0; t < 512; ++t) { const int v = tsum[t * 8 + tid]; tsum[t * 8 + tid] = run; run += v; } ebase[8 + tid] = run; }
    __syncthreads();
    if (tid == 0) { int b = 0; for (int e = 0; e < 8; ++e) { ebase[e] = b; b += (ebase[8 + e] + 255) & ~255; } ebase[16] = b / 256; }
    { int run[8];
#pragma unroll
      for (int e = 0; e < 8; ++e) run[e] = tsum[tid * 8 + e];
      for (int i = 0; i < IPT; ++i) { const int it = tid * IPT + i; if (it < nitems) {
#pragma unroll
          for (int e = 0; e < 8; ++e) { pre[it * 8 + e] = run[e]; run[e] += cnt[it * 8 + e]; } } } }
    __syncthreads();
    for (int r = F.bid * 512 + tid; r < nrows; r += F.G * 512) {
#pragma unroll
        for (int kk = 0; kk < 2; ++kk) { const int e = tope[2 * r + kk]; const int slot = ebase[e] + pre[(r >> 4) * 8 + e] + rank[2 * r + kk]; slotrow[slot] = r; slotdst[slot] = 2 * r + kk; }
    }
    if (F.bid == 0) {
        const int ntiles = ebase[16];
        if (tid == 0) tilex[0] = ntiles;
        for (int e = 0; e < 8; ++e) { const int b0 = ebase[e], tot = ebase[8 + e], pad = (tot + 255) & ~255;
            for (int s = b0 + tot + tid; s < b0 + pad; s += 512) { slotrow[s] = 0; slotdst[s] = -1; }
            for (int t = b0 / 256 + tid; t < (b0 + pad) / 256; t += 512) tilex[16 + t] = e; }
    }
}

__global__ void __launch_bounds__(512, 2) fwd_kernel(Args args) {
    extern __shared__ __attribute__((aligned(16))) unsigned char lds_raw[];
    Ctx F;
    F.lds = (LAS unsigned char*)lds_raw; F.tid = threadIdx.x; F.lane = F.tid & 63; F.wave = __builtin_amdgcn_readfirstlane(F.tid >> 6);
    F.G = gridDim.x; F.bid = blockIdx.x; F.gw = F.bid * 8 + F.wave; F.NGW = F.G * 8;
    F.in = args.in; F.out = args.out; F.ws = args.ws;
    unsigned char* ws = args.ws;
    volatile LAS unsigned* MISC = (volatile LAS unsigned*)(F.lds + MISC_OFF);
    if (F.tid < 64) MISC[F.tid] = 0u;
    __syncthreads();
    const int lo = args.ph_lo, hi = args.ph_hi;
    XcdBarrier bar; bar.bar = (unsigned*)(ws + WS_CTL) + 4096; bar.x = 0; bar.st = nullptr;
    const bool multi = (hi - lo) > 1;
    if (multi) bar = xcd_barrier_post((unsigned*)(ws + WS_CTL) + 4096, MISC + 8);
#define IN(k) (lo <= (k) && (k) < hi)
#define SEAM(k) do { if (IN(k) && IN((k) + 1)) xcd_barrier(bar); asm volatile("" : "+v"(F.tid)); F.lane = F.tid & 63; F.wave = __builtin_amdgcn_readfirstlane(F.tid >> 6); F.gw = F.bid * 8 + F.wave; } while (0)

    float* mods = (float*)(ws + WS_MODS);
    float* XC = (float*)(ws + WS_XC);
    bf16_t* H = (bf16_t*)(ws + WS_H);
    bf16_t* YE = (bf16_t*)(ws + WS_YE);

    if (IN(PH_P0)) { p0_prologue(F); }
    SEAM(PH_P0);

    for (int lp = 0; lp < 2; ++lp) {
        const int pb = PH_PAIR0 + lp * NPL;
        const int le = 2 * lp, lo_ = 2 * lp + 1;
        const float* modE = mods + (size_t)le * 3 * 6144; const float* modO = mods + (size_t)lo_ * 3 * 6144;
        const float* xsl = lp == 0 ? F.in[I_X] : F.out; const float* xsc = lp == 0 ? F.in[I_CTX] : XC;
        if (IN(pb + E1_NORM)) for (int rep_ = 0; rep_ < NREP(E1_NORM); ++rep_) {
            RowPass P{}; P.sl = xsl; P.sc = xsc; P.dl = F.out; P.dc = XC; P.gain = F.in[I_NMIX] + le * D; P.shift = modE + 0 * D; P.scale = modE + 1 * D; P.H = H; P.nrows = MT;
            if (lp == 0) row_pass<false, false, false>(F, P);
            else { P.YE = YE; P.topp = (const float*)(ws + WS_TOPP); P.gatef = mods + (size_t)(le - 1) * 3 * 6144 + 5 * D; row_pass<true, false, false>(F, P); }
        }
        SEAM(pb + E1_NORM);
        if (IN(pb + E2_GIN)) for (int rep_ = 0; rep_ < NREP(E2_GIN); ++rep_) {
            pg8::Gemm g{H, (const bf16_t*)(ws + WS_WINE) + (size_t)lp * NEIN * D, MT, NEIN, D, nullptr, nullptr, 0}; pg8::StaticOrder S; S.init(MT, NEIN, F.G, F.bid);
            pg8::EpiEvenIn E{(bf16_t*)(ws + WS_PZUV)};
            pg8::gemm_phase<pg8::EpiEvenIn, pg8::StaticOrder, true, false>(F.lds, g, S, E, F.tid);
        }
        SEAM(pb + E2_GIN);
        if (IN(pb + E3_FFTA)) for (int rep_ = 0; rep_ < NREP(E3_FFTA); ++rep_) fft_stage_a(F, (unsigned*)(ws + WS_CTL) + 8192 + 64 * (pb + E3_FFTA));
        SEAM(pb + E3_FFTA);
        if (IN(pb + E3_FFTC)) for (int rep_ = 0; rep_ < NREP(E3_FFTC); ++rep_) fft_stage_c_gmlp(F, lp, (unsigned*)(ws + WS_CTL) + 8192 + 64 * (pb + E3_FFTC));
        SEAM(pb + E3_FFTC);
        if (IN(pb + E4_GOUT)) for (int rep_ = 0; rep_ < NREP(E4_GOUT); ++rep_) {
            pg8::Gemm g{H, (const bf16_t*)(ws + WS_WOUTE) + (size_t)lp * D * D, MT, D, D, nullptr, nullptr, 0}; pg8::StaticOrder S; S.init(MT, D, F.G, F.bid);
            pg8::EpiRes E{lp == 0 ? xsl : (const float*)F.out, lp == 0 ? xsc : (const float*)XC, F.out, XC, modE + 2 * D};
            pg8::gemm_phase<pg8::EpiRes, pg8::StaticOrder, false, false>(F.lds, g, S, E, F.tid);
        }
        SEAM(pb + E4_GOUT);
        if (IN(pb + E5_NORM)) for (int rep_ = 0; rep_ < NREP(E5_NORM); ++rep_) {
            RowPass P{}; P.sl = F.out; P.sc = XC; P.gain = F.in[I_NFFN] + le * D; P.shift = modE + 3 * D; P.scale = modE + 4 * D; P.H = H; P.nrows = MT;
            row_pass<false, false, false>(F, P);
        }
        SEAM(pb + E5_NORM);
        if (IN(pb + E6_UP)) for (int rep_ = 0; rep_ < NREP(E6_UP); ++rep_) {
            pg8::Gemm g{H, (const bf16_t*)(ws + WS_W13) + (size_t)lp * NFF2 * D, MT, NFF2, D, nullptr, nullptr, 0}; pg8::StaticOrder S; S.init(MT, NFF2, F.G, F.bid);
            pg8::EpiSwiglu E{(bf16_t*)(ws + WS_HID), DFF};
            pg8::gemm_phase<pg8::EpiSwiglu, pg8::StaticOrder, true, false>(F.lds, g, S, E, F.tid);
        }
        SEAM(pb + E6_UP);
        if (IN(pb + E7_DOWN)) for (int rep_ = 0; rep_ < NREP(E7_DOWN); ++rep_) {
            pg8::Gemm g{(const bf16_t*)(ws + WS_HID), (const bf16_t*)(ws + WS_W2) + (size_t)lp * D * DFF, MT, D, DFF, nullptr, nullptr, 0}; pg8::StaticOrder S; S.init(MT, D, F.G, F.bid);
            pg8::EpiRes E{F.out, XC, F.out, XC, modE + 5 * D};
            pg8::gemm_phase<pg8::EpiRes, pg8::StaticOrder, false, false>(F.lds, g, S, E, F.tid);
        }
        SEAM(pb + E7_DOWN);
        const bool lastl = lp == 1;
        if (IN(pb + O1_NORM)) for (int rep_ = 0; rep_ < NREP(O1_NORM); ++rep_) {
            RowPass P{}; P.sl = F.out; P.sc = XC; P.gain = F.in[I_NMIX] + lo_ * D; P.shift = modO + 0 * D; P.scale = modO + 1 * D; P.H = H; P.nrows = MT;
            row_pass<false, false, false>(F, P);
        }
        SEAM(pb + O1_NORM);
        if (IN(pb + O2_GIN)) for (int rep_ = 0; rep_ < NREP(O2_GIN); ++rep_) {
            pg8::Gemm g{H, (const bf16_t*)(ws + WS_WINO) + (size_t)lp * NREC * D, MT, NREC, D, nullptr, nullptr, 0}; pg8::StaticOrder S; S.init(MT, NREC, F.G, F.bid);
            pg8::EpiOddIn E{(bf16_t*)(ws + WS_P5), (const float*)(ws + WS_LB) + lp * 2048};
            pg8::gemm_phase<pg8::EpiOddIn, pg8::StaticOrder, true, false>(F.lds, g, S, E, F.tid);
        }
        SEAM(pb + O2_GIN);
        if (IN(pb + O3_SCAN1)) for (int rep_ = 0; rep_ < NREP(O3_SCAN1); ++rep_) {
            const bf16_t* P5 = (const bf16_t*)(ws + WS_P5); float* SST = (float*)(ws + WS_SST); float* EG = (float*)(ws + WS_EG); float* S0 = (float*)(ws + WS_S0);
            const float* gain = F.in[I_RNORM] + lp * D;
            unsigned* wq = (unsigned*)(ws + WS_CTL) + 8192 + 64 * (pb + O3_SCAN1); volatile LAS unsigned* slot = (volatile LAS unsigned*)(F.lds + MISC_OFF + 64);
            for (int it = F.bid; it < 16 + 2048; ) {
                if (it < 16) { const int b = it >> 3, h = it & 7;
                    scan_pass3_item(F, P5, (size_t)ML + b * TCX, h, nullptr, nullptr, S0 + (size_t)((b * 8 + h) * 2 + 0) * 16384, S0 + (size_t)((b * 8 + h) * 2 + 1) * 16384, gain, YE, H, !lastl);
                } else { const int i2 = it - 16, seg = i2 & 63, dir = (i2 >> 6) & 1, h = (i2 >> 7) & 7, b = i2 >> 10;
                    scan_pass1_item(F, P5, b, h, dir, seg, SST, EG); }
                WQ_NEXT(it, wq, slot, F.G);
            }
        }
        SEAM(pb + O3_SCAN1);
        if (IN(pb + O4_CARRY)) for (int rep_ = 0; rep_ < NREP(O4_CARRY); ++rep_) { scan_carry(F); moe_convert(F, lp); }
        SEAM(pb + O4_CARRY);
        if (IN(pb + O5_SCAN3)) for (int rep_ = 0; rep_ < NREP(O5_SCAN3); ++rep_) {
            const bf16_t* P5 = (const bf16_t*)(ws + WS_P5); const float* SST = (const float*)(ws + WS_SST);
            const float* gain = F.in[I_RNORM] + lp * D;
            for (int it = F.bid; it < 1024; it += F.G) { const int seg = it & 63, h = (it >> 6) & 7, b = it >> 9; const int ch0 = (b * 8 + h) * 2;
                scan_pass3_item(F, P5, (size_t)b * TL + (size_t)seg * SEGL, h, SST + ((size_t)ch0 * NSEG + seg) * 16384, SST + ((size_t)(ch0 + 1) * NSEG + seg) * 16384, nullptr, nullptr, gain, YE, H, true); }
        }
        SEAM(pb + O5_SCAN3);
        if (IN(pb + O6_GOUT)) for (int rep_ = 0; rep_ < NREP(O6_GOUT); ++rep_) {
            pg8::Gemm g{H, (const bf16_t*)(ws + WS_WOUTO) + (size_t)lp * D * D, MT, D, D, nullptr, nullptr, 0}; pg8::StaticOrder S; S.init(MT, D, F.G, F.bid);
            pg8::EpiRes E{F.out, XC, F.out, XC, modO + 2 * D};
            pg8::gemm_phase<pg8::EpiRes, pg8::StaticOrder, false, false>(F.lds, g, S, E, F.tid);
        }
        SEAM(pb + O6_GOUT);
        const int nrm = lastl ? ML : MT;
        if (IN(pb + O7_NORM)) for (int rep_ = 0; rep_ < NREP(O7_NORM); ++rep_) {
            RowPass P{}; P.sl = F.out; P.sc = XC; P.gain = F.in[I_NFFN] + lo_ * D; P.shift = modO + 3 * D; P.scale = modO + 4 * D; P.H = H; P.nrows = nrm;
            P.rw = F.in[I_RW] + (size_t)lp * D * NE; P.tope = (int*)(ws + WS_TOPE); P.toppo = (float*)(ws + WS_TOPP); P.rank = (int*)(ws + WS_RANK); P.cnt = (int*)(ws + WS_CNT);
            row_pass<false, true, false>(F, P);
        }
        SEAM(pb + O7_NORM);
        if (IN(pb + O8_SLOTS)) for (int rep_ = 0; rep_ < NREP(O8_SLOTS); ++rep_) moe_slots(F, nrm);
        SEAM(pb + O8_SLOTS);
        if (IN(pb + O9_MUP)) for (int rep_ = 0; rep_ < NREP(O9_MUP); ++rep_) {
            const int* tilex = (const int*)(ws + WS_TILEX); const int ntiles = tilex[0];
            pg8::Gemm g{H, (const bf16_t*)(ws + WS_W13M), ntiles * 256, NEX2, D, (const int*)(ws + WS_SLOTROW), tilex + 16, (size_t)NEX2 * D}; pg8::StaticOrder S; S.init(ntiles * 256, NEX2, F.G, F.bid);
            pg8::EpiSwiglu E{(bf16_t*)(ws + WS_HIDM), DEX};
            pg8::gemm_phase<pg8::EpiSwiglu, pg8::StaticOrder, true, true>(F.lds, g, S, E, F.tid);
        }
        SEAM(pb + O9_MUP);
        if (IN(pb + O10_MDOWN)) for (int rep_ = 0; rep_ < NREP(O10_MDOWN); ++rep_) {
            const int* tilex = (const int*)(ws + WS_TILEX); const int ntiles = tilex[0];
            pg8::Gemm g{(const bf16_t*)(ws + WS_HIDM), (const bf16_t*)(ws + WS_W2M), ntiles * 256, D, DEX, nullptr, tilex + 16, (size_t)D * DEX}; pg8::StaticOrder S; S.init(ntiles * 256, D, F.G, F.bid);
            pg8::EpiMoeDown E{YE, (const int*)(ws + WS_SLOTDST)};
            pg8::gemm_phase<pg8::EpiMoeDown, pg8::StaticOrder, true, false>(F.lds, g, S, E, F.tid);
        }
        SEAM(pb + O10_MDOWN);
    }
    if (IN(PH_FINAL)) {
        RowPass P{}; P.sl = F.out; P.sc = XC; P.dl = F.out; P.dc = XC; P.gain = F.in[I_NOUT]; P.nrows = ML; P.YE = YE; P.topp = (const float*)(ws + WS_TOPP); P.gatef = mods + (size_t)3 * 3 * 6144 + 5 * D; P.fout = F.out;
        row_pass<true, false, true>(F, P);
    }
#undef IN
#undef SEAM
}

extern "C" void kernel_launch(void* const* d_in, const int* in_sizes, int n_in, void* d_out, int out_size, void* d_ws, size_t ws_size, hipStream_t stream) {
    static int grid = 0;
    if (grid == 0) {
        if (n_in != 24 || out_size != ML * D || ws_size < WS_END) { fprintf(stderr, "kernel_launch: unexpected problem (n_in %d, out %d, ws %zu < %zu)\n", n_in, out_size, ws_size, (size_t)WS_END); grid = -1; return; }
        int dev = 0, cus = 0, per_cu = 0;
        if (hipGetDevice(&dev) != hipSuccess || hipDeviceGetAttribute(&cus, hipDeviceAttributeMultiprocessorCount, dev) != hipSuccess) { grid = -1; return; }
        if (hipFuncSetAttribute((const void*)fwd_kernel, hipFuncAttributeMaxDynamicSharedMemorySize, LDS_BYTES) != hipSuccess) { fprintf(stderr, "kernel_launch: hipFuncSetAttribute failed\n"); grid = -1; return; }
        if (hipOccupancyMaxActiveBlocksPerMultiprocessor(&per_cu, (const void*)fwd_kernel, 512, LDS_BYTES) != hipSuccess || per_cu < 1) fprintf(stderr, "kernel_launch: occupancy query says %d\n", per_cu);
        (void)hipGetLastError();
        grid = cus;
    }
    if (grid < 0) return;
    (void)hipMemsetAsync((char*)d_ws + WS_CTL, 0, CTL_BYTES, stream);
    Args a{};
    for (int i = 0; i < 24; ++i) a.in[i] = (const float*)d_in[i];
    a.out = (float*)d_out; a.ws = (unsigned char*)d_ws;
#if PER_PHASE_LAUNCH
    for (int p = 0; p < NPHASE && p < PHASE_LIMIT; ++p) { a.ph_lo = p; a.ph_hi = p + 1; hipLaunchKernelGGL(fwd_kernel, dim3(grid), dim3(512), LDS_BYTES, stream, a); }
#else
    a.ph_lo = 0; a.ph_hi = NPHASE; hipLaunchKernelGGL(fwd_kernel, dim3(grid), dim3(512), LDS_BYTES, stream, a);
#endif
}
```

```cpp
#include <hip/hip_runtime.h>
#include <cstdio>
#include <cstdint>

#ifndef PER_PHASE_LAUNCH
#define PER_PHASE_LAUNCH 0
#endif
#ifndef REP_MASK
#define REP_MASK 0
#endif
#define NREP(x) (((REP_MASK >> (x)) & 1) ? 2 : 1)
#ifndef PHASE_LIMIT
#define PHASE_LIMIT 100
#endif
#ifndef P0_MASK
#define P0_MASK 63
#endif
#ifndef P0_T
#define P0_T 127
#endif

#define LAS __attribute__((address_space(3)))
typedef unsigned short bf16_t;
typedef short bf16x8 __attribute__((ext_vector_type(8)));
typedef short s16x4 __attribute__((ext_vector_type(4)));
typedef float f32x4 __attribute__((ext_vector_type(4)));
typedef float f32x2 __attribute__((ext_vector_type(2)));
typedef unsigned u32x4 __attribute__((ext_vector_type(4)));
typedef unsigned u32x2 __attribute__((ext_vector_type(2)));

constexpr int D = 1024, TL = 16384, ML = 32768, TCX = 256, MC = 512, MT = 33280;
constexpr int NEIN = 2048, DFF = 2816, NFF2 = 5632, NREC = 5120, DEX = 3584, NEX2 = 7168, NE = 8;
constexpr int NSEG = 64, SEGL = 256, CH = 32, NCHAIN = 32;
constexpr int MAXTILES = 268, NITEM16 = MT / 16;
constexpr float EPS = 1e-6f;

constexpr size_t MiB = 1u << 20, KiB = 1u << 10;
constexpr size_t WS_CTL = 0, CTL_BYTES = 1 * MiB;
constexpr size_t WS_MODS = 1 * MiB, WS_LB = 1 * MiB + 512 * KiB;
constexpr size_t WS_FA = 2 * MiB, WS_FC = 2 * MiB + 128 * KiB, WS_FX = 2 * MiB + 256 * KiB, WS_GW = 2 * MiB + 512 * KiB;
constexpr size_t WS_XC = 3 * MiB;
constexpr size_t WS_TOPE = 5 * MiB, WS_TOPP = 5 * MiB + 512 * KiB, WS_RANK = 6 * MiB, WS_CNT = 6 * MiB + 512 * KiB, WS_TILEX = 6 * MiB + 768 * KiB, WS_SLOTROW = 7 * MiB, WS_SLOTDST = 7 * MiB + 512 * KiB;
constexpr size_t WS_WINE = 8 * MiB, WS_WOUTE = 16 * MiB, WS_WINO = 20 * MiB, WS_WOUTO = 40 * MiB, WS_W13 = 44 * MiB, WS_W2 = 66 * MiB;
constexpr size_t WS_W13M = 80 * MiB, WS_W2M = 192 * MiB;
constexpr size_t WS_H = 248 * MiB, WS_YE = 314 * MiB, WS_BIG = 444 * MiB;
constexpr size_t WS_PZUV = WS_BIG, WS_UP = WS_BIG + 130 * MiB, WS_HID = WS_BIG, WS_P5 = WS_BIG, WS_SST = WS_BIG + 325 * MiB, WS_EG = WS_BIG + 453 * MiB, WS_S0 = WS_BIG + 454 * MiB, WS_HIDM = WS_BIG;
constexpr size_t WS_PARTC = WS_BIG + 469 * MiB, WS_PARTM = WS_PARTC + 24 * MiB;
constexpr size_t WS_SLOTOF = 1 * MiB + 576 * KiB;
constexpr size_t WS_END = WS_PARTM + 48 * MiB;
static_assert(WS_W2 + (size_t)2 * D * DFF * 2 <= WS_W13M, "static weights");
static_assert(WS_W2M + (size_t)NE * D * DEX * 2 <= WS_H && WS_H + (size_t)MT * D * 2 <= WS_YE && WS_YE + (size_t)MT * 2 * D * 2 <= WS_BIG, "ws map");
static_assert((size_t)MAXTILES * 256 * DEX * 2 <= 469 * MiB && (size_t)MT * NREC * 2 <= 325 * MiB && (size_t)MT * NEIN * 2 <= 130 * MiB, "big region");

constexpr int LDS_BYTES = 147456, MISC_OFF = 147456 - 256;
constexpr int XRS = 288;

typedef __bf16 bf16x2_t __attribute__((ext_vector_type(2)));
__device__ __forceinline__ unsigned f2bf(float f) { return (unsigned)__builtin_bit_cast(unsigned short, (__bf16)f); }
__device__ __forceinline__ unsigned pk2(float lo, float hi) { return __builtin_bit_cast(unsigned, __builtin_convertvector((f32x2){lo, hi}, bf16x2_t)); }
__device__ __forceinline__ float bf2f(unsigned short b) { return __builtin_bit_cast(float, (unsigned)b << 16); }
__device__ __forceinline__ float bflo(unsigned w) { return __builtin_bit_cast(float, w << 16); }
__device__ __forceinline__ float bfhi(unsigned w) { return __builtin_bit_cast(float, w & 0xffff0000u); }
__device__ __forceinline__ float shfl_x(float v, int o, int lane) { return __builtin_bit_cast(float, __builtin_amdgcn_ds_bpermute((lane ^ o) << 2, __builtin_bit_cast(int, v))); }
__device__ __forceinline__ float wave_sum(float v, int lane) {
#pragma unroll
    for (int o = 1; o < 64; o <<= 1) v += shfl_x(v, o, lane);
    return v;
}
__device__ __forceinline__ float siluf(float a) { return a * __builtin_amdgcn_rcpf(1.0f + __expf(-a)); }
#define WQ_NEXT(it, ctr, slot, G) do { __syncthreads(); if (threadIdx.x == 0) *(slot) = (unsigned)(G) + __hip_atomic_fetch_add((ctr), 1u, __ATOMIC_RELAXED, __HIP_MEMORY_SCOPE_AGENT); __syncthreads(); (it) = (int)*(slot); } while (0)
#define LDS_WAIT() asm volatile("s_waitcnt lgkmcnt(0)" ::: "memory")
#define VM_WAIT() asm volatile("s_waitcnt vmcnt(0)" ::: "memory")

#define XB_TMO      128
#define XB_XCNT(j)  (256  + 64 * (j))
#define XB_XSUB(j)  (1280 + 64 * (j))
#define XB_XGEN(j)  (2304 + 64 * (j))
#define XB_TOP      3328
#define XB_TOPGEN   3392
#define XCD_BAR_WORDS 3456
#define XB_SPIN_CAP (1u << 18)
__device__ __forceinline__ unsigned xb_ld(unsigned* p)              { return __hip_atomic_load(p, __ATOMIC_RELAXED, __HIP_MEMORY_SCOPE_AGENT); }
__device__ __forceinline__ unsigned xb_add(unsigned* p, unsigned v) { return __hip_atomic_fetch_add(p, v, __ATOMIC_RELAXED, __HIP_MEMORY_SCOPE_AGENT); }
__device__ __forceinline__ unsigned xb_xcc_id() { return (unsigned)__builtin_amdgcn_s_getreg((3 << 11) | 20) & 0xFu; }
#define XB_SPIN(cond, bar) do { unsigned _sp = 0; while (cond) { __builtin_amdgcn_s_sleep(1); \
    if ((++_sp & 255u) == 0u) { if (xb_ld(&(bar)[XB_TMO])) break; if (_sp > XB_SPIN_CAP) { atomicAdd(&(bar)[XB_TMO], 1u); break; } } } } while (0)
struct XcdBarrier { unsigned* bar; unsigned x; volatile LAS unsigned* st; };
__device__ __forceinline__ XcdBarrier xcd_barrier_post(unsigned* bar, volatile LAS unsigned* st) {
    XcdBarrier b; b.bar = bar; b.x = xb_xcc_id(); b.st = st;
    if (threadIdx.x == 0) (void)xb_add(&bar[XB_XCNT(b.x)], 1u);
    return b;
}
__device__ __forceinline__ void xcd_barrier_complete(unsigned* bar, unsigned x, unsigned& nloc, unsigned& nx) {
    const unsigned G = gridDim.x * gridDim.y * gridDim.z;
    unsigned sum, cnt, mine, sp = 0u;
    for (;;) {
        sum = 0u; cnt = 0u; mine = 0u;
#pragma unroll
        for (unsigned j = 0; j < 16; ++j) { const unsigned c = xb_ld(&bar[XB_XCNT(j)]); sum += c; cnt += (c > 0u) ? 1u : 0u; mine = (j == x) ? c : mine; }
        if (sum == G) break;
        __builtin_amdgcn_s_sleep(1);
        if ((++sp & 255u) == 0u) { if (xb_ld(&bar[XB_TMO])) break; if (sp > XB_SPIN_CAP) { atomicAdd(&bar[XB_TMO], 1u); break; } }
    }
    nloc = mine > 0u ? mine : 1u; nx = cnt > 0u ? cnt : 1u;
}
__device__ __forceinline__ void xcd_barrier(const XcdBarrier& b) {
    asm volatile("s_waitcnt vmcnt(0)" ::: "memory");
    __syncthreads();
    if (threadIdx.x == 0) {
        unsigned* bar = b.bar;
        __builtin_amdgcn_s_waitcnt(0);
        unsigned nloc = b.st[0], nx = b.st[1];
        if (nloc == 0u) { xcd_barrier_complete(bar, b.x, nloc, nx); b.st[0] = nloc; b.st[1] = nx; }
        const unsigned old = xb_add(&bar[XB_XSUB(b.x)], 1u);
        const unsigned gen = old / nloc;
        if (old + 1u == (gen + 1u) * nloc) {
            __builtin_amdgcn_fence(__ATOMIC_RELEASE, "agent");
            asm volatile("s_waitcnt vmcnt(0)" ::: "memory");
            const unsigned og = xb_add(&bar[XB_TOP], 1u);
            const unsigned tg = og / nx;
            if (og + 1u == (tg + 1u) * nx) xb_add(&bar[XB_TOPGEN], 1u);
            else XB_SPIN(xb_ld(&bar[XB_TOPGEN]) == tg, bar);
            __builtin_amdgcn_fence(__ATOMIC_ACQUIRE, "agent");
            xb_add(&bar[XB_XGEN(b.x)], 1u);
            asm volatile("s_waitcnt vmcnt(0)" ::: "memory");
        } else {
            XB_SPIN(xb_ld(&bar[XB_XGEN(b.x)]) == gen, bar);
            __builtin_amdgcn_fence(__ATOMIC_ACQUIRE, "agent");
            asm volatile("s_waitcnt vmcnt(0)" ::: "memory");
        }
    }
    __syncthreads();
}

namespace pg8 {
constexpr int BM = 256, BK = 64, HALF = 128, HTB = HALF * BK * 2, STAGE_BYTES = 8 * HTB, NXCD = 8, WGM = 8;
__host__ __device__ __forceinline__ int lds_byte(int r, int c) { const int st = (r >> 4) * 2 + (c >> 5), rr = r & 15, cc = c & 31, ob = rr * 64 + cc * 2; return st * 1024 + (ob ^ (((ob >> 9) & 1) << 5)); }
__host__ __device__ __forceinline__ void stage_rc(int b, int& R, int& C) { const int st = b / 1024, sb = b % 1024, swz = sb ^ (((sb >> 9) & 1) << 5); R = (st >> 1) * 16 + swz / 64; C = (st & 1) * 32 + (swz % 64) / 2; }
__host__ __device__ __forceinline__ int perm32(int rho) { const int n = rho >> 4, i = rho & 15; return 8 * (i >> 2) + 4 * n + (i & 3); }
struct Unit { int pm, pn, kt0, nt, kp; };
struct Gemm { const bf16_t* A; const bf16_t* Bt; int M, N, K; const int* arow; const int* grp; size_t gstride; };
struct StaticOrder {
    int nM, nN, nwg, G, c, ntk;
    __host__ __device__ void init(int M, int N, int K, int G_, int c_) { nM = M / BM; nN = N / BM; nwg = nM * nN; G = G_; c = c_; ntk = K / BK; }
    __host__ __device__ bool next(int i, Unit& u) const {
        const long L = (long)i * G + c; if (L >= nwg) return false;
        int wgid = (int)L; { const int q = nwg / NXCD, r = nwg % NXCD, xcd = wgid % NXCD, off = wgid / NXCD; wgid = (xcd < r ? xcd * (q + 1) : r * (q + 1) + (xcd - r) * q) + off; }
        const int nig = WGM * nN, gid = wgid / nig, fm = gid * WGM, gsz = (nM - fm) < WGM ? (nM - fm) : WGM;
        u.pm = fm + ((wgid % nig) % gsz); u.pn = (wgid % nig) / gsz; u.kt0 = 0; u.nt = ntk; u.kp = 0; return true;
    }
};
struct ResOrder {
    StaticOrder S; int nlat, npieces, q0, q1, G, c;
    __host__ __device__ void init(int K, int G_, int c_, bool with_ctx) { S.init(ML, D, K, G_, c_); nlat = S.nwg; const int ntk = K / BK; q1 = (ntk / 8) * 2; q0 = (ntk - 2 * q1) / 2; npieces = with_ctx ? 2 * 4 * 4 : 0; G = G_; c = c_; }
    __host__ __device__ bool next(int i, Unit& u) const {
        const long L = (long)i * G + c; if (L < nlat) return S.next(i, u);
        const int idx = (int)(L - nlat); if (idx >= npieces) return false;
        const int kp = idx & 3; u.kp = kp; u.kt0 = kp < 2 ? kp * q0 : 2 * q0 + (kp - 2) * q1; u.nt = kp < 2 ? q0 : q1; u.pn = (idx >> 2) & 3; u.pm = 128 + (idx >> 4); return true;
    }
};
struct MoeDownOrder {
    StaticOrder S; int nfull, ntail, G, c;
    __host__ __device__ void init(int ntiles, int G_, int c_) { const int pf = ntiles < 256 ? ntiles : 256; S.init(pf * BM, D, DEX, G_, c_); nfull = pf * 4; ntail = (ntiles - pf) * 16; G = G_; c = c_; }
    __host__ __device__ bool next(int i, Unit& u) const {
        const long L = (long)i * G + c; if (L < nfull) return S.next(i, u);
        const int idx = (int)(L - nfull); if (idx >= ntail) return false;
        u.kp = idx & 3; u.kt0 = 14 * (idx & 3); u.nt = 14; u.pn = (idx >> 2) & 3; u.pm = 256 + (idx >> 4); return true;
    }
};
__device__ __forceinline__ unsigned cvt_pk_bf16(float lo, float hi) { unsigned r; asm volatile("v_cvt_pk_bf16_f32 %0, %1, %2" : "=v"(r) : "v"(lo), "v"(hi)); return r; }
__device__ __forceinline__ f32x2 gelu_pk(f32x2 v) {
    const f32x2 av = __builtin_elementwise_abs(v), d = av * 0.2316418882f + 1.0f;
    f32x2 t; t.x = __builtin_amdgcn_rcpf(d.x); t.y = __builtin_amdgcn_rcpf(d.y);
    f32x2 q = t * 0.5307027145f + (-0.7265760135f); q = q * t + 0.7107068705f; q = q * t + (-0.142248368f); q = q * t + 0.127414796f; q = q * t;
    const f32x2 s = (v * v) * (-0.72134752044f);
    f32x2 e; e.x = __builtin_amdgcn_exp2f(s.x); e.y = __builtin_amdgcn_exp2f(s.y);
    const f32x2 m = v * (q * e), r = v - m;
    f32x2 o; o.x = v.x < 0.f ? m.x : r.x; o.y = v.y < 0.f ? m.y : r.y; return o;
}
template <class Epi, class Sched, bool ALIGN_EPI, bool GATHER>
__device__ __forceinline__ void gemm_phase(LAS unsigned char* lds, const Gemm g, const Sched& S, const Epi& E, const int tid) {
    const int wid = __builtin_amdgcn_readfirstlane(tid >> 6), lane = tid & 63, wr = wid >> 2, wc = wid & 3, fr = lane & 15, fq = lane >> 4;
    const int K = g.K;
    unsigned voffA[2], voffB[2];
    unsigned voffA1[2];
#pragma unroll
    for (int i = 0; i < 2; ++i) { int R, C; stage_rc(tid * 16 + i * 8192, R, C); const int Rb = Epi::PERM ? ((R & ~31) + perm32(R & 31)) : R;
        voffA[i] = (unsigned)(R * K + C) * 2u; voffA1[i] = voffA[i]; voffB[i] = (unsigned)(Rb * K + C) * 2u; }
    const size_t kstep = (size_t)(BK * 2);
    const size_t hstep = (size_t)HALF * K * 2;
    const size_t tstep = 2 * hstep;
    const unsigned ldsw = (unsigned)wid * 1024u;
    const int aoff = lds_byte(wr * 64 + fr, fq * 8), boff = lds_byte(wc * 32 + fr, fq * 8);
#define PG8_SA(b, h) (((b) * 2 + (h)) * HTB)
#define PG8_SB(b, h) ((4 + (b) * 2 + (h)) * HTB)
#define PG8_STAGE(bufoff, gbase, voff) do { _Pragma("unroll") for (int _i = 0; _i < 2; ++_i) \
        __builtin_amdgcn_global_load_lds((const unsigned*)((const char*)(gbase) + (voff)[_i]), (LAS unsigned*)(lds + (bufoff) + ldsw + _i * 8192), 16, 0, 0); } while (0)
#define PG8_LDA(dst, b, h) do { _Pragma("unroll") for (int m = 0; m < 4; ++m) _Pragma("unroll") for (int k = 0; k < 2; ++k) dst[m][k] = *(const LAS bf16x8*)(lds + PG8_SA(b, h) + aoff + m * 2048 + k * 1024); } while (0)
#define PG8_LDB(dst, b, h) do { _Pragma("unroll") for (int n = 0; n < 2; ++n) _Pragma("unroll") for (int k = 0; k < 2; ++k) dst[n][k] = *(const LAS bf16x8*)(lds + PG8_SB(b, h) + boff + n * 2048 + k * 1024); } while (0)
#define PG8_MMA(ai, bj, At, Bt) do { __builtin_amdgcn_s_setprio(1); _Pragma("unroll") for (int m = 0; m < 4; ++m) _Pragma("unroll") for (int n = 0; n < 2; ++n) _Pragma("unroll") for (int k = 0; k < 2; ++k) \
        acc[ai][bj][m][n] = __builtin_amdgcn_mfma_f32_16x16x32_bf16(Bt[n][k], At[m][k], acc[ai][bj][m][n], 0, 0, 0); __builtin_amdgcn_s_setprio(0); } while (0)
#define PG8_WAIT_V(n) asm volatile("s_waitcnt vmcnt(" #n ")" ::: "memory")
#define PG8_WAIT_L(n) asm volatile("s_waitcnt lgkmcnt(" #n ")" ::: "memory")
#define PG8_BAR __builtin_amdgcn_s_barrier()
#define PG8_SCHED __builtin_amdgcn_sched_barrier(0)
#define PG8_VA1 (GATHER ? voffA1 : voffA)
#define PG8_GOFF(u, v0, v1) do { _Pragma("unroll") for (int _i = 0; _i < 2; ++_i) { int R_, C_; stage_rc(tid * 16 + _i * 8192, R_, C_); \
        const int r0_ = g.arow[(u).pm * BM + R_], r1_ = g.arow[(u).pm * BM + HALF + R_]; v0[_i] = (unsigned)(r0_ * K + C_) * 2u; v1[_i] = (unsigned)(r1_ * K + C_) * 2u; } } while (0)
#define PG8_BBASE(u) ((const char*)g.Bt + (g.grp ? (size_t)g.grp[(u).pm] * g.gstride * 2 : (size_t)0) + (size_t)(u).pn * tstep + (size_t)(u).kt0 * kstep)
    Unit cur, nxt; int ui = 0;
    if (!S.next(0, cur)) return;
    f32x4 acc[2][2][4][2];
#pragma unroll
    for (int a = 0; a < 2; ++a)
#pragma unroll
        for (int b = 0; b < 2; ++b)
#pragma unroll
            for (int m = 0; m < 4; ++m)
#pragma unroll
                for (int n = 0; n < 2; ++n) acc[a][b][m][n] = (f32x4){0.f, 0.f, 0.f, 0.f};
    bf16x8 At[4][2], B0[2][2], B1[2][2];
    const char* cA = (GATHER ? (const char*)g.A : (const char*)g.A + (size_t)cur.pm * tstep) + (size_t)cur.kt0 * kstep;
    const size_t ah = GATHER ? (size_t)0 : hstep;
    if constexpr (GATHER) PG8_GOFF(cur, voffA, voffA1);
    const char* cB = PG8_BBASE(cur);
    PG8_STAGE(PG8_SB(0, 0), cB, voffB); PG8_STAGE(PG8_SA(0, 0), cA, voffA); PG8_STAGE(PG8_SB(0, 1), cB + hstep, voffB); PG8_STAGE(PG8_SA(0, 1), cA + ah, PG8_VA1);
    if (wr == 1) PG8_BAR;
    PG8_WAIT_V(4); PG8_BAR;
    PG8_STAGE(PG8_SB(1, 0), cB + kstep, voffB); PG8_STAGE(PG8_SA(1, 0), cA + kstep, voffA); PG8_STAGE(PG8_SB(1, 1), cB + hstep + kstep, voffB);
    PG8_WAIT_V(6); PG8_BAR;
    for (;;) {
        const bool has_next = S.next(ui + 1, nxt);
        const char* nA = !has_next ? cA : (GATHER ? (const char*)g.A : (const char*)g.A + (size_t)nxt.pm * tstep) + (size_t)nxt.kt0 * kstep; const char* nB = has_next ? PG8_BBASE(nxt) : cB;
        const int nt = cur.nt;
        for (int t = 0; t < nt; t += 2) {
            const bool last = (t == nt - 2);
            const char* a1 = cA + (size_t)(t + 1) * kstep;
            const char* a2 = last ? nA : cA + (size_t)(t + 2) * kstep; const char* b2 = last ? nB : cB + (size_t)(t + 2) * kstep;
            const char* a3 = a2 + kstep; const char* b3 = b2 + kstep;
            PG8_LDB(B0, 0, 0); PG8_SCHED; PG8_LDA(At, 0, 0); PG8_STAGE(PG8_SA(1, 1), a1 + ah, PG8_VA1);
            if constexpr (GATHER) { if (last && has_next) PG8_GOFF(nxt, voffA, voffA1); }
            PG8_WAIT_L(8); PG8_BAR; PG8_WAIT_L(0); PG8_MMA(0, 0, At, B0); PG8_BAR; PG8_SCHED;
            PG8_LDB(B1, 0, 1); PG8_STAGE(PG8_SB(0, 0), b2, voffB);
            PG8_BAR; PG8_WAIT_L(0); PG8_MMA(0, 1, At, B1); PG8_BAR;
            PG8_LDA(At, 0, 1); PG8_STAGE(PG8_SA(0, 0), a2, voffA);
            PG8_BAR; PG8_WAIT_L(0); PG8_MMA(1, 0, At, B0); PG8_BAR; PG8_SCHED;
            PG8_STAGE(PG8_SB(0, 1), b2 + hstep, voffB);
            PG8_WAIT_V(6); PG8_BAR; PG8_MMA(1, 1, At, B1); PG8_BAR;
            PG8_LDB(B0, 1, 0); PG8_SCHED; PG8_LDA(At, 1, 0); PG8_STAGE(PG8_SA(0, 1), a2 + ah, PG8_VA1);
            PG8_WAIT_L(8); PG8_BAR; PG8_WAIT_L(0); PG8_MMA(0, 0, At, B0); PG8_BAR; PG8_SCHED;
            PG8_LDB(B1, 1, 1); PG8_STAGE(PG8_SB(1, 0), b3, voffB);
            PG8_BAR; PG8_WAIT_L(0); PG8_MMA(0, 1, At, B1); PG8_BAR;
            PG8_LDA(At, 1, 1); PG8_STAGE(PG8_SA(1, 0), a3, voffA);
            PG8_BAR; PG8_WAIT_L(0); PG8_MMA(1, 0, At, B0); PG8_BAR; PG8_SCHED;
            PG8_STAGE(PG8_SB(1, 1), b3 + hstep, voffB);
            PG8_WAIT_V(6); PG8_BAR; PG8_MMA(1, 1, At, B1); PG8_BAR;
        }
        if constexpr (ALIGN_EPI) { if (wr == 0) PG8_BAR; }
        E(acc, cur, wr, wc, fr, fq);
        if (!has_next) break;
#pragma unroll
        for (int a = 0; a < 2; ++a)
#pragma unroll
            for (int b = 0; b < 2; ++b)
#pragma unroll
                for (int m = 0; m < 4; ++m)
#pragma unroll
                    for (int n = 0; n < 2; ++n) acc[a][b][m][n] = (f32x4){0.f, 0.f, 0.f, 0.f};
        cur = nxt; cA = nA; cB = nB; ++ui;
        if constexpr (ALIGN_EPI) { if (wr == 1) PG8_BAR; }
    }
    PG8_WAIT_V(0);
    if constexpr (!ALIGN_EPI) { if (wr == 0) PG8_BAR; }
    PG8_BAR;
#undef PG8_SA
#undef PG8_SB
#undef PG8_STAGE
#undef PG8_LDA
#undef PG8_LDB
#undef PG8_MMA
#undef PG8_WAIT_V
#undef PG8_WAIT_L
#undef PG8_BAR
#undef PG8_SCHED
#undef PG8_VA1
#undef PG8_GOFF
#undef PG8_BBASE
}

struct EpiEvenIn {
    static constexpr bool PERM = true;
    bf16_t* O;
    __device__ __forceinline__ void operator()(const f32x4 (&acc)[2][2][4][2], const Unit& u, int wr, int wc, int fr, int fq) const {
        const int row0 = u.pm * BM + wr * 64 + fr, col0 = u.pn * BM + wc * 32 + 8 * fq; const bool act = u.pn >= 4;
#pragma unroll
        for (int ai = 0; ai < 2; ++ai)
#pragma unroll
            for (int m = 0; m < 4; ++m) { bf16_t* rowp = O + (size_t)(row0 + ai * HALF + m * 16) * NEIN + col0;
#pragma unroll
                for (int bj = 0; bj < 2; ++bj) { f32x4 v0 = acc[ai][bj][m][0], v1 = acc[ai][bj][m][1];
                    if (act) { f32x2 a = gelu_pk((f32x2){v0[0], v0[1]}), b = gelu_pk((f32x2){v0[2], v0[3]}), c = gelu_pk((f32x2){v1[0], v1[1]}), d = gelu_pk((f32x2){v1[2], v1[3]});
                        v0 = (f32x4){a.x, a.y, b.x, b.y}; v1 = (f32x4){c.x, c.y, d.x, d.y}; }
                    u32x4 w; w.x = cvt_pk_bf16(v0[0], v0[1]); w.y = cvt_pk_bf16(v0[2], v0[3]); w.z = cvt_pk_bf16(v1[0], v1[1]); w.w = cvt_pk_bf16(v1[2], v1[3]);
                    *(u32x4*)(rowp + bj * HALF) = w; } }
    }
};
struct EpiRes {
    static constexpr bool PERM = false;
    const float* sl; float* dl; const float* gate; float* part;
    __device__ __forceinline__ void operator()(const f32x4 (&acc)[2][2][4][2], const Unit& u, int wr, int wc, int fr, int fq) const {
        const int col0 = u.pn * BM + wc * 32 + 4 * fq;
        if (u.pm >= 128) {
            float* dst = part + ((size_t)u.kp * MC + (size_t)(u.pm - 128) * BM) * D;
#pragma unroll
            for (int ai = 0; ai < 2; ++ai)
#pragma unroll
                for (int m = 0; m < 4; ++m) { const size_t off = (size_t)(ai * HALF + wr * 64 + m * 16 + fr) * D + col0;
#pragma unroll
                    for (int bj = 0; bj < 2; ++bj)
#pragma unroll
                        for (int n = 0; n < 2; ++n) *(f32x4*)(dst + off + bj * HALF + n * 16) = acc[ai][bj][m][n]; }
            return;
        }
        const int ms = u.pm >= 64 ? 1 : 0;
        const size_t rbase = (size_t)u.pm * BM;
        const float* src = sl + rbase * D; float* dst = dl + rbase * D;
        f32x4 gv[2][2];
#pragma unroll
        for (int bj = 0; bj < 2; ++bj)
#pragma unroll
            for (int n = 0; n < 2; ++n) gv[bj][n] = *(const f32x4*)(gate + ms * 6144 + col0 + bj * HALF + n * 16);
#pragma unroll
        for (int ai = 0; ai < 2; ++ai)
#pragma unroll
            for (int m = 0; m < 4; ++m) { const size_t off = (size_t)(ai * HALF + wr * 64 + m * 16 + fr) * D + col0;
#pragma unroll
                for (int bj = 0; bj < 2; ++bj)
#pragma unroll
                    for (int n = 0; n < 2; ++n) { const f32x4 xs = *(const f32x4*)(src + off + bj * HALF + n * 16); *(f32x4*)(dst + off + bj * HALF + n * 16) = xs + gv[bj][n] * acc[ai][bj][m][n]; } }
    }
};
struct EpiSwiglu {
    static constexpr bool PERM = true;
    bf16_t* O; int ldc;
    __device__ __forceinline__ void operator()(const f32x4 (&acc)[2][2][4][2], const Unit& u, int wr, int wc, int fr, int fq) const {
        const int row0 = u.pm * BM + wr * 64 + fr, col0 = u.pn * 128 + wc * 16 + 4 * fq;
#pragma unroll
        for (int ai = 0; ai < 2; ++ai)
#pragma unroll
            for (int m = 0; m < 4; ++m) { bf16_t* rowp = O + (size_t)(row0 + ai * HALF + m * 16) * ldc + col0;
#pragma unroll
                for (int bj = 0; bj < 2; ++bj) { const f32x4 a = acc[ai][bj][m][0], b = acc[ai][bj][m][1];
                    u32x2 w; w.x = cvt_pk_bf16(siluf(a[0]) * b[0], siluf(a[1]) * b[1]); w.y = cvt_pk_bf16(siluf(a[2]) * b[2], siluf(a[3]) * b[3]);
                    *(u32x2*)(rowp + bj * 64) = w; } }
    }
};
struct EpiOddIn {
    static constexpr bool PERM = true;
    bf16_t* O; const float* lb;
    __device__ __forceinline__ void operator()(const f32x4 (&acc)[2][2][4][2], const Unit& u, int wr, int wc, int fr, int fq) const {
        const int row0 = u.pm * BM + wr * 64 + fr, col0 = u.pn * BM + wc * 32 + 8 * fq; const int seg = u.pn >> 2;
        f32x4 lbv[2][2];
#pragma unroll
        for (int bj = 0; bj < 2; ++bj)
#pragma unroll
            for (int n = 0; n < 2; ++n) lbv[bj][n] = (seg == 2 || seg == 3) ? *(const f32x4*)(lb + (col0 - 2048) + bj * HALF + 4 * n) : (f32x4){0.f, 0.f, 0.f, 0.f};
#pragma unroll
        for (int ai = 0; ai < 2; ++ai)
#pragma unroll
            for (int m = 0; m < 4; ++m) { bf16_t* rowp = O + (size_t)(row0 + ai * HALF + m * 16) * NREC + col0;
#pragma unroll
                for (int bj = 0; bj < 2; ++bj) { f32x4 v[2] = {acc[ai][bj][m][0], acc[ai][bj][m][1]};
#pragma unroll
                    for (int n = 0; n < 2; ++n)
#pragma unroll
                        for (int i = 0; i < 4; ++i) { float x = v[n][i];
                            if (seg == 0) x = siluf(x) * 0.08838834764831845f;
                            else if (seg == 1) x = siluf(x);
                            else if (seg == 2 || seg == 3) { const float l = lbv[bj][n][i]; const float s = __builtin_amdgcn_rcpf(1.0f + __expf(-x)); const float f = l + (1.0f - l) * s; x = __logf(fmaxf(f, 1e-30f)); }
                            v[n][i] = x; }
                    u32x4 w; w.x = cvt_pk_bf16(v[0][0], v[0][1]); w.y = cvt_pk_bf16(v[0][2], v[0][3]); w.z = cvt_pk_bf16(v[1][0], v[1][1]); w.w = cvt_pk_bf16(v[1][2], v[1][3]);
                    *(u32x4*)(rowp + bj * HALF) = w; } }
    }
};
struct EpiNull { static constexpr bool PERM = true; float* sink;
    __device__ __forceinline__ void operator()(const f32x4 (&acc)[2][2][4][2], const Unit& u, int wr, int wc, int fr, int fq) const {
        float s = 0.f;
#pragma unroll
        for (int ai = 0; ai < 2; ++ai)
#pragma unroll
            for (int bj = 0; bj < 2; ++bj)
#pragma unroll
                for (int m = 0; m < 4; ++m)
#pragma unroll
                    for (int n = 0; n < 2; ++n) s += acc[ai][bj][m][n][0] + acc[ai][bj][m][n][1] + acc[ai][bj][m][n][2] + acc[ai][bj][m][n][3];
        if (s == 123.456f) sink[0] = s; } };
struct EpiMoeDown {
    static constexpr bool PERM = true;
    bf16_t* O; const int* dst; float* partm;
    __device__ __forceinline__ void operator()(const f32x4 (&acc)[2][2][4][2], const Unit& u, int wr, int wc, int fr, int fq) const {
        const int row0 = u.pm * BM + wr * 64 + fr, col0 = u.pn * BM + wc * 32 + 8 * fq;
        if (u.pm >= 256) {
            float* base = partm + ((size_t)u.kp * 3072 + (size_t)(row0 - 65536)) * D + col0;
#pragma unroll
            for (int ai = 0; ai < 2; ++ai)
#pragma unroll
                for (int m = 0; m < 4; ++m) { float* rowp = base + (size_t)(ai * HALF + m * 16) * D;
#pragma unroll
                    for (int bj = 0; bj < 2; ++bj) { *(f32x4*)(rowp + bj * HALF) = acc[ai][bj][m][0]; *(f32x4*)(rowp + bj * HALF + 4) = acc[ai][bj][m][1]; } }
            return;
        }
        int dd[2][4];
#pragma unroll
        for (int ai = 0; ai < 2; ++ai)
#pragma unroll
            for (int m = 0; m < 4; ++m) dd[ai][m] = dst[row0 + ai * HALF + m * 16];
#pragma unroll
        for (int ai = 0; ai < 2; ++ai)
#pragma unroll
            for (int m = 0; m < 4; ++m) { if (dd[ai][m] >= 0) { bf16_t* rowp = O + (size_t)dd[ai][m] * D + col0;
#pragma unroll
                for (int bj = 0; bj < 2; ++bj) { const f32x4 v0 = acc[ai][bj][m][0], v1 = acc[ai][bj][m][1];
                    u32x4 w; w.x = cvt_pk_bf16(v0[0], v0[1]); w.y = cvt_pk_bf16(v0[2], v0[3]); w.z = cvt_pk_bf16(v1[0], v1[1]); w.w = cvt_pk_bf16(v1[2], v1[3]);
                    *(u32x4*)(rowp + bj * HALF) = w; } } }
    }
};
}

struct Args { const float* in[24]; float* out; unsigned char* ws; int ph_lo, ph_hi; };
enum { I_X = 0, I_C, I_CTX, I_CCTX, I_WADA, I_BADA, I_NMIX, I_NFFN, I_NOUT, I_WINE, I_GW, I_GB, I_WOUTE, I_WINO, I_RLB, I_RNORM, I_WOUTO, I_F1, I_F3, I_F2, I_RW, I_M1, I_M3, I_M2 };
enum { PH_P0 = 0, PH_PAIR0 = 1, NPL = 18, PH_FINAL = 1 + 2 * NPL, NPHASE = PH_FINAL + 1 };
enum { E1_NORM = 0, E2_GIN, E3_FFTA, E3_FFTC, E4_GOUT, E5_NORM, E6_UP, E7_DOWN, O1_NORM, O2_GIN, O3_SCAN1, O4_CARRY, O5_SCAN3, O6_GOUT, O7_NORM, O8_SLOTS, O9_MUP, O10_MDOWN };

struct Ctx {
    LAS unsigned char* lds; int tid, lane, wave, G, bid, gw, NGW;
    const float* const* in; float* out; unsigned char* ws;
};

__device__ __forceinline__ void transpose_item(const float* W, int ld, int K, int N, bf16_t* WT, int mode, int roff, int item, int lane) {
    const int nblk = N / 64, kb = item / nblk, nb = item % nblk, k0 = 64 * kb, n0 = 64 * nb;
    const int c = lane & 15, kg = lane >> 4;
    const float* src = W + (size_t)(k0 + 8 * kg) * ld + n0 + 4 * c;
    f32x4 v[2][8];
#pragma unroll
    for (int hf = 0; hf < 2; ++hf)
#pragma unroll
        for (int i = 0; i < 8; ++i) v[hf][i] = __builtin_nontemporal_load((const f32x4*)(src + (size_t)(32 * hf + i) * ld));
#pragma unroll
    for (int i = 0; i < 4; ++i) { const int ng = n0 + 4 * c + i; const int drow = mode == 0 ? (roff + ng) : (((ng >> 2) << 3) + (ng & 3) + roff);
#pragma unroll
        for (int hf = 0; hf < 2; ++hf) { u32x4 o; o.x = pk2(v[hf][0][i], v[hf][1][i]); o.y = pk2(v[hf][2][i], v[hf][3][i]); o.z = pk2(v[hf][4][i], v[hf][5][i]); o.w = pk2(v[hf][6][i], v[hf][7][i]);
            *(u32x4*)(WT + (size_t)drow * K + k0 + 32 * hf + 8 * kg) = o; } }
}

__device__ __forceinline__ void p0_prologue(const Ctx& F) {
    const int tid = F.tid, lane = F.lane, wave = F.wave;
    unsigned char* ws = F.ws;
    LAS float* scond = (LAS float*)(F.lds);
    LAS float* part = (LAS float*)(F.lds + 16384);
    LAS float* ctab = (LAS float*)(F.lds + 32768);
    for (int i = tid; i < 3 * D; i += 512) { const int v = i / D, k = i % D; const float c = v < 2 ? F.in[I_C][v * D + k] : F.in[I_CCTX][k]; scond[i] = c / (1.0f + expf(-c)); }
    if (tid < 128) ctab[tid] = cosf(6.283185307179586f * (float)tid / 128.0f);
    __syncthreads();
    float* mods = (float*)(ws + WS_MODS);
    if (P0_MASK & 1)
    for (int it = F.bid; it < 4 * 48; it += F.G) {
        const int l = it / 48, cg = it % 48; const float* W = F.in[I_WADA] + (size_t)l * D * 6144 + cg * 128 + 2 * lane;
        float a0[2] = {0.f, 0.f}, a1[2] = {0.f, 0.f}, a2[2] = {0.f, 0.f};
#pragma unroll 16
        for (int kk = 0; kk < 128; ++kk) { const int k = wave * 128 + kk; const f32x2 w = __builtin_nontemporal_load((const f32x2*)(W + (size_t)k * 6144)); const float s0 = scond[k], s1 = scond[D + k], s2 = scond[2 * D + k];
            a0[0] += s0 * w.x; a0[1] += s0 * w.y; a1[0] += s1 * w.x; a1[1] += s1 * w.y; a2[0] += s2 * w.x; a2[1] += s2 * w.y; }
        part[(wave * 3 + 0) * 128 + 2 * lane] = a0[0]; part[(wave * 3 + 0) * 128 + 2 * lane + 1] = a0[1];
        part[(wave * 3 + 1) * 128 + 2 * lane] = a1[0]; part[(wave * 3 + 1) * 128 + 2 * lane + 1] = a1[1];
        part[(wave * 3 + 2) * 128 + 2 * lane] = a2[0]; part[(wave * 3 + 2) * 128 + 2 * lane + 1] = a2[1];
        __syncthreads();
        if (tid < 384) { const int v = tid / 128, c = tid % 128; float sum = 0.f;
#pragma unroll
            for (int w = 0; w < 8; ++w) sum += part[(w * 3 + v) * 128 + c];
            mods[((size_t)l * 3 + v) * 6144 + cg * 128 + c] = sum + F.in[I_BADA][l * 6144 + cg * 128 + c]; }
        __syncthreads();
    }
    const int gt = F.bid * 512 + tid, NGT = F.G * 512;
    float* LB = (float*)(ws + WS_LB);
    if (P0_MASK & 2)
    for (int i = gt; i < 4096; i += NGT) { const int j = i >> 11, r = i & 2047; float v = 0.f; if (j == 1) { const float r0 = F.in[I_RLB][r], r1 = F.in[I_RLB][2048 + r]; v = 1.0f / (1.0f + expf(r0 - r1)); v = fminf(fmaxf(v, 0.f), 1.f); } LB[i] = v; }
    bf16_t* FA = (bf16_t*)(ws + WS_FA); bf16_t* FC = (bf16_t*)(ws + WS_FC); bf16_t* FX = (bf16_t*)(ws + WS_FX); bf16_t* GW = (bf16_t*)(ws + WS_GW);
    if (P0_MASK & 4)
    for (int i = gt; i < 256 * 256; i += NGT) { const int r = i >> 8, c = i & 255, k1 = r & 127, t1 = c & 127; const float ang = 6.283185307179586f * (float)((k1 * t1) & 127) / 128.0f; float sn, cs; sincosf(ang, &sn, &cs);
        const int rr = r >> 7, cc = c >> 7; const float v = (rr == cc) ? cs : (rr == 0 ? -sn : sn); FA[i] = (bf16_t)f2bf(v); }
    if (P0_MASK & 4)
    for (int i = gt; i < 128 * 256; i += NGT) { const int k2 = i >> 8, c = i & 255, t2 = c & 127; const float ang = 6.283185307179586f * (float)((k2 * t2) & 127) / 128.0f; float sn, cs; sincosf(ang, &sn, &cs); FC[i] = (bf16_t)f2bf(c < 128 ? cs : -sn); }
    if (P0_MASK & 4)
    for (int i = gt; i < 256 * 512; i += NGT) { const int k = i >> 9, c = i & 511, t = c & 255; const float ang = 6.283185307179586f * (float)((k * t) & 255) / 256.0f; float sn, cs; sincosf(ang, &sn, &cs); FX[i] = (bf16_t)f2bf(c < 256 ? cs : -sn); }
    if (P0_MASK & 8)
    for (int i = gt; i < 2 * 4 * 128 * 128; i += NGT) GW[i] = (bf16_t)f2bf(F.in[I_GW][i]);
    bf16_t* WinE = (bf16_t*)(ws + WS_WINE);
    if (P0_MASK & 16)
    for (int it = F.gw; it < 2 * 4 * 16 * 32; it += F.NGW) {
        const int mg = it & 31, kb = (it >> 5) & 15, g = (it >> 9) & 3, j = it >> 11; const int k = kb * 64 + lane, m0 = mg * 4;
        const float* Wr = F.in[I_WINE] + (size_t)j * D * 1536 + (size_t)k * 1536 + g * 128;
        float aP[4] = {0.f, 0.f, 0.f, 0.f}, aQ[4] = {0.f, 0.f, 0.f, 0.f};
        for (int c4 = 0; c4 < 32; ++c4) { const f32x4 w = *(const f32x4*)(Wr + 4 * c4);
#pragma unroll
            for (int ci = 0; ci < 4; ++ci) { const int c = 4 * c4 + ci;
#pragma unroll
                for (int mm = 0; mm < 4; ++mm) { const int idx = (c * (m0 + mm)) & 127; aP[mm] += w[ci] * ctab[idx]; aQ[mm] += w[ci] * ctab[(idx - 32) & 127]; } } }
#pragma unroll
        for (int mm = 0; mm < 4; ++mm) { bf16_t* o = WinE + (size_t)j * NEIN * D; o[(size_t)(g * 128 + m0 + mm) * D + k] = (bf16_t)f2bf(aP[mm]); o[(size_t)(512 + g * 128 + m0 + mm) * D + k] = (bf16_t)f2bf(aQ[mm]); }
    }
    constexpr int NI_UV = 16 * 16, NI_SQ = 16 * 16, NI_INO = 16 * 80, NI_F13 = 16 * 44, NI_F2 = 44 * 16;
    constexpr int PER_J = NI_UV + NI_SQ + NI_INO + NI_SQ + 2 * NI_F13 + NI_F2;
    if (P0_MASK & 32)
    for (int it = F.gw; it < 2 * PER_J; it += F.NGW) {
        const int j = it / PER_J; int r = it % PER_J;
        const float* W; int ld, K, N, mode = 0, roff = 0; bf16_t* WT;
        if (r < NI_UV) { W = F.in[I_WINE] + (size_t)j * D * 1536 + 512; ld = 1536; K = D; N = 1024; WT = WinE + (size_t)j * NEIN * D; roff = 1024; }
        else if ((r -= NI_UV) < NI_SQ) { W = F.in[I_WOUTE] + (size_t)j * D * D; ld = D; K = D; N = D; WT = (bf16_t*)(ws + WS_WOUTE) + (size_t)j * D * D; }
        else if ((r -= NI_SQ) < NI_INO) { W = F.in[I_WINO] + (size_t)j * D * NREC; ld = NREC; K = D; N = NREC; WT = (bf16_t*)(ws + WS_WINO) + (size_t)j * NREC * D; }
        else if ((r -= NI_INO) < NI_SQ) { W = F.in[I_WOUTO] + (size_t)j * D * D; ld = D; K = D; N = D; WT = (bf16_t*)(ws + WS_WOUTO) + (size_t)j * D * D; }
        else if ((r -= NI_SQ) < NI_F13) { W = F.in[I_F1] + (size_t)j * D * DFF; ld = DFF; K = D; N = DFF; WT = (bf16_t*)(ws + WS_W13) + (size_t)j * NFF2 * D; mode = 1; }
        else if ((r -= NI_F13) < NI_F13) { W = F.in[I_F3] + (size_t)j * D * DFF; ld = DFF; K = D; N = DFF; WT = (bf16_t*)(ws + WS_W13) + (size_t)j * NFF2 * D; mode = 1; roff = 4; }
        else { r -= NI_F13; W = F.in[I_F2] + (size_t)j * DFF * D; ld = D; K = DFF; N = D; WT = (bf16_t*)(ws + WS_W2) + (size_t)j * D * DFF; }
        transpose_item(W, ld, K, N, WT, mode, roff, r, lane);
    }
}
__device__ __forceinline__ void moe_convert(const Ctx& F, int j) {
    constexpr int I_13 = 16 * 56, I_2 = 56 * 16, PER_E = 2 * I_13 + I_2;
    for (int it = F.gw; it < NE * PER_E; it += F.NGW) {
        const int e = it / PER_E; int r = it % PER_E; const size_t eo = (size_t)(j * NE + e);
        const float* W; int ld, K, N, mode = 0, roff = 0; bf16_t* WT;
        if (r < I_13) { W = F.in[I_M1] + eo * D * DEX; ld = DEX; K = D; N = DEX; WT = (bf16_t*)(F.ws + WS_W13M) + (size_t)e * NEX2 * D; mode = 1; }
        else if ((r -= I_13) < I_13) { W = F.in[I_M3] + eo * D * DEX; ld = DEX; K = D; N = DEX; WT = (bf16_t*)(F.ws + WS_W13M) + (size_t)e * NEX2 * D; mode = 1; roff = 4; }
        else { r -= I_13; W = F.in[I_M2] + eo * DEX * D; ld = D; K = DEX; N = D; WT = (bf16_t*)(F.ws + WS_W2M) + (size_t)e * D * DEX; }
        transpose_item(W, ld, K, N, WT, mode, roff, r, F.lane);
    }
}

struct RowPass {
    const float* sl; const float* sc;
    float* dl; float* dc;
    const float* gain;
    const float* shift; const float* scale;
    bf16_t* H;
    int nrows;
    const bf16_t* YE; const float* topp; const float* gatef;
    const float* rw; int* tope; float* toppo; int* rank; int* cnt;
    float* fout;
    const float* part; int kpn; const float* pgate;
    const int* slotof; const float* partm;
};
struct RowPart { int WB, WC; };
__device__ __forceinline__ RowPart row_part(int NW, int nrows) { RowPart q; q.WC = nrows > ML ? NW / 32 : 0; q.WB = (NW - q.WC) / 2; return q; }
__device__ __forceinline__ void row_chunk(const RowPart& q, int gw, int& r0, int& r1) {
    if (gw < 2 * q.WB) { const int b = gw / q.WB, i = gw % q.WB; r0 = b * TL + (int)(((long)i * TL) / q.WB); r1 = b * TL + (int)(((long)(i + 1) * TL) / q.WB); }
    else { const int i = gw - 2 * q.WB; r0 = ML + (i * MC) / q.WC; r1 = ML + ((i + 1) * MC) / q.WC; }
}
__device__ __forceinline__ int row_chunk_of(const RowPart& q, int r) {
    if (r < ML) { const int b = r >> 14, lr = r & (TL - 1); return b * q.WB + (int)(((long)q.WB * (lr + 1) - 1) / TL); }
    return 2 * q.WB + ((r - ML + 1) * q.WC - 1) / MC;
}
template <bool COMBINE, bool ROUTER, bool FINAL>
__device__ __forceinline__ void row_pass(const Ctx& F, const RowPass& P) {
    const int lane = F.lane;
    LAS float* rwl = (LAS float*)F.lds;
    if (ROUTER) { for (int i = F.tid; i < D * NE; i += 512) rwl[i] = P.rw[i]; __syncthreads(); }
    f32x4 gn[4];
#pragma unroll
    for (int j = 0; j < 4; ++j) gn[j] = *(const f32x4*)(P.gain + 4 * lane + 256 * j);
    const RowPart rp = row_part(F.NGW, P.nrows);
    int r0, r1; row_chunk(rp, F.gw, r0, r1);
    {
        int rc0 = 0, rc1 = 0, rc2 = 0, rc3 = 0, rc4 = 0, rc5 = 0, rc6 = 0, rc7 = 0;
        const bool isc = r0 >= ML; const int ms = isc ? 2 : (r0 >= TL ? 1 : 0);
        const float* xs0 = isc ? P.sc + (size_t)(r0 - ML) * D : P.sl + (size_t)r0 * D;
        if (!COMBINE && !FINAL) { if (isc && P.part) {
            float* xd = P.dc + (size_t)(r0 - ML) * D;
#pragma unroll 1
            for (int rr = 0; rr < r1 - r0; ++rr) {
#pragma unroll 2
                for (int j = 0; j < 4; ++j) { f32x4 a[4];
#pragma unroll
                    for (int kp = 0; kp < 4; ++kp) a[kp] = *(const f32x4*)(P.part + ((size_t)kp * MC + (size_t)(r0 - ML + rr)) * D + 4 * lane + 256 * j);
                    *(f32x4*)(xd + (size_t)rr * D + 4 * lane + 256 * j) = *(const f32x4*)(xs0 + (size_t)rr * D + 4 * lane + 256 * j) + *(const f32x4*)(P.pgate + 2 * 6144 + 4 * lane + 256 * j) * ((a[0] + a[1]) + (a[2] + a[3])); } }
            asm volatile("s_waitcnt vmcnt(0)" ::: "memory");
            xs0 = xd; } }
        float* xd0 = nullptr; if (COMBINE && !FINAL) xd0 = isc ? P.dc + (size_t)(r0 - ML) * D : P.dl + (size_t)r0 * D;
        f32x4 sh[4], scl[4], gf[4];
#pragma unroll
        for (int j = 0; j < 4; ++j) {
            if (!FINAL && !COMBINE && !ROUTER) { sh[j] = *(const f32x4*)(P.shift + ms * 6144 + 4 * lane + 256 * j); scl[j] = *(const f32x4*)(P.scale + ms * 6144 + 4 * lane + 256 * j) + 1.0f; }
            if (COMBINE) gf[j] = *(const f32x4*)(P.gatef + ms * 6144 + 4 * lane + 256 * j); }
        f32x4 v[4]; u32x2 ya[4], yb[4]; float p0 = 0.f, p1 = 0.f;
#pragma unroll
        for (int j = 0; j < 4; ++j) v[j] = *(const f32x4*)(xs0 + 4 * lane + 256 * j);
        if (COMBINE) { p0 = P.topp[2 * r0]; p1 = P.topp[2 * r0 + 1];
#pragma unroll
            for (int j = 0; j < 4; ++j) { ya[j] = *(const u32x2*)(P.YE + (size_t)(2 * r0) * D + 4 * lane + 256 * j); yb[j] = *(const u32x2*)(P.YE + (size_t)(2 * r0 + 1) * D + 4 * lane + 256 * j); } }
        for (int r = r0; r < r1; ++r) {
            const int rr = r - r0; const bool more = r + 1 < r1;
            f32x4 vn[4]; u32x2 yan[4], ybn[4]; float p0n = 0.f, p1n = 0.f;
            if (ROUTER) { if (rr > 0) {
#pragma unroll
                for (int j = 0; j < 4; ++j) v[j] = *(const f32x4*)(xs0 + (size_t)rr * D + 4 * lane + 256 * j); } }
            if (!ROUTER && more) {
#pragma unroll
                for (int j = 0; j < 4; ++j) vn[j] = *(const f32x4*)(xs0 + (size_t)(rr + 1) * D + 4 * lane + 256 * j);
                if (COMBINE) { p0n = P.topp[2 * r + 2]; p1n = P.topp[2 * r + 3];
#pragma unroll
                    for (int j = 0; j < 4; ++j) { yan[j] = *(const u32x2*)(P.YE + (size_t)(2 * r + 2) * D + 4 * lane + 256 * j); ybn[j] = *(const u32x2*)(P.YE + (size_t)(2 * r + 3) * D + 4 * lane + 256 * j); } }
            }
            if (COMBINE) {
                const int sl0 = P.slotof[2 * r], sl1 = P.slotof[2 * r + 1];
#pragma unroll
                for (int j = 0; j < 4; ++j) { const u32x2 a = ya[j], b = yb[j];
                    f32x4 y0 = (f32x4){bflo(a.x), bfhi(a.x), bflo(a.y), bfhi(a.y)}, y1 = (f32x4){bflo(b.x), bfhi(b.x), bflo(b.y), bfhi(b.y)};
                    if (sl0 >= 65536) { y0 = (f32x4){0.f, 0.f, 0.f, 0.f}; for (int kp = 0; kp < 4; ++kp) y0 = y0 + *(const f32x4*)(P.partm + ((size_t)kp * 3072 + (size_t)(sl0 - 65536)) * D + 4 * lane + 256 * j); }
                    if (sl1 >= 65536) { y1 = (f32x4){0.f, 0.f, 0.f, 0.f}; for (int kp = 0; kp < 4; ++kp) y1 = y1 + *(const f32x4*)(P.partm + ((size_t)kp * 3072 + (size_t)(sl1 - 65536)) * D + 4 * lane + 256 * j); }
                    v[j] = v[j] + gf[j] * (y0 * p0 + y1 * p1);
                    if (!FINAL) *(f32x4*)(xd0 + (size_t)rr * D + 4 * lane + 256 * j) = v[j]; }
            }
            float ss = 0.f;
#pragma unroll
            for (int j = 0; j < 4; ++j) ss += (v[j][0] * v[j][0] + v[j][1] * v[j][1]) + (v[j][2] * v[j][2] + v[j][3] * v[j][3]);
            const float rstd = rsqrtf(wave_sum(ss, lane) * (1.0f / D) + EPS);
            if (FINAL) {
#pragma unroll
                for (int j = 0; j < 4; ++j) *(f32x4*)(P.fout + (size_t)r * D + 4 * lane + 256 * j) = v[j] * rstd * gn[j];
            } else {
                f32x4 h[4];
#pragma unroll
                for (int j = 0; j < 4; ++j) { if (COMBINE || ROUTER) { sh[j] = *(const f32x4*)(P.shift + ms * 6144 + 4 * lane + 256 * j); scl[j] = *(const f32x4*)(P.scale + ms * 6144 + 4 * lane + 256 * j) + 1.0f; }
                    h[j] = (v[j] * rstd * gn[j]) * scl[j] + sh[j];
                    u32x2 w; w.x = pk2(h[j][0], h[j][1]); w.y = pk2(h[j][2], h[j][3]);
                    *(u32x2*)(P.H + (size_t)r * D + 4 * lane + 256 * j) = w; }
                if (ROUTER) {
                    float lg[8] = {0.f, 0.f, 0.f, 0.f, 0.f, 0.f, 0.f, 0.f};
#pragma unroll
                    for (int j = 0; j < 4; ++j) {
#pragma unroll
                        for (int i = 0; i < 4; ++i) { const int col = 4 * lane + 256 * j + i; const f32x4 w0 = *(const LAS f32x4*)(rwl + col * 8), w1 = *(const LAS f32x4*)(rwl + col * 8 + 4); const float hv = h[j][i];
                            lg[0] += hv * w0[0]; lg[1] += hv * w0[1]; lg[2] += hv * w0[2]; lg[3] += hv * w0[3]; lg[4] += hv * w1[0]; lg[5] += hv * w1[1]; lg[6] += hv * w1[2]; lg[7] += hv * w1[3]; }
                        __builtin_amdgcn_sched_barrier(0); }
#pragma unroll
                    for (int e = 0; e < 8; ++e) lg[e] = wave_sum(lg[e], lane);
                    int e0 = 0; float v0 = lg[0];
#pragma unroll
                    for (int e = 1; e < 8; ++e) if (lg[e] > v0) { v0 = lg[e]; e0 = e; }
                    int e1 = -1; float v1 = -3.0e38f;
#pragma unroll
                    for (int e = 0; e < 8; ++e) if (e != e0 && lg[e] > v1) { v1 = lg[e]; e1 = e; }
                    const float ex = expf(v1 - v0); const float q0 = 1.0f / (1.0f + ex), q1 = ex / (1.0f + ex);
                    const int rk0 = e0 == 0 ? rc0 : e0 == 1 ? rc1 : e0 == 2 ? rc2 : e0 == 3 ? rc3 : e0 == 4 ? rc4 : e0 == 5 ? rc5 : e0 == 6 ? rc6 : rc7;
                    const int rk1 = e1 == 0 ? rc0 : e1 == 1 ? rc1 : e1 == 2 ? rc2 : e1 == 3 ? rc3 : e1 == 4 ? rc4 : e1 == 5 ? rc5 : e1 == 6 ? rc6 : rc7;
                    rc0 += (e0 == 0) + (e1 == 0); rc1 += (e0 == 1) + (e1 == 1); rc2 += (e0 == 2) + (e1 == 2); rc3 += (e0 == 3) + (e1 == 3);
                    rc4 += (e0 == 4) + (e1 == 4); rc5 += (e0 == 5) + (e1 == 5); rc6 += (e0 == 6) + (e1 == 6); rc7 += (e0 == 7) + (e1 == 7);
                    if (lane == 0) { P.tope[2 * r] = e0; P.tope[2 * r + 1] = e1; P.toppo[2 * r] = q0; P.toppo[2 * r + 1] = q1; P.rank[2 * r] = rk0; P.rank[2 * r + 1] = rk1; }
                }
            }
            if (!ROUTER && more) {
#pragma unroll
                for (int j = 0; j < 4; ++j) { v[j] = vn[j]; if (COMBINE) { ya[j] = yan[j]; yb[j] = ybn[j]; } }
                if (COMBINE) { p0 = p0n; p1 = p1n; }
            }
        }
        if (ROUTER && lane == 0) { int* c = P.cnt + F.gw * 8; c[0] = rc0; c[1] = rc1; c[2] = rc2; c[3] = rc3; c[4] = rc4; c[5] = rc5; c[6] = rc6; c[7] = rc7; }
    }
}

template <int NB, int NKS>
__device__ __forceinline__ void lm_load_a(const bf16_t* A, int lda, const int (&i0)[NB], int kc0, bf16x8 (&ap)[NB][NKS], int lane) {
    const int i16 = lane & 15, q = lane >> 4;
#pragma unroll
    for (int b = 0; b < NB; ++b)
#pragma unroll
        for (int ks = 0; ks < NKS; ++ks) ap[b][ks] = *(const bf16x8*)(A + (size_t)(i0[b] + i16) * lda + kc0 + ks * 32 + 8 * q);
}
template <int NB, int NKS>
__device__ __forceinline__ void lm_core(const bf16x8 (&ap)[NB][NKS], LAS unsigned char* X, f32x4 (&acc)[NB][8], int lane) {
    const int i16 = lane & 15, q = lane >> 4;
    const int xoff = (8 * q + (i16 >> 2)) * XRS + 8 * (i16 & 3);
#pragma unroll
    for (int ks = 0; ks < NKS; ++ks) {
#pragma unroll
        for (int nt = 0; nt < 8; ++nt) {
            const s16x4 lo = __builtin_amdgcn_ds_read_tr16_b64_v4i16((LAS s16x4*)(X + ks * 32 * XRS + xoff + nt * 32));
            const s16x4 hi = __builtin_amdgcn_ds_read_tr16_b64_v4i16((LAS s16x4*)(X + ks * 32 * XRS + xoff + nt * 32 + 4 * XRS));
            const bf16x8 xf = __builtin_shufflevector(lo, hi, 0, 1, 2, 3, 4, 5, 6, 7);
#pragma unroll
            for (int b = 0; b < NB; ++b) acc[b][nt] = __builtin_amdgcn_mfma_f32_16x16x32_bf16(xf, ap[b][ks], acc[b][nt], 0, 0, 0);
        }
    }
}
template <int NB> __device__ __forceinline__ void zero_acc(f32x4 (&acc)[NB][8]) {
#pragma unroll
    for (int b = 0; b < NB; ++b)
#pragma unroll
        for (int nt = 0; nt < 8; ++nt) acc[b][nt] = (f32x4){0.f, 0.f, 0.f, 0.f};
}
__device__ __forceinline__ void stage_rows(const bf16_t* src, size_t sstride, int nrows, LAS unsigned char* X, int xr0, int tid) {
    for (int i = tid; i < nrows * 16; i += 512) { const int r = i >> 4, ch = i & 15; *(LAS u32x4*)(X + (xr0 + r) * XRS + ch * 16) = *(const u32x4*)(src + (size_t)r * sstride + ch * 8); }
}

__device__ __forceinline__ void fft_stage_a(const Ctx& F, unsigned* wq) {
    const bf16_t* PZ = (const bf16_t*)(F.ws + WS_PZUV); bf16_t* UP = (bf16_t*)(F.ws + WS_UP); bf16_t* Y = (bf16_t*)(F.ws + WS_H);
    const bf16_t* FA = (const bf16_t*)(F.ws + WS_FA); const bf16_t* FX = (const bf16_t*)(F.ws + WS_FX);
    LAS unsigned char* X = F.lds; const int lane = F.lane, w = F.wave, i16 = lane & 15, q = lane >> 4;
    volatile LAS unsigned* slot = (volatile LAS unsigned*)(F.lds + MISC_OFF + 64);
    bf16x8 apA[2][8]; { const int i0[2] = {16 * w, 128 + 16 * w}; lm_load_a<2, 8>(FA, 256, i0, 0, apA, lane); }
    for (int it0 = F.bid; it0 < 1024 + 16; ) {
        const int it = it0 < 16 ? 1024 + it0 : it0 - 16;
        if (it < 1024) {
            const int t2 = it & 127, g = (it >> 7) & 3, b = it >> 9;
            const bf16_t* src = PZ + ((size_t)b * TL + t2) * NEIN + g * 128;
            stage_rows(src, (size_t)128 * NEIN, 128, X, 0, F.tid);
            stage_rows(src + 512, (size_t)128 * NEIN, 128, X, 128, F.tid);
            __syncthreads();
            f32x4 acc[2][8]; zero_acc<2>(acc);
            lm_core<2, 8>(apA, X, acc, lane);
            const int k1 = 16 * w + i16; float sw, cw; sincosf(6.283185307179586f * (float)((k1 * t2) & 16383) / 16384.0f, &sw, &cw);
            bf16_t* orow = UP + ((size_t)((b * 4 + g) * 128 + k1) * 128 + t2) * 256;
#pragma unroll
            for (int nt = 0; nt < 8; ++nt) { const f32x4 ur = acc[0][nt], ui = acc[1][nt]; const int n = 16 * nt + 4 * q;
                u32x2 wr_, wi_; wr_.x = pk2(ur[0] * cw - ui[0] * sw, ur[1] * cw - ui[1] * sw); wr_.y = pk2(ur[2] * cw - ui[2] * sw, ur[3] * cw - ui[3] * sw);
                wi_.x = pk2(ur[0] * sw + ui[0] * cw, ur[1] * sw + ui[1] * cw); wi_.y = pk2(ur[2] * sw + ui[2] * cw, ur[3] * sw + ui[3] * cw);
                *(u32x2*)(orow + n) = wr_; *(u32x2*)(orow + 128 + n) = wi_; }
            __syncthreads();
        } else {
            const int ci = it - 1024, kh = ci & 1, g = (ci >> 1) & 3, b = ci >> 3;
            f32x4 acc[1][8]; zero_acc<1>(acc); const int i0[1] = {128 * kh + 16 * w};
            for (int c = 0; c < 2; ++c) {
                bf16x8 apx[1][8]; lm_load_a<1, 8>(FX, 512, i0, c * 256, apx, lane);
                stage_rows(PZ + ((size_t)ML + b * TCX) * NEIN + c * 512 + g * 128, NEIN, 256, X, 0, F.tid);
                __syncthreads();
                lm_core<1, 8>(apx, X, acc, lane);
                __syncthreads();
            }
            const int k = 128 * kh + 16 * w + i16; bf16_t* orow = Y + ((size_t)ML + b * TCX + k) * D + g * 128; const float nrm = 0.005524271728019903f;
#pragma unroll
            for (int nt = 0; nt < 8; ++nt) { const f32x4 a = acc[0][nt] * nrm; u32x2 o; o.x = pk2(a[0], a[1]); o.y = pk2(a[2], a[3]); *(u32x2*)(orow + 16 * nt + 4 * q) = o; }
        }
        WQ_NEXT(it0, wq, slot, F.G);
    }
}
__device__ __forceinline__ void fft_stage_c_gmlp(const Ctx& F, int j, unsigned* wq) {
    const bf16_t* PZ = (const bf16_t*)(F.ws + WS_PZUV); const bf16_t* UP = (const bf16_t*)(F.ws + WS_UP); bf16_t* Y = (bf16_t*)(F.ws + WS_H);
    const bf16_t* FC = (const bf16_t*)(F.ws + WS_FC); const bf16_t* GW = (const bf16_t*)(F.ws + WS_GW) + (size_t)j * 4 * 128 * 128;
    const float* gb = F.in[I_GB] + j * 512;
    LAS unsigned char* X = F.lds; const int lane = F.lane, w = F.wave, i16 = lane & 15, q = lane >> 4, tid = F.tid;
    volatile LAS unsigned* slot = (volatile LAS unsigned*)(F.lds + MISC_OFF + 64);
    bf16x8 apC[1][8]; { const int i0[1] = {16 * w}; lm_load_a<1, 8>(FC, 256, i0, 0, apC, lane); }
    for (int it = F.bid; it < 1024 + 1040; ) {
        if (it < 1024) {
            const int k1 = it & 127, g = (it >> 7) & 3, b = it >> 9;
            const bf16_t* src = UP + (size_t)((b * 4 + g) * 128 + k1) * 128 * 256;
            stage_rows(src, 256, 128, X, 0, tid);
            stage_rows(src + 128, 256, 128, X, 128, tid);
            __syncthreads();
            f32x4 acc[1][8]; zero_acc<1>(acc);
            lm_core<1, 8>(apC, X, acc, lane);
            const int k2 = 16 * w + i16; bf16_t* orow = Y + ((size_t)b * TL + k1 + 128 * k2) * D + g * 128; const float nrm = 0.0006905339660024878f;
#pragma unroll
            for (int nt = 0; nt < 8; ++nt) { const f32x4 a = acc[0][nt] * nrm; u32x2 o; o.x = pk2(a[0], a[1]); o.y = pk2(a[2], a[3]); *(u32x2*)(orow + 16 * nt + 4 * q) = o; }
            __syncthreads();
        } else {
            const int gi = it - 1024, h = gi & 3, ck = gi >> 2; const size_t r0 = (size_t)ck * 128;
            bf16x8 apg[1][4]; { const int i0[1] = {16 * w}; lm_load_a<1, 4>(GW + (size_t)h * 128 * 128, 128, i0, 0, apg, lane); }
            for (int i = tid; i < 128 * 16; i += 512) { const int r = i >> 4, ch = i & 15; const u32x4 raw = *(const u32x4*)(PZ + (r0 + r) * NEIN + 1536 + h * 128 + ch * 8);
                float x[8] = {bflo(raw.x), bfhi(raw.x), bflo(raw.y), bfhi(raw.y), bflo(raw.z), bfhi(raw.z), bflo(raw.w), bfhi(raw.w)};
                float s = 0.f;
#pragma unroll
                for (int e = 0; e < 8; ++e) s += x[e];
                s += shfl_x(s, 1, lane); s += shfl_x(s, 2, lane); s += shfl_x(s, 4, lane); s += shfl_x(s, 8, lane);
                const float mean = s * (1.0f / 128.0f); float qq = 0.f;
#pragma unroll
                for (int e = 0; e < 8; ++e) { x[e] -= mean; qq += x[e] * x[e]; }
                qq += shfl_x(qq, 1, lane); qq += shfl_x(qq, 2, lane); qq += shfl_x(qq, 4, lane); qq += shfl_x(qq, 8, lane);
                const float rs = rsqrtf(qq * (1.0f / 128.0f) + EPS);
                u32x4 o; o.x = pk2(x[0] * rs, x[1] * rs); o.y = pk2(x[2] * rs, x[3] * rs); o.z = pk2(x[4] * rs, x[5] * rs); o.w = pk2(x[6] * rs, x[7] * rs);
                *(LAS u32x4*)(X + r * XRS + ch * 16) = o; }
            __syncthreads();
            f32x4 acc[1][8]; zero_acc<1>(acc);
            lm_core<1, 4>(apg, X, acc, lane);
            const int t = 16 * w + i16; const float bias = gb[h * 128 + t];
            const bf16_t* urow = PZ + (r0 + t) * NEIN + 1024 + h * 128; bf16_t* orow = Y + (r0 + t) * D + 512 + h * 128;
#pragma unroll
            for (int nt = 0; nt < 8; ++nt) { const int n = 16 * nt + 4 * q; const u32x2 uu = *(const u32x2*)(urow + n); const f32x4 a = acc[0][nt];
                u32x2 o; o.x = pk2(bflo(uu.x) * (a[0] + bias), bfhi(uu.x) * (a[1] + bias)); o.y = pk2(bflo(uu.y) * (a[2] + bias), bfhi(uu.y) * (a[3] + bias)); *(u32x2*)(orow + n) = o; }
            __syncthreads();
        }
        WQ_NEXT(it, wq, slot, F.G);
    }
}

constexpr int S2_KT = 0, S2_QT = 36864, S2_V = 73728, S2_SC = 110592, S2_EB = 120832, S2_EBL = 122880, S2_RED = 124928, S2_END = 129024;
static_assert(S2_END <= MISC_OFF, "scan LDS");
constexpr int SCRS = 80;
template <bool NEEDQ>
__device__ __forceinline__ void half_prep(const Ctx& F, const bf16_t* P5, size_t hrow, bool rev, int h, int dir) {
    const int tid = F.tid, ck = F.wave >> 1, dk = ((F.wave & 1) << 6) + F.lane; LAS unsigned char* L = F.lds;
#pragma unroll
    for (int it = 0; it < 4; ++it) { const int idx = tid + 512 * it, p = idx >> 4, ch = idx & 15; const size_t r = hrow + (rev ? 127 - p : p); const bf16_t* rp = P5 + r * NREC + h * 128 + ch * 8;
        *(LAS u32x4*)(L + S2_KT + p * XRS + ch * 16) = *(const u32x4*)(rp + 2048 + dir * 1024);
        if (NEEDQ) *(LAS u32x4*)(L + S2_QT + p * XRS + ch * 16) = *(const u32x4*)(rp);
        *(LAS u32x4*)(L + S2_V + p * XRS + ch * 16) = *(const u32x4*)(rp + 4096); }
    __syncthreads();
    float b = 0.f; LAS unsigned char* kt = L + S2_KT + (32 * ck) * XRS + dk * 2; LAS unsigned char* qt = L + S2_QT + (32 * ck) * XRS + dk * 2;
#pragma unroll 8
    for (int i = 0; i < 32; ++i) { const float lf = bf2f(*(const LAS bf16_t*)(kt + i * XRS)); b += lf;
        const float kk = (1.0f - __expf(lf)) * __expf(fminf(-b, 80.0f));
        *(LAS bf16_t*)(kt + i * XRS) = (bf16_t)f2bf(kk);
        if (NEEDQ) { const float qv = bf2f(*(const LAS bf16_t*)(qt + i * XRS)); *(LAS bf16_t*)(qt + i * XRS) = (bf16_t)f2bf(qv * __expf(b)); } }
    ((LAS float*)(L + S2_EB))[ck * 128 + dk] = __expf(b);
    ((LAS float*)(L + S2_EBL))[ck * 128 + dk] = b;
}
__device__ __forceinline__ void state_update(const Ctx& F, f32x4 (&st)[8], int ck) {
    LAS unsigned char* L = F.lds; const int lane = F.lane, i16 = lane & 15, q = lane >> 4, w = F.wave;
    const int roff = (32 * ck + 8 * q + (i16 >> 2)) * XRS + 8 * (i16 & 3);
    const s16x4 vlo = __builtin_amdgcn_ds_read_tr16_b64_v4i16((LAS s16x4*)(L + S2_V + roff + w * 32));
    const s16x4 vhi = __builtin_amdgcn_ds_read_tr16_b64_v4i16((LAS s16x4*)(L + S2_V + roff + w * 32 + 4 * XRS));
    const bf16x8 vf = __builtin_shufflevector(vlo, vhi, 0, 1, 2, 3, 4, 5, 6, 7);
#pragma unroll
    for (int kb = 0; kb < 8; ++kb) {
        const s16x4 klo = __builtin_amdgcn_ds_read_tr16_b64_v4i16((LAS s16x4*)(L + S2_KT + roff + kb * 32));
        const s16x4 khi = __builtin_amdgcn_ds_read_tr16_b64_v4i16((LAS s16x4*)(L + S2_KT + roff + kb * 32 + 4 * XRS));
        const bf16x8 kf = __builtin_shufflevector(klo, khi, 0, 1, 2, 3, 4, 5, 6, 7);
        st[kb] = __builtin_amdgcn_mfma_f32_16x16x32_bf16(kf, vf, st[kb], 0, 0, 0);
        const f32x4 eb = *(const LAS f32x4*)(L + S2_EB + (ck * 128 + 16 * kb + 4 * q) * 4);
        st[kb] = st[kb] * eb;
    }
}
__device__ __forceinline__ void state_load(const float* src, f32x4 (&st)[8], int w, int lane) {
#pragma unroll
    for (int kb = 0; kb < 8; ++kb)
#pragma unroll
        for (int rg = 0; rg < 4; ++rg) st[kb][rg] = src ? src[((w * 8 + kb) * 4 + rg) * 64 + lane] : 0.f;
}
__device__ __forceinline__ void state_store(float* dst, const f32x4 (&st)[8], int w, int lane) {
#pragma unroll
    for (int kb = 0; kb < 8; ++kb)
#pragma unroll
        for (int rg = 0; rg < 4; ++rg) dst[((w * 8 + kb) * 4 + rg) * 64 + lane] = st[kb][rg];
}
__device__ __forceinline__ void scan_pass1_item(const Ctx& F, const bf16_t* P5, int b, int h, int dir, int seg, float* SST, float* EG) {
    const int chain = (b * 8 + h) * 2 + dir; const size_t rowb = (size_t)b * TL + (size_t)seg * SEGL;
    f32x4 st[8]; state_load(nullptr, st, F.wave, F.lane);
    float gacc = 0.f;
    for (int hs = 0; hs < 2; ++hs) {
        const size_t hrow = rowb + 128 * (dir ? 1 - hs : hs);
        half_prep<false>(F, P5, hrow, dir != 0, h, dir);
        __syncthreads();
        if (F.tid < 128) { const LAS float* ebl = (const LAS float*)(F.lds + S2_EBL); gacc += (ebl[F.tid] + ebl[128 + F.tid]) + (ebl[256 + F.tid] + ebl[384 + F.tid]); }
#pragma unroll 1
        for (int ck = 0; ck < 4; ++ck) { state_update(F, st, ck); __builtin_amdgcn_sched_barrier(0); }
        __syncthreads();
    }
    state_store(SST + ((size_t)chain * NSEG + seg) * 16384, st, F.wave, F.lane);
    if (F.tid < 128) EG[((size_t)chain * NSEG + seg) * 128 + F.tid] = __expf(gacc);
}
__device__ __forceinline__ void half_scores(const Ctx& F) {
    LAS unsigned char* L = F.lds; const int lane = F.lane, i16 = lane & 15, q = lane >> 4, w = F.wave, ck = w >> 1, u = w & 1;
#pragma unroll
    for (int tt = 0; tt < 2; ++tt) {
        const int ti = u == 0 ? tt : 1 - tt, si = u == 0 ? tt : tt;
        f32x4 sc = (f32x4){0.f, 0.f, 0.f, 0.f};
        if (si <= ti) {
#pragma unroll
            for (int ks = 0; ks < 4; ++ks) { const bf16x8 a = *(const LAS bf16x8*)(L + S2_QT + (32 * ck + 16 * ti + i16) * XRS + (32 * ks + 8 * q) * 2); const bf16x8 bb = *(const LAS bf16x8*)(L + S2_KT + (32 * ck + 16 * si + i16) * XRS + (32 * ks + 8 * q) * 2);
                sc = __builtin_amdgcn_mfma_f32_16x16x32_bf16(a, bb, sc, 0, 0, 0); }
        }
#pragma unroll
        for (int rg = 0; rg < 4; ++rg) { const int t = 16 * ti + 4 * q + rg, sidx = 16 * si + i16; *(LAS bf16_t*)(L + S2_SC + (32 * ck + t) * SCRS + sidx * 2) = (bf16_t)f2bf(sidx <= t ? sc[rg] : 0.f); }
    }
}
__device__ __forceinline__ void chunk_out(const Ctx& F, const f32x4 (&st)[8], int ck, f32x4 (&o)[2]) {
    LAS unsigned char* L = F.lds; const int lane = F.lane, i16 = lane & 15, q = lane >> 4, w = F.wave;
    o[0] = (f32x4){0.f, 0.f, 0.f, 0.f}; o[1] = (f32x4){0.f, 0.f, 0.f, 0.f};
#pragma unroll
    for (int ks = 0; ks < 4; ++ks) {
        u32x4 sp; sp.x = pk2(st[2 * ks][0], st[2 * ks][1]); sp.y = pk2(st[2 * ks][2], st[2 * ks][3]); sp.z = pk2(st[2 * ks + 1][0], st[2 * ks + 1][1]); sp.w = pk2(st[2 * ks + 1][2], st[2 * ks + 1][3]);
        const bf16x8 sf = __builtin_bit_cast(bf16x8, sp);
#pragma unroll
        for (int ti = 0; ti < 2; ++ti) { const LAS unsigned char* qrow = L + S2_QT + (32 * ck + 16 * ti + i16) * XRS + (32 * ks + 4 * q) * 2;
            const u32x2 qlo = *(const LAS u32x2*)(qrow), qhi = *(const LAS u32x2*)(qrow + 32);
            u32x4 qp; qp.x = qlo.x; qp.y = qlo.y; qp.z = qhi.x; qp.w = qhi.y;
            o[ti] = __builtin_amdgcn_mfma_f32_16x16x32_bf16(sf, __builtin_bit_cast(bf16x8, qp), o[ti], 0, 0, 0); }
    }
    const int roff = (32 * ck + 8 * q + (i16 >> 2)) * XRS + 8 * (i16 & 3);
    const s16x4 vlo = __builtin_amdgcn_ds_read_tr16_b64_v4i16((LAS s16x4*)(L + S2_V + roff + w * 32));
    const s16x4 vhi = __builtin_amdgcn_ds_read_tr16_b64_v4i16((LAS s16x4*)(L + S2_V + roff + w * 32 + 4 * XRS));
    const bf16x8 vf = __builtin_shufflevector(vlo, vhi, 0, 1, 2, 3, 4, 5, 6, 7);
#pragma unroll
    for (int ti = 0; ti < 2; ++ti) { const bf16x8 pf = *(const LAS bf16x8*)(L + S2_SC + (32 * ck + 16 * ti + i16) * SCRS + (8 * q) * 2); o[ti] = __builtin_amdgcn_mfma_f32_16x16x32_bf16(vf, pf, o[ti], 0, 0, 0); }
}
__device__ __forceinline__ void scan_pass3_item(const Ctx& F, const bf16_t* P5, size_t rowb, int h, const float* sin_f, const float* sin_b, float* fin_f, float* fin_b, const float* gain, bf16_t* OFT, bf16_t* Y, bool writey) {
    LAS unsigned char* L = F.lds; const int lane = F.lane, i16 = lane & 15, q = lane >> 4, w = F.wave;
    const int colo = h * 128 + 16 * w + 4 * q;
    f32x4 st[8];
    state_load(sin_f, st, w, lane);
    for (int hs = 0; hs < 2; ++hs) {
        const size_t hrow = rowb + 128 * hs;
        half_prep<true>(F, P5, hrow, false, h, 0);
        __syncthreads();
        half_scores(F);
        __syncthreads();
#pragma unroll 1
        for (int ck = 0; ck < 4; ++ck) { f32x4 o[2]; chunk_out(F, st, ck, o);
#pragma unroll
            for (int ti = 0; ti < 2; ++ti) { const size_t r = hrow + 32 * ck + 16 * ti + i16; u32x2 pkd; pkd.x = pk2(o[ti][0], o[ti][1]); pkd.y = pk2(o[ti][2], o[ti][3]); *(u32x2*)(OFT + r * D + colo) = pkd; }
            __builtin_amdgcn_sched_barrier(0);
            state_update(F, st, ck);
            __builtin_amdgcn_sched_barrier(0); }
        __syncthreads();
    }
    if (fin_f) state_store(fin_f, st, w, lane);
    state_load(sin_b, st, w, lane);
    const f32x4 gv = *(const f32x4*)(gain + colo);
    for (int hs = 0; hs < 2; ++hs) {
        const size_t hrow = rowb + 128 * (1 - hs);
        half_prep<true>(F, P5, hrow, true, h, 1);
        __syncthreads();
        half_scores(F);
        __syncthreads();
        LAS float* RED = (LAS float*)(L + S2_RED);
        u32x2 fc[2];
#pragma unroll
        for (int ti = 0; ti < 2; ++ti) fc[ti] = *(const u32x2*)(OFT + (hrow + 127 - (16 * ti + i16)) * D + colo);
#pragma unroll 1
        for (int ck = 0; ck < 4; ++ck) { u32x2 fn[2];
            const int ckn = ck < 3 ? ck + 1 : 3;
#pragma unroll
            for (int ti = 0; ti < 2; ++ti) fn[ti] = *(const u32x2*)(OFT + (hrow + 127 - (32 * ckn + 16 * ti + i16)) * D + colo);
            f32x4 o[2]; chunk_out(F, st, ck, o);
#pragma unroll
            for (int ti = 0; ti < 2; ++ti) { const int p = 32 * ck + 16 * ti + i16; const size_t r = hrow + 127 - p; const u32x2 f = fc[ti];
                o[ti][0] += bflo(f.x); o[ti][1] += bfhi(f.x); o[ti][2] += bflo(f.y); o[ti][3] += bfhi(f.y);
                float ss = (o[ti][0] * o[ti][0] + o[ti][1] * o[ti][1]) + (o[ti][2] * o[ti][2] + o[ti][3] * o[ti][3]);
                ss += shfl_x(ss, 16, lane); ss += shfl_x(ss, 32, lane);
                if (q == 0) RED[w * 128 + p] = ss;
                u32x2 pkd; pkd.x = pk2(o[ti][0], o[ti][1]); pkd.y = pk2(o[ti][2], o[ti][3]); *(u32x2*)(OFT + r * D + colo) = pkd; }
            fc[0] = fn[0]; fc[1] = fn[1];
            __builtin_amdgcn_sched_barrier(0);
            state_update(F, st, ck);
            __builtin_amdgcn_sched_barrier(0); }
        __syncthreads();
        if (writey) {
#pragma unroll
            for (int ck = 0; ck < 4; ++ck)
#pragma unroll
                for (int ti = 0; ti < 2; ++ti) { const int p = 32 * ck + 16 * ti + i16; float tot = 0.f;
#pragma unroll
                    for (int ww = 0; ww < 8; ++ww) tot += RED[ww * 128 + p];
                    const float rs = rsqrtf(tot * (1.0f / 128.0f) + EPS); const size_t r = hrow + 127 - p;
                    const u32x2 f = *(const u32x2*)(OFT + r * D + colo); const u32x2 sg = *(const u32x2*)(P5 + r * NREC + 1024 + colo);
                    u32x2 y; y.x = pk2(bflo(f.x) * rs * gv[0] * bflo(sg.x), bfhi(f.x) * rs * gv[1] * bfhi(sg.x)); y.y = pk2(bflo(f.y) * rs * gv[2] * bflo(sg.y), bfhi(f.y) * rs * gv[3] * bfhi(sg.y));
                    *(u32x2*)(Y + r * D + colo) = y; }
        }
        __syncthreads();
    }
    if (fin_b) state_store(fin_b, st, w, lane);
}
__device__ __forceinline__ void scan_carry(const Ctx& F) {
    float* SST = (float*)(F.ws + WS_SST); const float* EG = (const float*)(F.ws + WS_EG); const float* S0 = (const float*)(F.ws + WS_S0);
    const int gt = F.bid * 512 + F.tid, NGT = F.G * 512;
    for (int idx = gt; idx < NCHAIN * 16384; idx += NGT) {
        const int chain = idx >> 14, e = idx & 16383, dir = chain & 1;
        const int lanee = e & 63, rg = (e >> 6) & 3, kb = (e >> 8) & 7; const int dk = 16 * kb + 4 * (lanee >> 4) + rg;
        float cur = S0[(size_t)chain * 16384 + e];
        float* base = SST + (size_t)chain * NSEG * 16384 + e; const float* eg = EG + (size_t)chain * NSEG * 128 + dk;
        for (int s0 = 0; s0 < NSEG; s0 += 8) {
            float tmp[8], gg[8];
#pragma unroll
            for (int i = 0; i < 8; ++i) { const int seg = dir ? NSEG - 1 - (s0 + i) : s0 + i; tmp[i] = base[(size_t)seg * 16384]; gg[i] = eg[seg * 128]; }
#pragma unroll
            for (int i = 0; i < 8; ++i) { const int seg = dir ? NSEG - 1 - (s0 + i) : s0 + i; base[(size_t)seg * 16384] = cur; cur = gg[i] * cur + tmp[i]; }
        }
    }
}

__device__ __forceinline__ void moe_slots(const Ctx& F, int nrows) {
    const int tid = F.tid; const int nitems = F.NGW;
    const RowPart rp = row_part(F.NGW, nrows);
    const int* cnt = (const int*)(F.ws + WS_CNT); const int* tope = (const int*)(F.ws + WS_TOPE); const int* rank = (const int*)(F.ws + WS_RANK);
    int* slotrow = (int*)(F.ws + WS_SLOTROW); int* slotdst = (int*)(F.ws + WS_SLOTDST); int* tilex = (int*)(F.ws + WS_TILEX); int* slotof = (int*)(F.ws + WS_SLOTOF);
    LAS int* pre = (LAS int*)F.lds;
    LAS int* tsum = (LAS int*)(F.lds + 69632);
    LAS int* ebase = (LAS int*)(F.lds + 69632 + 16384);
    const int IPT = (nitems + 511) / 512;
    int loc[8] = {0, 0, 0, 0, 0, 0, 0, 0};
    for (int i = 0; i < IPT; ++i) { const int it = tid * IPT + i; if (it < nitems) {
#pragma unroll
        for (int e = 0; e < 8; ++e) loc[e] += cnt[it * 8 + e]; } }
#pragma unroll
    for (int e = 0; e < 8; ++e) tsum[tid * 8 + e] = loc[e];
    __syncthreads();
    if (tid < 8) { int run = 0; for (int t = 0; t < 512; ++t) { const int v = tsum[t * 8 + tid]; tsum[t * 8 + tid] = run; run += v; } ebase[8 + tid] = run; }
    __syncthreads();
    if (tid == 0) { int b = 0; for (int e = 0; e < 8; ++e) { ebase[e] = b; b += (ebase[8 + e] + 255) & ~255; } ebase[16] = b / 256; }
    { int run[8];
#pragma unroll
      for (int e = 0; e < 8; ++e) run[e] = tsum[tid * 8 + e];
      for (int i = 0; i < IPT; ++i) { const int it = tid * IPT + i; if (it < nitems) {
#pragma unroll
          for (int e = 0; e < 8; ++e) { pre[it * 8 + e] = run[e]; run[e] += cnt[it * 8 + e]; } } } }
    __syncthreads();
    for (int r = F.bid * 512 + tid; r < nrows; r += F.G * 512) {
        const int ch = row_chunk_of(rp, r);
#pragma unroll
        for (int kk = 0; kk < 2; ++kk) { const int e = tope[2 * r + kk]; const int slot = ebase[e] + pre[ch * 8 + e] + rank[2 * r + kk]; slotrow[slot] = r; slotdst[slot] = 2 * r + kk; slotof[2 * r + kk] = slot; }
    }
    if (F.bid == 0) {
        const int ntiles = ebase[16];
        if (tid == 0) tilex[0] = ntiles;
        for (int e = 0; e < 8; ++e) { const int b0 = ebase[e], tot = ebase[8 + e], pad = (tot + 255) & ~255;
            for (int s = b0 + tot + tid; s < b0 + pad; s += 512) { slotrow[s] = 0; slotdst[s] = -1; }
            for (int t = b0 / 256 + tid; t < (b0 + pad) / 256; t += 512) tilex[16 + t] = e; }
    }
}

__global__ void __launch_bounds__(512, 2) fwd_kernel(Args args) {
    extern __shared__ __attribute__((aligned(16))) unsigned char lds_raw[];
    Ctx F;
    F.lds = (LAS unsigned char*)lds_raw; F.tid = threadIdx.x; F.lane = F.tid & 63; F.wave = __builtin_amdgcn_readfirstlane(F.tid >> 6);
    F.G = gridDim.x; F.bid = blockIdx.x; F.gw = F.bid * 8 + F.wave; F.NGW = F.G * 8;
    F.in = args.in; F.out = args.out; F.ws = args.ws;
    volatile LAS unsigned* MISC = (volatile LAS unsigned*)(F.lds + MISC_OFF);
    if (F.tid < 64) MISC[F.tid] = 0u;
    __syncthreads();
    const int lo = args.ph_lo, hi = args.ph_hi;
    XcdBarrier bar; bar.bar = (unsigned*)(F.ws + WS_CTL) + 4096; bar.x = 0; bar.st = nullptr;
    const bool multi = (hi - lo) > 1;
    if (multi) bar = xcd_barrier_post((unsigned*)(F.ws + WS_CTL) + 4096, MISC + 8);
#define IN(k) (lo <= (k) && (k) < hi)
#define SEAM(k) do { if (IN(k) && IN((k) + 1)) xcd_barrier(bar); asm volatile("" : "+v"(F.tid), "+s"(F.ws), "+s"(F.out), "+s"(F.G)); F.NGW = F.G * 8; F.lane = F.tid & 63; F.wave = __builtin_amdgcn_readfirstlane(F.tid >> 6); F.gw = F.bid * 8 + F.wave; } while (0)

#define MODS_ ((float*)(F.ws + WS_MODS))
#define XC_ ((float*)(F.ws + WS_XC))
#define H_ ((bf16_t*)(F.ws + WS_H))
#define YE_ ((bf16_t*)(F.ws + WS_YE))

    if (IN(PH_P0)) for (int rep_ = 0; rep_ < NREP(18); ++rep_) { p0_prologue(F); }
    SEAM(PH_P0);

#if defined(PROBE_GEMM)
    if (IN(PH_P0)) {
        pg8::Gemm g{H_, (const bf16_t*)(F.ws + WS_WINE), ML, NEIN, D, nullptr, nullptr, 0}; pg8::StaticOrder S; S.init(ML, NEIN, D, F.G, F.bid);
#if PROBE_GEMM == 1
        pg8::EpiEvenIn E{(bf16_t*)(F.ws + WS_UP)}; pg8::gemm_phase<pg8::EpiEvenIn, pg8::StaticOrder, true, false>(F.lds, g, S, E, F.tid);
#elif PROBE_GEMM == 2
        pg8::EpiNull E{(float*)(F.ws + WS_UP)}; pg8::gemm_phase<pg8::EpiNull, pg8::StaticOrder, true, false>(F.lds, g, S, E, F.tid);
#endif
        xcd_barrier(bar);
    }
#endif

    for (int lp = 0; lp < 2; ++lp) {
        const int pb = PH_PAIR0 + lp * NPL;
        const int le = 2 * lp, lo_ = 2 * lp + 1;
        const float* modE = MODS_ + (size_t)le * 3 * 6144; const float* modO = MODS_ + (size_t)lo_ * 3 * 6144;
        const float* xsl = lp == 0 ? F.in[I_X] : F.out; const float* xsc = lp == 0 ? F.in[I_CTX] : XC_;
        if (IN(pb + E1_NORM)) for (int rep_ = 0; rep_ < NREP(E1_NORM); ++rep_) {
            RowPass P{}; P.sl = xsl; P.sc = xsc; P.dl = F.out; P.dc = XC_; P.gain = F.in[I_NMIX] + le * D; P.shift = modE + 0 * D; P.scale = modE + 1 * D; P.H = H_; P.nrows = MT;
            if (lp == 0) row_pass<false, false, false>(F, P);
            else { P.YE = YE_; P.topp = (const float*)(F.ws + WS_TOPP); P.gatef = MODS_ + (size_t)(le - 1) * 3 * 6144 + 5 * D; P.slotof = (const int*)(F.ws + WS_SLOTOF); P.partm = (const float*)(F.ws + WS_PARTM); row_pass<true, false, false>(F, P); }
        }
        SEAM(pb + E1_NORM);
        if (IN(pb + E2_GIN)) for (int rep_ = 0; rep_ < NREP(E2_GIN); ++rep_) {
            pg8::Gemm g{H_, (const bf16_t*)(F.ws + WS_WINE) + (size_t)lp * NEIN * D, MT, NEIN, D, nullptr, nullptr, 0}; pg8::StaticOrder S; S.init(MT, NEIN, D, F.G, F.bid);
            pg8::EpiEvenIn E{(bf16_t*)(F.ws + WS_PZUV)};
            pg8::gemm_phase<pg8::EpiEvenIn, pg8::StaticOrder, true, false>(F.lds, g, S, E, F.tid);
        }
        SEAM(pb + E2_GIN);
        if (IN(pb + E3_FFTA)) for (int rep_ = 0; rep_ < NREP(E3_FFTA); ++rep_) fft_stage_a(F, (unsigned*)(F.ws + WS_CTL) + 8192 + 64 * (pb + E3_FFTA));
        SEAM(pb + E3_FFTA);
        if (IN(pb + E3_FFTC)) for (int rep_ = 0; rep_ < NREP(E3_FFTC); ++rep_) fft_stage_c_gmlp(F, lp, (unsigned*)(F.ws + WS_CTL) + 8192 + 64 * (pb + E3_FFTC));
        SEAM(pb + E3_FFTC);
        if (IN(pb + E4_GOUT)) for (int rep_ = 0; rep_ < NREP(E4_GOUT); ++rep_) {
            pg8::Gemm g{H_, (const bf16_t*)(F.ws + WS_WOUTE) + (size_t)lp * D * D, MT, D, D, nullptr, nullptr, 0}; pg8::ResOrder S; S.init(D, F.G, F.bid, true);
            pg8::EpiRes E{lp == 0 ? xsl : (const float*)F.out, F.out, modE + 2 * D, (float*)(F.ws + WS_PARTC)};
            pg8::gemm_phase<pg8::EpiRes, pg8::ResOrder, false, false>(F.lds, g, S, E, F.tid);
        }
        SEAM(pb + E4_GOUT);
        if (IN(pb + E5_NORM)) for (int rep_ = 0; rep_ < NREP(E5_NORM); ++rep_) {
            RowPass P{}; P.sl = F.out; P.sc = lp == 0 ? xsc : (const float*)XC_; P.dc = XC_; P.gain = F.in[I_NFFN] + le * D; P.shift = modE + 3 * D; P.scale = modE + 4 * D; P.H = H_; P.nrows = MT;
            P.part = (const float*)(F.ws + WS_PARTC); P.kpn = 4; P.pgate = modE + 2 * D;
            row_pass<false, false, false>(F, P);
        }
        SEAM(pb + E5_NORM);
        if (IN(pb + E6_UP)) for (int rep_ = 0; rep_ < NREP(E6_UP); ++rep_) {
            pg8::Gemm g{H_, (const bf16_t*)(F.ws + WS_W13) + (size_t)lp * NFF2 * D, MT, NFF2, D, nullptr, nullptr, 0}; pg8::StaticOrder S; S.init(MT, NFF2, D, F.G, F.bid);
            pg8::EpiSwiglu E{(bf16_t*)(F.ws + WS_HID), DFF};
            pg8::gemm_phase<pg8::EpiSwiglu, pg8::StaticOrder, true, false>(F.lds, g, S, E, F.tid);
        }
        SEAM(pb + E6_UP);
        if (IN(pb + E7_DOWN)) for (int rep_ = 0; rep_ < NREP(E7_DOWN); ++rep_) {
            pg8::Gemm g{(const bf16_t*)(F.ws + WS_HID), (const bf16_t*)(F.ws + WS_W2) + (size_t)lp * D * DFF, MT, D, DFF, nullptr, nullptr, 0}; pg8::ResOrder S; S.init(DFF, F.G, F.bid, true);
            pg8::EpiRes E{F.out, F.out, modE + 5 * D, (float*)(F.ws + WS_PARTC)};
            pg8::gemm_phase<pg8::EpiRes, pg8::ResOrder, false, false>(F.lds, g, S, E, F.tid);
        }
        SEAM(pb + E7_DOWN);
        const bool lastl = lp == 1;
        if (IN(pb + O1_NORM)) for (int rep_ = 0; rep_ < NREP(O1_NORM); ++rep_) {
            RowPass P{}; P.sl = F.out; P.sc = XC_; P.dc = XC_; P.gain = F.in[I_NMIX] + lo_ * D; P.shift = modO + 0 * D; P.scale = modO + 1 * D; P.H = H_; P.nrows = MT;
            P.part = (const float*)(F.ws + WS_PARTC); P.kpn = 11; P.pgate = modE + 5 * D;
            row_pass<false, false, false>(F, P);
        }
        SEAM(pb + O1_NORM);
        if (IN(pb + O2_GIN)) for (int rep_ = 0; rep_ < NREP(O2_GIN); ++rep_) {
            pg8::Gemm g{H_, (const bf16_t*)(F.ws + WS_WINO) + (size_t)lp * NREC * D, MT, NREC, D, nullptr, nullptr, 0}; pg8::StaticOrder S; S.init(MT, NREC, D, F.G, F.bid);
            pg8::EpiOddIn E{(bf16_t*)(F.ws + WS_P5), (const float*)(F.ws + WS_LB) + lp * 2048};
            pg8::gemm_phase<pg8::EpiOddIn, pg8::StaticOrder, true, false>(F.lds, g, S, E, F.tid);
        }
        SEAM(pb + O2_GIN);
        if (IN(pb + O3_SCAN1)) for (int rep_ = 0; rep_ < NREP(O3_SCAN1); ++rep_) {
            const bf16_t* P5 = (const bf16_t*)(F.ws + WS_P5); float* SST = (float*)(F.ws + WS_SST); float* EG = (float*)(F.ws + WS_EG); float* S0 = (float*)(F.ws + WS_S0);
            const float* gain = F.in[I_RNORM] + lp * D;
            unsigned* wq = (unsigned*)(F.ws + WS_CTL) + 8192 + 64 * (pb + O3_SCAN1); volatile LAS unsigned* slot = (volatile LAS unsigned*)(F.lds + MISC_OFF + 64);
            for (int it = F.bid; it < 16 + 2048; ) {
                if (it < 16) { const int b = it >> 3, h = it & 7;
                    scan_pass3_item(F, P5, (size_t)ML + b * TCX, h, nullptr, nullptr, S0 + (size_t)((b * 8 + h) * 2 + 0) * 16384, S0 + (size_t)((b * 8 + h) * 2 + 1) * 16384, gain, YE_, H_, !lastl);
                } else { const int i2 = it - 16, seg = i2 & 63, dir = (i2 >> 6) & 1, h = (i2 >> 7) & 7, b = i2 >> 10;
                    scan_pass1_item(F, P5, b, h, dir, seg, SST, EG); }
                WQ_NEXT(it, wq, slot, F.G);
            }
        }
        SEAM(pb + O3_SCAN1);
        if (IN(pb + O4_CARRY)) for (int rep_ = 0; rep_ < NREP(O4_CARRY); ++rep_) { scan_carry(F); for (int rep2_ = 0; rep2_ < NREP(19); ++rep2_) moe_convert(F, lp); }
        SEAM(pb + O4_CARRY);
        if (IN(pb + O5_SCAN3)) for (int rep_ = 0; rep_ < NREP(O5_SCAN3); ++rep_) {
            const bf16_t* P5 = (const bf16_t*)(F.ws + WS_P5); const float* SST = (const float*)(F.ws + WS_SST);
            const float* gain = F.in[I_RNORM] + lp * D;
            for (int it = F.bid; it < 1024; it += F.G) { const int seg = it & 63, h = (it >> 6) & 7, b = it >> 9; const int ch0 = (b * 8 + h) * 2;
                scan_pass3_item(F, P5, (size_t)b * TL + (size_t)seg * SEGL, h, SST + ((size_t)ch0 * NSEG + seg) * 16384, SST + ((size_t)(ch0 + 1) * NSEG + seg) * 16384, nullptr, nullptr, gain, YE_, H_, true); }
        }
        SEAM(pb + O5_SCAN3);
        if (IN(pb + O6_GOUT)) for (int rep_ = 0; rep_ < NREP(O6_GOUT); ++rep_) {
            pg8::Gemm g{H_, (const bf16_t*)(F.ws + WS_WOUTO) + (size_t)lp * D * D, MT, D, D, nullptr, nullptr, 0}; pg8::ResOrder S; S.init(D, F.G, F.bid, !lastl);
            pg8::EpiRes E{F.out, F.out, modO + 2 * D, (float*)(F.ws + WS_PARTC)};
            pg8::gemm_phase<pg8::EpiRes, pg8::ResOrder, false, false>(F.lds, g, S, E, F.tid);
        }
        SEAM(pb + O6_GOUT);
        const int nrm = lastl ? ML : MT;
        if (IN(pb + O7_NORM)) for (int rep_ = 0; rep_ < NREP(O7_NORM); ++rep_) {
            RowPass P{}; P.sl = F.out; P.sc = XC_; P.gain = F.in[I_NFFN] + lo_ * D; P.shift = modO + 3 * D; P.scale = modO + 4 * D; P.H = H_; P.nrows = nrm;
            P.dc = XC_; P.part = lastl ? nullptr : (const float*)(F.ws + WS_PARTC); P.kpn = 4; P.pgate = modO + 2 * D;
            P.rw = F.in[I_RW] + (size_t)lp * D * NE; P.tope = (int*)(F.ws + WS_TOPE); P.toppo = (float*)(F.ws + WS_TOPP); P.rank = (int*)(F.ws + WS_RANK); P.cnt = (int*)(F.ws + WS_CNT);
            row_pass<false, true, false>(F, P);
        }
        SEAM(pb + O7_NORM);
        if (IN(pb + O8_SLOTS)) for (int rep_ = 0; rep_ < NREP(O8_SLOTS); ++rep_) moe_slots(F, nrm);
        SEAM(pb + O8_SLOTS);
        if (IN(pb + O9_MUP)) for (int rep_ = 0; rep_ < NREP(O9_MUP); ++rep_) {
            const int* tilex = (const int*)(F.ws + WS_TILEX); const int ntiles = tilex[0];
            pg8::Gemm g{H_, (const bf16_t*)(F.ws + WS_W13M), ntiles * 256, NEX2, D, (const int*)(F.ws + WS_SLOTROW), tilex + 16, (size_t)NEX2 * D}; pg8::StaticOrder S; S.init(ntiles * 256, NEX2, D, F.G, F.bid);
            pg8::EpiSwiglu E{(bf16_t*)(F.ws + WS_HIDM), DEX};
            pg8::gemm_phase<pg8::EpiSwiglu, pg8::StaticOrder, true, true>(F.lds, g, S, E, F.tid);
        }
        SEAM(pb + O9_MUP);
        if (IN(pb + O10_MDOWN)) for (int rep_ = 0; rep_ < NREP(O10_MDOWN); ++rep_) {
            const int* tilex = (const int*)(F.ws + WS_TILEX); const int ntiles = tilex[0];
            pg8::Gemm g{(const bf16_t*)(F.ws + WS_HIDM), (const bf16_t*)(F.ws + WS_W2M), ntiles * 256, D, DEX, nullptr, tilex + 16, (size_t)D * DEX}; pg8::MoeDownOrder S; S.init(ntiles, F.G, F.bid);
            pg8::EpiMoeDown E{YE_, (const int*)(F.ws + WS_SLOTDST), (float*)(F.ws + WS_PARTM)};
            pg8::gemm_phase<pg8::EpiMoeDown, pg8::MoeDownOrder, true, false>(F.lds, g, S, E, F.tid);
        }
        SEAM(pb + O10_MDOWN);
    }
    if (IN(PH_FINAL)) {
        RowPass P{}; P.sl = F.out; P.sc = XC_; P.dl = F.out; P.dc = XC_; P.gain = F.in[I_NOUT]; P.nrows = ML; P.YE = YE_; P.topp = (const float*)(F.ws + WS_TOPP); P.gatef = MODS_ + (size_t)3 * 3 * 6144 + 5 * D; P.fout = F.out; P.slotof = (const int*)(F.ws + WS_SLOTOF); P.partm = (const float*)(F.ws + WS_PARTM);
        row_pass<true, false, true>(F, P);
    }
#undef IN
#undef SEAM
#undef MODS_
#undef XC_
#undef H_
#undef YE_
}

extern "C" void kernel_launch(void* const* d_in, const int* in_sizes, int n_in, void* d_out, int out_size, void* d_ws, size_t ws_size, hipStream_t stream) {
    static int grid = 0;
    if (grid == 0) {
        if (n_in != 24 || out_size != ML * D || ws_size < WS_END) { fprintf(stderr, "kernel_launch: unexpected problem (n_in %d, out %d, ws %zu < %zu)\n", n_in, out_size, ws_size, (size_t)WS_END); grid = -1; return; }
        int dev = 0, cus = 0, per_cu = 0;
        if (hipGetDevice(&dev) != hipSuccess || hipDeviceGetAttribute(&cus, hipDeviceAttributeMultiprocessorCount, dev) != hipSuccess) { grid = -1; return; }
        if (hipFuncSetAttribute((const void*)fwd_kernel, hipFuncAttributeMaxDynamicSharedMemorySize, LDS_BYTES) != hipSuccess) { fprintf(stderr, "kernel_launch: hipFuncSetAttribute failed\n"); grid = -1; return; }
        if (hipOccupancyMaxActiveBlocksPerMultiprocessor(&per_cu, (const void*)fwd_kernel, 512, LDS_BYTES) != hipSuccess || per_cu < 1) fprintf(stderr, "kernel_launch: occupancy query says %d\n", per_cu);
        (void)hipGetLastError();
        grid = cus;
    }
    if (grid < 0) return;
    (void)hipMemsetAsync((char*)d_ws + WS_CTL, 0, CTL_BYTES, stream);
    Args a{};
    for (int i = 0; i < 24; ++i) a.in[i] = (const float*)d_in[i];
    a.out = (float*)d_out; a.ws = (unsigned char*)d_ws;
#if PER_PHASE_LAUNCH
    for (int p = 0; p < NPHASE && p < PHASE_LIMIT; ++p) { a.ph_lo = p; a.ph_hi = p + 1; hipLaunchKernelGGL(fwd_kernel, dim3(grid), dim3(512), LDS_BYTES, stream, a); }
#else
    a.ph_lo = 0; a.ph_hi = NPHASE; hipLaunchKernelGGL(fwd_kernel, dim3(grid), dim3(512), LDS_BYTES, stream, a);
#endif
}
```

```cpp
#include <hip/hip_runtime.h>
#include <cstdio>
#include <cstdint>

#ifndef PER_PHASE_LAUNCH
#define PER_PHASE_LAUNCH 0
#endif
#ifndef CTX_KP
#define CTX_KP 4
#endif
#ifndef REP_MASK
#define REP_MASK 0
#endif
#define NREP(x) (((REP_MASK >> (x)) & 1) ? 2 : 1)
#ifndef PHASE_LIMIT
#define PHASE_LIMIT 100
#endif
#ifndef P0_MASK
#define P0_MASK 63
#endif
#ifndef P0_T
#define P0_T 127
#endif

#define LAS __attribute__((address_space(3)))
typedef unsigned short bf16_t;
typedef short bf16x8 __attribute__((ext_vector_type(8)));
typedef short s16x4 __attribute__((ext_vector_type(4)));
typedef float f32x4 __attribute__((ext_vector_type(4)));
typedef float f32x2 __attribute__((ext_vector_type(2)));
typedef unsigned u32x4 __attribute__((ext_vector_type(4)));
typedef unsigned u32x2 __attribute__((ext_vector_type(2)));

constexpr int D = 1024, TL = 16384, ML = 32768, TCX = 256, MC = 512, MT = 33280;
constexpr int NEIN = 2048, DFF = 2816, NFF2 = 5632, NREC = 5120, DEX = 3584, NEX2 = 7168, NE = 8;
constexpr int NSEG = 64, SEGL = 256, CH = 32, NCHAIN = 32;
constexpr int MAXTILES = 268, NITEM16 = MT / 16;
constexpr float EPS = 1e-6f;

constexpr size_t MiB = 1u << 20, KiB = 1u << 10;
constexpr size_t WS_CTL = 0, CTL_BYTES = 1 * MiB;
constexpr size_t WS_MODS = 1 * MiB, WS_LB = 1 * MiB + 512 * KiB;
constexpr size_t WS_FA = 2 * MiB, WS_FC = 2 * MiB + 128 * KiB, WS_FX = 2 * MiB + 256 * KiB, WS_GW = 2 * MiB + 512 * KiB;
constexpr size_t WS_XC = 3 * MiB;
constexpr size_t WS_TOPE = 5 * MiB, WS_TOPP = 5 * MiB + 512 * KiB, WS_RANK = 6 * MiB, WS_CNT = 6 * MiB + 512 * KiB, WS_TILEX = 6 * MiB + 768 * KiB, WS_SLOTROW = 7 * MiB, WS_SLOTDST = 7 * MiB + 512 * KiB;
constexpr size_t WS_WINE = 8 * MiB, WS_WOUTE = 16 * MiB, WS_WINO = 20 * MiB, WS_WOUTO = 40 * MiB, WS_W13 = 44 * MiB, WS_W2 = 66 * MiB;
constexpr size_t WS_W13M = 80 * MiB, WS_W2M = 192 * MiB;
constexpr size_t WS_H = 248 * MiB, WS_YE = 314 * MiB, WS_BIG = 444 * MiB;
constexpr size_t WS_PZUV = WS_BIG, WS_UP = WS_BIG + 130 * MiB, WS_HID = WS_BIG, WS_P5 = WS_BIG, WS_SST = WS_BIG + 325 * MiB, WS_EG = WS_BIG + 453 * MiB, WS_S0 = WS_BIG + 454 * MiB, WS_HIDM = WS_BIG;
constexpr size_t WS_PARTC = WS_BIG + 469 * MiB, WS_PARTM = WS_PARTC + 24 * MiB;
constexpr size_t WS_SLOTOF = 1 * MiB + 576 * KiB;
constexpr size_t WS_END = WS_PARTM + 48 * MiB;
static_assert(WS_W2 + (size_t)2 * D * DFF * 2 <= WS_W13M, "static weights");
static_assert(WS_W2M + (size_t)NE * D * DEX * 2 <= WS_H && WS_H + (size_t)MT * D * 2 <= WS_YE && WS_YE + (size_t)MT * 2 * D * 2 <= WS_BIG, "ws map");
static_assert((size_t)MAXTILES * 256 * DEX * 2 <= 469 * MiB && (size_t)MT * NREC * 2 <= 325 * MiB && (size_t)MT * NEIN * 2 <= 130 * MiB, "big region");

constexpr int LDS_BYTES = 147456, MISC_OFF = 147456 - 256;
constexpr int XRS = 288;

typedef __bf16 bf16x2_t __attribute__((ext_vector_type(2)));
__device__ __forceinline__ unsigned f2bf(float f) { return (unsigned)__builtin_bit_cast(unsigned short, (__bf16)f); }
__device__ __forceinline__ unsigned pk2(float lo, float hi) { return __builtin_bit_cast(unsigned, __builtin_convertvector((f32x2){lo, hi}, bf16x2_t)); }
__device__ __forceinline__ float bf2f(unsigned short b) { return __builtin_bit_cast(float, (unsigned)b << 16); }
__device__ __forceinline__ float bflo(unsigned w) { return __builtin_bit_cast(float, w << 16); }
__device__ __forceinline__ float bfhi(unsigned w) { return __builtin_bit_cast(float, w & 0xffff0000u); }
__device__ __forceinline__ float shfl_x(float v, int o, int lane) { return __builtin_bit_cast(float, __builtin_amdgcn_ds_bpermute((lane ^ o) << 2, __builtin_bit_cast(int, v))); }
__device__ __forceinline__ float wave_sum(float v, int lane) {
#pragma unroll
    for (int o = 1; o < 64; o <<= 1) v += shfl_x(v, o, lane);
    return v;
}
__device__ __forceinline__ float siluf(float a) { return a * __builtin_amdgcn_rcpf(1.0f + __expf(-a)); }
#define WQ_NEXT(it, ctr, slot, G) do { __syncthreads(); if (threadIdx.x == 0) *(slot) = (unsigned)(G) + __hip_atomic_fetch_add((ctr), 1u, __ATOMIC_RELAXED, __HIP_MEMORY_SCOPE_AGENT); __syncthreads(); (it) = (int)*(slot); } while (0)
#define LDS_WAIT() asm volatile("s_waitcnt lgkmcnt(0)" ::: "memory")
#define VM_WAIT() asm volatile("s_waitcnt vmcnt(0)" ::: "memory")

#define XB_TMO      128
#define XB_XCNT(j)  (256  + 64 * (j))
#define XB_XSUB(j)  (1280 + 64 * (j))
#define XB_XGEN(j)  (2304 + 64 * (j))
#define XB_TOP      3328
#define XB_TOPGEN   3392
#define XCD_BAR_WORDS 3456
#define XB_SPIN_CAP (1u << 18)
__device__ __forceinline__ unsigned xb_ld(unsigned* p)              { return __hip_atomic_load(p, __ATOMIC_RELAXED, __HIP_MEMORY_SCOPE_AGENT); }
__device__ __forceinline__ unsigned xb_add(unsigned* p, unsigned v) { return __hip_atomic_fetch_add(p, v, __ATOMIC_RELAXED, __HIP_MEMORY_SCOPE_AGENT); }
__device__ __forceinline__ unsigned xb_xcc_id() { return (unsigned)__builtin_amdgcn_s_getreg((3 << 11) | 20) & 0xFu; }
#define XB_SPIN(cond, bar) do { unsigned _sp = 0; while (cond) { __builtin_amdgcn_s_sleep(1); \
    if ((++_sp & 255u) == 0u) { if (xb_ld(&(bar)[XB_TMO])) break; if (_sp > XB_SPIN_CAP) { atomicAdd(&(bar)[XB_TMO], 1u); break; } } } } while (0)
struct XcdBarrier { unsigned* bar; unsigned x; volatile LAS unsigned* st; };
__device__ __forceinline__ XcdBarrier xcd_barrier_post(unsigned* bar, volatile LAS unsigned* st) {
    XcdBarrier b; b.bar = bar; b.x = xb_xcc_id(); b.st = st;
    if (threadIdx.x == 0) (void)xb_add(&bar[XB_XCNT(b.x)], 1u);
    return b;
}
__device__ __forceinline__ void xcd_barrier_complete(unsigned* bar, unsigned x, unsigned& nloc, unsigned& nx) {
    const unsigned G = gridDim.x * gridDim.y * gridDim.z;
    unsigned sum, cnt, mine, sp = 0u;
    for (;;) {
        sum = 0u; cnt = 0u; mine = 0u;
#pragma unroll
        for (unsigned j = 0; j < 16; ++j) { const unsigned c = xb_ld(&bar[XB_XCNT(j)]); sum += c; cnt += (c > 0u) ? 1u : 0u; mine = (j == x) ? c : mine; }
        if (sum == G) break;
        __builtin_amdgcn_s_sleep(1);
        if ((++sp & 255u) == 0u) { if (xb_ld(&bar[XB_TMO])) break; if (sp > XB_SPIN_CAP) { atomicAdd(&bar[XB_TMO], 1u); break; } }
    }
    nloc = mine > 0u ? mine : 1u; nx = cnt > 0u ? cnt : 1u;
}
__device__ __forceinline__ void xcd_barrier(const XcdBarrier& b) {
    asm volatile("s_waitcnt vmcnt(0)" ::: "memory");
    __syncthreads();
    if (threadIdx.x == 0) {
        unsigned* bar = b.bar;
        __builtin_amdgcn_s_waitcnt(0);
        unsigned nloc = b.st[0], nx = b.st[1];
        if (nloc == 0u) { xcd_barrier_complete(bar, b.x, nloc, nx); b.st[0] = nloc; b.st[1] = nx; }
        const unsigned old = xb_add(&bar[XB_XSUB(b.x)], 1u);
        const unsigned gen = old / nloc;
        if (old + 1u == (gen + 1u) * nloc) {
            __builtin_amdgcn_fence(__ATOMIC_RELEASE, "agent");
            asm volatile("s_waitcnt vmcnt(0)" ::: "memory");
            const unsigned og = xb_add(&bar[XB_TOP], 1u);
            const unsigned tg = og / nx;
            if (og + 1u == (tg + 1u) * nx) xb_add(&bar[XB_TOPGEN], 1u);
            else XB_SPIN(xb_ld(&bar[XB_TOPGEN]) == tg, bar);
            __builtin_amdgcn_fence(__ATOMIC_ACQUIRE, "agent");
            xb_add(&bar[XB_XGEN(b.x)], 1u);
            asm volatile("s_waitcnt vmcnt(0)" ::: "memory");
        } else {
            XB_SPIN(xb_ld(&bar[XB_XGEN(b.x)]) == gen, bar);
            __builtin_amdgcn_fence(__ATOMIC_ACQUIRE, "agent");
            asm volatile("s_waitcnt vmcnt(0)" ::: "memory");
        }
    }
    __syncthreads();
}

namespace pg8 {
constexpr int BM = 256, BK = 64, HALF = 128, HTB = HALF * BK * 2, STAGE_BYTES = 8 * HTB, NXCD = 8, WGM = 8;
__host__ __device__ __forceinline__ int lds_byte(int r, int c) { const int st = (r >> 4) * 2 + (c >> 5), rr = r & 15, cc = c & 31, ob = rr * 64 + cc * 2; return st * 1024 + (ob ^ (((ob >> 9) & 1) << 5)); }
__host__ __device__ __forceinline__ void stage_rc(int b, int& R, int& C) { const int st = b / 1024, sb = b % 1024, swz = sb ^ (((sb >> 9) & 1) << 5); R = (st >> 1) * 16 + swz / 64; C = (st & 1) * 32 + (swz % 64) / 2; }
__host__ __device__ __forceinline__ int perm32(int rho) { const int n = rho >> 4, i = rho & 15; return 8 * (i >> 2) + 4 * n + (i & 3); }
struct Unit { int pm, pn, kt0, nt, kp; };
struct Gemm { const bf16_t* A; const bf16_t* Bt; int M, N, K; const int* arow; const int* grp; size_t gstride; };
struct StaticOrder {
    int nM, nN, nwg, G, c, ntk;
    __host__ __device__ void init(int M, int N, int K, int G_, int c_) { nM = M / BM; nN = N / BM; nwg = nM * nN; G = G_; c = c_; ntk = K / BK; }
    __host__ __device__ bool next(int i, Unit& u) const {
        const long L = (long)i * G + c; if (L >= nwg) return false;
        int wgid = (int)L; { const int q = nwg / NXCD, r = nwg % NXCD, xcd = wgid % NXCD, off = wgid / NXCD; wgid = (xcd < r ? xcd * (q + 1) : r * (q + 1) + (xcd - r) * q) + off; }
        const int nig = WGM * nN, gid = wgid / nig, fm = gid * WGM, gsz = (nM - fm) < WGM ? (nM - fm) : WGM;
        u.pm = fm + ((wgid % nig) % gsz); u.pn = (wgid % nig) / gsz; u.kt0 = 0; u.nt = ntk; u.kp = 0; return true;
    }
};
struct ResOrder {
    StaticOrder S; int nlat, npieces, q0, q1, G, c;
    __host__ __device__ void init(int K, int G_, int c_, bool with_ctx) { S.init(ML, D, K, G_, c_); nlat = S.nwg; const int ntk = K / BK; q1 = (ntk / 8) * 2; q0 = (ntk - 2 * q1) / 2; npieces = with_ctx ? 2 * 4 * CTX_KP : 0; if (CTX_KP == 1) { q0 = ntk; q1 = 0; } G = G_; c = c_; }
    __host__ __device__ bool next(int i, Unit& u) const {
        const long L = (long)i * G + c; if (L < nlat) return S.next(i, u);
        const int idx = (int)(L - nlat); if (idx >= npieces) return false;
        const int kp = idx % CTX_KP, rest = idx / CTX_KP; u.kp = kp; u.kt0 = kp < 2 ? kp * q0 : 2 * q0 + (kp - 2) * q1; u.nt = kp < 2 ? q0 : q1; u.pn = rest & 3; u.pm = 128 + (rest >> 2); return true;
    }
};
struct MoeDownOrder {
    StaticOrder S; int nfull, ntail, G, c;
    __host__ __device__ void init(int ntiles, int G_, int c_) { const int pf = ntiles < 256 ? ntiles : 256; S.init(pf * BM, D, DEX, G_, c_); nfull = pf * 4; ntail = (ntiles - pf) * 16; G = G_; c = c_; }
    __host__ __device__ bool next(int i, Unit& u) const {
        const long L = (long)i * G + c; if (L < nfull) return S.next(i, u);
        const int idx = (int)(L - nfull); if (idx >= ntail) return false;
        u.kp = idx & 3; u.kt0 = 14 * (idx & 3); u.nt = 14; u.pn = (idx >> 2) & 3; u.pm = 256 + (idx >> 4); return true;
    }
};
__device__ __forceinline__ unsigned cvt_pk_bf16(float lo, float hi) { unsigned r; asm volatile("v_cvt_pk_bf16_f32 %0, %1, %2" : "=v"(r) : "v"(lo), "v"(hi)); return r; }
__device__ __forceinline__ f32x2 gelu_pk(f32x2 v) {
    const f32x2 av = __builtin_elementwise_abs(v), d = av * 0.2316418882f + 1.0f;
    f32x2 t; t.x = __builtin_amdgcn_rcpf(d.x); t.y = __builtin_amdgcn_rcpf(d.y);
    f32x2 q = t * 0.5307027145f + (-0.7265760135f); q = q * t + 0.7107068705f; q = q * t + (-0.142248368f); q = q * t + 0.127414796f; q = q * t;
    const f32x2 s = (v * v) * (-0.72134752044f);
    f32x2 e; e.x = __builtin_amdgcn_exp2f(s.x); e.y = __builtin_amdgcn_exp2f(s.y);
    const f32x2 m = v * (q * e), r = v - m;
    f32x2 o; o.x = v.x < 0.f ? m.x : r.x; o.y = v.y < 0.f ? m.y : r.y; return o;
}
template <class Epi, class Sched, bool ALIGN_EPI, bool GATHER>
__device__ __forceinline__ void gemm_phase(LAS unsigned char* lds, const Gemm g, const Sched& S, const Epi& E, const int tid) {
    const int wid = __builtin_amdgcn_readfirstlane(tid >> 6), lane = tid & 63, wr = wid >> 2, wc = wid & 3, fr = lane & 15, fq = lane >> 4;
    const int K = g.K;
    unsigned voffA[2], voffB[2];
    unsigned voffA1[2];
#pragma unroll
    for (int i = 0; i < 2; ++i) { int R, C; stage_rc(tid * 16 + i * 8192, R, C); const int Rb = Epi::PERM ? ((R & ~31) + perm32(R & 31)) : R;
        voffA[i] = (unsigned)(R * K + C) * 2u; voffA1[i] = voffA[i]; voffB[i] = (unsigned)(Rb * K + C) * 2u; }
    const size_t kstep = (size_t)(BK * 2);
    const size_t hstep = (size_t)HALF * K * 2;
    const size_t tstep = 2 * hstep;
    const unsigned ldsw = (unsigned)wid * 1024u;
    const int aoff = lds_byte(wr * 64 + fr, fq * 8), boff = lds_byte(wc * 32 + fr, fq * 8);
#define PG8_SA(b, h) (((b) * 2 + (h)) * HTB)
#define PG8_SB(b, h) ((4 + (b) * 2 + (h)) * HTB)
#define PG8_STAGE(bufoff, gbase, voff) do { _Pragma("unroll") for (int _i = 0; _i < 2; ++_i) \
        __builtin_amdgcn_global_load_lds((const unsigned*)((const char*)(gbase) + (voff)[_i]), (LAS unsigned*)(lds + (bufoff) + ldsw + _i * 8192), 16, 0, 0); } while (0)
#define PG8_LDA(dst, b, h) do { _Pragma("unroll") for (int m = 0; m < 4; ++m) _Pragma("unroll") for (int k = 0; k < 2; ++k) dst[m][k] = *(const LAS bf16x8*)(lds + PG8_SA(b, h) + aoff + m * 2048 + k * 1024); } while (0)
#define PG8_LDB(dst, b, h) do { _Pragma("unroll") for (int n = 0; n < 2; ++n) _Pragma("unroll") for (int k = 0; k < 2; ++k) dst[n][k] = *(const LAS bf16x8*)(lds + PG8_SB(b, h) + boff + n * 2048 + k * 1024); } while (0)
#define PG8_MMA(ai, bj, At, Bt) do { __builtin_amdgcn_s_setprio(1); _Pragma("unroll") for (int m = 0; m < 4; ++m) _Pragma("unroll") for (int n = 0; n < 2; ++n) _Pragma("unroll") for (int k = 0; k < 2; ++k) \
        acc[ai][bj][m][n] = __builtin_amdgcn_mfma_f32_16x16x32_bf16(Bt[n][k], At[m][k], acc[ai][bj][m][n], 0, 0, 0); __builtin_amdgcn_s_setprio(0); } while (0)
#define PG8_WAIT_V(n) asm volatile("s_waitcnt vmcnt(" #n ")" ::: "memory")
#define PG8_WAIT_L(n) asm volatile("s_waitcnt lgkmcnt(" #n ")" ::: "memory")
#define PG8_BAR __builtin_amdgcn_s_barrier()
#define PG8_SCHED __builtin_amdgcn_sched_barrier(0)
#define PG8_VA1 (GATHER ? voffA1 : voffA)
#define PG8_GOFF(u, v0, v1) do { _Pragma("unroll") for (int _i = 0; _i < 2; ++_i) { int R_, C_; stage_rc(tid * 16 + _i * 8192, R_, C_); \
        const int r0_ = g.arow[(u).pm * BM + R_], r1_ = g.arow[(u).pm * BM + HALF + R_]; v0[_i] = (unsigned)(r0_ * K + C_) * 2u; v1[_i] = (unsigned)(r1_ * K + C_) * 2u; } } while (0)
#define PG8_BBASE(u) ((const char*)g.Bt + (g.grp ? (size_t)g.grp[(u).pm] * g.gstride * 2 : (size_t)0) + (size_t)(u).pn * tstep + (size_t)(u).kt0 * kstep)
    Unit cur, nxt; int ui = 0;
    if (!S.next(0, cur)) return;
    f32x4 acc[2][2][4][2];
#pragma unroll
    for (int a = 0; a < 2; ++a)
#pragma unroll
        for (int b = 0; b < 2; ++b)
#pragma unroll
            for (int m = 0; m < 4; ++m)
#pragma unroll
                for (int n = 0; n < 2; ++n) acc[a][b][m][n] = (f32x4){0.f, 0.f, 0.f, 0.f};
    bf16x8 At[4][2], B0[2][2], B1[2][2];
    const char* cA = (GATHER ? (const char*)g.A : (const char*)g.A + (size_t)cur.pm * tstep) + (size_t)cur.kt0 * kstep;
    const size_t ah = GATHER ? (size_t)0 : hstep;
    if constexpr (GATHER) PG8_GOFF(cur, voffA, voffA1);
    const char* cB = PG8_BBASE(cur);
    PG8_STAGE(PG8_SB(0, 0), cB, voffB); PG8_STAGE(PG8_SA(0, 0), cA, voffA); PG8_STAGE(PG8_SB(0, 1), cB + hstep, voffB); PG8_STAGE(PG8_SA(0, 1), cA + ah, PG8_VA1);
    if (wr == 1) PG8_BAR;
    PG8_WAIT_V(4); PG8_BAR;
    PG8_STAGE(PG8_SB(1, 0), cB + kstep, voffB); PG8_STAGE(PG8_SA(1, 0), cA + kstep, voffA); PG8_STAGE(PG8_SB(1, 1), cB + hstep + kstep, voffB);
    PG8_WAIT_V(6); PG8_BAR;
    for (;;) {
        const bool has_next = S.next(ui + 1, nxt);
        const char* nA = !has_next ? cA : (GATHER ? (const char*)g.A : (const char*)g.A + (size_t)nxt.pm * tstep) + (size_t)nxt.kt0 * kstep; const char* nB = has_next ? PG8_BBASE(nxt) : cB;
        const int nt = cur.nt;
        for (int t = 0; t < nt; t += 2) {
            const bool last = (t == nt - 2);
            const char* a1 = cA + (size_t)(t + 1) * kstep;
            const char* a2 = last ? nA : cA + (size_t)(t + 2) * kstep; const char* b2 = last ? nB : cB + (size_t)(t + 2) * kstep;
            const char* a3 = a2 + kstep; const char* b3 = b2 + kstep;
            PG8_LDB(B0, 0, 0); PG8_SCHED; PG8_LDA(At, 0, 0); PG8_STAGE(PG8_SA(1, 1), a1 + ah, PG8_VA1);
            if constexpr (GATHER) { if (last && has_next) PG8_GOFF(nxt, voffA, voffA1); }
            PG8_WAIT_L(8); PG8_BAR; PG8_WAIT_L(0); PG8_MMA(0, 0, At, B0); PG8_BAR; PG8_SCHED;
            PG8_LDB(B1, 0, 1); PG8_STAGE(PG8_SB(0, 0), b2, voffB);
            PG8_BAR; PG8_WAIT_L(0); PG8_MMA(0, 1, At, B1); PG8_BAR;
            PG8_LDA(At, 0, 1); PG8_STAGE(PG8_SA(0, 0), a2, voffA);
            PG8_BAR; PG8_WAIT_L(0); PG8_MMA(1, 0, At, B0); PG8_BAR; PG8_SCHED;
            PG8_STAGE(PG8_SB(0, 1), b2 + hstep, voffB);
            PG8_WAIT_V(6); PG8_BAR; PG8_MMA(1, 1, At, B1); PG8_BAR;
            PG8_LDB(B0, 1, 0); PG8_SCHED; PG8_LDA(At, 1, 0); PG8_STAGE(PG8_SA(0, 1), a2 + ah, PG8_VA1);
            PG8_WAIT_L(8); PG8_BAR; PG8_WAIT_L(0); PG8_MMA(0, 0, At, B0); PG8_BAR; PG8_SCHED;
            PG8_LDB(B1, 1, 1); PG8_STAGE(PG8_SB(1, 0), b3, voffB);
            PG8_BAR; PG8_WAIT_L(0); PG8_MMA(0, 1, At, B1); PG8_BAR;
            PG8_LDA(At, 1, 1); PG8_STAGE(PG8_SA(1, 0), a3, voffA);
            PG8_BAR; PG8_WAIT_L(0); PG8_MMA(1, 0, At, B0); PG8_BAR; PG8_SCHED;
            PG8_STAGE(PG8_SB(1, 1), b3 + hstep, voffB);
            PG8_WAIT_V(6); PG8_BAR; PG8_MMA(1, 1, At, B1); PG8_BAR;
        }
        if constexpr (ALIGN_EPI) { if (wr == 0) PG8_BAR; }
        E(acc, cur, wr, wc, fr, fq);
        if (!has_next) break;
#pragma unroll
        for (int a = 0; a < 2; ++a)
#pragma unroll
            for (int b = 0; b < 2; ++b)
#pragma unroll
                for (int m = 0; m < 4; ++m)
#pragma unroll
                    for (int n = 0; n < 2; ++n) acc[a][b][m][n] = (f32x4){0.f, 0.f, 0.f, 0.f};
        cur = nxt; cA = nA; cB = nB; ++ui;
        if constexpr (ALIGN_EPI) { if (wr == 1) PG8_BAR; }
    }
    PG8_WAIT_V(0);
    if constexpr (!ALIGN_EPI) { if (wr == 0) PG8_BAR; }
    PG8_BAR;
#undef PG8_SA
#undef PG8_SB
#undef PG8_STAGE
#undef PG8_LDA
#undef PG8_LDB
#undef PG8_MMA
#undef PG8_WAIT_V
#undef PG8_WAIT_L
#undef PG8_BAR
#undef PG8_SCHED
#undef PG8_VA1
#undef PG8_GOFF
#undef PG8_BBASE
}

struct EpiEvenIn {
    static constexpr bool PERM = true;
    bf16_t* O;
    __device__ __forceinline__ void operator()(const f32x4 (&acc)[2][2][4][2], const Unit& u, int wr, int wc, int fr, int fq) const {
        const int row0 = u.pm * BM + wr * 64 + fr, col0 = u.pn * BM + wc * 32 + 8 * fq; const bool act = u.pn >= 4;
#pragma unroll
        for (int ai = 0; ai < 2; ++ai)
#pragma unroll
            for (int m = 0; m < 4; ++m) { bf16_t* rowp = O + (size_t)(row0 + ai * HALF + m * 16) * NEIN + col0;
#pragma unroll
                for (int bj = 0; bj < 2; ++bj) { f32x4 v0 = acc[ai][bj][m][0], v1 = acc[ai][bj][m][1];
                    if (act) { f32x2 a = gelu_pk((f32x2){v0[0], v0[1]}), b = gelu_pk((f32x2){v0[2], v0[3]}), c = gelu_pk((f32x2){v1[0], v1[1]}), d = gelu_pk((f32x2){v1[2], v1[3]});
                        v0 = (f32x4){a.x, a.y, b.x, b.y}; v1 = (f32x4){c.x, c.y, d.x, d.y}; }
                    u32x4 w; w.x = cvt_pk_bf16(v0[0], v0[1]); w.y = cvt_pk_bf16(v0[2], v0[3]); w.z = cvt_pk_bf16(v1[0], v1[1]); w.w = cvt_pk_bf16(v1[2], v1[3]);
                    *(u32x4*)(rowp + bj * HALF) = w; } }
    }
};
struct EpiRes {
    static constexpr bool PERM = false;
    const float* sl; float* dl; const float* gate; float* part;
    __device__ __forceinline__ void operator()(const f32x4 (&acc)[2][2][4][2], const Unit& u, int wr, int wc, int fr, int fq) const {
        const int col0 = u.pn * BM + wc * 32 + 4 * fq;
        if (u.pm >= 128) {
            float* dst = part + ((size_t)u.kp * MC + (size_t)(u.pm - 128) * BM) * D;
#pragma unroll
            for (int ai = 0; ai < 2; ++ai)
#pragma unroll
                for (int m = 0; m < 4; ++m) { const size_t off = (size_t)(ai * HALF + wr * 64 + m * 16 + fr) * D + col0;
#pragma unroll
                    for (int bj = 0; bj < 2; ++bj)
#pragma unroll
                        for (int n = 0; n < 2; ++n) *(f32x4*)(dst + off + bj * HALF + n * 16) = acc[ai][bj][m][n]; }
            return;
        }
        const int ms = u.pm >= 64 ? 1 : 0;
        const size_t rbase = (size_t)u.pm * BM;
        const float* src = sl + rbase * D; float* dst = dl + rbase * D;
        f32x4 gv[2][2];
#pragma unroll
        for (int bj = 0; bj < 2; ++bj)
#pragma unroll
            for (int n = 0; n < 2; ++n) gv[bj][n] = *(const f32x4*)(gate + ms * 6144 + col0 + bj * HALF + n * 16);
#pragma unroll
        for (int ai = 0; ai < 2; ++ai)
#pragma unroll
            for (int m = 0; m < 4; ++m) { const size_t off = (size_t)(ai * HALF + wr * 64 + m * 16 + fr) * D + col0;
#pragma unroll
                for (int bj = 0; bj < 2; ++bj)
#pragma unroll
                    for (int n = 0; n < 2; ++n) { const f32x4 xs = *(const f32x4*)(src + off + bj * HALF + n * 16); *(f32x4*)(dst + off + bj * HALF + n * 16) = xs + gv[bj][n] * acc[ai][bj][m][n]; } }
    }
};
struct EpiSwiglu {
    static constexpr bool PERM = true;
    bf16_t* O; int ldc;
    __device__ __forceinline__ void operator()(const f32x4 (&acc)[2][2][4][2], const Unit& u, int wr, int wc, int fr, int fq) const {
        const int row0 = u.pm * BM + wr * 64 + fr, col0 = u.pn * 128 + wc * 16 + 4 * fq;
#pragma unroll
        for (int ai = 0; ai < 2; ++ai)
#pragma unroll
            for (int m = 0; m < 4; ++m) { bf16_t* rowp = O + (size_t)(row0 + ai * HALF + m * 16) * ldc + col0;
#pragma unroll
                for (int bj = 0; bj < 2; ++bj) { const f32x4 a = acc[ai][bj][m][0], b = acc[ai][bj][m][1];
                    u32x2 w; w.x = cvt_pk_bf16(siluf(a[0]) * b[0], siluf(a[1]) * b[1]); w.y = cvt_pk_bf16(siluf(a[2]) * b[2], siluf(a[3]) * b[3]);
                    *(u32x2*)(rowp + bj * 64) = w; } }
    }
};
struct EpiOddIn {
    static constexpr bool PERM = true;
    bf16_t* O; const float* lb;
    __device__ __forceinline__ void operator()(const f32x4 (&acc)[2][2][4][2], const Unit& u, int wr, int wc, int fr, int fq) const {
        const int row0 = u.pm * BM + wr * 64 + fr, col0 = u.pn * BM + wc * 32 + 8 * fq; const int seg = u.pn >> 2;
        f32x4 lbv[2][2];
#pragma unroll
        for (int bj = 0; bj < 2; ++bj)
#pragma unroll
            for (int n = 0; n < 2; ++n) lbv[bj][n] = (seg == 2 || seg == 3) ? *(const f32x4*)(lb + (col0 - 2048) + bj * HALF + 4 * n) : (f32x4){0.f, 0.f, 0.f, 0.f};
#pragma unroll
        for (int ai = 0; ai < 2; ++ai)
#pragma unroll
            for (int m = 0; m < 4; ++m) { bf16_t* rowp = O + ((size_t)((u.pn & 3) * 2) * MT + (size_t)(row0 + ai * HALF + m * 16)) * 640 + seg * 128 + wc * 32 + 8 * fq;
#pragma unroll
                for (int bj = 0; bj < 2; ++bj) { f32x4 v[2] = {acc[ai][bj][m][0], acc[ai][bj][m][1]};
#pragma unroll
                    for (int n = 0; n < 2; ++n)
#pragma unroll
                        for (int i = 0; i < 4; ++i) { float x = v[n][i];
                            if (seg == 0) x = siluf(x) * 0.08838834764831845f;
                            else if (seg == 1) x = siluf(x);
                            else if (seg == 2 || seg == 3) { const float l = lbv[bj][n][i]; const float s = __builtin_amdgcn_rcpf(1.0f + __expf(-x)); const float f = l + (1.0f - l) * s; x = __logf(fmaxf(f, 1e-30f)); }
                            v[n][i] = x; }
                    u32x4 w; w.x = cvt_pk_bf16(v[0][0], v[0][1]); w.y = cvt_pk_bf16(v[0][2], v[0][3]); w.z = cvt_pk_bf16(v[1][0], v[1][1]); w.w = cvt_pk_bf16(v[1][2], v[1][3]);
                    *(u32x4*)(rowp + (size_t)bj * MT * 640) = w; } }
    }
};
struct EpiNull { static constexpr bool PERM = true; float* sink;
    __device__ __forceinline__ void operator()(const f32x4 (&acc)[2][2][4][2], const Unit& u, int wr, int wc, int fr, int fq) const {
        float s = 0.f;
#pragma unroll
        for (int ai = 0; ai < 2; ++ai)
#pragma unroll
            for (int bj = 0; bj < 2; ++bj)
#pragma unroll
                for (int m = 0; m < 4; ++m)
#pragma unroll
                    for (int n = 0; n < 2; ++n) s += acc[ai][bj][m][n][0] + acc[ai][bj][m][n][1] + acc[ai][bj][m][n][2] + acc[ai][bj][m][n][3];
        if (s == 123.456f) sink[0] = s; } };
struct EpiMoeDown {
    static constexpr bool PERM = true;
    bf16_t* O; const int* dst; float* partm;
    __device__ __forceinline__ void operator()(const f32x4 (&acc)[2][2][4][2], const Unit& u, int wr, int wc, int fr, int fq) const {
        const int row0 = u.pm * BM + wr * 64 + fr, col0 = u.pn * BM + wc * 32 + 8 * fq;
        if (u.pm >= 256) {
            float* base = partm + ((size_t)u.kp * 3072 + (size_t)(row0 - 65536)) * D + col0;
#pragma unroll
            for (int ai = 0; ai < 2; ++ai)
#pragma unroll
                for (int m = 0; m < 4; ++m) { float* rowp = base + (size_t)(ai * HALF + m * 16) * D;
#pragma unroll
                    for (int bj = 0; bj < 2; ++bj) { *(f32x4*)(rowp + bj * HALF) = acc[ai][bj][m][0]; *(f32x4*)(rowp + bj * HALF + 4) = acc[ai][bj][m][1]; } }
            return;
        }
        int dd[2][4];
#pragma unroll
        for (int ai = 0; ai < 2; ++ai)
#pragma unroll
            for (int m = 0; m < 4; ++m) dd[ai][m] = dst[row0 + ai * HALF + m * 16];
#pragma unroll
        for (int ai = 0; ai < 2; ++ai)
#pragma unroll
            for (int m = 0; m < 4; ++m) { if (dd[ai][m] >= 0) { bf16_t* rowp = O + (size_t)dd[ai][m] * D + col0;
#pragma unroll
                for (int bj = 0; bj < 2; ++bj) { const f32x4 v0 = acc[ai][bj][m][0], v1 = acc[ai][bj][m][1];
                    u32x4 w; w.x = cvt_pk_bf16(v0[0], v0[1]); w.y = cvt_pk_bf16(v0[2], v0[3]); w.z = cvt_pk_bf16(v1[0], v1[1]); w.w = cvt_pk_bf16(v1[2], v1[3]);
                    *(u32x4*)(rowp + bj * HALF) = w; } } }
    }
};
}

struct Args { const float* in[24]; float* out; unsigned char* ws; int ph_lo, ph_hi; };
enum { I_X = 0, I_C, I_CTX, I_CCTX, I_WADA, I_BADA, I_NMIX, I_NFFN, I_NOUT, I_WINE, I_GW, I_GB, I_WOUTE, I_WINO, I_RLB, I_RNORM, I_WOUTO, I_F1, I_F3, I_F2, I_RW, I_M1, I_M3, I_M2 };
enum { PH_P0 = 0, PH_PAIR0 = 1, NPL = 18, PH_FINAL = 1 + 2 * NPL, NPHASE = PH_FINAL + 1 };
enum { E1_NORM = 0, E2_GIN, E3_FFTA, E3_FFTC, E4_GOUT, E5_NORM, E6_UP, E7_DOWN, O1_NORM, O2_GIN, O3_SCAN1, O4_CARRY, O5_SCAN3, O6_GOUT, O7_NORM, O8_SLOTS, O9_MUP, O10_MDOWN };

struct Ctx {
    LAS unsigned char* lds; int tid, lane, wave, G, bid, gw, NGW;
    const float* const* in; float* out; unsigned char* ws;
};

__device__ __forceinline__ void transpose_item(const float* W, int ld, int K, int N, bf16_t* WT, int mode, int roff, int item, int lane) {
    const int nblk = N / 64, kb = item / nblk, nb = item % nblk, k0 = 64 * kb, n0 = 64 * nb;
    const int c = lane & 15, kg = lane >> 4;
    const float* src = W + (size_t)(k0 + 8 * kg) * ld + n0 + 4 * c;
    f32x4 v[2][8];
#pragma unroll
    for (int hf = 0; hf < 2; ++hf)
#pragma unroll
        for (int i = 0; i < 8; ++i) v[hf][i] = __builtin_nontemporal_load((const f32x4*)(src + (size_t)(32 * hf + i) * ld));
#pragma unroll
    for (int i = 0; i < 4; ++i) { const int ng = n0 + 4 * c + i; const int drow = mode == 0 ? (roff + ng) : (((ng >> 2) << 3) + (ng & 3) + roff);
#pragma unroll
        for (int hf = 0; hf < 2; ++hf) { u32x4 o; o.x = pk2(v[hf][0][i], v[hf][1][i]); o.y = pk2(v[hf][2][i], v[hf][3][i]); o.z = pk2(v[hf][4][i], v[hf][5][i]); o.w = pk2(v[hf][6][i], v[hf][7][i]);
            *(u32x4*)(WT + (size_t)drow * K + k0 + 32 * hf + 8 * kg) = o; } }
}

__device__ __forceinline__ void p0_prologue(const Ctx& F) {
    const int tid = F.tid, lane = F.lane, wave = F.wave;
    unsigned char* ws = F.ws;
    LAS float* scond = (LAS float*)(F.lds);
    LAS float* part = (LAS float*)(F.lds + 16384);
    LAS float* ctab = (LAS float*)(F.lds + 32768);
    for (int i = tid; i < 3 * D; i += 512) { const int v = i / D, k = i % D; const float c = v < 2 ? F.in[I_C][v * D + k] : F.in[I_CCTX][k]; scond[i] = c / (1.0f + expf(-c)); }
    if (tid < 128) ctab[tid] = cosf(6.283185307179586f * (float)tid / 128.0f);
    __syncthreads();
    float* mods = (float*)(ws + WS_MODS);
    if (P0_MASK & 1)
    for (int it = F.bid; it < 4 * 48; it += F.G) {
        const int l = it / 48, cg = it % 48; const float* W = F.in[I_WADA] + (size_t)l * D * 6144 + cg * 128 + 2 * lane;
        float a0[2] = {0.f, 0.f}, a1[2] = {0.f, 0.f}, a2[2] = {0.f, 0.f};
#pragma unroll 16
        for (int kk = 0; kk < 128; ++kk) { const int k = wave * 128 + kk; const f32x2 w = __builtin_nontemporal_load((const f32x2*)(W + (size_t)k * 6144)); const float s0 = scond[k], s1 = scond[D + k], s2 = scond[2 * D + k];
            a0[0] += s0 * w.x; a0[1] += s0 * w.y; a1[0] += s1 * w.x; a1[1] += s1 * w.y; a2[0] += s2 * w.x; a2[1] += s2 * w.y; }
        part[(wave * 3 + 0) * 128 + 2 * lane] = a0[0]; part[(wave * 3 + 0) * 128 + 2 * lane + 1] = a0[1];
        part[(wave * 3 + 1) * 128 + 2 * lane] = a1[0]; part[(wave * 3 + 1) * 128 + 2 * lane + 1] = a1[1];
        part[(wave * 3 + 2) * 128 + 2 * lane] = a2[0]; part[(wave * 3 + 2) * 128 + 2 * lane + 1] = a2[1];
        __syncthreads();
        if (tid < 384) { const int v = tid / 128, c = tid % 128; float sum = 0.f;
#pragma unroll
            for (int w = 0; w < 8; ++w) sum += part[(w * 3 + v) * 128 + c];
            mods[((size_t)l * 3 + v) * 6144 + cg * 128 + c] = sum + F.in[I_BADA][l * 6144 + cg * 128 + c]; }
        __syncthreads();
    }
    const int gt = F.bid * 512 + tid, NGT = F.G * 512;
    float* LB = (float*)(ws + WS_LB);
    if (P0_MASK & 2)
    for (int i = gt; i < 4096; i += NGT) { const int j = i >> 11, r = i & 2047; float v = 0.f; if (j == 1) { const float r0 = F.in[I_RLB][r], r1 = F.in[I_RLB][2048 + r]; v = 1.0f / (1.0f + expf(r0 - r1)); v = fminf(fmaxf(v, 0.f), 1.f); } LB[i] = v; }
    bf16_t* FA = (bf16_t*)(ws + WS_FA); bf16_t* FC = (bf16_t*)(ws + WS_FC); bf16_t* FX = (bf16_t*)(ws + WS_FX); bf16_t* GW = (bf16_t*)(ws + WS_GW);
    if (P0_MASK & 4)
    for (int i = gt; i < 256 * 256; i += NGT) { const int r = i >> 8, c = i & 255, k1 = r & 127, t1 = c & 127; const float ang = 6.283185307179586f * (float)((k1 * t1) & 127) / 128.0f; float sn, cs; sincosf(ang, &sn, &cs);
        const int rr = r >> 7, cc = c >> 7; const float v = (rr == cc) ? cs : (rr == 0 ? -sn : sn); FA[i] = (bf16_t)f2bf(v); }
    if (P0_MASK & 4)
    for (int i = gt; i < 128 * 256; i += NGT) { const int k2 = i >> 8, c = i & 255, t2 = c & 127; const float ang = 6.283185307179586f * (float)((k2 * t2) & 127) / 128.0f; float sn, cs; sincosf(ang, &sn, &cs); FC[i] = (bf16_t)f2bf(c < 128 ? cs : -sn); }
    if (P0_MASK & 4)
    for (int i = gt; i < 256 * 512; i += NGT) { const int k = i >> 9, c = i & 511, t = c & 255; const float ang = 6.283185307179586f * (float)((k * t) & 255) / 256.0f; float sn, cs; sincosf(ang, &sn, &cs); FX[i] = (bf16_t)f2bf(c < 256 ? cs : -sn); }
    if (P0_MASK & 8)
    for (int i = gt; i < 2 * 4 * 128 * 128; i += NGT) GW[i] = (bf16_t)f2bf(F.in[I_GW][i]);
    bf16_t* WinE = (bf16_t*)(ws + WS_WINE);
    if (P0_MASK & 16)
    for (int it = F.gw; it < 2 * 4 * 16 * 32; it += F.NGW) {
        const int mg = it & 31, kb = (it >> 5) & 15, g = (it >> 9) & 3, j = it >> 11; const int k = kb * 64 + lane, m0 = mg * 4;
        const float* Wr = F.in[I_WINE] + (size_t)j * D * 1536 + (size_t)k * 1536 + g * 128;
        float aP[4] = {0.f, 0.f, 0.f, 0.f}, aQ[4] = {0.f, 0.f, 0.f, 0.f};
        for (int c4 = 0; c4 < 32; ++c4) { const f32x4 w = *(const f32x4*)(Wr + 4 * c4);
#pragma unroll
            for (int ci = 0; ci < 4; ++ci) { const int c = 4 * c4 + ci;
#pragma unroll
                for (int mm = 0; mm < 4; ++mm) { const int idx = (c * (m0 + mm)) & 127; aP[mm] += w[ci] * ctab[idx]; aQ[mm] += w[ci] * ctab[(idx - 32) & 127]; } } }
#pragma unroll
        for (int mm = 0; mm < 4; ++mm) { bf16_t* o = WinE + (size_t)j * NEIN * D; o[(size_t)(g * 128 + m0 + mm) * D + k] = (bf16_t)f2bf(aP[mm]); o[(size_t)(512 + g * 128 + m0 + mm) * D + k] = (bf16_t)f2bf(aQ[mm]); }
    }
    constexpr int NI_UV = 16 * 16, NI_SQ = 16 * 16, NI_INO = 16 * 80, NI_F13 = 16 * 44, NI_F2 = 44 * 16;
    constexpr int PER_J = NI_UV + NI_SQ + NI_INO + NI_SQ + 2 * NI_F13 + NI_F2;
    if (P0_MASK & 32)
    for (int it = F.gw; it < 2 * PER_J; it += F.NGW) {
        const int j = it / PER_J; int r = it % PER_J;
        const float* W; int ld, K, N, mode = 0, roff = 0; bf16_t* WT;
        if (r < NI_UV) { W = F.in[I_WINE] + (size_t)j * D * 1536 + 512; ld = 1536; K = D; N = 1024; WT = WinE + (size_t)j * NEIN * D; roff = 1024; }
        else if ((r -= NI_UV) < NI_SQ) { W = F.in[I_WOUTE] + (size_t)j * D * D; ld = D; K = D; N = D; WT = (bf16_t*)(ws + WS_WOUTE) + (size_t)j * D * D; }
        else if ((r -= NI_SQ) < NI_INO) { W = F.in[I_WINO] + (size_t)j * D * NREC; ld = NREC; K = D; N = NREC; WT = (bf16_t*)(ws + WS_WINO) + (size_t)j * NREC * D; }
        else if ((r -= NI_INO) < NI_SQ) { W = F.in[I_WOUTO] + (size_t)j * D * D; ld = D; K = D; N = D; WT = (bf16_t*)(ws + WS_WOUTO) + (size_t)j * D * D; }
        else if ((r -= NI_SQ) < NI_F13) { W = F.in[I_F1] + (size_t)j * D * DFF; ld = DFF; K = D; N = DFF; WT = (bf16_t*)(ws + WS_W13) + (size_t)j * NFF2 * D; mode = 1; }
        else if ((r -= NI_F13) < NI_F13) { W = F.in[I_F3] + (size_t)j * D * DFF; ld = DFF; K = D; N = DFF; WT = (bf16_t*)(ws + WS_W13) + (size_t)j * NFF2 * D; mode = 1; roff = 4; }
        else { r -= NI_F13; W = F.in[I_F2] + (size_t)j * DFF * D; ld = D; K = DFF; N = D; WT = (bf16_t*)(ws + WS_W2) + (size_t)j * D * DFF; }
        transpose_item(W, ld, K, N, WT, mode, roff, r, lane);
    }
}
constexpr int MOE_CONV_ITEMS = NE * (2 * 16 * 56 + 56 * 16);
__device__ __forceinline__ void moe_convert_item(const Ctx& F, int j, int it) {
    constexpr int I_13 = 16 * 56, I_2 = 56 * 16, PER_E = 2 * I_13 + I_2;
    const int e = it / PER_E; int r = it % PER_E; const size_t eo = (size_t)(j * NE + e);
    const float* W; int ld, K, N, mode = 0, roff = 0; bf16_t* WT;
    if (r < I_13) { W = F.in[I_M1] + eo * D * DEX; ld = DEX; K = D; N = DEX; WT = (bf16_t*)(F.ws + WS_W13M) + (size_t)e * NEX2 * D; mode = 1; }
    else if ((r -= I_13) < I_13) { W = F.in[I_M3] + eo * D * DEX; ld = DEX; K = D; N = DEX; WT = (bf16_t*)(F.ws + WS_W13M) + (size_t)e * NEX2 * D; mode = 1; roff = 4; }
    else { r -= I_13; W = F.in[I_M2] + eo * DEX * D; ld = D; K = DEX; N = D; WT = (bf16_t*)(F.ws + WS_W2M) + (size_t)e * D * DEX; }
    transpose_item(W, ld, K, N, WT, mode, roff, r, F.lane);
}

struct RowPass {
    const float* sl; const float* sc;
    float* dl; float* dc;
    const float* gain;
    const float* shift; const float* scale;
    bf16_t* H;
    int nrows;
    const bf16_t* YE; const float* topp; const float* gatef;
    const float* rw; int* tope; float* toppo; int* rank; int* cnt;
    float* fout;
    const float* part; int kpn; const float* pgate;
    const int* slotof; const float* partm;
};
struct RowPart { int WB, WC; };
__device__ __forceinline__ RowPart row_part(int NW, int nrows) { RowPart q; q.WC = nrows > ML ? NW / 32 : 0; q.WB = (NW - q.WC) / 2; return q; }
__device__ __forceinline__ void row_chunk(const RowPart& q, int gw, int& r0, int& r1) {
    if (gw < 2 * q.WB) { const int b = gw / q.WB, i = gw % q.WB; r0 = b * TL + (int)(((long)i * TL) / q.WB); r1 = b * TL + (int)(((long)(i + 1) * TL) / q.WB); }
    else { const int i = gw - 2 * q.WB; r0 = ML + (i * MC) / q.WC; r1 = ML + ((i + 1) * MC) / q.WC; }
}
__device__ __forceinline__ int row_chunk_of(const RowPart& q, int r) {
    if (r < ML) { const int b = r >> 14, lr = r & (TL - 1); return b * q.WB + (int)(((long)q.WB * (lr + 1) - 1) / TL); }
    return 2 * q.WB + ((r - ML + 1) * q.WC - 1) / MC;
}
template <bool COMBINE, bool ROUTER, bool FINAL>
__device__ __forceinline__ void row_pass(const Ctx& F, const RowPass& P) {
    const int lane = F.lane;
    LAS float* rwl = (LAS float*)F.lds;
    if (ROUTER) { for (int i = F.tid; i < D * NE; i += 512) rwl[i] = P.rw[i]; __syncthreads(); }
    f32x4 gn[4];
#pragma unroll
    for (int j = 0; j < 4; ++j) gn[j] = *(const f32x4*)(P.gain + 4 * lane + 256 * j);
    const RowPart rp = row_part(F.NGW, P.nrows);
    int r0, r1; row_chunk(rp, F.gw, r0, r1);
    {
        int rc0 = 0, rc1 = 0, rc2 = 0, rc3 = 0, rc4 = 0, rc5 = 0, rc6 = 0, rc7 = 0;
        const bool isc = r0 >= ML; const int ms = isc ? 2 : (r0 >= TL ? 1 : 0);
        const float* xs0 = isc ? P.sc + (size_t)(r0 - ML) * D : P.sl + (size_t)r0 * D;
        if (!COMBINE && !FINAL) { if (isc && P.part) {
            float* xd = P.dc + (size_t)(r0 - ML) * D;
#pragma unroll 1
            for (int rr = 0; rr < r1 - r0; ++rr) {
#pragma unroll 2
                for (int j = 0; j < 4; ++j) { f32x4 a[4];
#pragma unroll
                    for (int kp = 0; kp < 4; ++kp) a[kp] = kp < P.kpn ? *(const f32x4*)(P.part + ((size_t)kp * MC + (size_t)(r0 - ML + rr)) * D + 4 * lane + 256 * j) : (f32x4){0.f, 0.f, 0.f, 0.f};
                    *(f32x4*)(xd + (size_t)rr * D + 4 * lane + 256 * j) = *(const f32x4*)(xs0 + (size_t)rr * D + 4 * lane + 256 * j) + *(const f32x4*)(P.pgate + 2 * 6144 + 4 * lane + 256 * j) * ((a[0] + a[1]) + (a[2] + a[3])); } }
            asm volatile("s_waitcnt vmcnt(0)" ::: "memory");
            xs0 = xd; } }
        float* xd0 = nullptr; if (COMBINE && !FINAL) xd0 = isc ? P.dc + (size_t)(r0 - ML) * D : P.dl + (size_t)r0 * D;
        f32x4 sh[4], scl[4], gf[4];
#pragma unroll
        for (int j = 0; j < 4; ++j) {
            if (!FINAL && !COMBINE && !ROUTER) { sh[j] = *(const f32x4*)(P.shift + ms * 6144 + 4 * lane + 256 * j); scl[j] = *(const f32x4*)(P.scale + ms * 6144 + 4 * lane + 256 * j) + 1.0f; }
            if (COMBINE) gf[j] = *(const f32x4*)(P.gatef + ms * 6144 + 4 * lane + 256 * j); }
        f32x4 v[4]; u32x2 ya[4], yb[4]; float p0 = 0.f, p1 = 0.f;
#pragma unroll
        for (int j = 0; j < 4; ++j) v[j] = *(const f32x4*)(xs0 + 4 * lane + 256 * j);
        if (COMBINE) { p0 = P.topp[2 * r0]; p1 = P.topp[2 * r0 + 1];
#pragma unroll
            for (int j = 0; j < 4; ++j) { ya[j] = *(const u32x2*)(P.YE + (size_t)(2 * r0) * D + 4 * lane + 256 * j); yb[j] = *(const u32x2*)(P.YE + (size_t)(2 * r0 + 1) * D + 4 * lane + 256 * j); } }
        for (int r = r0; r < r1; ++r) {
            const int rr = r - r0; const bool more = r + 1 < r1;
            f32x4 vn[4]; u32x2 yan[4], ybn[4]; float p0n = 0.f, p1n = 0.f;
            if (more) {
#pragma unroll
                for (int j = 0; j < 4; ++j) vn[j] = *(const f32x4*)(xs0 + (size_t)(rr + 1) * D + 4 * lane + 256 * j);
                if (COMBINE) { p0n = P.topp[2 * r + 2]; p1n = P.topp[2 * r + 3];
#pragma unroll
                    for (int j = 0; j < 4; ++j) { yan[j] = *(const u32x2*)(P.YE + (size_t)(2 * r + 2) * D + 4 * lane + 256 * j); ybn[j] = *(const u32x2*)(P.YE + (size_t)(2 * r + 3) * D + 4 * lane + 256 * j); } }
            }
            if (COMBINE) {
                const int sl0 = P.slotof[2 * r], sl1 = P.slotof[2 * r + 1];
#pragma unroll
                for (int j = 0; j < 4; ++j) { const u32x2 a = ya[j], b = yb[j];
                    f32x4 y0 = (f32x4){bflo(a.x), bfhi(a.x), bflo(a.y), bfhi(a.y)}, y1 = (f32x4){bflo(b.x), bfhi(b.x), bflo(b.y), bfhi(b.y)};
                    if (sl0 >= 65536) { y0 = (f32x4){0.f, 0.f, 0.f, 0.f}; for (int kp = 0; kp < 4; ++kp) y0 = y0 + *(const f32x4*)(P.partm + ((size_t)kp * 3072 + (size_t)(sl0 - 65536)) * D + 4 * lane + 256 * j); }
                    if (sl1 >= 65536) { y1 = (f32x4){0.f, 0.f, 0.f, 0.f}; for (int kp = 0; kp < 4; ++kp) y1 = y1 + *(const f32x4*)(P.partm + ((size_t)kp * 3072 + (size_t)(sl1 - 65536)) * D + 4 * lane + 256 * j); }
                    v[j] = v[j] + gf[j] * (y0 * p0 + y1 * p1);
                    if (!FINAL) *(f32x4*)(xd0 + (size_t)rr * D + 4 * lane + 256 * j) = v[j]; }
            }
            float ss = 0.f;
#pragma unroll
            for (int j = 0; j < 4; ++j) ss += (v[j][0] * v[j][0] + v[j][1] * v[j][1]) + (v[j][2] * v[j][2] + v[j][3] * v[j][3]);
            const float rstd = rsqrtf(wave_sum(ss, lane) * (1.0f / D) + EPS);
            if (FINAL) {
#pragma unroll
                for (int j = 0; j < 4; ++j) *(f32x4*)(P.fout + (size_t)r * D + 4 * lane + 256 * j) = v[j] * rstd * gn[j];
            } else {
                f32x4 h[4];
#pragma unroll
                for (int j = 0; j < 4; ++j) { if (COMBINE || ROUTER) { sh[j] = *(const f32x4*)(P.shift + ms * 6144 + 4 * lane + 256 * j); scl[j] = *(const f32x4*)(P.scale + ms * 6144 + 4 * lane + 256 * j) + 1.0f; }
                    h[j] = (v[j] * rstd * gn[j]) * scl[j] + sh[j];
                    u32x2 w; w.x = pk2(h[j][0], h[j][1]); w.y = pk2(h[j][2], h[j][3]);
                    *(u32x2*)(P.H + (size_t)r * D + 4 * lane + 256 * j) = w; }
                if (ROUTER) {
                    float lg[8] = {0.f, 0.f, 0.f, 0.f, 0.f, 0.f, 0.f, 0.f};
#pragma unroll
                    for (int j = 0; j < 4; ++j) {
#pragma unroll
                        for (int i = 0; i < 4; ++i) { const int col = 4 * lane + 256 * j + i; const f32x4 w0 = *(const LAS f32x4*)(rwl + col * 8), w1 = *(const LAS f32x4*)(rwl + col * 8 + 4); const float hv = h[j][i];
                            lg[0] += hv * w0[0]; lg[1] += hv * w0[1]; lg[2] += hv * w0[2]; lg[3] += hv * w0[3]; lg[4] += hv * w1[0]; lg[5] += hv * w1[1]; lg[6] += hv * w1[2]; lg[7] += hv * w1[3]; }
                        __builtin_amdgcn_sched_barrier(0); }
#pragma unroll
                    for (int e = 0; e < 8; ++e) lg[e] = wave_sum(lg[e], lane);
                    int e0 = 0; float v0 = lg[0];
#pragma unroll
                    for (int e = 1; e < 8; ++e) if (lg[e] > v0) { v0 = lg[e]; e0 = e; }
                    int e1 = -1; float v1 = -3.0e38f;
#pragma unroll
                    for (int e = 0; e < 8; ++e) if (e != e0 && lg[e] > v1) { v1 = lg[e]; e1 = e; }
                    const float ex = expf(v1 - v0); const float q0 = 1.0f / (1.0f + ex), q1 = ex / (1.0f + ex);
                    const int rk0 = e0 == 0 ? rc0 : e0 == 1 ? rc1 : e0 == 2 ? rc2 : e0 == 3 ? rc3 : e0 == 4 ? rc4 : e0 == 5 ? rc5 : e0 == 6 ? rc6 : rc7;
                    const int rk1 = e1 == 0 ? rc0 : e1 == 1 ? rc1 : e1 == 2 ? rc2 : e1 == 3 ? rc3 : e1 == 4 ? rc4 : e1 == 5 ? rc5 : e1 == 6 ? rc6 : rc7;
                    rc0 += (e0 == 0) + (e1 == 0); rc1 += (e0 == 1) + (e1 == 1); rc2 += (e0 == 2) + (e1 == 2); rc3 += (e0 == 3) + (e1 == 3);
                    rc4 += (e0 == 4) + (e1 == 4); rc5 += (e0 == 5) + (e1 == 5); rc6 += (e0 == 6) + (e1 == 6); rc7 += (e0 == 7) + (e1 == 7);
                    if (lane == 0) { P.tope[2 * r] = e0; P.tope[2 * r + 1] = e1; P.toppo[2 * r] = q0; P.toppo[2 * r + 1] = q1; P.rank[2 * r] = rk0; P.rank[2 * r + 1] = rk1; }
                }
            }
            if (more) {
#pragma unroll
                for (int j = 0; j < 4; ++j) { v[j] = vn[j]; if (COMBINE) { ya[j] = yan[j]; yb[j] = ybn[j]; } }
                if (COMBINE) { p0 = p0n; p1 = p1n; }
            }
        }
        if (ROUTER && lane == 0) { int* c = P.cnt + F.gw * 8; c[0] = rc0; c[1] = rc1; c[2] = rc2; c[3] = rc3; c[4] = rc4; c[5] = rc5; c[6] = rc6; c[7] = rc7; }
    }
}

template <int NB, int NKS>
__device__ __forceinline__ void lm_load_a(const bf16_t* A, int lda, const int (&i0)[NB], int kc0, bf16x8 (&ap)[NB][NKS], int lane) {
    const int i16 = lane & 15, q = lane >> 4;
#pragma unroll
    for (int b = 0; b < NB; ++b)
#pragma unroll
        for (int ks = 0; ks < NKS; ++ks) ap[b][ks] = *(const bf16x8*)(A + (size_t)(i0[b] + i16) * lda + kc0 + ks * 32 + 8 * q);
}
template <int NB, int NKS>
__device__ __forceinline__ void lm_core(const bf16x8 (&ap)[NB][NKS], LAS unsigned char* X, f32x4 (&acc)[NB][8], int lane) {
    const int i16 = lane & 15, q = lane >> 4;
    const int xoff = (8 * q + (i16 >> 2)) * XRS + 8 * (i16 & 3);
#pragma unroll
    for (int ks = 0; ks < NKS; ++ks) {
        s16x4 lo[8], hi[8];
#pragma unroll
        for (int nt = 0; nt < 8; ++nt) {
            lo[nt] = __builtin_amdgcn_ds_read_tr16_b64_v4i16((LAS s16x4*)(X + ks * 32 * XRS + xoff + nt * 32));
            hi[nt] = __builtin_amdgcn_ds_read_tr16_b64_v4i16((LAS s16x4*)(X + ks * 32 * XRS + xoff + nt * 32 + 4 * XRS)); }
        __builtin_amdgcn_sched_barrier(0);
#pragma unroll
        for (int nt = 0; nt < 8; ++nt) { const bf16x8 xf = __builtin_shufflevector(lo[nt], hi[nt], 0, 1, 2, 3, 4, 5, 6, 7);
#pragma unroll
            for (int b = 0; b < NB; ++b) acc[b][nt] = __builtin_amdgcn_mfma_f32_16x16x32_bf16(xf, ap[b][ks], acc[b][nt], 0, 0, 0); }
    }
}
template <int NB> __device__ __forceinline__ void zero_acc(f32x4 (&acc)[NB][8]) {
#pragma unroll
    for (int b = 0; b < NB; ++b)
#pragma unroll
        for (int nt = 0; nt < 8; ++nt) acc[b][nt] = (f32x4){0.f, 0.f, 0.f, 0.f};
}
__device__ __forceinline__ void stage_rows(const bf16_t* src, size_t sstride, int nrows, LAS unsigned char* X, int xr0, int tid) {
    for (int i = tid; i < nrows * 16; i += 512) { const int r = i >> 4, ch = i & 15; *(LAS u32x4*)(X + (xr0 + r) * XRS + ch * 16) = *(const u32x4*)(src + (size_t)r * sstride + ch * 8); }
}

__device__ __forceinline__ void fft_stage_a(const Ctx& F, unsigned* wq) {
    const bf16_t* PZ = (const bf16_t*)(F.ws + WS_PZUV); bf16_t* UP = (bf16_t*)(F.ws + WS_UP); bf16_t* Y = (bf16_t*)(F.ws + WS_H);
    const bf16_t* FA = (const bf16_t*)(F.ws + WS_FA); const bf16_t* FX = (const bf16_t*)(F.ws + WS_FX);
    LAS unsigned char* X = F.lds; const int lane = F.lane, w = F.wave, i16 = lane & 15, q = lane >> 4;
    volatile LAS unsigned* slot = (volatile LAS unsigned*)(F.lds + MISC_OFF + 64);
    bf16x8 apA[2][8]; { const int i0[2] = {16 * w, 128 + 16 * w}; lm_load_a<2, 8>(FA, 256, i0, 0, apA, lane); }
    for (int it0 = F.bid; it0 < 1024 + 16; ) {
        const int it = it0 < 16 ? 1024 + it0 : it0 - 16;
        if (it < 1024) {
            const int t2 = it & 127, g = (it >> 7) & 3, b = it >> 9;
            const bf16_t* src = PZ + ((size_t)b * TL + t2) * NEIN + g * 128;
            stage_rows(src, (size_t)128 * NEIN, 128, X, 0, F.tid);
            stage_rows(src + 512, (size_t)128 * NEIN, 128, X, 128, F.tid);
            __syncthreads();
            f32x4 acc[2][8]; zero_acc<2>(acc);
            lm_core<2, 8>(apA, X, acc, lane);
            const int k1 = 16 * w + i16; float sw, cw; sincosf(6.283185307179586f * (float)((k1 * t2) & 16383) / 16384.0f, &sw, &cw);
            bf16_t* orow = UP + ((size_t)((b * 4 + g) * 128 + k1) * 128 + t2) * 256;
#pragma unroll
            for (int nt = 0; nt < 8; ++nt) { const f32x4 ur = acc[0][nt], ui = acc[1][nt]; const int n = 16 * nt + 4 * q;
                u32x2 wr_, wi_; wr_.x = pk2(ur[0] * cw - ui[0] * sw, ur[1] * cw - ui[1] * sw); wr_.y = pk2(ur[2] * cw - ui[2] * sw, ur[3] * cw - ui[3] * sw);
                wi_.x = pk2(ur[0] * sw + ui[0] * cw, ur[1] * sw + ui[1] * cw); wi_.y = pk2(ur[2] * sw + ui[2] * cw, ur[3] * sw + ui[3] * cw);
                *(u32x2*)(orow + n) = wr_; *(u32x2*)(orow + 128 + n) = wi_; }
            __syncthreads();
        } else {
            const int ci = it - 1024, kh = ci & 1, g = (ci >> 1) & 3, b = ci >> 3;
            f32x4 acc[1][8]; zero_acc<1>(acc); const int i0[1] = {128 * kh + 16 * w};
            for (int c = 0; c < 2; ++c) {
                bf16x8 apx[1][8]; lm_load_a<1, 8>(FX, 512, i0, c * 256, apx, lane);
                stage_rows(PZ + ((size_t)ML + b * TCX) * NEIN + c * 512 + g * 128, NEIN, 256, X, 0, F.tid);
                __syncthreads();
                lm_core<1, 8>(apx, X, acc, lane);
                __syncthreads();
            }
            const int k = 128 * kh + 16 * w + i16; bf16_t* orow = Y + ((size_t)ML + b * TCX + k) * D + g * 128; const float nrm = 0.005524271728019903f;
#pragma unroll
            for (int nt = 0; nt < 8; ++nt) { const f32x4 a = acc[0][nt] * nrm; u32x2 o; o.x = pk2(a[0], a[1]); o.y = pk2(a[2], a[3]); *(u32x2*)(orow + 16 * nt + 4 * q) = o; }
        }
        WQ_NEXT(it0, wq, slot, F.G);
    }
}
__device__ __forceinline__ void fft_stage_c_gmlp(const Ctx& F, int j, unsigned* wq) {
    const bf16_t* PZ = (const bf16_t*)(F.ws + WS_PZUV); const bf16_t* UP = (const bf16_t*)(F.ws + WS_UP); bf16_t* Y = (bf16_t*)(F.ws + WS_H);
    const bf16_t* FC = (const bf16_t*)(F.ws + WS_FC); const bf16_t* GW = (const bf16_t*)(F.ws + WS_GW) + (size_t)j * 4 * 128 * 128;
    const float* gb = F.in[I_GB] + j * 512;
    LAS unsigned char* X = F.lds; const int lane = F.lane, w = F.wave, i16 = lane & 15, q = lane >> 4, tid = F.tid;
    volatile LAS unsigned* slot = (volatile LAS unsigned*)(F.lds + MISC_OFF + 64);
    bf16x8 apC[1][8]; { const int i0[1] = {16 * w}; lm_load_a<1, 8>(FC, 256, i0, 0, apC, lane); }
    for (int it = F.bid; it < 1024 + 1040; ) {
        if (it < 1024) {
            const int k1 = it & 127, g = (it >> 7) & 3, b = it >> 9;
            const bf16_t* src = UP + (size_t)((b * 4 + g) * 128 + k1) * 128 * 256;
            stage_rows(src, 256, 128, X, 0, tid);
            stage_rows(src + 128, 256, 128, X, 128, tid);
            __syncthreads();
            f32x4 acc[1][8]; zero_acc<1>(acc);
            lm_core<1, 8>(apC, X, acc, lane);
            const int k2 = 16 * w + i16; bf16_t* orow = Y + ((size_t)b * TL + k1 + 128 * k2) * D + g * 128; const float nrm = 0.0006905339660024878f;
#pragma unroll
            for (int nt = 0; nt < 8; ++nt) { const f32x4 a = acc[0][nt] * nrm; u32x2 o; o.x = pk2(a[0], a[1]); o.y = pk2(a[2], a[3]); *(u32x2*)(orow + 16 * nt + 4 * q) = o; }
            __syncthreads();
        } else {
            const int gi = it - 1024, h = gi & 3, ck = gi >> 2; const size_t r0 = (size_t)ck * 128;
            bf16x8 apg[1][4]; { const int i0[1] = {16 * w}; lm_load_a<1, 4>(GW + (size_t)h * 128 * 128, 128, i0, 0, apg, lane); }
            for (int i = tid; i < 128 * 16; i += 512) { const int r = i >> 4, ch = i & 15; const u32x4 raw = *(const u32x4*)(PZ + (r0 + r) * NEIN + 1536 + h * 128 + ch * 8);
                float x[8] = {bflo(raw.x), bfhi(raw.x), bflo(raw.y), bfhi(raw.y), bflo(raw.z), bfhi(raw.z), bflo(raw.w), bfhi(raw.w)};
                float s = 0.f;
#pragma unroll
                for (int e = 0; e < 8; ++e) s += x[e];
                s += shfl_x(s, 1, lane); s += shfl_x(s, 2, lane); s += shfl_x(s, 4, lane); s += shfl_x(s, 8, lane);
                const float mean = s * (1.0f / 128.0f); float qq = 0.f;
#pragma unroll
                for (int e = 0; e < 8; ++e) { x[e] -= mean; qq += x[e] * x[e]; }
                qq += shfl_x(qq, 1, lane); qq += shfl_x(qq, 2, lane); qq += shfl_x(qq, 4, lane); qq += shfl_x(qq, 8, lane);
                const float rs = rsqrtf(qq * (1.0f / 128.0f) + EPS);
                u32x4 o; o.x = pk2(x[0] * rs, x[1] * rs); o.y = pk2(x[2] * rs, x[3] * rs); o.z = pk2(x[4] * rs, x[5] * rs); o.w = pk2(x[6] * rs, x[7] * rs);
                *(LAS u32x4*)(X + r * XRS + ch * 16) = o; }
            __syncthreads();
            f32x4 acc[1][8]; zero_acc<1>(acc);
            lm_core<1, 4>(apg, X, acc, lane);
            const int t = 16 * w + i16; const float bias = gb[h * 128 + t];
            const bf16_t* urow = PZ + (r0 + t) * NEIN + 1024 + h * 128; bf16_t* orow = Y + (r0 + t) * D + 512 + h * 128;
#pragma unroll
            for (int nt = 0; nt < 8; ++nt) { const int n = 16 * nt + 4 * q; const u32x2 uu = *(const u32x2*)(urow + n); const f32x4 a = acc[0][nt];
                u32x2 o; o.x = pk2(bflo(uu.x) * (a[0] + bias), bfhi(uu.x) * (a[1] + bias)); o.y = pk2(bflo(uu.y) * (a[2] + bias), bfhi(uu.y) * (a[3] + bias)); *(u32x2*)(orow + n) = o; }
            __syncthreads();
        }
        WQ_NEXT(it, wq, slot, F.G);
    }
}

constexpr int S2_KT = 0, S2_QT = 36864, S2_V = 73728, S2_SC = 110592, S2_EB = 120832, S2_EBL = 122880, S2_RED = 124928, S2_END = 129024;
static_assert(S2_END <= MISC_OFF, "scan LDS");
constexpr int SCRS = 80;
template <bool NEEDQ>
__device__ __forceinline__ void half_prep(const Ctx& F, const bf16_t* P5, size_t hrow, bool rev, int h, int dir) {
    const int tid = F.tid, ck = F.wave >> 1, dk = ((F.wave & 1) << 6) + F.lane; LAS unsigned char* L = F.lds;
#pragma unroll
    for (int it = 0; it < 4; ++it) { const int idx = tid + 512 * it, p = idx >> 4, ch = idx & 15; const size_t r = hrow + (rev ? 127 - p : p); const bf16_t* rp = P5 + ((size_t)h * MT + r) * 640 + ch * 8;
        *(LAS u32x4*)(L + S2_KT + p * XRS + ch * 16) = *(const u32x4*)(rp + (2 + dir) * 128);
        if (NEEDQ) *(LAS u32x4*)(L + S2_QT + p * XRS + ch * 16) = *(const u32x4*)(rp);
        *(LAS u32x4*)(L + S2_V + p * XRS + ch * 16) = *(const u32x4*)(rp + 4 * 128); }
    __syncthreads();
    float b = 0.f; LAS unsigned char* kt = L + S2_KT + (32 * ck) * XRS + dk * 2; LAS unsigned char* qt = L + S2_QT + (32 * ck) * XRS + dk * 2;
    bf16_t lfr[32], qr[32];
#pragma unroll
    for (int i = 0; i < 32; ++i) { lfr[i] = *(const LAS bf16_t*)(kt + i * XRS); if (NEEDQ) qr[i] = *(const LAS bf16_t*)(qt + i * XRS); }
    __builtin_amdgcn_sched_barrier(0);
#pragma unroll
    for (int i = 0; i < 32; ++i) { const float lf = bf2f(lfr[i]); b += lf;
        const float kk = (1.0f - __expf(lf)) * __expf(fminf(-b, 80.0f));
        *(LAS bf16_t*)(kt + i * XRS) = (bf16_t)f2bf(kk);
        if (NEEDQ) *(LAS bf16_t*)(qt + i * XRS) = (bf16_t)f2bf(bf2f(qr[i]) * __expf(b)); }
    ((LAS float*)(L + S2_EB))[ck * 128 + dk] = __expf(b);
    ((LAS float*)(L + S2_EBL))[ck * 128 + dk] = b;
}
__device__ __forceinline__ void state_update(const Ctx& F, f32x4 (&st)[8], int ck) {
    LAS unsigned char* L = F.lds; const int lane = F.lane, i16 = lane & 15, q = lane >> 4, w = F.wave;
    const int roff = (32 * ck + 8 * q + (i16 >> 2)) * XRS + 8 * (i16 & 3);
    s16x4 vlo = __builtin_amdgcn_ds_read_tr16_b64_v4i16((LAS s16x4*)(L + S2_V + roff + w * 32));
    s16x4 vhi = __builtin_amdgcn_ds_read_tr16_b64_v4i16((LAS s16x4*)(L + S2_V + roff + w * 32 + 4 * XRS));
    s16x4 klo[8], khi[8]; f32x4 eb[8];
#pragma unroll
    for (int kb = 0; kb < 8; ++kb) {
        klo[kb] = __builtin_amdgcn_ds_read_tr16_b64_v4i16((LAS s16x4*)(L + S2_KT + roff + kb * 32));
        khi[kb] = __builtin_amdgcn_ds_read_tr16_b64_v4i16((LAS s16x4*)(L + S2_KT + roff + kb * 32 + 4 * XRS)); }
#pragma unroll
    for (int kb = 0; kb < 8; ++kb) eb[kb] = *(const LAS f32x4*)(L + S2_EB + (ck * 128 + 16 * kb + 4 * q) * 4);
    __builtin_amdgcn_sched_barrier(0);
    const bf16x8 vf = __builtin_shufflevector(vlo, vhi, 0, 1, 2, 3, 4, 5, 6, 7);
#pragma unroll
    for (int kb = 0; kb < 8; ++kb) st[kb] = __builtin_amdgcn_mfma_f32_16x16x32_bf16(__builtin_shufflevector(klo[kb], khi[kb], 0, 1, 2, 3, 4, 5, 6, 7), vf, st[kb], 0, 0, 0);
#pragma unroll
    for (int kb = 0; kb < 8; ++kb) st[kb] = st[kb] * eb[kb];
}
__device__ __forceinline__ void state_load(const float* src, f32x4 (&st)[8], int w, int lane) {
#pragma unroll
    for (int kb = 0; kb < 8; ++kb)
#pragma unroll
        for (int rg = 0; rg < 4; ++rg) st[kb][rg] = src ? src[((w * 8 + kb) * 4 + rg) * 64 + lane] : 0.f;
}
__device__ __forceinline__ void state_store(float* dst, const f32x4 (&st)[8], int w, int lane) {
#pragma unroll
    for (int kb = 0; kb < 8; ++kb)
#pragma unroll
        for (int rg = 0; rg < 4; ++rg) dst[((w * 8 + kb) * 4 + rg) * 64 + lane] = st[kb][rg];
}
__device__ __forceinline__ void scan_pass1_item(const Ctx& F, const bf16_t* P5, int b, int h, int dir, int seg, float* SST, float* EG) {
    const int chain = (b * 8 + h) * 2 + dir; const size_t rowb = (size_t)b * TL + (size_t)seg * SEGL;
    f32x4 st[8]; state_load(nullptr, st, F.wave, F.lane);
    float gacc = 0.f;
    for (int hs = 0; hs < 2; ++hs) {
        const size_t hrow = rowb + 128 * (dir ? 1 - hs : hs);
        half_prep<false>(F, P5, hrow, dir != 0, h, dir);
        __syncthreads();
        if (F.tid < 128) { const LAS float* ebl = (const LAS float*)(F.lds + S2_EBL); gacc += (ebl[F.tid] + ebl[128 + F.tid]) + (ebl[256 + F.tid] + ebl[384 + F.tid]); }
#pragma unroll 1
        for (int ck = 0; ck < 4; ++ck) { state_update(F, st, ck); __builtin_amdgcn_sched_barrier(0); }
        __syncthreads();
    }
    state_store(SST + ((size_t)chain * NSEG + seg) * 16384, st, F.wave, F.lane);
    if (F.tid < 128) EG[((size_t)chain * NSEG + seg) * 128 + F.tid] = __expf(gacc);
}
__device__ __forceinline__ void half_scores(const Ctx& F) {
    LAS unsigned char* L = F.lds; const int lane = F.lane, i16 = lane & 15, q = lane >> 4, w = F.wave, ck = w >> 1, u = w & 1;
#pragma unroll
    for (int tt = 0; tt < 2; ++tt) {
        const int ti = u == 0 ? tt : 1 - tt, si = u == 0 ? tt : tt;
        f32x4 sc = (f32x4){0.f, 0.f, 0.f, 0.f};
        if (si <= ti) {
#pragma unroll
            for (int ks = 0; ks < 4; ++ks) { const bf16x8 a = *(const LAS bf16x8*)(L + S2_QT + (32 * ck + 16 * ti + i16) * XRS + (32 * ks + 8 * q) * 2); const bf16x8 bb = *(const LAS bf16x8*)(L + S2_KT + (32 * ck + 16 * si + i16) * XRS + (32 * ks + 8 * q) * 2);
                sc = __builtin_amdgcn_mfma_f32_16x16x32_bf16(a, bb, sc, 0, 0, 0); }
        }
#pragma unroll
        for (int rg = 0; rg < 4; ++rg) { const int t = 16 * ti + 4 * q + rg, sidx = 16 * si + i16; *(LAS bf16_t*)(L + S2_SC + (32 * ck + t) * SCRS + sidx * 2) = (bf16_t)f2bf(sidx <= t ? sc[rg] : 0.f); }
    }
}
__device__ __forceinline__ void chunk_out(const Ctx& F, const f32x4 (&st)[8], int ck, f32x4 (&o)[2]) {
    LAS unsigned char* L = F.lds; const int lane = F.lane, i16 = lane & 15, q = lane >> 4, w = F.wave;
    const int roff = (32 * ck + 8 * q + (i16 >> 2)) * XRS + 8 * (i16 & 3);
    u32x2 qlo[4][2], qhi[4][2];
#pragma unroll
    for (int ks = 0; ks < 4; ++ks)
#pragma unroll
        for (int ti = 0; ti < 2; ++ti) { const LAS unsigned char* qrow = L + S2_QT + (32 * ck + 16 * ti + i16) * XRS + (32 * ks + 4 * q) * 2; qlo[ks][ti] = *(const LAS u32x2*)(qrow); qhi[ks][ti] = *(const LAS u32x2*)(qrow + 32); }
    s16x4 vlo = __builtin_amdgcn_ds_read_tr16_b64_v4i16((LAS s16x4*)(L + S2_V + roff + w * 32));
    s16x4 vhi = __builtin_amdgcn_ds_read_tr16_b64_v4i16((LAS s16x4*)(L + S2_V + roff + w * 32 + 4 * XRS));
    bf16x8 pf[2];
#pragma unroll
    for (int ti = 0; ti < 2; ++ti) pf[ti] = *(const LAS bf16x8*)(L + S2_SC + (32 * ck + 16 * ti + i16) * SCRS + (8 * q) * 2);
    bf16x8 sf[4];
#pragma unroll
    for (int ks = 0; ks < 4; ++ks) { u32x4 sp; sp.x = pk2(st[2 * ks][0], st[2 * ks][1]); sp.y = pk2(st[2 * ks][2], st[2 * ks][3]); sp.z = pk2(st[2 * ks + 1][0], st[2 * ks + 1][1]); sp.w = pk2(st[2 * ks + 1][2], st[2 * ks + 1][3]); sf[ks] = __builtin_bit_cast(bf16x8, sp); }
    __builtin_amdgcn_sched_barrier(0);
    o[0] = (f32x4){0.f, 0.f, 0.f, 0.f}; o[1] = (f32x4){0.f, 0.f, 0.f, 0.f};
#pragma unroll
    for (int ks = 0; ks < 4; ++ks)
#pragma unroll
        for (int ti = 0; ti < 2; ++ti) { u32x4 qp; qp.x = qlo[ks][ti].x; qp.y = qlo[ks][ti].y; qp.z = qhi[ks][ti].x; qp.w = qhi[ks][ti].y;
            o[ti] = __builtin_amdgcn_mfma_f32_16x16x32_bf16(sf[ks], __builtin_bit_cast(bf16x8, qp), o[ti], 0, 0, 0); }
    const bf16x8 vf = __builtin_shufflevector(vlo, vhi, 0, 1, 2, 3, 4, 5, 6, 7);
#pragma unroll
    for (int ti = 0; ti < 2; ++ti) o[ti] = __builtin_amdgcn_mfma_f32_16x16x32_bf16(vf, pf[ti], o[ti], 0, 0, 0);
}
__device__ __forceinline__ void scan_pass3_item(const Ctx& F, const bf16_t* P5, size_t rowb, int h, const float* sin_f, const float* sin_b, float* fin_f, float* fin_b, const float* gain, bf16_t* OFT, bf16_t* Y, bool writey) {
    LAS unsigned char* L = F.lds; int lane = F.lane; asm volatile("" : "+v"(lane));
    const int i16 = lane & 15, q = lane >> 4, w = F.wave;
    const int colo = h * 128 + 16 * w + 4 * q;
    f32x4 st[8];
    state_load(sin_f, st, w, lane);
    for (int hs = 0; hs < 2; ++hs) {
        const size_t hrow = rowb + 128 * hs;
        half_prep<true>(F, P5, hrow, false, h, 0);
        __syncthreads();
        half_scores(F);
        __syncthreads();
#pragma unroll 1
        for (int ck = 0; ck < 4; ++ck) { f32x4 o[2]; chunk_out(F, st, ck, o);
#pragma unroll
            for (int ti = 0; ti < 2; ++ti) { const size_t r = hrow + 32 * ck + 16 * ti + i16; u32x2 pkd; pkd.x = pk2(o[ti][0], o[ti][1]); pkd.y = pk2(o[ti][2], o[ti][3]); *(u32x2*)(OFT + r * D + colo) = pkd; }
            __builtin_amdgcn_sched_barrier(0);
            state_update(F, st, ck);
            __builtin_amdgcn_sched_barrier(0); }
        __syncthreads();
    }
    if (fin_f) state_store(fin_f, st, w, lane);
    state_load(sin_b, st, w, lane);
    const f32x4 gv = *(const f32x4*)(gain + colo);
    for (int hs = 0; hs < 2; ++hs) {
        const size_t hrow = rowb + 128 * (1 - hs);
        half_prep<true>(F, P5, hrow, true, h, 1);
        __syncthreads();
        half_scores(F);
        __syncthreads();
        LAS float* RED = (LAS float*)(L + S2_RED);
        u32x2 fc[2];
#pragma unroll
        for (int ti = 0; ti < 2; ++ti) fc[ti] = *(const u32x2*)(OFT + (hrow + 127 - (16 * ti + i16)) * D + colo);
#pragma unroll 1
        for (int ck = 0; ck < 4; ++ck) { u32x2 fn[2];
            const int ckn = ck < 3 ? ck + 1 : 3;
#pragma unroll
            for (int ti = 0; ti < 2; ++ti) fn[ti] = *(const u32x2*)(OFT + (hrow + 127 - (32 * ckn + 16 * ti + i16)) * D + colo);
            f32x4 o[2]; chunk_out(F, st, ck, o);
#pragma unroll
            for (int ti = 0; ti < 2; ++ti) { const int p = 32 * ck + 16 * ti + i16; const size_t r = hrow + 127 - p; const u32x2 f = fc[ti];
                o[ti][0] += bflo(f.x); o[ti][1] += bfhi(f.x); o[ti][2] += bflo(f.y); o[ti][3] += bfhi(f.y);
                float ss = (o[ti][0] * o[ti][0] + o[ti][1] * o[ti][1]) + (o[ti][2] * o[ti][2] + o[ti][3] * o[ti][3]);
                ss += shfl_x(ss, 16, lane); ss += shfl_x(ss, 32, lane);
                if (q == 0) RED[w * 128 + p] = ss;
                u32x2 pkd; pkd.x = pk2(o[ti][0], o[ti][1]); pkd.y = pk2(o[ti][2], o[ti][3]); *(u32x2*)(OFT + r * D + colo) = pkd; }
            fc[0] = fn[0]; fc[1] = fn[1];
            __builtin_amdgcn_sched_barrier(0);
            state_update(F, st, ck);
            __builtin_amdgcn_sched_barrier(0); }
        __syncthreads();
        if (writey) {
#pragma unroll
            for (int ck = 0; ck < 4; ++ck)
#pragma unroll
                for (int ti = 0; ti < 2; ++ti) { const int p = 32 * ck + 16 * ti + i16; float tot = 0.f;
#pragma unroll
                    for (int ww = 0; ww < 8; ++ww) tot += RED[ww * 128 + p];
                    const float rs = rsqrtf(tot * (1.0f / 128.0f) + EPS); const size_t r = hrow + 127 - p;
                    const u32x2 f = *(const u32x2*)(OFT + r * D + colo); const u32x2 sg = *(const u32x2*)(P5 + ((size_t)h * MT + r) * 640 + 128 + 16 * w + 4 * q);
                    u32x2 y; y.x = pk2(bflo(f.x) * rs * gv[0] * bflo(sg.x), bfhi(f.x) * rs * gv[1] * bfhi(sg.x)); y.y = pk2(bflo(f.y) * rs * gv[2] * bflo(sg.y), bfhi(f.y) * rs * gv[3] * bfhi(sg.y));
                    *(u32x2*)(Y + r * D + colo) = y; }
        }
        __syncthreads();
    }
    if (fin_b) state_store(fin_b, st, w, lane);
}
__device__ __forceinline__ void scan_carry(const Ctx& F) {
    float* SST = (float*)(F.ws + WS_SST); const float* EG = (const float*)(F.ws + WS_EG); const float* S0 = (const float*)(F.ws + WS_S0);
    const int gt = F.bid * 512 + F.tid, NGT = F.G * 512;
    for (int idx = gt; idx < NCHAIN * 16384; idx += NGT) {
        const int chain = idx >> 14, e = idx & 16383, dir = chain & 1;
        const int lanee = e & 63, rg = (e >> 6) & 3, kb = (e >> 8) & 7; const int dk = 16 * kb + 4 * (lanee >> 4) + rg;
        float cur = S0[(size_t)chain * 16384 + e];
        float* base = SST + (size_t)chain * NSEG * 16384 + e; const float* eg = EG + (size_t)chain * NSEG * 128 + dk;
        for (int s0 = 0; s0 < NSEG; s0 += 8) {
            float tmp[8], gg[8];
#pragma unroll
            for (int i = 0; i < 8; ++i) { const int seg = dir ? NSEG - 1 - (s0 + i) : s0 + i; tmp[i] = base[(size_t)seg * 16384]; gg[i] = eg[seg * 128]; }
#pragma unroll
            for (int i = 0; i < 8; ++i) { const int seg = dir ? NSEG - 1 - (s0 + i) : s0 + i; base[(size_t)seg * 16384] = cur; cur = gg[i] * cur + tmp[i]; }
        }
    }
}

__device__ __forceinline__ void moe_slots(const Ctx& F, int nrows) {
    const int tid = F.tid; const int nitems = F.NGW;
    const RowPart rp = row_part(F.NGW, nrows);
    const int* cnt = (const int*)(F.ws + WS_CNT); const int* tope = (const int*)(F.ws + WS_TOPE); const int* rank = (const int*)(F.ws + WS_RANK);
    int* slotrow = (int*)(F.ws + WS_SLOTROW); int* slotdst = (int*)(F.ws + WS_SLOTDST); int* tilex = (int*)(F.ws + WS_TILEX); int* slotof = (int*)(F.ws + WS_SLOTOF);
    LAS int* pre = (LAS int*)F.lds;
    LAS int* tsum = (LAS int*)(F.lds + 69632);
    LAS int* ebase = (LAS int*)(F.lds + 69632 + 16384);
    const int IPT = (nitems + 511) / 512;
    int loc[8] = {0, 0, 0, 0, 0, 0, 0, 0};
    for (int i = 0; i < IPT; ++i) { const int it = tid * IPT + i; if (it < nitems) {
#pragma unroll
        for (int e = 0; e < 8; ++e) loc[e] += cnt[it * 8 + e]; } }
#pragma unroll
    for (int e = 0; e < 8; ++e) tsum[tid * 8 + e] = loc[e];
    __syncthreads();
    if (tid < 8) { int run = 0; for (int t = 0; t < 512; ++t) { const int v = tsum[t * 8 + tid]; tsum[t * 8 + tid] = run; run += v; } ebase[8 + tid] = run; }
    __syncthreads();
    if (tid == 0) { int b = 0; for (int e = 0; e < 8; ++e) { ebase[e] = b; b += (ebase[8 + e] + 255) & ~255; } ebase[16] = b / 256; }
    { int run[8];
#pragma unroll
      for (int e = 0; e < 8; ++e) run[e] = tsum[tid * 8 + e];
      for (int i = 0; i < IPT; ++i) { const int it = tid * IPT + i; if (it < nitems) {
#pragma unroll
          for (int e = 0; e < 8; ++e) { pre[it * 8 + e] = run[e]; run[e] += cnt[it * 8 + e]; } } } }
    __syncthreads();
    for (int r = F.bid * 512 + tid; r < nrows; r += F.G * 512) {
        const int ch = row_chunk_of(rp, r);
#pragma unroll
        for (int kk = 0; kk < 2; ++kk) { const int e = tope[2 * r + kk]; const int slot = ebase[e] + pre[ch * 8 + e] + rank[2 * r + kk]; slotrow[slot] = r; slotdst[slot] = 2 * r + kk; slotof[2 * r + kk] = slot; }
    }
    if (F.bid == 0) {
        const int ntiles = ebase[16];
        if (tid == 0) tilex[0] = ntiles;
        for (int e = 0; e < 8; ++e) { const int b0 = ebase[e], tot = ebase[8 + e], pad = (tot + 255) & ~255;
            for (int s = b0 + tot + tid; s < b0 + pad; s += 512) { slotrow[s] = 0; slotdst[s] = -1; }
            for (int t = b0 / 256 + tid; t < (b0 + pad) / 256; t += 512) tilex[16 + t] = e; }
    }
}

__global__ void __launch_bounds__(512, 2) fwd_kernel(Args args) {
    extern __shared__ __attribute__((aligned(16))) unsigned char lds_raw[];
    Ctx F;
    F.lds = (LAS unsigned char*)lds_raw; F.tid = threadIdx.x; F.lane = F.tid & 63; F.wave = __builtin_amdgcn_readfirstlane(F.tid >> 6);
    F.G = gridDim.x; F.bid = blockIdx.x; F.gw = F.bid * 8 + F.wave; F.NGW = F.G * 8;
    F.in = args.in; F.out = args.out; F.ws = args.ws;
    volatile LAS unsigned* MISC = (volatile LAS unsigned*)(F.lds + MISC_OFF);
    if (F.tid < 64) MISC[F.tid] = 0u;
    __syncthreads();
    const int lo = args.ph_lo, hi = args.ph_hi;
    XcdBarrier bar; bar.bar = (unsigned*)(F.ws + WS_CTL) + 4096; bar.x = 0; bar.st = nullptr;
    const bool multi = (hi - lo) > 1;
    if (multi) bar = xcd_barrier_post((unsigned*)(F.ws + WS_CTL) + 4096, MISC + 8);
#define IN(k) (lo <= (k) && (k) < hi)
#if defined(PROBE_TMASK)
    unsigned long long pt_last = __builtin_amdgcn_s_memrealtime(), pt_acc = 0ull;
#define PROBE_T(k) do { const unsigned long long now_ = __builtin_amdgcn_s_memrealtime(); if ((((unsigned long long)(PROBE_TMASK)) >> (k)) & 1ull) pt_acc += now_ - pt_last; pt_last = now_; } while (0)
#else
#define PROBE_T(k) do { } while (0)
#endif
#define SEAM(k) do { if (IN(k) && IN((k) + 1)) xcd_barrier(bar); PROBE_T(k); asm volatile("" : "+v"(F.tid), "+s"(F.ws), "+s"(F.out), "+s"(F.G)); F.NGW = F.G * 8; F.lane = F.tid & 63; F.wave = __builtin_amdgcn_readfirstlane(F.tid >> 6); F.gw = F.bid * 8 + F.wave; } while (0)

#define MODS_ ((float*)(F.ws + WS_MODS))
#define XC_ ((float*)(F.ws + WS_XC))
#define H_ ((bf16_t*)(F.ws + WS_H))
#define YE_ ((bf16_t*)(F.ws + WS_YE))

    if (IN(PH_P0)) for (int rep_ = 0; rep_ < NREP(18); ++rep_) { p0_prologue(F); }
#if defined(PROBE_SLEEP)
    if (IN(PH_P0)) { const unsigned long long t0 = __builtin_amdgcn_s_memrealtime(); while (__builtin_amdgcn_s_memrealtime() - t0 < (unsigned long long)PROBE_SLEEP * 100ull) __builtin_amdgcn_s_sleep(32); }
#endif
    SEAM(PH_P0);

#if defined(PROBE_GEMM)
    if (IN(PH_P0)) {
        pg8::Gemm g{H_, (const bf16_t*)(F.ws + WS_WINE), ML, NEIN, D, nullptr, nullptr, 0}; pg8::StaticOrder S; S.init(ML, NEIN, D, F.G, F.bid);
#if PROBE_GEMM == 1
        pg8::EpiEvenIn E{(bf16_t*)(F.ws + WS_UP)}; pg8::gemm_phase<pg8::EpiEvenIn, pg8::StaticOrder, true, false>(F.lds, g, S, E, F.tid);
#elif PROBE_GEMM == 2
        pg8::EpiNull E{(float*)(F.ws + WS_UP)}; pg8::gemm_phase<pg8::EpiNull, pg8::StaticOrder, true, false>(F.lds, g, S, E, F.tid);
#endif
        xcd_barrier(bar);
    }
#endif

    for (int lp = 0; lp < 2; ++lp) {
        const int pb = PH_PAIR0 + lp * NPL;
        const int le = 2 * lp, lo_ = 2 * lp + 1;
        const float* modE = MODS_ + (size_t)le * 3 * 6144; const float* modO = MODS_ + (size_t)lo_ * 3 * 6144;
        const float* xsl = lp == 0 ? F.in[I_X] : F.out; const float* xsc = lp == 0 ? F.in[I_CTX] : XC_;
        if (IN(pb + E1_NORM)) for (int rep_ = 0; rep_ < NREP(E1_NORM); ++rep_) {
            RowPass P{}; P.sl = xsl; P.sc = xsc; P.dl = F.out; P.dc = XC_; P.gain = F.in[I_NMIX] + le * D; P.shift = modE + 0 * D; P.scale = modE + 1 * D; P.H = H_; P.nrows = MT;
            if (lp == 0) row_pass<false, false, false>(F, P);
            else { P.YE = YE_; P.topp = (const float*)(F.ws + WS_TOPP); P.gatef = MODS_ + (size_t)(le - 1) * 3 * 6144 + 5 * D; P.slotof = (const int*)(F.ws + WS_SLOTOF); P.partm = (const float*)(F.ws + WS_PARTM); row_pass<true, false, false>(F, P); }
        }
        SEAM(pb + E1_NORM);
        if (IN(pb + E2_GIN)) for (int rep_ = 0; rep_ < NREP(E2_GIN); ++rep_) {
            pg8::Gemm g{H_, (const bf16_t*)(F.ws + WS_WINE) + (size_t)lp * NEIN * D, MT, NEIN, D, nullptr, nullptr, 0}; pg8::StaticOrder S; S.init(MT, NEIN, D, F.G, F.bid);
            pg8::EpiEvenIn E{(bf16_t*)(F.ws + WS_PZUV)};
            pg8::gemm_phase<pg8::EpiEvenIn, pg8::StaticOrder, true, false>(F.lds, g, S, E, F.tid);
        }
        SEAM(pb + E2_GIN);
        if (IN(pb + E3_FFTA)) for (int rep_ = 0; rep_ < NREP(E3_FFTA); ++rep_) fft_stage_a(F, (unsigned*)(F.ws + WS_CTL) + 8192 + 64 * (pb + E3_FFTA));
        SEAM(pb + E3_FFTA);
        if (IN(pb + E3_FFTC)) for (int rep_ = 0; rep_ < NREP(E3_FFTC); ++rep_) fft_stage_c_gmlp(F, lp, (unsigned*)(F.ws + WS_CTL) + 8192 + 64 * (pb + E3_FFTC));
        SEAM(pb + E3_FFTC);
        if (IN(pb + E4_GOUT)) for (int rep_ = 0; rep_ < NREP(E4_GOUT); ++rep_) {
            pg8::Gemm g{H_, (const bf16_t*)(F.ws + WS_WOUTE) + (size_t)lp * D * D, MT, D, D, nullptr, nullptr, 0}; pg8::ResOrder S; S.init(D, F.G, F.bid, true);
            pg8::EpiRes E{lp == 0 ? xsl : (const float*)F.out, F.out, modE + 2 * D, (float*)(F.ws + WS_PARTC)};
            pg8::gemm_phase<pg8::EpiRes, pg8::ResOrder, false, false>(F.lds, g, S, E, F.tid);
        }
        SEAM(pb + E4_GOUT);
        if (IN(pb + E5_NORM)) for (int rep_ = 0; rep_ < NREP(E5_NORM); ++rep_) {
            RowPass P{}; P.sl = F.out; P.sc = lp == 0 ? xsc : (const float*)XC_; P.dc = XC_; P.gain = F.in[I_NFFN] + le * D; P.shift = modE + 3 * D; P.scale = modE + 4 * D; P.H = H_; P.nrows = MT;
            P.part = (const float*)(F.ws + WS_PARTC); P.kpn = CTX_KP; P.pgate = modE + 2 * D;
            row_pass<false, false, false>(F, P);
        }
        SEAM(pb + E5_NORM);
        if (IN(pb + E6_UP)) for (int rep_ = 0; rep_ < NREP(E6_UP); ++rep_) {
            pg8::Gemm g{H_, (const bf16_t*)(F.ws + WS_W13) + (size_t)lp * NFF2 * D, MT, NFF2, D, nullptr, nullptr, 0}; pg8::StaticOrder S; S.init(MT, NFF2, D, F.G, F.bid);
            pg8::EpiSwiglu E{(bf16_t*)(F.ws + WS_HID), DFF};
            pg8::gemm_phase<pg8::EpiSwiglu, pg8::StaticOrder, true, false>(F.lds, g, S, E, F.tid);
        }
        SEAM(pb + E6_UP);
        if (IN(pb + E7_DOWN)) for (int rep_ = 0; rep_ < NREP(E7_DOWN); ++rep_) {
            pg8::Gemm g{(const bf16_t*)(F.ws + WS_HID), (const bf16_t*)(F.ws + WS_W2) + (size_t)lp * D * DFF, MT, D, DFF, nullptr, nullptr, 0}; pg8::ResOrder S; S.init(DFF, F.G, F.bid, true);
            pg8::EpiRes E{F.out, F.out, modE + 5 * D, (float*)(F.ws + WS_PARTC)};
            pg8::gemm_phase<pg8::EpiRes, pg8::ResOrder, false, false>(F.lds, g, S, E, F.tid);
        }
        SEAM(pb + E7_DOWN);
        const bool lastl = lp == 1;
        if (IN(pb + O1_NORM)) for (int rep_ = 0; rep_ < NREP(O1_NORM); ++rep_) {
            RowPass P{}; P.sl = F.out; P.sc = XC_; P.dc = XC_; P.gain = F.in[I_NMIX] + lo_ * D; P.shift = modO + 0 * D; P.scale = modO + 1 * D; P.H = H_; P.nrows = MT;
            P.part = (const float*)(F.ws + WS_PARTC); P.kpn = CTX_KP; P.pgate = modE + 5 * D;
            row_pass<false, false, false>(F, P);
        }
        SEAM(pb + O1_NORM);
        if (IN(pb + O2_GIN)) for (int rep_ = 0; rep_ < NREP(O2_GIN); ++rep_) {
            pg8::Gemm g{H_, (const bf16_t*)(F.ws + WS_WINO) + (size_t)lp * NREC * D, MT, NREC, D, nullptr, nullptr, 0}; pg8::StaticOrder S; S.init(MT, NREC, D, F.G, F.bid);
            pg8::EpiOddIn E{(bf16_t*)(F.ws + WS_P5), (const float*)(F.ws + WS_LB) + lp * 2048};
            pg8::gemm_phase<pg8::EpiOddIn, pg8::StaticOrder, true, false>(F.lds, g, S, E, F.tid);
        }
        SEAM(pb + O2_GIN);
        if (IN(pb + O3_SCAN1)) for (int rep_ = 0; rep_ < NREP(O3_SCAN1); ++rep_) {
            const bf16_t* P5 = (const bf16_t*)(F.ws + WS_P5); float* SST = (float*)(F.ws + WS_SST); float* EG = (float*)(F.ws + WS_EG); float* S0 = (float*)(F.ws + WS_S0);
            const float* gain = F.in[I_RNORM] + lp * D;
            unsigned* wq = (unsigned*)(F.ws + WS_CTL) + 8192 + 64 * (pb + O3_SCAN1); volatile LAS unsigned* slot = (volatile LAS unsigned*)(F.lds + MISC_OFF + 64);
            for (int it = F.bid; it < 16 + 2048 + MOE_CONV_ITEMS / 8; ) {
                asm volatile("" : "+v"(F.tid)); F.lane = F.tid & 63;
                int it2 = it;
                if (it >= 16) { const int y = it - 16; int cv = -1;
                    if (y < 4096) { if (y & 1) cv = y >> 1; else it2 = 16 + (y >> 1); } else cv = 2048 + (y - 4096);
                    if (cv >= 0) { moe_convert_item(F, lp, cv * 8 + F.wave); WQ_NEXT(it, wq, slot, F.G); continue; } }
                if (it2 < 16) { const int b = it2 >> 3, h = it2 & 7;
                    scan_pass3_item(F, P5, (size_t)ML + b * TCX, h, nullptr, nullptr, S0 + (size_t)((b * 8 + h) * 2 + 0) * 16384, S0 + (size_t)((b * 8 + h) * 2 + 1) * 16384, gain, YE_, H_, !lastl);
                } else { const int i2 = it2 - 16, seg = i2 & 63, dir = (i2 >> 6) & 1, h = (i2 >> 7) & 7, b = i2 >> 10;
                    scan_pass1_item(F, P5, b, h, dir, seg, SST, EG); }
                WQ_NEXT(it, wq, slot, F.G);
            }
        }
        SEAM(pb + O3_SCAN1);
        if (IN(pb + O4_CARRY)) for (int rep_ = 0; rep_ < NREP(O4_CARRY); ++rep_) { scan_carry(F); }
        SEAM(pb + O4_CARRY);
        if (IN(pb + O5_SCAN3)) for (int rep_ = 0; rep_ < NREP(O5_SCAN3); ++rep_) {
            const bf16_t* P5 = (const bf16_t*)(F.ws + WS_P5); const float* SST = (const float*)(F.ws + WS_SST);
            const float* gain = F.in[I_RNORM] + lp * D;
            for (int it = F.bid; it < 1024; it += F.G) { const int seg = it & 63, h = (it >> 6) & 7, b = it >> 9; const int ch0 = (b * 8 + h) * 2;
                asm volatile("" : "+v"(F.tid)); F.lane = F.tid & 63;
                scan_pass3_item(F, P5, (size_t)b * TL + (size_t)seg * SEGL, h, SST + ((size_t)ch0 * NSEG + seg) * 16384, SST + ((size_t)(ch0 + 1) * NSEG + seg) * 16384, nullptr, nullptr, gain, YE_, H_, true); }
        }
        SEAM(pb + O5_SCAN3);
        if (IN(pb + O6_GOUT)) for (int rep_ = 0; rep_ < NREP(O6_GOUT); ++rep_) {
            pg8::Gemm g{H_, (const bf16_t*)(F.ws + WS_WOUTO) + (size_t)lp * D * D, MT, D, D, nullptr, nullptr, 0}; pg8::ResOrder S; S.init(D, F.G, F.bid, !lastl);
            pg8::EpiRes E{F.out, F.out, modO + 2 * D, (float*)(F.ws + WS_PARTC)};
            pg8::gemm_phase<pg8::EpiRes, pg8::ResOrder, false, false>(F.lds, g, S, E, F.tid);
        }
        SEAM(pb + O6_GOUT);
        const int nrm = lastl ? ML : MT;
        if (IN(pb + O7_NORM)) for (int rep_ = 0; rep_ < NREP(O7_NORM); ++rep_) {
            RowPass P{}; P.sl = F.out; P.sc = XC_; P.gain = F.in[I_NFFN] + lo_ * D; P.shift = modO + 3 * D; P.scale = modO + 4 * D; P.H = H_; P.nrows = nrm;
            P.dc = XC_; P.part = lastl ? nullptr : (const float*)(F.ws + WS_PARTC); P.kpn = CTX_KP; P.pgate = modO + 2 * D;
            P.rw = F.in[I_RW] + (size_t)lp * D * NE; P.tope = (int*)(F.ws + WS_TOPE); P.toppo = (float*)(F.ws + WS_TOPP); P.rank = (int*)(F.ws + WS_RANK); P.cnt = (int*)(F.ws + WS_CNT);
            row_pass<false, true, false>(F, P);
        }
        SEAM(pb + O7_NORM);
        if (IN(pb + O8_SLOTS)) for (int rep_ = 0; rep_ < NREP(O8_SLOTS); ++rep_) moe_slots(F, nrm);
        SEAM(pb + O8_SLOTS);
        if (IN(pb + O9_MUP)) for (int rep_ = 0; rep_ < NREP(O9_MUP); ++rep_) {
            const int* tilex = (const int*)(F.ws + WS_TILEX); const int ntiles = tilex[0];
            pg8::Gemm g{H_, (const bf16_t*)(F.ws + WS_W13M), ntiles * 256, NEX2, D, (const int*)(F.ws + WS_SLOTROW), tilex + 16, (size_t)NEX2 * D}; pg8::StaticOrder S; S.init(ntiles * 256, NEX2, D, F.G, F.bid);
            pg8::EpiSwiglu E{(bf16_t*)(F.ws + WS_HIDM), DEX};
            pg8::gemm_phase<pg8::EpiSwiglu, pg8::StaticOrder, true, true>(F.lds, g, S, E, F.tid);
        }
        SEAM(pb + O9_MUP);
        if (IN(pb + O10_MDOWN)) for (int rep_ = 0; rep_ < NREP(O10_MDOWN); ++rep_) {
            const int* tilex = (const int*)(F.ws + WS_TILEX); const int ntiles = tilex[0];
            pg8::Gemm g{(const bf16_t*)(F.ws + WS_HIDM), (const bf16_t*)(F.ws + WS_W2M), ntiles * 256, D, DEX, nullptr, tilex + 16, (size_t)D * DEX}; pg8::MoeDownOrder S; S.init(ntiles, F.G, F.bid);
            pg8::EpiMoeDown E{YE_, (const int*)(F.ws + WS_SLOTDST), (float*)(F.ws + WS_PARTM)};
            pg8::gemm_phase<pg8::EpiMoeDown, pg8::MoeDownOrder, true, false>(F.lds, g, S, E, F.tid);
        }
        SEAM(pb + O10_MDOWN);
    }
    if (IN(PH_FINAL)) {
        RowPass P{}; P.sl = F.out; P.sc = XC_; P.dl = F.out; P.dc = XC_; P.gain = F.in[I_NOUT]; P.nrows = ML; P.YE = YE_; P.topp = (const float*)(F.ws + WS_TOPP); P.gatef = MODS_ + (size_t)3 * 3 * 6144 + 5 * D; P.fout = F.out; P.slotof = (const int*)(F.ws + WS_SLOTOF); P.partm = (const float*)(F.ws + WS_PARTM);
        row_pass<true, false, true>(F, P);
    }
    PROBE_T(PH_FINAL);
#if defined(PROBE_TMASK)
    if (F.bid == 0 && F.tid == 0) { const unsigned long long t0 = __builtin_amdgcn_s_memrealtime(); while (__builtin_amdgcn_s_memrealtime() - t0 < pt_acc * 4ull) __builtin_amdgcn_s_sleep(32); }
#endif
#undef IN
#undef SEAM
#undef MODS_
#undef XC_
#undef H_
#undef YE_
}

extern "C" void kernel_launch(void* const* d_in, const int* in_sizes, int n_in, void* d_out, int out_size, void* d_ws, size_t ws_size, hipStream_t stream) {
    static int grid = 0;
    if (grid == 0) {
        if (n_in != 24 || out_size != ML * D || ws_size < WS_END) { fprintf(stderr, "kernel_launch: unexpected problem (n_in %d, out %d, ws %zu < %zu)\n", n_in, out_size, ws_size, (size_t)WS_END); grid = -1; return; }
        int dev = 0, cus = 0, per_cu = 0;
        if (hipGetDevice(&dev) != hipSuccess || hipDeviceGetAttribute(&cus, hipDeviceAttributeMultiprocessorCount, dev) != hipSuccess) { grid = -1; return; }
        if (hipFuncSetAttribute((const void*)fwd_kernel, hipFuncAttributeMaxDynamicSharedMemorySize, LDS_BYTES) != hipSuccess) { fprintf(stderr, "kernel_launch: hipFuncSetAttribute failed\n"); grid = -1; return; }
        if (hipOccupancyMaxActiveBlocksPerMultiprocessor(&per_cu, (const void*)fwd_kernel, 512, LDS_BYTES) != hipSuccess || per_cu < 1) fprintf(stderr, "kernel_launch: occupancy query says %d\n", per_cu);
        (void)hipGetLastError();
        grid = cus;
    }
    if (grid < 0) return;
    (void)hipMemsetAsync((char*)d_ws + WS_CTL, 0, CTL_BYTES, stream);
    Args a{};
    for (int i = 0; i < 24; ++i) a.in[i] = (const float*)d_in[i];
    a.out = (float*)d_out; a.ws = (unsigned char*)d_ws;
#if PER_PHASE_LAUNCH
    for (int p = 0; p < NPHASE && p < PHASE_LIMIT; ++p) { a.ph_lo = p; a.ph_hi = p + 1; hipLaunchKernelGGL(fwd_kernel, dim3(grid), dim3(512), LDS_BYTES, stream, a); }
#else
    a.ph_lo = 0; a.ph_hi = NPHASE; hipLaunchKernelGGL(fwd_kernel, dim3(grid), dim3(512), LDS_BYTES, stream, a);
#endif
}
```

```cpp
#include <hip/hip_runtime.h>
#include <cstdio>
#include <cstdint>

#ifndef PER_PHASE_LAUNCH
#define PER_PHASE_LAUNCH 0
#endif
#ifndef CTX_KP
#define CTX_KP 4
#endif
#ifndef REP_MASK
#define REP_MASK 0
#endif
#define NREP(x) (((REP_MASK >> (x)) & 1) ? 2 : 1)
#ifndef PHASE_LIMIT
#define PHASE_LIMIT 100
#endif
#ifndef P0_MASK
#define P0_MASK 63
#endif
#ifndef P0_T
#define P0_T 127
#endif

#define LAS __attribute__((address_space(3)))
typedef unsigned short bf16_t;
typedef short bf16x8 __attribute__((ext_vector_type(8)));
typedef short s16x4 __attribute__((ext_vector_type(4)));
typedef float f32x4 __attribute__((ext_vector_type(4)));
typedef float f32x2 __attribute__((ext_vector_type(2)));
typedef unsigned u32x4 __attribute__((ext_vector_type(4)));
typedef unsigned u32x2 __attribute__((ext_vector_type(2)));

constexpr int D = 1024, TL = 16384, ML = 32768, TCX = 256, MC = 512, MT = 33280;
constexpr int NEIN = 2048, DFF = 2816, NFF2 = 5632, NREC = 5120, DEX = 3584, NEX2 = 7168, NE = 8;
constexpr int NSEG = 64, SEGL = 256, CH = 32, NCHAIN = 32;
constexpr int MAXTILES = 268, NITEM16 = MT / 16;
constexpr float EPS = 1e-6f;

constexpr size_t MiB = 1u << 20, KiB = 1u << 10;
constexpr size_t WS_CTL = 0, CTL_BYTES = 1 * MiB;
constexpr size_t WS_MODS = 1 * MiB, WS_LB = 1 * MiB + 512 * KiB;
constexpr size_t WS_FA = 2 * MiB, WS_FC = 2 * MiB + 128 * KiB, WS_FX = 2 * MiB + 256 * KiB, WS_GW = 2 * MiB + 512 * KiB;
constexpr size_t WS_XC = 3 * MiB;
constexpr size_t WS_TOPE = 5 * MiB, WS_TOPP = 5 * MiB + 512 * KiB, WS_RANK = 6 * MiB, WS_CNT = 6 * MiB + 512 * KiB, WS_TILEX = 6 * MiB + 768 * KiB, WS_SLOTROW = 7 * MiB, WS_SLOTDST = 7 * MiB + 512 * KiB;
constexpr size_t WS_WINE = 8 * MiB, WS_WOUTE = 16 * MiB, WS_WINO = 20 * MiB, WS_WOUTO = 40 * MiB, WS_W13 = 44 * MiB, WS_W2 = 66 * MiB;
constexpr size_t WS_W13M = 77 * MiB, WS_W2M = 189 * MiB;
constexpr size_t WS_H = 245 * MiB, WS_YE = 310 * MiB, WS_BIG = 440 * MiB;
constexpr size_t WS_PZUV = WS_BIG, WS_UP = WS_BIG + 130 * MiB, WS_HID = WS_BIG, WS_P5 = WS_BIG, WS_SST = WS_BIG + 325 * MiB, WS_EG = WS_BIG + 453 * MiB, WS_S0 = WS_BIG + 454 * MiB, WS_HIDM = WS_BIG;
constexpr size_t WS_PARTC = WS_BIG + 469 * MiB, WS_PARTM = WS_PARTC + 8 * MiB;
constexpr size_t WS_SLOTOF = 1 * MiB + 576 * KiB;
constexpr size_t WS_XB = WS_PARTM + 48 * MiB;
constexpr size_t WS_END = WS_XB + 65 * MiB;
static_assert(WS_END <= (size_t)1032 * MiB, "workspace must stay below the sum of the input sizes (1032.7 MiB)");
static_assert(WS_W2 + (size_t)2 * D * DFF * 2 <= WS_W13M, "static weights");
static_assert(WS_W2M + (size_t)NE * D * DEX * 2 <= WS_H && WS_H + (size_t)MT * D * 2 <= WS_YE && WS_YE + (size_t)MT * 2 * D * 2 <= WS_BIG, "ws map");
static_assert((size_t)MAXTILES * 256 * DEX * 2 <= 469 * MiB && (size_t)MT * NREC * 2 <= 325 * MiB && (size_t)MT * NEIN * 2 <= 130 * MiB, "big region");

constexpr int LDS_BYTES = 147456, MISC_OFF = 147456 - 256;
constexpr int XRS = 288;

typedef __bf16 bf16x2_t __attribute__((ext_vector_type(2)));
__device__ __forceinline__ unsigned f2bf(float f) { return (unsigned)__builtin_bit_cast(unsigned short, (__bf16)f); }
__device__ __forceinline__ unsigned pk2(float lo, float hi) { return __builtin_bit_cast(unsigned, __builtin_convertvector((f32x2){lo, hi}, bf16x2_t)); }
__device__ __forceinline__ float bf2f(unsigned short b) { return __builtin_bit_cast(float, (unsigned)b << 16); }
__device__ __forceinline__ float bflo(unsigned w) { return __builtin_bit_cast(float, w << 16); }
__device__ __forceinline__ float bfhi(unsigned w) { return __builtin_bit_cast(float, w & 0xffff0000u); }
__device__ __forceinline__ float shfl_x(float v, int o, int lane) { return __builtin_bit_cast(float, __builtin_amdgcn_ds_bpermute((lane ^ o) << 2, __builtin_bit_cast(int, v))); }
__device__ __forceinline__ float wave_sum(float v, int lane) {
#pragma unroll
    for (int o = 1; o < 64; o <<= 1) v += shfl_x(v, o, lane);
    return v;
}
__device__ __forceinline__ float siluf(float a) { return a * __builtin_amdgcn_rcpf(1.0f + __expf(-a)); }
#define WQ_NEXT(it, ctr, slot, G) do { __syncthreads(); if (threadIdx.x == 0) *(slot) = (unsigned)(G) + __hip_atomic_fetch_add((ctr), 1u, __ATOMIC_RELAXED, __HIP_MEMORY_SCOPE_AGENT); __syncthreads(); (it) = (int)*(slot); } while (0)
#define LDS_WAIT() asm volatile("s_waitcnt lgkmcnt(0)" ::: "memory")
#define VM_WAIT() asm volatile("s_waitcnt vmcnt(0)" ::: "memory")

#define XB_TMO      128
#define XB_XCNT(j)  (256  + 64 * (j))
#define XB_XSUB(j)  (1280 + 64 * (j))
#define XB_XGEN(j)  (2304 + 64 * (j))
#define XB_TOP      3328
#define XB_TOPGEN   3392
#define XCD_BAR_WORDS 3456
#define XB_SPIN_CAP (1u << 18)
__device__ __forceinline__ unsigned xb_ld(unsigned* p)              { return __hip_atomic_load(p, __ATOMIC_RELAXED, __HIP_MEMORY_SCOPE_AGENT); }
__device__ __forceinline__ unsigned xb_add(unsigned* p, unsigned v) { return __hip_atomic_fetch_add(p, v, __ATOMIC_RELAXED, __HIP_MEMORY_SCOPE_AGENT); }
__device__ __forceinline__ unsigned xb_xcc_id() { return (unsigned)__builtin_amdgcn_s_getreg((3 << 11) | 20) & 0xFu; }
#define XB_SPIN(cond, bar) do { unsigned _sp = 0; while (cond) { __builtin_amdgcn_s_sleep(1); \
    if ((++_sp & 255u) == 0u) { if (xb_ld(&(bar)[XB_TMO])) break; if (_sp > XB_SPIN_CAP) { atomicAdd(&(bar)[XB_TMO], 1u); break; } } } } while (0)
struct XcdBarrier { unsigned* bar; unsigned x; volatile LAS unsigned* st; };
__device__ __forceinline__ XcdBarrier xcd_barrier_post(unsigned* bar, volatile LAS unsigned* st) {
    XcdBarrier b; b.bar = bar; b.x = xb_xcc_id(); b.st = st;
    if (threadIdx.x == 0) (void)xb_add(&bar[XB_XCNT(b.x)], 1u);
    return b;
}
__device__ __forceinline__ void xcd_barrier_complete(unsigned* bar, unsigned x, unsigned& nloc, unsigned& nx) {
    const unsigned G = gridDim.x * gridDim.y * gridDim.z;
    unsigned sum, cnt, mine, sp = 0u;
    for (;;) {
        sum = 0u; cnt = 0u; mine = 0u;
#pragma unroll
        for (unsigned j = 0; j < 16; ++j) { const unsigned c = xb_ld(&bar[XB_XCNT(j)]); sum += c; cnt += (c > 0u) ? 1u : 0u; mine = (j == x) ? c : mine; }
        if (sum == G) break;
        __builtin_amdgcn_s_sleep(1);
        if ((++sp & 255u) == 0u) { if (xb_ld(&bar[XB_TMO])) break; if (sp > XB_SPIN_CAP) { atomicAdd(&bar[XB_TMO], 1u); break; } }
    }
    nloc = mine > 0u ? mine : 1u; nx = cnt > 0u ? cnt : 1u;
}
__device__ __forceinline__ void xcd_barrier(const XcdBarrier& b) {
    asm volatile("s_waitcnt vmcnt(0)" ::: "memory");
    __syncthreads();
    if (threadIdx.x == 0) {
        unsigned* bar = b.bar;
        __builtin_amdgcn_s_waitcnt(0);
        unsigned nloc = b.st[0], nx = b.st[1];
        if (nloc == 0u) { xcd_barrier_complete(bar, b.x, nloc, nx); b.st[0] = nloc; b.st[1] = nx; }
        const unsigned old = xb_add(&bar[XB_XSUB(b.x)], 1u);
        const unsigned gen = old / nloc;
        if (old + 1u == (gen + 1u) * nloc) {
            __builtin_amdgcn_fence(__ATOMIC_RELEASE, "agent");
            asm volatile("s_waitcnt vmcnt(0)" ::: "memory");
            const unsigned og = xb_add(&bar[XB_TOP], 1u);
            const unsigned tg = og / nx;
            if (og + 1u == (tg + 1u) * nx) xb_add(&bar[XB_TOPGEN], 1u);
            else XB_SPIN(xb_ld(&bar[XB_TOPGEN]) == tg, bar);
            __builtin_amdgcn_fence(__ATOMIC_ACQUIRE, "agent");
            xb_add(&bar[XB_XGEN(b.x)], 1u);
            asm volatile("s_waitcnt vmcnt(0)" ::: "memory");
        } else {
            XB_SPIN(xb_ld(&bar[XB_XGEN(b.x)]) == gen, bar);
            __builtin_amdgcn_fence(__ATOMIC_ACQUIRE, "agent");
            asm volatile("s_waitcnt vmcnt(0)" ::: "memory");
        }
    }
    __syncthreads();
}

namespace pg8 {
constexpr int BM = 256, BK = 64, HALF = 128, HTB = HALF * BK * 2, STAGE_BYTES = 8 * HTB, NXCD = 8, WGM = 8;
__host__ __device__ __forceinline__ int lds_byte(int r, int c) { const int st = (r >> 4) * 2 + (c >> 5), rr = r & 15, cc = c & 31, ob = rr * 64 + cc * 2; return st * 1024 + (ob ^ (((ob >> 9) & 1) << 5)); }
__host__ __device__ __forceinline__ void stage_rc(int b, int& R, int& C) { const int st = b / 1024, sb = b % 1024, swz = sb ^ (((sb >> 9) & 1) << 5); R = (st >> 1) * 16 + swz / 64; C = (st & 1) * 32 + (swz % 64) / 2; }
__host__ __device__ __forceinline__ int perm32(int rho) { const int n = rho >> 4, i = rho & 15; return 8 * (i >> 2) + 4 * n + (i & 3); }
struct Unit { int pm, pn, kt0, nt, kp; };
struct Gemm { const bf16_t* A; const bf16_t* Bt; int M, N, K; const int* arow; const int* grp; size_t gstride; };
struct StaticOrder {
    int nM, nN, nwg, G, c, ntk;
    __host__ __device__ void init(int M, int N, int K, int G_, int c_) { nM = M / BM; nN = N / BM; nwg = nM * nN; G = G_; c = c_; ntk = K / BK; }
    __host__ __device__ bool next(int i, Unit& u) const {
        const long L = (long)i * G + c; if (L >= nwg) return false;
        int wgid = (int)L; { const int q = nwg / NXCD, r = nwg % NXCD, xcd = wgid % NXCD, off = wgid / NXCD; wgid = (xcd < r ? xcd * (q + 1) : r * (q + 1) + (xcd - r) * q) + off; }
        const int nig = WGM * nN, gid = wgid / nig, fm = gid * WGM, gsz = (nM - fm) < WGM ? (nM - fm) : WGM;
        u.pm = fm + ((wgid % nig) % gsz); u.pn = (wgid % nig) / gsz; u.kt0 = 0; u.nt = ntk; u.kp = 0; return true;
    }
};
struct ResOrder {
    StaticOrder S; int nlat, npieces, q0, q1, G, c;
    __host__ __device__ void init(int K, int G_, int c_, bool with_ctx) { S.init(ML, D, K, G_, c_); nlat = S.nwg; const int ntk = K / BK; q1 = (ntk / 8) * 2; q0 = (ntk - 2 * q1) / 2; npieces = with_ctx ? 2 * 4 * CTX_KP : 0; if (CTX_KP == 1) { q0 = ntk; q1 = 0; } G = G_; c = c_; }
    __host__ __device__ bool next(int i, Unit& u) const {
        const long L = (long)i * G + c; if (L < nlat) return S.next(i, u);
        const int idx = (int)(L - nlat); if (idx >= npieces) return false;
        const int kp = idx % CTX_KP, rest = idx / CTX_KP; u.kp = kp; u.kt0 = kp < 2 ? kp * q0 : 2 * q0 + (kp - 2) * q1; u.nt = kp < 2 ? q0 : q1; u.pn = rest & 3; u.pm = 128 + (rest >> 2); return true;
    }
};
struct MoeDownOrder {
    StaticOrder S; int nfull, ntail, G, c;
    __host__ __device__ void init(int ntiles, int G_, int c_) { const int pf = ntiles < 256 ? ntiles : 256; S.init(pf * BM, D, DEX, G_, c_); nfull = pf * 4; ntail = (ntiles - pf) * 16; G = G_; c = c_; }
    __host__ __device__ bool next(int i, Unit& u) const {
        const long L = (long)i * G + c; if (L < nfull) return S.next(i, u);
        const int idx = (int)(L - nfull); if (idx >= ntail) return false;
        u.kp = idx & 3; u.kt0 = 14 * (idx & 3); u.nt = 14; u.pn = (idx >> 2) & 3; u.pm = 256 + (idx >> 4); return true;
    }
};
__device__ __forceinline__ unsigned cvt_pk_bf16(float lo, float hi) { unsigned r; asm volatile("v_cvt_pk_bf16_f32 %0, %1, %2" : "=v"(r) : "v"(lo), "v"(hi)); return r; }
__device__ __forceinline__ f32x2 gelu_pk(f32x2 v) {
    const f32x2 av = __builtin_elementwise_abs(v), d = av * 0.2316418882f + 1.0f;
    f32x2 t; t.x = __builtin_amdgcn_rcpf(d.x); t.y = __builtin_amdgcn_rcpf(d.y);
    f32x2 q = t * 0.5307027145f + (-0.7265760135f); q = q * t + 0.7107068705f; q = q * t + (-0.142248368f); q = q * t + 0.127414796f; q = q * t;
    const f32x2 s = (v * v) * (-0.72134752044f);
    f32x2 e; e.x = __builtin_amdgcn_exp2f(s.x); e.y = __builtin_amdgcn_exp2f(s.y);
    const f32x2 m = v * (q * e), r = v - m;
    f32x2 o; o.x = v.x < 0.f ? m.x : r.x; o.y = v.y < 0.f ? m.y : r.y; return o;
}
template <class Epi, class Sched, bool ALIGN_EPI, bool GATHER>
__device__ __forceinline__ void gemm_phase(LAS unsigned char* lds, const Gemm g, const Sched& S, const Epi& E, const int tid) {
    const int wid = __builtin_amdgcn_readfirstlane(tid >> 6), lane = tid & 63, wr = wid >> 2, wc = wid & 3, fr = lane & 15, fq = lane >> 4;
    const int K = g.K;
    unsigned voffA[2], voffB[2];
    unsigned voffA1[2];
#pragma unroll
    for (int i = 0; i < 2; ++i) { int R, C; stage_rc(tid * 16 + i * 8192, R, C); const int Rb = Epi::PERM == 2 ? (64 * (R >> 5) + perm32(R & 31)) : Epi::PERM ? ((R & ~31) + perm32(R & 31)) : R;
        voffA[i] = (unsigned)(R * K + C) * 2u; voffA1[i] = voffA[i]; voffB[i] = (unsigned)(Rb * K + C) * 2u; }
    const size_t kstep = (size_t)(BK * 2);
    const size_t hstep = (size_t)HALF * K * 2;
    const size_t tstep = 2 * hstep;
    const size_t hstepB = Epi::PERM == 2 ? (size_t)32 * K * 2 : hstep;
    const unsigned ldsw = (unsigned)wid * 1024u;
    const int aoff = lds_byte(wr * 64 + fr, fq * 8), boff = lds_byte(wc * 32 + fr, fq * 8);
#define PG8_SA(b, h) (((b) * 2 + (h)) * HTB)
#define PG8_SB(b, h) ((4 + (b) * 2 + (h)) * HTB)
#define PG8_STAGE(bufoff, gbase, voff) do { _Pragma("unroll") for (int _i = 0; _i < 2; ++_i) \
        __builtin_amdgcn_global_load_lds((const unsigned*)((const char*)(gbase) + (voff)[_i]), (LAS unsigned*)(lds + (bufoff) + ldsw + _i * 8192), 16, 0, 0); } while (0)
#define PG8_LDA(dst, b, h) do { _Pragma("unroll") for (int m = 0; m < 4; ++m) _Pragma("unroll") for (int k = 0; k < 2; ++k) dst[m][k] = *(const LAS bf16x8*)(lds + PG8_SA(b, h) + aoff + m * 2048 + k * 1024); } while (0)
#define PG8_LDB(dst, b, h) do { _Pragma("unroll") for (int n = 0; n < 2; ++n) _Pragma("unroll") for (int k = 0; k < 2; ++k) dst[n][k] = *(const LAS bf16x8*)(lds + PG8_SB(b, h) + boff + n * 2048 + k * 1024); } while (0)
#define PG8_MMA(ai, bj, At, Bt) do { __builtin_amdgcn_s_setprio(1); _Pragma("unroll") for (int m = 0; m < 4; ++m) _Pragma("unroll") for (int n = 0; n < 2; ++n) _Pragma("unroll") for (int k = 0; k < 2; ++k) \
        acc[ai][bj][m][n] = __builtin_amdgcn_mfma_f32_16x16x32_bf16(Bt[n][k], At[m][k], acc[ai][bj][m][n], 0, 0, 0); __builtin_amdgcn_s_setprio(0); } while (0)
#define PG8_WAIT_V(n) asm volatile("s_waitcnt vmcnt(" #n ")" ::: "memory")
#define PG8_WAIT_L(n) asm volatile("s_waitcnt lgkmcnt(" #n ")" ::: "memory")
#define PG8_BAR __builtin_amdgcn_s_barrier()
#define PG8_SCHED __builtin_amdgcn_sched_barrier(0)
#define PG8_VA1 (GATHER ? voffA1 : voffA)
#define PG8_GOFF(u, v0, v1) do { _Pragma("unroll") for (int _i = 0; _i < 2; ++_i) { int R_, C_; stage_rc(tid * 16 + _i * 8192, R_, C_); \
        const int r0_ = g.arow[(u).pm * BM + R_], r1_ = g.arow[(u).pm * BM + HALF + R_]; v0[_i] = (unsigned)(r0_ * K + C_) * 2u; v1[_i] = (unsigned)(r1_ * K + C_) * 2u; } } while (0)
#define PG8_GROWS(u, q0, q1) do { _Pragma("unroll") for (int _i = 0; _i < 2; ++_i) { int R_, C_; stage_rc(tid * 16 + _i * 8192, R_, C_); q0[_i] = g.arow[(u).pm * BM + R_]; q1[_i] = g.arow[(u).pm * BM + HALF + R_]; } } while (0)
#define PG8_GOFFR(q0, q1, v0, v1) do { _Pragma("unroll") for (int _i = 0; _i < 2; ++_i) { int R_, C_; stage_rc(tid * 16 + _i * 8192, R_, C_); v0[_i] = (unsigned)(q0[_i] * K + C_) * 2u; v1[_i] = (unsigned)(q1[_i] * K + C_) * 2u; } } while (0)
#define PG8_BBASE(u) ((const char*)g.Bt + (g.grp ? (size_t)g.grp[(u).pm] * g.gstride * 2 : (size_t)0) + (size_t)(u).pn * tstep + (size_t)(u).kt0 * kstep)
    Unit cur, nxt; int ui = 0;
    if (!S.next(0, cur)) return;
    f32x4 acc[2][2][4][2];
#pragma unroll
    for (int a = 0; a < 2; ++a)
#pragma unroll
        for (int b = 0; b < 2; ++b)
#pragma unroll
            for (int m = 0; m < 4; ++m)
#pragma unroll
                for (int n = 0; n < 2; ++n) acc[a][b][m][n] = (f32x4){0.f, 0.f, 0.f, 0.f};
    bf16x8 At[4][2], B0[2][2], B1[2][2];
    const char* cA = (GATHER ? (const char*)g.A : (const char*)g.A + (size_t)cur.pm * tstep) + (size_t)cur.kt0 * kstep;
    const size_t ah = GATHER ? (size_t)0 : hstep;
    int gq0[2] = {0, 0}, gq1[2] = {0, 0};
    if constexpr (GATHER) { PG8_GOFF(cur, voffA, voffA1); Unit n1_; if (S.next(1, n1_)) PG8_GROWS(n1_, gq0, gq1); asm volatile("" : "+v"(gq0[0]), "+v"(gq0[1]), "+v"(gq1[0]), "+v"(gq1[1])); }
    const char* cB = PG8_BBASE(cur);
    PG8_STAGE(PG8_SB(0, 0), cB, voffB); PG8_STAGE(PG8_SA(0, 0), cA, voffA); PG8_STAGE(PG8_SB(0, 1), cB + hstepB, voffB); PG8_STAGE(PG8_SA(0, 1), cA + ah, PG8_VA1);
    if (wr == 1) PG8_BAR;
    PG8_WAIT_V(4); PG8_BAR;
    PG8_STAGE(PG8_SB(1, 0), cB + kstep, voffB); PG8_STAGE(PG8_SA(1, 0), cA + kstep, voffA); PG8_STAGE(PG8_SB(1, 1), cB + hstepB + kstep, voffB);
    PG8_WAIT_V(6); PG8_BAR;
    for (;;) {
        const bool has_next = S.next(ui + 1, nxt);
        const char* nA = !has_next ? cA : (GATHER ? (const char*)g.A : (const char*)g.A + (size_t)nxt.pm * tstep) + (size_t)nxt.kt0 * kstep; const char* nB = has_next ? PG8_BBASE(nxt) : cB;
        const int nt = cur.nt;
        for (int t = 0; t < nt; t += 2) {
            const bool last = (t == nt - 2);
            const char* a1 = cA + (size_t)(t + 1) * kstep;
            const char* a2 = last ? nA : cA + (size_t)(t + 2) * kstep; const char* b2 = last ? nB : cB + (size_t)(t + 2) * kstep;
            const char* a3 = a2 + kstep; const char* b3 = b2 + kstep;
            PG8_LDB(B0, 0, 0); PG8_SCHED; PG8_LDA(At, 0, 0); PG8_STAGE(PG8_SA(1, 1), a1 + ah, PG8_VA1);
            if constexpr (GATHER) { if (last && has_next) PG8_GOFFR(gq0, gq1, voffA, voffA1); }
            PG8_WAIT_L(8); PG8_BAR; PG8_WAIT_L(0); PG8_MMA(0, 0, At, B0); PG8_BAR; PG8_SCHED;
            PG8_LDB(B1, 0, 1); PG8_STAGE(PG8_SB(0, 0), b2, voffB);
            PG8_BAR; PG8_WAIT_L(0); PG8_MMA(0, 1, At, B1); PG8_BAR;
            PG8_LDA(At, 0, 1); PG8_STAGE(PG8_SA(0, 0), a2, voffA);
            PG8_BAR; PG8_WAIT_L(0); PG8_MMA(1, 0, At, B0); PG8_BAR; PG8_SCHED;
            PG8_STAGE(PG8_SB(0, 1), b2 + hstepB, voffB);
            PG8_WAIT_V(6); PG8_BAR; PG8_MMA(1, 1, At, B1); PG8_BAR;
            PG8_LDB(B0, 1, 0); PG8_SCHED; PG8_LDA(At, 1, 0); PG8_STAGE(PG8_SA(0, 1), a2 + ah, PG8_VA1);
            PG8_WAIT_L(8); PG8_BAR; PG8_WAIT_L(0); PG8_MMA(0, 0, At, B0); PG8_BAR; PG8_SCHED;
            PG8_LDB(B1, 1, 1); PG8_STAGE(PG8_SB(1, 0), b3, voffB);
            PG8_BAR; PG8_WAIT_L(0); PG8_MMA(0, 1, At, B1); PG8_BAR;
            PG8_LDA(At, 1, 1); PG8_STAGE(PG8_SA(1, 0), a3, voffA);
            PG8_BAR; PG8_WAIT_L(0); PG8_MMA(1, 0, At, B0); PG8_BAR; PG8_SCHED;
            PG8_STAGE(PG8_SB(1, 1), b3 + hstepB, voffB);
            PG8_WAIT_V(6); PG8_BAR; PG8_MMA(1, 1, At, B1); PG8_BAR;
        }
        if constexpr (ALIGN_EPI) { if (wr == 0) PG8_BAR; }
        int gt0[2] = {0, 0}, gt1[2] = {0, 0};
        if constexpr (GATHER) { Unit n2_; if (S.next(ui + 2, n2_)) PG8_GROWS(n2_, gt0, gt1); }
        E(acc, cur, wr, wc, fr, fq);
        if constexpr (GATHER) { asm volatile("" : "+v"(gt0[0]), "+v"(gt0[1]), "+v"(gt1[0]), "+v"(gt1[1])); gq0[0] = gt0[0]; gq0[1] = gt0[1]; gq1[0] = gt1[0]; gq1[1] = gt1[1]; }
        if (!has_next) break;
#pragma unroll
        for (int a = 0; a < 2; ++a)
#pragma unroll
            for (int b = 0; b < 2; ++b)
#pragma unroll
                for (int m = 0; m < 4; ++m)
#pragma unroll
                    for (int n = 0; n < 2; ++n) acc[a][b][m][n] = (f32x4){0.f, 0.f, 0.f, 0.f};
        cur = nxt; cA = nA; cB = nB; ++ui;
        if constexpr (ALIGN_EPI) { if (wr == 1) PG8_BAR; }
    }
    PG8_WAIT_V(0);
    if constexpr (!ALIGN_EPI) { if (wr == 0) PG8_BAR; }
    PG8_BAR;
#undef PG8_SA
#undef PG8_SB
#undef PG8_STAGE
#undef PG8_LDA
#undef PG8_LDB
#undef PG8_MMA
#undef PG8_WAIT_V
#undef PG8_WAIT_L
#undef PG8_BAR
#undef PG8_SCHED
#undef PG8_VA1
#undef PG8_GOFF
#undef PG8_GROWS
#undef PG8_GOFFR
#undef PG8_BBASE
}

struct EpiEvenIn {
    static constexpr bool PERM = true;
    bf16_t* O;
    template <bool ACT> __device__ __forceinline__ void run(const f32x4 (&acc)[2][2][4][2], const Unit& u, int wr, int wc, int fr, int fq) const {
        const int row0 = u.pm * BM + wr * 64 + fr, col0 = u.pn * BM + wc * 32 + 8 * fq;
#pragma unroll
        for (int ai = 0; ai < 2; ++ai)
#pragma unroll
            for (int m = 0; m < 4; ++m) { bf16_t* rowp = O + (size_t)(row0 + ai * HALF + m * 16) * NEIN + col0;
#pragma unroll
                for (int bj = 0; bj < 2; ++bj) { f32x4 v0 = acc[ai][bj][m][0], v1 = acc[ai][bj][m][1];
                    if (ACT) { f32x2 a = gelu_pk((f32x2){v0[0], v0[1]}), b = gelu_pk((f32x2){v0[2], v0[3]}), c = gelu_pk((f32x2){v1[0], v1[1]}), d = gelu_pk((f32x2){v1[2], v1[3]});
                        v0 = (f32x4){a.x, a.y, b.x, b.y}; v1 = (f32x4){c.x, c.y, d.x, d.y}; }
                    u32x4 w; w.x = cvt_pk_bf16(v0[0], v0[1]); w.y = cvt_pk_bf16(v0[2], v0[3]); w.z = cvt_pk_bf16(v1[0], v1[1]); w.w = cvt_pk_bf16(v1[2], v1[3]);
                    *(u32x4*)(rowp + bj * HALF) = w; } }
    }
    __device__ __forceinline__ void operator()(const f32x4 (&acc)[2][2][4][2], const Unit& u, int wr, int wc, int fr, int fq) const {
        if (u.pn >= 4) run<true>(acc, u, wr, wc, fr, fq); else run<false>(acc, u, wr, wc, fr, fq);
    }
};
template <bool SRC_F32> struct EpiRes {
    static constexpr bool PERM = true;
    const float* sl32; bf16_t* xb; const float* gate; float* part;
    __device__ __forceinline__ void operator()(const f32x4 (&acc)[2][2][4][2], const Unit& u, int wr, int wc, int fr, int fq) const {
        const int col0 = u.pn * BM + wc * 32 + 8 * fq;
        typedef __attribute__((address_space(1))) const char gcc_t; typedef __attribute__((address_space(1))) char gc_t;
        if (u.pm >= 128) {
            gc_t* dst = (gc_t*)(part + ((size_t)u.kp * MC + (size_t)(u.pm - 128) * BM) * D);
#pragma unroll
            for (int ai = 0; ai < 2; ++ai)
#pragma unroll
                for (int m = 0; m < 4; ++m) { const unsigned off = (unsigned)((ai * HALF + wr * 64 + m * 16 + fr) * D + col0) * 4u;
#pragma unroll
                    for (int bj = 0; bj < 2; ++bj) { *(__attribute__((address_space(1))) f32x4*)(dst + off + (unsigned)(bj * HALF) * 4u) = acc[ai][bj][m][0]; *(__attribute__((address_space(1))) f32x4*)(dst + off + (unsigned)(bj * HALF + 4) * 4u) = acc[ai][bj][m][1]; } }
            return;
        }
        const int ms = u.pm >= 64 ? 1 : 0;
        const size_t rbase = (size_t)u.pm * BM;
        gcc_t* src32 = (gcc_t*)(sl32 + rbase * D); gc_t* xbp = (gc_t*)(xb + rbase * D); gcc_t* gp = (gcc_t*)(gate + ms * 6144);
        f32x4 gv[2][2];
#pragma unroll
        for (int bj = 0; bj < 2; ++bj)
#pragma unroll
            for (int n = 0; n < 2; ++n) gv[bj][n] = *(__attribute__((address_space(1))) const f32x4*)(gp + (unsigned)(col0 + bj * HALF + 4 * n) * 4u);
        if (SRC_F32) {
#pragma unroll
            for (int ai = 0; ai < 2; ++ai)
#pragma unroll
                for (int mh = 0; mh < 2; ++mh) {
                    f32x4 xr[2][2][2];
#pragma unroll
                    for (int mm = 0; mm < 2; ++mm) { const unsigned eo = (unsigned)((ai * HALF + wr * 64 + (2 * mh + mm) * 16 + fr) * D + col0);
#pragma unroll
                        for (int bj = 0; bj < 2; ++bj) { xr[mm][bj][0] = *(__attribute__((address_space(1))) const f32x4*)(src32 + (eo + bj * HALF) * 4u); xr[mm][bj][1] = *(__attribute__((address_space(1))) const f32x4*)(src32 + (eo + bj * HALF + 4) * 4u); } }
                    __builtin_amdgcn_sched_barrier(0);
#pragma unroll
                    for (int mm = 0; mm < 2; ++mm) { const int m = 2 * mh + mm; const unsigned eo = (unsigned)((ai * HALF + wr * 64 + m * 16 + fr) * D + col0);
#pragma unroll
                        for (int bj = 0; bj < 2; ++bj) { const f32x4 y0 = xr[mm][bj][0] + gv[bj][0] * acc[ai][bj][m][0], y1 = xr[mm][bj][1] + gv[bj][1] * acc[ai][bj][m][1];
                            u32x4 w; w.x = cvt_pk_bf16(y0[0], y0[1]); w.y = cvt_pk_bf16(y0[2], y0[3]); w.z = cvt_pk_bf16(y1[0], y1[1]); w.w = cvt_pk_bf16(y1[2], y1[3]);
                            *(__attribute__((address_space(1))) u32x4*)(xbp + (eo + bj * HALF) * 2u) = w; } }
                    __builtin_amdgcn_sched_barrier(0);
                }
        } else {
#pragma unroll
            for (int ai = 0; ai < 2; ++ai) {
                u32x4 raw[4][2];
#pragma unroll
                for (int m = 0; m < 4; ++m) { const unsigned eo = (unsigned)((ai * HALF + wr * 64 + m * 16 + fr) * D + col0);
#pragma unroll
                    for (int bj = 0; bj < 2; ++bj) raw[m][bj] = *(__attribute__((address_space(1))) const u32x4*)(xbp + (eo + bj * HALF) * 2u); }
                __builtin_amdgcn_sched_barrier(0);
#pragma unroll
                for (int m = 0; m < 4; ++m) { const unsigned eo = (unsigned)((ai * HALF + wr * 64 + m * 16 + fr) * D + col0);
#pragma unroll
                    for (int bj = 0; bj < 2; ++bj) { const u32x4 r = raw[m][bj];
                        const f32x4 x0 = (f32x4){bflo(r.x), bfhi(r.x), bflo(r.y), bfhi(r.y)}, x1 = (f32x4){bflo(r.z), bfhi(r.z), bflo(r.w), bfhi(r.w)};
                        const f32x4 y0 = x0 + gv[bj][0] * acc[ai][bj][m][0], y1 = x1 + gv[bj][1] * acc[ai][bj][m][1];
                        u32x4 w; w.x = cvt_pk_bf16(y0[0], y0[1]); w.y = cvt_pk_bf16(y0[2], y0[3]); w.z = cvt_pk_bf16(y1[0], y1[1]); w.w = cvt_pk_bf16(y1[2], y1[3]);
                        *(__attribute__((address_space(1))) u32x4*)(xbp + (eo + bj * HALF) * 2u) = w; } }
                __builtin_amdgcn_sched_barrier(0);
            }
        }
    }
};
struct EpiSwiglu {
    static constexpr bool PERM = true;
    bf16_t* O; int ldc;
    __device__ __forceinline__ void operator()(const f32x4 (&acc)[2][2][4][2], const Unit& u, int wr, int wc, int fr, int fq) const {
        const int row0 = u.pm * BM + wr * 64 + fr, col0 = u.pn * 128 + wc * 32 + 8 * fq;
#pragma unroll
        for (int ai = 0; ai < 2; ++ai)
#pragma unroll
            for (int m = 0; m < 4; ++m) { bf16_t* rowp = O + (size_t)(row0 + ai * HALF + m * 16) * ldc + col0;
                float y[8];
#pragma unroll
                for (int n = 0; n < 2; ++n)
#pragma unroll
                    for (int i = 0; i < 4; ++i) { const float a = acc[ai][0][m][n][i], b = acc[ai][1][m][n][i]; y[4 * n + i] = (a * b) * __builtin_amdgcn_rcpf(1.0f + __builtin_amdgcn_exp2f(a * -1.44269504089f)); }
                u32x4 w; w.x = cvt_pk_bf16(y[0], y[1]); w.y = cvt_pk_bf16(y[2], y[3]); w.z = cvt_pk_bf16(y[4], y[5]); w.w = cvt_pk_bf16(y[6], y[7]);
                *(u32x4*)rowp = w; }
    }
};
struct EpiOddIn {
    static constexpr int PERM = 2;
    bf16_t* O; const float* lb;
    template <int MODE> __device__ __forceinline__ void run(const f32x4 (&acc)[2][2][4][2], const Unit& u, int wr, int wc, int fr, int fq, float c) const {
        const int row0 = u.pm * BM + wr * 64 + fr, col0 = u.pn * BM + wc * 64 + 8 * fq; const int seg = u.pn >> 2;
        f32x4 lbv[2][2];
        if (MODE == 1) {
#pragma unroll
            for (int bj = 0; bj < 2; ++bj)
#pragma unroll
                for (int n = 0; n < 2; ++n) lbv[bj][n] = *(const f32x4*)(lb + (col0 - 2048) + bj * 32 + 4 * n); }
#pragma unroll
        for (int ai = 0; ai < 2; ++ai)
#pragma unroll
            for (int m = 0; m < 4; ++m) { bf16_t* rowp = O + ((size_t)((u.pn & 3) * 2 + (wc >> 1)) * MT + (size_t)(row0 + ai * HALF + m * 16)) * 640 + seg * 128 + (wc & 1) * 64 + 8 * fq;
#pragma unroll
                for (int bj = 0; bj < 2; ++bj) { f32x4 v[2] = {acc[ai][bj][m][0], acc[ai][bj][m][1]};
#pragma unroll
                    for (int n = 0; n < 2; ++n)
#pragma unroll
                        for (int i = 0; i < 4; ++i) { float x = v[n][i];
                            if (MODE == 0) x = (x * c) * __builtin_amdgcn_rcpf(1.0f + __builtin_amdgcn_exp2f(x * -1.44269504089f));
                            else if (MODE == 1) { const float l = lbv[bj][n][i]; const float s = __builtin_amdgcn_rcpf(1.0f + __builtin_amdgcn_exp2f(x * -1.44269504089f)); const float f = l + (1.0f - l) * s; x = __builtin_amdgcn_logf(fmaxf(f, 1e-30f)) * 0.69314718056f; }
                            v[n][i] = x; }
                    u32x4 w; w.x = cvt_pk_bf16(v[0][0], v[0][1]); w.y = cvt_pk_bf16(v[0][2], v[0][3]); w.z = cvt_pk_bf16(v[1][0], v[1][1]); w.w = cvt_pk_bf16(v[1][2], v[1][3]);
                    *(u32x4*)(rowp + bj * 32) = w; } }
    }
    __device__ __forceinline__ void operator()(const f32x4 (&acc)[2][2][4][2], const Unit& u, int wr, int wc, int fr, int fq) const {
        const int seg = u.pn >> 2;
        if (seg == 0) run<0>(acc, u, wr, wc, fr, fq, 0.08838834764831845f);
        else if (seg == 1) run<0>(acc, u, wr, wc, fr, fq, 1.0f);
        else if (seg == 4) run<2>(acc, u, wr, wc, fr, fq, 1.0f);
        else run<1>(acc, u, wr, wc, fr, fq, 1.0f);
    }
};
struct EpiNull { static constexpr bool PERM = true; float* sink;
    __device__ __forceinline__ void operator()(const f32x4 (&acc)[2][2][4][2], const Unit& u, int wr, int wc, int fr, int fq) const {
        float s = 0.f;
#pragma unroll
        for (int ai = 0; ai < 2; ++ai)
#pragma unroll
            for (int bj = 0; bj < 2; ++bj)
#pragma unroll
                for (int m = 0; m < 4; ++m)
#pragma unroll
                    for (int n = 0; n < 2; ++n) s += acc[ai][bj][m][n][0] + acc[ai][bj][m][n][1] + acc[ai][bj][m][n][2] + acc[ai][bj][m][n][3];
        if (s == 123.456f) sink[0] = s; } };
struct EpiMoeDown {
    static constexpr bool PERM = true;
    bf16_t* O; const int* dst; float* partm;
    __device__ __forceinline__ void operator()(const f32x4 (&acc)[2][2][4][2], const Unit& u, int wr, int wc, int fr, int fq) const {
        const int row0 = u.pm * BM + wr * 64 + fr, col0 = u.pn * BM + wc * 32 + 8 * fq;
        if (u.pm >= 256) {
            float* base = partm + ((size_t)u.kp * 3072 + (size_t)(row0 - 65536)) * D + col0;
#pragma unroll
            for (int ai = 0; ai < 2; ++ai)
#pragma unroll
                for (int m = 0; m < 4; ++m) { float* rowp = base + (size_t)(ai * HALF + m * 16) * D;
#pragma unroll
                    for (int bj = 0; bj < 2; ++bj) { *(f32x4*)(rowp + bj * HALF) = acc[ai][bj][m][0]; *(f32x4*)(rowp + bj * HALF + 4) = acc[ai][bj][m][1]; } }
            return;
        }
        bf16_t* base = O + (size_t)row0 * D + col0;
#pragma unroll
        for (int ai = 0; ai < 2; ++ai)
#pragma unroll
            for (int m = 0; m < 4; ++m) { bf16_t* rowp = base + (size_t)(ai * HALF + m * 16) * D;
#pragma unroll
                for (int bj = 0; bj < 2; ++bj) { const f32x4 v0 = acc[ai][bj][m][0], v1 = acc[ai][bj][m][1];
                    u32x4 w; w.x = cvt_pk_bf16(v0[0], v0[1]); w.y = cvt_pk_bf16(v0[2], v0[3]); w.z = cvt_pk_bf16(v1[0], v1[1]); w.w = cvt_pk_bf16(v1[2], v1[3]);
                    *(u32x4*)(rowp + bj * HALF) = w; } }
    }
};
}

struct Args { const float* in[24]; float* out; unsigned char* ws; int ph_lo, ph_hi; };
enum { I_X = 0, I_C, I_CTX, I_CCTX, I_WADA, I_BADA, I_NMIX, I_NFFN, I_NOUT, I_WINE, I_GW, I_GB, I_WOUTE, I_WINO, I_RLB, I_RNORM, I_WOUTO, I_F1, I_F3, I_F2, I_RW, I_M1, I_M3, I_M2 };
enum { PH_P0 = 0, PH_PAIR0 = 1, NPL = 18, PH_FINAL = 1 + 2 * NPL, NPHASE = PH_FINAL + 1 };
enum { E1_NORM = 0, E2_GIN, E3_FFTA, E3_FFTC, E4_GOUT, E5_NORM, E6_UP, E7_DOWN, O1_NORM, O2_GIN, O3_SCAN1, O4_CARRY, O5_SCAN3, O6_GOUT, O7_NORM, O8_SLOTS, O9_MUP, O10_MDOWN };

#define LAUNDER_WS_OUT(extra_) do { auto w_ = (__attribute__((address_space(1))) unsigned char*)F.ws; auto o_ = (__attribute__((address_space(1))) float*)F.out; \
        asm volatile("" : "+s"(w_), "+s"(o_) extra_); F.ws = (unsigned char*)w_; F.out = (float*)o_; } while (0)
#define FIN(i) (F.in[i])
struct Ctx {
    LAS unsigned char* lds; int tid, lane, wave, G, bid, gw, NGW;
    const float* const* in; float* out; unsigned char* ws;
};

__device__ __forceinline__ void transpose_item(const float* W, int ld, int K, int N, bf16_t* WT, int mode, int roff, int item, int lane) {
    const int nblk = N / 64, kb = item / nblk, nb = item % nblk, k0 = 64 * kb, n0 = 64 * nb;
    const int c = lane & 15, kg = lane >> 4;
    const float* src = W + (size_t)(k0 + 8 * kg) * ld + n0 + 4 * c;
    f32x4 v[2][8];
#pragma unroll
    for (int hf = 0; hf < 2; ++hf)
#pragma unroll
        for (int i = 0; i < 8; ++i) v[hf][i] = __builtin_nontemporal_load((const f32x4*)(src + (size_t)(32 * hf + i) * ld));
    __builtin_amdgcn_sched_barrier(0);
#pragma unroll
    for (int i = 0; i < 4; ++i) { const int ng = n0 + 4 * c + i; const int drow = mode == 0 ? (roff + ng) : (((ng >> 7) << 8) + (ng & 127) + roff);
#pragma unroll
        for (int hf = 0; hf < 2; ++hf) { u32x4 o; o.x = pk2(v[hf][0][i], v[hf][1][i]); o.y = pk2(v[hf][2][i], v[hf][3][i]); o.z = pk2(v[hf][4][i], v[hf][5][i]); o.w = pk2(v[hf][6][i], v[hf][7][i]);
            *(u32x4*)(WT + (size_t)drow * K + k0 + 32 * hf + 8 * kg) = o; } }
}

__device__ __forceinline__ void p0_prologue(const Ctx& F) {
    const int tid = F.tid, lane = F.lane, wave = F.wave;
    unsigned char* ws = F.ws;
    LAS float* scond = (LAS float*)(F.lds);
    LAS float* part = (LAS float*)(F.lds + 16384);
    LAS float* ctab = (LAS float*)(F.lds + 32768);
    for (int i = tid; i < 3 * D; i += 512) { const int v = i / D, k = i % D; const float c = v < 2 ? FIN(I_C)[v * D + k] : FIN(I_CCTX)[k]; scond[i] = c / (1.0f + expf(-c)); }
    if (tid < 128) ctab[tid] = cosf(6.283185307179586f * (float)tid / 128.0f);
    __syncthreads();
    float* mods = (float*)(ws + WS_MODS);
    if (P0_MASK & 1)
    for (int it = F.bid; it < 4 * 48; it += F.G) {
        const int l = it / 48, cg = it % 48; const float* W = FIN(I_WADA) + (size_t)l * D * 6144 + cg * 128 + 2 * lane;
        float a0[2] = {0.f, 0.f}, a1[2] = {0.f, 0.f}, a2[2] = {0.f, 0.f};
#pragma unroll 16
        for (int kk = 0; kk < 128; ++kk) { const int k = wave * 128 + kk; const f32x2 w = __builtin_nontemporal_load((const f32x2*)(W + (size_t)k * 6144)); const float s0 = scond[k], s1 = scond[D + k], s2 = scond[2 * D + k];
            a0[0] += s0 * w.x; a0[1] += s0 * w.y; a1[0] += s1 * w.x; a1[1] += s1 * w.y; a2[0] += s2 * w.x; a2[1] += s2 * w.y; }
        part[(wave * 3 + 0) * 128 + 2 * lane] = a0[0]; part[(wave * 3 + 0) * 128 + 2 * lane + 1] = a0[1];
        part[(wave * 3 + 1) * 128 + 2 * lane] = a1[0]; part[(wave * 3 + 1) * 128 + 2 * lane + 1] = a1[1];
        part[(wave * 3 + 2) * 128 + 2 * lane] = a2[0]; part[(wave * 3 + 2) * 128 + 2 * lane + 1] = a2[1];
        __syncthreads();
        if (tid < 384) { const int v = tid / 128, c = tid % 128; float sum = 0.f;
#pragma unroll
            for (int w = 0; w < 8; ++w) sum += part[(w * 3 + v) * 128 + c];
            mods[((size_t)l * 3 + v) * 6144 + cg * 128 + c] = sum + FIN(I_BADA)[l * 6144 + cg * 128 + c]; }
        __syncthreads();
    }
    const int gt = F.bid * 512 + tid, NGT = F.G * 512;
    float* LB = (float*)(ws + WS_LB);
    if (P0_MASK & 2)
    for (int i = gt; i < 4096; i += NGT) { const int j = i >> 11, r = i & 2047; float v = 0.f; if (j == 1) { const float r0 = FIN(I_RLB)[r], r1 = FIN(I_RLB)[2048 + r]; v = 1.0f / (1.0f + expf(r0 - r1)); v = fminf(fmaxf(v, 0.f), 1.f); } LB[i] = v; }
    bf16_t* FA = (bf16_t*)(ws + WS_FA); bf16_t* FC = (bf16_t*)(ws + WS_FC); bf16_t* FX = (bf16_t*)(ws + WS_FX); bf16_t* GW = (bf16_t*)(ws + WS_GW);
    if (P0_MASK & 4)
    for (int i = gt; i < 256 * 256; i += NGT) { const int r = i >> 8, c = i & 255, k1 = r & 127, t1 = c & 127; const float ang = 6.283185307179586f * (float)((k1 * t1) & 127) / 128.0f; float sn, cs; sincosf(ang, &sn, &cs);
        const int rr = r >> 7, cc = c >> 7; const float v = (rr == cc) ? cs : (rr == 0 ? -sn : sn); FA[i] = (bf16_t)f2bf(v); }
    if (P0_MASK & 4)
    for (int i = gt; i < 128 * 256; i += NGT) { const int k2 = i >> 8, c = i & 255, t2 = c & 127; const float ang = 6.283185307179586f * (float)((k2 * t2) & 127) / 128.0f; float sn, cs; sincosf(ang, &sn, &cs); FC[i] = (bf16_t)f2bf(c < 128 ? cs : -sn); }
    if (P0_MASK & 4)
    for (int i = gt; i < 256 * 512; i += NGT) { const int k = i >> 9, c = i & 511, t = c & 255; const float ang = 6.283185307179586f * (float)((k * t) & 255) / 256.0f; float sn, cs; sincosf(ang, &sn, &cs); FX[i] = (bf16_t)f2bf(c < 256 ? cs : -sn); }
    if (P0_MASK & 8)
    for (int i = gt; i < 2 * 4 * 128 * 128; i += NGT) GW[i] = (bf16_t)f2bf(FIN(I_GW)[i]);
    bf16_t* WinE = (bf16_t*)(ws + WS_WINE);
    if (P0_MASK & 16)
    for (int it = F.gw; it < 2 * 4 * 16 * 32; it += F.NGW) {
        const int mg = it & 31, kb = (it >> 5) & 15, g = (it >> 9) & 3, j = it >> 11; const int k = kb * 64 + lane, m0 = mg * 4;
        const float* Wr = FIN(I_WINE) + (size_t)j * D * 1536 + (size_t)k * 1536 + g * 128;
        float aP[4] = {0.f, 0.f, 0.f, 0.f}, aQ[4] = {0.f, 0.f, 0.f, 0.f};
        f32x4 wq_[32];
#pragma unroll
        for (int c4 = 0; c4 < 32; ++c4) wq_[c4] = *(const f32x4*)(Wr + 4 * c4);
        __builtin_amdgcn_sched_barrier(0);
#pragma unroll
        for (int c4 = 0; c4 < 32; ++c4) { const f32x4 w = wq_[c4];
#pragma unroll
            for (int ci = 0; ci < 4; ++ci) { const int c = 4 * c4 + ci;
#pragma unroll
                for (int mm = 0; mm < 4; ++mm) { const int idx = (c * (m0 + mm)) & 127; aP[mm] += w[ci] * ctab[idx]; aQ[mm] += w[ci] * ctab[(idx - 32) & 127]; } } }
#pragma unroll
        for (int mm = 0; mm < 4; ++mm) { bf16_t* o = WinE + (size_t)j * NEIN * D; o[(size_t)(g * 128 + m0 + mm) * D + k] = (bf16_t)f2bf(aP[mm]); o[(size_t)(512 + g * 128 + m0 + mm) * D + k] = (bf16_t)f2bf(aQ[mm]); }
    }
    constexpr int NI_UV = 16 * 16, NI_SQ = 16 * 16, NI_INO = 16 * 80, NI_F13 = 16 * 44, NI_F2 = 44 * 16;
    constexpr int PER_J = NI_UV + NI_SQ + NI_INO + NI_SQ + 2 * NI_F13 + NI_F2;
    if (P0_MASK & 32)
    for (int it = F.gw; it < 2 * PER_J; it += F.NGW) {
        const int j = it / PER_J; int r = it % PER_J;
        const float* W; int ld, K, N, mode = 0, roff = 0; bf16_t* WT;
        if (r < NI_UV) { W = FIN(I_WINE) + (size_t)j * D * 1536 + 512; ld = 1536; K = D; N = 1024; WT = WinE + (size_t)j * NEIN * D; roff = 1024; }
        else if ((r -= NI_UV) < NI_SQ) { W = FIN(I_WOUTE) + (size_t)j * D * D; ld = D; K = D; N = D; WT = (bf16_t*)(ws + WS_WOUTE) + (size_t)j * D * D; }
        else if ((r -= NI_SQ) < NI_INO) { W = FIN(I_WINO) + (size_t)j * D * NREC; ld = NREC; K = D; N = NREC; WT = (bf16_t*)(ws + WS_WINO) + (size_t)j * NREC * D; }
        else if ((r -= NI_INO) < NI_SQ) { W = FIN(I_WOUTO) + (size_t)j * D * D; ld = D; K = D; N = D; WT = (bf16_t*)(ws + WS_WOUTO) + (size_t)j * D * D; }
        else if ((r -= NI_SQ) < NI_F13) { W = FIN(I_F1) + (size_t)j * D * DFF; ld = DFF; K = D; N = DFF; WT = (bf16_t*)(ws + WS_W13) + (size_t)j * NFF2 * D; mode = 1; }
        else if ((r -= NI_F13) < NI_F13) { W = FIN(I_F3) + (size_t)j * D * DFF; ld = DFF; K = D; N = DFF; WT = (bf16_t*)(ws + WS_W13) + (size_t)j * NFF2 * D; mode = 1; roff = 128; }
        else { r -= NI_F13; W = FIN(I_F2) + (size_t)j * DFF * D; ld = D; K = DFF; N = D; WT = (bf16_t*)(ws + WS_W2) + (size_t)j * D * DFF; }
        transpose_item(W, ld, K, N, WT, mode, roff, r, lane);
    }
}
constexpr int MOE_CONV_ITEMS = NE * (2 * 16 * 56 + 56 * 16);
__device__ __forceinline__ void moe_convert_item(const Ctx& F, int j, int it) {
    constexpr int I_13 = 16 * 56, I_2 = 56 * 16, PER_E = 2 * I_13 + I_2;
    const int e = it / PER_E; int r = it % PER_E; const size_t eo = (size_t)(j * NE + e);
    const float* W; int ld, K, N, mode = 0, roff = 0; bf16_t* WT;
    if (r < I_13) { W = FIN(I_M1) + eo * D * DEX; ld = DEX; K = D; N = DEX; WT = (bf16_t*)(F.ws + WS_W13M) + (size_t)e * NEX2 * D; mode = 1; }
    else if ((r -= I_13) < I_13) { W = FIN(I_M3) + eo * D * DEX; ld = DEX; K = D; N = DEX; WT = (bf16_t*)(F.ws + WS_W13M) + (size_t)e * NEX2 * D; mode = 1; roff = 128; }
    else { r -= I_13; W = FIN(I_M2) + eo * DEX * D; ld = D; K = DEX; N = D; WT = (bf16_t*)(F.ws + WS_W2M) + (size_t)e * D * DEX; }
    transpose_item(W, ld, K, N, WT, mode, roff, r, F.lane);
}

struct RowPass {
    const float* sl; const float* sc;
    bf16_t* xb;
    const float* gain;
    const float* shift; const float* scale;
    bf16_t* H;
    int nrows;
    const bf16_t* YE; const float* topp; const float* gatef;
    const float* rw; int* tope; float* toppo; int* rank; int* cnt;
    float* fout;
    const float* part; int kpn; const float* pgate; const float* csrc32;
    const int* slotof; const float* partm;
};
struct RowPart { int WB, WC; };
__device__ __forceinline__ RowPart row_part(int NW, int nrows) { RowPart q; q.WC = nrows > ML ? NW / 32 : 0; q.WB = (NW - q.WC) / 2; return q; }
__device__ __forceinline__ void row_chunk(const RowPart& q, int gw, int& r0, int& r1) {
    if (gw < 2 * q.WB) { const int b = gw / q.WB, i = gw % q.WB; r0 = b * TL + (int)(((long)i * TL) / q.WB); r1 = b * TL + (int)(((long)(i + 1) * TL) / q.WB); }
    else { const int i = gw - 2 * q.WB; r0 = ML + (i * MC) / q.WC; r1 = ML + ((i + 1) * MC) / q.WC; }
}
__device__ __forceinline__ int row_chunk_of(const RowPart& q, int r) {
    if (r < ML) { const int b = r >> 14, lr = r & (TL - 1); return b * q.WB + (int)(((long)q.WB * (lr + 1) - 1) / TL); }
    return 2 * q.WB + ((r - ML + 1) * q.WC - 1) / MC;
}
__device__ __forceinline__ f32x4 bf4(u32x2 r) { return (f32x4){bflo(r.x), bfhi(r.x), bflo(r.y), bfhi(r.y)}; }
template <bool COMBINE, bool ROUTER, bool FINAL, bool SRCB>
__device__ __forceinline__ void row_pass(const Ctx& F, const RowPass& P) {
    const int lane = F.lane;
    f32x4 rwr[16][2];
    if (ROUTER) {
#pragma unroll
        for (int j = 0; j < 4; ++j)
#pragma unroll
            for (int i = 0; i < 4; ++i) { const int col = 4 * lane + 256 * j + i; rwr[4 * j + i][0] = *(const f32x4*)(P.rw + col * 8); rwr[4 * j + i][1] = *(const f32x4*)(P.rw + col * 8 + 4); } }
    f32x4 gn[4];
#pragma unroll
    for (int j = 0; j < 4; ++j) gn[j] = *(const f32x4*)(P.gain + 4 * lane + 256 * j);
    const RowPart rp = row_part(F.NGW, P.nrows);
    int r0, r1; row_chunk(rp, F.gw, r0, r1);
    {
        int rc0 = 0, rc1 = 0, rc2 = 0, rc3 = 0, rc4 = 0, rc5 = 0, rc6 = 0, rc7 = 0;
        const bool isc = r0 >= ML; const int ms = isc ? 2 : (r0 >= TL ? 1 : 0);
        const float* xs32 = SRCB ? nullptr : (isc ? P.sc + (size_t)(r0 - ML) * D : P.sl + (size_t)r0 * D);
        bf16_t* xb0 = P.xb + (size_t)r0 * D;
        if (SRCB && !COMBINE && !FINAL) { if (isc && P.part) {
            const float* c32 = P.csrc32 ? P.csrc32 + (size_t)(r0 - ML) * D : nullptr;
#pragma unroll 1
            for (int rr = 0; rr < r1 - r0; ++rr) {
#pragma unroll 2
                for (int j = 0; j < 4; ++j) { f32x4 a[4];
#pragma unroll
                    for (int kp = 0; kp < 4; ++kp) a[kp] = kp < P.kpn ? *(const f32x4*)(P.part + ((size_t)kp * MC + (size_t)(r0 - ML + rr)) * D + 4 * lane + 256 * j) : (f32x4){0.f, 0.f, 0.f, 0.f};
                    const f32x4 x0 = c32 ? *(const f32x4*)(c32 + (size_t)rr * D + 4 * lane + 256 * j) : bf4(*(const u32x2*)(xb0 + (size_t)rr * D + 4 * lane + 256 * j));
                    const f32x4 y = x0 + *(const f32x4*)(P.pgate + 2 * 6144 + 4 * lane + 256 * j) * ((a[0] + a[1]) + (a[2] + a[3]));
                    u32x2 w; w.x = pk2(y[0], y[1]); w.y = pk2(y[2], y[3]); *(u32x2*)(xb0 + (size_t)rr * D + 4 * lane + 256 * j) = w; } }
            asm volatile("s_waitcnt vmcnt(0)" ::: "memory"); } }
        f32x4 sh[4], scl[4], gf[4];
#pragma unroll
        for (int j = 0; j < 4; ++j) {
            if (!FINAL && !COMBINE && !ROUTER) { sh[j] = *(const f32x4*)(P.shift + ms * 6144 + 4 * lane + 256 * j); scl[j] = *(const f32x4*)(P.scale + ms * 6144 + 4 * lane + 256 * j) + 1.0f; }
            if (COMBINE) gf[j] = *(const f32x4*)(P.gatef + ms * 6144 + 4 * lane + 256 * j); }
        f32x4 v[4]; f32x4 v32n[4]; u32x2 vbn[4]; u32x2 ya[4], yb[4]; float p0 = 0.f, p1 = 0.f;
#pragma unroll
        for (int j = 0; j < 4; ++j) v[j] = SRCB ? bf4(*(const u32x2*)(xb0 + 4 * lane + 256 * j)) : *(const f32x4*)(xs32 + 4 * lane + 256 * j);
        if (COMBINE) { p0 = P.topp[2 * r0]; p1 = P.topp[2 * r0 + 1];
#pragma unroll
            for (int j = 0; j < 4; ++j) { ya[j] = *(const u32x2*)(P.YE + (size_t)(2 * r0) * D + 4 * lane + 256 * j); yb[j] = *(const u32x2*)(P.YE + (size_t)(2 * r0 + 1) * D + 4 * lane + 256 * j); } }
        for (int r = r0; r < r1; ++r) {
            const int rr = r - r0; const bool more = r + 1 < r1;
            u32x2 yan[4], ybn[4]; float p0n = 0.f, p1n = 0.f;
            if (more) {
#pragma unroll
                for (int j = 0; j < 4; ++j) { if (SRCB) vbn[j] = *(const u32x2*)(xb0 + (size_t)(rr + 1) * D + 4 * lane + 256 * j); else v32n[j] = *(const f32x4*)(xs32 + (size_t)(rr + 1) * D + 4 * lane + 256 * j); }
                if (COMBINE) { p0n = P.topp[2 * r + 2]; p1n = P.topp[2 * r + 3];
#pragma unroll
                    for (int j = 0; j < 4; ++j) { yan[j] = *(const u32x2*)(P.YE + (size_t)(2 * r + 2) * D + 4 * lane + 256 * j); ybn[j] = *(const u32x2*)(P.YE + (size_t)(2 * r + 3) * D + 4 * lane + 256 * j); } }
            }
            if (COMBINE) {
                const int sl0 = P.slotof[2 * r], sl1 = P.slotof[2 * r + 1];
#pragma unroll
                for (int j = 0; j < 4; ++j) { f32x4 y0 = bf4(ya[j]), y1 = bf4(yb[j]);
                    if (sl0 >= 65536) { y0 = (f32x4){0.f, 0.f, 0.f, 0.f}; for (int kp = 0; kp < 4; ++kp) y0 = y0 + *(const f32x4*)(P.partm + ((size_t)kp * 3072 + (size_t)(sl0 - 65536)) * D + 4 * lane + 256 * j); }
                    if (sl1 >= 65536) { y1 = (f32x4){0.f, 0.f, 0.f, 0.f}; for (int kp = 0; kp < 4; ++kp) y1 = y1 + *(const f32x4*)(P.partm + ((size_t)kp * 3072 + (size_t)(sl1 - 65536)) * D + 4 * lane + 256 * j); }
                    v[j] = v[j] + gf[j] * (y0 * p0 + y1 * p1);
                    if (!FINAL) { u32x2 w; w.x = pk2(v[j][0], v[j][1]); w.y = pk2(v[j][2], v[j][3]); *(u32x2*)(xb0 + (size_t)rr * D + 4 * lane + 256 * j) = w; } }
            }
            float ss = 0.f;
#pragma unroll
            for (int j = 0; j < 4; ++j) ss += (v[j][0] * v[j][0] + v[j][1] * v[j][1]) + (v[j][2] * v[j][2] + v[j][3] * v[j][3]);
            const float rstd = rsqrtf(wave_sum(ss, lane) * (1.0f / D) + EPS);
            if (FINAL) {
#pragma unroll
                for (int j = 0; j < 4; ++j) *(f32x4*)(P.fout + (size_t)r * D + 4 * lane + 256 * j) = v[j] * rstd * gn[j];
            } else {
                f32x4 h[4];
#pragma unroll
                for (int j = 0; j < 4; ++j) { if (COMBINE || ROUTER) { sh[j] = *(const f32x4*)(P.shift + ms * 6144 + 4 * lane + 256 * j); scl[j] = *(const f32x4*)(P.scale + ms * 6144 + 4 * lane + 256 * j) + 1.0f; }
                    h[j] = (v[j] * rstd * gn[j]) * scl[j] + sh[j];
                    u32x2 w; w.x = pk2(h[j][0], h[j][1]); w.y = pk2(h[j][2], h[j][3]);
                    *(u32x2*)(P.H + (size_t)r * D + 4 * lane + 256 * j) = w; }
                if (ROUTER) {
                    float lg[8] = {0.f, 0.f, 0.f, 0.f, 0.f, 0.f, 0.f, 0.f};
#pragma unroll
                    for (int j = 0; j < 4; ++j) {
#pragma unroll
                        for (int i = 0; i < 4; ++i) { const f32x4 w0 = rwr[4 * j + i][0], w1 = rwr[4 * j + i][1]; const float hv = h[j][i];
                            lg[0] += hv * w0[0]; lg[1] += hv * w0[1]; lg[2] += hv * w0[2]; lg[3] += hv * w0[3]; lg[4] += hv * w1[0]; lg[5] += hv * w1[1]; lg[6] += hv * w1[2]; lg[7] += hv * w1[3]; }
                        __builtin_amdgcn_sched_barrier(0); }
                    {
                        const bool b5 = (lane & 32) != 0, b4 = (lane & 16) != 0, b3 = (lane & 8) != 0;
                        float a4[4], a2[2];
#pragma unroll
                        for (int i = 0; i < 4; ++i) { const float snd = b5 ? lg[i] : lg[4 + i], kp_ = b5 ? lg[4 + i] : lg[i]; a4[i] = kp_ + shfl_x(snd, 32, lane); }
#pragma unroll
                        for (int i = 0; i < 2; ++i) { const float snd = b4 ? a4[i] : a4[2 + i], kp_ = b4 ? a4[2 + i] : a4[i]; a2[i] = kp_ + shfl_x(snd, 16, lane); }
                        float c1; { const float snd = b3 ? a2[0] : a2[1], kp_ = b3 ? a2[1] : a2[0]; c1 = kp_ + shfl_x(snd, 8, lane); }
                        c1 += shfl_x(c1, 4, lane); c1 += shfl_x(c1, 2, lane); c1 += shfl_x(c1, 1, lane);
#pragma unroll
                        for (int e = 0; e < 8; ++e) lg[e] = __builtin_bit_cast(float, __builtin_amdgcn_readlane(__builtin_bit_cast(int, c1), 8 * e));
                    }
                    int e0 = 0; float v0 = lg[0];
#pragma unroll
                    for (int e = 1; e < 8; ++e) if (lg[e] > v0) { v0 = lg[e]; e0 = e; }
                    int e1 = -1; float v1 = -3.0e38f;
#pragma unroll
                    for (int e = 0; e < 8; ++e) if (e != e0 && lg[e] > v1) { v1 = lg[e]; e1 = e; }
                    const float ex = expf(v1 - v0); const float q0 = 1.0f / (1.0f + ex), q1 = ex / (1.0f + ex);
                    const int rk0 = e0 == 0 ? rc0 : e0 == 1 ? rc1 : e0 == 2 ? rc2 : e0 == 3 ? rc3 : e0 == 4 ? rc4 : e0 == 5 ? rc5 : e0 == 6 ? rc6 : rc7;
                    const int rk1 = e1 == 0 ? rc0 : e1 == 1 ? rc1 : e1 == 2 ? rc2 : e1 == 3 ? rc3 : e1 == 4 ? rc4 : e1 == 5 ? rc5 : e1 == 6 ? rc6 : rc7;
                    rc0 += (e0 == 0) + (e1 == 0); rc1 += (e0 == 1) + (e1 == 1); rc2 += (e0 == 2) + (e1 == 2); rc3 += (e0 == 3) + (e1 == 3);
                    rc4 += (e0 == 4) + (e1 == 4); rc5 += (e0 == 5) + (e1 == 5); rc6 += (e0 == 6) + (e1 == 6); rc7 += (e0 == 7) + (e1 == 7);
                    if (lane == 0) { P.tope[2 * r] = e0; P.tope[2 * r + 1] = e1; P.toppo[2 * r] = q0; P.toppo[2 * r + 1] = q1; P.rank[2 * r] = rk0; P.rank[2 * r + 1] = rk1; }
                }
            }
            if (more) {
#pragma unroll
                for (int j = 0; j < 4; ++j) { v[j] = SRCB ? bf4(vbn[j]) : v32n[j]; if (COMBINE) { ya[j] = yan[j]; yb[j] = ybn[j]; } }
                if (COMBINE) { p0 = p0n; p1 = p1n; }
            }
        }
        if (ROUTER && lane == 0) { int* c = P.cnt + F.gw * 8; c[0] = rc0; c[1] = rc1; c[2] = rc2; c[3] = rc3; c[4] = rc4; c[5] = rc5; c[6] = rc6; c[7] = rc7; }
    }
}

template <bool COMBINE, bool ROUTER, bool FINAL, int RB>
__device__ __forceinline__ void row_pass_b(const Ctx& F, const RowPass& P) {
    const int lane = F.lane;
    f32x4 rwr[16][2];
    if (ROUTER) {
#pragma unroll
        for (int j = 0; j < 4; ++j)
#pragma unroll
            for (int i = 0; i < 4; ++i) { const int col = 4 * lane + 256 * j + i; rwr[4 * j + i][0] = *(const f32x4*)(P.rw + col * 8); rwr[4 * j + i][1] = *(const f32x4*)(P.rw + col * 8 + 4); } }
    f32x4 gn[4];
    if (!ROUTER) {
#pragma unroll
        for (int j = 0; j < 4; ++j) gn[j] = *(const f32x4*)(P.gain + 4 * lane + 256 * j); }
    const RowPart rp = row_part(F.NGW, P.nrows);
    int r0, r1; row_chunk(rp, F.gw, r0, r1);
    int rc0 = 0, rc1 = 0, rc2 = 0, rc3 = 0, rc4 = 0, rc5 = 0, rc6 = 0, rc7 = 0;
    const bool isc = r0 >= ML; const int ms = isc ? 2 : (r0 >= TL ? 1 : 0);
    bf16_t* xb0 = P.xb + (size_t)r0 * D;
    if (!COMBINE && !FINAL) { if (isc && P.part) {
        const float* c32 = P.csrc32 ? P.csrc32 + (size_t)(r0 - ML) * D : nullptr;
#pragma unroll 1
        for (int rr = 0; rr < r1 - r0; ++rr) {
#pragma unroll 2
            for (int j = 0; j < 4; ++j) { f32x4 a[4];
#pragma unroll
                for (int kp = 0; kp < 4; ++kp) a[kp] = kp < P.kpn ? *(const f32x4*)(P.part + ((size_t)kp * MC + (size_t)(r0 - ML + rr)) * D + 4 * lane + 256 * j) : (f32x4){0.f, 0.f, 0.f, 0.f};
                const f32x4 x0 = c32 ? *(const f32x4*)(c32 + (size_t)rr * D + 4 * lane + 256 * j) : bf4(*(const u32x2*)(xb0 + (size_t)rr * D + 4 * lane + 256 * j));
                const f32x4 y = x0 + *(const f32x4*)(P.pgate + 2 * 6144 + 4 * lane + 256 * j) * ((a[0] + a[1]) + (a[2] + a[3]));
                u32x2 w; w.x = pk2(y[0], y[1]); w.y = pk2(y[2], y[3]); *(u32x2*)(xb0 + (size_t)rr * D + 4 * lane + 256 * j) = w; } }
        asm volatile("s_waitcnt vmcnt(0)" ::: "memory"); } }
    f32x4 sh[4], scl[4], gf[4];
#pragma unroll
    for (int j = 0; j < 4; ++j) {
        if (!FINAL && !ROUTER) { sh[j] = *(const f32x4*)(P.shift + ms * 6144 + 4 * lane + 256 * j); scl[j] = *(const f32x4*)(P.scale + ms * 6144 + 4 * lane + 256 * j) + 1.0f; }
        if (COMBINE) gf[j] = *(const f32x4*)(P.gatef + ms * 6144 + 4 * lane + 256 * j); }
    const int nr = r1 - r0;
    u32x2 cur[RB][4], nxt[RB][4], ya[RB][4], yb[RB][4], yan[RB][4], ybn[RB][4];
#define RPB_LOAD(X, YA, YB, base_) do { _Pragma("unroll") for (int k = 0; k < RB; ++k) { const int rk_ = ((base_) + k < nr) ? (base_) + k : nr - 1; \
        int sa_ = 0, sb_ = 0; if (COMBINE) { sa_ = P.slotof[2 * (r0 + rk_)]; sb_ = P.slotof[2 * (r0 + rk_) + 1]; sa_ = sa_ < 65536 ? sa_ : 65535; sb_ = sb_ < 65536 ? sb_ : 65535; }     \
        _Pragma("unroll") for (int j = 0; j < 4; ++j) { X[k][j] = *(const u32x2*)(xb0 + (size_t)rk_ * D + 4 * lane + 256 * j); \
            if (COMBINE) { YA[k][j] = *(const u32x2*)(P.YE + (size_t)sa_ * D + 4 * lane + 256 * j); YB[k][j] = *(const u32x2*)(P.YE + (size_t)sb_ * D + 4 * lane + 256 * j); } } } } while (0)
    const int ng = (nr + RB - 1) / RB; int gi = F.gw % ng;
    RPB_LOAD(cur, ya, yb, gi * RB);
    for (int it = 0; it < ng; ++it) {
        const int rb = gi * RB; gi = gi + 1 == ng ? 0 : gi + 1;
        if (it + 1 < ng) RPB_LOAD(nxt, yan, ybn, gi * RB);
        f32x4 v[RB][4]; float ss[RB];
#pragma unroll
        for (int k = 0; k < RB; ++k) {
            const int rk = (rb + k < nr) ? rb + k : nr - 1; const int r = r0 + rk;
#pragma unroll
            for (int j = 0; j < 4; ++j) v[k][j] = bf4(cur[k][j]);
            if (COMBINE) {
                const float p0 = P.topp[2 * r], p1 = P.topp[2 * r + 1]; const int sl0 = P.slotof[2 * r], sl1 = P.slotof[2 * r + 1];
#pragma unroll
                for (int j = 0; j < 4; ++j) { f32x4 y0 = bf4(ya[k][j]), y1 = bf4(yb[k][j]);
                    if (sl0 >= 65536) { y0 = (f32x4){0.f, 0.f, 0.f, 0.f}; for (int kp = 0; kp < 4; ++kp) y0 = y0 + *(const f32x4*)(P.partm + ((size_t)kp * 3072 + (size_t)(sl0 - 65536)) * D + 4 * lane + 256 * j); }
                    if (sl1 >= 65536) { y1 = (f32x4){0.f, 0.f, 0.f, 0.f}; for (int kp = 0; kp < 4; ++kp) y1 = y1 + *(const f32x4*)(P.partm + ((size_t)kp * 3072 + (size_t)(sl1 - 65536)) * D + 4 * lane + 256 * j); }
                    v[k][j] = v[k][j] + gf[j] * (y0 * p0 + y1 * p1);
                    if (!FINAL && rb + k < nr) { u32x2 w; w.x = pk2(v[k][j][0], v[k][j][1]); w.y = pk2(v[k][j][2], v[k][j][3]); *(u32x2*)(xb0 + (size_t)rk * D + 4 * lane + 256 * j) = w; } }
            }
            float s_ = 0.f;
#pragma unroll
            for (int j = 0; j < 4; ++j) s_ += (v[k][j][0] * v[k][j][0] + v[k][j][1] * v[k][j][1]) + (v[k][j][2] * v[k][j][2] + v[k][j][3] * v[k][j][3]);
            ss[k] = s_;
        }
#pragma unroll
        for (int o = 1; o < 64; o <<= 1)
#pragma unroll
            for (int k = 0; k < RB; ++k) ss[k] += shfl_x(ss[k], o, lane);
#pragma unroll
        for (int k = 0; k < RB; ++k) {
            if (rb + k < nr) {
                const int r = r0 + rb + k; const float rstd = rsqrtf(ss[k] * (1.0f / D) + EPS);
                if (FINAL) {
#pragma unroll
                    for (int j = 0; j < 4; ++j) *(f32x4*)(P.fout + (size_t)r * D + 4 * lane + 256 * j) = v[k][j] * rstd * gn[j];
                } else {
                    f32x4 h[4];
#pragma unroll
                    for (int j = 0; j < 4; ++j) {
                        if (ROUTER) { const f32x4 g_ = *(const f32x4*)(P.gain + 4 * lane + 256 * j), s_ = *(const f32x4*)(P.scale + ms * 6144 + 4 * lane + 256 * j) + 1.0f, t_ = *(const f32x4*)(P.shift + ms * 6144 + 4 * lane + 256 * j);
                            h[j] = (bf4(cur[k][j]) * rstd * g_) * s_ + t_; }
                        else h[j] = (v[k][j] * rstd * gn[j]) * scl[j] + sh[j];
                        u32x2 w; w.x = pk2(h[j][0], h[j][1]); w.y = pk2(h[j][2], h[j][3]);
                        *(u32x2*)(P.H + (size_t)r * D + 4 * lane + 256 * j) = w; }
                    if (ROUTER) {
                        float lg[8] = {0.f, 0.f, 0.f, 0.f, 0.f, 0.f, 0.f, 0.f};
#pragma unroll
                        for (int j = 0; j < 4; ++j)
#pragma unroll
                            for (int i = 0; i < 4; ++i) { const f32x4 w0 = rwr[4 * j + i][0], w1 = rwr[4 * j + i][1]; const float hv = h[j][i];
                                lg[0] += hv * w0[0]; lg[1] += hv * w0[1]; lg[2] += hv * w0[2]; lg[3] += hv * w0[3]; lg[4] += hv * w1[0]; lg[5] += hv * w1[1]; lg[6] += hv * w1[2]; lg[7] += hv * w1[3]; }
                        {
                            const bool b5 = (lane & 32) != 0, b4 = (lane & 16) != 0, b3 = (lane & 8) != 0;
                            float a4[4], a2[2];
#pragma unroll
                            for (int i = 0; i < 4; ++i) { const float snd = b5 ? lg[i] : lg[4 + i], kp_ = b5 ? lg[4 + i] : lg[i]; a4[i] = kp_ + shfl_x(snd, 32, lane); }
#pragma unroll
                            for (int i = 0; i < 2; ++i) { const float snd = b4 ? a4[i] : a4[2 + i], kp_ = b4 ? a4[2 + i] : a4[i]; a2[i] = kp_ + shfl_x(snd, 16, lane); }
                            float c1; { const float snd = b3 ? a2[0] : a2[1], kp_ = b3 ? a2[1] : a2[0]; c1 = kp_ + shfl_x(snd, 8, lane); }
                            c1 += shfl_x(c1, 4, lane); c1 += shfl_x(c1, 2, lane); c1 += shfl_x(c1, 1, lane);
#pragma unroll
                            for (int e = 0; e < 8; ++e) lg[e] = __builtin_bit_cast(float, __builtin_amdgcn_readlane(__builtin_bit_cast(int, c1), 8 * e));
                        }
                        int e0 = 0; float v0 = lg[0];
#pragma unroll
                        for (int e = 1; e < 8; ++e) if (lg[e] > v0) { v0 = lg[e]; e0 = e; }
                        int e1 = -1; float v1 = -3.0e38f;
#pragma unroll
                        for (int e = 0; e < 8; ++e) if (e != e0 && lg[e] > v1) { v1 = lg[e]; e1 = e; }
                        const float ex = expf(v1 - v0); const float q0 = 1.0f / (1.0f + ex), q1 = ex / (1.0f + ex);
                        const int rk0 = e0 == 0 ? rc0 : e0 == 1 ? rc1 : e0 == 2 ? rc2 : e0 == 3 ? rc3 : e0 == 4 ? rc4 : e0 == 5 ? rc5 : e0 == 6 ? rc6 : rc7;
                        const int rk1 = e1 == 0 ? rc0 : e1 == 1 ? rc1 : e1 == 2 ? rc2 : e1 == 3 ? rc3 : e1 == 4 ? rc4 : e1 == 5 ? rc5 : e1 == 6 ? rc6 : rc7;
                        rc0 += (e0 == 0) + (e1 == 0); rc1 += (e0 == 1) + (e1 == 1); rc2 += (e0 == 2) + (e1 == 2); rc3 += (e0 == 3) + (e1 == 3);
                        rc4 += (e0 == 4) + (e1 == 4); rc5 += (e0 == 5) + (e1 == 5); rc6 += (e0 == 6) + (e1 == 6); rc7 += (e0 == 7) + (e1 == 7);
                        if (lane == 0) { P.tope[2 * r] = e0; P.tope[2 * r + 1] = e1; P.toppo[2 * r] = q0; P.toppo[2 * r + 1] = q1; P.rank[2 * r] = rk0; P.rank[2 * r + 1] = rk1; }
                    }
                }
            }
        }
        if (it + 1 < ng) {
#pragma unroll
            for (int k = 0; k < RB; ++k)
#pragma unroll
                for (int j = 0; j < 4; ++j) { cur[k][j] = nxt[k][j]; if (COMBINE) { ya[k][j] = yan[k][j]; yb[k][j] = ybn[k][j]; } }
        }
    }
#undef RPB_LOAD
    if (ROUTER && lane == 0) { int* c = P.cnt + F.gw * 8; c[0] = rc0; c[1] = rc1; c[2] = rc2; c[3] = rc3; c[4] = rc4; c[5] = rc5; c[6] = rc6; c[7] = rc7; }
}

template <int NB, int NKS>
__device__ __forceinline__ void lm_load_a(const bf16_t* A, int lda, const int (&i0)[NB], int kc0, bf16x8 (&ap)[NB][NKS], int lane) {
    const int i16 = lane & 15, q = lane >> 4;
#pragma unroll
    for (int b = 0; b < NB; ++b)
#pragma unroll
        for (int ks = 0; ks < NKS; ++ks) ap[b][ks] = *(const bf16x8*)(A + (size_t)(i0[b] + i16) * lda + kc0 + ks * 32 + 8 * q);
}
template <int NB, int NKS>
__device__ __forceinline__ void lm_core(const bf16x8 (&ap)[NB][NKS], LAS unsigned char* X, f32x4 (&acc)[NB][8], int lane) {
    const int i16 = lane & 15, q = lane >> 4;
    const int xoff = (8 * q + (i16 >> 2)) * XRS + 8 * (i16 & 3);
#pragma unroll
    for (int ks = 0; ks < NKS; ++ks) {
        s16x4 lo[8], hi[8];
#pragma unroll
        for (int nt = 0; nt < 8; ++nt) {
            lo[nt] = __builtin_amdgcn_ds_read_tr16_b64_v4i16((LAS s16x4*)(X + ks * 32 * XRS + xoff + nt * 32));
            hi[nt] = __builtin_amdgcn_ds_read_tr16_b64_v4i16((LAS s16x4*)(X + ks * 32 * XRS + xoff + nt * 32 + 4 * XRS)); }
        __builtin_amdgcn_sched_barrier(0);
#pragma unroll
        for (int nt = 0; nt < 8; ++nt) { const bf16x8 xf = __builtin_shufflevector(lo[nt], hi[nt], 0, 1, 2, 3, 4, 5, 6, 7);
#pragma unroll
            for (int b = 0; b < NB; ++b) acc[b][nt] = __builtin_amdgcn_mfma_f32_16x16x32_bf16(xf, ap[b][ks], acc[b][nt], 0, 0, 0); }
    }
}
template <int NB> __device__ __forceinline__ void zero_acc(f32x4 (&acc)[NB][8]) {
#pragma unroll
    for (int b = 0; b < NB; ++b)
#pragma unroll
        for (int nt = 0; nt < 8; ++nt) acc[b][nt] = (f32x4){0.f, 0.f, 0.f, 0.f};
}
__device__ __forceinline__ void stage_rows(const bf16_t* src, size_t sstride, int nrows, LAS unsigned char* X, int xr0, int tid) {
    for (int i = tid; i < nrows * 16; i += 512) { const int r = i >> 4, ch = i & 15; *(LAS u32x4*)(X + (xr0 + r) * XRS + ch * 16) = *(const u32x4*)(src + (size_t)r * sstride + ch * 8); }
}

__device__ __forceinline__ void fft_stage_a(const Ctx& F, unsigned* wq) {
    const bf16_t* PZ = (const bf16_t*)(F.ws + WS_PZUV); bf16_t* UP = (bf16_t*)(F.ws + WS_UP); bf16_t* Y = (bf16_t*)(F.ws + WS_H);
    const bf16_t* FA = (const bf16_t*)(F.ws + WS_FA); const bf16_t* FX = (const bf16_t*)(F.ws + WS_FX);
    LAS unsigned char* X = F.lds; const int lane = F.lane, w = F.wave, i16 = lane & 15, q = lane >> 4;
    volatile LAS unsigned* slot = (volatile LAS unsigned*)(F.lds + MISC_OFF + 64);
    bf16x8 apA[2][8]; { const int i0[2] = {16 * w, 128 + 16 * w}; lm_load_a<2, 8>(FA, 256, i0, 0, apA, lane); }
    for (int it0 = F.bid; it0 < 1024 + 16; ) {
        const int it = it0 < 16 ? 1024 + it0 : it0 - 16;
        if (it < 1024) {
            const int t2 = it & 127, g = (it >> 7) & 3, b = it >> 9;
            const bf16_t* src = PZ + ((size_t)b * TL + t2) * NEIN + g * 128;
            stage_rows(src, (size_t)128 * NEIN, 128, X, 0, F.tid);
            stage_rows(src + 512, (size_t)128 * NEIN, 128, X, 128, F.tid);
            __syncthreads();
            f32x4 acc[2][8]; zero_acc<2>(acc);
            lm_core<2, 8>(apA, X, acc, lane);
            const int k1 = 16 * w + i16; float sw, cw; sincosf(6.283185307179586f * (float)((k1 * t2) & 16383) / 16384.0f, &sw, &cw);
            bf16_t* orow = UP + ((size_t)((b * 4 + g) * 128 + k1) * 128 + t2) * 256;
#pragma unroll
            for (int nt = 0; nt < 8; ++nt) { const f32x4 ur = acc[0][nt], ui = acc[1][nt]; const int n = 16 * nt + 4 * q;
                u32x2 wr_, wi_; wr_.x = pk2(ur[0] * cw - ui[0] * sw, ur[1] * cw - ui[1] * sw); wr_.y = pk2(ur[2] * cw - ui[2] * sw, ur[3] * cw - ui[3] * sw);
                wi_.x = pk2(ur[0] * sw + ui[0] * cw, ur[1] * sw + ui[1] * cw); wi_.y = pk2(ur[2] * sw + ui[2] * cw, ur[3] * sw + ui[3] * cw);
                *(u32x2*)(orow + n) = wr_; *(u32x2*)(orow + 128 + n) = wi_; }
            __syncthreads();
        } else {
            const int ci = it - 1024, kh = ci & 1, g = (ci >> 1) & 3, b = ci >> 3;
            f32x4 acc[1][8]; zero_acc<1>(acc); const int i0[1] = {128 * kh + 16 * w};
            for (int c = 0; c < 2; ++c) {
                bf16x8 apx[1][8]; lm_load_a<1, 8>(FX, 512, i0, c * 256, apx, lane);
                stage_rows(PZ + ((size_t)ML + b * TCX) * NEIN + c * 512 + g * 128, NEIN, 256, X, 0, F.tid);
                __syncthreads();
                lm_core<1, 8>(apx, X, acc, lane);
                __syncthreads();
            }
            const int k = 128 * kh + 16 * w + i16; bf16_t* orow = Y + ((size_t)ML + b * TCX + k) * D + g * 128; const float nrm = 0.005524271728019903f;
#pragma unroll
            for (int nt = 0; nt < 8; ++nt) { const f32x4 a = acc[0][nt] * nrm; u32x2 o; o.x = pk2(a[0], a[1]); o.y = pk2(a[2], a[3]); *(u32x2*)(orow + 16 * nt + 4 * q) = o; }
        }
        WQ_NEXT(it0, wq, slot, F.G);
    }
}
__device__ __forceinline__ void fft_stage_c_gmlp(const Ctx& F, int j, unsigned* wq) {
    const bf16_t* PZ = (const bf16_t*)(F.ws + WS_PZUV); const bf16_t* UP = (const bf16_t*)(F.ws + WS_UP); bf16_t* Y = (bf16_t*)(F.ws + WS_H);
    const bf16_t* FC = (const bf16_t*)(F.ws + WS_FC); const bf16_t* GW = (const bf16_t*)(F.ws + WS_GW) + (size_t)j * 4 * 128 * 128;
    const float* gb = FIN(I_GB) + j * 512;
    LAS unsigned char* X = F.lds; const int lane = F.lane, w = F.wave, i16 = lane & 15, q = lane >> 4, tid = F.tid;
    volatile LAS unsigned* slot = (volatile LAS unsigned*)(F.lds + MISC_OFF + 64);
    bf16x8 apC[1][8]; { const int i0[1] = {16 * w}; lm_load_a<1, 8>(FC, 256, i0, 0, apC, lane); }
    for (int it = F.bid; it < 1024 + 1040; ) {
        if (it < 1024) {
            const int k1 = it & 127, g = (it >> 7) & 3, b = it >> 9;
            const bf16_t* src = UP + (size_t)((b * 4 + g) * 128 + k1) * 128 * 256;
            stage_rows(src, 256, 128, X, 0, tid);
            stage_rows(src + 128, 256, 128, X, 128, tid);
            __syncthreads();
            f32x4 acc[1][8]; zero_acc<1>(acc);
            lm_core<1, 8>(apC, X, acc, lane);
            const int k2 = 16 * w + i16; bf16_t* orow = Y + ((size_t)b * TL + k1 + 128 * k2) * D + g * 128; const float nrm = 0.0006905339660024878f;
#pragma unroll
            for (int nt = 0; nt < 8; ++nt) { const f32x4 a = acc[0][nt] * nrm; u32x2 o; o.x = pk2(a[0], a[1]); o.y = pk2(a[2], a[3]); *(u32x2*)(orow + 16 * nt + 4 * q) = o; }
            __syncthreads();
        } else {
            const int gi = it - 1024, h = gi & 3, ck = gi >> 2; const size_t r0 = (size_t)ck * 128;
            bf16x8 apg[1][4]; { const int i0[1] = {16 * w}; lm_load_a<1, 4>(GW + (size_t)h * 128 * 128, 128, i0, 0, apg, lane); }
            u32x4 raw4[4];
#pragma unroll
            for (int i4 = 0; i4 < 4; ++i4) { const int i = tid + 512 * i4, r = i >> 4, ch = i & 15; raw4[i4] = *(const u32x4*)(PZ + (r0 + r) * NEIN + 1536 + h * 128 + ch * 8); }
            __builtin_amdgcn_sched_barrier(0);
#pragma unroll
            for (int i4 = 0; i4 < 4; ++i4) { const int i = tid + 512 * i4, r = i >> 4, ch = i & 15; const u32x4 raw = raw4[i4];
                float x[8] = {bflo(raw.x), bfhi(raw.x), bflo(raw.y), bfhi(raw.y), bflo(raw.z), bfhi(raw.z), bflo(raw.w), bfhi(raw.w)};
                float s = 0.f;
#pragma unroll
                for (int e = 0; e < 8; ++e) s += x[e];
                s += shfl_x(s, 1, lane); s += shfl_x(s, 2, lane); s += shfl_x(s, 4, lane); s += shfl_x(s, 8, lane);
                const float mean = s * (1.0f / 128.0f); float qq = 0.f;
#pragma unroll
                for (int e = 0; e < 8; ++e) { x[e] -= mean; qq += x[e] * x[e]; }
                qq += shfl_x(qq, 1, lane); qq += shfl_x(qq, 2, lane); qq += shfl_x(qq, 4, lane); qq += shfl_x(qq, 8, lane);
                const float rs = rsqrtf(qq * (1.0f / 128.0f) + EPS);
                u32x4 o; o.x = pk2(x[0] * rs, x[1] * rs); o.y = pk2(x[2] * rs, x[3] * rs); o.z = pk2(x[4] * rs, x[5] * rs); o.w = pk2(x[6] * rs, x[7] * rs);
                *(LAS u32x4*)(X + r * XRS + ch * 16) = o; }
            const int t = 16 * w + i16; const float bias = gb[h * 128 + t];
            const bf16_t* urow = PZ + (r0 + t) * NEIN + 1024 + h * 128; bf16_t* orow = Y + (r0 + t) * D + 512 + h * 128;
            u32x2 uu8[8];
#pragma unroll
            for (int nt = 0; nt < 8; ++nt) uu8[nt] = *(const u32x2*)(urow + 16 * nt + 4 * q);
            __syncthreads();
            f32x4 acc[1][8]; zero_acc<1>(acc);
            lm_core<1, 4>(apg, X, acc, lane);
            __builtin_amdgcn_sched_barrier(0);
#pragma unroll
            for (int nt = 0; nt < 8; ++nt) { const int n = 16 * nt + 4 * q; const u32x2 uu = uu8[nt]; const f32x4 a = acc[0][nt];
                u32x2 o; o.x = pk2(bflo(uu.x) * (a[0] + bias), bfhi(uu.x) * (a[1] + bias)); o.y = pk2(bflo(uu.y) * (a[2] + bias), bfhi(uu.y) * (a[3] + bias)); *(u32x2*)(orow + n) = o; }
            __syncthreads();
        }
        WQ_NEXT(it, wq, slot, F.G);
    }
}

constexpr int S2_KT = 0, S2_QT = 36864, S2_V = 73728, S2_SC = 110592, S2_EB = 120832, S2_EBL = 122880, S2_RED = 124928, S2_END = 129024;
static_assert(S2_END <= MISC_OFF, "scan LDS");
constexpr int SCRS = 80;
template <bool NEEDQ>
__device__ __forceinline__ void half_prep(const Ctx& F, const bf16_t* P5, size_t hrow, bool rev, int h, int dir) {
    const int tid = F.tid, ck = F.wave >> 1, dk = ((F.wave & 1) << 6) + F.lane; LAS unsigned char* L = F.lds;
#pragma unroll
    for (int it = 0; it < 4; ++it) { const int idx = tid + 512 * it, p = idx >> 4, ch = idx & 15; const size_t r = hrow + (rev ? 127 - p : p); const bf16_t* rp = P5 + ((size_t)h * MT + r) * 640 + ch * 8;
        *(LAS u32x4*)(L + S2_KT + p * XRS + ch * 16) = *(const u32x4*)(rp + (2 + dir) * 128);
        if (NEEDQ) *(LAS u32x4*)(L + S2_QT + p * XRS + ch * 16) = *(const u32x4*)(rp);
        *(LAS u32x4*)(L + S2_V + p * XRS + ch * 16) = *(const u32x4*)(rp + 4 * 128); }
    __syncthreads();
    float b = 0.f; LAS unsigned char* kt = L + S2_KT + (32 * ck) * XRS + dk * 2; LAS unsigned char* qt = L + S2_QT + (32 * ck) * XRS + dk * 2;
    bf16_t lfr[32], qr[32];
#pragma unroll
    for (int i = 0; i < 32; ++i) { lfr[i] = *(const LAS bf16_t*)(kt + i * XRS); if (NEEDQ) qr[i] = *(const LAS bf16_t*)(qt + i * XRS); }
    __builtin_amdgcn_sched_barrier(0);
#pragma unroll
    for (int i = 0; i < 32; ++i) { const float lf = bf2f(lfr[i]); b += lf;
        const float kk = (1.0f - __expf(lf)) * __expf(fminf(-b, 80.0f));
        *(LAS bf16_t*)(kt + i * XRS) = (bf16_t)f2bf(kk);
        if (NEEDQ) *(LAS bf16_t*)(qt + i * XRS) = (bf16_t)f2bf(bf2f(qr[i]) * __expf(b)); }
    ((LAS float*)(L + S2_EB))[ck * 128 + dk] = __expf(b);
    ((LAS float*)(L + S2_EBL))[ck * 128 + dk] = b;
}
__device__ __forceinline__ void prep1_issue(const Ctx& F, const bf16_t* P5, size_t hrow, bool rev, int h, int dir, u32x4 (&pf)[8]) {
    const int tid = F.tid;
#pragma unroll
    for (int it = 0; it < 4; ++it) { const int idx = tid + 512 * it, p = idx >> 4, ch = idx & 15; const size_t r = hrow + (rev ? 127 - p : p); const bf16_t* rp = P5 + ((size_t)h * MT + r) * 640 + ch * 8;
        pf[2 * it] = *(const u32x4*)(rp + (2 + dir) * 128); pf[2 * it + 1] = *(const u32x4*)(rp + 4 * 128); }
}
__device__ __forceinline__ void prep1_commit(const Ctx& F, const u32x4 (&pf)[8]) {
    const int tid = F.tid, ck = F.wave >> 1, dk = ((F.wave & 1) << 6) + F.lane; LAS unsigned char* L = F.lds;
#pragma unroll
    for (int it = 0; it < 4; ++it) { const int idx = tid + 512 * it, p = idx >> 4, ch = idx & 15;
        *(LAS u32x4*)(L + S2_KT + p * XRS + ch * 16) = pf[2 * it]; *(LAS u32x4*)(L + S2_V + p * XRS + ch * 16) = pf[2 * it + 1]; }
    __syncthreads();
    float b = 0.f; LAS unsigned char* kt = L + S2_KT + (32 * ck) * XRS + dk * 2;
    bf16_t lfr[32];
#pragma unroll
    for (int i = 0; i < 32; ++i) lfr[i] = *(const LAS bf16_t*)(kt + i * XRS);
    __builtin_amdgcn_sched_barrier(0);
#pragma unroll
    for (int i = 0; i < 32; ++i) { const float lf = bf2f(lfr[i]); b += lf; *(LAS bf16_t*)(kt + i * XRS) = (bf16_t)f2bf((1.0f - __expf(lf)) * __expf(fminf(-b, 80.0f))); }
    ((LAS float*)(L + S2_EB))[ck * 128 + dk] = __expf(b);
    ((LAS float*)(L + S2_EBL))[ck * 128 + dk] = b;
}
__device__ __forceinline__ void state_update(const Ctx& F, f32x4 (&st)[8], int ck) {
    LAS unsigned char* L = F.lds; const int lane = F.lane, i16 = lane & 15, q = lane >> 4, w = F.wave;
    const int roff = (32 * ck + 8 * q + (i16 >> 2)) * XRS + 8 * (i16 & 3);
    s16x4 vlo = __builtin_amdgcn_ds_read_tr16_b64_v4i16((LAS s16x4*)(L + S2_V + roff + w * 32));
    s16x4 vhi = __builtin_amdgcn_ds_read_tr16_b64_v4i16((LAS s16x4*)(L + S2_V + roff + w * 32 + 4 * XRS));
    const bf16x8 vf = __builtin_shufflevector(vlo, vhi, 0, 1, 2, 3, 4, 5, 6, 7);
#pragma unroll
    for (int hb = 0; hb < 2; ++hb) {
        s16x4 klo[4], khi[4]; f32x4 eb[4];
#pragma unroll
        for (int k4 = 0; k4 < 4; ++k4) { const int kb = 4 * hb + k4;
            klo[k4] = __builtin_amdgcn_ds_read_tr16_b64_v4i16((LAS s16x4*)(L + S2_KT + roff + kb * 32));
            khi[k4] = __builtin_amdgcn_ds_read_tr16_b64_v4i16((LAS s16x4*)(L + S2_KT + roff + kb * 32 + 4 * XRS)); }
#pragma unroll
        for (int k4 = 0; k4 < 4; ++k4) eb[k4] = *(const LAS f32x4*)(L + S2_EB + (ck * 128 + 16 * (4 * hb + k4) + 4 * q) * 4);
        __builtin_amdgcn_sched_barrier(0);
#pragma unroll
        for (int k4 = 0; k4 < 4; ++k4) st[4 * hb + k4] = __builtin_amdgcn_mfma_f32_16x16x32_bf16(__builtin_shufflevector(klo[k4], khi[k4], 0, 1, 2, 3, 4, 5, 6, 7), vf, st[4 * hb + k4], 0, 0, 0);
#pragma unroll
        for (int k4 = 0; k4 < 4; ++k4) st[4 * hb + k4] = st[4 * hb + k4] * eb[k4];
        __builtin_amdgcn_sched_barrier(0);
    }
}
__device__ __forceinline__ void state_load(const float* src, f32x4 (&st)[8], int w, int lane) {
    const float* p0 = src + w * 2048 + lane; const float* p1 = p0 + 1024;
#pragma unroll
    for (int kb = 0; kb < 8; ++kb)
#pragma unroll
        for (int rg = 0; rg < 4; ++rg) st[kb][rg] = src ? (kb < 4 ? p0[(kb * 4 + rg) * 64] : p1[((kb - 4) * 4 + rg) * 64]) : 0.f;
}
__device__ __forceinline__ void state_store(float* dst, const f32x4 (&st)[8], int w, int lane) {
    float* p0 = dst + w * 2048 + lane; float* p1 = p0 + 1024;
#pragma unroll
    for (int kb = 0; kb < 8; ++kb)
#pragma unroll
        for (int rg = 0; rg < 4; ++rg) { if (kb < 4) p0[(kb * 4 + rg) * 64] = st[kb][rg]; else p1[((kb - 4) * 4 + rg) * 64] = st[kb][rg]; }
}
__device__ __forceinline__ void scan_pass1_item(const Ctx& F, const bf16_t* P5, int b, int h, int dir, int seg, float* SST, float* EG) {
    const int chain = (b * 8 + h) * 2 + dir; const size_t rowb = (size_t)b * TL + (size_t)seg * SEGL;
    f32x4 st[8]; state_load(nullptr, st, F.wave, F.lane);
    float gacc = 0.f;
    u32x4 pf[8];
    prep1_issue(F, P5, rowb + 128 * (dir ? 1 : 0), dir != 0, h, dir, pf);
    for (int hs = 0; hs < 2; ++hs) {
        prep1_commit(F, pf);
        __syncthreads();
        if (hs == 0) prep1_issue(F, P5, rowb + 128 * (dir ? 0 : 1), dir != 0, h, dir, pf);
        if (F.tid < 128) { const LAS float* ebl = (const LAS float*)(F.lds + S2_EBL); gacc += (ebl[F.tid] + ebl[128 + F.tid]) + (ebl[256 + F.tid] + ebl[384 + F.tid]); }
#pragma unroll 1
        for (int ck = 0; ck < 4; ++ck) { state_update(F, st, ck); __builtin_amdgcn_sched_barrier(0); }
        __syncthreads();
    }
    state_store(SST + ((size_t)chain * NSEG + seg) * 16384, st, F.wave, F.lane);
    if (F.tid < 128) EG[((size_t)chain * NSEG + seg) * 128 + F.tid] = __expf(gacc);
}
__device__ __forceinline__ void half_scores(const Ctx& F) {
    LAS unsigned char* L = F.lds; const int lane = F.lane, i16 = lane & 15, q = lane >> 4, w = F.wave, ck = w >> 1, u = w & 1;
#pragma unroll
    for (int tt = 0; tt < 2; ++tt) {
        const int ti = u == 0 ? tt : 1 - tt, si = u == 0 ? tt : tt;
        f32x4 sc = (f32x4){0.f, 0.f, 0.f, 0.f};
        if (si <= ti) {
#pragma unroll
            for (int ks = 0; ks < 4; ++ks) { const bf16x8 a = *(const LAS bf16x8*)(L + S2_QT + (32 * ck + 16 * ti + i16) * XRS + (32 * ks + 8 * q) * 2); const bf16x8 bb = *(const LAS bf16x8*)(L + S2_KT + (32 * ck + 16 * si + i16) * XRS + (32 * ks + 8 * q) * 2);
                sc = __builtin_amdgcn_mfma_f32_16x16x32_bf16(a, bb, sc, 0, 0, 0); }
        }
#pragma unroll
        for (int rg = 0; rg < 4; ++rg) { const int t = 16 * ti + 4 * q + rg, sidx = 16 * si + i16; *(LAS bf16_t*)(L + S2_SC + (32 * ck + t) * SCRS + sidx * 2) = (bf16_t)f2bf(sidx <= t ? sc[rg] : 0.f); }
    }
}
__device__ __forceinline__ void chunk_out(const Ctx& F, const f32x4 (&st)[8], int ck, f32x4 (&o)[2]) {
    LAS unsigned char* L = F.lds; const int lane = F.lane, i16 = lane & 15, q = lane >> 4, w = F.wave;
    const int roff = (32 * ck + 8 * q + (i16 >> 2)) * XRS + 8 * (i16 & 3);
    o[0] = (f32x4){0.f, 0.f, 0.f, 0.f}; o[1] = (f32x4){0.f, 0.f, 0.f, 0.f};
    s16x4 vlo = __builtin_amdgcn_ds_read_tr16_b64_v4i16((LAS s16x4*)(L + S2_V + roff + w * 32));
    s16x4 vhi = __builtin_amdgcn_ds_read_tr16_b64_v4i16((LAS s16x4*)(L + S2_V + roff + w * 32 + 4 * XRS));
    bf16x8 pf[2];
#pragma unroll
    for (int ti = 0; ti < 2; ++ti) pf[ti] = *(const LAS bf16x8*)(L + S2_SC + (32 * ck + 16 * ti + i16) * SCRS + (8 * q) * 2);
#pragma unroll
    for (int kh = 0; kh < 2; ++kh) {
        u32x2 qlo[2][2], qhi[2][2]; bf16x8 sf[2];
#pragma unroll
        for (int k2 = 0; k2 < 2; ++k2) { const int ks = 2 * kh + k2;
#pragma unroll
            for (int ti = 0; ti < 2; ++ti) { const LAS unsigned char* qrow = L + S2_QT + (32 * ck + 16 * ti + i16) * XRS + (32 * ks + 4 * q) * 2; qlo[k2][ti] = *(const LAS u32x2*)(qrow); qhi[k2][ti] = *(const LAS u32x2*)(qrow + 32); }
            u32x4 sp; sp.x = pk2(st[2 * ks][0], st[2 * ks][1]); sp.y = pk2(st[2 * ks][2], st[2 * ks][3]); sp.z = pk2(st[2 * ks + 1][0], st[2 * ks + 1][1]); sp.w = pk2(st[2 * ks + 1][2], st[2 * ks + 1][3]); sf[k2] = __builtin_bit_cast(bf16x8, sp); }
        __builtin_amdgcn_sched_barrier(0);
#pragma unroll
        for (int k2 = 0; k2 < 2; ++k2)
#pragma unroll
            for (int ti = 0; ti < 2; ++ti) { u32x4 qp; qp.x = qlo[k2][ti].x; qp.y = qlo[k2][ti].y; qp.z = qhi[k2][ti].x; qp.w = qhi[k2][ti].y;
                o[ti] = __builtin_amdgcn_mfma_f32_16x16x32_bf16(sf[k2], __builtin_bit_cast(bf16x8, qp), o[ti], 0, 0, 0); }
        __builtin_amdgcn_sched_barrier(0);
    }
    const bf16x8 vf = __builtin_shufflevector(vlo, vhi, 0, 1, 2, 3, 4, 5, 6, 7);
#pragma unroll
    for (int ti = 0; ti < 2; ++ti) o[ti] = __builtin_amdgcn_mfma_f32_16x16x32_bf16(vf, pf[ti], o[ti], 0, 0, 0);
}
__device__ __forceinline__ void rows_g2l(const bf16_t* g, size_t row0, int rstep, int c0, LAS unsigned char* T, int tid) {
#pragma unroll
    for (int it = 0; it < 4; ++it) { const int idx = tid + 512 * it, p = idx >> 4, ch = idx & 15; *(LAS u32x4*)(T + p * XRS + ch * 16) = *(const u32x4*)(g + (size_t)((long)row0 + (long)rstep * p) * D + c0 + ch * 8); }
}
__device__ __forceinline__ void rows_l2g(bf16_t* g, size_t row0, int rstep, int c0, const LAS unsigned char* T, int tid) {
#pragma unroll
    for (int it = 0; it < 4; ++it) { const int idx = tid + 512 * it, p = idx >> 4, ch = idx & 15; *(u32x4*)(g + (size_t)((long)row0 + (long)rstep * p) * D + c0 + ch * 8) = *(const LAS u32x4*)(T + p * XRS + ch * 16); }
}
__device__ __forceinline__ void scan_pass3_item(const Ctx& F, const bf16_t* P5, size_t rowb, int h, const float* sin_f, const float* sin_b, float* fin_f, float* fin_b, const float* gain, bf16_t* OFT, bf16_t* Y, bool writey) {
    LAS unsigned char* L = F.lds; int lane = F.lane; asm volatile("" : "+v"(lane));
    const int i16 = lane & 15, q = lane >> 4, w = F.wave;
    const int colo = h * 128 + 16 * w + 4 * q;
    f32x4 st[8];
    state_load(sin_f, st, w, lane);
    for (int hs = 0; hs < 2; ++hs) {
        const size_t hrow = rowb + 128 * hs;
        half_prep<true>(F, P5, hrow, false, h, 0);
        __syncthreads();
        half_scores(F);
        __syncthreads();
        u32x2 of[4][2];
#pragma unroll
        for (int ck = 0; ck < 4; ++ck) { f32x4 o[2]; chunk_out(F, st, ck, o);
#pragma unroll
            for (int ti = 0; ti < 2; ++ti) { of[ck][ti].x = pk2(o[ti][0], o[ti][1]); of[ck][ti].y = pk2(o[ti][2], o[ti][3]); }
            __builtin_amdgcn_sched_barrier(0);
            state_update(F, st, ck);
            __builtin_amdgcn_sched_barrier(0); }
        __syncthreads();
#pragma unroll
        for (int ck = 0; ck < 4; ++ck)
#pragma unroll
            for (int ti = 0; ti < 2; ++ti) *(LAS u32x2*)(L + S2_QT + (32 * ck + 16 * ti + i16) * XRS + (16 * w + 4 * q) * 2) = of[ck][ti];
        __syncthreads();
        rows_l2g(OFT, hrow, 1, h * 128, L + S2_QT, F.tid);
        __syncthreads();
    }
    if (fin_f) state_store(fin_f, st, w, lane);
    state_load(sin_b, st, w, lane);
    const f32x4 gv = *(const f32x4*)(gain + colo);
    for (int hs = 0; hs < 2; ++hs) {
        const size_t hrow = rowb + 128 * (1 - hs);
        half_prep<true>(F, P5, hrow, true, h, 1);
        __syncthreads();
        half_scores(F);
        __syncthreads();
        LAS float* RED = (LAS float*)(L + S2_RED);
        f32x4 oa[4][2];
#pragma unroll
        for (int ck = 0; ck < 4; ++ck) { chunk_out(F, st, ck, oa[ck]);
            __builtin_amdgcn_sched_barrier(0);
            state_update(F, st, ck);
            __builtin_amdgcn_sched_barrier(0); }
        __syncthreads();
        rows_g2l(OFT, hrow + 127, -1, h * 128, L + S2_QT, F.tid);
        if (writey) {
#pragma unroll
            for (int it = 0; it < 4; ++it) { const int idx = F.tid + 512 * it, p = idx >> 4, ch = idx & 15; *(LAS u32x4*)(L + S2_KT + p * XRS + ch * 16) = *(const u32x4*)(P5 + ((size_t)h * MT + (hrow + 127 - p)) * 640 + 128 + ch * 8); } }
        __syncthreads();
#pragma unroll
        for (int ck = 0; ck < 4; ++ck)
#pragma unroll
            for (int ti = 0; ti < 2; ++ti) { const int p = 32 * ck + 16 * ti + i16; const u32x2 f = *(const LAS u32x2*)(L + S2_QT + p * XRS + (16 * w + 4 * q) * 2);
                oa[ck][ti][0] += bflo(f.x); oa[ck][ti][1] += bfhi(f.x); oa[ck][ti][2] += bflo(f.y); oa[ck][ti][3] += bfhi(f.y);
                float ss = (oa[ck][ti][0] * oa[ck][ti][0] + oa[ck][ti][1] * oa[ck][ti][1]) + (oa[ck][ti][2] * oa[ck][ti][2] + oa[ck][ti][3] * oa[ck][ti][3]);
                ss += shfl_x(ss, 16, lane); ss += shfl_x(ss, 32, lane);
                if (q == 0) RED[w * 128 + p] = ss; __builtin_amdgcn_sched_barrier(0); }
        __syncthreads();
        if (writey) {
#pragma unroll
            for (int ck = 0; ck < 4; ++ck)
#pragma unroll
                for (int ti = 0; ti < 2; ++ti) { __builtin_amdgcn_sched_barrier(0); const int p = 32 * ck + 16 * ti + i16; float tot = 0.f;
#pragma unroll
                    for (int ww = 0; ww < 8; ++ww) tot += RED[ww * 128 + p];
                    const float rs = rsqrtf(tot * (1.0f / 128.0f) + EPS);
                    const u32x2 sg = *(const LAS u32x2*)(L + S2_KT + p * XRS + (16 * w + 4 * q) * 2);
                    u32x2 y; y.x = pk2(oa[ck][ti][0] * rs * gv[0] * bflo(sg.x), oa[ck][ti][1] * rs * gv[1] * bfhi(sg.x)); y.y = pk2(oa[ck][ti][2] * rs * gv[2] * bflo(sg.y), oa[ck][ti][3] * rs * gv[3] * bfhi(sg.y));
                    *(LAS u32x2*)(L + S2_V + p * XRS + (16 * w + 4 * q) * 2) = y; }
            __syncthreads();
            rows_l2g(Y, hrow + 127, -1, h * 128, L + S2_V, F.tid);
        }
        __syncthreads();
    }
    if (fin_b) state_store(fin_b, st, w, lane);
}
constexpr int G2_KT = 0, G2_QT = 18432, G2_V = 36864, G2_SC = 55296, G2_EB = 60416, G2_EBL = 61440, G2_RED = 62464, G2_SLOT = 63488, G2_BYTES = 65536;
static_assert(2 * G2_BYTES <= MISC_OFF, "two-group scan LDS");
struct GC { LAS unsigned char* L; int tid, lane, wg; LAS unsigned* bar; unsigned epoch; };
__device__ __forceinline__ void gsync(GC& G) {
    asm volatile("s_waitcnt vmcnt(0) lgkmcnt(0)" ::: "memory");
    G.epoch += 4u;
    if (G.lane == 0) (void)__hip_atomic_fetch_add(G.bar, 1u, __ATOMIC_RELAXED, __HIP_MEMORY_SCOPE_WORKGROUP);
    while (__hip_atomic_load(G.bar, __ATOMIC_RELAXED, __HIP_MEMORY_SCOPE_WORKGROUP) < G.epoch) __builtin_amdgcn_s_sleep(0);
    asm volatile("" ::: "memory");
}
__device__ __forceinline__ void gsync_l(GC& G) {
    asm volatile("s_waitcnt lgkmcnt(0)" ::: "memory");
    G.epoch += 4u;
    if (G.lane == 0) (void)__hip_atomic_fetch_add(G.bar, 1u, __ATOMIC_RELAXED, __HIP_MEMORY_SCOPE_WORKGROUP);
    while (__hip_atomic_load(G.bar, __ATOMIC_RELAXED, __HIP_MEMORY_SCOPE_WORKGROUP) < G.epoch) __builtin_amdgcn_s_sleep(0);
    asm volatile("" ::: "memory");
}
__device__ __forceinline__ void quarter_load1(const GC& G, const bf16_t* P5, size_t hrow, bool rev, int h, int dir, u32x4 (&rk)[4], u32x4 (&rv)[4]) {
#pragma unroll
    for (int it = 0; it < 4; ++it) { const int idx = G.tid + 256 * it, p = idx >> 4, ch = idx & 15; const size_t r = hrow + (rev ? 63 - p : p); const bf16_t* rp = P5 + ((size_t)h * MT + r) * 640 + ch * 8;
        rk[it] = *(const u32x4*)(rp + (2 + dir) * 128); rv[it] = *(const u32x4*)(rp + 4 * 128); }
}
__device__ __forceinline__ void quarter_prep1(GC& G, const u32x4 (&rk)[4], const u32x4 (&rv)[4]) {
    const int tid = G.tid, ck = G.wg >> 1, dk = ((G.wg & 1) << 6) + G.lane; LAS unsigned char* L = G.L;
#pragma unroll
    for (int it = 0; it < 4; ++it) { const int idx = tid + 256 * it, p = idx >> 4, ch = idx & 15;
        *(LAS u32x4*)(L + G2_KT + p * XRS + ch * 16) = rk[it]; *(LAS u32x4*)(L + G2_V + p * XRS + ch * 16) = rv[it]; }
}
__device__ __forceinline__ void quarter_cols1(GC& G) {
    const int ck = G.wg >> 1, dk = ((G.wg & 1) << 6) + G.lane; LAS unsigned char* L = G.L;
    float b = 0.f; LAS unsigned char* kt = L + G2_KT + (32 * ck) * XRS + dk * 2;
    bf16_t lfr[32];
#pragma unroll
    for (int i = 0; i < 32; ++i) lfr[i] = *(const LAS bf16_t*)(kt + i * XRS);
    __builtin_amdgcn_sched_barrier(0);
#pragma unroll
    for (int i = 0; i < 32; ++i) { const float lf = bf2f(lfr[i]); b += lf;
        *(LAS bf16_t*)(kt + i * XRS) = (bf16_t)f2bf((1.0f - __expf(lf)) * __expf(fminf(-b, 80.0f))); }
    ((LAS float*)(L + G2_EB))[ck * 128 + dk] = __expf(b);
    ((LAS float*)(L + G2_EBL))[ck * 128 + dk] = b;
}
template <bool NEEDQ>
__device__ __forceinline__ void quarter_prep(GC& G, const bf16_t* P5, size_t hrow, bool rev, int h, int dir) {
    const int tid = G.tid, ck = G.wg >> 1, dk = ((G.wg & 1) << 6) + G.lane; LAS unsigned char* L = G.L;
    {
        u32x4 rk_[4], rq_[4], rv_[4];
#pragma unroll
        for (int it = 0; it < 4; ++it) { const int idx = tid + 256 * it, p = idx >> 4, ch = idx & 15; const size_t r = hrow + (rev ? 63 - p : p); const bf16_t* rp = P5 + ((size_t)h * MT + r) * 640 + ch * 8;
            rk_[it] = *(const u32x4*)(rp + (2 + dir) * 128); if (NEEDQ) rq_[it] = *(const u32x4*)(rp); rv_[it] = *(const u32x4*)(rp + 4 * 128); }
        __builtin_amdgcn_sched_barrier(0);
#pragma unroll
        for (int it = 0; it < 4; ++it) { const int idx = tid + 256 * it, p = idx >> 4, ch = idx & 15;
            *(LAS u32x4*)(L + G2_KT + p * XRS + ch * 16) = rk_[it]; if (NEEDQ) *(LAS u32x4*)(L + G2_QT + p * XRS + ch * 16) = rq_[it]; *(LAS u32x4*)(L + G2_V + p * XRS + ch * 16) = rv_[it]; }
    }
    gsync(G);
    float b = 0.f; LAS unsigned char* kt = L + G2_KT + (32 * ck) * XRS + dk * 2; LAS unsigned char* qt = L + G2_QT + (32 * ck) * XRS + dk * 2;
    bf16_t lfr[32], qr[32];
#pragma unroll
    for (int i = 0; i < 32; ++i) { lfr[i] = *(const LAS bf16_t*)(kt + i * XRS); if (NEEDQ) qr[i] = *(const LAS bf16_t*)(qt + i * XRS); }
    __builtin_amdgcn_sched_barrier(0);
#pragma unroll
    for (int i = 0; i < 32; ++i) { const float lf = bf2f(lfr[i]); b += lf;
        *(LAS bf16_t*)(kt + i * XRS) = (bf16_t)f2bf((1.0f - __expf(lf)) * __expf(fminf(-b, 80.0f)));
        if (NEEDQ) *(LAS bf16_t*)(qt + i * XRS) = (bf16_t)f2bf(bf2f(qr[i]) * __expf(b)); }
    ((LAS float*)(L + G2_EB))[ck * 128 + dk] = __expf(b);
    ((LAS float*)(L + G2_EBL))[ck * 128 + dk] = b;
}
__device__ __forceinline__ void state_update_g(const GC& G, f32x4 (&st)[2][8], int ck) {
    LAS unsigned char* L = G.L; const int lane = G.lane, i16 = lane & 15, q = lane >> 4, wg = G.wg;
    const int roff = (32 * ck + 8 * q + (i16 >> 2)) * XRS + 8 * (i16 & 3);
    bf16x8 vf[2];
#pragma unroll
    for (int ct = 0; ct < 2; ++ct) { const s16x4 vlo = __builtin_amdgcn_ds_read_tr16_b64_v4i16((LAS s16x4*)(L + G2_V + roff + (2 * wg + ct) * 32));
        const s16x4 vhi = __builtin_amdgcn_ds_read_tr16_b64_v4i16((LAS s16x4*)(L + G2_V + roff + (2 * wg + ct) * 32 + 4 * XRS)); vf[ct] = __builtin_shufflevector(vlo, vhi, 0, 1, 2, 3, 4, 5, 6, 7); }
#pragma unroll
    for (int hb = 0; hb < 2; ++hb) {
        s16x4 klo[4], khi[4]; f32x4 eb[4];
#pragma unroll
        for (int k4 = 0; k4 < 4; ++k4) { const int kb = 4 * hb + k4;
            klo[k4] = __builtin_amdgcn_ds_read_tr16_b64_v4i16((LAS s16x4*)(L + G2_KT + roff + kb * 32));
            khi[k4] = __builtin_amdgcn_ds_read_tr16_b64_v4i16((LAS s16x4*)(L + G2_KT + roff + kb * 32 + 4 * XRS)); }
#pragma unroll
        for (int k4 = 0; k4 < 4; ++k4) eb[k4] = *(const LAS f32x4*)(L + G2_EB + (ck * 128 + 16 * (4 * hb + k4) + 4 * q) * 4);
        __builtin_amdgcn_sched_barrier(0);
#pragma unroll
        for (int k4 = 0; k4 < 4; ++k4) { const bf16x8 kf = __builtin_shufflevector(klo[k4], khi[k4], 0, 1, 2, 3, 4, 5, 6, 7);
#pragma unroll
            for (int ct = 0; ct < 2; ++ct) st[ct][4 * hb + k4] = __builtin_amdgcn_mfma_f32_16x16x32_bf16(kf, vf[ct], st[ct][4 * hb + k4], 0, 0, 0); }
#pragma unroll
        for (int k4 = 0; k4 < 4; ++k4)
#pragma unroll
            for (int ct = 0; ct < 2; ++ct) st[ct][4 * hb + k4] = st[ct][4 * hb + k4] * eb[k4];
        __builtin_amdgcn_sched_barrier(0);
    }
}
__device__ __forceinline__ void state_load_g(const float* src, f32x4 (&st)[2][8], int wg, int lane) {
#pragma unroll
    for (int ct = 0; ct < 2; ++ct) { const float* p0 = src + (2 * wg + ct) * 2048 + lane; const float* p1 = p0 + 1024;
#pragma unroll
        for (int kb = 0; kb < 8; ++kb)
#pragma unroll
            for (int rg = 0; rg < 4; ++rg) st[ct][kb][rg] = src ? (kb < 4 ? p0[(kb * 4 + rg) * 64] : p1[((kb - 4) * 4 + rg) * 64]) : 0.f; }
}
__device__ __forceinline__ void state_store_g(float* dst, const f32x4 (&st)[2][8], int wg, int lane) {
#pragma unroll
    for (int ct = 0; ct < 2; ++ct) { float* p0 = dst + (2 * wg + ct) * 2048 + lane; float* p1 = p0 + 1024;
#pragma unroll
        for (int kb = 0; kb < 8; ++kb)
#pragma unroll
            for (int rg = 0; rg < 4; ++rg) { if (kb < 4) p0[(kb * 4 + rg) * 64] = st[ct][kb][rg]; else p1[((kb - 4) * 4 + rg) * 64] = st[ct][kb][rg]; } }
}
__device__ __forceinline__ void quarter_scores(const GC& G) {
    LAS unsigned char* L = G.L; const int lane = G.lane, i16 = lane & 15, q = lane >> 4, ck = G.wg >> 1, u = G.wg & 1;
#pragma unroll
    for (int tt = 0; tt < 2; ++tt) {
        const int ti = u == 0 ? tt : 1 - tt, si = tt;
        f32x4 sc = (f32x4){0.f, 0.f, 0.f, 0.f};
        if (si <= ti) {
#pragma unroll
            for (int ks = 0; ks < 4; ++ks) { const bf16x8 a = *(const LAS bf16x8*)(L + G2_QT + (32 * ck + 16 * ti + i16) * XRS + (32 * ks + 8 * q) * 2); const bf16x8 bb = *(const LAS bf16x8*)(L + G2_KT + (32 * ck + 16 * si + i16) * XRS + (32 * ks + 8 * q) * 2);
                sc = __builtin_amdgcn_mfma_f32_16x16x32_bf16(a, bb, sc, 0, 0, 0); }
        }
#pragma unroll
        for (int rg = 0; rg < 4; ++rg) { const int t = 16 * ti + 4 * q + rg, sidx = 16 * si + i16; *(LAS bf16_t*)(L + G2_SC + (32 * ck + t) * SCRS + sidx * 2) = (bf16_t)f2bf(sidx <= t ? sc[rg] : 0.f); }
    }
}
__device__ __forceinline__ void chunk_out_g(const GC& G, const f32x4 (&st)[2][8], int ck, f32x4 (&o)[2][2]) {
    LAS unsigned char* L = G.L; const int lane = G.lane, i16 = lane & 15, q = lane >> 4, wg = G.wg;
    const int roff = (32 * ck + 8 * q + (i16 >> 2)) * XRS + 8 * (i16 & 3);
#pragma unroll
    for (int ct = 0; ct < 2; ++ct) { o[ct][0] = (f32x4){0.f, 0.f, 0.f, 0.f}; o[ct][1] = (f32x4){0.f, 0.f, 0.f, 0.f}; }
    bf16x8 vf[2], pf[2];
#pragma unroll
    for (int ct = 0; ct < 2; ++ct) { const s16x4 vlo = __builtin_amdgcn_ds_read_tr16_b64_v4i16((LAS s16x4*)(L + G2_V + roff + (2 * wg + ct) * 32));
        const s16x4 vhi = __builtin_amdgcn_ds_read_tr16_b64_v4i16((LAS s16x4*)(L + G2_V + roff + (2 * wg + ct) * 32 + 4 * XRS)); vf[ct] = __builtin_shufflevector(vlo, vhi, 0, 1, 2, 3, 4, 5, 6, 7); }
#pragma unroll
    for (int ti = 0; ti < 2; ++ti) pf[ti] = *(const LAS bf16x8*)(L + G2_SC + (32 * ck + 16 * ti + i16) * SCRS + (8 * q) * 2);
#pragma unroll
    for (int kh = 0; kh < 2; ++kh) {
        u32x2 qlo[2][2], qhi[2][2]; bf16x8 sf[2][2];
#pragma unroll
        for (int k2 = 0; k2 < 2; ++k2) { const int ks = 2 * kh + k2;
#pragma unroll
            for (int ti = 0; ti < 2; ++ti) { const LAS unsigned char* qrow = L + G2_QT + (32 * ck + 16 * ti + i16) * XRS + (32 * ks + 4 * q) * 2; qlo[k2][ti] = *(const LAS u32x2*)(qrow); qhi[k2][ti] = *(const LAS u32x2*)(qrow + 32); }
#pragma unroll
            for (int ct = 0; ct < 2; ++ct) { u32x4 sp; sp.x = pk2(st[ct][2 * ks][0], st[ct][2 * ks][1]); sp.y = pk2(st[ct][2 * ks][2], st[ct][2 * ks][3]); sp.z = pk2(st[ct][2 * ks + 1][0], st[ct][2 * ks + 1][1]); sp.w = pk2(st[ct][2 * ks + 1][2], st[ct][2 * ks + 1][3]); sf[k2][ct] = __builtin_bit_cast(bf16x8, sp); } }
        __builtin_amdgcn_sched_barrier(0);
#pragma unroll
        for (int k2 = 0; k2 < 2; ++k2)
#pragma unroll
            for (int ti = 0; ti < 2; ++ti) { u32x4 qp; qp.x = qlo[k2][ti].x; qp.y = qlo[k2][ti].y; qp.z = qhi[k2][ti].x; qp.w = qhi[k2][ti].y;
#pragma unroll
                for (int ct = 0; ct < 2; ++ct) o[ct][ti] = __builtin_amdgcn_mfma_f32_16x16x32_bf16(sf[k2][ct], __builtin_bit_cast(bf16x8, qp), o[ct][ti], 0, 0, 0); }
        __builtin_amdgcn_sched_barrier(0);
    }
#pragma unroll
    for (int ct = 0; ct < 2; ++ct)
#pragma unroll
        for (int ti = 0; ti < 2; ++ti) o[ct][ti] = __builtin_amdgcn_mfma_f32_16x16x32_bf16(vf[ct], pf[ti], o[ct][ti], 0, 0, 0);
}
__device__ __forceinline__ void rows_g2l_g(const bf16_t* g, size_t row0, int rstep, int c0, LAS unsigned char* T, int tid) {
    u32x4 r_[4];
#pragma unroll
    for (int it = 0; it < 4; ++it) { const int idx = tid + 256 * it, p = idx >> 4, ch = idx & 15; r_[it] = *(const u32x4*)(g + (size_t)((long)row0 + (long)rstep * p) * D + c0 + ch * 8); }
    __builtin_amdgcn_sched_barrier(0);
#pragma unroll
    for (int it = 0; it < 4; ++it) { const int idx = tid + 256 * it, p = idx >> 4, ch = idx & 15; *(LAS u32x4*)(T + p * XRS + ch * 16) = r_[it]; }
}
__device__ __forceinline__ void rows_l2g_g(bf16_t* g, size_t row0, int rstep, int c0, const LAS unsigned char* T, int tid) {
#pragma unroll
    for (int it = 0; it < 4; ++it) { const int idx = tid + 256 * it, p = idx >> 4, ch = idx & 15; *(u32x4*)(g + (size_t)((long)row0 + (long)rstep * p) * D + c0 + ch * 8) = *(const LAS u32x4*)(T + p * XRS + ch * 16); }
}
__device__ __forceinline__ void scan_pass1_item_g(GC& G, const bf16_t* P5, int b, int h, int dir, int seg, float* SST, float* EG) {
    const int chain = (b * 8 + h) * 2 + dir; const size_t rowb = (size_t)b * TL + (size_t)seg * SEGL;
    f32x4 st[2][8]; state_load_g(nullptr, st, G.wg, G.lane);
    float gacc = 0.f;
    u32x4 rk[4], rv[4];
    quarter_load1(G, P5, rowb + 64 * (dir ? 3 : 0), dir != 0, h, dir, rk, rv);
    for (int hs = 0; hs < 4; ++hs) {
        asm volatile("s_waitcnt vmcnt(0)" ::: "memory");
        quarter_prep1(G, rk, rv);
        __builtin_amdgcn_sched_barrier(0);
        if (hs < 3) quarter_load1(G, P5, rowb + 64 * (dir ? 2 - hs : hs + 1), dir != 0, h, dir, rk, rv);
        gsync_l(G);
        quarter_cols1(G);
        gsync_l(G);
        if (G.tid < 128) { const LAS float* ebl = (const LAS float*)(G.L + G2_EBL); gacc += ebl[G.tid] + ebl[128 + G.tid]; }
#pragma unroll 1
        for (int ck = 0; ck < 2; ++ck) { state_update_g(G, st, ck); __builtin_amdgcn_sched_barrier(0); }
        gsync_l(G);
    }
    state_store_g(SST + ((size_t)chain * NSEG + seg) * 16384, st, G.wg, G.lane);
    if (G.tid < 128) EG[((size_t)chain * NSEG + seg) * 128 + G.tid] = __expf(gacc);
}
__device__ __forceinline__ void scan_pass3_item_g(GC& G, const bf16_t* P5, size_t rowb, int h, const float* sin_f, const float* sin_b, float* fin_f, float* fin_b, const float* gain, bf16_t* OFT, bf16_t* Y, bool writey) {
    LAS unsigned char* L = G.L; const int lane = G.lane, i16 = lane & 15, q = lane >> 4, wg = G.wg;
    f32x4 st[2][8];
    state_load_g(sin_f, st, wg, lane);
    for (int hs = 0; hs < 4; ++hs) {
        const size_t hrow = rowb + 64 * hs;
        quarter_prep<true>(G, P5, hrow, false, h, 0);
        gsync(G);
        quarter_scores(G);
        gsync(G);
        u32x2 of[2][2][2];
#pragma unroll
        for (int ck = 0; ck < 2; ++ck) { f32x4 o[2][2]; chunk_out_g(G, st, ck, o);
#pragma unroll
            for (int ct = 0; ct < 2; ++ct)
#pragma unroll
                for (int ti = 0; ti < 2; ++ti) { of[ck][ct][ti].x = pk2(o[ct][ti][0], o[ct][ti][1]); of[ck][ct][ti].y = pk2(o[ct][ti][2], o[ct][ti][3]); }
            __builtin_amdgcn_sched_barrier(0);
            state_update_g(G, st, ck);
            __builtin_amdgcn_sched_barrier(0); }
        gsync(G);
#pragma unroll
        for (int ck = 0; ck < 2; ++ck)
#pragma unroll
            for (int ct = 0; ct < 2; ++ct)
#pragma unroll
                for (int ti = 0; ti < 2; ++ti) *(LAS u32x2*)(L + G2_QT + (32 * ck + 16 * ti + i16) * XRS + (32 * wg + 16 * ct + 4 * q) * 2) = of[ck][ct][ti];
        gsync(G);
        rows_l2g_g(OFT, hrow, 1, h * 128, L + G2_QT, G.tid);
        gsync(G);
    }
    if (fin_f) state_store_g(fin_f, st, wg, lane);
    state_load_g(sin_b, st, wg, lane);
    f32x4 gv[2];
#pragma unroll
    for (int ct = 0; ct < 2; ++ct) gv[ct] = *(const f32x4*)(gain + h * 128 + 32 * wg + 16 * ct + 4 * q);
    for (int hs = 0; hs < 4; ++hs) {
        const size_t hrow = rowb + 64 * (3 - hs);
        quarter_prep<true>(G, P5, hrow, true, h, 1);
        gsync(G);
        quarter_scores(G);
        gsync(G);
        LAS float* RED = (LAS float*)(L + G2_RED);
        f32x4 oa[2][2][2];
#pragma unroll
        for (int ck = 0; ck < 2; ++ck) { chunk_out_g(G, st, ck, oa[ck]);
            __builtin_amdgcn_sched_barrier(0);
            state_update_g(G, st, ck);
            __builtin_amdgcn_sched_barrier(0); }
        gsync(G);
        rows_g2l_g(OFT, hrow + 63, -1, h * 128, L + G2_QT, G.tid);
        if (writey) { u32x4 gr_[4];
#pragma unroll
            for (int it = 0; it < 4; ++it) { const int idx = G.tid + 256 * it, p = idx >> 4, ch = idx & 15; gr_[it] = *(const u32x4*)(P5 + ((size_t)h * MT + (hrow + 63 - p)) * 640 + 128 + ch * 8); }
            __builtin_amdgcn_sched_barrier(0);
#pragma unroll
            for (int it = 0; it < 4; ++it) { const int idx = G.tid + 256 * it, p = idx >> 4, ch = idx & 15; *(LAS u32x4*)(L + G2_KT + p * XRS + ch * 16) = gr_[it]; } }
        gsync(G);
#pragma unroll
        for (int ck = 0; ck < 2; ++ck)
#pragma unroll
            for (int ti = 0; ti < 2; ++ti) { const int p = 32 * ck + 16 * ti + i16; float ss = 0.f;
#pragma unroll
                for (int ct = 0; ct < 2; ++ct) { const u32x2 f = *(const LAS u32x2*)(L + G2_QT + p * XRS + (32 * wg + 16 * ct + 4 * q) * 2);
                    oa[ck][ct][ti][0] += bflo(f.x); oa[ck][ct][ti][1] += bfhi(f.x); oa[ck][ct][ti][2] += bflo(f.y); oa[ck][ct][ti][3] += bfhi(f.y);
                    ss += (oa[ck][ct][ti][0] * oa[ck][ct][ti][0] + oa[ck][ct][ti][1] * oa[ck][ct][ti][1]) + (oa[ck][ct][ti][2] * oa[ck][ct][ti][2] + oa[ck][ct][ti][3] * oa[ck][ct][ti][3]); }
                ss += shfl_x(ss, 16, lane); ss += shfl_x(ss, 32, lane);
                if (q == 0) RED[wg * 64 + p] = ss; }
        gsync(G);
        if (writey) {
#pragma unroll
            for (int ck = 0; ck < 2; ++ck)
#pragma unroll
                for (int ti = 0; ti < 2; ++ti) { const int p = 32 * ck + 16 * ti + i16; const float tot = (RED[p] + RED[64 + p]) + (RED[128 + p] + RED[192 + p]);
                    const float rs = rsqrtf(tot * (1.0f / 128.0f) + EPS);
#pragma unroll
                    for (int ct = 0; ct < 2; ++ct) { const u32x2 sg = *(const LAS u32x2*)(L + G2_KT + p * XRS + (32 * wg + 16 * ct + 4 * q) * 2);
                        u32x2 y; y.x = pk2(oa[ck][ct][ti][0] * rs * gv[ct][0] * bflo(sg.x), oa[ck][ct][ti][1] * rs * gv[ct][1] * bfhi(sg.x)); y.y = pk2(oa[ck][ct][ti][2] * rs * gv[ct][2] * bflo(sg.y), oa[ck][ct][ti][3] * rs * gv[ct][3] * bfhi(sg.y));
                        *(LAS u32x2*)(L + G2_V + p * XRS + (32 * wg + 16 * ct + 4 * q) * 2) = y; } }
            gsync(G);
            rows_l2g_g(Y, hrow + 63, -1, h * 128, L + G2_V, G.tid);
        }
        gsync(G);
    }
    if (fin_b) state_store_g(fin_b, st, wg, lane);
}
__device__ __forceinline__ int gq_next(GC& G, unsigned* ctr, unsigned ngroups) {
    LAS unsigned* slot = (LAS unsigned*)(G.L + G2_SLOT);
    gsync(G);
    if (G.tid == 0) *slot = ngroups + __hip_atomic_fetch_add(ctr, 1u, __ATOMIC_RELAXED, __HIP_MEMORY_SCOPE_AGENT);
    gsync(G);
    return (int)*slot;
}
__device__ __forceinline__ unsigned gq_fetch(const GC& G, unsigned* ctr, unsigned ngroups) { return G.tid == 0 ? ngroups + __hip_atomic_fetch_add(ctr, 1u, __ATOMIC_RELAXED, __HIP_MEMORY_SCOPE_AGENT) : 0u; }
__device__ __forceinline__ int gq_publish(GC& G, unsigned v) {
    LAS unsigned* slot = (LAS unsigned*)(G.L + G2_SLOT);
    gsync(G);
    if (G.tid == 0) *slot = v;
    gsync(G);
    return (int)*slot;
}

__device__ __forceinline__ void scan_carry(const Ctx& F) {
    float* SST = (float*)(F.ws + WS_SST); const float* EG = (const float*)(F.ws + WS_EG); const float* S0 = (const float*)(F.ws + WS_S0);
    const int gt = F.bid * 512 + F.tid, NGT = F.G * 512;
    for (int idx = gt; idx < NCHAIN * 16384; idx += NGT) {
        const int chain = idx >> 14, e = idx & 16383, dir = chain & 1;
        const int lanee = e & 63, rg = (e >> 6) & 3, kb = (e >> 8) & 7; const int dk = 16 * kb + 4 * (lanee >> 4) + rg;
        float cur = S0[(size_t)chain * 16384 + e];
        float* base = SST + (size_t)chain * NSEG * 16384 + e; const float* eg = EG + (size_t)chain * NSEG * 128 + dk;
        for (int s0 = 0; s0 < NSEG; s0 += 8) {
            float tmp[8], gg[8];
#pragma unroll
            for (int i = 0; i < 8; ++i) { const int seg = dir ? NSEG - 1 - (s0 + i) : s0 + i; tmp[i] = base[(size_t)seg * 16384]; gg[i] = eg[seg * 128]; }
#pragma unroll
            for (int i = 0; i < 8; ++i) { const int seg = dir ? NSEG - 1 - (s0 + i) : s0 + i; base[(size_t)seg * 16384] = cur; cur = gg[i] * cur + tmp[i]; }
        }
    }
}

__device__ __forceinline__ void moe_slots(const Ctx& F, int nrows) {
    const int tid = F.tid; const int nitems = F.NGW;
    const RowPart rp = row_part(F.NGW, nrows);
    const int* cnt = (const int*)(F.ws + WS_CNT); const int* tope = (const int*)(F.ws + WS_TOPE); const int* rank = (const int*)(F.ws + WS_RANK);
    int* slotrow = (int*)(F.ws + WS_SLOTROW); int* slotdst = (int*)(F.ws + WS_SLOTDST); int* tilex = (int*)(F.ws + WS_TILEX); int* slotof = (int*)(F.ws + WS_SLOTOF);
    LAS int* pre = (LAS int*)F.lds;
    LAS int* tsum = (LAS int*)(F.lds + 69632);
    LAS int* ebase = (LAS int*)(F.lds + 69632 + 16384);
    const int IPT = (nitems + 511) / 512;
    int loc[8] = {0, 0, 0, 0, 0, 0, 0, 0};
    for (int i = 0; i < IPT; ++i) { const int it = tid * IPT + i; if (it < nitems) {
#pragma unroll
        for (int e = 0; e < 8; ++e) loc[e] += cnt[it * 8 + e]; } }
    {
        const int lane = F.lane, wv = F.wave; LAS int* wsum = ebase + 32;
        int inc[8];
#pragma unroll
        for (int e = 0; e < 8; ++e) { int v = loc[e];
#pragma unroll
            for (int o = 1; o < 64; o <<= 1) { const int u = __builtin_amdgcn_ds_bpermute(((lane - o) & 63) << 2, v); if (lane >= o) v += u; }
            inc[e] = v; }
        if (lane == 63) {
#pragma unroll
            for (int e = 0; e < 8; ++e) wsum[wv * 8 + e] = inc[e]; }
        __syncthreads();
#pragma unroll
        for (int e = 0; e < 8; ++e) { int below = 0, tot = 0;
#pragma unroll
            for (int w2 = 0; w2 < 8; ++w2) { const int t_ = wsum[w2 * 8 + e]; tot += t_; if (w2 < wv) below += t_; }
            tsum[tid * 8 + e] = below + inc[e] - loc[e];
            if (tid == 0) ebase[8 + e] = tot; }
    }
    __syncthreads();
    if (tid == 0) { int b = 0; for (int e = 0; e < 8; ++e) { ebase[e] = b; b += (ebase[8 + e] + 255) & ~255; } ebase[16] = b / 256; }
    { int run[8];
#pragma unroll
      for (int e = 0; e < 8; ++e) run[e] = tsum[tid * 8 + e];
      for (int i = 0; i < IPT; ++i) { const int it = tid * IPT + i; if (it < nitems) {
#pragma unroll
          for (int e = 0; e < 8; ++e) { pre[it * 8 + e] = run[e]; run[e] += cnt[it * 8 + e]; } } } }
    __syncthreads();
    for (int r = F.bid * 512 + tid; r < nrows; r += F.G * 512) {
        const int ch = row_chunk_of(rp, r);
#pragma unroll
        for (int kk = 0; kk < 2; ++kk) { const int e = tope[2 * r + kk]; const int slot = ebase[e] + pre[ch * 8 + e] + rank[2 * r + kk]; slotrow[slot] = r; slotdst[slot] = 2 * r + kk; slotof[2 * r + kk] = slot; }
    }
    if (F.bid == 0) {
        const int ntiles = ebase[16];
        if (tid == 0) tilex[0] = ntiles;
        for (int e = 0; e < 8; ++e) { const int b0 = ebase[e], tot = ebase[8 + e], pad = (tot + 255) & ~255;
            for (int s = b0 + tot + tid; s < b0 + pad; s += 512) { slotrow[s] = 0; slotdst[s] = -1; }
            for (int t = b0 / 256 + tid; t < (b0 + pad) / 256; t += 512) tilex[16 + t] = e; }
    }
}

__global__ void __launch_bounds__(512, 2) fwd_kernel(Args args) {
    extern __shared__ __attribute__((aligned(16))) unsigned char lds_raw[];
    Ctx F;
    F.lds = (LAS unsigned char*)lds_raw; F.tid = threadIdx.x; F.lane = F.tid & 63; F.wave = __builtin_amdgcn_readfirstlane(F.tid >> 6);
    F.G = gridDim.x; F.bid = blockIdx.x; F.gw = F.bid * 8 + F.wave; F.NGW = F.G * 8;
    F.in = args.in; F.out = args.out; F.ws = args.ws;
    volatile LAS unsigned* MISC = (volatile LAS unsigned*)(F.lds + MISC_OFF);
    if (F.tid < 64) MISC[F.tid] = 0u;
    __syncthreads();
    const int lo = args.ph_lo, hi = args.ph_hi;
    XcdBarrier bar; bar.bar = (unsigned*)(F.ws + WS_CTL) + 4096; bar.x = 0; bar.st = nullptr;
    const bool multi = (hi - lo) > 1;
    if (multi) bar = xcd_barrier_post((unsigned*)(F.ws + WS_CTL) + 4096, MISC + 8);
#define IN(k) (lo <= (k) && (k) < hi)
#if defined(PROBE_TMASK)
    unsigned long long pt_last = __builtin_amdgcn_s_memrealtime(), pt_acc = 0ull;
#define PROBE_T(k) do { const unsigned long long now_ = __builtin_amdgcn_s_memrealtime(); if ((((unsigned long long)(PROBE_TMASK)) >> (k)) & 1ull) pt_acc += now_ - pt_last; pt_last = now_; } while (0)
#else
#define PROBE_T(k) do { } while (0)
#endif
#define SEAM(k) do { if (IN(k) && IN((k) + 1)) xcd_barrier(bar); PROBE_T(k); asm volatile("" : "+v"(F.tid), "+s"(F.G)); LAUNDER_WS_OUT(); F.NGW = F.G * 8; F.lane = F.tid & 63; F.wave = __builtin_amdgcn_readfirstlane(F.tid >> 6); F.gw = F.bid * 8 + F.wave; } while (0)

#define MODS_ ((float*)(F.ws + WS_MODS))
#define XB_ ((bf16_t*)(F.ws + WS_XB))
#define H_ ((bf16_t*)(F.ws + WS_H))
#define YE_ ((bf16_t*)(F.ws + WS_YE))

    if (IN(PH_P0)) for (int rep_ = 0; rep_ < NREP(18); ++rep_) { p0_prologue(F); }
#if defined(PROBE_SLEEP)
    if (IN(PH_P0)) { const unsigned long long t0 = __builtin_amdgcn_s_memrealtime(); while (__builtin_amdgcn_s_memrealtime() - t0 < (unsigned long long)PROBE_SLEEP * 100ull) __builtin_amdgcn_s_sleep(32); }
#endif
    SEAM(PH_P0);

#if defined(PROBE_GEMM)
    if (IN(PH_P0)) {
        pg8::Gemm g{H_, (const bf16_t*)(F.ws + WS_WINE), ML, NEIN, D, nullptr, nullptr, 0}; pg8::StaticOrder S; S.init(ML, NEIN, D, F.G, F.bid);
#if PROBE_GEMM == 1
        pg8::EpiEvenIn E{(bf16_t*)(F.ws + WS_UP)}; pg8::gemm_phase<pg8::EpiEvenIn, pg8::StaticOrder, true, false>(F.lds, g, S, E, F.tid);
#elif PROBE_GEMM == 2
        pg8::EpiNull E{(float*)(F.ws + WS_UP)}; pg8::gemm_phase<pg8::EpiNull, pg8::StaticOrder, true, false>(F.lds, g, S, E, F.tid);
#endif
        xcd_barrier(bar);
    }
#endif

    for (int lp = 0; lp < 2; ++lp) {
        const int pb = PH_PAIR0 + lp * NPL;
        const int le = 2 * lp, lo_ = 2 * lp + 1;
        const float* modE = MODS_ + (size_t)le * 3 * 6144; const float* modO = MODS_ + (size_t)lo_ * 3 * 6144;
        if (IN(pb + E1_NORM)) for (int rep_ = 0; rep_ < NREP(E1_NORM); ++rep_) {
            RowPass P{}; P.sl = FIN(I_X); P.sc = FIN(I_CTX); P.xb = XB_; P.gain = FIN(I_NMIX) + le * D; P.shift = modE + 0 * D; P.scale = modE + 1 * D; P.H = H_; P.nrows = MT;
            if (lp == 0) row_pass<false, false, false, false>(F, P);
            else { P.YE = YE_; P.topp = (const float*)(F.ws + WS_TOPP); P.gatef = MODS_ + (size_t)(le - 1) * 3 * 6144 + 5 * D; P.slotof = (const int*)(F.ws + WS_SLOTOF); P.partm = (const float*)(F.ws + WS_PARTM); row_pass_b<true, false, false, 2>(F, P); }
        }
        SEAM(pb + E1_NORM);
        if (IN(pb + E2_GIN)) for (int rep_ = 0; rep_ < NREP(E2_GIN); ++rep_) {
            pg8::Gemm g{H_, (const bf16_t*)(F.ws + WS_WINE) + (size_t)lp * NEIN * D, MT, NEIN, D, nullptr, nullptr, 0}; pg8::StaticOrder S; S.init(MT, NEIN, D, F.G, F.bid);
            pg8::EpiEvenIn E{(bf16_t*)(F.ws + WS_PZUV)};
            pg8::gemm_phase<pg8::EpiEvenIn, pg8::StaticOrder, true, false>(F.lds, g, S, E, F.tid);
        }
        SEAM(pb + E2_GIN);
        if (IN(pb + E3_FFTA)) for (int rep_ = 0; rep_ < NREP(E3_FFTA); ++rep_) fft_stage_a(F, (unsigned*)(F.ws + WS_CTL) + 8192 + 64 * (pb + E3_FFTA));
        SEAM(pb + E3_FFTA);
        if (IN(pb + E3_FFTC)) for (int rep_ = 0; rep_ < NREP(E3_FFTC); ++rep_) fft_stage_c_gmlp(F, lp, (unsigned*)(F.ws + WS_CTL) + 8192 + 64 * (pb + E3_FFTC));
        SEAM(pb + E3_FFTC);
        if (IN(pb + E4_GOUT)) for (int rep_ = 0; rep_ < NREP(E4_GOUT); ++rep_) {
            pg8::Gemm g{H_, (const bf16_t*)(F.ws + WS_WOUTE) + (size_t)lp * D * D, MT, D, D, nullptr, nullptr, 0}; pg8::ResOrder S; S.init(D, F.G, F.bid, true);
            if (lp == 0) { pg8::EpiRes<true> E{FIN(I_X), XB_, modE + 2 * D, (float*)(F.ws + WS_PARTC)}; pg8::gemm_phase<pg8::EpiRes<true>, pg8::ResOrder, false, false>(F.lds, g, S, E, F.tid); }
            else { pg8::EpiRes<false> E{nullptr, XB_, modE + 2 * D, (float*)(F.ws + WS_PARTC)}; pg8::gemm_phase<pg8::EpiRes<false>, pg8::ResOrder, false, false>(F.lds, g, S, E, F.tid); }
        }
        SEAM(pb + E4_GOUT);
        if (IN(pb + E5_NORM)) for (int rep_ = 0; rep_ < NREP(E5_NORM); ++rep_) {
            RowPass P{}; P.xb = XB_; P.csrc32 = lp == 0 ? FIN(I_CTX) : nullptr; P.gain = FIN(I_NFFN) + le * D; P.shift = modE + 3 * D; P.scale = modE + 4 * D; P.H = H_; P.nrows = MT;
            P.part = (const float*)(F.ws + WS_PARTC); P.kpn = CTX_KP; P.pgate = modE + 2 * D;
            row_pass_b<false, false, false, 4>(F, P);
        }
        SEAM(pb + E5_NORM);
        if (IN(pb + E6_UP)) for (int rep_ = 0; rep_ < NREP(E6_UP); ++rep_) {
            pg8::Gemm g{H_, (const bf16_t*)(F.ws + WS_W13) + (size_t)lp * NFF2 * D, MT, NFF2, D, nullptr, nullptr, 0}; pg8::StaticOrder S; S.init(MT, NFF2, D, F.G, F.bid);
            pg8::EpiSwiglu E{(bf16_t*)(F.ws + WS_HID), DFF};
            pg8::gemm_phase<pg8::EpiSwiglu, pg8::StaticOrder, true, false>(F.lds, g, S, E, F.tid);
        }
        SEAM(pb + E6_UP);
        if (IN(pb + E7_DOWN)) for (int rep_ = 0; rep_ < NREP(E7_DOWN); ++rep_) {
            pg8::Gemm g{(const bf16_t*)(F.ws + WS_HID), (const bf16_t*)(F.ws + WS_W2) + (size_t)lp * D * DFF, MT, D, DFF, nullptr, nullptr, 0}; pg8::ResOrder S; S.init(DFF, F.G, F.bid, true);
            pg8::EpiRes<false> E{nullptr, XB_, modE + 5 * D, (float*)(F.ws + WS_PARTC)};
            pg8::gemm_phase<pg8::EpiRes<false>, pg8::ResOrder, false, false>(F.lds, g, S, E, F.tid);
        }
        SEAM(pb + E7_DOWN);
        const bool lastl = lp == 1;
        if (IN(pb + O1_NORM)) for (int rep_ = 0; rep_ < NREP(O1_NORM); ++rep_) {
            RowPass P{}; P.xb = XB_; P.gain = FIN(I_NMIX) + lo_ * D; P.shift = modO + 0 * D; P.scale = modO + 1 * D; P.H = H_; P.nrows = MT;
            P.part = (const float*)(F.ws + WS_PARTC); P.kpn = CTX_KP; P.pgate = modE + 5 * D;
            row_pass_b<false, false, false, 4>(F, P);
        }
        SEAM(pb + O1_NORM);
        if (IN(pb + O2_GIN)) for (int rep_ = 0; rep_ < NREP(O2_GIN); ++rep_) {
            pg8::Gemm g{H_, (const bf16_t*)(F.ws + WS_WINO) + (size_t)lp * NREC * D, MT, NREC, D, nullptr, nullptr, 0}; pg8::StaticOrder S; S.init(MT, NREC, D, F.G, F.bid);
            pg8::EpiOddIn E{(bf16_t*)(F.ws + WS_P5), (const float*)(F.ws + WS_LB) + lp * 2048};
            pg8::gemm_phase<pg8::EpiOddIn, pg8::StaticOrder, true, false>(F.lds, g, S, E, F.tid);
        }
        SEAM(pb + O2_GIN);
        if (IN(pb + O3_SCAN1)) {
            const int grp = F.wave >> 2; const int NG = F.G * 2, gid = F.bid * 2 + grp;
            GC G; G.L = F.lds + grp * G2_BYTES; G.wg = F.wave & 3; G.tid = F.tid & 255; G.lane = F.lane; G.bar = (LAS unsigned*)(F.lds + MISC_OFF + 128 + 4 * grp);
            __syncthreads(); G.epoch = __hip_atomic_load(G.bar, __ATOMIC_RELAXED, __HIP_MEMORY_SCOPE_WORKGROUP);
            constexpr int NCONV = MOE_CONV_ITEMS / 4, NITEMS = 16 + 4096 + (NCONV - 2048);
            for (int it = gid; it < NITEMS; ) {
                { int t_ = F.tid; asm volatile("" : "+v"(t_)); LAUNDER_WS_OUT(); G.tid = t_ & 255; G.lane = t_ & 63; F.lane = G.lane; }
                const bf16_t* P5 = (const bf16_t*)(F.ws + WS_P5); float* SST = (float*)(F.ws + WS_SST); float* EG = (float*)(F.ws + WS_EG); float* S0 = (float*)(F.ws + WS_S0);
                const float* gain = FIN(I_RNORM) + lp * D; unsigned* wq = (unsigned*)(F.ws + WS_CTL) + 8192 + 64 * (pb + O3_SCAN1);
                const unsigned nxt_it = gq_fetch(G, wq, (unsigned)NG);
                int it2 = it, cv = -1;
                if (it >= 16) { const int y = it - 16; if (y < 4096) { if (y & 1) cv = y >> 1; else it2 = 16 + (y >> 1); } else cv = 2048 + (y - 4096); }
                if (cv >= 0) moe_convert_item(F, lp, cv * 4 + G.wg);
                else if (it2 < 16) { const int b = it2 >> 3, h = it2 & 7;
                    scan_pass3_item_g(G, P5, (size_t)ML + b * TCX, h, nullptr, nullptr, S0 + (size_t)((b * 8 + h) * 2 + 0) * 16384, S0 + (size_t)((b * 8 + h) * 2 + 1) * 16384, gain, YE_, H_, !lastl);
                } else { const int i2 = it2 - 16, seg = i2 & 63, dir = (i2 >> 6) & 1, h = (i2 >> 7) & 7, b = i2 >> 10;
                    scan_pass1_item_g(G, P5, b, h, dir, seg, SST, EG); }
                it = gq_publish(G, nxt_it);
            }
        }
        SEAM(pb + O3_SCAN1);
        if (IN(pb + O4_CARRY)) for (int rep_ = 0; rep_ < NREP(O4_CARRY); ++rep_) { scan_carry(F); }
        SEAM(pb + O4_CARRY);
        if (IN(pb + O5_SCAN3)) {
            const int grp = F.wave >> 2; const int NG = F.G * 2, gid = F.bid * 2 + grp;
            GC G; G.L = F.lds + grp * G2_BYTES; G.wg = F.wave & 3; G.tid = F.tid & 255; G.lane = F.lane; G.bar = (LAS unsigned*)(F.lds + MISC_OFF + 128 + 4 * grp);
            __syncthreads(); G.epoch = __hip_atomic_load(G.bar, __ATOMIC_RELAXED, __HIP_MEMORY_SCOPE_WORKGROUP);
            for (int it = gid; it < 1024; it += NG) { const int seg = it & 63, h = (it >> 6) & 7, b = it >> 9; const int ch0 = (b * 8 + h) * 2;
                { int t_ = F.tid; asm volatile("" : "+v"(t_)); LAUNDER_WS_OUT(); G.tid = t_ & 255; G.lane = t_ & 63; }
                const bf16_t* P5 = (const bf16_t*)(F.ws + WS_P5); const float* SST = (const float*)(F.ws + WS_SST); const float* gain = FIN(I_RNORM) + lp * D;
                scan_pass3_item_g(G, P5, (size_t)b * TL + (size_t)seg * SEGL, h, SST + ((size_t)ch0 * NSEG + seg) * 16384, SST + ((size_t)(ch0 + 1) * NSEG + seg) * 16384, nullptr, nullptr, gain, YE_, H_, true); }
        }
        SEAM(pb + O5_SCAN3);
        if (IN(pb + O6_GOUT)) for (int rep_ = 0; rep_ < NREP(O6_GOUT); ++rep_) {
            pg8::Gemm g{H_, (const bf16_t*)(F.ws + WS_WOUTO) + (size_t)lp * D * D, MT, D, D, nullptr, nullptr, 0}; pg8::ResOrder S; S.init(D, F.G, F.bid, !lastl);
            pg8::EpiRes<false> E{nullptr, XB_, modO + 2 * D, (float*)(F.ws + WS_PARTC)};
            pg8::gemm_phase<pg8::EpiRes<false>, pg8::ResOrder, false, false>(F.lds, g, S, E, F.tid);
        }
        SEAM(pb + O6_GOUT);
        const int nrm = lastl ? ML : MT;
        if (IN(pb + O7_NORM)) for (int rep_ = 0; rep_ < NREP(O7_NORM); ++rep_) {
            RowPass P{}; P.xb = XB_; P.gain = FIN(I_NFFN) + lo_ * D; P.shift = modO + 3 * D; P.scale = modO + 4 * D; P.H = H_; P.nrows = nrm;
            P.part = lastl ? nullptr : (const float*)(F.ws + WS_PARTC); P.kpn = CTX_KP; P.pgate = modO + 2 * D;
            P.rw = FIN(I_RW) + (size_t)lp * D * NE; P.tope = (int*)(F.ws + WS_TOPE); P.toppo = (float*)(F.ws + WS_TOPP); P.rank = (int*)(F.ws + WS_RANK); P.cnt = (int*)(F.ws + WS_CNT);
            row_pass_b<false, true, false, 2>(F, P);
        }
        SEAM(pb + O7_NORM);
        if (IN(pb + O8_SLOTS)) for (int rep_ = 0; rep_ < NREP(O8_SLOTS); ++rep_) moe_slots(F, nrm);
        SEAM(pb + O8_SLOTS);
        if (IN(pb + O9_MUP)) for (int rep_ = 0; rep_ < NREP(O9_MUP); ++rep_) {
            const int* tilex = (const int*)(F.ws + WS_TILEX); const int ntiles = __builtin_amdgcn_readfirstlane(tilex[0]);
            pg8::Gemm g{H_, (const bf16_t*)(F.ws + WS_W13M), ntiles * 256, NEX2, D, (const int*)(F.ws + WS_SLOTROW), tilex + 16, (size_t)NEX2 * D}; pg8::StaticOrder S; S.init(ntiles * 256, NEX2, D, F.G, F.bid);
            pg8::EpiSwiglu E{(bf16_t*)(F.ws + WS_HIDM), DEX};
            pg8::gemm_phase<pg8::EpiSwiglu, pg8::StaticOrder, true, true>(F.lds, g, S, E, F.tid);
        }
        SEAM(pb + O9_MUP);
        if (IN(pb + O10_MDOWN)) for (int rep_ = 0; rep_ < NREP(O10_MDOWN); ++rep_) {
            const int* tilex = (const int*)(F.ws + WS_TILEX); const int ntiles = __builtin_amdgcn_readfirstlane(tilex[0]);
            pg8::Gemm g{(const bf16_t*)(F.ws + WS_HIDM), (const bf16_t*)(F.ws + WS_W2M), ntiles * 256, D, DEX, nullptr, tilex + 16, (size_t)D * DEX}; pg8::MoeDownOrder S; S.init(ntiles, F.G, F.bid);
            pg8::EpiMoeDown E{YE_, (const int*)(F.ws + WS_SLOTDST), (float*)(F.ws + WS_PARTM)};
            pg8::gemm_phase<pg8::EpiMoeDown, pg8::MoeDownOrder, true, false>(F.lds, g, S, E, F.tid);
        }
        SEAM(pb + O10_MDOWN);
    }
    if (IN(PH_FINAL)) {
        RowPass P{}; P.xb = XB_; P.gain = FIN(I_NOUT); P.nrows = ML; P.YE = YE_; P.topp = (const float*)(F.ws + WS_TOPP); P.gatef = MODS_ + (size_t)3 * 3 * 6144 + 5 * D; P.fout = F.out; P.slotof = (const int*)(F.ws + WS_SLOTOF); P.partm = (const float*)(F.ws + WS_PARTM);
        row_pass_b<true, false, true, 2>(F, P);
    }
    PROBE_T(PH_FINAL);
#if defined(PROBE_TMASK)
    if (F.bid == 0 && F.tid == 0) { const unsigned long long t0 = __builtin_amdgcn_s_memrealtime(); while (__builtin_amdgcn_s_memrealtime() - t0 < pt_acc * 4ull) __builtin_amdgcn_s_sleep(32); }
#endif
#undef IN
#undef SEAM
#undef MODS_
#undef XB_
#undef H_
#undef YE_
}

extern "C" void kernel_launch(void* const* d_in, const int* in_sizes, int n_in, void* d_out, int out_size, void* d_ws, size_t ws_size, hipStream_t stream) {
    static int grid = 0;
    if (grid == 0) {
        if (n_in != 24 || out_size != ML * D || ws_size < WS_END) { fprintf(stderr, "kernel_launch: unexpected problem (n_in %d, out %d, ws %zu < %zu)\n", n_in, out_size, ws_size, (size_t)WS_END); grid = -1; return; }
        int dev = 0, cus = 0, per_cu = 0;
        if (hipGetDevice(&dev) != hipSuccess || hipDeviceGetAttribute(&cus, hipDeviceAttributeMultiprocessorCount, dev) != hipSuccess) { grid = -1; return; }
        if (hipFuncSetAttribute((const void*)fwd_kernel, hipFuncAttributeMaxDynamicSharedMemorySize, LDS_BYTES) != hipSuccess) { fprintf(stderr, "kernel_launch: hipFuncSetAttribute failed\n"); grid = -1; return; }
        if (hipOccupancyMaxActiveBlocksPerMultiprocessor(&per_cu, (const void*)fwd_kernel, 512, LDS_BYTES) != hipSuccess || per_cu < 1) fprintf(stderr, "kernel_launch: occupancy query says %d\n", per_cu);
        (void)hipGetLastError();
        grid = cus;
    }
    if (grid < 0) return;
    (void)hipMemsetAsync((char*)d_ws + WS_CTL, 0, CTL_BYTES, stream);
    Args a{};
    for (int i = 0; i < 24; ++i) a.in[i] = (const float*)d_in[i];
    a.out = (float*)d_out; a.ws = (unsigned char*)d_ws;
#if PER_PHASE_LAUNCH
    for (int p = 0; p < NPHASE && p < PHASE_LIMIT; ++p) { a.ph_lo = p; a.ph_hi = p + 1; hipLaunchKernelGGL(fwd_kernel, dim3(grid), dim3(512), LDS_BYTES, stream, a); }
#else
    a.ph_lo = 0; a.ph_hi = NPHASE; hipLaunchKernelGGL(fwd_kernel, dim3(grid), dim3(512), LDS_BYTES, stream, a);
#endif
}
```

```cpp
#include <hip/hip_runtime.h>
#include <cstdio>
#include <cstdint>

#ifndef PER_PHASE_LAUNCH
#define PER_PHASE_LAUNCH 0
#endif
#ifndef CTX_KP
#define CTX_KP 4
#endif
#ifndef REP_MASK
#define REP_MASK 0
#endif
#define NREP(x) (((REP_MASK >> (x)) & 1) ? 2 : 1)
#ifndef PHASE_LIMIT
#define PHASE_LIMIT 100
#endif
#ifndef P0_MASK
#define P0_MASK 63
#endif
#ifndef P0_T
#define P0_T 127
#endif

#define LAS __attribute__((address_space(3)))
typedef unsigned short bf16_t;
typedef short bf16x8 __attribute__((ext_vector_type(8)));
typedef short s16x4 __attribute__((ext_vector_type(4)));
typedef float f32x4 __attribute__((ext_vector_type(4)));
typedef float f32x2 __attribute__((ext_vector_type(2)));
typedef unsigned u32x4 __attribute__((ext_vector_type(4)));
typedef unsigned u32x2 __attribute__((ext_vector_type(2)));

constexpr int D = 1024, TL = 16384, ML = 32768, TCX = 256, MC = 512, MT = 33280;
constexpr int NEIN = 2048, DFF = 2816, NFF2 = 5632, NREC = 5120, DEX = 3584, NEX2 = 7168, NE = 8;
constexpr int NSEG = 64, SEGL = 256, CH = 32, NCHAIN = 32;
constexpr int MAXTILES = 268, NITEM16 = MT / 16;
constexpr float EPS = 1e-6f;

constexpr size_t MiB = 1u << 20, KiB = 1u << 10;
constexpr size_t WS_CTL = 0, CTL_BYTES = 1 * MiB;
constexpr size_t WS_MODS = 1 * MiB, WS_LB = 1 * MiB + 512 * KiB;
constexpr size_t WS_FA = 2 * MiB, WS_FC = 2 * MiB + 128 * KiB, WS_FX = 2 * MiB + 256 * KiB, WS_GW = 2 * MiB + 512 * KiB;
constexpr size_t WS_XC = 3 * MiB;
constexpr size_t WS_TOPE = 5 * MiB, WS_TOPP = 5 * MiB + 512 * KiB, WS_RANK = 6 * MiB, WS_CNT = 6 * MiB + 512 * KiB, WS_TILEX = 6 * MiB + 768 * KiB, WS_SLOTROW = 7 * MiB, WS_SLOTDST = 7 * MiB + 512 * KiB;
constexpr size_t WS_WINE = 8 * MiB, WS_WOUTE = 16 * MiB, WS_WINO = 20 * MiB, WS_WOUTO = 40 * MiB, WS_W13 = 44 * MiB, WS_W2 = 66 * MiB;
constexpr size_t WS_W13M = 77 * MiB, WS_W2M = 189 * MiB;
constexpr size_t WS_H = 245 * MiB, WS_YE = 310 * MiB, WS_BIG = 440 * MiB;
constexpr size_t WS_PZUV = WS_BIG, WS_UP = WS_BIG + 130 * MiB, WS_HID = WS_BIG, WS_P5 = WS_BIG, WS_SST = WS_BIG + 325 * MiB, WS_EG = WS_BIG + 453 * MiB, WS_S0 = WS_BIG + 454 * MiB, WS_HIDM = WS_BIG;
constexpr size_t WS_PARTC = WS_BIG + 469 * MiB, WS_PARTM = WS_PARTC + 8 * MiB;
constexpr size_t WS_SLOTOF = 1 * MiB + 576 * KiB;
constexpr size_t WS_XB = WS_PARTM + 48 * MiB;
constexpr size_t WS_END = WS_XB + 65 * MiB;
static_assert(WS_END <= (size_t)1032 * MiB, "workspace must stay below the sum of the input sizes (1032.7 MiB)");
static_assert(WS_W2 + (size_t)2 * D * DFF * 2 <= WS_W13M, "static weights");
static_assert(WS_W2M + (size_t)NE * D * DEX * 2 <= WS_H && WS_H + (size_t)MT * D * 2 <= WS_YE && WS_YE + (size_t)MT * 2 * D * 2 <= WS_BIG, "ws map");
static_assert((size_t)MAXTILES * 256 * DEX * 2 <= 469 * MiB && (size_t)MT * NREC * 2 <= 325 * MiB && (size_t)MT * NEIN * 2 <= 130 * MiB, "big region");

constexpr int LDS_BYTES = 147456, MISC_OFF = 147456 - 256;
constexpr int XRS = 288;

typedef __bf16 bf16x2_t __attribute__((ext_vector_type(2)));
__device__ __forceinline__ unsigned f2bf(float f) { return (unsigned)__builtin_bit_cast(unsigned short, (__bf16)f); }
__device__ __forceinline__ unsigned pk2(float lo, float hi) { return __builtin_bit_cast(unsigned, __builtin_convertvector((f32x2){lo, hi}, bf16x2_t)); }
__device__ __forceinline__ float bf2f(unsigned short b) { return __builtin_bit_cast(float, (unsigned)b << 16); }
__device__ __forceinline__ float bflo(unsigned w) { return __builtin_bit_cast(float, w << 16); }
__device__ __forceinline__ float bfhi(unsigned w) { return __builtin_bit_cast(float, w & 0xffff0000u); }
__device__ __forceinline__ float shfl_x(float v, int o, int lane) { return __builtin_bit_cast(float, __builtin_amdgcn_ds_bpermute((lane ^ o) << 2, __builtin_bit_cast(int, v))); }
__device__ __forceinline__ float wave_sum(float v, int lane) {
#pragma unroll
    for (int o = 1; o < 64; o <<= 1) v += shfl_x(v, o, lane);
    return v;
}
__device__ __forceinline__ float siluf(float a) { return a * __builtin_amdgcn_rcpf(1.0f + __expf(-a)); }
#define WQ_NEXT(it, ctr, slot, G) do { __syncthreads(); if (threadIdx.x == 0) *(slot) = (unsigned)(G) + __hip_atomic_fetch_add((ctr), 1u, __ATOMIC_RELAXED, __HIP_MEMORY_SCOPE_AGENT); __syncthreads(); (it) = (int)*(slot); } while (0)
#define LDS_WAIT() asm volatile("s_waitcnt lgkmcnt(0)" ::: "memory")
#define VM_WAIT() asm volatile("s_waitcnt vmcnt(0)" ::: "memory")

#define XB_TMO      128
#define XB_XCNT(j)  (256  + 64 * (j))
#define XB_XSUB(j)  (1280 + 64 * (j))
#define XB_XGEN(j)  (2304 + 64 * (j))
#define XB_TOP      3328
#define XB_TOPGEN   3392
#define XCD_BAR_WORDS 3456
#define XB_SPIN_CAP (1u << 18)
__device__ __forceinline__ unsigned xb_ld(unsigned* p)              { return __hip_atomic_load(p, __ATOMIC_RELAXED, __HIP_MEMORY_SCOPE_AGENT); }
__device__ __forceinline__ unsigned xb_add(unsigned* p, unsigned v) { return __hip_atomic_fetch_add(p, v, __ATOMIC_RELAXED, __HIP_MEMORY_SCOPE_AGENT); }
__device__ __forceinline__ unsigned xb_xcc_id() { return (unsigned)__builtin_amdgcn_s_getreg((3 << 11) | 20) & 0xFu; }
#define XB_SPIN(cond, bar) do { unsigned _sp = 0; while (cond) { __builtin_amdgcn_s_sleep(1); \
    if ((++_sp & 255u) == 0u) { if (xb_ld(&(bar)[XB_TMO])) break; if (_sp > XB_SPIN_CAP) { atomicAdd(&(bar)[XB_TMO], 1u); break; } } } } while (0)
struct XcdBarrier { unsigned* bar; unsigned x; volatile LAS unsigned* st; };
__device__ __forceinline__ XcdBarrier xcd_barrier_post(unsigned* bar, volatile LAS unsigned* st) {
    XcdBarrier b; b.bar = bar; b.x = xb_xcc_id(); b.st = st;
    if (threadIdx.x == 0) (void)xb_add(&bar[XB_XCNT(b.x)], 1u);
    return b;
}
__device__ __forceinline__ void xcd_barrier_complete(unsigned* bar, unsigned x, unsigned& nloc, unsigned& nx) {
    const unsigned G = gridDim.x * gridDim.y * gridDim.z;
    unsigned sum, cnt, mine, sp = 0u;
    for (;;) {
        sum = 0u; cnt = 0u; mine = 0u;
#pragma unroll
        for (unsigned j = 0; j < 16; ++j) { const unsigned c = xb_ld(&bar[XB_XCNT(j)]); sum += c; cnt += (c > 0u) ? 1u : 0u; mine = (j == x) ? c : mine; }
        if (sum == G) break;
        __builtin_amdgcn_s_sleep(1);
        if ((++sp & 255u) == 0u) { if (xb_ld(&bar[XB_TMO])) break; if (sp > XB_SPIN_CAP) { atomicAdd(&bar[XB_TMO], 1u); break; } }
    }
    nloc = mine > 0u ? mine : 1u; nx = cnt > 0u ? cnt : 1u;
}
__device__ __forceinline__ void xcd_barrier(const XcdBarrier& b) {
    asm volatile("s_waitcnt vmcnt(0)" ::: "memory");
    __syncthreads();
    if (threadIdx.x == 0) {
        unsigned* bar = b.bar;
        __builtin_amdgcn_s_waitcnt(0);
        unsigned nloc = b.st[0], nx = b.st[1];
        if (nloc == 0u) { xcd_barrier_complete(bar, b.x, nloc, nx); b.st[0] = nloc; b.st[1] = nx; }
        const unsigned old = xb_add(&bar[XB_XSUB(b.x)], 1u);
        const unsigned gen = old / nloc;
        if (old + 1u == (gen + 1u) * nloc) {
            __builtin_amdgcn_fence(__ATOMIC_RELEASE, "agent");
            asm volatile("s_waitcnt vmcnt(0)" ::: "memory");
            const unsigned og = xb_add(&bar[XB_TOP], 1u);
            const unsigned tg = og / nx;
            if (og + 1u == (tg + 1u) * nx) xb_add(&bar[XB_TOPGEN], 1u);
            else XB_SPIN(xb_ld(&bar[XB_TOPGEN]) == tg, bar);
            __builtin_amdgcn_fence(__ATOMIC_ACQUIRE, "agent");
            xb_add(&bar[XB_XGEN(b.x)], 1u);
            asm volatile("s_waitcnt vmcnt(0)" ::: "memory");
        } else {
            XB_SPIN(xb_ld(&bar[XB_XGEN(b.x)]) == gen, bar);
            __builtin_amdgcn_fence(__ATOMIC_ACQUIRE, "agent");
            asm volatile("s_waitcnt vmcnt(0)" ::: "memory");
        }
    }
    __syncthreads();
}

namespace pg8 {
constexpr int BM = 256, BK = 64, HALF = 128, HTB = HALF * BK * 2, STAGE_BYTES = 8 * HTB, NXCD = 8, WGM = 4;
__host__ __device__ __forceinline__ int lds_byte(int r, int c) { const int st = (r >> 4) * 2 + (c >> 5), rr = r & 15, cc = c & 31, ob = rr * 64 + cc * 2; return st * 1024 + (ob ^ (((ob >> 9) & 1) << 5)); }
__host__ __device__ __forceinline__ void stage_rc(int b, int& R, int& C) { const int st = b / 1024, sb = b % 1024, swz = sb ^ (((sb >> 9) & 1) << 5); R = (st >> 1) * 16 + swz / 64; C = (st & 1) * 32 + (swz % 64) / 2; }
__host__ __device__ __forceinline__ int perm32(int rho) { const int n = rho >> 4, i = rho & 15; return 8 * (i >> 2) + 4 * n + (i & 3); }
struct Unit { int pm, pn, kt0, nt, kp; };
struct Gemm { const bf16_t* A; const bf16_t* Bt; int M, N, K; const int* arow; const int* grp; size_t gstride; };
struct StaticOrder {
    int nM, nN, nwg, G, c, ntk;
    __host__ __device__ void init(int M, int N, int K, int G_, int c_) { nM = M / BM; nN = N / BM; nwg = nM * nN; G = G_; c = c_; ntk = K / BK; }
    __host__ __device__ bool next(int i, Unit& u) const {
        const long L = (long)i * G + c; if (L >= nwg) return false;
        int wgid = (int)L; { const int q = nwg / NXCD, r = nwg % NXCD, xcd = wgid % NXCD, off = wgid / NXCD; wgid = (xcd < r ? xcd * (q + 1) : r * (q + 1) + (xcd - r) * q) + off; }
        const int nig = WGM * nN, gid = wgid / nig, fm = gid * WGM, gsz = (nM - fm) < WGM ? (nM - fm) : WGM;
        u.pm = fm + ((wgid % nig) % gsz); u.pn = (wgid % nig) / gsz; u.kt0 = 0; u.nt = ntk; u.kp = 0; return true;
    }
};
struct ResOrder {
    StaticOrder S; int nlat, npieces, q0, q1, G, c;
    __host__ __device__ void init(int K, int G_, int c_, bool with_ctx) { S.init(ML, D, K, G_, c_); nlat = S.nwg; const int ntk = K / BK; q1 = (ntk / 8) * 2; q0 = (ntk - 2 * q1) / 2; npieces = with_ctx ? 2 * 4 * CTX_KP : 0; if (CTX_KP == 1) { q0 = ntk; q1 = 0; } G = G_; c = c_; }
    __host__ __device__ bool next(int i, Unit& u) const {
        const long L = (long)i * G + c; if (L < nlat) return S.next(i, u);
        const int idx = (int)(L - nlat); if (idx >= npieces) return false;
        const int kp = idx % CTX_KP, rest = idx / CTX_KP; u.kp = kp; u.kt0 = kp < 2 ? kp * q0 : 2 * q0 + (kp - 2) * q1; u.nt = kp < 2 ? q0 : q1; u.pn = rest & 3; u.pm = 128 + (rest >> 2); return true;
    }
};
struct MoeDownOrder {
    StaticOrder S; int nfull, ntail, G, c;
    __host__ __device__ void init(int ntiles, int G_, int c_) { const int pf = ntiles < 256 ? ntiles : 256; S.init(pf * BM, D, DEX, G_, c_); nfull = pf * 4; ntail = (ntiles - pf) * 16; G = G_; c = c_; }
    __host__ __device__ bool next(int i, Unit& u) const {
        const long L = (long)i * G + c; if (L < nfull) return S.next(i, u);
        const int idx = (int)(L - nfull); if (idx >= ntail) return false;
        u.kp = idx & 3; u.kt0 = 14 * (idx & 3); u.nt = 14; u.pn = (idx >> 2) & 3; u.pm = 256 + (idx >> 4); return true;
    }
};
__device__ __forceinline__ unsigned cvt_pk_bf16(float lo, float hi) { unsigned r; asm volatile("v_cvt_pk_bf16_f32 %0, %1, %2" : "=v"(r) : "v"(lo), "v"(hi)); return r; }
__device__ __forceinline__ f32x2 gelu_pk(f32x2 v) {
    const f32x2 av = __builtin_elementwise_abs(v), d = av * 0.2316418882f + 1.0f;
    f32x2 t; t.x = __builtin_amdgcn_rcpf(d.x); t.y = __builtin_amdgcn_rcpf(d.y);
    f32x2 q = t * 0.5307027145f + (-0.7265760135f); q = q * t + 0.7107068705f; q = q * t + (-0.142248368f); q = q * t + 0.127414796f; q = q * t;
    const f32x2 s = (v * v) * (-0.72134752044f);
    f32x2 e; e.x = __builtin_amdgcn_exp2f(s.x); e.y = __builtin_amdgcn_exp2f(s.y);
    const f32x2 m = v * (q * e), r = v - m;
    f32x2 o; o.x = v.x < 0.f ? m.x : r.x; o.y = v.y < 0.f ? m.y : r.y; return o;
}
template <class Epi, class Sched, bool ALIGN_EPI, bool GATHER>
__device__ __forceinline__ void gemm_phase(LAS unsigned char* lds, const Gemm g, const Sched& S, const Epi& E, const int tid) {
    const int wid = __builtin_amdgcn_readfirstlane(tid >> 6), lane = tid & 63, wr = wid >> 2, wc = wid & 3, fr = lane & 15, fq = lane >> 4;
    const int K = g.K;
    unsigned voffA[2], voffB[2];
    unsigned voffA1[2];
#pragma unroll
    for (int i = 0; i < 2; ++i) { int R, C; stage_rc(tid * 16 + i * 8192, R, C); const int Rb = Epi::PERM == 2 ? (64 * (R >> 5) + perm32(R & 31)) : Epi::PERM ? ((R & ~31) + perm32(R & 31)) : R;
        voffA[i] = (unsigned)(R * K + C) * 2u; voffA1[i] = voffA[i]; voffB[i] = (unsigned)(Rb * K + C) * 2u; }
    const size_t kstep = (size_t)(BK * 2);
    const size_t hstep = (size_t)HALF * K * 2;
    const size_t tstep = 2 * hstep;
    const size_t hstepB = Epi::PERM == 2 ? (size_t)32 * K * 2 : hstep;
    const unsigned ldsw = (unsigned)wid * 1024u;
    const int aoff = lds_byte(wr * 64 + fr, fq * 8), boff = lds_byte(wc * 32 + fr, fq * 8);
#define PG8_SA(b, h) (((b) * 2 + (h)) * HTB)
#define PG8_SB(b, h) ((4 + (b) * 2 + (h)) * HTB)
#define PG8_STAGE(bufoff, gbase, voff) do { _Pragma("unroll") for (int _i = 0; _i < 2; ++_i) \
        __builtin_amdgcn_global_load_lds((const unsigned*)((const char*)(gbase) + (voff)[_i]), (LAS unsigned*)(lds + (bufoff) + ldsw + _i * 8192), 16, 0, 0); } while (0)
#define PG8_LDA(dst, b, h) do { _Pragma("unroll") for (int m = 0; m < 4; ++m) _Pragma("unroll") for (int k = 0; k < 2; ++k) dst[m][k] = *(const LAS bf16x8*)(lds + PG8_SA(b, h) + aoff + m * 2048 + k * 1024); } while (0)
#define PG8_LDB(dst, b, h) do { _Pragma("unroll") for (int n = 0; n < 2; ++n) _Pragma("unroll") for (int k = 0; k < 2; ++k) dst[n][k] = *(const LAS bf16x8*)(lds + PG8_SB(b, h) + boff + n * 2048 + k * 1024); } while (0)
#define PG8_MMA(ai, bj, At, Bt) do { __builtin_amdgcn_s_setprio(1); _Pragma("unroll") for (int m = 0; m < 4; ++m) _Pragma("unroll") for (int n = 0; n < 2; ++n) _Pragma("unroll") for (int k = 0; k < 2; ++k) \
        acc[ai][bj][m][n] = __builtin_amdgcn_mfma_f32_16x16x32_bf16(Bt[n][k], At[m][k], acc[ai][bj][m][n], 0, 0, 0); __builtin_amdgcn_s_setprio(0); } while (0)
#define PG8_WAIT_V(n) asm volatile("s_waitcnt vmcnt(" #n ")" ::: "memory")
#define PG8_WAIT_L(n) asm volatile("s_waitcnt lgkmcnt(" #n ")" ::: "memory")
#define PG8_BAR __builtin_amdgcn_s_barrier()
#define PG8_SCHED __builtin_amdgcn_sched_barrier(0)
#define PG8_VA1 (GATHER ? voffA1 : voffA)
#define PG8_GOFF(u, v0, v1) do { _Pragma("unroll") for (int _i = 0; _i < 2; ++_i) { int R_, C_; stage_rc(tid * 16 + _i * 8192, R_, C_); \
        const int r0_ = g.arow[(u).pm * BM + R_], r1_ = g.arow[(u).pm * BM + HALF + R_]; v0[_i] = (unsigned)(r0_ * K + C_) * 2u; v1[_i] = (unsigned)(r1_ * K + C_) * 2u; } } while (0)
#define PG8_GROWS(u, q0, q1) do { _Pragma("unroll") for (int _i = 0; _i < 2; ++_i) { int R_, C_; stage_rc(tid * 16 + _i * 8192, R_, C_); q0[_i] = g.arow[(u).pm * BM + R_]; q1[_i] = g.arow[(u).pm * BM + HALF + R_]; } } while (0)
#define PG8_GOFFR(q0, q1, v0, v1) do { _Pragma("unroll") for (int _i = 0; _i < 2; ++_i) { int R_, C_; stage_rc(tid * 16 + _i * 8192, R_, C_); v0[_i] = (unsigned)(q0[_i] * K + C_) * 2u; v1[_i] = (unsigned)(q1[_i] * K + C_) * 2u; } } while (0)
#define PG8_BBASE(u) ((const char*)g.Bt + (g.grp ? (size_t)g.grp[(u).pm] * g.gstride * 2 : (size_t)0) + (size_t)(u).pn * tstep + (size_t)(u).kt0 * kstep)
    Unit cur, nxt; int ui = 0;
    if (!S.next(0, cur)) return;
    f32x4 acc[2][2][4][2];
#pragma unroll
    for (int a = 0; a < 2; ++a)
#pragma unroll
        for (int b = 0; b < 2; ++b)
#pragma unroll
            for (int m = 0; m < 4; ++m)
#pragma unroll
                for (int n = 0; n < 2; ++n) acc[a][b][m][n] = (f32x4){0.f, 0.f, 0.f, 0.f};
    bf16x8 At[4][2], B0[2][2], B1[2][2];
    const char* cA = (GATHER ? (const char*)g.A : (const char*)g.A + (size_t)cur.pm * tstep) + (size_t)cur.kt0 * kstep;
    const size_t ah = GATHER ? (size_t)0 : hstep;
    int gq0[2] = {0, 0}, gq1[2] = {0, 0};
    if constexpr (GATHER) { PG8_GOFF(cur, voffA, voffA1); Unit n1_; if (S.next(1, n1_)) PG8_GROWS(n1_, gq0, gq1); asm volatile("" : "+v"(gq0[0]), "+v"(gq0[1]), "+v"(gq1[0]), "+v"(gq1[1])); }
    const char* cB = PG8_BBASE(cur);
    PG8_STAGE(PG8_SB(0, 0), cB, voffB); PG8_STAGE(PG8_SA(0, 0), cA, voffA); PG8_STAGE(PG8_SB(0, 1), cB + hstepB, voffB); PG8_STAGE(PG8_SA(0, 1), cA + ah, PG8_VA1);
    if (wr == 1) PG8_BAR;
    PG8_WAIT_V(4); PG8_BAR;
    PG8_STAGE(PG8_SB(1, 0), cB + kstep, voffB); PG8_STAGE(PG8_SA(1, 0), cA + kstep, voffA); PG8_STAGE(PG8_SB(1, 1), cB + hstepB + kstep, voffB);
    PG8_WAIT_V(6); PG8_BAR;
    for (;;) {
        const bool has_next = S.next(ui + 1, nxt);
        const char* nA = !has_next ? cA : (GATHER ? (const char*)g.A : (const char*)g.A + (size_t)nxt.pm * tstep) + (size_t)nxt.kt0 * kstep; const char* nB = has_next ? PG8_BBASE(nxt) : cB;
        const int nt = cur.nt;
        for (int t = 0; t < nt; t += 2) {
            const bool last = (t == nt - 2);
            const char* a1 = cA + (size_t)(t + 1) * kstep;
            const char* a2 = last ? nA : cA + (size_t)(t + 2) * kstep; const char* b2 = last ? nB : cB + (size_t)(t + 2) * kstep;
            const char* a3 = a2 + kstep; const char* b3 = b2 + kstep;
            PG8_LDB(B0, 0, 0); PG8_SCHED; PG8_LDA(At, 0, 0); PG8_STAGE(PG8_SA(1, 1), a1 + ah, PG8_VA1);
            if constexpr (GATHER) { if (last && has_next) PG8_GOFFR(gq0, gq1, voffA, voffA1); }
            PG8_WAIT_L(8); PG8_BAR; PG8_WAIT_L(0); PG8_MMA(0, 0, At, B0); PG8_BAR; PG8_SCHED;
            PG8_LDB(B1, 0, 1); PG8_STAGE(PG8_SB(0, 0), b2, voffB);
            PG8_BAR; PG8_WAIT_L(0); PG8_MMA(0, 1, At, B1); PG8_BAR;
            PG8_LDA(At, 0, 1); PG8_STAGE(PG8_SA(0, 0), a2, voffA);
            PG8_BAR; PG8_WAIT_L(0); PG8_MMA(1, 0, At, B0); PG8_BAR; PG8_SCHED;
            PG8_STAGE(PG8_SB(0, 1), b2 + hstepB, voffB);
            PG8_WAIT_V(6); PG8_BAR; PG8_MMA(1, 1, At, B1); PG8_BAR;
            PG8_LDB(B0, 1, 0); PG8_SCHED; PG8_LDA(At, 1, 0); PG8_STAGE(PG8_SA(0, 1), a2 + ah, PG8_VA1);
            PG8_WAIT_L(8); PG8_BAR; PG8_WAIT_L(0); PG8_MMA(0, 0, At, B0); PG8_BAR; PG8_SCHED;
            PG8_LDB(B1, 1, 1); PG8_STAGE(PG8_SB(1, 0), b3, voffB);
            PG8_BAR; PG8_WAIT_L(0); PG8_MMA(0, 1, At, B1); PG8_BAR;
            PG8_LDA(At, 1, 1); PG8_STAGE(PG8_SA(1, 0), a3, voffA);
            PG8_BAR; PG8_WAIT_L(0); PG8_MMA(1, 0, At, B0); PG8_BAR; PG8_SCHED;
            PG8_STAGE(PG8_SB(1, 1), b3 + hstepB, voffB);
            PG8_WAIT_V(6); PG8_BAR; PG8_MMA(1, 1, At, B1); PG8_BAR;
        }
        if constexpr (ALIGN_EPI) { if (wr == 0) PG8_BAR; }
        int gt0[2] = {0, 0}, gt1[2] = {0, 0};
        if constexpr (GATHER) { Unit n2_; if (S.next(ui + 2, n2_)) PG8_GROWS(n2_, gt0, gt1); }
        E(acc, cur, wr, wc, fr, fq);
        if constexpr (GATHER) { asm volatile("" : "+v"(gt0[0]), "+v"(gt0[1]), "+v"(gt1[0]), "+v"(gt1[1])); gq0[0] = gt0[0]; gq0[1] = gt0[1]; gq1[0] = gt1[0]; gq1[1] = gt1[1]; }
        if (!has_next) break;
#pragma unroll
        for (int a = 0; a < 2; ++a)
#pragma unroll
            for (int b = 0; b < 2; ++b)
#pragma unroll
                for (int m = 0; m < 4; ++m)
#pragma unroll
                    for (int n = 0; n < 2; ++n) acc[a][b][m][n] = (f32x4){0.f, 0.f, 0.f, 0.f};
        cur = nxt; cA = nA; cB = nB; ++ui;
        if constexpr (ALIGN_EPI) { if (wr == 1) PG8_BAR; }
    }
    PG8_WAIT_V(0);
    if constexpr (!ALIGN_EPI) { if (wr == 0) PG8_BAR; }
    PG8_BAR;
#undef PG8_SA
#undef PG8_SB
#undef PG8_STAGE
#undef PG8_LDA
#undef PG8_LDB
#undef PG8_MMA
#undef PG8_WAIT_V
#undef PG8_WAIT_L
#undef PG8_BAR
#undef PG8_SCHED
#undef PG8_VA1
#undef PG8_GOFF
#undef PG8_GROWS
#undef PG8_GOFFR
#undef PG8_BBASE
}

struct EpiEvenIn {
    static constexpr bool PERM = true;
    bf16_t* O;
    template <bool ACT> __device__ __forceinline__ void run(const f32x4 (&acc)[2][2][4][2], const Unit& u, int wr, int wc, int fr, int fq) const {
        const int row0 = u.pm * BM + wr * 64 + fr, col0 = u.pn * BM + wc * 32 + 8 * fq;
#pragma unroll
        for (int ai = 0; ai < 2; ++ai)
#pragma unroll
            for (int m = 0; m < 4; ++m) { bf16_t* rowp = O + (size_t)(row0 + ai * HALF + m * 16) * NEIN + col0;
#pragma unroll
                for (int bj = 0; bj < 2; ++bj) { f32x4 v0 = acc[ai][bj][m][0], v1 = acc[ai][bj][m][1];
                    if (ACT) { f32x2 a = gelu_pk((f32x2){v0[0], v0[1]}), b = gelu_pk((f32x2){v0[2], v0[3]}), c = gelu_pk((f32x2){v1[0], v1[1]}), d = gelu_pk((f32x2){v1[2], v1[3]});
                        v0 = (f32x4){a.x, a.y, b.x, b.y}; v1 = (f32x4){c.x, c.y, d.x, d.y}; }
                    u32x4 w; w.x = cvt_pk_bf16(v0[0], v0[1]); w.y = cvt_pk_bf16(v0[2], v0[3]); w.z = cvt_pk_bf16(v1[0], v1[1]); w.w = cvt_pk_bf16(v1[2], v1[3]);
                    *(u32x4*)(rowp + bj * HALF) = w; } }
    }
    __device__ __forceinline__ void operator()(const f32x4 (&acc)[2][2][4][2], const Unit& u, int wr, int wc, int fr, int fq) const {
        if (u.pn >= 4) run<true>(acc, u, wr, wc, fr, fq); else run<false>(acc, u, wr, wc, fr, fq);
    }
};
template <bool SRC_F32> struct EpiRes {
    static constexpr bool PERM = true;
    const float* sl32; bf16_t* xb; const float* gate; float* part;
    __device__ __forceinline__ void operator()(const f32x4 (&acc)[2][2][4][2], const Unit& u, int wr, int wc, int fr, int fq) const {
        const int col0 = u.pn * BM + wc * 32 + 8 * fq;
        typedef __attribute__((address_space(1))) const char gcc_t; typedef __attribute__((address_space(1))) char gc_t;
        if (u.pm >= 128) {
            gc_t* dst = (gc_t*)(part + ((size_t)u.kp * MC + (size_t)(u.pm - 128) * BM) * D);
#pragma unroll
            for (int ai = 0; ai < 2; ++ai)
#pragma unroll
                for (int m = 0; m < 4; ++m) { const unsigned off = (unsigned)((ai * HALF + wr * 64 + m * 16 + fr) * D + col0) * 4u;
#pragma unroll
                    for (int bj = 0; bj < 2; ++bj) { *(__attribute__((address_space(1))) f32x4*)(dst + off + (unsigned)(bj * HALF) * 4u) = acc[ai][bj][m][0]; *(__attribute__((address_space(1))) f32x4*)(dst + off + (unsigned)(bj * HALF + 4) * 4u) = acc[ai][bj][m][1]; } }
            return;
        }
        const int ms = u.pm >= 64 ? 1 : 0;
        const size_t rbase = (size_t)u.pm * BM;
        gcc_t* src32 = (gcc_t*)(sl32 + rbase * D); gc_t* xbp = (gc_t*)(xb + rbase * D); gcc_t* gp = (gcc_t*)(gate + ms * 6144);
        f32x4 gv[2][2];
#pragma unroll
        for (int bj = 0; bj < 2; ++bj)
#pragma unroll
            for (int n = 0; n < 2; ++n) gv[bj][n] = *(__attribute__((address_space(1))) const f32x4*)(gp + (unsigned)(col0 + bj * HALF + 4 * n) * 4u);
        if (SRC_F32) {
#pragma unroll
            for (int ai = 0; ai < 2; ++ai)
#pragma unroll
                for (int mh = 0; mh < 2; ++mh) {
                    f32x4 xr[2][2][2];
#pragma unroll
                    for (int mm = 0; mm < 2; ++mm) { const unsigned eo = (unsigned)((ai * HALF + wr * 64 + (2 * mh + mm) * 16 + fr) * D + col0);
#pragma unroll
                        for (int bj = 0; bj < 2; ++bj) { xr[mm][bj][0] = *(__attribute__((address_space(1))) const f32x4*)(src32 + (eo + bj * HALF) * 4u); xr[mm][bj][1] = *(__attribute__((address_space(1))) const f32x4*)(src32 + (eo + bj * HALF + 4) * 4u); } }
                    __builtin_amdgcn_sched_barrier(0);
#pragma unroll
                    for (int mm = 0; mm < 2; ++mm) { const int m = 2 * mh + mm; const unsigned eo = (unsigned)((ai * HALF + wr * 64 + m * 16 + fr) * D + col0);
#pragma unroll
                        for (int bj = 0; bj < 2; ++bj) { const f32x4 y0 = xr[mm][bj][0] + gv[bj][0] * acc[ai][bj][m][0], y1 = xr[mm][bj][1] + gv[bj][1] * acc[ai][bj][m][1];
                            u32x4 w; w.x = cvt_pk_bf16(y0[0], y0[1]); w.y = cvt_pk_bf16(y0[2], y0[3]); w.z = cvt_pk_bf16(y1[0], y1[1]); w.w = cvt_pk_bf16(y1[2], y1[3]);
                            *(__attribute__((address_space(1))) u32x4*)(xbp + (eo + bj * HALF) * 2u) = w; } }
                    __builtin_amdgcn_sched_barrier(0);
                }
        } else {
#pragma unroll
            for (int ai = 0; ai < 2; ++ai) {
                u32x4 raw[4][2];
#pragma unroll
                for (int m = 0; m < 4; ++m) { const unsigned eo = (unsigned)((ai * HALF + wr * 64 + m * 16 + fr) * D + col0);
#pragma unroll
                    for (int bj = 0; bj < 2; ++bj) raw[m][bj] = *(__attribute__((address_space(1))) const u32x4*)(xbp + (eo + bj * HALF) * 2u); }
                __builtin_amdgcn_sched_barrier(0);
#pragma unroll
                for (int m = 0; m < 4; ++m) { const unsigned eo = (unsigned)((ai * HALF + wr * 64 + m * 16 + fr) * D + col0);
#pragma unroll
                    for (int bj = 0; bj < 2; ++bj) { const u32x4 r = raw[m][bj];
                        const f32x4 x0 = (f32x4){bflo(r.x), bfhi(r.x), bflo(r.y), bfhi(r.y)}, x1 = (f32x4){bflo(r.z), bfhi(r.z), bflo(r.w), bfhi(r.w)};
                        const f32x4 y0 = x0 + gv[bj][0] * acc[ai][bj][m][0], y1 = x1 + gv[bj][1] * acc[ai][bj][m][1];
                        u32x4 w; w.x = cvt_pk_bf16(y0[0], y0[1]); w.y = cvt_pk_bf16(y0[2], y0[3]); w.z = cvt_pk_bf16(y1[0], y1[1]); w.w = cvt_pk_bf16(y1[2], y1[3]);
                        *(__attribute__((address_space(1))) u32x4*)(xbp + (eo + bj * HALF) * 2u) = w; } }
                __builtin_amdgcn_sched_barrier(0);
            }
        }
    }
};
struct EpiSwiglu {
    static constexpr bool PERM = true;
    bf16_t* O; int ldc;
    __device__ __forceinline__ void operator()(const f32x4 (&acc)[2][2][4][2], const Unit& u, int wr, int wc, int fr, int fq) const {
        const int row0 = u.pm * BM + wr * 64 + fr, col0 = u.pn * 128 + wc * 32 + 8 * fq;
#pragma unroll
        for (int ai = 0; ai < 2; ++ai)
#pragma unroll
            for (int m = 0; m < 4; ++m) { bf16_t* rowp = O + (size_t)(row0 + ai * HALF + m * 16) * ldc + col0;
                float y[8];
#pragma unroll
                for (int n = 0; n < 2; ++n)
#pragma unroll
                    for (int i = 0; i < 4; ++i) { const float a = acc[ai][0][m][n][i], b = acc[ai][1][m][n][i]; y[4 * n + i] = (a * b) * __builtin_amdgcn_rcpf(1.0f + __builtin_amdgcn_exp2f(a * -1.44269504089f)); }
                u32x4 w; w.x = cvt_pk_bf16(y[0], y[1]); w.y = cvt_pk_bf16(y[2], y[3]); w.z = cvt_pk_bf16(y[4], y[5]); w.w = cvt_pk_bf16(y[6], y[7]);
                *(u32x4*)rowp = w; }
    }
};
struct EpiOddIn {
    static constexpr int PERM = 2;
    bf16_t* O; const float* lb;
    template <int MODE> __device__ __forceinline__ void run(const f32x4 (&acc)[2][2][4][2], const Unit& u, int wr, int wc, int fr, int fq, float c) const {
        const int row0 = u.pm * BM + wr * 64 + fr, col0 = u.pn * BM + wc * 64 + 8 * fq; const int seg = u.pn >> 2;
        f32x4 lbv[2][2];
        if (MODE == 1) {
#pragma unroll
            for (int bj = 0; bj < 2; ++bj)
#pragma unroll
                for (int n = 0; n < 2; ++n) lbv[bj][n] = *(const f32x4*)(lb + (col0 - 2048) + bj * 32 + 4 * n); }
#pragma unroll
        for (int ai = 0; ai < 2; ++ai)
#pragma unroll
            for (int m = 0; m < 4; ++m) { bf16_t* rowp = O + ((size_t)((u.pn & 3) * 2 + (wc >> 1)) * MT + (size_t)(row0 + ai * HALF + m * 16)) * 640 + seg * 128 + (wc & 1) * 64 + 8 * fq;
#pragma unroll
                for (int bj = 0; bj < 2; ++bj) { f32x4 v[2] = {acc[ai][bj][m][0], acc[ai][bj][m][1]};
#pragma unroll
                    for (int n = 0; n < 2; ++n)
#pragma unroll
                        for (int i = 0; i < 4; ++i) { float x = v[n][i];
                            if (MODE == 0) x = (x * c) * __builtin_amdgcn_rcpf(1.0f + __builtin_amdgcn_exp2f(x * -1.44269504089f));
                            else if (MODE == 1) { const float l = lbv[bj][n][i]; const float s = __builtin_amdgcn_rcpf(1.0f + __builtin_amdgcn_exp2f(x * -1.44269504089f)); const float f = l + (1.0f - l) * s; x = __builtin_amdgcn_logf(fmaxf(f, 1e-30f)) * 0.69314718056f; }
                            v[n][i] = x; }
                    u32x4 w; w.x = cvt_pk_bf16(v[0][0], v[0][1]); w.y = cvt_pk_bf16(v[0][2], v[0][3]); w.z = cvt_pk_bf16(v[1][0], v[1][1]); w.w = cvt_pk_bf16(v[1][2], v[1][3]);
                    *(u32x4*)(rowp + bj * 32) = w; } }
    }
    __device__ __forceinline__ void operator()(const f32x4 (&acc)[2][2][4][2], const Unit& u, int wr, int wc, int fr, int fq) const {
        const int seg = u.pn >> 2;
        if (seg == 0) run<0>(acc, u, wr, wc, fr, fq, 0.08838834764831845f);
        else if (seg == 1) run<0>(acc, u, wr, wc, fr, fq, 1.0f);
        else if (seg == 4) run<2>(acc, u, wr, wc, fr, fq, 1.0f);
        else run<1>(acc, u, wr, wc, fr, fq, 1.0f);
    }
};
struct EpiNull { static constexpr bool PERM = true; float* sink;
    __device__ __forceinline__ void operator()(const f32x4 (&acc)[2][2][4][2], const Unit& u, int wr, int wc, int fr, int fq) const {
        float s = 0.f;
#pragma unroll
        for (int ai = 0; ai < 2; ++ai)
#pragma unroll
            for (int bj = 0; bj < 2; ++bj)
#pragma unroll
                for (int m = 0; m < 4; ++m)
#pragma unroll
                    for (int n = 0; n < 2; ++n) s += acc[ai][bj][m][n][0] + acc[ai][bj][m][n][1] + acc[ai][bj][m][n][2] + acc[ai][bj][m][n][3];
        if (s == 123.456f) sink[0] = s; } };
struct EpiMoeDown {
    static constexpr bool PERM = true;
    bf16_t* O; const int* dst; float* partm;
    __device__ __forceinline__ void operator()(const f32x4 (&acc)[2][2][4][2], const Unit& u, int wr, int wc, int fr, int fq) const {
        const int row0 = u.pm * BM + wr * 64 + fr, col0 = u.pn * BM + wc * 32 + 8 * fq;
        if (u.pm >= 256) {
            float* base = partm + ((size_t)u.kp * 3072 + (size_t)(row0 - 65536)) * D + col0;
#pragma unroll
            for (int ai = 0; ai < 2; ++ai)
#pragma unroll
                for (int m = 0; m < 4; ++m) { float* rowp = base + (size_t)(ai * HALF + m * 16) * D;
#pragma unroll
                    for (int bj = 0; bj < 2; ++bj) { *(f32x4*)(rowp + bj * HALF) = acc[ai][bj][m][0]; *(f32x4*)(rowp + bj * HALF + 4) = acc[ai][bj][m][1]; } }
            return;
        }
        bf16_t* base = O + (size_t)row0 * D + col0;
#pragma unroll
        for (int ai = 0; ai < 2; ++ai)
#pragma unroll
            for (int m = 0; m < 4; ++m) { bf16_t* rowp = base + (size_t)(ai * HALF + m * 16) * D;
#pragma unroll
                for (int bj = 0; bj < 2; ++bj) { const f32x4 v0 = acc[ai][bj][m][0], v1 = acc[ai][bj][m][1];
                    u32x4 w; w.x = cvt_pk_bf16(v0[0], v0[1]); w.y = cvt_pk_bf16(v0[2], v0[3]); w.z = cvt_pk_bf16(v1[0], v1[1]); w.w = cvt_pk_bf16(v1[2], v1[3]);
                    *(u32x4*)(rowp + bj * HALF) = w; } }
    }
};
}

struct Args { const float* in[24]; float* out; unsigned char* ws; int ph_lo, ph_hi; };
enum { I_X = 0, I_C, I_CTX, I_CCTX, I_WADA, I_BADA, I_NMIX, I_NFFN, I_NOUT, I_WINE, I_GW, I_GB, I_WOUTE, I_WINO, I_RLB, I_RNORM, I_WOUTO, I_F1, I_F3, I_F2, I_RW, I_M1, I_M3, I_M2 };
enum { PH_P0 = 0, PH_PAIR0 = 1, NPL = 18, PH_FINAL = 1 + 2 * NPL, NPHASE = PH_FINAL + 1 };
enum { E1_NORM = 0, E2_GIN, E3_FFTA, E3_FFTC, E4_GOUT, E5_NORM, E6_UP, E7_DOWN, O1_NORM, O2_GIN, O3_SCAN1, O4_CARRY, O5_SCAN3, O6_GOUT, O7_NORM, O8_SLOTS, O9_MUP, O10_MDOWN };

#define LAUNDER_WS_OUT(extra_) do { auto w_ = (__attribute__((address_space(1))) unsigned char*)F.ws; auto o_ = (__attribute__((address_space(1))) float*)F.out; \
        asm volatile("" : "+s"(w_), "+s"(o_) extra_); F.ws = (unsigned char*)w_; F.out = (float*)o_; } while (0)
#define FIN(i) (F.in[i])
struct Ctx {
    LAS unsigned char* lds; int tid, lane, wave, G, bid, gw, NGW;
    const float* const* in; float* out; unsigned char* ws;
};

__device__ __forceinline__ void transpose_item(const float* W, int ld, int K, int N, bf16_t* WT, int mode, int roff, int item, int lane) {
    const int nblk = N / 64, kb = item / nblk, nb = item % nblk, k0 = 64 * kb, n0 = 64 * nb;
    const int c = lane & 15, kg = lane >> 4;
    const float* src = W + (size_t)(k0 + 8 * kg) * ld + n0 + 4 * c;
    f32x4 v[2][8];
#pragma unroll
    for (int hf = 0; hf < 2; ++hf)
#pragma unroll
        for (int i = 0; i < 8; ++i) v[hf][i] = __builtin_nontemporal_load((const f32x4*)(src + (size_t)(32 * hf + i) * ld));
    __builtin_amdgcn_sched_barrier(0);
#pragma unroll
    for (int i = 0; i < 4; ++i) { const int ng = n0 + 4 * c + i; const int drow = mode == 0 ? (roff + ng) : (((ng >> 7) << 8) + (ng & 127) + roff);
#pragma unroll
        for (int hf = 0; hf < 2; ++hf) { u32x4 o; o.x = pk2(v[hf][0][i], v[hf][1][i]); o.y = pk2(v[hf][2][i], v[hf][3][i]); o.z = pk2(v[hf][4][i], v[hf][5][i]); o.w = pk2(v[hf][6][i], v[hf][7][i]);
            *(u32x4*)(WT + (size_t)drow * K + k0 + 32 * hf + 8 * kg) = o; } }
}

__device__ __forceinline__ void p0_prologue(const Ctx& F) {
    const int tid = F.tid, lane = F.lane, wave = F.wave;
    unsigned char* ws = F.ws;
    LAS float* scond = (LAS float*)(F.lds);
    LAS float* part = (LAS float*)(F.lds + 16384);
    LAS float* ctab = (LAS float*)(F.lds + 32768);
    for (int i = tid; i < 3 * D; i += 512) { const int v = i / D, k = i % D; const float c = v < 2 ? FIN(I_C)[v * D + k] : FIN(I_CCTX)[k]; scond[i] = c / (1.0f + expf(-c)); }
    if (tid < 128) ctab[tid] = cosf(6.283185307179586f * (float)tid / 128.0f);
    __syncthreads();
    float* mods = (float*)(ws + WS_MODS);
    if (P0_MASK & 1)
    for (int it = F.bid; it < 4 * 48; it += F.G) {
        const int l = it / 48, cg = it % 48; const float* W = FIN(I_WADA) + (size_t)l * D * 6144 + cg * 128 + 2 * lane;
        float a0[2] = {0.f, 0.f}, a1[2] = {0.f, 0.f}, a2[2] = {0.f, 0.f};
#pragma unroll 16
        for (int kk = 0; kk < 128; ++kk) { const int k = wave * 128 + kk; const f32x2 w = __builtin_nontemporal_load((const f32x2*)(W + (size_t)k * 6144)); const float s0 = scond[k], s1 = scond[D + k], s2 = scond[2 * D + k];
            a0[0] += s0 * w.x; a0[1] += s0 * w.y; a1[0] += s1 * w.x; a1[1] += s1 * w.y; a2[0] += s2 * w.x; a2[1] += s2 * w.y; }
        part[(wave * 3 + 0) * 128 + 2 * lane] = a0[0]; part[(wave * 3 + 0) * 128 + 2 * lane + 1] = a0[1];
        part[(wave * 3 + 1) * 128 + 2 * lane] = a1[0]; part[(wave * 3 + 1) * 128 + 2 * lane + 1] = a1[1];
        part[(wave * 3 + 2) * 128 + 2 * lane] = a2[0]; part[(wave * 3 + 2) * 128 + 2 * lane + 1] = a2[1];
        __syncthreads();
        if (tid < 384) { const int v = tid / 128, c = tid % 128; float sum = 0.f;
#pragma unroll
            for (int w = 0; w < 8; ++w) sum += part[(w * 3 + v) * 128 + c];
            mods[((size_t)l * 3 + v) * 6144 + cg * 128 + c] = sum + FIN(I_BADA)[l * 6144 + cg * 128 + c]; }
        __syncthreads();
    }
    const int gt = F.bid * 512 + tid, NGT = F.G * 512;
    float* LB = (float*)(ws + WS_LB);
    if (P0_MASK & 2)
    for (int i = gt; i < 4096; i += NGT) { const int j = i >> 11, r = i & 2047; float v = 0.f; if (j == 1) { const float r0 = FIN(I_RLB)[r], r1 = FIN(I_RLB)[2048 + r]; v = 1.0f / (1.0f + expf(r0 - r1)); v = fminf(fmaxf(v, 0.f), 1.f); } LB[i] = v; }
    bf16_t* FA = (bf16_t*)(ws + WS_FA); bf16_t* FC = (bf16_t*)(ws + WS_FC); bf16_t* FX = (bf16_t*)(ws + WS_FX); bf16_t* GW = (bf16_t*)(ws + WS_GW);
    if (P0_MASK & 4)
    for (int i = gt; i < 256 * 256; i += NGT) { const int r = i >> 8, c = i & 255, k1 = r & 127, t1 = c & 127; const float ang = 6.283185307179586f * (float)((k1 * t1) & 127) / 128.0f; float sn, cs; sincosf(ang, &sn, &cs);
        const int rr = r >> 7, cc = c >> 7; const float v = (rr == cc) ? cs : (rr == 0 ? -sn : sn); FA[i] = (bf16_t)f2bf(v); }
    if (P0_MASK & 4)
    for (int i = gt; i < 128 * 256; i += NGT) { const int k2 = i >> 8, c = i & 255, t2 = c & 127; const float ang = 6.283185307179586f * (float)((k2 * t2) & 127) / 128.0f; float sn, cs; sincosf(ang, &sn, &cs); FC[i] = (bf16_t)f2bf(c < 128 ? cs : -sn); }
    if (P0_MASK & 4)
    for (int i = gt; i < 256 * 512; i += NGT) { const int k = i >> 9, c = i & 511, t = c & 255; const float ang = 6.283185307179586f * (float)((k * t) & 255) / 256.0f; float sn, cs; sincosf(ang, &sn, &cs); FX[i] = (bf16_t)f2bf(c < 256 ? cs : -sn); }
    if (P0_MASK & 8)
    for (int i = gt; i < 2 * 4 * 128 * 128; i += NGT) GW[i] = (bf16_t)f2bf(FIN(I_GW)[i]);
    bf16_t* WinE = (bf16_t*)(ws + WS_WINE);
    if (P0_MASK & 16)
    for (int it = F.gw; it < 2 * 4 * 16 * 32; it += F.NGW) {
        const int mg = it & 31, kb = (it >> 5) & 15, g = (it >> 9) & 3, j = it >> 11; const int k = kb * 64 + lane, m0 = mg * 4;
        const float* Wr = FIN(I_WINE) + (size_t)j * D * 1536 + (size_t)k * 1536 + g * 128;
        float aP[4] = {0.f, 0.f, 0.f, 0.f}, aQ[4] = {0.f, 0.f, 0.f, 0.f};
        f32x4 wq_[32];
#pragma unroll
        for (int c4 = 0; c4 < 32; ++c4) wq_[c4] = *(const f32x4*)(Wr + 4 * c4);
        __builtin_amdgcn_sched_barrier(0);
#pragma unroll
        for (int c4 = 0; c4 < 32; ++c4) { const f32x4 w = wq_[c4];
#pragma unroll
            for (int ci = 0; ci < 4; ++ci) { const int c = 4 * c4 + ci;
#pragma unroll
                for (int mm = 0; mm < 4; ++mm) { const int idx = (c * (m0 + mm)) & 127; aP[mm] += w[ci] * ctab[idx]; aQ[mm] += w[ci] * ctab[(idx - 32) & 127]; } } }
#pragma unroll
        for (int mm = 0; mm < 4; ++mm) { bf16_t* o = WinE + (size_t)j * NEIN * D; o[(size_t)(g * 128 + m0 + mm) * D + k] = (bf16_t)f2bf(aP[mm]); o[(size_t)(512 + g * 128 + m0 + mm) * D + k] = (bf16_t)f2bf(aQ[mm]); }
    }
    constexpr int NI_UV = 16 * 16, NI_SQ = 16 * 16, NI_INO = 16 * 80, NI_F13 = 16 * 44, NI_F2 = 44 * 16;
    constexpr int PER_J = NI_UV + NI_SQ + NI_INO + NI_SQ + 2 * NI_F13 + NI_F2;
    if (P0_MASK & 32)
    for (int it = F.gw; it < 2 * PER_J; it += F.NGW) {
        const int j = it / PER_J; int r = it % PER_J;
        const float* W; int ld, K, N, mode = 0, roff = 0; bf16_t* WT;
        if (r < NI_UV) { W = FIN(I_WINE) + (size_t)j * D * 1536 + 512; ld = 1536; K = D; N = 1024; WT = WinE + (size_t)j * NEIN * D; roff = 1024; }
        else if ((r -= NI_UV) < NI_SQ) { W = FIN(I_WOUTE) + (size_t)j * D * D; ld = D; K = D; N = D; WT = (bf16_t*)(ws + WS_WOUTE) + (size_t)j * D * D; }
        else if ((r -= NI_SQ) < NI_INO) { W = FIN(I_WINO) + (size_t)j * D * NREC; ld = NREC; K = D; N = NREC; WT = (bf16_t*)(ws + WS_WINO) + (size_t)j * NREC * D; }
        else if ((r -= NI_INO) < NI_SQ) { W = FIN(I_WOUTO) + (size_t)j * D * D; ld = D; K = D; N = D; WT = (bf16_t*)(ws + WS_WOUTO) + (size_t)j * D * D; }
        else if ((r -= NI_SQ) < NI_F13) { W = FIN(I_F1) + (size_t)j * D * DFF; ld = DFF; K = D; N = DFF; WT = (bf16_t*)(ws + WS_W13) + (size_t)j * NFF2 * D; mode = 1; }
        else if ((r -= NI_F13) < NI_F13) { W = FIN(I_F3) + (size_t)j * D * DFF; ld = DFF; K = D; N = DFF; WT = (bf16_t*)(ws + WS_W13) + (size_t)j * NFF2 * D; mode = 1; roff = 128; }
        else { r -= NI_F13; W = FIN(I_F2) + (size_t)j * DFF * D; ld = D; K = DFF; N = D; WT = (bf16_t*)(ws + WS_W2) + (size_t)j * D * DFF; }
        transpose_item(W, ld, K, N, WT, mode, roff, r, lane);
    }
}
constexpr int MOE_CONV_ITEMS = NE * (2 * 16 * 56 + 56 * 16);
__device__ __forceinline__ void moe_convert_item(const Ctx& F, int j, int it) {
    constexpr int I_13 = 16 * 56, I_2 = 56 * 16, PER_E = 2 * I_13 + I_2;
    const int e = it / PER_E; int r = it % PER_E; const size_t eo = (size_t)(j * NE + e);
    const float* W; int ld, K, N, mode = 0, roff = 0; bf16_t* WT;
    if (r < I_13) { W = FIN(I_M1) + eo * D * DEX; ld = DEX; K = D; N = DEX; WT = (bf16_t*)(F.ws + WS_W13M) + (size_t)e * NEX2 * D; mode = 1; }
    else if ((r -= I_13) < I_13) { W = FIN(I_M3) + eo * D * DEX; ld = DEX; K = D; N = DEX; WT = (bf16_t*)(F.ws + WS_W13M) + (size_t)e * NEX2 * D; mode = 1; roff = 128; }
    else { r -= I_13; W = FIN(I_M2) + eo * DEX * D; ld = D; K = DEX; N = D; WT = (bf16_t*)(F.ws + WS_W2M) + (size_t)e * D * DEX; }
    transpose_item(W, ld, K, N, WT, mode, roff, r, F.lane);
}

struct RowPass {
    const float* sl; const float* sc;
    bf16_t* xb;
    const float* gain;
    const float* shift; const float* scale;
    bf16_t* H;
    int nrows;
    const bf16_t* YE; const float* topp; const float* gatef;
    const float* rw; int* tope; float* toppo; int* rank; int* cnt;
    float* fout;
    const float* part; int kpn; const float* pgate; const float* csrc32;
    const int* slotof; const float* partm;
};
struct RowPart { int WB, WC; };
__device__ __forceinline__ RowPart row_part(int NW, int nrows) { RowPart q; q.WC = nrows > ML ? NW / 32 : 0; q.WB = (NW - q.WC) / 2; return q; }
__device__ __forceinline__ void row_chunk(const RowPart& q, int gw, int& r0, int& r1) {
    if (gw < 2 * q.WB) { const int b = gw / q.WB, i = gw % q.WB; r0 = b * TL + (int)(((long)i * TL) / q.WB); r1 = b * TL + (int)(((long)(i + 1) * TL) / q.WB); }
    else { const int i = gw - 2 * q.WB; r0 = ML + (i * MC) / q.WC; r1 = ML + ((i + 1) * MC) / q.WC; }
}
__device__ __forceinline__ int row_chunk_of(const RowPart& q, int r) {
    if (r < ML) { const int b = r >> 14, lr = r & (TL - 1); return b * q.WB + (int)(((long)q.WB * (lr + 1) - 1) / TL); }
    return 2 * q.WB + ((r - ML + 1) * q.WC - 1) / MC;
}
__device__ __forceinline__ f32x4 bf4(u32x2 r) { return (f32x4){bflo(r.x), bfhi(r.x), bflo(r.y), bfhi(r.y)}; }
template <bool COMBINE, bool ROUTER, bool FINAL, bool SRCB>
__device__ __forceinline__ void row_pass(const Ctx& F, const RowPass& P) {
    const int lane = F.lane;
    f32x4 rwr[16][2];
    if (ROUTER) {
#pragma unroll
        for (int j = 0; j < 4; ++j)
#pragma unroll
            for (int i = 0; i < 4; ++i) { const int col = 4 * lane + 256 * j + i; rwr[4 * j + i][0] = *(const f32x4*)(P.rw + col * 8); rwr[4 * j + i][1] = *(const f32x4*)(P.rw + col * 8 + 4); } }
    f32x4 gn[4];
#pragma unroll
    for (int j = 0; j < 4; ++j) gn[j] = *(const f32x4*)(P.gain + 4 * lane + 256 * j);
    const RowPart rp = row_part(F.NGW, P.nrows);
    int r0, r1; row_chunk(rp, F.gw, r0, r1);
    {
        int rc0 = 0, rc1 = 0, rc2 = 0, rc3 = 0, rc4 = 0, rc5 = 0, rc6 = 0, rc7 = 0;
        const bool isc = r0 >= ML; const int ms = isc ? 2 : (r0 >= TL ? 1 : 0);
        const float* xs32 = SRCB ? nullptr : (isc ? P.sc + (size_t)(r0 - ML) * D : P.sl + (size_t)r0 * D);
        bf16_t* xb0 = P.xb + (size_t)r0 * D;
        if (SRCB && !COMBINE && !FINAL) { if (isc && P.part) {
            const float* c32 = P.csrc32 ? P.csrc32 + (size_t)(r0 - ML) * D : nullptr;
#pragma unroll 1
            for (int rr = 0; rr < r1 - r0; ++rr) {
#pragma unroll 2
                for (int j = 0; j < 4; ++j) { f32x4 a[4];
#pragma unroll
                    for (int kp = 0; kp < 4; ++kp) a[kp] = kp < P.kpn ? *(const f32x4*)(P.part + ((size_t)kp * MC + (size_t)(r0 - ML + rr)) * D + 4 * lane + 256 * j) : (f32x4){0.f, 0.f, 0.f, 0.f};
                    const f32x4 x0 = c32 ? *(const f32x4*)(c32 + (size_t)rr * D + 4 * lane + 256 * j) : bf4(*(const u32x2*)(xb0 + (size_t)rr * D + 4 * lane + 256 * j));
                    const f32x4 y = x0 + *(const f32x4*)(P.pgate + 2 * 6144 + 4 * lane + 256 * j) * ((a[0] + a[1]) + (a[2] + a[3]));
                    u32x2 w; w.x = pk2(y[0], y[1]); w.y = pk2(y[2], y[3]); *(u32x2*)(xb0 + (size_t)rr * D + 4 * lane + 256 * j) = w; } }
            asm volatile("s_waitcnt vmcnt(0)" ::: "memory"); } }
        f32x4 sh[4], scl[4], gf[4];
#pragma unroll
        for (int j = 0; j < 4; ++j) {
            if (!FINAL && !COMBINE && !ROUTER) { sh[j] = *(const f32x4*)(P.shift + ms * 6144 + 4 * lane + 256 * j); scl[j] = *(const f32x4*)(P.scale + ms * 6144 + 4 * lane + 256 * j) + 1.0f; }
            if (COMBINE) gf[j] = *(const f32x4*)(P.gatef + ms * 6144 + 4 * lane + 256 * j); }
        f32x4 v[4]; f32x4 v32n[4]; u32x2 vbn[4]; u32x2 ya[4], yb[4]; float p0 = 0.f, p1 = 0.f;
#pragma unroll
        for (int j = 0; j < 4; ++j) v[j] = SRCB ? bf4(*(const u32x2*)(xb0 + 4 * lane + 256 * j)) : *(const f32x4*)(xs32 + 4 * lane + 256 * j);
        if (COMBINE) { p0 = P.topp[2 * r0]; p1 = P.topp[2 * r0 + 1];
#pragma unroll
            for (int j = 0; j < 4; ++j) { ya[j] = *(const u32x2*)(P.YE + (size_t)(2 * r0) * D + 4 * lane + 256 * j); yb[j] = *(const u32x2*)(P.YE + (size_t)(2 * r0 + 1) * D + 4 * lane + 256 * j); } }
        for (int r = r0; r < r1; ++r) {
            const int rr = r - r0; const bool more = r + 1 < r1;
            u32x2 yan[4], ybn[4]; float p0n = 0.f, p1n = 0.f;
            if (more) {
#pragma unroll
                for (int j = 0; j < 4; ++j) { if (SRCB) vbn[j] = *(const u32x2*)(xb0 + (size_t)(rr + 1) * D + 4 * lane + 256 * j); else v32n[j] = *(const f32x4*)(xs32 + (size_t)(rr + 1) * D + 4 * lane + 256 * j); }
                if (COMBINE) { p0n = P.topp[2 * r + 2]; p1n = P.topp[2 * r + 3];
#pragma unroll
                    for (int j = 0; j < 4; ++j) { yan[j] = *(const u32x2*)(P.YE + (size_t)(2 * r + 2) * D + 4 * lane + 256 * j); ybn[j] = *(const u32x2*)(P.YE + (size_t)(2 * r + 3) * D + 4 * lane + 256 * j); } }
            }
            if (COMBINE) {
                const int sl0 = P.slotof[2 * r], sl1 = P.slotof[2 * r + 1];
#pragma unroll
                for (int j = 0; j < 4; ++j) { f32x4 y0 = bf4(ya[j]), y1 = bf4(yb[j]);
                    if (sl0 >= 65536) { y0 = (f32x4){0.f, 0.f, 0.f, 0.f}; for (int kp = 0; kp < 4; ++kp) y0 = y0 + *(const f32x4*)(P.partm + ((size_t)kp * 3072 + (size_t)(sl0 - 65536)) * D + 4 * lane + 256 * j); }
                    if (sl1 >= 65536) { y1 = (f32x4){0.f, 0.f, 0.f, 0.f}; for (int kp = 0; kp < 4; ++kp) y1 = y1 + *(const f32x4*)(P.partm + ((size_t)kp * 3072 + (size_t)(sl1 - 65536)) * D + 4 * lane + 256 * j); }
                    v[j] = v[j] + gf[j] * (y0 * p0 + y1 * p1);
                    if (!FINAL) { u32x2 w; w.x = pk2(v[j][0], v[j][1]); w.y = pk2(v[j][2], v[j][3]); *(u32x2*)(xb0 + (size_t)rr * D + 4 * lane + 256 * j) = w; } }
            }
            float ss = 0.f;
#pragma unroll
            for (int j = 0; j < 4; ++j) ss += (v[j][0] * v[j][0] + v[j][1] * v[j][1]) + (v[j][2] * v[j][2] + v[j][3] * v[j][3]);
            const float rstd = rsqrtf(wave_sum(ss, lane) * (1.0f / D) + EPS);
            if (FINAL) {
#pragma unroll
                for (int j = 0; j < 4; ++j) *(f32x4*)(P.fout + (size_t)r * D + 4 * lane + 256 * j) = v[j] * rstd * gn[j];
            } else {
                f32x4 h[4];
#pragma unroll
                for (int j = 0; j < 4; ++j) { if (COMBINE || ROUTER) { sh[j] = *(const f32x4*)(P.shift + ms * 6144 + 4 * lane + 256 * j); scl[j] = *(const f32x4*)(P.scale + ms * 6144 + 4 * lane + 256 * j) + 1.0f; }
                    h[j] = (v[j] * rstd * gn[j]) * scl[j] + sh[j];
                    u32x2 w; w.x = pk2(h[j][0], h[j][1]); w.y = pk2(h[j][2], h[j][3]);
                    *(u32x2*)(P.H + (size_t)r * D + 4 * lane + 256 * j) = w; }
                if (ROUTER) {
                    float lg[8] = {0.f, 0.f, 0.f, 0.f, 0.f, 0.f, 0.f, 0.f};
#pragma unroll
                    for (int j = 0; j < 4; ++j) {
#pragma unroll
                        for (int i = 0; i < 4; ++i) { const f32x4 w0 = rwr[4 * j + i][0], w1 = rwr[4 * j + i][1]; const float hv = h[j][i];
                            lg[0] += hv * w0[0]; lg[1] += hv * w0[1]; lg[2] += hv * w0[2]; lg[3] += hv * w0[3]; lg[4] += hv * w1[0]; lg[5] += hv * w1[1]; lg[6] += hv * w1[2]; lg[7] += hv * w1[3]; }
                        __builtin_amdgcn_sched_barrier(0); }
                    {
                        const bool b5 = (lane & 32) != 0, b4 = (lane & 16) != 0, b3 = (lane & 8) != 0;
                        float a4[4], a2[2];
#pragma unroll
                        for (int i = 0; i < 4; ++i) { const float snd = b5 ? lg[i] : lg[4 + i], kp_ = b5 ? lg[4 + i] : lg[i]; a4[i] = kp_ + shfl_x(snd, 32, lane); }
#pragma unroll
                        for (int i = 0; i < 2; ++i) { const float snd = b4 ? a4[i] : a4[2 + i], kp_ = b4 ? a4[2 + i] : a4[i]; a2[i] = kp_ + shfl_x(snd, 16, lane); }
                        float c1; { const float snd = b3 ? a2[0] : a2[1], kp_ = b3 ? a2[1] : a2[0]; c1 = kp_ + shfl_x(snd, 8, lane); }
                        c1 += shfl_x(c1, 4, lane); c1 += shfl_x(c1, 2, lane); c1 += shfl_x(c1, 1, lane);
#pragma unroll
                        for (int e = 0; e < 8; ++e) lg[e] = __builtin_bit_cast(float, __builtin_amdgcn_readlane(__builtin_bit_cast(int, c1), 8 * e));
                    }
                    int e0 = 0; float v0 = lg[0];
#pragma unroll
                    for (int e = 1; e < 8; ++e) if (lg[e] > v0) { v0 = lg[e]; e0 = e; }
                    int e1 = -1; float v1 = -3.0e38f;
#pragma unroll
                    for (int e = 0; e < 8; ++e) if (e != e0 && lg[e] > v1) { v1 = lg[e]; e1 = e; }
                    const float ex = expf(v1 - v0); const float q0 = 1.0f / (1.0f + ex), q1 = ex / (1.0f + ex);
                    const int rk0 = e0 == 0 ? rc0 : e0 == 1 ? rc1 : e0 == 2 ? rc2 : e0 == 3 ? rc3 : e0 == 4 ? rc4 : e0 == 5 ? rc5 : e0 == 6 ? rc6 : rc7;
                    const int rk1 = e1 == 0 ? rc0 : e1 == 1 ? rc1 : e1 == 2 ? rc2 : e1 == 3 ? rc3 : e1 == 4 ? rc4 : e1 == 5 ? rc5 : e1 == 6 ? rc6 : rc7;
                    rc0 += (e0 == 0) + (e1 == 0); rc1 += (e0 == 1) + (e1 == 1); rc2 += (e0 == 2) + (e1 == 2); rc3 += (e0 == 3) + (e1 == 3);
                    rc4 += (e0 == 4) + (e1 == 4); rc5 += (e0 == 5) + (e1 == 5); rc6 += (e0 == 6) + (e1 == 6); rc7 += (e0 == 7) + (e1 == 7);
                    if (lane == 0) { P.tope[2 * r] = e0; P.tope[2 * r + 1] = e1; P.toppo[2 * r] = q0; P.toppo[2 * r + 1] = q1; P.rank[2 * r] = rk0; P.rank[2 * r + 1] = rk1; }
                }
            }
            if (more) {
#pragma unroll
                for (int j = 0; j < 4; ++j) { v[j] = SRCB ? bf4(vbn[j]) : v32n[j]; if (COMBINE) { ya[j] = yan[j]; yb[j] = ybn[j]; } }
                if (COMBINE) { p0 = p0n; p1 = p1n; }
            }
        }
        if (ROUTER && lane == 0) { int* c = P.cnt + F.gw * 8; c[0] = rc0; c[1] = rc1; c[2] = rc2; c[3] = rc3; c[4] = rc4; c[5] = rc5; c[6] = rc6; c[7] = rc7; }
    }
}

template <bool COMBINE, bool ROUTER, bool FINAL, int RB>
__device__ __forceinline__ void row_pass_b(const Ctx& F, const RowPass& P) {
    const int lane = F.lane;
    f32x4 rwr[16][2];
    if (ROUTER) {
#pragma unroll
        for (int j = 0; j < 4; ++j)
#pragma unroll
            for (int i = 0; i < 4; ++i) { const int col = 4 * lane + 256 * j + i; rwr[4 * j + i][0] = *(const f32x4*)(P.rw + col * 8); rwr[4 * j + i][1] = *(const f32x4*)(P.rw + col * 8 + 4); } }
    f32x4 gn[4];
    if (!ROUTER) {
#pragma unroll
        for (int j = 0; j < 4; ++j) gn[j] = *(const f32x4*)(P.gain + 4 * lane + 256 * j); }
    const RowPart rp = row_part(F.NGW, P.nrows);
    int r0, r1; row_chunk(rp, F.gw, r0, r1);
    int rc0 = 0, rc1 = 0, rc2 = 0, rc3 = 0, rc4 = 0, rc5 = 0, rc6 = 0, rc7 = 0;
    const bool isc = r0 >= ML; const int ms = isc ? 2 : (r0 >= TL ? 1 : 0);
    bf16_t* xb0 = P.xb + (size_t)r0 * D;
    if (!COMBINE && !FINAL) { if (isc && P.part) {
        const float* c32 = P.csrc32 ? P.csrc32 + (size_t)(r0 - ML) * D : nullptr;
#pragma unroll 1
        for (int rr = 0; rr < r1 - r0; ++rr) {
#pragma unroll 2
            for (int j = 0; j < 4; ++j) { f32x4 a[4];
#pragma unroll
                for (int kp = 0; kp < 4; ++kp) a[kp] = kp < P.kpn ? *(const f32x4*)(P.part + ((size_t)kp * MC + (size_t)(r0 - ML + rr)) * D + 4 * lane + 256 * j) : (f32x4){0.f, 0.f, 0.f, 0.f};
                const f32x4 x0 = c32 ? *(const f32x4*)(c32 + (size_t)rr * D + 4 * lane + 256 * j) : bf4(*(const u32x2*)(xb0 + (size_t)rr * D + 4 * lane + 256 * j));
                const f32x4 y = x0 + *(const f32x4*)(P.pgate + 2 * 6144 + 4 * lane + 256 * j) * ((a[0] + a[1]) + (a[2] + a[3]));
                u32x2 w; w.x = pk2(y[0], y[1]); w.y = pk2(y[2], y[3]); *(u32x2*)(xb0 + (size_t)rr * D + 4 * lane + 256 * j) = w; } }
        asm volatile("s_waitcnt vmcnt(0)" ::: "memory"); } }
    f32x4 sh[4], scl[4], gf[4];
#pragma unroll
    for (int j = 0; j < 4; ++j) {
        if (!FINAL && !ROUTER) { sh[j] = *(const f32x4*)(P.shift + ms * 6144 + 4 * lane + 256 * j); scl[j] = *(const f32x4*)(P.scale + ms * 6144 + 4 * lane + 256 * j) + 1.0f; }
        if (COMBINE) gf[j] = *(const f32x4*)(P.gatef + ms * 6144 + 4 * lane + 256 * j); }
    const int nr = r1 - r0;
    u32x2 cur[RB][4], nxt[RB][4], ya[RB][4], yb[RB][4], yan[RB][4], ybn[RB][4];
#define RPB_LOAD(X, YA, YB, base_) do { _Pragma("unroll") for (int k = 0; k < RB; ++k) { const int rk_ = ((base_) + k < nr) ? (base_) + k : nr - 1; \
        int sa_ = 0, sb_ = 0; if (COMBINE) { sa_ = P.slotof[2 * (r0 + rk_)]; sb_ = P.slotof[2 * (r0 + rk_) + 1]; sa_ = sa_ < 65536 ? sa_ : 65535; sb_ = sb_ < 65536 ? sb_ : 65535; }     \
        _Pragma("unroll") for (int j = 0; j < 4; ++j) { X[k][j] = *(const u32x2*)(xb0 + (size_t)rk_ * D + 4 * lane + 256 * j); \
            if (COMBINE) { YA[k][j] = *(const u32x2*)(P.YE + (size_t)sa_ * D + 4 * lane + 256 * j); YB[k][j] = *(const u32x2*)(P.YE + (size_t)sb_ * D + 4 * lane + 256 * j); } } } } while (0)
    const int ng = (nr + RB - 1) / RB; int gi = F.gw % ng;
    RPB_LOAD(cur, ya, yb, gi * RB);
    for (int it = 0; it < ng; ++it) {
        const int rb = gi * RB; gi = gi + 1 == ng ? 0 : gi + 1;
        if (it + 1 < ng) RPB_LOAD(nxt, yan, ybn, gi * RB);
        f32x4 v[RB][4]; float ss[RB];
#pragma unroll
        for (int k = 0; k < RB; ++k) {
            const int rk = (rb + k < nr) ? rb + k : nr - 1; const int r = r0 + rk;
#pragma unroll
            for (int j = 0; j < 4; ++j) v[k][j] = bf4(cur[k][j]);
            if (COMBINE) {
                const float p0 = P.topp[2 * r], p1 = P.topp[2 * r + 1]; const int sl0 = P.slotof[2 * r], sl1 = P.slotof[2 * r + 1];
#pragma unroll
                for (int j = 0; j < 4; ++j) { f32x4 y0 = bf4(ya[k][j]), y1 = bf4(yb[k][j]);
                    if (sl0 >= 65536) { y0 = (f32x4){0.f, 0.f, 0.f, 0.f}; for (int kp = 0; kp < 4; ++kp) y0 = y0 + *(const f32x4*)(P.partm + ((size_t)kp * 3072 + (size_t)(sl0 - 65536)) * D + 4 * lane + 256 * j); }
                    if (sl1 >= 65536) { y1 = (f32x4){0.f, 0.f, 0.f, 0.f}; for (int kp = 0; kp < 4; ++kp) y1 = y1 + *(const f32x4*)(P.partm + ((size_t)kp * 3072 + (size_t)(sl1 - 65536)) * D + 4 * lane + 256 * j); }
                    v[k][j] = v[k][j] + gf[j] * (y0 * p0 + y1 * p1);
                    if (!FINAL && rb + k < nr) { u32x2 w; w.x = pk2(v[k][j][0], v[k][j][1]); w.y = pk2(v[k][j][2], v[k][j][3]); *(u32x2*)(xb0 + (size_t)rk * D + 4 * lane + 256 * j) = w; } }
            }
            float s_ = 0.f;
#pragma unroll
            for (int j = 0; j < 4; ++j) s_ += (v[k][j][0] * v[k][j][0] + v[k][j][1] * v[k][j][1]) + (v[k][j][2] * v[k][j][2] + v[k][j][3] * v[k][j][3]);
            ss[k] = s_;
        }
#pragma unroll
        for (int o = 1; o < 64; o <<= 1)
#pragma unroll
            for (int k = 0; k < RB; ++k) ss[k] += shfl_x(ss[k], o, lane);
#pragma unroll
        for (int k = 0; k < RB; ++k) {
            if (rb + k < nr) {
                const int r = r0 + rb + k; const float rstd = rsqrtf(ss[k] * (1.0f / D) + EPS);
                if (FINAL) {
#pragma unroll
                    for (int j = 0; j < 4; ++j) *(f32x4*)(P.fout + (size_t)r * D + 4 * lane + 256 * j) = v[k][j] * rstd * gn[j];
                } else {
                    f32x4 h[4];
#pragma unroll
                    for (int j = 0; j < 4; ++j) {
                        if (ROUTER) { const f32x4 g_ = *(const f32x4*)(P.gain + 4 * lane + 256 * j), s_ = *(const f32x4*)(P.scale + ms * 6144 + 4 * lane + 256 * j) + 1.0f, t_ = *(const f32x4*)(P.shift + ms * 6144 + 4 * lane + 256 * j);
                            h[j] = (bf4(cur[k][j]) * rstd * g_) * s_ + t_; }
                        else h[j] = (v[k][j] * rstd * gn[j]) * scl[j] + sh[j];
                        u32x2 w; w.x = pk2(h[j][0], h[j][1]); w.y = pk2(h[j][2], h[j][3]);
                        *(u32x2*)(P.H + (size_t)r * D + 4 * lane + 256 * j) = w; }
                    if (ROUTER) {
                        float lg[8] = {0.f, 0.f, 0.f, 0.f, 0.f, 0.f, 0.f, 0.f};
#pragma unroll
                        for (int j = 0; j < 4; ++j)
#pragma unroll
                            for (int i = 0; i < 4; ++i) { const f32x4 w0 = rwr[4 * j + i][0], w1 = rwr[4 * j + i][1]; const float hv = h[j][i];
                                lg[0] += hv * w0[0]; lg[1] += hv * w0[1]; lg[2] += hv * w0[2]; lg[3] += hv * w0[3]; lg[4] += hv * w1[0]; lg[5] += hv * w1[1]; lg[6] += hv * w1[2]; lg[7] += hv * w1[3]; }
                        {
                            const bool b5 = (lane & 32) != 0, b4 = (lane & 16) != 0, b3 = (lane & 8) != 0;
                            float a4[4], a2[2];
#pragma unroll
                            for (int i = 0; i < 4; ++i) { const float snd = b5 ? lg[i] : lg[4 + i], kp_ = b5 ? lg[4 + i] : lg[i]; a4[i] = kp_ + shfl_x(snd, 32, lane); }
#pragma unroll
                            for (int i = 0; i < 2; ++i) { const float snd = b4 ? a4[i] : a4[2 + i], kp_ = b4 ? a4[2 + i] : a4[i]; a2[i] = kp_ + shfl_x(snd, 16, lane); }
                            float c1; { const float snd = b3 ? a2[0] : a2[1], kp_ = b3 ? a2[1] : a2[0]; c1 = kp_ + shfl_x(snd, 8, lane); }
                            c1 += shfl_x(c1, 4, lane); c1 += shfl_x(c1, 2, lane); c1 += shfl_x(c1, 1, lane);
#pragma unroll
                            for (int e = 0; e < 8; ++e) lg[e] = __builtin_bit_cast(float, __builtin_amdgcn_readlane(__builtin_bit_cast(int, c1), 8 * e));
                        }
                        int e0 = 0; float v0 = lg[0];
#pragma unroll
                        for (int e = 1; e < 8; ++e) if (lg[e] > v0) { v0 = lg[e]; e0 = e; }
                        int e1 = -1; float v1 = -3.0e38f;
#pragma unroll
                        for (int e = 0; e < 8; ++e) if (e != e0 && lg[e] > v1) { v1 = lg[e]; e1 = e; }
                        const float ex = expf(v1 - v0); const float q0 = 1.0f / (1.0f + ex), q1 = ex / (1.0f + ex);
                        const int rk0 = e0 == 0 ? rc0 : e0 == 1 ? rc1 : e0 == 2 ? rc2 : e0 == 3 ? rc3 : e0 == 4 ? rc4 : e0 == 5 ? rc5 : e0 == 6 ? rc6 : rc7;
                        const int rk1 = e1 == 0 ? rc0 : e1 == 1 ? rc1 : e1 == 2 ? rc2 : e1 == 3 ? rc3 : e1 == 4 ? rc4 : e1 == 5 ? rc5 : e1 == 6 ? rc6 : rc7;
                        rc0 += (e0 == 0) + (e1 == 0); rc1 += (e0 == 1) + (e1 == 1); rc2 += (e0 == 2) + (e1 == 2); rc3 += (e0 == 3) + (e1 == 3);
                        rc4 += (e0 == 4) + (e1 == 4); rc5 += (e0 == 5) + (e1 == 5); rc6 += (e0 == 6) + (e1 == 6); rc7 += (e0 == 7) + (e1 == 7);
                        if (lane == 0) { P.tope[2 * r] = e0; P.tope[2 * r + 1] = e1; P.toppo[2 * r] = q0; P.toppo[2 * r + 1] = q1; P.rank[2 * r] = rk0; P.rank[2 * r + 1] = rk1; }
                    }
                }
            }
        }
        if (it + 1 < ng) {
#pragma unroll
            for (int k = 0; k < RB; ++k)
#pragma unroll
                for (int j = 0; j < 4; ++j) { cur[k][j] = nxt[k][j]; if (COMBINE) { ya[k][j] = yan[k][j]; yb[k][j] = ybn[k][j]; } }
        }
    }
#undef RPB_LOAD
    if (ROUTER && lane == 0) { int* c = P.cnt + F.gw * 8; c[0] = rc0; c[1] = rc1; c[2] = rc2; c[3] = rc3; c[4] = rc4; c[5] = rc5; c[6] = rc6; c[7] = rc7; }
}

template <int NB, int NKS>
__device__ __forceinline__ void lm_load_a(const bf16_t* A, int lda, const int (&i0)[NB], int kc0, bf16x8 (&ap)[NB][NKS], int lane) {
    const int i16 = lane & 15, q = lane >> 4;
#pragma unroll
    for (int b = 0; b < NB; ++b)
#pragma unroll
        for (int ks = 0; ks < NKS; ++ks) ap[b][ks] = *(const bf16x8*)(A + (size_t)(i0[b] + i16) * lda + kc0 + ks * 32 + 8 * q);
}
template <int NB, int NKS>
__device__ __forceinline__ void lm_core(const bf16x8 (&ap)[NB][NKS], LAS unsigned char* X, f32x4 (&acc)[NB][8], int lane) {
    const int i16 = lane & 15, q = lane >> 4;
    const int xoff = (8 * q + (i16 >> 2)) * XRS + 8 * (i16 & 3);
#pragma unroll
    for (int ks = 0; ks < NKS; ++ks) {
        s16x4 lo[8], hi[8];
#pragma unroll
        for (int nt = 0; nt < 8; ++nt) {
            lo[nt] = __builtin_amdgcn_ds_read_tr16_b64_v4i16((LAS s16x4*)(X + ks * 32 * XRS + xoff + nt * 32));
            hi[nt] = __builtin_amdgcn_ds_read_tr16_b64_v4i16((LAS s16x4*)(X + ks * 32 * XRS + xoff + nt * 32 + 4 * XRS)); }
        __builtin_amdgcn_sched_barrier(0);
#pragma unroll
        for (int nt = 0; nt < 8; ++nt) { const bf16x8 xf = __builtin_shufflevector(lo[nt], hi[nt], 0, 1, 2, 3, 4, 5, 6, 7);
#pragma unroll
            for (int b = 0; b < NB; ++b) acc[b][nt] = __builtin_amdgcn_mfma_f32_16x16x32_bf16(xf, ap[b][ks], acc[b][nt], 0, 0, 0); }
    }
}
template <int NB> __device__ __forceinline__ void zero_acc(f32x4 (&acc)[NB][8]) {
#pragma unroll
    for (int b = 0; b < NB; ++b)
#pragma unroll
        for (int nt = 0; nt < 8; ++nt) acc[b][nt] = (f32x4){0.f, 0.f, 0.f, 0.f};
}
__device__ __forceinline__ void stage_rows(const bf16_t* src, size_t sstride, int nrows, LAS unsigned char* X, int xr0, int tid) {
    for (int i = tid; i < nrows * 16; i += 512) { const int r = i >> 4, ch = i & 15; *(LAS u32x4*)(X + (xr0 + r) * XRS + ch * 16) = *(const u32x4*)(src + (size_t)r * sstride + ch * 8); }
}

__device__ __forceinline__ void fft_stage_a(const Ctx& F, unsigned* wq) {
    const bf16_t* PZ = (const bf16_t*)(F.ws + WS_PZUV); bf16_t* UP = (bf16_t*)(F.ws + WS_UP); bf16_t* Y = (bf16_t*)(F.ws + WS_H);
    const bf16_t* FA = (const bf16_t*)(F.ws + WS_FA); const bf16_t* FX = (const bf16_t*)(F.ws + WS_FX);
    LAS unsigned char* X = F.lds; const int lane = F.lane, w = F.wave, i16 = lane & 15, q = lane >> 4;
    volatile LAS unsigned* slot = (volatile LAS unsigned*)(F.lds + MISC_OFF + 64);
    bf16x8 apA[2][8]; { const int i0[2] = {16 * w, 128 + 16 * w}; lm_load_a<2, 8>(FA, 256, i0, 0, apA, lane); }
    for (int it0 = F.bid; it0 < 1024 + 16; ) {
        const int it = it0 < 16 ? 1024 + it0 : it0 - 16;
        if (it < 1024) {
            const int t2 = it & 127, g = (it >> 7) & 3, b = it >> 9;
            const bf16_t* src = PZ + ((size_t)b * TL + t2) * NEIN + g * 128;
            stage_rows(src, (size_t)128 * NEIN, 128, X, 0, F.tid);
            stage_rows(src + 512, (size_t)128 * NEIN, 128, X, 128, F.tid);
            __syncthreads();
            f32x4 acc[2][8]; zero_acc<2>(acc);
            lm_core<2, 8>(apA, X, acc, lane);
            const int k1 = 16 * w + i16; float sw, cw; sincosf(6.283185307179586f * (float)((k1 * t2) & 16383) / 16384.0f, &sw, &cw);
            bf16_t* orow = UP + ((size_t)((b * 4 + g) * 128 + k1) * 128 + t2) * 256;
#pragma unroll
            for (int nt = 0; nt < 8; ++nt) { const f32x4 ur = acc[0][nt], ui = acc[1][nt]; const int n = 16 * nt + 4 * q;
                u32x2 wr_, wi_; wr_.x = pk2(ur[0] * cw - ui[0] * sw, ur[1] * cw - ui[1] * sw); wr_.y = pk2(ur[2] * cw - ui[2] * sw, ur[3] * cw - ui[3] * sw);
                wi_.x = pk2(ur[0] * sw + ui[0] * cw, ur[1] * sw + ui[1] * cw); wi_.y = pk2(ur[2] * sw + ui[2] * cw, ur[3] * sw + ui[3] * cw);
                *(u32x2*)(orow + n) = wr_; *(u32x2*)(orow + 128 + n) = wi_; }
            __syncthreads();
        } else {
            const int ci = it - 1024, kh = ci & 1, g = (ci >> 1) & 3, b = ci >> 3;
            f32x4 acc[1][8]; zero_acc<1>(acc); const int i0[1] = {128 * kh + 16 * w};
            for (int c = 0; c < 2; ++c) {
                bf16x8 apx[1][8]; lm_load_a<1, 8>(FX, 512, i0, c * 256, apx, lane);
                stage_rows(PZ + ((size_t)ML + b * TCX) * NEIN + c * 512 + g * 128, NEIN, 256, X, 0, F.tid);
                __syncthreads();
                lm_core<1, 8>(apx, X, acc, lane);
                __syncthreads();
            }
            const int k = 128 * kh + 16 * w + i16; bf16_t* orow = Y + ((size_t)ML + b * TCX + k) * D + g * 128; const float nrm = 0.005524271728019903f;
#pragma unroll
            for (int nt = 0; nt < 8; ++nt) { const f32x4 a = acc[0][nt] * nrm; u32x2 o; o.x = pk2(a[0], a[1]); o.y = pk2(a[2], a[3]); *(u32x2*)(orow + 16 * nt + 4 * q) = o; }
        }
        WQ_NEXT(it0, wq, slot, F.G);
    }
}
__device__ __forceinline__ void fft_stage_c_gmlp(const Ctx& F, int j, unsigned* wq) {
    const bf16_t* PZ = (const bf16_t*)(F.ws + WS_PZUV); const bf16_t* UP = (const bf16_t*)(F.ws + WS_UP); bf16_t* Y = (bf16_t*)(F.ws + WS_H);
    const bf16_t* FC = (const bf16_t*)(F.ws + WS_FC); const bf16_t* GW = (const bf16_t*)(F.ws + WS_GW) + (size_t)j * 4 * 128 * 128;
    const float* gb = FIN(I_GB) + j * 512;
    LAS unsigned char* X = F.lds; const int lane = F.lane, w = F.wave, i16 = lane & 15, q = lane >> 4, tid = F.tid;
    volatile LAS unsigned* slot = (volatile LAS unsigned*)(F.lds + MISC_OFF + 64);
    bf16x8 apC[1][8]; { const int i0[1] = {16 * w}; lm_load_a<1, 8>(FC, 256, i0, 0, apC, lane); }
    for (int it = F.bid; it < 1024 + 1040; ) {
        if (it < 1024) {
            const int k1 = it & 127, g = (it >> 7) & 3, b = it >> 9;
            const bf16_t* src = UP + (size_t)((b * 4 + g) * 128 + k1) * 128 * 256;
            stage_rows(src, 256, 128, X, 0, tid);
            stage_rows(src + 128, 256, 128, X, 128, tid);
            __syncthreads();
            f32x4 acc[1][8]; zero_acc<1>(acc);
            lm_core<1, 8>(apC, X, acc, lane);
            const int k2 = 16 * w + i16; bf16_t* orow = Y + ((size_t)b * TL + k1 + 128 * k2) * D + g * 128; const float nrm = 0.0006905339660024878f;
#pragma unroll
            for (int nt = 0; nt < 8; ++nt) { const f32x4 a = acc[0][nt] * nrm; u32x2 o; o.x = pk2(a[0], a[1]); o.y = pk2(a[2], a[3]); *(u32x2*)(orow + 16 * nt + 4 * q) = o; }
            __syncthreads();
        } else {
            const int gi = it - 1024, h = gi & 3, ck = gi >> 2; const size_t r0 = (size_t)ck * 128;
            bf16x8 apg[1][4]; { const int i0[1] = {16 * w}; lm_load_a<1, 4>(GW + (size_t)h * 128 * 128, 128, i0, 0, apg, lane); }
            u32x4 raw4[4];
#pragma unroll
            for (int i4 = 0; i4 < 4; ++i4) { const int i = tid + 512 * i4, r = i >> 4, ch = i & 15; raw4[i4] = *(const u32x4*)(PZ + (r0 + r) * NEIN + 1536 + h * 128 + ch * 8); }
            __builtin_amdgcn_sched_barrier(0);
#pragma unroll
            for (int i4 = 0; i4 < 4; ++i4) { const int i = tid + 512 * i4, r = i >> 4, ch = i & 15; const u32x4 raw = raw4[i4];
                float x[8] = {bflo(raw.x), bfhi(raw.x), bflo(raw.y), bfhi(raw.y), bflo(raw.z), bfhi(raw.z), bflo(raw.w), bfhi(raw.w)};
                float s = 0.f;
#pragma unroll
                for (int e = 0; e < 8; ++e) s += x[e];
                s += shfl_x(s, 1, lane); s += shfl_x(s, 2, lane); s += shfl_x(s, 4, lane); s += shfl_x(s, 8, lane);
                const float mean = s * (1.0f / 128.0f); float qq = 0.f;
#pragma unroll
                for (int e = 0; e < 8; ++e) { x[e] -= mean; qq += x[e] * x[e]; }
                qq += shfl_x(qq, 1, lane); qq += shfl_x(qq, 2, lane); qq += shfl_x(qq, 4, lane); qq += shfl_x(qq, 8, lane);
                const float rs = rsqrtf(qq * (1.0f / 128.0f) + EPS);
                u32x4 o; o.x = pk2(x[0] * rs, x[1] * rs); o.y = pk2(x[2] * rs, x[3] * rs); o.z = pk2(x[4] * rs, x[5] * rs); o.w = pk2(x[6] * rs, x[7] * rs);
                *(LAS u32x4*)(X + r * XRS + ch * 16) = o; }
            const int t = 16 * w + i16; const float bias = gb[h * 128 + t];
            const bf16_t* urow = PZ + (r0 + t) * NEIN + 1024 + h * 128; bf16_t* orow = Y + (r0 + t) * D + 512 + h * 128;
            u32x2 uu8[8];
#pragma unroll
            for (int nt = 0; nt < 8; ++nt) uu8[nt] = *(const u32x2*)(urow + 16 * nt + 4 * q);
            __syncthreads();
            f32x4 acc[1][8]; zero_acc<1>(acc);
            lm_core<1, 4>(apg, X, acc, lane);
            __builtin_amdgcn_sched_barrier(0);
#pragma unroll
            for (int nt = 0; nt < 8; ++nt) { const int n = 16 * nt + 4 * q; const u32x2 uu = uu8[nt]; const f32x4 a = acc[0][nt];
                u32x2 o; o.x = pk2(bflo(uu.x) * (a[0] + bias), bfhi(uu.x) * (a[1] + bias)); o.y = pk2(bflo(uu.y) * (a[2] + bias), bfhi(uu.y) * (a[3] + bias)); *(u32x2*)(orow + n) = o; }
            __syncthreads();
        }
        WQ_NEXT(it, wq, slot, F.G);
    }
}

constexpr int S2_KT = 0, S2_QT = 36864, S2_V = 73728, S2_SC = 110592, S2_EB = 120832, S2_EBL = 122880, S2_RED = 124928, S2_END = 129024;
static_assert(S2_END <= MISC_OFF, "scan LDS");
constexpr int SCRS = 80;
template <bool NEEDQ>
__device__ __forceinline__ void half_prep(const Ctx& F, const bf16_t* P5, size_t hrow, bool rev, int h, int dir) {
    const int tid = F.tid, ck = F.wave >> 1, dk = ((F.wave & 1) << 6) + F.lane; LAS unsigned char* L = F.lds;
#pragma unroll
    for (int it = 0; it < 4; ++it) { const int idx = tid + 512 * it, p = idx >> 4, ch = idx & 15; const size_t r = hrow + (rev ? 127 - p : p); const bf16_t* rp = P5 + ((size_t)h * MT + r) * 640 + ch * 8;
        *(LAS u32x4*)(L + S2_KT + p * XRS + ch * 16) = *(const u32x4*)(rp + (2 + dir) * 128);
        if (NEEDQ) *(LAS u32x4*)(L + S2_QT + p * XRS + ch * 16) = *(const u32x4*)(rp);
        *(LAS u32x4*)(L + S2_V + p * XRS + ch * 16) = *(const u32x4*)(rp + 4 * 128); }
    __syncthreads();
    float b = 0.f; LAS unsigned char* kt = L + S2_KT + (32 * ck) * XRS + dk * 2; LAS unsigned char* qt = L + S2_QT + (32 * ck) * XRS + dk * 2;
    bf16_t lfr[32], qr[32];
#pragma unroll
    for (int i = 0; i < 32; ++i) { lfr[i] = *(const LAS bf16_t*)(kt + i * XRS); if (NEEDQ) qr[i] = *(const LAS bf16_t*)(qt + i * XRS); }
    __builtin_amdgcn_sched_barrier(0);
#pragma unroll
    for (int i = 0; i < 32; ++i) { const float lf = bf2f(lfr[i]); b += lf;
        const float kk = (1.0f - __expf(lf)) * __expf(fminf(-b, 80.0f));
        *(LAS bf16_t*)(kt + i * XRS) = (bf16_t)f2bf(kk);
        if (NEEDQ) *(LAS bf16_t*)(qt + i * XRS) = (bf16_t)f2bf(bf2f(qr[i]) * __expf(b)); }
    ((LAS float*)(L + S2_EB))[ck * 128 + dk] = __expf(b);
    ((LAS float*)(L + S2_EBL))[ck * 128 + dk] = b;
}
__device__ __forceinline__ void prep1_issue(const Ctx& F, const bf16_t* P5, size_t hrow, bool rev, int h, int dir, u32x4 (&pf)[8]) {
    const int tid = F.tid;
#pragma unroll
    for (int it = 0; it < 4; ++it) { const int idx = tid + 512 * it, p = idx >> 4, ch = idx & 15; const size_t r = hrow + (rev ? 127 - p : p); const bf16_t* rp = P5 + ((size_t)h * MT + r) * 640 + ch * 8;
        pf[2 * it] = *(const u32x4*)(rp + (2 + dir) * 128); pf[2 * it + 1] = *(const u32x4*)(rp + 4 * 128); }
}
__device__ __forceinline__ void prep1_commit(const Ctx& F, const u32x4 (&pf)[8]) {
    const int tid = F.tid, ck = F.wave >> 1, dk = ((F.wave & 1) << 6) + F.lane; LAS unsigned char* L = F.lds;
#pragma unroll
    for (int it = 0; it < 4; ++it) { const int idx = tid + 512 * it, p = idx >> 4, ch = idx & 15;
        *(LAS u32x4*)(L + S2_KT + p * XRS + ch * 16) = pf[2 * it]; *(LAS u32x4*)(L + S2_V + p * XRS + ch * 16) = pf[2 * it + 1]; }
    __syncthreads();
    float b = 0.f; LAS unsigned char* kt = L + S2_KT + (32 * ck) * XRS + dk * 2;
    bf16_t lfr[32];
#pragma unroll
    for (int i = 0; i < 32; ++i) lfr[i] = *(const LAS bf16_t*)(kt + i * XRS);
    __builtin_amdgcn_sched_barrier(0);
#pragma unroll
    for (int i = 0; i < 32; ++i) { const float lf = bf2f(lfr[i]); b += lf; *(LAS bf16_t*)(kt + i * XRS) = (bf16_t)f2bf((1.0f - __expf(lf)) * __expf(fminf(-b, 80.0f))); }
    ((LAS float*)(L + S2_EB))[ck * 128 + dk] = __expf(b);
    ((LAS float*)(L + S2_EBL))[ck * 128 + dk] = b;
}
__device__ __forceinline__ void state_update(const Ctx& F, f32x4 (&st)[8], int ck) {
    LAS unsigned char* L = F.lds; const int lane = F.lane, i16 = lane & 15, q = lane >> 4, w = F.wave;
    const int roff = (32 * ck + 8 * q + (i16 >> 2)) * XRS + 8 * (i16 & 3);
    s16x4 vlo = __builtin_amdgcn_ds_read_tr16_b64_v4i16((LAS s16x4*)(L + S2_V + roff + w * 32));
    s16x4 vhi = __builtin_amdgcn_ds_read_tr16_b64_v4i16((LAS s16x4*)(L + S2_V + roff + w * 32 + 4 * XRS));
    const bf16x8 vf = __builtin_shufflevector(vlo, vhi, 0, 1, 2, 3, 4, 5, 6, 7);
#pragma unroll
    for (int hb = 0; hb < 2; ++hb) {
        s16x4 klo[4], khi[4]; f32x4 eb[4];
#pragma unroll
        for (int k4 = 0; k4 < 4; ++k4) { const int kb = 4 * hb + k4;
            klo[k4] = __builtin_amdgcn_ds_read_tr16_b64_v4i16((LAS s16x4*)(L + S2_KT + roff + kb * 32));
            khi[k4] = __builtin_amdgcn_ds_read_tr16_b64_v4i16((LAS s16x4*)(L + S2_KT + roff + kb * 32 + 4 * XRS)); }
#pragma unroll
        for (int k4 = 0; k4 < 4; ++k4) eb[k4] = *(const LAS f32x4*)(L + S2_EB + (ck * 128 + 16 * (4 * hb + k4) + 4 * q) * 4);
        __builtin_amdgcn_sched_barrier(0);
#pragma unroll
        for (int k4 = 0; k4 < 4; ++k4) st[4 * hb + k4] = __builtin_amdgcn_mfma_f32_16x16x32_bf16(__builtin_shufflevector(klo[k4], khi[k4], 0, 1, 2, 3, 4, 5, 6, 7), vf, st[4 * hb + k4], 0, 0, 0);
#pragma unroll
        for (int k4 = 0; k4 < 4; ++k4) st[4 * hb + k4] = st[4 * hb + k4] * eb[k4];
        __builtin_amdgcn_sched_barrier(0);
    }
}
__device__ __forceinline__ void state_load(const float* src, f32x4 (&st)[8], int w, int lane) {
    const float* p0 = src + w * 2048 + lane; const float* p1 = p0 + 1024;
#pragma unroll
    for (int kb = 0; kb < 8; ++kb)
#pragma unroll
        for (int rg = 0; rg < 4; ++rg) st[kb][rg] = src ? (kb < 4 ? p0[(kb * 4 + rg) * 64] : p1[((kb - 4) * 4 + rg) * 64]) : 0.f;
}
__device__ __forceinline__ void state_store(float* dst, const f32x4 (&st)[8], int w, int lane) {
    float* p0 = dst + w * 2048 + lane; float* p1 = p0 + 1024;
#pragma unroll
    for (int kb = 0; kb < 8; ++kb)
#pragma unroll
        for (int rg = 0; rg < 4; ++rg) { if (kb < 4) p0[(kb * 4 + rg) * 64] = st[kb][rg]; else p1[((kb - 4) * 4 + rg) * 64] = st[kb][rg]; }
}
__device__ __forceinline__ void scan_pass1_item(const Ctx& F, const bf16_t* P5, int b, int h, int dir, int seg, float* SST, float* EG) {
    const int chain = (b * 8 + h) * 2 + dir; const size_t rowb = (size_t)b * TL + (size_t)seg * SEGL;
    f32x4 st[8]; state_load(nullptr, st, F.wave, F.lane);
    float gacc = 0.f;
    u32x4 pf[8];
    prep1_issue(F, P5, rowb + 128 * (dir ? 1 : 0), dir != 0, h, dir, pf);
    for (int hs = 0; hs < 2; ++hs) {
        prep1_commit(F, pf);
        __syncthreads();
        if (hs == 0) prep1_issue(F, P5, rowb + 128 * (dir ? 0 : 1), dir != 0, h, dir, pf);
        if (F.tid < 128) { const LAS float* ebl = (const LAS float*)(F.lds + S2_EBL); gacc += (ebl[F.tid] + ebl[128 + F.tid]) + (ebl[256 + F.tid] + ebl[384 + F.tid]); }
#pragma unroll 1
        for (int ck = 0; ck < 4; ++ck) { state_update(F, st, ck); __builtin_amdgcn_sched_barrier(0); }
        __syncthreads();
    }
    state_store(SST + ((size_t)chain * NSEG + seg) * 16384, st, F.wave, F.lane);
    if (F.tid < 128) EG[((size_t)chain * NSEG + seg) * 128 + F.tid] = __expf(gacc);
}
__device__ __forceinline__ void half_scores(const Ctx& F) {
    LAS unsigned char* L = F.lds; const int lane = F.lane, i16 = lane & 15, q = lane >> 4, w = F.wave, ck = w >> 1, u = w & 1;
#pragma unroll
    for (int tt = 0; tt < 2; ++tt) {
        const int ti = u == 0 ? tt : 1 - tt, si = u == 0 ? tt : tt;
        f32x4 sc = (f32x4){0.f, 0.f, 0.f, 0.f};
        if (si <= ti) {
#pragma unroll
            for (int ks = 0; ks < 4; ++ks) { const bf16x8 a = *(const LAS bf16x8*)(L + S2_QT + (32 * ck + 16 * ti + i16) * XRS + (32 * ks + 8 * q) * 2); const bf16x8 bb = *(const LAS bf16x8*)(L + S2_KT + (32 * ck + 16 * si + i16) * XRS + (32 * ks + 8 * q) * 2);
                sc = __builtin_amdgcn_mfma_f32_16x16x32_bf16(a, bb, sc, 0, 0, 0); }
        }
#pragma unroll
        for (int rg = 0; rg < 4; ++rg) { const int t = 16 * ti + 4 * q + rg, sidx = 16 * si + i16; *(LAS bf16_t*)(L + S2_SC + (32 * ck + t) * SCRS + sidx * 2) = (bf16_t)f2bf(sidx <= t ? sc[rg] : 0.f); }
    }
}
__device__ __forceinline__ void chunk_out(const Ctx& F, const f32x4 (&st)[8], int ck, f32x4 (&o)[2]) {
    LAS unsigned char* L = F.lds; const int lane = F.lane, i16 = lane & 15, q = lane >> 4, w = F.wave;
    const int roff = (32 * ck + 8 * q + (i16 >> 2)) * XRS + 8 * (i16 & 3);
    o[0] = (f32x4){0.f, 0.f, 0.f, 0.f}; o[1] = (f32x4){0.f, 0.f, 0.f, 0.f};
    s16x4 vlo = __builtin_amdgcn_ds_read_tr16_b64_v4i16((LAS s16x4*)(L + S2_V + roff + w * 32));
    s16x4 vhi = __builtin_amdgcn_ds_read_tr16_b64_v4i16((LAS s16x4*)(L + S2_V + roff + w * 32 + 4 * XRS));
    bf16x8 pf[2];
#pragma unroll
    for (int ti = 0; ti < 2; ++ti) pf[ti] = *(const LAS bf16x8*)(L + S2_SC + (32 * ck + 16 * ti + i16) * SCRS + (8 * q) * 2);
#pragma unroll
    for (int kh = 0; kh < 2; ++kh) {
        u32x2 qlo[2][2], qhi[2][2]; bf16x8 sf[2];
#pragma unroll
        for (int k2 = 0; k2 < 2; ++k2) { const int ks = 2 * kh + k2;
#pragma unroll
            for (int ti = 0; ti < 2; ++ti) { const LAS unsigned char* qrow = L + S2_QT + (32 * ck + 16 * ti + i16) * XRS + (32 * ks + 4 * q) * 2; qlo[k2][ti] = *(const LAS u32x2*)(qrow); qhi[k2][ti] = *(const LAS u32x2*)(qrow + 32); }
            u32x4 sp; sp.x = pk2(st[2 * ks][0], st[2 * ks][1]); sp.y = pk2(st[2 * ks][2], st[2 * ks][3]); sp.z = pk2(st[2 * ks + 1][0], st[2 * ks + 1][1]); sp.w = pk2(st[2 * ks + 1][2], st[2 * ks + 1][3]); sf[k2] = __builtin_bit_cast(bf16x8, sp); }
        __builtin_amdgcn_sched_barrier(0);
#pragma unroll
        for (int k2 = 0; k2 < 2; ++k2)
#pragma unroll
            for (int ti = 0; ti < 2; ++ti) { u32x4 qp; qp.x = qlo[k2][ti].x; qp.y = qlo[k2][ti].y; qp.z = qhi[k2][ti].x; qp.w = qhi[k2][ti].y;
                o[ti] = __builtin_amdgcn_mfma_f32_16x16x32_bf16(sf[k2], __builtin_bit_cast(bf16x8, qp), o[ti], 0, 0, 0); }
        __builtin_amdgcn_sched_barrier(0);
    }
    const bf16x8 vf = __builtin_shufflevector(vlo, vhi, 0, 1, 2, 3, 4, 5, 6, 7);
#pragma unroll
    for (int ti = 0; ti < 2; ++ti) o[ti] = __builtin_amdgcn_mfma_f32_16x16x32_bf16(vf, pf[ti], o[ti], 0, 0, 0);
}
__device__ __forceinline__ void rows_g2l(const bf16_t* g, size_t row0, int rstep, int c0, LAS unsigned char* T, int tid) {
#pragma unroll
    for (int it = 0; it < 4; ++it) { const int idx = tid + 512 * it, p = idx >> 4, ch = idx & 15; *(LAS u32x4*)(T + p * XRS + ch * 16) = *(const u32x4*)(g + (size_t)((long)row0 + (long)rstep * p) * D + c0 + ch * 8); }
}
__device__ __forceinline__ void rows_l2g(bf16_t* g, size_t row0, int rstep, int c0, const LAS unsigned char* T, int tid) {
#pragma unroll
    for (int it = 0; it < 4; ++it) { const int idx = tid + 512 * it, p = idx >> 4, ch = idx & 15; *(u32x4*)(g + (size_t)((long)row0 + (long)rstep * p) * D + c0 + ch * 8) = *(const LAS u32x4*)(T + p * XRS + ch * 16); }
}
__device__ __forceinline__ void scan_pass3_item(const Ctx& F, const bf16_t* P5, size_t rowb, int h, const float* sin_f, const float* sin_b, float* fin_f, float* fin_b, const float* gain, bf16_t* OFT, bf16_t* Y, bool writey) {
    LAS unsigned char* L = F.lds; int lane = F.lane; asm volatile("" : "+v"(lane));
    const int i16 = lane & 15, q = lane >> 4, w = F.wave;
    const int colo = h * 128 + 16 * w + 4 * q;
    f32x4 st[8];
    state_load(sin_f, st, w, lane);
    for (int hs = 0; hs < 2; ++hs) {
        const size_t hrow = rowb + 128 * hs;
        half_prep<true>(F, P5, hrow, false, h, 0);
        __syncthreads();
        half_scores(F);
        __syncthreads();
        u32x2 of[4][2];
#pragma unroll
        for (int ck = 0; ck < 4; ++ck) { f32x4 o[2]; chunk_out(F, st, ck, o);
#pragma unroll
            for (int ti = 0; ti < 2; ++ti) { of[ck][ti].x = pk2(o[ti][0], o[ti][1]); of[ck][ti].y = pk2(o[ti][2], o[ti][3]); }
            __builtin_amdgcn_sched_barrier(0);
            state_update(F, st, ck);
            __builtin_amdgcn_sched_barrier(0); }
        __syncthreads();
#pragma unroll
        for (int ck = 0; ck < 4; ++ck)
#pragma unroll
            for (int ti = 0; ti < 2; ++ti) *(LAS u32x2*)(L + S2_QT + (32 * ck + 16 * ti + i16) * XRS + (16 * w + 4 * q) * 2) = of[ck][ti];
        __syncthreads();
        rows_l2g(OFT, hrow, 1, h * 128, L + S2_QT, F.tid);
        __syncthreads();
    }
    if (fin_f) state_store(fin_f, st, w, lane);
    state_load(sin_b, st, w, lane);
    const f32x4 gv = *(const f32x4*)(gain + colo);
    for (int hs = 0; hs < 2; ++hs) {
        const size_t hrow = rowb + 128 * (1 - hs);
        half_prep<true>(F, P5, hrow, true, h, 1);
        __syncthreads();
        half_scores(F);
        __syncthreads();
        LAS float* RED = (LAS float*)(L + S2_RED);
        f32x4 oa[4][2];
#pragma unroll
        for (int ck = 0; ck < 4; ++ck) { chunk_out(F, st, ck, oa[ck]);
            __builtin_amdgcn_sched_barrier(0);
            state_update(F, st, ck);
            __builtin_amdgcn_sched_barrier(0); }
        __syncthreads();
        rows_g2l(OFT, hrow + 127, -1, h * 128, L + S2_QT, F.tid);
        if (writey) {
#pragma unroll
            for (int it = 0; it < 4; ++it) { const int idx = F.tid + 512 * it, p = idx >> 4, ch = idx & 15; *(LAS u32x4*)(L + S2_KT + p * XRS + ch * 16) = *(const u32x4*)(P5 + ((size_t)h * MT + (hrow + 127 - p)) * 640 + 128 + ch * 8); } }
        __syncthreads();
#pragma unroll
        for (int ck = 0; ck < 4; ++ck)
#pragma unroll
            for (int ti = 0; ti < 2; ++ti) { const int p = 32 * ck + 16 * ti + i16; const u32x2 f = *(const LAS u32x2*)(L + S2_QT + p * XRS + (16 * w + 4 * q) * 2);
                oa[ck][ti][0] += bflo(f.x); oa[ck][ti][1] += bfhi(f.x); oa[ck][ti][2] += bflo(f.y); oa[ck][ti][3] += bfhi(f.y);
                float ss = (oa[ck][ti][0] * oa[ck][ti][0] + oa[ck][ti][1] * oa[ck][ti][1]) + (oa[ck][ti][2] * oa[ck][ti][2] + oa[ck][ti][3] * oa[ck][ti][3]);
                ss += shfl_x(ss, 16, lane); ss += shfl_x(ss, 32, lane);
                if (q == 0) RED[w * 128 + p] = ss; __builtin_amdgcn_sched_barrier(0); }
        __syncthreads();
        if (writey) {
#pragma unroll
            for (int ck = 0; ck < 4; ++ck)
#pragma unroll
                for (int ti = 0; ti < 2; ++ti) { __builtin_amdgcn_sched_barrier(0); const int p = 32 * ck + 16 * ti + i16; float tot = 0.f;
#pragma unroll
                    for (int ww = 0; ww < 8; ++ww) tot += RED[ww * 128 + p];
                    const float rs = rsqrtf(tot * (1.0f / 128.0f) + EPS);
                    const u32x2 sg = *(const LAS u32x2*)(L + S2_KT + p * XRS + (16 * w + 4 * q) * 2);
                    u32x2 y; y.x = pk2(oa[ck][ti][0] * rs * gv[0] * bflo(sg.x), oa[ck][ti][1] * rs * gv[1] * bfhi(sg.x)); y.y = pk2(oa[ck][ti][2] * rs * gv[2] * bflo(sg.y), oa[ck][ti][3] * rs * gv[3] * bfhi(sg.y));
                    *(LAS u32x2*)(L + S2_V + p * XRS + (16 * w + 4 * q) * 2) = y; }
            __syncthreads();
            rows_l2g(Y, hrow + 127, -1, h * 128, L + S2_V, F.tid);
        }
        __syncthreads();
    }
    if (fin_b) state_store(fin_b, st, w, lane);
}
constexpr int G2_KT = 0, G2_QT = 18432, G2_V = 36864, G2_SC = 55296, G2_EB = 60416, G2_EBL = 61440, G2_RED = 62464, G2_SLOT = 63488, G2_BYTES = 65536;
static_assert(2 * G2_BYTES <= MISC_OFF, "two-group scan LDS");
struct GC { LAS unsigned char* L; int tid, lane, wg; LAS unsigned* bar; unsigned epoch; };
__device__ __forceinline__ void gsync(GC& G) {
    asm volatile("s_waitcnt vmcnt(0) lgkmcnt(0)" ::: "memory");
    G.epoch += 4u;
    if (G.lane == 0) (void)__hip_atomic_fetch_add(G.bar, 1u, __ATOMIC_RELAXED, __HIP_MEMORY_SCOPE_WORKGROUP);
    while (__hip_atomic_load(G.bar, __ATOMIC_RELAXED, __HIP_MEMORY_SCOPE_WORKGROUP) < G.epoch) __builtin_amdgcn_s_sleep(0);
    asm volatile("" ::: "memory");
}
__device__ __forceinline__ void gsync_l(GC& G) {
    asm volatile("s_waitcnt lgkmcnt(0)" ::: "memory");
    G.epoch += 4u;
    if (G.lane == 0) (void)__hip_atomic_fetch_add(G.bar, 1u, __ATOMIC_RELAXED, __HIP_MEMORY_SCOPE_WORKGROUP);
    while (__hip_atomic_load(G.bar, __ATOMIC_RELAXED, __HIP_MEMORY_SCOPE_WORKGROUP) < G.epoch) __builtin_amdgcn_s_sleep(0);
    asm volatile("" ::: "memory");
}
__device__ __forceinline__ void quarter_load1(const GC& G, const bf16_t* P5, size_t hrow, bool rev, int h, int dir, u32x4 (&rk)[4], u32x4 (&rv)[4]) {
#pragma unroll
    for (int it = 0; it < 4; ++it) { const int idx = G.tid + 256 * it, p = idx >> 4, ch = idx & 15; const size_t r = hrow + (rev ? 63 - p : p); const bf16_t* rp = P5 + ((size_t)h * MT + r) * 640 + ch * 8;
        rk[it] = *(const u32x4*)(rp + (2 + dir) * 128); rv[it] = *(const u32x4*)(rp + 4 * 128); }
}
__device__ __forceinline__ void quarter_prep1(GC& G, const u32x4 (&rk)[4], const u32x4 (&rv)[4]) {
    const int tid = G.tid, ck = G.wg >> 1, dk = ((G.wg & 1) << 6) + G.lane; LAS unsigned char* L = G.L;
#pragma unroll
    for (int it = 0; it < 4; ++it) { const int idx = tid + 256 * it, p = idx >> 4, ch = idx & 15;
        *(LAS u32x4*)(L + G2_KT + p * XRS + ch * 16) = rk[it]; *(LAS u32x4*)(L + G2_V + p * XRS + ch * 16) = rv[it]; }
}
__device__ __forceinline__ void quarter_cols1(GC& G) {
    const int ck = G.wg >> 1, dk = ((G.wg & 1) << 6) + G.lane; LAS unsigned char* L = G.L;
    float b = 0.f; LAS unsigned char* kt = L + G2_KT + (32 * ck) * XRS + dk * 2;
    bf16_t lfr[32];
#pragma unroll
    for (int i = 0; i < 32; ++i) lfr[i] = *(const LAS bf16_t*)(kt + i * XRS);
    __builtin_amdgcn_sched_barrier(0);
#pragma unroll
    for (int i = 0; i < 32; ++i) { const float lf = bf2f(lfr[i]); b += lf;
        *(LAS bf16_t*)(kt + i * XRS) = (bf16_t)f2bf((1.0f - __expf(lf)) * __expf(fminf(-b, 80.0f))); }
    ((LAS float*)(L + G2_EB))[ck * 128 + dk] = __expf(b);
    ((LAS float*)(L + G2_EBL))[ck * 128 + dk] = b;
}
template <bool NEEDQ>
__device__ __forceinline__ void quarter_prep(GC& G, const bf16_t* P5, size_t hrow, bool rev, int h, int dir) {
    const int tid = G.tid, ck = G.wg >> 1, dk = ((G.wg & 1) << 6) + G.lane; LAS unsigned char* L = G.L;
    {
        u32x4 rk_[4], rq_[4], rv_[4];
#pragma unroll
        for (int it = 0; it < 4; ++it) { const int idx = tid + 256 * it, p = idx >> 4, ch = idx & 15; const size_t r = hrow + (rev ? 63 - p : p); const bf16_t* rp = P5 + ((size_t)h * MT + r) * 640 + ch * 8;
            rk_[it] = *(const u32x4*)(rp + (2 + dir) * 128); if (NEEDQ) rq_[it] = *(const u32x4*)(rp); rv_[it] = *(const u32x4*)(rp + 4 * 128); }
        __builtin_amdgcn_sched_barrier(0);
#pragma unroll
        for (int it = 0; it < 4; ++it) { const int idx = tid + 256 * it, p = idx >> 4, ch = idx & 15;
            *(LAS u32x4*)(L + G2_KT + p * XRS + ch * 16) = rk_[it]; if (NEEDQ) *(LAS u32x4*)(L + G2_QT + p * XRS + ch * 16) = rq_[it]; *(LAS u32x4*)(L + G2_V + p * XRS + ch * 16) = rv_[it]; }
    }
    gsync(G);
    float b = 0.f; LAS unsigned char* kt = L + G2_KT + (32 * ck) * XRS + dk * 2; LAS unsigned char* qt = L + G2_QT + (32 * ck) * XRS + dk * 2;
    bf16_t lfr[32], qr[32];
#pragma unroll
    for (int i = 0; i < 32; ++i) { lfr[i] = *(const LAS bf16_t*)(kt + i * XRS); if (NEEDQ) qr[i] = *(const LAS bf16_t*)(qt + i * XRS); }
    __builtin_amdgcn_sched_barrier(0);
#pragma unroll
    for (int i = 0; i < 32; ++i) { const float lf = bf2f(lfr[i]); b += lf;
        *(LAS bf16_t*)(kt + i * XRS) = (bf16_t)f2bf((1.0f - __expf(lf)) * __expf(fminf(-b, 80.0f)));
        if (NEEDQ) *(LAS bf16_t*)(qt + i * XRS) = (bf16_t)f2bf(bf2f(qr[i]) * __expf(b)); }
    ((LAS float*)(L + G2_EB))[ck * 128 + dk] = __expf(b);
    ((LAS float*)(L + G2_EBL))[ck * 128 + dk] = b;
}
__device__ __forceinline__ void state_update_g(const GC& G, f32x4 (&st)[2][8], int ck) {
    LAS unsigned char* L = G.L; const int lane = G.lane, i16 = lane & 15, q = lane >> 4, wg = G.wg;
    const int roff = (32 * ck + 8 * q + (i16 >> 2)) * XRS + 8 * (i16 & 3);
    bf16x8 vf[2];
#pragma unroll
    for (int ct = 0; ct < 2; ++ct) { const s16x4 vlo = __builtin_amdgcn_ds_read_tr16_b64_v4i16((LAS s16x4*)(L + G2_V + roff + (2 * wg + ct) * 32));
        const s16x4 vhi = __builtin_amdgcn_ds_read_tr16_b64_v4i16((LAS s16x4*)(L + G2_V + roff + (2 * wg + ct) * 32 + 4 * XRS)); vf[ct] = __builtin_shufflevector(vlo, vhi, 0, 1, 2, 3, 4, 5, 6, 7); }
#pragma unroll
    for (int hb = 0; hb < 2; ++hb) {
        s16x4 klo[4], khi[4]; f32x4 eb[4];
#pragma unroll
        for (int k4 = 0; k4 < 4; ++k4) { const int kb = 4 * hb + k4;
            klo[k4] = __builtin_amdgcn_ds_read_tr16_b64_v4i16((LAS s16x4*)(L + G2_KT + roff + kb * 32));
            khi[k4] = __builtin_amdgcn_ds_read_tr16_b64_v4i16((LAS s16x4*)(L + G2_KT + roff + kb * 32 + 4 * XRS)); }
#pragma unroll
        for (int k4 = 0; k4 < 4; ++k4) eb[k4] = *(const LAS f32x4*)(L + G2_EB + (ck * 128 + 16 * (4 * hb + k4) + 4 * q) * 4);
        __builtin_amdgcn_sched_barrier(0);
#pragma unroll
        for (int k4 = 0; k4 < 4; ++k4) { const bf16x8 kf = __builtin_shufflevector(klo[k4], khi[k4], 0, 1, 2, 3, 4, 5, 6, 7);
#pragma unroll
            for (int ct = 0; ct < 2; ++ct) st[ct][4 * hb + k4] = __builtin_amdgcn_mfma_f32_16x16x32_bf16(kf, vf[ct], st[ct][4 * hb + k4], 0, 0, 0); }
#pragma unroll
        for (int k4 = 0; k4 < 4; ++k4)
#pragma unroll
            for (int ct = 0; ct < 2; ++ct) st[ct][4 * hb + k4] = st[ct][4 * hb + k4] * eb[k4];
        __builtin_amdgcn_sched_barrier(0);
    }
}
__device__ __forceinline__ void state_load_g(const float* src, f32x4 (&st)[2][8], int wg, int lane) {
#pragma unroll
    for (int ct = 0; ct < 2; ++ct) { const float* p0 = src + (2 * wg + ct) * 2048 + lane; const float* p1 = p0 + 1024;
#pragma unroll
        for (int kb = 0; kb < 8; ++kb)
#pragma unroll
            for (int rg = 0; rg < 4; ++rg) st[ct][kb][rg] = src ? (kb < 4 ? p0[(kb * 4 + rg) * 64] : p1[((kb - 4) * 4 + rg) * 64]) : 0.f; }
}
__device__ __forceinline__ void state_store_g(float* dst, const f32x4 (&st)[2][8], int wg, int lane) {
#pragma unroll
    for (int ct = 0; ct < 2; ++ct) { float* p0 = dst + (2 * wg + ct) * 2048 + lane; float* p1 = p0 + 1024;
#pragma unroll
        for (int kb = 0; kb < 8; ++kb)
#pragma unroll
            for (int rg = 0; rg < 4; ++rg) { if (kb < 4) p0[(kb * 4 + rg) * 64] = st[ct][kb][rg]; else p1[((kb - 4) * 4 + rg) * 64] = st[ct][kb][rg]; } }
}
__device__ __forceinline__ void quarter_scores(const GC& G) {
    LAS unsigned char* L = G.L; const int lane = G.lane, i16 = lane & 15, q = lane >> 4, ck = G.wg >> 1, u = G.wg & 1;
#pragma unroll
    for (int tt = 0; tt < 2; ++tt) {
        const int ti = u == 0 ? tt : 1 - tt, si = tt;
        f32x4 sc = (f32x4){0.f, 0.f, 0.f, 0.f};
        if (si <= ti) {
#pragma unroll
            for (int ks = 0; ks < 4; ++ks) { const bf16x8 a = *(const LAS bf16x8*)(L + G2_QT + (32 * ck + 16 * ti + i16) * XRS + (32 * ks + 8 * q) * 2); const bf16x8 bb = *(const LAS bf16x8*)(L + G2_KT + (32 * ck + 16 * si + i16) * XRS + (32 * ks + 8 * q) * 2);
                sc = __builtin_amdgcn_mfma_f32_16x16x32_bf16(a, bb, sc, 0, 0, 0); }
        }
#pragma unroll
        for (int rg = 0; rg < 4; ++rg) { const int t = 16 * ti + 4 * q + rg, sidx = 16 * si + i16; *(LAS bf16_t*)(L + G2_SC + (32 * ck + t) * SCRS + sidx * 2) = (bf16_t)f2bf(sidx <= t ? sc[rg] : 0.f); }
    }
}
__device__ __forceinline__ void chunk_out_g(const GC& G, const f32x4 (&st)[2][8], int ck, f32x4 (&o)[2][2]) {
    LAS unsigned char* L = G.L; const int lane = G.lane, i16 = lane & 15, q = lane >> 4, wg = G.wg;
    const int roff = (32 * ck + 8 * q + (i16 >> 2)) * XRS + 8 * (i16 & 3);
#pragma unroll
    for (int ct = 0; ct < 2; ++ct) { o[ct][0] = (f32x4){0.f, 0.f, 0.f, 0.f}; o[ct][1] = (f32x4){0.f, 0.f, 0.f, 0.f}; }
    bf16x8 vf[2], pf[2];
#pragma unroll
    for (int ct = 0; ct < 2; ++ct) { const s16x4 vlo = __builtin_amdgcn_ds_read_tr16_b64_v4i16((LAS s16x4*)(L + G2_V + roff + (2 * wg + ct) * 32));
        const s16x4 vhi = __builtin_amdgcn_ds_read_tr16_b64_v4i16((LAS s16x4*)(L + G2_V + roff + (2 * wg + ct) * 32 + 4 * XRS)); vf[ct] = __builtin_shufflevector(vlo, vhi, 0, 1, 2, 3, 4, 5, 6, 7); }
#pragma unroll
    for (int ti = 0; ti < 2; ++ti) pf[ti] = *(const LAS bf16x8*)(L + G2_SC + (32 * ck + 16 * ti + i16) * SCRS + (8 * q) * 2);
#pragma unroll
    for (int kh = 0; kh < 2; ++kh) {
        u32x2 qlo[2][2], qhi[2][2]; bf16x8 sf[2][2];
#pragma unroll
        for (int k2 = 0; k2 < 2; ++k2) { const int ks = 2 * kh + k2;
#pragma unroll
            for (int ti = 0; ti < 2; ++ti) { const LAS unsigned char* qrow = L + G2_QT + (32 * ck + 16 * ti + i16) * XRS + (32 * ks + 4 * q) * 2; qlo[k2][ti] = *(const LAS u32x2*)(qrow); qhi[k2][ti] = *(const LAS u32x2*)(qrow + 32); }
#pragma unroll
            for (int ct = 0; ct < 2; ++ct) { u32x4 sp; sp.x = pk2(st[ct][2 * ks][0], st[ct][2 * ks][1]); sp.y = pk2(st[ct][2 * ks][2], st[ct][2 * ks][3]); sp.z = pk2(st[ct][2 * ks + 1][0], st[ct][2 * ks + 1][1]); sp.w = pk2(st[ct][2 * ks + 1][2], st[ct][2 * ks + 1][3]); sf[k2][ct] = __builtin_bit_cast(bf16x8, sp); } }
        __builtin_amdgcn_sched_barrier(0);
#pragma unroll
        for (int k2 = 0; k2 < 2; ++k2)
#pragma unroll
            for (int ti = 0; ti < 2; ++ti) { u32x4 qp; qp.x = qlo[k2][ti].x; qp.y = qlo[k2][ti].y; qp.z = qhi[k2][ti].x; qp.w = qhi[k2][ti].y;
#pragma unroll
                for (int ct = 0; ct < 2; ++ct) o[ct][ti] = __builtin_amdgcn_mfma_f32_16x16x32_bf16(sf[k2][ct], __builtin_bit_cast(bf16x8, qp), o[ct][ti], 0, 0, 0); }
        __builtin_amdgcn_sched_barrier(0);
    }
#pragma unroll
    for (int ct = 0; ct < 2; ++ct)
#pragma unroll
        for (int ti = 0; ti < 2; ++ti) o[ct][ti] = __builtin_amdgcn_mfma_f32_16x16x32_bf16(vf[ct], pf[ti], o[ct][ti], 0, 0, 0);
}
__device__ __forceinline__ void rows_g2l_g(const bf16_t* g, size_t row0, int rstep, int c0, LAS unsigned char* T, int tid) {
    u32x4 r_[4];
#pragma unroll
    for (int it = 0; it < 4; ++it) { const int idx = tid + 256 * it, p = idx >> 4, ch = idx & 15; r_[it] = *(const u32x4*)(g + (size_t)((long)row0 + (long)rstep * p) * D + c0 + ch * 8); }
    __builtin_amdgcn_sched_barrier(0);
#pragma unroll
    for (int it = 0; it < 4; ++it) { const int idx = tid + 256 * it, p = idx >> 4, ch = idx & 15; *(LAS u32x4*)(T + p * XRS + ch * 16) = r_[it]; }
}
__device__ __forceinline__ void rows_l2g_g(bf16_t* g, size_t row0, int rstep, int c0, const LAS unsigned char* T, int tid) {
#pragma unroll
    for (int it = 0; it < 4; ++it) { const int idx = tid + 256 * it, p = idx >> 4, ch = idx & 15; *(u32x4*)(g + (size_t)((long)row0 + (long)rstep * p) * D + c0 + ch * 8) = *(const LAS u32x4*)(T + p * XRS + ch * 16); }
}
__device__ __forceinline__ void scan_pass1_item_g(GC& G, const bf16_t* P5, int b, int h, int dir, int seg, float* SST, float* EG) {
    const int chain = (b * 8 + h) * 2 + dir; const size_t rowb = (size_t)b * TL + (size_t)seg * SEGL;
    f32x4 st[2][8]; state_load_g(nullptr, st, G.wg, G.lane);
    float gacc = 0.f;
    u32x4 rk[4], rv[4];
    quarter_load1(G, P5, rowb + 64 * (dir ? 3 : 0), dir != 0, h, dir, rk, rv);
    for (int hs = 0; hs < 4; ++hs) {
        asm volatile("s_waitcnt vmcnt(0)" ::: "memory");
        quarter_prep1(G, rk, rv);
        __builtin_amdgcn_sched_barrier(0);
        if (hs < 3) quarter_load1(G, P5, rowb + 64 * (dir ? 2 - hs : hs + 1), dir != 0, h, dir, rk, rv);
        gsync_l(G);
        quarter_cols1(G);
        gsync_l(G);
        if (G.tid < 128) { const LAS float* ebl = (const LAS float*)(G.L + G2_EBL); gacc += ebl[G.tid] + ebl[128 + G.tid]; }
#pragma unroll 1
        for (int ck = 0; ck < 2; ++ck) { state_update_g(G, st, ck); __builtin_amdgcn_sched_barrier(0); }
        gsync_l(G);
    }
    state_store_g(SST + ((size_t)chain * NSEG + seg) * 16384, st, G.wg, G.lane);
    if (G.tid < 128) EG[((size_t)chain * NSEG + seg) * 128 + G.tid] = __expf(gacc);
}
__device__ __forceinline__ void scan_pass3_item_g(GC& G, const bf16_t* P5, size_t rowb, int h, const float* sin_f, const float* sin_b, float* fin_f, float* fin_b, const float* gain, bf16_t* OFT, bf16_t* Y, bool writey) {
    LAS unsigned char* L = G.L; const int lane = G.lane, i16 = lane & 15, q = lane >> 4, wg = G.wg;
    f32x4 st[2][8];
    state_load_g(sin_f, st, wg, lane);
    for (int hs = 0; hs < 4; ++hs) {
        const size_t hrow = rowb + 64 * hs;
        quarter_prep<true>(G, P5, hrow, false, h, 0);
        gsync(G);
        quarter_scores(G);
        gsync(G);
        u32x2 of[2][2][2];
#pragma unroll
        for (int ck = 0; ck < 2; ++ck) { f32x4 o[2][2]; chunk_out_g(G, st, ck, o);
#pragma unroll
            for (int ct = 0; ct < 2; ++ct)
#pragma unroll
                for (int ti = 0; ti < 2; ++ti) { of[ck][ct][ti].x = pk2(o[ct][ti][0], o[ct][ti][1]); of[ck][ct][ti].y = pk2(o[ct][ti][2], o[ct][ti][3]); }
            __builtin_amdgcn_sched_barrier(0);
            state_update_g(G, st, ck);
            __builtin_amdgcn_sched_barrier(0); }
        gsync(G);
#pragma unroll
        for (int ck = 0; ck < 2; ++ck)
#pragma unroll
            for (int ct = 0; ct < 2; ++ct)
#pragma unroll
                for (int ti = 0; ti < 2; ++ti) *(LAS u32x2*)(L + G2_QT + (32 * ck + 16 * ti + i16) * XRS + (32 * wg + 16 * ct + 4 * q) * 2) = of[ck][ct][ti];
        gsync(G);
        rows_l2g_g(OFT, hrow, 1, h * 128, L + G2_QT, G.tid);
        gsync(G);
    }
    if (fin_f) state_store_g(fin_f, st, wg, lane);
    state_load_g(sin_b, st, wg, lane);
    f32x4 gv[2];
#pragma unroll
    for (int ct = 0; ct < 2; ++ct) gv[ct] = *(const f32x4*)(gain + h * 128 + 32 * wg + 16 * ct + 4 * q);
    for (int hs = 0; hs < 4; ++hs) {
        const size_t hrow = rowb + 64 * (3 - hs);
        quarter_prep<true>(G, P5, hrow, true, h, 1);
        gsync(G);
        quarter_scores(G);
        gsync(G);
        LAS float* RED = (LAS float*)(L + G2_RED);
        f32x4 oa[2][2][2];
#pragma unroll
        for (int ck = 0; ck < 2; ++ck) { chunk_out_g(G, st, ck, oa[ck]);
            __builtin_amdgcn_sched_barrier(0);
            state_update_g(G, st, ck);
            __builtin_amdgcn_sched_barrier(0); }
        gsync(G);
        rows_g2l_g(OFT, hrow + 63, -1, h * 128, L + G2_QT, G.tid);
        if (writey) { u32x4 gr_[4];
#pragma unroll
            for (int it = 0; it < 4; ++it) { const int idx = G.tid + 256 * it, p = idx >> 4, ch = idx & 15; gr_[it] = *(const u32x4*)(P5 + ((size_t)h * MT + (hrow + 63 - p)) * 640 + 128 + ch * 8); }
            __builtin_amdgcn_sched_barrier(0);
#pragma unroll
            for (int it = 0; it < 4; ++it) { const int idx = G.tid + 256 * it, p = idx >> 4, ch = idx & 15; *(LAS u32x4*)(L + G2_KT + p * XRS + ch * 16) = gr_[it]; } }
        gsync(G);
#pragma unroll
        for (int ck = 0; ck < 2; ++ck)
#pragma unroll
            for (int ti = 0; ti < 2; ++ti) { const int p = 32 * ck + 16 * ti + i16; float ss = 0.f;
#pragma unroll
                for (int ct = 0; ct < 2; ++ct) { const u32x2 f = *(const LAS u32x2*)(L + G2_QT + p * XRS + (32 * wg + 16 * ct + 4 * q) * 2);
                    oa[ck][ct][ti][0] += bflo(f.x); oa[ck][ct][ti][1] += bfhi(f.x); oa[ck][ct][ti][2] += bflo(f.y); oa[ck][ct][ti][3] += bfhi(f.y);
                    ss += (oa[ck][ct][ti][0] * oa[ck][ct][ti][0] + oa[ck][ct][ti][1] * oa[ck][ct][ti][1]) + (oa[ck][ct][ti][2] * oa[ck][ct][ti][2] + oa[ck][ct][ti][3] * oa[ck][ct][ti][3]); }
                ss += shfl_x(ss, 16, lane); ss += shfl_x(ss, 32, lane);
                if (q == 0) RED[wg * 64 + p] = ss; }
        gsync(G);
        if (writey) {
#pragma unroll
            for (int ck = 0; ck < 2; ++ck)
#pragma unroll
                for (int ti = 0; ti < 2; ++ti) { const int p = 32 * ck + 16 * ti + i16; const float tot = (RED[p] + RED[64 + p]) + (RED[128 + p] + RED[192 + p]);
                    const float rs = rsqrtf(tot * (1.0f / 128.0f) + EPS);
#pragma unroll
                    for (int ct = 0; ct < 2; ++ct) { const u32x2 sg = *(const LAS u32x2*)(L + G2_KT + p * XRS + (32 * wg + 16 * ct + 4 * q) * 2);
                        u32x2 y; y.x = pk2(oa[ck][ct][ti][0] * rs * gv[ct][0] * bflo(sg.x), oa[ck][ct][ti][1] * rs * gv[ct][1] * bfhi(sg.x)); y.y = pk2(oa[ck][ct][ti][2] * rs * gv[ct][2] * bflo(sg.y), oa[ck][ct][ti][3] * rs * gv[ct][3] * bfhi(sg.y));
                        *(LAS u32x2*)(L + G2_V + p * XRS + (32 * wg + 16 * ct + 4 * q) * 2) = y; } }
            gsync(G);
            rows_l2g_g(Y, hrow + 63, -1, h * 128, L + G2_V, G.tid);
        }
        gsync(G);
    }
    if (fin_b) state_store_g(fin_b, st, wg, lane);
}
__device__ __forceinline__ int gq_next(GC& G, unsigned* ctr, unsigned ngroups) {
    LAS unsigned* slot = (LAS unsigned*)(G.L + G2_SLOT);
    gsync(G);
    if (G.tid == 0) *slot = ngroups + __hip_atomic_fetch_add(ctr, 1u, __ATOMIC_RELAXED, __HIP_MEMORY_SCOPE_AGENT);
    gsync(G);
    return (int)*slot;
}

__device__ __forceinline__ void scan_carry(const Ctx& F) {
    float* SST = (float*)(F.ws + WS_SST); const float* EG = (const float*)(F.ws + WS_EG); const float* S0 = (const float*)(F.ws + WS_S0);
    const int gt = F.bid * 512 + F.tid, NGT = F.G * 512;
    for (int idx = gt; idx < NCHAIN * 16384; idx += NGT) {
        const int chain = idx >> 14, e = idx & 16383, dir = chain & 1;
        const int lanee = e & 63, rg = (e >> 6) & 3, kb = (e >> 8) & 7; const int dk = 16 * kb + 4 * (lanee >> 4) + rg;
        float cur = S0[(size_t)chain * 16384 + e];
        float* base = SST + (size_t)chain * NSEG * 16384 + e; const float* eg = EG + (size_t)chain * NSEG * 128 + dk;
        for (int s0 = 0; s0 < NSEG; s0 += 8) {
            float tmp[8], gg[8];
#pragma unroll
            for (int i = 0; i < 8; ++i) { const int seg = dir ? NSEG - 1 - (s0 + i) : s0 + i; tmp[i] = base[(size_t)seg * 16384]; gg[i] = eg[seg * 128]; }
#pragma unroll
            for (int i = 0; i < 8; ++i) { const int seg = dir ? NSEG - 1 - (s0 + i) : s0 + i; base[(size_t)seg * 16384] = cur; cur = gg[i] * cur + tmp[i]; }
        }
    }
}

__device__ __forceinline__ void moe_slots(const Ctx& F, int nrows) {
    const int tid = F.tid; const int nitems = F.NGW;
    const RowPart rp = row_part(F.NGW, nrows);
    const int* cnt = (const int*)(F.ws + WS_CNT); const int* tope = (const int*)(F.ws + WS_TOPE); const int* rank = (const int*)(F.ws + WS_RANK);
    int* slotrow = (int*)(F.ws + WS_SLOTROW); int* slotdst = (int*)(F.ws + WS_SLOTDST); int* tilex = (int*)(F.ws + WS_TILEX); int* slotof = (int*)(F.ws + WS_SLOTOF);
    LAS int* pre = (LAS int*)F.lds;
    LAS int* tsum = (LAS int*)(F.lds + 69632);
    LAS int* ebase = (LAS int*)(F.lds + 69632 + 16384);
    const int IPT = (nitems + 511) / 512;
    int loc[8] = {0, 0, 0, 0, 0, 0, 0, 0};
    for (int i = 0; i < IPT; ++i) { const int it = tid * IPT + i; if (it < nitems) {
#pragma unroll
        for (int e = 0; e < 8; ++e) loc[e] += cnt[it * 8 + e]; } }
    {
        const int lane = F.lane, wv = F.wave; LAS int* wsum = ebase + 32;
        int inc[8];
#pragma unroll
        for (int e = 0; e < 8; ++e) { int v = loc[e];
#pragma unroll
            for (int o = 1; o < 64; o <<= 1) { const int u = __builtin_amdgcn_ds_bpermute(((lane - o) & 63) << 2, v); if (lane >= o) v += u; }
            inc[e] = v; }
        if (lane == 63) {
#pragma unroll
            for (int e = 0; e < 8; ++e) wsum[wv * 8 + e] = inc[e]; }
        __syncthreads();
#pragma unroll
        for (int e = 0; e < 8; ++e) { int below = 0, tot = 0;
#pragma unroll
            for (int w2 = 0; w2 < 8; ++w2) { const int t_ = wsum[w2 * 8 + e]; tot += t_; if (w2 < wv) below += t_; }
            tsum[tid * 8 + e] = below + inc[e] - loc[e];
            if (tid == 0) ebase[8 + e] = tot; }
    }
    __syncthreads();
    if (tid == 0) { int b = 0; for (int e = 0; e < 8; ++e) { ebase[e] = b; b += (ebase[8 + e] + 255) & ~255; } ebase[16] = b / 256; }
    { int run[8];
#pragma unroll
      for (int e = 0; e < 8; ++e) run[e] = tsum[tid * 8 + e];
      for (int i = 0; i < IPT; ++i) { const int it = tid * IPT + i; if (it < nitems) {
#pragma unroll
          for (int e = 0; e < 8; ++e) { pre[it * 8 + e] = run[e]; run[e] += cnt[it * 8 + e]; } } } }
    __syncthreads();
    for (int r = F.bid * 512 + tid; r < nrows; r += F.G * 512) {
        const int ch = row_chunk_of(rp, r);
#pragma unroll
        for (int kk = 0; kk < 2; ++kk) { const int e = tope[2 * r + kk]; const int slot = ebase[e] + pre[ch * 8 + e] + rank[2 * r + kk]; slotrow[slot] = r; slotdst[slot] = 2 * r + kk; slotof[2 * r + kk] = slot; }
    }
    if (F.bid == 0) {
        const int ntiles = ebase[16];
        if (tid == 0) tilex[0] = ntiles;
        for (int e = 0; e < 8; ++e) { const int b0 = ebase[e], tot = ebase[8 + e], pad = (tot + 255) & ~255;
            for (int s = b0 + tot + tid; s < b0 + pad; s += 512) { slotrow[s] = 0; slotdst[s] = -1; }
            for (int t = b0 / 256 + tid; t < (b0 + pad) / 256; t += 512) tilex[16 + t] = e; }
    }
}

__global__ void __launch_bounds__(512, 2) fwd_kernel(Args args) {
    extern __shared__ __attribute__((aligned(16))) unsigned char lds_raw[];
    Ctx F;
    F.lds = (LAS unsigned char*)lds_raw; F.tid = threadIdx.x; F.lane = F.tid & 63; F.wave = __builtin_amdgcn_readfirstlane(F.tid >> 6);
    F.G = gridDim.x; F.bid = blockIdx.x; F.gw = F.bid * 8 + F.wave; F.NGW = F.G * 8;
    F.in = args.in; F.out = args.out; F.ws = args.ws;
    volatile LAS unsigned* MISC = (volatile LAS unsigned*)(F.lds + MISC_OFF);
    if (F.tid < 64) MISC[F.tid] = 0u;
    __syncthreads();
    const int lo = args.ph_lo, hi = args.ph_hi;
    XcdBarrier bar; bar.bar = (unsigned*)(F.ws + WS_CTL) + 4096; bar.x = 0; bar.st = nullptr;
    const bool multi = (hi - lo) > 1;
    if (multi) bar = xcd_barrier_post((unsigned*)(F.ws + WS_CTL) + 4096, MISC + 8);
#define IN(k) (lo <= (k) && (k) < hi)
#if defined(PROBE_TMASK)
    unsigned long long pt_last = __builtin_amdgcn_s_memrealtime(), pt_acc = 0ull;
#define PROBE_T(k) do { const unsigned long long now_ = __builtin_amdgcn_s_memrealtime(); if ((((unsigned long long)(PROBE_TMASK)) >> (k)) & 1ull) pt_acc += now_ - pt_last; pt_last = now_; } while (0)
#else
#define PROBE_T(k) do { } while (0)
#endif
#define SEAM(k) do { if (IN(k) && IN((k) + 1)) xcd_barrier(bar); PROBE_T(k); asm volatile("" : "+v"(F.tid), "+s"(F.G)); LAUNDER_WS_OUT(); F.NGW = F.G * 8; F.lane = F.tid & 63; F.wave = __builtin_amdgcn_readfirstlane(F.tid >> 6); F.gw = F.bid * 8 + F.wave; } while (0)

#define MODS_ ((float*)(F.ws + WS_MODS))
#define XB_ ((bf16_t*)(F.ws + WS_XB))
#define H_ ((bf16_t*)(F.ws + WS_H))
#define YE_ ((bf16_t*)(F.ws + WS_YE))

    if (IN(PH_P0)) for (int rep_ = 0; rep_ < NREP(18); ++rep_) { p0_prologue(F); }
#if defined(PROBE_SLEEP)
    if (IN(PH_P0)) { const unsigned long long t0 = __builtin_amdgcn_s_memrealtime(); while (__builtin_amdgcn_s_memrealtime() - t0 < (unsigned long long)PROBE_SLEEP * 100ull) __builtin_amdgcn_s_sleep(32); }
#endif
    SEAM(PH_P0);

#if defined(PROBE_GEMM)
    if (IN(PH_P0)) {
        pg8::Gemm g{H_, (const bf16_t*)(F.ws + WS_WINE), ML, NEIN, D, nullptr, nullptr, 0}; pg8::StaticOrder S; S.init(ML, NEIN, D, F.G, F.bid);
#if PROBE_GEMM == 1
        pg8::EpiEvenIn E{(bf16_t*)(F.ws + WS_UP)}; pg8::gemm_phase<pg8::EpiEvenIn, pg8::StaticOrder, true, false>(F.lds, g, S, E, F.tid);
#elif PROBE_GEMM == 2
        pg8::EpiNull E{(float*)(F.ws + WS_UP)}; pg8::gemm_phase<pg8::EpiNull, pg8::StaticOrder, true, false>(F.lds, g, S, E, F.tid);
#endif
        xcd_barrier(bar);
    }
#endif

    for (int lp = 0; lp < 2; ++lp) {
        const int pb = PH_PAIR0 + lp * NPL;
        const int le = 2 * lp, lo_ = 2 * lp + 1;
        const float* modE = MODS_ + (size_t)le * 3 * 6144; const float* modO = MODS_ + (size_t)lo_ * 3 * 6144;
        if (IN(pb + E1_NORM)) for (int rep_ = 0; rep_ < NREP(E1_NORM); ++rep_) {
            RowPass P{}; P.sl = FIN(I_X); P.sc = FIN(I_CTX); P.xb = XB_; P.gain = FIN(I_NMIX) + le * D; P.shift = modE + 0 * D; P.scale = modE + 1 * D; P.H = H_; P.nrows = MT;
            if (lp == 0) row_pass<false, false, false, false>(F, P);
            else { P.YE = YE_; P.topp = (const float*)(F.ws + WS_TOPP); P.gatef = MODS_ + (size_t)(le - 1) * 3 * 6144 + 5 * D; P.slotof = (const int*)(F.ws + WS_SLOTOF); P.partm = (const float*)(F.ws + WS_PARTM); row_pass_b<true, false, false, 2>(F, P); }
        }
        SEAM(pb + E1_NORM);
        if (IN(pb + E2_GIN)) for (int rep_ = 0; rep_ < NREP(E2_GIN); ++rep_) {
            pg8::Gemm g{H_, (const bf16_t*)(F.ws + WS_WINE) + (size_t)lp * NEIN * D, MT, NEIN, D, nullptr, nullptr, 0}; pg8::StaticOrder S; S.init(MT, NEIN, D, F.G, F.bid);
            pg8::EpiEvenIn E{(bf16_t*)(F.ws + WS_PZUV)};
            pg8::gemm_phase<pg8::EpiEvenIn, pg8::StaticOrder, true, false>(F.lds, g, S, E, F.tid);
        }
        SEAM(pb + E2_GIN);
        if (IN(pb + E3_FFTA)) for (int rep_ = 0; rep_ < NREP(E3_FFTA); ++rep_) fft_stage_a(F, (unsigned*)(F.ws + WS_CTL) + 8192 + 64 * (pb + E3_FFTA));
        SEAM(pb + E3_FFTA);
        if (IN(pb + E3_FFTC)) for (int rep_ = 0; rep_ < NREP(E3_FFTC); ++rep_) fft_stage_c_gmlp(F, lp, (unsigned*)(F.ws + WS_CTL) + 8192 + 64 * (pb + E3_FFTC));
        SEAM(pb + E3_FFTC);
        if (IN(pb + E4_GOUT)) for (int rep_ = 0; rep_ < NREP(E4_GOUT); ++rep_) {
            pg8::Gemm g{H_, (const bf16_t*)(F.ws + WS_WOUTE) + (size_t)lp * D * D, MT, D, D, nullptr, nullptr, 0}; pg8::ResOrder S; S.init(D, F.G, F.bid, true);
            if (lp == 0) { pg8::EpiRes<true> E{FIN(I_X), XB_, modE + 2 * D, (float*)(F.ws + WS_PARTC)}; pg8::gemm_phase<pg8::EpiRes<true>, pg8::ResOrder, false, false>(F.lds, g, S, E, F.tid); }
            else { pg8::EpiRes<false> E{nullptr, XB_, modE + 2 * D, (float*)(F.ws + WS_PARTC)}; pg8::gemm_phase<pg8::EpiRes<false>, pg8::ResOrder, false, false>(F.lds, g, S, E, F.tid); }
        }
        SEAM(pb + E4_GOUT);
        if (IN(pb + E5_NORM)) for (int rep_ = 0; rep_ < NREP(E5_NORM); ++rep_) {
            RowPass P{}; P.xb = XB_; P.csrc32 = lp == 0 ? FIN(I_CTX) : nullptr; P.gain = FIN(I_NFFN) + le * D; P.shift = modE + 3 * D; P.scale = modE + 4 * D; P.H = H_; P.nrows = MT;
            P.part = (const float*)(F.ws + WS_PARTC); P.kpn = CTX_KP; P.pgate = modE + 2 * D;
            row_pass_b<false, false, false, 4>(F, P);
        }
        SEAM(pb + E5_NORM);
        if (IN(pb + E6_UP)) for (int rep_ = 0; rep_ < NREP(E6_UP); ++rep_) {
            pg8::Gemm g{H_, (const bf16_t*)(F.ws + WS_W13) + (size_t)lp * NFF2 * D, MT, NFF2, D, nullptr, nullptr, 0}; pg8::StaticOrder S; S.init(MT, NFF2, D, F.G, F.bid);
            pg8::EpiSwiglu E{(bf16_t*)(F.ws + WS_HID), DFF};
            pg8::gemm_phase<pg8::EpiSwiglu, pg8::StaticOrder, true, false>(F.lds, g, S, E, F.tid);
        }
        SEAM(pb + E6_UP);
        if (IN(pb + E7_DOWN)) for (int rep_ = 0; rep_ < NREP(E7_DOWN); ++rep_) {
            pg8::Gemm g{(const bf16_t*)(F.ws + WS_HID), (const bf16_t*)(F.ws + WS_W2) + (size_t)lp * D * DFF, MT, D, DFF, nullptr, nullptr, 0}; pg8::ResOrder S; S.init(DFF, F.G, F.bid, true);
            pg8::EpiRes<false> E{nullptr, XB_, modE + 5 * D, (float*)(F.ws + WS_PARTC)};
            pg8::gemm_phase<pg8::EpiRes<false>, pg8::ResOrder, false, false>(F.lds, g, S, E, F.tid);
        }
        SEAM(pb + E7_DOWN);
        const bool lastl = lp == 1;
        if (IN(pb + O1_NORM)) for (int rep_ = 0; rep_ < NREP(O1_NORM); ++rep_) {
            RowPass P{}; P.xb = XB_; P.gain = FIN(I_NMIX) + lo_ * D; P.shift = modO + 0 * D; P.scale = modO + 1 * D; P.H = H_; P.nrows = MT;
            P.part = (const float*)(F.ws + WS_PARTC); P.kpn = CTX_KP; P.pgate = modE + 5 * D;
            row_pass_b<false, false, false, 4>(F, P);
        }
        SEAM(pb + O1_NORM);
        if (IN(pb + O2_GIN)) for (int rep_ = 0; rep_ < NREP(O2_GIN); ++rep_) {
            pg8::Gemm g{H_, (const bf16_t*)(F.ws + WS_WINO) + (size_t)lp * NREC * D, MT, NREC, D, nullptr, nullptr, 0}; pg8::StaticOrder S; S.init(MT, NREC, D, F.G, F.bid);
            pg8::EpiOddIn E{(bf16_t*)(F.ws + WS_P5), (const float*)(F.ws + WS_LB) + lp * 2048};
            pg8::gemm_phase<pg8::EpiOddIn, pg8::StaticOrder, true, false>(F.lds, g, S, E, F.tid);
        }
        SEAM(pb + O2_GIN);
        if (IN(pb + O3_SCAN1)) {
            const int grp = F.wave >> 2; const int NG = F.G * 2, gid = F.bid * 2 + grp;
            GC G; G.L = F.lds + grp * G2_BYTES; G.wg = F.wave & 3; G.tid = F.tid & 255; G.lane = F.lane; G.bar = (LAS unsigned*)(F.lds + MISC_OFF + 128 + 4 * grp);
            __syncthreads(); G.epoch = __hip_atomic_load(G.bar, __ATOMIC_RELAXED, __HIP_MEMORY_SCOPE_WORKGROUP);
            constexpr int NCONV = MOE_CONV_ITEMS / 4, NITEMS = 16 + 4096 + (NCONV - 2048);
            for (int it = gid; it < NITEMS; ) {
                { int t_ = F.tid; asm volatile("" : "+v"(t_)); LAUNDER_WS_OUT(); G.tid = t_ & 255; G.lane = t_ & 63; F.lane = G.lane; }
                const bf16_t* P5 = (const bf16_t*)(F.ws + WS_P5); float* SST = (float*)(F.ws + WS_SST); float* EG = (float*)(F.ws + WS_EG); float* S0 = (float*)(F.ws + WS_S0);
                const float* gain = FIN(I_RNORM) + lp * D; unsigned* wq = (unsigned*)(F.ws + WS_CTL) + 8192 + 64 * (pb + O3_SCAN1);
                int it2 = it, cv = -1;
                if (it >= 16) { const int y = it - 16; if (y < 4096) { if (y & 1) cv = y >> 1; else it2 = 16 + (y >> 1); } else cv = 2048 + (y - 4096); }
                if (cv >= 0) moe_convert_item(F, lp, cv * 4 + G.wg);
                else if (it2 < 16) { const int b = it2 >> 3, h = it2 & 7;
                    scan_pass3_item_g(G, P5, (size_t)ML + b * TCX, h, nullptr, nullptr, S0 + (size_t)((b * 8 + h) * 2 + 0) * 16384, S0 + (size_t)((b * 8 + h) * 2 + 1) * 16384, gain, YE_, H_, !lastl);
                } else { const int i2 = it2 - 16, seg = i2 & 63, dir = (i2 >> 6) & 1, h = (i2 >> 7) & 7, b = i2 >> 10;
                    scan_pass1_item_g(G, P5, b, h, dir, seg, SST, EG); }
                it = gq_next(G, wq, (unsigned)NG);
            }
        }
        SEAM(pb + O3_SCAN1);
        if (IN(pb + O4_CARRY)) for (int rep_ = 0; rep_ < NREP(O4_CARRY); ++rep_) { scan_carry(F); }
        SEAM(pb + O4_CARRY);
        if (IN(pb + O5_SCAN3)) {
            const int grp = F.wave >> 2; const int NG = F.G * 2, gid = F.bid * 2 + grp;
            GC G; G.L = F.lds + grp * G2_BYTES; G.wg = F.wave & 3; G.tid = F.tid & 255; G.lane = F.lane; G.bar = (LAS unsigned*)(F.lds + MISC_OFF + 128 + 4 * grp);
            __syncthreads(); G.epoch = __hip_atomic_load(G.bar, __ATOMIC_RELAXED, __HIP_MEMORY_SCOPE_WORKGROUP);
            for (int it = gid; it < 1024; it += NG) { const int seg = it & 63, h = (it >> 6) & 7, b = it >> 9; const int ch0 = (b * 8 + h) * 2;
                { int t_ = F.tid; asm volatile("" : "+v"(t_)); LAUNDER_WS_OUT(); G.tid = t_ & 255; G.lane = t_ & 63; }
                const bf16_t* P5 = (const bf16_t*)(F.ws + WS_P5); const float* SST = (const float*)(F.ws + WS_SST); const float* gain = FIN(I_RNORM) + lp * D;
                scan_pass3_item_g(G, P5, (size_t)b * TL + (size_t)seg * SEGL, h, SST + ((size_t)ch0 * NSEG + seg) * 16384, SST + ((size_t)(ch0 + 1) * NSEG + seg) * 16384, nullptr, nullptr, gain, YE_, H_, true); }
        }
        SEAM(pb + O5_SCAN3);
        if (IN(pb + O6_GOUT)) for (int rep_ = 0; rep_ < NREP(O6_GOUT); ++rep_) {
            pg8::Gemm g{H_, (const bf16_t*)(F.ws + WS_WOUTO) + (size_t)lp * D * D, MT, D, D, nullptr, nullptr, 0}; pg8::ResOrder S; S.init(D, F.G, F.bid, !lastl);
            pg8::EpiRes<false> E{nullptr, XB_, modO + 2 * D, (float*)(F.ws + WS_PARTC)};
            pg8::gemm_phase<pg8::EpiRes<false>, pg8::ResOrder, false, false>(F.lds, g, S, E, F.tid);
        }
        SEAM(pb + O6_GOUT);
        const int nrm = lastl ? ML : MT;
        if (IN(pb + O7_NORM)) for (int rep_ = 0; rep_ < NREP(O7_NORM); ++rep_) {
            RowPass P{}; P.xb = XB_; P.gain = FIN(I_NFFN) + lo_ * D; P.shift = modO + 3 * D; P.scale = modO + 4 * D; P.H = H_; P.nrows = nrm;
            P.part = lastl ? nullptr : (const float*)(F.ws + WS_PARTC); P.kpn = CTX_KP; P.pgate = modO + 2 * D;
            P.rw = FIN(I_RW) + (size_t)lp * D * NE; P.tope = (int*)(F.ws + WS_TOPE); P.toppo = (float*)(F.ws + WS_TOPP); P.rank = (int*)(F.ws + WS_RANK); P.cnt = (int*)(F.ws + WS_CNT);
            row_pass_b<false, true, false, 2>(F, P);
        }
        SEAM(pb + O7_NORM);
        if (IN(pb + O8_SLOTS)) for (int rep_ = 0; rep_ < NREP(O8_SLOTS); ++rep_) moe_slots(F, nrm);
        SEAM(pb + O8_SLOTS);
        if (IN(pb + O9_MUP)) for (int rep_ = 0; rep_ < NREP(O9_MUP); ++rep_) {
            const int* tilex = (const int*)(F.ws + WS_TILEX); const int ntiles = __builtin_amdgcn_readfirstlane(tilex[0]);
            pg8::Gemm g{H_, (const bf16_t*)(F.ws + WS_W13M), ntiles * 256, NEX2, D, (const int*)(F.ws + WS_SLOTROW), tilex + 16, (size_t)NEX2 * D}; pg8::StaticOrder S; S.init(ntiles * 256, NEX2, D, F.G, F.bid);
            pg8::EpiSwiglu E{(bf16_t*)(F.ws + WS_HIDM), DEX};
            pg8::gemm_phase<pg8::EpiSwiglu, pg8::StaticOrder, true, true>(F.lds, g, S, E, F.tid);
        }
        SEAM(pb + O9_MUP);
        if (IN(pb + O10_MDOWN)) for (int rep_ = 0; rep_ < NREP(O10_MDOWN); ++rep_) {
            const int* tilex = (const int*)(F.ws + WS_TILEX); const int ntiles = __builtin_amdgcn_readfirstlane(tilex[0]);
            pg8::Gemm g{(const bf16_t*)(F.ws + WS_HIDM), (const bf16_t*)(F.ws + WS_W2M), ntiles * 256, D, DEX, nullptr, tilex + 16, (size_t)D * DEX}; pg8::MoeDownOrder S; S.init(ntiles, F.G, F.bid);
            pg8::EpiMoeDown E{YE_, (const int*)(F.ws + WS_SLOTDST), (float*)(F.ws + WS_PARTM)};
            pg8::gemm_phase<pg8::EpiMoeDown, pg8::MoeDownOrder, true, false>(F.lds, g, S, E, F.tid);
        }
        SEAM(pb + O10_MDOWN);
    }
    if (IN(PH_FINAL)) {
        RowPass P{}; P.xb = XB_; P.gain = FIN(I_NOUT); P.nrows = ML; P.YE = YE_; P.topp = (const float*)(F.ws + WS_TOPP); P.gatef = MODS_ + (size_t)3 * 3 * 6144 + 5 * D; P.fout = F.out; P.slotof = (const int*)(F.ws + WS_SLOTOF); P.partm = (const float*)(F.ws + WS_PARTM);
        row_pass_b<true, false, true, 2>(F, P);
    }
    PROBE_T(PH_FINAL);
#if defined(PROBE_TMASK)
    if (F.bid == 0 && F.tid == 0) { const unsigned long long t0 = __builtin_amdgcn_s_memrealtime(); while (__builtin_amdgcn_s_memrealtime() - t0 < pt_acc * 4ull) __builtin_amdgcn_s_sleep(32); }
#endif
#undef IN
#undef SEAM
#undef MODS_
#undef XB_
#undef H_
#undef YE_
}

extern "C" void kernel_launch(void* const* d_in, const int* in_sizes, int n_in, void* d_out, int out_size, void* d_ws, size_t ws_size, hipStream_t stream) {
    static int grid = 0;
    if (grid == 0) {
        if (n_in != 24 || out_size != ML * D || ws_size < WS_END) { fprintf(stderr, "kernel_launch: unexpected problem (n_in %d, out %d, ws %zu < %zu)\n", n_in, out_size, ws_size, (size_t)WS_END); grid = -1; return; }
        int dev = 0, cus = 0, per_cu = 0;
        if (hipGetDevice(&dev) != hipSuccess || hipDeviceGetAttribute(&cus, hipDeviceAttributeMultiprocessorCount, dev) != hipSuccess) { grid = -1; return; }
        if (hipFuncSetAttribute((const void*)fwd_kernel, hipFuncAttributeMaxDynamicSharedMemorySize, LDS_BYTES) != hipSuccess) { fprintf(stderr, "kernel_launch: hipFuncSetAttribute failed\n"); grid = -1; return; }
        if (hipOccupancyMaxActiveBlocksPerMultiprocessor(&per_cu, (const void*)fwd_kernel, 512, LDS_BYTES) != hipSuccess || per_cu < 1) fprintf(stderr, "kernel_launch: occupancy query says %d\n", per_cu);
        (void)hipGetLastError();
        grid = cus;
    }
    if (grid < 0) return;
    (void)hipMemsetAsync((char*)d_ws + WS_CTL, 0, CTL_BYTES, stream);
    Args a{};
    for (int i = 0; i < 24; ++i) a.in[i] = (const float*)d_in[i];
    a.out = (float*)d_out; a.ws = (unsigned char*)d_ws;
#if PER_PHASE_LAUNCH
    for (int p = 0; p < NPHASE && p < PHASE_LIMIT; ++p) { a.ph_lo = p; a.ph_hi = p + 1; hipLaunchKernelGGL(fwd_kernel, dim3(grid), dim3(512), LDS_BYTES, stream, a); }
#else
    a.ph_lo = 0; a.ph_hi = NPHASE; hipLaunchKernelGGL(fwd_kernel, dim3(grid), dim3(512), LDS_BYTES, stream, a);
#endif
}
```

```cpp
#include <hip/hip_runtime.h>
#include <cstdio>
#include <cstdint>

#ifndef PER_PHASE_LAUNCH
#define PER_PHASE_LAUNCH 0
#endif
#ifndef CTX_KP
#define CTX_KP 4
#endif
#ifndef REP_MASK
#define REP_MASK 0
#endif
#define NREP(x) (((REP_MASK >> (x)) & 1) ? 2 : 1)
#ifndef PHASE_LIMIT
#define PHASE_LIMIT 100
#endif
#ifndef P0_MASK
#define P0_MASK 63
#endif
#ifndef P0_T
#define P0_T 127
#endif

#define LAS __attribute__((address_space(3)))
typedef unsigned short bf16_t;
typedef short bf16x8 __attribute__((ext_vector_type(8)));
typedef short s16x4 __attribute__((ext_vector_type(4)));
typedef float f32x4 __attribute__((ext_vector_type(4)));
typedef float f32x2 __attribute__((ext_vector_type(2)));
typedef unsigned u32x4 __attribute__((ext_vector_type(4)));
typedef unsigned u32x2 __attribute__((ext_vector_type(2)));

constexpr int D = 1024, TL = 16384, ML = 32768, TCX = 256, MC = 512, MT = 33280;
constexpr int NEIN = 2048, DFF = 2816, NFF2 = 5632, NREC = 5120, DEX = 3584, NEX2 = 7168, NE = 8;
constexpr int NSEG = 64, SEGL = 256, CH = 32, NCHAIN = 32;
constexpr int MAXTILES = 268, NITEM16 = MT / 16;
constexpr float EPS = 1e-6f;

constexpr size_t MiB = 1u << 20, KiB = 1u << 10;
constexpr size_t WS_CTL = 0, CTL_BYTES = 1 * MiB;
constexpr size_t WS_MODS = 1 * MiB, WS_LB = 1 * MiB + 512 * KiB;
constexpr size_t WS_FA = 2 * MiB, WS_FC = 2 * MiB + 128 * KiB, WS_FX = 2 * MiB + 256 * KiB, WS_GW = 2 * MiB + 512 * KiB;
constexpr size_t WS_XC = 3 * MiB;
constexpr size_t WS_TOPE = 5 * MiB, WS_TOPP = 5 * MiB + 512 * KiB, WS_RANK = 6 * MiB, WS_CNT = 6 * MiB + 512 * KiB, WS_TILEX = 6 * MiB + 768 * KiB, WS_SLOTROW = 7 * MiB, WS_SLOTDST = 7 * MiB + 512 * KiB;
constexpr size_t WS_WINE = 8 * MiB, WS_WOUTE = 16 * MiB, WS_WINO = 20 * MiB, WS_WOUTO = 40 * MiB, WS_W13 = 44 * MiB, WS_W2 = 66 * MiB;
constexpr size_t WS_W13M = 77 * MiB, WS_W2M = 189 * MiB;
constexpr size_t WS_H = 245 * MiB, WS_YE = 310 * MiB, WS_BIG = 440 * MiB;
constexpr size_t WS_PZUV = WS_BIG, WS_UP = WS_BIG + 130 * MiB, WS_HID = WS_BIG, WS_P5 = WS_BIG, WS_SST = WS_BIG + 325 * MiB, WS_EG = WS_BIG + 453 * MiB, WS_S0 = WS_BIG + 454 * MiB, WS_HIDM = WS_BIG;
constexpr size_t WS_PARTC = WS_BIG + 469 * MiB, WS_PARTM = WS_PARTC + 8 * MiB;
constexpr size_t WS_SLOTOF = 1 * MiB + 576 * KiB;
constexpr size_t WS_XB = WS_PARTM + 48 * MiB;
constexpr size_t WS_END = WS_XB + 65 * MiB;
static_assert(WS_END <= (size_t)1032 * MiB, "workspace must stay below the sum of the input sizes (1032.7 MiB)");
static_assert(WS_W2 + (size_t)2 * D * DFF * 2 <= WS_W13M, "static weights");
static_assert(WS_W2M + (size_t)NE * D * DEX * 2 <= WS_H && WS_H + (size_t)MT * D * 2 <= WS_YE && WS_YE + (size_t)MT * 2 * D * 2 <= WS_BIG, "ws map");
static_assert((size_t)MAXTILES * 256 * DEX * 2 <= 469 * MiB && (size_t)MT * NREC * 2 <= 325 * MiB && (size_t)MT * NEIN * 2 <= 130 * MiB, "big region");

constexpr int LDS_BYTES = 147456, MISC_OFF = 147456 - 256;
constexpr int XRS = 288;

typedef __bf16 bf16x2_t __attribute__((ext_vector_type(2)));
__device__ __forceinline__ unsigned f2bf(float f) { return (unsigned)__builtin_bit_cast(unsigned short, (__bf16)f); }
__device__ __forceinline__ unsigned pk2(float lo, float hi) { return __builtin_bit_cast(unsigned, __builtin_convertvector((f32x2){lo, hi}, bf16x2_t)); }
__device__ __forceinline__ float bf2f(unsigned short b) { return __builtin_bit_cast(float, (unsigned)b << 16); }
__device__ __forceinline__ float bflo(unsigned w) { return __builtin_bit_cast(float, w << 16); }
__device__ __forceinline__ float bfhi(unsigned w) { return __builtin_bit_cast(float, w & 0xffff0000u); }
__device__ __forceinline__ float shfl_x(float v, int o, int lane) { return __builtin_bit_cast(float, __builtin_amdgcn_ds_bpermute((lane ^ o) << 2, __builtin_bit_cast(int, v))); }
__device__ __forceinline__ float wave_sum(float v, int lane) {
#pragma unroll
    for (int o = 1; o < 64; o <<= 1) v += shfl_x(v, o, lane);
    return v;
}
__device__ __forceinline__ float siluf(float a) { return a * __builtin_amdgcn_rcpf(1.0f + __expf(-a)); }
#define WQ_NEXT(it, ctr, slot, G) do { __syncthreads(); if (threadIdx.x == 0) *(slot) = (unsigned)(G) + __hip_atomic_fetch_add((ctr), 1u, __ATOMIC_RELAXED, __HIP_MEMORY_SCOPE_AGENT); __syncthreads(); (it) = (int)*(slot); } while (0)
#define LDS_WAIT() asm volatile("s_waitcnt lgkmcnt(0)" ::: "memory")
#define VM_WAIT() asm volatile("s_waitcnt vmcnt(0)" ::: "memory")

#define XB_TMO      128
#define XB_XCNT(j)  (256  + 64 * (j))
#define XB_XSUB(j)  (1280 + 64 * (j))
#define XB_XGEN(j)  (2304 + 64 * (j))
#define XB_TOP      3328
#define XB_TOPGEN   3392
#define XCD_BAR_WORDS 3456
#define XB_SPIN_CAP (1u << 18)
__device__ __forceinline__ unsigned xb_ld(unsigned* p)              { return __hip_atomic_load(p, __ATOMIC_RELAXED, __HIP_MEMORY_SCOPE_AGENT); }
__device__ __forceinline__ unsigned xb_add(unsigned* p, unsigned v) { return __hip_atomic_fetch_add(p, v, __ATOMIC_RELAXED, __HIP_MEMORY_SCOPE_AGENT); }
__device__ __forceinline__ unsigned xb_xcc_id() { return (unsigned)__builtin_amdgcn_s_getreg((3 << 11) | 20) & 0xFu; }
#define XB_SPIN(cond, bar) do { unsigned _sp = 0; while (cond) { __builtin_amdgcn_s_sleep(1); \
    if ((++_sp & 255u) == 0u) { if (xb_ld(&(bar)[XB_TMO])) break; if (_sp > XB_SPIN_CAP) { atomicAdd(&(bar)[XB_TMO], 1u); break; } } } } while (0)
struct XcdBarrier { unsigned* bar; unsigned x; volatile LAS unsigned* st; };
__device__ __forceinline__ XcdBarrier xcd_barrier_post(unsigned* bar, volatile LAS unsigned* st) {
    XcdBarrier b; b.bar = bar; b.x = xb_xcc_id(); b.st = st;
    if (threadIdx.x == 0) (void)xb_add(&bar[XB_XCNT(b.x)], 1u);
    return b;
}
__device__ __forceinline__ void xcd_barrier_complete(unsigned* bar, unsigned x, unsigned& nloc, unsigned& nx) {
    const unsigned G = gridDim.x * gridDim.y * gridDim.z;
    unsigned sum, cnt, mine, sp = 0u;
    for (;;) {
        sum = 0u; cnt = 0u; mine = 0u;
#pragma unroll
        for (unsigned j = 0; j < 16; ++j) { const unsigned c = xb_ld(&bar[XB_XCNT(j)]); sum += c; cnt += (c > 0u) ? 1u : 0u; mine = (j == x) ? c : mine; }
        if (sum == G) break;
        __builtin_amdgcn_s_sleep(1);
        if ((++sp & 255u) == 0u) { if (xb_ld(&bar[XB_TMO])) break; if (sp > XB_SPIN_CAP) { atomicAdd(&bar[XB_TMO], 1u); break; } }
    }
    nloc = mine > 0u ? mine : 1u; nx = cnt > 0u ? cnt : 1u;
}
__device__ __forceinline__ void xcd_barrier(const XcdBarrier& b) {
    asm volatile("s_waitcnt vmcnt(0)" ::: "memory");
    __syncthreads();
    if (threadIdx.x == 0) {
        unsigned* bar = b.bar;
        __builtin_amdgcn_s_waitcnt(0);
        unsigned nloc = b.st[0], nx = b.st[1];
        if (nloc == 0u) { xcd_barrier_complete(bar, b.x, nloc, nx); b.st[0] = nloc; b.st[1] = nx; }
        const unsigned old = xb_add(&bar[XB_XSUB(b.x)], 1u);
        const unsigned gen = old / nloc;
        if (old + 1u == (gen + 1u) * nloc) {
            __builtin_amdgcn_fence(__ATOMIC_RELEASE, "agent");
            asm volatile("s_waitcnt vmcnt(0)" ::: "memory");
            const unsigned og = xb_add(&bar[XB_TOP], 1u);
            const unsigned tg = og / nx;
            if (og + 1u == (tg + 1u) * nx) xb_add(&bar[XB_TOPGEN], 1u);
            else XB_SPIN(xb_ld(&bar[XB_TOPGEN]) == tg, bar);
            __builtin_amdgcn_fence(__ATOMIC_ACQUIRE, "agent");
            xb_add(&bar[XB_XGEN(b.x)], 1u);
            asm volatile("s_waitcnt vmcnt(0)" ::: "memory");
        } else {
            XB_SPIN(xb_ld(&bar[XB_XGEN(b.x)]) == gen, bar);
            __builtin_amdgcn_fence(__ATOMIC_ACQUIRE, "agent");
            asm volatile("s_waitcnt vmcnt(0)" ::: "memory");
        }
    }
    __syncthreads();
}

namespace pg8 {
constexpr int BM = 256, BK = 64, HALF = 128, HTB = HALF * BK * 2, STAGE_BYTES = 8 * HTB, NXCD = 8, WGM = 4;
__host__ __device__ __forceinline__ int lds_byte(int r, int c) { const int st = (r >> 4) * 2 + (c >> 5), rr = r & 15, cc = c & 31, ob = rr * 64 + cc * 2; return st * 1024 + (ob ^ (((ob >> 9) & 1) << 5)); }
__host__ __device__ __forceinline__ void stage_rc(int b, int& R, int& C) { const int st = b / 1024, sb = b % 1024, swz = sb ^ (((sb >> 9) & 1) << 5); R = (st >> 1) * 16 + swz / 64; C = (st & 1) * 32 + (swz % 64) / 2; }
__host__ __device__ __forceinline__ int perm32(int rho) { const int n = rho >> 4, i = rho & 15; return 8 * (i >> 2) + 4 * n + (i & 3); }
struct Unit { int pm, pn, kt0, nt, kp; };
struct Gemm { const bf16_t* A; const bf16_t* Bt; int M, N, K; const int* arow; const int* grp; size_t gstride; };
struct StaticOrder {
    int nM, nN, nwg, G, c, ntk;
    __host__ __device__ void init(int M, int N, int K, int G_, int c_) { nM = M / BM; nN = N / BM; nwg = nM * nN; G = G_; c = c_; ntk = K / BK; }
    __host__ __device__ bool next(int i, Unit& u) const {
        const long L = (long)i * G + c; if (L >= nwg) return false;
        int wgid = (int)L; { const int q = nwg / NXCD, r = nwg % NXCD, xcd = wgid % NXCD, off = wgid / NXCD; wgid = (xcd < r ? xcd * (q + 1) : r * (q + 1) + (xcd - r) * q) + off; }
        const int nig = WGM * nN, gid = wgid / nig, fm = gid * WGM, gsz = (nM - fm) < WGM ? (nM - fm) : WGM;
        u.pm = fm + ((wgid % nig) % gsz); u.pn = (wgid % nig) / gsz; u.kt0 = 0; u.nt = ntk; u.kp = 0; return true;
    }
};
struct ResOrder {
    StaticOrder S; int nlat, npieces, q0, q1, G, c;
    __host__ __device__ void init(int K, int G_, int c_, bool with_ctx) { S.init(ML, D, K, G_, c_); nlat = S.nwg; const int ntk = K / BK; q1 = (ntk / 8) * 2; q0 = (ntk - 2 * q1) / 2; npieces = with_ctx ? 2 * 4 * CTX_KP : 0; if (CTX_KP == 1) { q0 = ntk; q1 = 0; } G = G_; c = c_; }
    __host__ __device__ bool next(int i, Unit& u) const {
        const long L = (long)i * G + c; if (L < nlat) return S.next(i, u);
        const int idx = (int)(L - nlat); if (idx >= npieces) return false;
        const int kp = idx % CTX_KP, rest = idx / CTX_KP; u.kp = kp; u.kt0 = kp < 2 ? kp * q0 : 2 * q0 + (kp - 2) * q1; u.nt = kp < 2 ? q0 : q1; u.pn = rest & 3; u.pm = 128 + (rest >> 2); return true;
    }
};
struct MoeDownOrder {
    StaticOrder S; int nfull, ntail, G, c;
    __host__ __device__ void init(int ntiles, int G_, int c_) { const int pf = ntiles < 256 ? ntiles : 256; S.init(pf * BM, D, DEX, G_, c_); nfull = pf * 4; ntail = (ntiles - pf) * 16; G = G_; c = c_; }
    __host__ __device__ bool next(int i, Unit& u) const {
        const long L = (long)i * G + c; if (L < nfull) return S.next(i, u);
        const int idx = (int)(L - nfull); if (idx >= ntail) return false;
        u.kp = idx & 3; u.kt0 = 14 * (idx & 3); u.nt = 14; u.pn = (idx >> 2) & 3; u.pm = 256 + (idx >> 4); return true;
    }
};
__device__ __forceinline__ unsigned cvt_pk_bf16(float lo, float hi) { unsigned r; asm volatile("v_cvt_pk_bf16_f32 %0, %1, %2" : "=v"(r) : "v"(lo), "v"(hi)); return r; }
__device__ __forceinline__ f32x2 gelu_pk(f32x2 v) {
    const f32x2 av = __builtin_elementwise_abs(v), d = av * 0.2316418882f + 1.0f;
    f32x2 t; t.x = __builtin_amdgcn_rcpf(d.x); t.y = __builtin_amdgcn_rcpf(d.y);
    f32x2 q = t * 0.5307027145f + (-0.7265760135f); q = q * t + 0.7107068705f; q = q * t + (-0.142248368f); q = q * t + 0.127414796f; q = q * t;
    const f32x2 s = (v * v) * (-0.72134752044f);
    f32x2 e; e.x = __builtin_amdgcn_exp2f(s.x); e.y = __builtin_amdgcn_exp2f(s.y);
    const f32x2 m = v * (q * e), r = v - m;
    f32x2 o; o.x = v.x < 0.f ? m.x : r.x; o.y = v.y < 0.f ? m.y : r.y; return o;
}
template <class Epi, class Sched, bool ALIGN_EPI, bool GATHER>
__device__ __forceinline__ void gemm_phase(LAS unsigned char* lds, const Gemm g, const Sched& S, const Epi& E, const int tid) {
    const int wid = __builtin_amdgcn_readfirstlane(tid >> 6), lane = tid & 63, wr = wid >> 2, wc = wid & 3, fr = lane & 15, fq = lane >> 4;
    const int K = g.K;
    unsigned voffA[2], voffB[2];
    unsigned voffA1[2];
#pragma unroll
    for (int i = 0; i < 2; ++i) { int R, C; stage_rc(tid * 16 + i * 8192, R, C); const int Rb = Epi::PERM == 2 ? (64 * (R >> 5) + perm32(R & 31)) : Epi::PERM ? ((R & ~31) + perm32(R & 31)) : R;
        voffA[i] = (unsigned)(R * K + C) * 2u; voffA1[i] = voffA[i]; voffB[i] = (unsigned)(Rb * K + C) * 2u; }
    const size_t kstep = (size_t)(BK * 2);
    const size_t hstep = (size_t)HALF * K * 2;
    const size_t tstep = 2 * hstep;
    const size_t hstepB = Epi::PERM == 2 ? (size_t)32 * K * 2 : hstep;
    const unsigned ldsw = (unsigned)wid * 1024u;
    const int aoff = lds_byte(wr * 64 + fr, fq * 8), boff = lds_byte(wc * 32 + fr, fq * 8);
#define PG8_SA(b, h) (((b) * 2 + (h)) * HTB)
#define PG8_SB(b, h) ((4 + (b) * 2 + (h)) * HTB)
#define PG8_STAGE(bufoff, gbase, voff) do { _Pragma("unroll") for (int _i = 0; _i < 2; ++_i) \
        __builtin_amdgcn_global_load_lds((const unsigned*)((const char*)(gbase) + (voff)[_i]), (LAS unsigned*)(lds + (bufoff) + ldsw + _i * 8192), 16, 0, 0); } while (0)
#define PG8_LDA(dst, b, h) do { _Pragma("unroll") for (int m = 0; m < 4; ++m) _Pragma("unroll") for (int k = 0; k < 2; ++k) dst[m][k] = *(const LAS bf16x8*)(lds + PG8_SA(b, h) + aoff + m * 2048 + k * 1024); } while (0)
#define PG8_LDB(dst, b, h) do { _Pragma("unroll") for (int n = 0; n < 2; ++n) _Pragma("unroll") for (int k = 0; k < 2; ++k) dst[n][k] = *(const LAS bf16x8*)(lds + PG8_SB(b, h) + boff + n * 2048 + k * 1024); } while (0)
#define PG8_MMA(ai, bj, At, Bt) do { __builtin_amdgcn_s_setprio(1); _Pragma("unroll") for (int m = 0; m < 4; ++m) _Pragma("unroll") for (int n = 0; n < 2; ++n) _Pragma("unroll") for (int k = 0; k < 2; ++k) \
        acc[ai][bj][m][n] = __builtin_amdgcn_mfma_f32_16x16x32_bf16(Bt[n][k], At[m][k], acc[ai][bj][m][n], 0, 0, 0); __builtin_amdgcn_s_setprio(0); } while (0)
#define PG8_WAIT_V(n) asm volatile("s_waitcnt vmcnt(" #n ")" ::: "memory")
#define PG8_WAIT_L(n) asm volatile("s_waitcnt lgkmcnt(" #n ")" ::: "memory")
#define PG8_BAR __builtin_amdgcn_s_barrier()
#define PG8_SCHED __builtin_amdgcn_sched_barrier(0)
#define PG8_VA1 (GATHER ? voffA1 : voffA)
#define PG8_GOFF(u, v0, v1) do { _Pragma("unroll") for (int _i = 0; _i < 2; ++_i) { int R_, C_; stage_rc(tid * 16 + _i * 8192, R_, C_); \
        const int r0_ = g.arow[(u).pm * BM + R_], r1_ = g.arow[(u).pm * BM + HALF + R_]; v0[_i] = (unsigned)(r0_ * K + C_) * 2u; v1[_i] = (unsigned)(r1_ * K + C_) * 2u; } } while (0)
#define PG8_GROWS(u, q0, q1) do { _Pragma("unroll") for (int _i = 0; _i < 2; ++_i) { int R_, C_; stage_rc(tid * 16 + _i * 8192, R_, C_); q0[_i] = g.arow[(u).pm * BM + R_]; q1[_i] = g.arow[(u).pm * BM + HALF + R_]; } } while (0)
#define PG8_GOFFR(q0, q1, v0, v1) do { _Pragma("unroll") for (int _i = 0; _i < 2; ++_i) { int R_, C_; stage_rc(tid * 16 + _i * 8192, R_, C_); v0[_i] = (unsigned)(q0[_i] * K + C_) * 2u; v1[_i] = (unsigned)(q1[_i] * K + C_) * 2u; } } while (0)
#define PG8_BBASE(u) ((const char*)g.Bt + (g.grp ? (size_t)g.grp[(u).pm] * g.gstride * 2 : (size_t)0) + (size_t)(u).pn * tstep + (size_t)(u).kt0 * kstep)
    Unit cur, nxt; int ui = 0;
    if (!S.next(0, cur)) return;
    f32x4 acc[2][2][4][2];
#pragma unroll
    for (int a = 0; a < 2; ++a)
#pragma unroll
        for (int b = 0; b < 2; ++b)
#pragma unroll
            for (int m = 0; m < 4; ++m)
#pragma unroll
                for (int n = 0; n < 2; ++n) acc[a][b][m][n] = (f32x4){0.f, 0.f, 0.f, 0.f};
    bf16x8 At[4][2], B0[2][2], B1[2][2];
    const char* cA = (GATHER ? (const char*)g.A : (const char*)g.A + (size_t)cur.pm * tstep) + (size_t)cur.kt0 * kstep;
    const size_t ah = GATHER ? (size_t)0 : hstep;
    int gq0[2] = {0, 0}, gq1[2] = {0, 0};
    if constexpr (GATHER) { PG8_GOFF(cur, voffA, voffA1); Unit n1_; if (S.next(1, n1_)) PG8_GROWS(n1_, gq0, gq1); asm volatile("" : "+v"(gq0[0]), "+v"(gq0[1]), "+v"(gq1[0]), "+v"(gq1[1])); }
    const char* cB = PG8_BBASE(cur);
    PG8_STAGE(PG8_SB(0, 0), cB, voffB); PG8_STAGE(PG8_SA(0, 0), cA, voffA); PG8_STAGE(PG8_SB(0, 1), cB + hstepB, voffB); PG8_STAGE(PG8_SA(0, 1), cA + ah, PG8_VA1);
    if (wr == 1) PG8_BAR;
    PG8_WAIT_V(4); PG8_BAR;
    PG8_STAGE(PG8_SB(1, 0), cB + kstep, voffB); PG8_STAGE(PG8_SA(1, 0), cA + kstep, voffA); PG8_STAGE(PG8_SB(1, 1), cB + hstepB + kstep, voffB);
    PG8_WAIT_V(6); PG8_BAR;
    for (;;) {
        const bool has_next = S.next(ui + 1, nxt);
        const char* nA = !has_next ? cA : (GATHER ? (const char*)g.A : (const char*)g.A + (size_t)nxt.pm * tstep) + (size_t)nxt.kt0 * kstep; const char* nB = has_next ? PG8_BBASE(nxt) : cB;
        const int nt = cur.nt;
        for (int t = 0; t < nt; t += 2) {
            const bool last = (t == nt - 2);
            const char* a1 = cA + (size_t)(t + 1) * kstep;
            const char* a2 = last ? nA : cA + (size_t)(t + 2) * kstep; const char* b2 = last ? nB : cB + (size_t)(t + 2) * kstep;
            const char* a3 = a2 + kstep; const char* b3 = b2 + kstep;
            PG8_LDB(B0, 0, 0); PG8_SCHED; PG8_LDA(At, 0, 0); PG8_STAGE(PG8_SA(1, 1), a1 + ah, PG8_VA1);
            if constexpr (GATHER) { if (last && has_next) PG8_GOFFR(gq0, gq1, voffA, voffA1); }
            PG8_WAIT_L(8); PG8_BAR; PG8_WAIT_L(0); PG8_MMA(0, 0, At, B0); PG8_BAR; PG8_SCHED;
            PG8_LDB(B1, 0, 1); PG8_STAGE(PG8_SB(0, 0), b2, voffB);
            PG8_BAR; PG8_WAIT_L(0); PG8_MMA(0, 1, At, B1); PG8_BAR;
            PG8_LDA(At, 0, 1); PG8_STAGE(PG8_SA(0, 0), a2, voffA);
            PG8_BAR; PG8_WAIT_L(0); PG8_MMA(1, 0, At, B0); PG8_BAR; PG8_SCHED;
            PG8_STAGE(PG8_SB(0, 1), b2 + hstepB, voffB);
            PG8_WAIT_V(6); PG8_BAR; PG8_MMA(1, 1, At, B1); PG8_BAR;
            PG8_LDB(B0, 1, 0); PG8_SCHED; PG8_LDA(At, 1, 0); PG8_STAGE(PG8_SA(0, 1), a2 + ah, PG8_VA1);
            PG8_WAIT_L(8); PG8_BAR; PG8_WAIT_L(0); PG8_MMA(0, 0, At, B0); PG8_BAR; PG8_SCHED;
            PG8_LDB(B1, 1, 1); PG8_STAGE(PG8_SB(1, 0), b3, voffB);
            PG8_BAR; PG8_WAIT_L(0); PG8_MMA(0, 1, At, B1); PG8_BAR;
            PG8_LDA(At, 1, 1); PG8_STAGE(PG8_SA(1, 0), a3, voffA);
            PG8_BAR; PG8_WAIT_L(0); PG8_MMA(1, 0, At, B0); PG8_BAR; PG8_SCHED;
            PG8_STAGE(PG8_SB(1, 1), b3 + hstepB, voffB);
            PG8_WAIT_V(6); PG8_BAR; PG8_MMA(1, 1, At, B1); PG8_BAR;
        }
        if constexpr (ALIGN_EPI) { if (wr == 0) PG8_BAR; }
        int gt0[2] = {0, 0}, gt1[2] = {0, 0};
        if constexpr (GATHER) { Unit n2_; if (S.next(ui + 2, n2_)) PG8_GROWS(n2_, gt0, gt1); }
        E(acc, cur, wr, wc, fr, fq);
        if constexpr (GATHER) { asm volatile("" : "+v"(gt0[0]), "+v"(gt0[1]), "+v"(gt1[0]), "+v"(gt1[1])); gq0[0] = gt0[0]; gq0[1] = gt0[1]; gq1[0] = gt1[0]; gq1[1] = gt1[1]; }
        if (!has_next) break;
#pragma unroll
        for (int a = 0; a < 2; ++a)
#pragma unroll
            for (int b = 0; b < 2; ++b)
#pragma unroll
                for (int m = 0; m < 4; ++m)
#pragma unroll
                    for (int n = 0; n < 2; ++n) acc[a][b][m][n] = (f32x4){0.f, 0.f, 0.f, 0.f};
        cur = nxt; cA = nA; cB = nB; ++ui;
        if constexpr (ALIGN_EPI) { if (wr == 1) PG8_BAR; }
    }
    PG8_WAIT_V(0);
    if constexpr (!ALIGN_EPI) { if (wr == 0) PG8_BAR; }
    PG8_BAR;
#undef PG8_SA
#undef PG8_SB
#undef PG8_STAGE
#undef PG8_LDA
#undef PG8_LDB
#undef PG8_MMA
#undef PG8_WAIT_V
#undef PG8_WAIT_L
#undef PG8_BAR
#undef PG8_SCHED
#undef PG8_VA1
#undef PG8_GOFF
#undef PG8_GROWS
#undef PG8_GOFFR
#undef PG8_BBASE
}

struct EpiEvenIn {
    static constexpr bool PERM = true;
    bf16_t* O;
    template <bool ACT> __device__ __forceinline__ void run(const f32x4 (&acc)[2][2][4][2], const Unit& u, int wr, int wc, int fr, int fq) const {
        const int row0 = u.pm * BM + wr * 64 + fr, col0 = u.pn * BM + wc * 32 + 8 * fq;
#pragma unroll
        for (int ai = 0; ai < 2; ++ai)
#pragma unroll
            for (int m = 0; m < 4; ++m) { bf16_t* rowp = O + (size_t)(row0 + ai * HALF + m * 16) * NEIN + col0;
#pragma unroll
                for (int bj = 0; bj < 2; ++bj) { f32x4 v0 = acc[ai][bj][m][0], v1 = acc[ai][bj][m][1];
                    if (ACT) { f32x2 a = gelu_pk((f32x2){v0[0], v0[1]}), b = gelu_pk((f32x2){v0[2], v0[3]}), c = gelu_pk((f32x2){v1[0], v1[1]}), d = gelu_pk((f32x2){v1[2], v1[3]});
                        v0 = (f32x4){a.x, a.y, b.x, b.y}; v1 = (f32x4){c.x, c.y, d.x, d.y}; }
                    u32x4 w; w.x = cvt_pk_bf16(v0[0], v0[1]); w.y = cvt_pk_bf16(v0[2], v0[3]); w.z = cvt_pk_bf16(v1[0], v1[1]); w.w = cvt_pk_bf16(v1[2], v1[3]);
                    *(u32x4*)(rowp + bj * HALF) = w; } }
    }
    __device__ __forceinline__ void operator()(const f32x4 (&acc)[2][2][4][2], const Unit& u, int wr, int wc, int fr, int fq) const {
        if (u.pn >= 4) run<true>(acc, u, wr, wc, fr, fq); else run<false>(acc, u, wr, wc, fr, fq);
    }
};
template <bool SRC_F32> struct EpiRes {
    static constexpr bool PERM = true;
    const float* sl32; bf16_t* xb; const float* gate; float* part;
    __device__ __forceinline__ void operator()(const f32x4 (&acc)[2][2][4][2], const Unit& u, int wr, int wc, int fr, int fq) const {
        const int col0 = u.pn * BM + wc * 32 + 8 * fq;
        typedef __attribute__((address_space(1))) const char gcc_t; typedef __attribute__((address_space(1))) char gc_t;
        if (u.pm >= 128) {
            gc_t* dst = (gc_t*)(part + ((size_t)u.kp * MC + (size_t)(u.pm - 128) * BM) * D);
#pragma unroll
            for (int ai = 0; ai < 2; ++ai)
#pragma unroll
                for (int m = 0; m < 4; ++m) { const unsigned off = (unsigned)((ai * HALF + wr * 64 + m * 16 + fr) * D + col0) * 4u;
#pragma unroll
                    for (int bj = 0; bj < 2; ++bj) { *(__attribute__((address_space(1))) f32x4*)(dst + off + (unsigned)(bj * HALF) * 4u) = acc[ai][bj][m][0]; *(__attribute__((address_space(1))) f32x4*)(dst + off + (unsigned)(bj * HALF + 4) * 4u) = acc[ai][bj][m][1]; } }
            return;
        }
        const int ms = u.pm >= 64 ? 1 : 0;
        const size_t rbase = (size_t)u.pm * BM;
        gcc_t* src32 = (gcc_t*)(sl32 + rbase * D); gc_t* xbp = (gc_t*)(xb + rbase * D); gcc_t* gp = (gcc_t*)(gate + ms * 6144);
        f32x4 gv[2][2];
#pragma unroll
        for (int bj = 0; bj < 2; ++bj)
#pragma unroll
            for (int n = 0; n < 2; ++n) gv[bj][n] = *(__attribute__((address_space(1))) const f32x4*)(gp + (unsigned)(col0 + bj * HALF + 4 * n) * 4u);
        if (SRC_F32) {
#pragma unroll
            for (int ai = 0; ai < 2; ++ai)
#pragma unroll
                for (int mh = 0; mh < 2; ++mh) {
                    f32x4 xr[2][2][2];
#pragma unroll
                    for (int mm = 0; mm < 2; ++mm) { const unsigned eo = (unsigned)((ai * HALF + wr * 64 + (2 * mh + mm) * 16 + fr) * D + col0);
#pragma unroll
                        for (int bj = 0; bj < 2; ++bj) { xr[mm][bj][0] = *(__attribute__((address_space(1))) const f32x4*)(src32 + (eo + bj * HALF) * 4u); xr[mm][bj][1] = *(__attribute__((address_space(1))) const f32x4*)(src32 + (eo + bj * HALF + 4) * 4u); } }
                    __builtin_amdgcn_sched_barrier(0);
#pragma unroll
                    for (int mm = 0; mm < 2; ++mm) { const int m = 2 * mh + mm; const unsigned eo = (unsigned)((ai * HALF + wr * 64 + m * 16 + fr) * D + col0);
#pragma unroll
                        for (int bj = 0; bj < 2; ++bj) { const f32x4 y0 = xr[mm][bj][0] + gv[bj][0] * acc[ai][bj][m][0], y1 = xr[mm][bj][1] + gv[bj][1] * acc[ai][bj][m][1];
                            u32x4 w; w.x = cvt_pk_bf16(y0[0], y0[1]); w.y = cvt_pk_bf16(y0[2], y0[3]); w.z = cvt_pk_bf16(y1[0], y1[1]); w.w = cvt_pk_bf16(y1[2], y1[3]);
                            *(__attribute__((address_space(1))) u32x4*)(xbp + (eo + bj * HALF) * 2u) = w; } }
                    __builtin_amdgcn_sched_barrier(0);
                }
        } else {
#pragma unroll
            for (int ai = 0; ai < 2; ++ai) {
                u32x4 raw[4][2];
#pragma unroll
                for (int m = 0; m < 4; ++m) { const unsigned eo = (unsigned)((ai * HALF + wr * 64 + m * 16 + fr) * D + col0);
#pragma unroll
                    for (int bj = 0; bj < 2; ++bj) raw[m][bj] = *(__attribute__((address_space(1))) const u32x4*)(xbp + (eo + bj * HALF) * 2u); }
                __builtin_amdgcn_sched_barrier(0);
#pragma unroll
                for (int m = 0; m < 4; ++m) { const unsigned eo = (unsigned)((ai * HALF + wr * 64 + m * 16 + fr) * D + col0);
#pragma unroll
                    for (int bj = 0; bj < 2; ++bj) { const u32x4 r = raw[m][bj];
                        const f32x4 x0 = (f32x4){bflo(r.x), bfhi(r.x), bflo(r.y), bfhi(r.y)}, x1 = (f32x4){bflo(r.z), bfhi(r.z), bflo(r.w), bfhi(r.w)};
                        const f32x4 y0 = x0 + gv[bj][0] * acc[ai][bj][m][0], y1 = x1 + gv[bj][1] * acc[ai][bj][m][1];
                        u32x4 w; w.x = cvt_pk_bf16(y0[0], y0[1]); w.y = cvt_pk_bf16(y0[2], y0[3]); w.z = cvt_pk_bf16(y1[0], y1[1]); w.w = cvt_pk_bf16(y1[2], y1[3]);
                        *(__attribute__((address_space(1))) u32x4*)(xbp + (eo + bj * HALF) * 2u) = w; } }
                __builtin_amdgcn_sched_barrier(0);
            }
        }
    }
};
struct EpiSwiglu {
    static constexpr bool PERM = true;
    bf16_t* O; int ldc;
    __device__ __forceinline__ void operator()(const f32x4 (&acc)[2][2][4][2], const Unit& u, int wr, int wc, int fr, int fq) const {
        const int row0 = u.pm * BM + wr * 64 + fr, col0 = u.pn * 128 + wc * 32 + 8 * fq;
#pragma unroll
        for (int ai = 0; ai < 2; ++ai)
#pragma unroll
            for (int m = 0; m < 4; ++m) { bf16_t* rowp = O + (size_t)(row0 + ai * HALF + m * 16) * ldc + col0;
                float y[8];
#pragma unroll
                for (int n = 0; n < 2; ++n)
#pragma unroll
                    for (int i = 0; i < 4; ++i) { const float a = acc[ai][0][m][n][i], b = acc[ai][1][m][n][i]; y[4 * n + i] = (a * b) * __builtin_amdgcn_rcpf(1.0f + __builtin_amdgcn_exp2f(a * -1.44269504089f)); }
                u32x4 w; w.x = cvt_pk_bf16(y[0], y[1]); w.y = cvt_pk_bf16(y[2], y[3]); w.z = cvt_pk_bf16(y[4], y[5]); w.w = cvt_pk_bf16(y[6], y[7]);
                *(u32x4*)rowp = w;
                if (m & 1) __builtin_amdgcn_sched_barrier(0); }
    }
};
struct EpiOddIn {
    static constexpr int PERM = 2;
    bf16_t* O; const float* lb;
    template <int MODE> __device__ __forceinline__ void run(const f32x4 (&acc)[2][2][4][2], const Unit& u, int wr, int wc, int fr, int fq, float c) const {
        const int row0 = u.pm * BM + wr * 64 + fr, col0 = u.pn * BM + wc * 64 + 8 * fq; const int seg = u.pn >> 2;
        f32x4 lbv[2][2];
        if (MODE == 1) {
#pragma unroll
            for (int bj = 0; bj < 2; ++bj)
#pragma unroll
                for (int n = 0; n < 2; ++n) lbv[bj][n] = *(const f32x4*)(lb + (col0 - 2048) + bj * 32 + 4 * n); }
#pragma unroll
        for (int ai = 0; ai < 2; ++ai)
#pragma unroll
            for (int m = 0; m < 4; ++m) { bf16_t* rowp = O + ((size_t)((u.pn & 3) * 2 + (wc >> 1)) * MT + (size_t)(row0 + ai * HALF + m * 16)) * 640 + seg * 128 + (wc & 1) * 64 + 8 * fq;
#pragma unroll
                for (int bj = 0; bj < 2; ++bj) { f32x4 v[2] = {acc[ai][bj][m][0], acc[ai][bj][m][1]};
#pragma unroll
                    for (int n = 0; n < 2; ++n)
#pragma unroll
                        for (int i = 0; i < 4; ++i) { float x = v[n][i];
                            if (MODE == 0) x = (x * c) * __builtin_amdgcn_rcpf(1.0f + __builtin_amdgcn_exp2f(x * -1.44269504089f));
                            else if (MODE == 1) { const float l = lbv[bj][n][i]; const float s = __builtin_amdgcn_rcpf(1.0f + __builtin_amdgcn_exp2f(x * -1.44269504089f)); const float f = l + (1.0f - l) * s; x = __builtin_amdgcn_logf(fmaxf(f, 1e-30f)) * 0.69314718056f; }
                            v[n][i] = x; }
                    u32x4 w; w.x = cvt_pk_bf16(v[0][0], v[0][1]); w.y = cvt_pk_bf16(v[0][2], v[0][3]); w.z = cvt_pk_bf16(v[1][0], v[1][1]); w.w = cvt_pk_bf16(v[1][2], v[1][3]);
                    *(u32x4*)(rowp + bj * 32) = w; } }
    }
    __device__ __forceinline__ void operator()(const f32x4 (&acc)[2][2][4][2], const Unit& u, int wr, int wc, int fr, int fq) const {
        const int seg = u.pn >> 2;
        if (seg == 0) run<0>(acc, u, wr, wc, fr, fq, 0.08838834764831845f);
        else if (seg == 1) run<0>(acc, u, wr, wc, fr, fq, 1.0f);
        else if (seg == 4) run<2>(acc, u, wr, wc, fr, fq, 1.0f);
        else run<1>(acc, u, wr, wc, fr, fq, 1.0f);
    }
};
struct EpiNull { static constexpr bool PERM = true; float* sink;
    __device__ __forceinline__ void operator()(const f32x4 (&acc)[2][2][4][2], const Unit& u, int wr, int wc, int fr, int fq) const {
        float s = 0.f;
#pragma unroll
        for (int ai = 0; ai < 2; ++ai)
#pragma unroll
            for (int bj = 0; bj < 2; ++bj)
#pragma unroll
                for (int m = 0; m < 4; ++m)
#pragma unroll
                    for (int n = 0; n < 2; ++n) s += acc[ai][bj][m][n][0] + acc[ai][bj][m][n][1] + acc[ai][bj][m][n][2] + acc[ai][bj][m][n][3];
        if (s == 123.456f) sink[0] = s; } };
struct EpiMoeDown {
    static constexpr bool PERM = true;
    bf16_t* O; const int* dst; float* partm;
    __device__ __forceinline__ void operator()(const f32x4 (&acc)[2][2][4][2], const Unit& u, int wr, int wc, int fr, int fq) const {
        const int row0 = u.pm * BM + wr * 64 + fr, col0 = u.pn * BM + wc * 32 + 8 * fq;
        if (u.pm >= 256) {
            float* base = partm + ((size_t)u.kp * 3072 + (size_t)(row0 - 65536)) * D + col0;
#pragma unroll
            for (int ai = 0; ai < 2; ++ai)
#pragma unroll
                for (int m = 0; m < 4; ++m) { float* rowp = base + (size_t)(ai * HALF + m * 16) * D;
#pragma unroll
                    for (int bj = 0; bj < 2; ++bj) { *(f32x4*)(rowp + bj * HALF) = acc[ai][bj][m][0]; *(f32x4*)(rowp + bj * HALF + 4) = acc[ai][bj][m][1]; } }
            return;
        }
        bf16_t* base = O + (size_t)row0 * D + col0;
#pragma unroll
        for (int ai = 0; ai < 2; ++ai)
#pragma unroll
            for (int m = 0; m < 4; ++m) { bf16_t* rowp = base + (size_t)(ai * HALF + m * 16) * D;
#pragma unroll
                for (int bj = 0; bj < 2; ++bj) { const f32x4 v0 = acc[ai][bj][m][0], v1 = acc[ai][bj][m][1];
                    u32x4 w; w.x = cvt_pk_bf16(v0[0], v0[1]); w.y = cvt_pk_bf16(v0[2], v0[3]); w.z = cvt_pk_bf16(v1[0], v1[1]); w.w = cvt_pk_bf16(v1[2], v1[3]);
                    *(u32x4*)(rowp + bj * HALF) = w; } }
    }
};
}

struct Args { const float* in[24]; float* out; unsigned char* ws; int ph_lo, ph_hi; };
enum { I_X = 0, I_C, I_CTX, I_CCTX, I_WADA, I_BADA, I_NMIX, I_NFFN, I_NOUT, I_WINE, I_GW, I_GB, I_WOUTE, I_WINO, I_RLB, I_RNORM, I_WOUTO, I_F1, I_F3, I_F2, I_RW, I_M1, I_M3, I_M2 };
enum { PH_P0 = 0, PH_PAIR0 = 1, NPL = 18, PH_FINAL = 1 + 2 * NPL, NPHASE = PH_FINAL + 1 };
enum { E1_NORM = 0, E2_GIN, E3_FFTA, E3_FFTC, E4_GOUT, E5_NORM, E6_UP, E7_DOWN, O1_NORM, O2_GIN, O3_SCAN1, O4_CARRY, O5_SCAN3, O6_GOUT, O7_NORM, O8_SLOTS, O9_MUP, O10_MDOWN };

#define LAUNDER_WS_OUT(extra_) do { auto w_ = (__attribute__((address_space(1))) unsigned char*)F.ws; auto o_ = (__attribute__((address_space(1))) float*)F.out; \
        asm volatile("" : "+s"(w_), "+s"(o_) extra_); F.ws = (unsigned char*)w_; F.out = (float*)o_; } while (0)
#define FIN(i) (F.in[i])
struct Ctx {
    LAS unsigned char* lds; int tid, lane, wave, G, bid, gw, NGW;
    const float* const* in; float* out; unsigned char* ws;
};

__device__ __forceinline__ void transpose_item(const float* W, int ld, int K, int N, bf16_t* WT, int mode, int roff, int item, int lane) {
    const int nblk = N / 64, kb = item / nblk, nb = item % nblk, k0 = 64 * kb, n0 = 64 * nb;
    const int c = lane & 15, kg = lane >> 4;
    const float* src = W + (size_t)(k0 + 8 * kg) * ld + n0 + 4 * c;
    f32x4 v[2][8];
#pragma unroll
    for (int hf = 0; hf < 2; ++hf)
#pragma unroll
        for (int i = 0; i < 8; ++i) v[hf][i] = __builtin_nontemporal_load((const f32x4*)(src + (size_t)(32 * hf + i) * ld));
    __builtin_amdgcn_sched_barrier(0);
#pragma unroll
    for (int i = 0; i < 4; ++i) { const int ng = n0 + 4 * c + i; const int drow = mode == 0 ? (roff + ng) : (((ng >> 7) << 8) + (ng & 127) + roff);
#pragma unroll
        for (int hf = 0; hf < 2; ++hf) { u32x4 o; o.x = pk2(v[hf][0][i], v[hf][1][i]); o.y = pk2(v[hf][2][i], v[hf][3][i]); o.z = pk2(v[hf][4][i], v[hf][5][i]); o.w = pk2(v[hf][6][i], v[hf][7][i]);
            *(u32x4*)(WT + (size_t)drow * K + k0 + 32 * hf + 8 * kg) = o; } }
}

__device__ __forceinline__ void p0_prologue(const Ctx& F) {
    const int tid = F.tid, lane = F.lane, wave = F.wave;
    unsigned char* ws = F.ws;
    LAS float* scond = (LAS float*)(F.lds);
    LAS float* part = (LAS float*)(F.lds + 16384);
    LAS float* ctab = (LAS float*)(F.lds + 32768);
    for (int i = tid; i < 3 * D; i += 512) { const int v = i / D, k = i % D; const float c = v < 2 ? FIN(I_C)[v * D + k] : FIN(I_CCTX)[k]; scond[i] = c / (1.0f + expf(-c)); }
    if (tid < 128) ctab[tid] = cosf(6.283185307179586f * (float)tid / 128.0f);
    __syncthreads();
    float* mods = (float*)(ws + WS_MODS);
    if (P0_MASK & 1)
    for (int it = F.bid; it < 4 * 48; it += F.G) {
        const int l = it / 48, cg = it % 48; const float* W = FIN(I_WADA) + (size_t)l * D * 6144 + cg * 128 + 2 * lane;
        float a0[2] = {0.f, 0.f}, a1[2] = {0.f, 0.f}, a2[2] = {0.f, 0.f};
#pragma unroll 16
        for (int kk = 0; kk < 128; ++kk) { const int k = wave * 128 + kk; const f32x2 w = __builtin_nontemporal_load((const f32x2*)(W + (size_t)k * 6144)); const float s0 = scond[k], s1 = scond[D + k], s2 = scond[2 * D + k];
            a0[0] += s0 * w.x; a0[1] += s0 * w.y; a1[0] += s1 * w.x; a1[1] += s1 * w.y; a2[0] += s2 * w.x; a2[1] += s2 * w.y; }
        part[(wave * 3 + 0) * 128 + 2 * lane] = a0[0]; part[(wave * 3 + 0) * 128 + 2 * lane + 1] = a0[1];
        part[(wave * 3 + 1) * 128 + 2 * lane] = a1[0]; part[(wave * 3 + 1) * 128 + 2 * lane + 1] = a1[1];
        part[(wave * 3 + 2) * 128 + 2 * lane] = a2[0]; part[(wave * 3 + 2) * 128 + 2 * lane + 1] = a2[1];
        __syncthreads();
        if (tid < 384) { const int v = tid / 128, c = tid % 128; float sum = 0.f;
#pragma unroll
            for (int w = 0; w < 8; ++w) sum += part[(w * 3 + v) * 128 + c];
            mods[((size_t)l * 3 + v) * 6144 + cg * 128 + c] = sum + FIN(I_BADA)[l * 6144 + cg * 128 + c]; }
        __syncthreads();
    }
    const int gt = F.bid * 512 + tid, NGT = F.G * 512;
    float* LB = (float*)(ws + WS_LB);
    if (P0_MASK & 2)
    for (int i = gt; i < 4096; i += NGT) { const int j = i >> 11, r = i & 2047; float v = 0.f; if (j == 1) { const float r0 = FIN(I_RLB)[r], r1 = FIN(I_RLB)[2048 + r]; v = 1.0f / (1.0f + expf(r0 - r1)); v = fminf(fmaxf(v, 0.f), 1.f); } LB[i] = v; }
    bf16_t* FA = (bf16_t*)(ws + WS_FA); bf16_t* FC = (bf16_t*)(ws + WS_FC); bf16_t* FX = (bf16_t*)(ws + WS_FX); bf16_t* GW = (bf16_t*)(ws + WS_GW);
    if (P0_MASK & 4)
    for (int i = gt; i < 256 * 256; i += NGT) { const int r = i >> 8, c = i & 255, k1 = r & 127, t1 = c & 127; const float ang = 6.283185307179586f * (float)((k1 * t1) & 127) / 128.0f; float sn, cs; sincosf(ang, &sn, &cs);
        const int rr = r >> 7, cc = c >> 7; const float v = (rr == cc) ? cs : (rr == 0 ? -sn : sn); FA[i] = (bf16_t)f2bf(v); }
    if (P0_MASK & 4)
    for (int i = gt; i < 128 * 256; i += NGT) { const int k2 = i >> 8, c = i & 255, t2 = c & 127; const float ang = 6.283185307179586f * (float)((k2 * t2) & 127) / 128.0f; float sn, cs; sincosf(ang, &sn, &cs); FC[i] = (bf16_t)f2bf(c < 128 ? cs : -sn); }
    if (P0_MASK & 4)
    for (int i = gt; i < 256 * 512; i += NGT) { const int k = i >> 9, c = i & 511, t = c & 255; const float ang = 6.283185307179586f * (float)((k * t) & 255) / 256.0f; float sn, cs; sincosf(ang, &sn, &cs); FX[i] = (bf16_t)f2bf(c < 256 ? cs : -sn); }
    if (P0_MASK & 8)
    for (int i = gt; i < 2 * 4 * 128 * 128; i += NGT) GW[i] = (bf16_t)f2bf(FIN(I_GW)[i]);
    bf16_t* WinE = (bf16_t*)(ws + WS_WINE);
    if (P0_MASK & 16)
    for (int it = F.gw; it < 2 * 4 * 16 * 32; it += F.NGW) {
        const int mg = it & 31, kb = (it >> 5) & 15, g = (it >> 9) & 3, j = it >> 11; const int k = kb * 64 + lane, m0 = mg * 4;
        const float* Wr = FIN(I_WINE) + (size_t)j * D * 1536 + (size_t)k * 1536 + g * 128;
        float aP[4] = {0.f, 0.f, 0.f, 0.f}, aQ[4] = {0.f, 0.f, 0.f, 0.f};
        f32x4 wq_[32];
#pragma unroll
        for (int c4 = 0; c4 < 32; ++c4) wq_[c4] = *(const f32x4*)(Wr + 4 * c4);
        __builtin_amdgcn_sched_barrier(0);
#pragma unroll
        for (int c4 = 0; c4 < 32; ++c4) { const f32x4 w = wq_[c4];
#pragma unroll
            for (int ci = 0; ci < 4; ++ci) { const int c = 4 * c4 + ci;
#pragma unroll
                for (int mm = 0; mm < 4; ++mm) { const int idx = (c * (m0 + mm)) & 127; aP[mm] += w[ci] * ctab[idx]; aQ[mm] += w[ci] * ctab[(idx - 32) & 127]; } } }
#pragma unroll
        for (int mm = 0; mm < 4; ++mm) { bf16_t* o = WinE + (size_t)j * NEIN * D; o[(size_t)(g * 128 + m0 + mm) * D + k] = (bf16_t)f2bf(aP[mm]); o[(size_t)(512 + g * 128 + m0 + mm) * D + k] = (bf16_t)f2bf(aQ[mm]); }
    }
    constexpr int NI_UV = 16 * 16, NI_SQ = 16 * 16, NI_INO = 16 * 80, NI_F13 = 16 * 44, NI_F2 = 44 * 16;
    constexpr int PER_J = NI_UV + NI_SQ + NI_INO + NI_SQ + 2 * NI_F13 + NI_F2;
    if (P0_MASK & 32)
    for (int it = F.gw; it < 2 * PER_J; it += F.NGW) {
        const int j = it / PER_J; int r = it % PER_J;
        const float* W; int ld, K, N, mode = 0, roff = 0; bf16_t* WT;
        if (r < NI_UV) { W = FIN(I_WINE) + (size_t)j * D * 1536 + 512; ld = 1536; K = D; N = 1024; WT = WinE + (size_t)j * NEIN * D; roff = 1024; }
        else if ((r -= NI_UV) < NI_SQ) { W = FIN(I_WOUTE) + (size_t)j * D * D; ld = D; K = D; N = D; WT = (bf16_t*)(ws + WS_WOUTE) + (size_t)j * D * D; }
        else if ((r -= NI_SQ) < NI_INO) { W = FIN(I_WINO) + (size_t)j * D * NREC; ld = NREC; K = D; N = NREC; WT = (bf16_t*)(ws + WS_WINO) + (size_t)j * NREC * D; }
        else if ((r -= NI_INO) < NI_SQ) { W = FIN(I_WOUTO) + (size_t)j * D * D; ld = D; K = D; N = D; WT = (bf16_t*)(ws + WS_WOUTO) + (size_t)j * D * D; }
        else if ((r -= NI_SQ) < NI_F13) { W = FIN(I_F1) + (size_t)j * D * DFF; ld = DFF; K = D; N = DFF; WT = (bf16_t*)(ws + WS_W13) + (size_t)j * NFF2 * D; mode = 1; }
        else if ((r -= NI_F13) < NI_F13) { W = FIN(I_F3) + (size_t)j * D * DFF; ld = DFF; K = D; N = DFF; WT = (bf16_t*)(ws + WS_W13) + (size_t)j * NFF2 * D; mode = 1; roff = 128; }
        else { r -= NI_F13; W = FIN(I_F2) + (size_t)j * DFF * D; ld = D; K = DFF; N = D; WT = (bf16_t*)(ws + WS_W2) + (size_t)j * D * DFF; }
        transpose_item(W, ld, K, N, WT, mode, roff, r, lane);
    }
}
constexpr int MOE_CONV_ITEMS = NE * (2 * 16 * 56 + 56 * 16);
__device__ __forceinline__ void moe_convert_item(const Ctx& F, int j, int it) {
    constexpr int I_13 = 16 * 56, I_2 = 56 * 16, PER_E = 2 * I_13 + I_2;
    const int e = it / PER_E; int r = it % PER_E; const size_t eo = (size_t)(j * NE + e);
    const float* W; int ld, K, N, mode = 0, roff = 0; bf16_t* WT;
    if (r < I_13) { W = FIN(I_M1) + eo * D * DEX; ld = DEX; K = D; N = DEX; WT = (bf16_t*)(F.ws + WS_W13M) + (size_t)e * NEX2 * D; mode = 1; }
    else if ((r -= I_13) < I_13) { W = FIN(I_M3) + eo * D * DEX; ld = DEX; K = D; N = DEX; WT = (bf16_t*)(F.ws + WS_W13M) + (size_t)e * NEX2 * D; mode = 1; roff = 128; }
    else { r -= I_13; W = FIN(I_M2) + eo * DEX * D; ld = D; K = DEX; N = D; WT = (bf16_t*)(F.ws + WS_W2M) + (size_t)e * D * DEX; }
    transpose_item(W, ld, K, N, WT, mode, roff, r, F.lane);
}

struct RowPass {
    const float* sl; const float* sc;
    bf16_t* xb;
    const float* gain;
    const float* shift; const float* scale;
    bf16_t* H;
    int nrows;
    const bf16_t* YE; const float* topp; const float* gatef;
    const float* rw; int* tope; float* toppo; int* rank; int* cnt;
    float* fout;
    const float* part; int kpn; const float* pgate; const float* csrc32;
    const int* slotof; const float* partm;
};
struct RowPart { int WB, WC; };
__device__ __forceinline__ RowPart row_part(int NW, int nrows) { RowPart q; q.WC = nrows > ML ? NW / 32 : 0; q.WB = (NW - q.WC) / 2; return q; }
__device__ __forceinline__ void row_chunk(const RowPart& q, int gw, int& r0, int& r1) {
    if (gw < 2 * q.WB) { const int b = gw / q.WB, i = gw % q.WB; r0 = b * TL + (int)(((long)i * TL) / q.WB); r1 = b * TL + (int)(((long)(i + 1) * TL) / q.WB); }
    else { const int i = gw - 2 * q.WB; r0 = ML + (i * MC) / q.WC; r1 = ML + ((i + 1) * MC) / q.WC; }
}
__device__ __forceinline__ int row_chunk_of(const RowPart& q, int r) {
    if (r < ML) { const int b = r >> 14, lr = r & (TL - 1); return b * q.WB + (int)(((long)q.WB * (lr + 1) - 1) / TL); }
    return 2 * q.WB + ((r - ML + 1) * q.WC - 1) / MC;
}
__device__ __forceinline__ f32x4 bf4(u32x2 r) { return (f32x4){bflo(r.x), bfhi(r.x), bflo(r.y), bfhi(r.y)}; }
template <bool COMBINE, bool ROUTER, bool FINAL, bool SRCB>
__device__ __forceinline__ void row_pass(const Ctx& F, const RowPass& P) {
    const int lane = F.lane;
    f32x4 rwr[16][2];
    if (ROUTER) {
#pragma unroll
        for (int j = 0; j < 4; ++j)
#pragma unroll
            for (int i = 0; i < 4; ++i) { const int col = 4 * lane + 256 * j + i; rwr[4 * j + i][0] = *(const f32x4*)(P.rw + col * 8); rwr[4 * j + i][1] = *(const f32x4*)(P.rw + col * 8 + 4); } }
    f32x4 gn[4];
#pragma unroll
    for (int j = 0; j < 4; ++j) gn[j] = *(const f32x4*)(P.gain + 4 * lane + 256 * j);
    const RowPart rp = row_part(F.NGW, P.nrows);
    int r0, r1; row_chunk(rp, F.gw, r0, r1);
    {
        int rc0 = 0, rc1 = 0, rc2 = 0, rc3 = 0, rc4 = 0, rc5 = 0, rc6 = 0, rc7 = 0;
        const bool isc = r0 >= ML; const int ms = isc ? 2 : (r0 >= TL ? 1 : 0);
        const float* xs32 = SRCB ? nullptr : (isc ? P.sc + (size_t)(r0 - ML) * D : P.sl + (size_t)r0 * D);
        bf16_t* xb0 = P.xb + (size_t)r0 * D;
        if (SRCB && !COMBINE && !FINAL) { if (isc && P.part) {
            const float* c32 = P.csrc32 ? P.csrc32 + (size_t)(r0 - ML) * D : nullptr;
#pragma unroll 1
            for (int rr = 0; rr < r1 - r0; ++rr) {
#pragma unroll 2
                for (int j = 0; j < 4; ++j) { f32x4 a[4];
#pragma unroll
                    for (int kp = 0; kp < 4; ++kp) a[kp] = kp < P.kpn ? *(const f32x4*)(P.part + ((size_t)kp * MC + (size_t)(r0 - ML + rr)) * D + 4 * lane + 256 * j) : (f32x4){0.f, 0.f, 0.f, 0.f};
                    const f32x4 x0 = c32 ? *(const f32x4*)(c32 + (size_t)rr * D + 4 * lane + 256 * j) : bf4(*(const u32x2*)(xb0 + (size_t)rr * D + 4 * lane + 256 * j));
                    const f32x4 y = x0 + *(const f32x4*)(P.pgate + 2 * 6144 + 4 * lane + 256 * j) * ((a[0] + a[1]) + (a[2] + a[3]));
                    u32x2 w; w.x = pk2(y[0], y[1]); w.y = pk2(y[2], y[3]); *(u32x2*)(xb0 + (size_t)rr * D + 4 * lane + 256 * j) = w; } }
            asm volatile("s_waitcnt vmcnt(0)" ::: "memory"); } }
        f32x4 sh[4], scl[4], gf[4];
#pragma unroll
        for (int j = 0; j < 4; ++j) {
            if (!FINAL && !COMBINE && !ROUTER) { sh[j] = *(const f32x4*)(P.shift + ms * 6144 + 4 * lane + 256 * j); scl[j] = *(const f32x4*)(P.scale + ms * 6144 + 4 * lane + 256 * j) + 1.0f; }
            if (COMBINE) gf[j] = *(const f32x4*)(P.gatef + ms * 6144 + 4 * lane + 256 * j); }
        f32x4 v[4]; f32x4 v32n[4]; u32x2 vbn[4]; u32x2 ya[4], yb[4]; float p0 = 0.f, p1 = 0.f;
#pragma unroll
        for (int j = 0; j < 4; ++j) v[j] = SRCB ? bf4(*(const u32x2*)(xb0 + 4 * lane + 256 * j)) : *(const f32x4*)(xs32 + 4 * lane + 256 * j);
        if (COMBINE) { p0 = P.topp[2 * r0]; p1 = P.topp[2 * r0 + 1];
#pragma unroll
            for (int j = 0; j < 4; ++j) { ya[j] = *(const u32x2*)(P.YE + (size_t)(2 * r0) * D + 4 * lane + 256 * j); yb[j] = *(const u32x2*)(P.YE + (size_t)(2 * r0 + 1) * D + 4 * lane + 256 * j); } }
        for (int r = r0; r < r1; ++r) {
            const int rr = r - r0; const bool more = r + 1 < r1;
            u32x2 yan[4], ybn[4]; float p0n = 0.f, p1n = 0.f;
            if (more) {
#pragma unroll
                for (int j = 0; j < 4; ++j) { if (SRCB) vbn[j] = *(const u32x2*)(xb0 + (size_t)(rr + 1) * D + 4 * lane + 256 * j); else v32n[j] = *(const f32x4*)(xs32 + (size_t)(rr + 1) * D + 4 * lane + 256 * j); }
                if (COMBINE) { p0n = P.topp[2 * r + 2]; p1n = P.topp[2 * r + 3];
#pragma unroll
                    for (int j = 0; j < 4; ++j) { yan[j] = *(const u32x2*)(P.YE + (size_t)(2 * r + 2) * D + 4 * lane + 256 * j); ybn[j] = *(const u32x2*)(P.YE + (size_t)(2 * r + 3) * D + 4 * lane + 256 * j); } }
            }
            if (COMBINE) {
                const int sl0 = P.slotof[2 * r], sl1 = P.slotof[2 * r + 1];
#pragma unroll
                for (int j = 0; j < 4; ++j) { f32x4 y0 = bf4(ya[j]), y1 = bf4(yb[j]);
                    if (sl0 >= 65536) { y0 = (f32x4){0.f, 0.f, 0.f, 0.f}; for (int kp = 0; kp < 4; ++kp) y0 = y0 + *(const f32x4*)(P.partm + ((size_t)kp * 3072 + (size_t)(sl0 - 65536)) * D + 4 * lane + 256 * j); }
                    if (sl1 >= 65536) { y1 = (f32x4){0.f, 0.f, 0.f, 0.f}; for (int kp = 0; kp < 4; ++kp) y1 = y1 + *(const f32x4*)(P.partm + ((size_t)kp * 3072 + (size_t)(sl1 - 65536)) * D + 4 * lane + 256 * j); }
                    v[j] = v[j] + gf[j] * (y0 * p0 + y1 * p1);
                    if (!FINAL) { u32x2 w; w.x = pk2(v[j][0], v[j][1]); w.y = pk2(v[j][2], v[j][3]); *(u32x2*)(xb0 + (size_t)rr * D + 4 * lane + 256 * j) = w; } }
            }
            float ss = 0.f;
#pragma unroll
            for (int j = 0; j < 4; ++j) ss += (v[j][0] * v[j][0] + v[j][1] * v[j][1]) + (v[j][2] * v[j][2] + v[j][3] * v[j][3]);
            const float rstd = rsqrtf(wave_sum(ss, lane) * (1.0f / D) + EPS);
            if (FINAL) {
#pragma unroll
                for (int j = 0; j < 4; ++j) *(f32x4*)(P.fout + (size_t)r * D + 4 * lane + 256 * j) = v[j] * rstd * gn[j];
            } else {
                f32x4 h[4];
#pragma unroll
                for (int j = 0; j < 4; ++j) { if (COMBINE || ROUTER) { sh[j] = *(const f32x4*)(P.shift + ms * 6144 + 4 * lane + 256 * j); scl[j] = *(const f32x4*)(P.scale + ms * 6144 + 4 * lane + 256 * j) + 1.0f; }
                    h[j] = (v[j] * rstd * gn[j]) * scl[j] + sh[j];
                    u32x2 w; w.x = pk2(h[j][0], h[j][1]); w.y = pk2(h[j][2], h[j][3]);
                    *(u32x2*)(P.H + (size_t)r * D + 4 * lane + 256 * j) = w; }
                if (ROUTER) {
                    float lg[8] = {0.f, 0.f, 0.f, 0.f, 0.f, 0.f, 0.f, 0.f};
#pragma unroll
                    for (int j = 0; j < 4; ++j) {
#pragma unroll
                        for (int i = 0; i < 4; ++i) { const f32x4 w0 = rwr[4 * j + i][0], w1 = rwr[4 * j + i][1]; const float hv = h[j][i];
                            lg[0] += hv * w0[0]; lg[1] += hv * w0[1]; lg[2] += hv * w0[2]; lg[3] += hv * w0[3]; lg[4] += hv * w1[0]; lg[5] += hv * w1[1]; lg[6] += hv * w1[2]; lg[7] += hv * w1[3]; }
                        __builtin_amdgcn_sched_barrier(0); }
                    {
                        const bool b5 = (lane & 32) != 0, b4 = (lane & 16) != 0, b3 = (lane & 8) != 0;
                        float a4[4], a2[2];
#pragma unroll
                        for (int i = 0; i < 4; ++i) { const float snd = b5 ? lg[i] : lg[4 + i], kp_ = b5 ? lg[4 + i] : lg[i]; a4[i] = kp_ + shfl_x(snd, 32, lane); }
#pragma unroll
                        for (int i = 0; i < 2; ++i) { const float snd = b4 ? a4[i] : a4[2 + i], kp_ = b4 ? a4[2 + i] : a4[i]; a2[i] = kp_ + shfl_x(snd, 16, lane); }
                        float c1; { const float snd = b3 ? a2[0] : a2[1], kp_ = b3 ? a2[1] : a2[0]; c1 = kp_ + shfl_x(snd, 8, lane); }
                        c1 += shfl_x(c1, 4, lane); c1 += shfl_x(c1, 2, lane); c1 += shfl_x(c1, 1, lane);
#pragma unroll
                        for (int e = 0; e < 8; ++e) lg[e] = __builtin_bit_cast(float, __builtin_amdgcn_readlane(__builtin_bit_cast(int, c1), 8 * e));
                    }
                    int e0 = 0; float v0 = lg[0];
#pragma unroll
                    for (int e = 1; e < 8; ++e) if (lg[e] > v0) { v0 = lg[e]; e0 = e; }
                    int e1 = -1; float v1 = -3.0e38f;
#pragma unroll
                    for (int e = 0; e < 8; ++e) if (e != e0 && lg[e] > v1) { v1 = lg[e]; e1 = e; }
                    const float ex = expf(v1 - v0); const float q0 = 1.0f / (1.0f + ex), q1 = ex / (1.0f + ex);
                    const int rk0 = e0 == 0 ? rc0 : e0 == 1 ? rc1 : e0 == 2 ? rc2 : e0 == 3 ? rc3 : e0 == 4 ? rc4 : e0 == 5 ? rc5 : e0 == 6 ? rc6 : rc7;
                    const int rk1 = e1 == 0 ? rc0 : e1 == 1 ? rc1 : e1 == 2 ? rc2 : e1 == 3 ? rc3 : e1 == 4 ? rc4 : e1 == 5 ? rc5 : e1 == 6 ? rc6 : rc7;
                    rc0 += (e0 == 0) + (e1 == 0); rc1 += (e0 == 1) + (e1 == 1); rc2 += (e0 == 2) + (e1 == 2); rc3 += (e0 == 3) + (e1 == 3);
                    rc4 += (e0 == 4) + (e1 == 4); rc5 += (e0 == 5) + (e1 == 5); rc6 += (e0 == 6) + (e1 == 6); rc7 += (e0 == 7) + (e1 == 7);
                    if (lane == 0) { P.tope[2 * r] = e0; P.tope[2 * r + 1] = e1; P.toppo[2 * r] = q0; P.toppo[2 * r + 1] = q1; P.rank[2 * r] = rk0; P.rank[2 * r + 1] = rk1; }
                }
            }
            if (more) {
#pragma unroll
                for (int j = 0; j < 4; ++j) { v[j] = SRCB ? bf4(vbn[j]) : v32n[j]; if (COMBINE) { ya[j] = yan[j]; yb[j] = ybn[j]; } }
                if (COMBINE) { p0 = p0n; p1 = p1n; }
            }
        }
        if (ROUTER && lane == 0) { int* c = P.cnt + F.gw * 8; c[0] = rc0; c[1] = rc1; c[2] = rc2; c[3] = rc3; c[4] = rc4; c[5] = rc5; c[6] = rc6; c[7] = rc7; }
    }
}

template <bool COMBINE, bool ROUTER, bool FINAL, int RB>
__device__ __forceinline__ void row_pass_b(const Ctx& F, const RowPass& P) {
    const int lane = F.lane;
    f32x4 rwr[16][2];
    if (ROUTER) {
#pragma unroll
        for (int j = 0; j < 4; ++j)
#pragma unroll
            for (int i = 0; i < 4; ++i) { const int col = 4 * lane + 256 * j + i; rwr[4 * j + i][0] = *(const f32x4*)(P.rw + col * 8); rwr[4 * j + i][1] = *(const f32x4*)(P.rw + col * 8 + 4); } }
    f32x4 gn[4];
    if (!ROUTER) {
#pragma unroll
        for (int j = 0; j < 4; ++j) gn[j] = *(const f32x4*)(P.gain + 4 * lane + 256 * j); }
    const RowPart rp = row_part(F.NGW, P.nrows);
    int r0, r1; row_chunk(rp, F.gw, r0, r1);
    int rc0 = 0, rc1 = 0, rc2 = 0, rc3 = 0, rc4 = 0, rc5 = 0, rc6 = 0, rc7 = 0;
    const bool isc = r0 >= ML; const int ms = isc ? 2 : (r0 >= TL ? 1 : 0);
    bf16_t* xb0 = P.xb + (size_t)r0 * D;
    if (!COMBINE && !FINAL) { if (isc && P.part) {
        const float* c32 = P.csrc32 ? P.csrc32 + (size_t)(r0 - ML) * D : nullptr;
#pragma unroll 1
        for (int rr = 0; rr < r1 - r0; ++rr) {
#pragma unroll 2
            for (int j = 0; j < 4; ++j) { f32x4 a[4];
#pragma unroll
                for (int kp = 0; kp < 4; ++kp) a[kp] = kp < P.kpn ? *(const f32x4*)(P.part + ((size_t)kp * MC + (size_t)(r0 - ML + rr)) * D + 4 * lane + 256 * j) : (f32x4){0.f, 0.f, 0.f, 0.f};
                const f32x4 x0 = c32 ? *(const f32x4*)(c32 + (size_t)rr * D + 4 * lane + 256 * j) : bf4(*(const u32x2*)(xb0 + (size_t)rr * D + 4 * lane + 256 * j));
                const f32x4 y = x0 + *(const f32x4*)(P.pgate + 2 * 6144 + 4 * lane + 256 * j) * ((a[0] + a[1]) + (a[2] + a[3]));
                u32x2 w; w.x = pk2(y[0], y[1]); w.y = pk2(y[2], y[3]); *(u32x2*)(xb0 + (size_t)rr * D + 4 * lane + 256 * j) = w; } }
        asm volatile("s_waitcnt vmcnt(0)" ::: "memory"); } }
    f32x4 sh[4], scl[4], gf[4];
#pragma unroll
    for (int j = 0; j < 4; ++j) {
        if (!FINAL && !ROUTER) { sh[j] = *(const f32x4*)(P.shift + ms * 6144 + 4 * lane + 256 * j); scl[j] = *(const f32x4*)(P.scale + ms * 6144 + 4 * lane + 256 * j) + 1.0f; }
        if (COMBINE) gf[j] = *(const f32x4*)(P.gatef + ms * 6144 + 4 * lane + 256 * j); }
    const int nr = r1 - r0;
    u32x2 cur[RB][4], nxt[RB][4], ya[RB][4], yb[RB][4], yan[RB][4], ybn[RB][4];
#define RPB_LOAD(X, YA, YB, base_) do { _Pragma("unroll") for (int k = 0; k < RB; ++k) { const int rk_ = ((base_) + k < nr) ? (base_) + k : nr - 1; \
        int sa_ = 0, sb_ = 0; if (COMBINE) { sa_ = P.slotof[2 * (r0 + rk_)]; sb_ = P.slotof[2 * (r0 + rk_) + 1]; sa_ = sa_ < 65536 ? sa_ : 65535; sb_ = sb_ < 65536 ? sb_ : 65535; }     \
        _Pragma("unroll") for (int j = 0; j < 4; ++j) { X[k][j] = *(const u32x2*)(xb0 + (size_t)rk_ * D + 4 * lane + 256 * j); \
            if (COMBINE) { YA[k][j] = *(const u32x2*)(P.YE + (size_t)sa_ * D + 4 * lane + 256 * j); YB[k][j] = *(const u32x2*)(P.YE + (size_t)sb_ * D + 4 * lane + 256 * j); } } } } while (0)
    const int ng = (nr + RB - 1) / RB; int gi = F.gw % ng;
    RPB_LOAD(cur, ya, yb, gi * RB);
    for (int it = 0; it < ng; ++it) {
        const int rb = gi * RB; gi = gi + 1 == ng ? 0 : gi + 1;
        if (it + 1 < ng) RPB_LOAD(nxt, yan, ybn, gi * RB);
        f32x4 v[RB][4]; float ss[RB];
#pragma unroll
        for (int k = 0; k < RB; ++k) {
            const int rk = (rb + k < nr) ? rb + k : nr - 1; const int r = r0 + rk;
#pragma unroll
            for (int j = 0; j < 4; ++j) v[k][j] = bf4(cur[k][j]);
            if (COMBINE) {
                const float p0 = P.topp[2 * r], p1 = P.topp[2 * r + 1]; const int sl0 = P.slotof[2 * r], sl1 = P.slotof[2 * r + 1];
#pragma unroll
                for (int j = 0; j < 4; ++j) { f32x4 y0 = bf4(ya[k][j]), y1 = bf4(yb[k][j]);
                    if (sl0 >= 65536) { y0 = (f32x4){0.f, 0.f, 0.f, 0.f}; for (int kp = 0; kp < 4; ++kp) y0 = y0 + *(const f32x4*)(P.partm + ((size_t)kp * 3072 + (size_t)(sl0 - 65536)) * D + 4 * lane + 256 * j); }
                    if (sl1 >= 65536) { y1 = (f32x4){0.f, 0.f, 0.f, 0.f}; for (int kp = 0; kp < 4; ++kp) y1 = y1 + *(const f32x4*)(P.partm + ((size_t)kp * 3072 + (size_t)(sl1 - 65536)) * D + 4 * lane + 256 * j); }
                    v[k][j] = v[k][j] + gf[j] * (y0 * p0 + y1 * p1);
                    if (!FINAL && rb + k < nr) { u32x2 w; w.x = pk2(v[k][j][0], v[k][j][1]); w.y = pk2(v[k][j][2], v[k][j][3]); *(u32x2*)(xb0 + (size_t)rk * D + 4 * lane + 256 * j) = w; } }
            }
            float s_ = 0.f;
#pragma unroll
            for (int j = 0; j < 4; ++j) s_ += (v[k][j][0] * v[k][j][0] + v[k][j][1] * v[k][j][1]) + (v[k][j][2] * v[k][j][2] + v[k][j][3] * v[k][j][3]);
            ss[k] = s_;
        }
#pragma unroll
        for (int o = 1; o < 64; o <<= 1)
#pragma unroll
            for (int k = 0; k < RB; ++k) ss[k] += shfl_x(ss[k], o, lane);
#pragma unroll
        for (int k = 0; k < RB; ++k) {
            if (rb + k < nr) {
                const int r = r0 + rb + k; const float rstd = rsqrtf(ss[k] * (1.0f / D) + EPS);
                if (FINAL) {
#pragma unroll
                    for (int j = 0; j < 4; ++j) *(f32x4*)(P.fout + (size_t)r * D + 4 * lane + 256 * j) = v[k][j] * rstd * gn[j];
                } else {
                    f32x4 h[4];
#pragma unroll
                    for (int j = 0; j < 4; ++j) {
                        if (ROUTER) { const f32x4 g_ = *(const f32x4*)(P.gain + 4 * lane + 256 * j), s_ = *(const f32x4*)(P.scale + ms * 6144 + 4 * lane + 256 * j) + 1.0f, t_ = *(const f32x4*)(P.shift + ms * 6144 + 4 * lane + 256 * j);
                            h[j] = (bf4(cur[k][j]) * rstd * g_) * s_ + t_; }
                        else h[j] = (v[k][j] * rstd * gn[j]) * scl[j] + sh[j];
                        u32x2 w; w.x = pk2(h[j][0], h[j][1]); w.y = pk2(h[j][2], h[j][3]);
                        *(u32x2*)(P.H + (size_t)r * D + 4 * lane + 256 * j) = w; }
                    if (ROUTER) {
                        float lg[8] = {0.f, 0.f, 0.f, 0.f, 0.f, 0.f, 0.f, 0.f};
#pragma unroll
                        for (int j = 0; j < 4; ++j)
#pragma unroll
                            for (int i = 0; i < 4; ++i) { const f32x4 w0 = rwr[4 * j + i][0], w1 = rwr[4 * j + i][1]; const float hv = h[j][i];
                                lg[0] += hv * w0[0]; lg[1] += hv * w0[1]; lg[2] += hv * w0[2]; lg[3] += hv * w0[3]; lg[4] += hv * w1[0]; lg[5] += hv * w1[1]; lg[6] += hv * w1[2]; lg[7] += hv * w1[3]; }
                        {
                            const bool b5 = (lane & 32) != 0, b4 = (lane & 16) != 0, b3 = (lane & 8) != 0;
                            float a4[4], a2[2];
#pragma unroll
                            for (int i = 0; i < 4; ++i) { const float snd = b5 ? lg[i] : lg[4 + i], kp_ = b5 ? lg[4 + i] : lg[i]; a4[i] = kp_ + shfl_x(snd, 32, lane); }
#pragma unroll
                            for (int i = 0; i < 2; ++i) { const float snd = b4 ? a4[i] : a4[2 + i], kp_ = b4 ? a4[2 + i] : a4[i]; a2[i] = kp_ + shfl_x(snd, 16, lane); }
                            float c1; { const float snd = b3 ? a2[0] : a2[1], kp_ = b3 ? a2[1] : a2[0]; c1 = kp_ + shfl_x(snd, 8, lane); }
                            c1 += shfl_x(c1, 4, lane); c1 += shfl_x(c1, 2, lane); c1 += shfl_x(c1, 1, lane);
#pragma unroll
                            for (int e = 0; e < 8; ++e) lg[e] = __builtin_bit_cast(float, __builtin_amdgcn_readlane(__builtin_bit_cast(int, c1), 8 * e));
                        }
                        int e0 = 0; float v0 = lg[0];
#pragma unroll
                        for (int e = 1; e < 8; ++e) if (lg[e] > v0) { v0 = lg[e]; e0 = e; }
                        int e1 = -1; float v1 = -3.0e38f;
#pragma unroll
                        for (int e = 0; e < 8; ++e) if (e != e0 && lg[e] > v1) { v1 = lg[e]; e1 = e; }
                        const float ex = expf(v1 - v0); const float q0 = 1.0f / (1.0f + ex), q1 = ex / (1.0f + ex);
                        const int rk0 = e0 == 0 ? rc0 : e0 == 1 ? rc1 : e0 == 2 ? rc2 : e0 == 3 ? rc3 : e0 == 4 ? rc4 : e0 == 5 ? rc5 : e0 == 6 ? rc6 : rc7;
                        const int rk1 = e1 == 0 ? rc0 : e1 == 1 ? rc1 : e1 == 2 ? rc2 : e1 == 3 ? rc3 : e1 == 4 ? rc4 : e1 == 5 ? rc5 : e1 == 6 ? rc6 : rc7;
                        rc0 += (e0 == 0) + (e1 == 0); rc1 += (e0 == 1) + (e1 == 1); rc2 += (e0 == 2) + (e1 == 2); rc3 += (e0 == 3) + (e1 == 3);
                        rc4 += (e0 == 4) + (e1 == 4); rc5 += (e0 == 5) + (e1 == 5); rc6 += (e0 == 6) + (e1 == 6); rc7 += (e0 == 7) + (e1 == 7);
                        if (lane == 0) { P.tope[2 * r] = e0; P.tope[2 * r + 1] = e1; P.toppo[2 * r] = q0; P.toppo[2 * r + 1] = q1; P.rank[2 * r] = rk0; P.rank[2 * r + 1] = rk1; }
                    }
                }
            }
        }
        if (it + 1 < ng) {
#pragma unroll
            for (int k = 0; k < RB; ++k)
#pragma unroll
                for (int j = 0; j < 4; ++j) { cur[k][j] = nxt[k][j]; if (COMBINE) { ya[k][j] = yan[k][j]; yb[k][j] = ybn[k][j]; } }
        }
    }
#undef RPB_LOAD
    if (ROUTER && lane == 0) { int* c = P.cnt + F.gw * 8; c[0] = rc0; c[1] = rc1; c[2] = rc2; c[3] = rc3; c[4] = rc4; c[5] = rc5; c[6] = rc6; c[7] = rc7; }
}

template <int NB, int NKS>
__device__ __forceinline__ void lm_load_a(const bf16_t* A, int lda, const int (&i0)[NB], int kc0, bf16x8 (&ap)[NB][NKS], int lane) {
    const int i16 = lane & 15, q = lane >> 4;
#pragma unroll
    for (int b = 0; b < NB; ++b)
#pragma unroll
        for (int ks = 0; ks < NKS; ++ks) ap[b][ks] = *(const bf16x8*)(A + (size_t)(i0[b] + i16) * lda + kc0 + ks * 32 + 8 * q);
}
template <int NB, int NKS>
__device__ __forceinline__ void lm_core(const bf16x8 (&ap)[NB][NKS], LAS unsigned char* X, f32x4 (&acc)[NB][8], int lane) {
    const int i16 = lane & 15, q = lane >> 4;
    const int xoff = (8 * q + (i16 >> 2)) * XRS + 8 * (i16 & 3);
#pragma unroll
    for (int ks = 0; ks < NKS; ++ks) {
        s16x4 lo[8], hi[8];
#pragma unroll
        for (int nt = 0; nt < 8; ++nt) {
            lo[nt] = __builtin_amdgcn_ds_read_tr16_b64_v4i16((LAS s16x4*)(X + ks * 32 * XRS + xoff + nt * 32));
            hi[nt] = __builtin_amdgcn_ds_read_tr16_b64_v4i16((LAS s16x4*)(X + ks * 32 * XRS + xoff + nt * 32 + 4 * XRS)); }
        __builtin_amdgcn_sched_barrier(0);
#pragma unroll
        for (int nt = 0; nt < 8; ++nt) { const bf16x8 xf = __builtin_shufflevector(lo[nt], hi[nt], 0, 1, 2, 3, 4, 5, 6, 7);
#pragma unroll
            for (int b = 0; b < NB; ++b) acc[b][nt] = __builtin_amdgcn_mfma_f32_16x16x32_bf16(xf, ap[b][ks], acc[b][nt], 0, 0, 0); }
    }
}
template <int NB> __device__ __forceinline__ void zero_acc(f32x4 (&acc)[NB][8]) {
#pragma unroll
    for (int b = 0; b < NB; ++b)
#pragma unroll
        for (int nt = 0; nt < 8; ++nt) acc[b][nt] = (f32x4){0.f, 0.f, 0.f, 0.f};
}
__device__ __forceinline__ void stage_rows(const bf16_t* src, size_t sstride, int nrows, LAS unsigned char* X, int xr0, int tid) {
    for (int i = tid; i < nrows * 16; i += 512) { const int r = i >> 4, ch = i & 15; *(LAS u32x4*)(X + (xr0 + r) * XRS + ch * 16) = *(const u32x4*)(src + (size_t)r * sstride + ch * 8); }
}

__device__ __forceinline__ void fft_stage_a(const Ctx& F, unsigned* wq) {
    const bf16_t* PZ = (const bf16_t*)(F.ws + WS_PZUV); bf16_t* UP = (bf16_t*)(F.ws + WS_UP); bf16_t* Y = (bf16_t*)(F.ws + WS_H);
    const bf16_t* FA = (const bf16_t*)(F.ws + WS_FA); const bf16_t* FX = (const bf16_t*)(F.ws + WS_FX);
    LAS unsigned char* X = F.lds; const int lane = F.lane, w = F.wave, i16 = lane & 15, q = lane >> 4;
    volatile LAS unsigned* slot = (volatile LAS unsigned*)(F.lds + MISC_OFF + 64);
    bf16x8 apA[2][8]; { const int i0[2] = {16 * w, 128 + 16 * w}; lm_load_a<2, 8>(FA, 256, i0, 0, apA, lane); }
    for (int it0 = F.bid; it0 < 1024 + 16; ) {
        const int it = it0 < 16 ? 1024 + it0 : it0 - 16;
        if (it < 1024) {
            const int t2 = it & 127, g = (it >> 7) & 3, b = it >> 9;
            const bf16_t* src = PZ + ((size_t)b * TL + t2) * NEIN + g * 128;
            stage_rows(src, (size_t)128 * NEIN, 128, X, 0, F.tid);
            stage_rows(src + 512, (size_t)128 * NEIN, 128, X, 128, F.tid);
            __syncthreads();
            f32x4 acc[2][8]; zero_acc<2>(acc);
            lm_core<2, 8>(apA, X, acc, lane);
            const int k1 = 16 * w + i16; float sw, cw; sincosf(6.283185307179586f * (float)((k1 * t2) & 16383) / 16384.0f, &sw, &cw);
            bf16_t* orow = UP + ((size_t)((b * 4 + g) * 128 + k1) * 128 + t2) * 256;
#pragma unroll
            for (int nt = 0; nt < 8; ++nt) { const f32x4 ur = acc[0][nt], ui = acc[1][nt]; const int n = 16 * nt + 4 * q;
                u32x2 wr_, wi_; wr_.x = pk2(ur[0] * cw - ui[0] * sw, ur[1] * cw - ui[1] * sw); wr_.y = pk2(ur[2] * cw - ui[2] * sw, ur[3] * cw - ui[3] * sw);
                wi_.x = pk2(ur[0] * sw + ui[0] * cw, ur[1] * sw + ui[1] * cw); wi_.y = pk2(ur[2] * sw + ui[2] * cw, ur[3] * sw + ui[3] * cw);
                *(u32x2*)(orow + n) = wr_; *(u32x2*)(orow + 128 + n) = wi_; }
            __syncthreads();
        } else {
            const int ci = it - 1024, kh = ci & 1, g = (ci >> 1) & 3, b = ci >> 3;
            f32x4 acc[1][8]; zero_acc<1>(acc); const int i0[1] = {128 * kh + 16 * w};
            for (int c = 0; c < 2; ++c) {
                bf16x8 apx[1][8]; lm_load_a<1, 8>(FX, 512, i0, c * 256, apx, lane);
                stage_rows(PZ + ((size_t)ML + b * TCX) * NEIN + c * 512 + g * 128, NEIN, 256, X, 0, F.tid);
                __syncthreads();
                lm_core<1, 8>(apx, X, acc, lane);
                __syncthreads();
            }
            const int k = 128 * kh + 16 * w + i16; bf16_t* orow = Y + ((size_t)ML + b * TCX + k) * D + g * 128; const float nrm = 0.005524271728019903f;
#pragma unroll
            for (int nt = 0; nt < 8; ++nt) { const f32x4 a = acc[0][nt] * nrm; u32x2 o; o.x = pk2(a[0], a[1]); o.y = pk2(a[2], a[3]); *(u32x2*)(orow + 16 * nt + 4 * q) = o; }
        }
        WQ_NEXT(it0, wq, slot, F.G);
    }
}
__device__ __forceinline__ void fft_stage_c_gmlp(const Ctx& F, int j, unsigned* wq) {
    const bf16_t* PZ = (const bf16_t*)(F.ws + WS_PZUV); const bf16_t* UP = (const bf16_t*)(F.ws + WS_UP); bf16_t* Y = (bf16_t*)(F.ws + WS_H);
    const bf16_t* FC = (const bf16_t*)(F.ws + WS_FC); const bf16_t* GW = (const bf16_t*)(F.ws + WS_GW) + (size_t)j * 4 * 128 * 128;
    const float* gb = FIN(I_GB) + j * 512;
    LAS unsigned char* X = F.lds; const int lane = F.lane, w = F.wave, i16 = lane & 15, q = lane >> 4, tid = F.tid;
    volatile LAS unsigned* slot = (volatile LAS unsigned*)(F.lds + MISC_OFF + 64);
    bf16x8 apC[1][8]; { const int i0[1] = {16 * w}; lm_load_a<1, 8>(FC, 256, i0, 0, apC, lane); }
    for (int it = F.bid; it < 1024 + 1040; ) {
        if (it < 1024) {
            const int k1 = it & 127, g = (it >> 7) & 3, b = it >> 9;
            const bf16_t* src = UP + (size_t)((b * 4 + g) * 128 + k1) * 128 * 256;
            stage_rows(src, 256, 128, X, 0, tid);
            stage_rows(src + 128, 256, 128, X, 128, tid);
            __syncthreads();
            f32x4 acc[1][8]; zero_acc<1>(acc);
            lm_core<1, 8>(apC, X, acc, lane);
            const int k2 = 16 * w + i16; bf16_t* orow = Y + ((size_t)b * TL + k1 + 128 * k2) * D + g * 128; const float nrm = 0.0006905339660024878f;
#pragma unroll
            for (int nt = 0; nt < 8; ++nt) { const f32x4 a = acc[0][nt] * nrm; u32x2 o; o.x = pk2(a[0], a[1]); o.y = pk2(a[2], a[3]); *(u32x2*)(orow + 16 * nt + 4 * q) = o; }
            __syncthreads();
        } else {
            const int gi = it - 1024, h = gi & 3, ck = gi >> 2; const size_t r0 = (size_t)ck * 128;
            bf16x8 apg[1][4]; { const int i0[1] = {16 * w}; lm_load_a<1, 4>(GW + (size_t)h * 128 * 128, 128, i0, 0, apg, lane); }
            u32x4 raw4[4];
#pragma unroll
            for (int i4 = 0; i4 < 4; ++i4) { const int i = tid + 512 * i4, r = i >> 4, ch = i & 15; raw4[i4] = *(const u32x4*)(PZ + (r0 + r) * NEIN + 1536 + h * 128 + ch * 8); }
            __builtin_amdgcn_sched_barrier(0);
#pragma unroll
            for (int i4 = 0; i4 < 4; ++i4) { const int i = tid + 512 * i4, r = i >> 4, ch = i & 15; const u32x4 raw = raw4[i4];
                float x[8] = {bflo(raw.x), bfhi(raw.x), bflo(raw.y), bfhi(raw.y), bflo(raw.z), bfhi(raw.z), bflo(raw.w), bfhi(raw.w)};
                float s = 0.f;
#pragma unroll
                for (int e = 0; e < 8; ++e) s += x[e];
                s += shfl_x(s, 1, lane); s += shfl_x(s, 2, lane); s += shfl_x(s, 4, lane); s += shfl_x(s, 8, lane);
                const float mean = s * (1.0f / 128.0f); float qq = 0.f;
#pragma unroll
                for (int e = 0; e < 8; ++e) { x[e] -= mean; qq += x[e] * x[e]; }
                qq += shfl_x(qq, 1, lane); qq += shfl_x(qq, 2, lane); qq += shfl_x(qq, 4, lane); qq += shfl_x(qq, 8, lane);
                const float rs = rsqrtf(qq * (1.0f / 128.0f) + EPS);
                u32x4 o; o.x = pk2(x[0] * rs, x[1] * rs); o.y = pk2(x[2] * rs, x[3] * rs); o.z = pk2(x[4] * rs, x[5] * rs); o.w = pk2(x[6] * rs, x[7] * rs);
                *(LAS u32x4*)(X + r * XRS + ch * 16) = o; }
            const int t = 16 * w + i16; const float bias = gb[h * 128 + t];
            const bf16_t* urow = PZ + (r0 + t) * NEIN + 1024 + h * 128; bf16_t* orow = Y + (r0 + t) * D + 512 + h * 128;
            u32x2 uu8[8];
#pragma unroll
            for (int nt = 0; nt < 8; ++nt) uu8[nt] = *(const u32x2*)(urow + 16 * nt + 4 * q);
            __syncthreads();
            f32x4 acc[1][8]; zero_acc<1>(acc);
            lm_core<1, 4>(apg, X, acc, lane);
            __builtin_amdgcn_sched_barrier(0);
#pragma unroll
            for (int nt = 0; nt < 8; ++nt) { const int n = 16 * nt + 4 * q; const u32x2 uu = uu8[nt]; const f32x4 a = acc[0][nt];
                u32x2 o; o.x = pk2(bflo(uu.x) * (a[0] + bias), bfhi(uu.x) * (a[1] + bias)); o.y = pk2(bflo(uu.y) * (a[2] + bias), bfhi(uu.y) * (a[3] + bias)); *(u32x2*)(orow + n) = o; }
            __syncthreads();
        }
        WQ_NEXT(it, wq, slot, F.G);
    }
}

constexpr int S2_KT = 0, S2_QT = 36864, S2_V = 73728, S2_SC = 110592, S2_EB = 120832, S2_EBL = 122880, S2_RED = 124928, S2_END = 129024;
static_assert(S2_END <= MISC_OFF, "scan LDS");
constexpr int SCRS = 80;
template <bool NEEDQ>
__device__ __forceinline__ void half_prep(const Ctx& F, const bf16_t* P5, size_t hrow, bool rev, int h, int dir) {
    const int tid = F.tid, ck = F.wave >> 1, dk = ((F.wave & 1) << 6) + F.lane; LAS unsigned char* L = F.lds;
#pragma unroll
    for (int it = 0; it < 4; ++it) { const int idx = tid + 512 * it, p = idx >> 4, ch = idx & 15; const size_t r = hrow + (rev ? 127 - p : p); const bf16_t* rp = P5 + ((size_t)h * MT + r) * 640 + ch * 8;
        *(LAS u32x4*)(L + S2_KT + p * XRS + ch * 16) = *(const u32x4*)(rp + (2 + dir) * 128);
        if (NEEDQ) *(LAS u32x4*)(L + S2_QT + p * XRS + ch * 16) = *(const u32x4*)(rp);
        *(LAS u32x4*)(L + S2_V + p * XRS + ch * 16) = *(const u32x4*)(rp + 4 * 128); }
    __syncthreads();
    float b = 0.f; LAS unsigned char* kt = L + S2_KT + (32 * ck) * XRS + dk * 2; LAS unsigned char* qt = L + S2_QT + (32 * ck) * XRS + dk * 2;
    bf16_t lfr[32], qr[32];
#pragma unroll
    for (int i = 0; i < 32; ++i) { lfr[i] = *(const LAS bf16_t*)(kt + i * XRS); if (NEEDQ) qr[i] = *(const LAS bf16_t*)(qt + i * XRS); }
    __builtin_amdgcn_sched_barrier(0);
#pragma unroll
    for (int i = 0; i < 32; ++i) { const float lf = bf2f(lfr[i]); b += lf;
        const float kk = (1.0f - __expf(lf)) * __expf(fminf(-b, 80.0f));
        *(LAS bf16_t*)(kt + i * XRS) = (bf16_t)f2bf(kk);
        if (NEEDQ) *(LAS bf16_t*)(qt + i * XRS) = (bf16_t)f2bf(bf2f(qr[i]) * __expf(b)); }
    ((LAS float*)(L + S2_EB))[ck * 128 + dk] = __expf(b);
    ((LAS float*)(L + S2_EBL))[ck * 128 + dk] = b;
}
__device__ __forceinline__ void prep1_issue(const Ctx& F, const bf16_t* P5, size_t hrow, bool rev, int h, int dir, u32x4 (&pf)[8]) {
    const int tid = F.tid;
#pragma unroll
    for (int it = 0; it < 4; ++it) { const int idx = tid + 512 * it, p = idx >> 4, ch = idx & 15; const size_t r = hrow + (rev ? 127 - p : p); const bf16_t* rp = P5 + ((size_t)h * MT + r) * 640 + ch * 8;
        pf[2 * it] = *(const u32x4*)(rp + (2 + dir) * 128); pf[2 * it + 1] = *(const u32x4*)(rp + 4 * 128); }
}
__device__ __forceinline__ void prep1_commit(const Ctx& F, const u32x4 (&pf)[8]) {
    const int tid = F.tid, ck = F.wave >> 1, dk = ((F.wave & 1) << 6) + F.lane; LAS unsigned char* L = F.lds;
#pragma unroll
    for (int it = 0; it < 4; ++it) { const int idx = tid + 512 * it, p = idx >> 4, ch = idx & 15;
        *(LAS u32x4*)(L + S2_KT + p * XRS + ch * 16) = pf[2 * it]; *(LAS u32x4*)(L + S2_V + p * XRS + ch * 16) = pf[2 * it + 1]; }
    __syncthreads();
    float b = 0.f; LAS unsigned char* kt = L + S2_KT + (32 * ck) * XRS + dk * 2;
    bf16_t lfr[32];
#pragma unroll
    for (int i = 0; i < 32; ++i) lfr[i] = *(const LAS bf16_t*)(kt + i * XRS);
    __builtin_amdgcn_sched_barrier(0);
#pragma unroll
    for (int i = 0; i < 32; ++i) { const float lf = bf2f(lfr[i]); b += lf; *(LAS bf16_t*)(kt + i * XRS) = (bf16_t)f2bf((1.0f - __expf(lf)) * __expf(fminf(-b, 80.0f))); }
    ((LAS float*)(L + S2_EB))[ck * 128 + dk] = __expf(b);
    ((LAS float*)(L + S2_EBL))[ck * 128 + dk] = b;
}
__device__ __forceinline__ void state_update(const Ctx& F, f32x4 (&st)[8], int ck) {
    LAS unsigned char* L = F.lds; const int lane = F.lane, i16 = lane & 15, q = lane >> 4, w = F.wave;
    const int roff = (32 * ck + 8 * q + (i16 >> 2)) * XRS + 8 * (i16 & 3);
    s16x4 vlo = __builtin_amdgcn_ds_read_tr16_b64_v4i16((LAS s16x4*)(L + S2_V + roff + w * 32));
    s16x4 vhi = __builtin_amdgcn_ds_read_tr16_b64_v4i16((LAS s16x4*)(L + S2_V + roff + w * 32 + 4 * XRS));
    const bf16x8 vf = __builtin_shufflevector(vlo, vhi, 0, 1, 2, 3, 4, 5, 6, 7);
#pragma unroll
    for (int hb = 0; hb < 2; ++hb) {
        s16x4 klo[4], khi[4]; f32x4 eb[4];
#pragma unroll
        for (int k4 = 0; k4 < 4; ++k4) { const int kb = 4 * hb + k4;
            klo[k4] = __builtin_amdgcn_ds_read_tr16_b64_v4i16((LAS s16x4*)(L + S2_KT + roff + kb * 32));
            khi[k4] = __builtin_amdgcn_ds_read_tr16_b64_v4i16((LAS s16x4*)(L + S2_KT + roff + kb * 32 + 4 * XRS)); }
#pragma unroll
        for (int k4 = 0; k4 < 4; ++k4) eb[k4] = *(const LAS f32x4*)(L + S2_EB + (ck * 128 + 16 * (4 * hb + k4) + 4 * q) * 4);
        __builtin_amdgcn_sched_barrier(0);
#pragma unroll
        for (int k4 = 0; k4 < 4; ++k4) st[4 * hb + k4] = __builtin_amdgcn_mfma_f32_16x16x32_bf16(__builtin_shufflevector(klo[k4], khi[k4], 0, 1, 2, 3, 4, 5, 6, 7), vf, st[4 * hb + k4], 0, 0, 0);
#pragma unroll
        for (int k4 = 0; k4 < 4; ++k4) st[4 * hb + k4] = st[4 * hb + k4] * eb[k4];
        __builtin_amdgcn_sched_barrier(0);
    }
}
__device__ __forceinline__ void state_load(const float* src, f32x4 (&st)[8], int w, int lane) {
    const float* p0 = src + w * 2048 + lane; const float* p1 = p0 + 1024;
#pragma unroll
    for (int kb = 0; kb < 8; ++kb)
#pragma unroll
        for (int rg = 0; rg < 4; ++rg) st[kb][rg] = src ? (kb < 4 ? p0[(kb * 4 + rg) * 64] : p1[((kb - 4) * 4 + rg) * 64]) : 0.f;
}
__device__ __forceinline__ void state_store(float* dst, const f32x4 (&st)[8], int w, int lane) {
    float* p0 = dst + w * 2048 + lane; float* p1 = p0 + 1024;
#pragma unroll
    for (int kb = 0; kb < 8; ++kb)
#pragma unroll
        for (int rg = 0; rg < 4; ++rg) { if (kb < 4) p0[(kb * 4 + rg) * 64] = st[kb][rg]; else p1[((kb - 4) * 4 + rg) * 64] = st[kb][rg]; }
}
__device__ __forceinline__ void scan_pass1_item(const Ctx& F, const bf16_t* P5, int b, int h, int dir, int seg, float* SST, float* EG) {
    const int chain = (b * 8 + h) * 2 + dir; const size_t rowb = (size_t)b * TL + (size_t)seg * SEGL;
    f32x4 st[8]; state_load(nullptr, st, F.wave, F.lane);
    float gacc = 0.f;
    u32x4 pf[8];
    prep1_issue(F, P5, rowb + 128 * (dir ? 1 : 0), dir != 0, h, dir, pf);
    for (int hs = 0; hs < 2; ++hs) {
        prep1_commit(F, pf);
        __syncthreads();
        if (hs == 0) prep1_issue(F, P5, rowb + 128 * (dir ? 0 : 1), dir != 0, h, dir, pf);
        if (F.tid < 128) { const LAS float* ebl = (const LAS float*)(F.lds + S2_EBL); gacc += (ebl[F.tid] + ebl[128 + F.tid]) + (ebl[256 + F.tid] + ebl[384 + F.tid]); }
#pragma unroll 1
        for (int ck = 0; ck < 4; ++ck) { state_update(F, st, ck); __builtin_amdgcn_sched_barrier(0); }
        __syncthreads();
    }
    state_store(SST + ((size_t)chain * NSEG + seg) * 16384, st, F.wave, F.lane);
    if (F.tid < 128) EG[((size_t)chain * NSEG + seg) * 128 + F.tid] = __expf(gacc);
}
__device__ __forceinline__ void half_scores(const Ctx& F) {
    LAS unsigned char* L = F.lds; const int lane = F.lane, i16 = lane & 15, q = lane >> 4, w = F.wave, ck = w >> 1, u = w & 1;
#pragma unroll
    for (int tt = 0; tt < 2; ++tt) {
        const int ti = u == 0 ? tt : 1 - tt, si = u == 0 ? tt : tt;
        f32x4 sc = (f32x4){0.f, 0.f, 0.f, 0.f};
        if (si <= ti) {
#pragma unroll
            for (int ks = 0; ks < 4; ++ks) { const bf16x8 a = *(const LAS bf16x8*)(L + S2_QT + (32 * ck + 16 * ti + i16) * XRS + (32 * ks + 8 * q) * 2); const bf16x8 bb = *(const LAS bf16x8*)(L + S2_KT + (32 * ck + 16 * si + i16) * XRS + (32 * ks + 8 * q) * 2);
                sc = __builtin_amdgcn_mfma_f32_16x16x32_bf16(a, bb, sc, 0, 0, 0); }
        }
#pragma unroll
        for (int rg = 0; rg < 4; ++rg) { const int t = 16 * ti + 4 * q + rg, sidx = 16 * si + i16; *(LAS bf16_t*)(L + S2_SC + (32 * ck + t) * SCRS + sidx * 2) = (bf16_t)f2bf(sidx <= t ? sc[rg] : 0.f); }
    }
}
__device__ __forceinline__ void chunk_out(const Ctx& F, const f32x4 (&st)[8], int ck, f32x4 (&o)[2]) {
    LAS unsigned char* L = F.lds; const int lane = F.lane, i16 = lane & 15, q = lane >> 4, w = F.wave;
    const int roff = (32 * ck + 8 * q + (i16 >> 2)) * XRS + 8 * (i16 & 3);
    o[0] = (f32x4){0.f, 0.f, 0.f, 0.f}; o[1] = (f32x4){0.f, 0.f, 0.f, 0.f};
    s16x4 vlo = __builtin_amdgcn_ds_read_tr16_b64_v4i16((LAS s16x4*)(L + S2_V + roff + w * 32));
    s16x4 vhi = __builtin_amdgcn_ds_read_tr16_b64_v4i16((LAS s16x4*)(L + S2_V + roff + w * 32 + 4 * XRS));
    bf16x8 pf[2];
#pragma unroll
    for (int ti = 0; ti < 2; ++ti) pf[ti] = *(const LAS bf16x8*)(L + S2_SC + (32 * ck + 16 * ti + i16) * SCRS + (8 * q) * 2);
#pragma unroll
    for (int kh = 0; kh < 2; ++kh) {
        u32x2 qlo[2][2], qhi[2][2]; bf16x8 sf[2];
#pragma unroll
        for (int k2 = 0; k2 < 2; ++k2) { const int ks = 2 * kh + k2;
#pragma unroll
            for (int ti = 0; ti < 2; ++ti) { const LAS unsigned char* qrow = L + S2_QT + (32 * ck + 16 * ti + i16) * XRS + (32 * ks + 4 * q) * 2; qlo[k2][ti] = *(const LAS u32x2*)(qrow); qhi[k2][ti] = *(const LAS u32x2*)(qrow + 32); }
            u32x4 sp; sp.x = pk2(st[2 * ks][0], st[2 * ks][1]); sp.y = pk2(st[2 * ks][2], st[2 * ks][3]); sp.z = pk2(st[2 * ks + 1][0], st[2 * ks + 1][1]); sp.w = pk2(st[2 * ks + 1][2], st[2 * ks + 1][3]); sf[k2] = __builtin_bit_cast(bf16x8, sp); }
        __builtin_amdgcn_sched_barrier(0);
#pragma unroll
        for (int k2 = 0; k2 < 2; ++k2)
#pragma unroll
            for (int ti = 0; ti < 2; ++ti) { u32x4 qp; qp.x = qlo[k2][ti].x; qp.y = qlo[k2][ti].y; qp.z = qhi[k2][ti].x; qp.w = qhi[k2][ti].y;
                o[ti] = __builtin_amdgcn_mfma_f32_16x16x32_bf16(sf[k2], __builtin_bit_cast(bf16x8, qp), o[ti], 0, 0, 0); }
        __builtin_amdgcn_sched_barrier(0);
    }
    const bf16x8 vf = __builtin_shufflevector(vlo, vhi, 0, 1, 2, 3, 4, 5, 6, 7);
#pragma unroll
    for (int ti = 0; ti < 2; ++ti) o[ti] = __builtin_amdgcn_mfma_f32_16x16x32_bf16(vf, pf[ti], o[ti], 0, 0, 0);
}
__device__ __forceinline__ void rows_g2l(const bf16_t* g, size_t row0, int rstep, int c0, LAS unsigned char* T, int tid) {
#pragma unroll
    for (int it = 0; it < 4; ++it) { const int idx = tid + 512 * it, p = idx >> 4, ch = idx & 15; *(LAS u32x4*)(T + p * XRS + ch * 16) = *(const u32x4*)(g + (size_t)((long)row0 + (long)rstep * p) * D + c0 + ch * 8); }
}
__device__ __forceinline__ void rows_l2g(bf16_t* g, size_t row0, int rstep, int c0, const LAS unsigned char* T, int tid) {
#pragma unroll
    for (int it = 0; it < 4; ++it) { const int idx = tid + 512 * it, p = idx >> 4, ch = idx & 15; *(u32x4*)(g + (size_t)((long)row0 + (long)rstep * p) * D + c0 + ch * 8) = *(const LAS u32x4*)(T + p * XRS + ch * 16); }
}
__device__ __forceinline__ void scan_pass3_item(const Ctx& F, const bf16_t* P5, size_t rowb, int h, const float* sin_f, const float* sin_b, float* fin_f, float* fin_b, const float* gain, bf16_t* OFT, bf16_t* Y, bool writey) {
    LAS unsigned char* L = F.lds; int lane = F.lane; asm volatile("" : "+v"(lane));
    const int i16 = lane & 15, q = lane >> 4, w = F.wave;
    const int colo = h * 128 + 16 * w + 4 * q;
    f32x4 st[8];
    state_load(sin_f, st, w, lane);
    for (int hs = 0; hs < 2; ++hs) {
        const size_t hrow = rowb + 128 * hs;
        half_prep<true>(F, P5, hrow, false, h, 0);
        __syncthreads();
        half_scores(F);
        __syncthreads();
        u32x2 of[4][2];
#pragma unroll
        for (int ck = 0; ck < 4; ++ck) { f32x4 o[2]; chunk_out(F, st, ck, o);
#pragma unroll
            for (int ti = 0; ti < 2; ++ti) { of[ck][ti].x = pk2(o[ti][0], o[ti][1]); of[ck][ti].y = pk2(o[ti][2], o[ti][3]); }
            __builtin_amdgcn_sched_barrier(0);
            state_update(F, st, ck);
            __builtin_amdgcn_sched_barrier(0); }
        __syncthreads();
#pragma unroll
        for (int ck = 0; ck < 4; ++ck)
#pragma unroll
            for (int ti = 0; ti < 2; ++ti) *(LAS u32x2*)(L + S2_QT + (32 * ck + 16 * ti + i16) * XRS + (16 * w + 4 * q) * 2) = of[ck][ti];
        __syncthreads();
        rows_l2g(OFT, hrow, 1, h * 128, L + S2_QT, F.tid);
        __syncthreads();
    }
    if (fin_f) state_store(fin_f, st, w, lane);
    state_load(sin_b, st, w, lane);
    const f32x4 gv = *(const f32x4*)(gain + colo);
    for (int hs = 0; hs < 2; ++hs) {
        const size_t hrow = rowb + 128 * (1 - hs);
        half_prep<true>(F, P5, hrow, true, h, 1);
        __syncthreads();
        half_scores(F);
        __syncthreads();
        LAS float* RED = (LAS float*)(L + S2_RED);
        f32x4 oa[4][2];
#pragma unroll
        for (int ck = 0; ck < 4; ++ck) { chunk_out(F, st, ck, oa[ck]);
            __builtin_amdgcn_sched_barrier(0);
            state_update(F, st, ck);
            __builtin_amdgcn_sched_barrier(0); }
        __syncthreads();
        rows_g2l(OFT, hrow + 127, -1, h * 128, L + S2_QT, F.tid);
        if (writey) {
#pragma unroll
            for (int it = 0; it < 4; ++it) { const int idx = F.tid + 512 * it, p = idx >> 4, ch = idx & 15; *(LAS u32x4*)(L + S2_KT + p * XRS + ch * 16) = *(const u32x4*)(P5 + ((size_t)h * MT + (hrow + 127 - p)) * 640 + 128 + ch * 8); } }
        __syncthreads();
#pragma unroll
        for (int ck = 0; ck < 4; ++ck)
#pragma unroll
            for (int ti = 0; ti < 2; ++ti) { const int p = 32 * ck + 16 * ti + i16; const u32x2 f = *(const LAS u32x2*)(L + S2_QT + p * XRS + (16 * w + 4 * q) * 2);
                oa[ck][ti][0] += bflo(f.x); oa[ck][ti][1] += bfhi(f.x); oa[ck][ti][2] += bflo(f.y); oa[ck][ti][3] += bfhi(f.y);
                float ss = (oa[ck][ti][0] * oa[ck][ti][0] + oa[ck][ti][1] * oa[ck][ti][1]) + (oa[ck][ti][2] * oa[ck][ti][2] + oa[ck][ti][3] * oa[ck][ti][3]);
                ss += shfl_x(ss, 16, lane); ss += shfl_x(ss, 32, lane);
                if (q == 0) RED[w * 128 + p] = ss; __builtin_amdgcn_sched_barrier(0); }
        __syncthreads();
        if (writey) {
#pragma unroll
            for (int ck = 0; ck < 4; ++ck)
#pragma unroll
                for (int ti = 0; ti < 2; ++ti) { __builtin_amdgcn_sched_barrier(0); const int p = 32 * ck + 16 * ti + i16; float tot = 0.f;
#pragma unroll
                    for (int ww = 0; ww < 8; ++ww) tot += RED[ww * 128 + p];
                    const float rs = rsqrtf(tot * (1.0f / 128.0f) + EPS);
                    const u32x2 sg = *(const LAS u32x2*)(L + S2_KT + p * XRS + (16 * w + 4 * q) * 2);
                    u32x2 y; y.x = pk2(oa[ck][ti][0] * rs * gv[0] * bflo(sg.x), oa[ck][ti][1] * rs * gv[1] * bfhi(sg.x)); y.y = pk2(oa[ck][ti][2] * rs * gv[2] * bflo(sg.y), oa[ck][ti][3] * rs * gv[3] * bfhi(sg.y));
                    *(LAS u32x2*)(L + S2_V + p * XRS + (16 * w + 4 * q) * 2) = y; }
            __syncthreads();
            rows_l2g(Y, hrow + 127, -1, h * 128, L + S2_V, F.tid);
        }
        __syncthreads();
    }
    if (fin_b) state_store(fin_b, st, w, lane);
}
constexpr int G2_KT = 0, G2_QT = 18432, G2_V = 36864, G2_SC = 55296, G2_EB = 60416, G2_EBL = 61440, G2_RED = 62464, G2_SLOT = 63488, G2_BYTES = 65536;
static_assert(2 * G2_BYTES <= MISC_OFF, "two-group scan LDS");
struct GC { LAS unsigned char* L; int tid, lane, wg; LAS unsigned* bar; unsigned epoch; };
__device__ __forceinline__ void gsync(GC& G) {
    asm volatile("s_waitcnt vmcnt(0) lgkmcnt(0)" ::: "memory");
    G.epoch += 4u;
    if (G.lane == 0) (void)__hip_atomic_fetch_add(G.bar, 1u, __ATOMIC_RELAXED, __HIP_MEMORY_SCOPE_WORKGROUP);
    while (__hip_atomic_load(G.bar, __ATOMIC_RELAXED, __HIP_MEMORY_SCOPE_WORKGROUP) < G.epoch) __builtin_amdgcn_s_sleep(0);
    asm volatile("" ::: "memory");
}
__device__ __forceinline__ void gsync_l(GC& G) {
    asm volatile("s_waitcnt lgkmcnt(0)" ::: "memory");
    G.epoch += 4u;
    if (G.lane == 0) (void)__hip_atomic_fetch_add(G.bar, 1u, __ATOMIC_RELAXED, __HIP_MEMORY_SCOPE_WORKGROUP);
    while (__hip_atomic_load(G.bar, __ATOMIC_RELAXED, __HIP_MEMORY_SCOPE_WORKGROUP) < G.epoch) __builtin_amdgcn_s_sleep(0);
    asm volatile("" ::: "memory");
}
__device__ __forceinline__ void quarter_load1(const GC& G, const bf16_t* P5, size_t hrow, bool rev, int h, int dir, u32x4 (&rk)[4], u32x4 (&rv)[4]) {
#pragma unroll
    for (int it = 0; it < 4; ++it) { const int idx = G.tid + 256 * it, p = idx >> 4, ch = idx & 15; const size_t r = hrow + (rev ? 63 - p : p); const bf16_t* rp = P5 + ((size_t)h * MT + r) * 640 + ch * 8;
        rk[it] = *(const u32x4*)(rp + (2 + dir) * 128); rv[it] = *(const u32x4*)(rp + 4 * 128); }
}
__device__ __forceinline__ void quarter_prep1(GC& G, const u32x4 (&rk)[4], const u32x4 (&rv)[4]) {
    const int tid = G.tid, ck = G.wg >> 1, dk = ((G.wg & 1) << 6) + G.lane; LAS unsigned char* L = G.L;
#pragma unroll
    for (int it = 0; it < 4; ++it) { const int idx = tid + 256 * it, p = idx >> 4, ch = idx & 15;
        *(LAS u32x4*)(L + G2_KT + p * XRS + ch * 16) = rk[it]; *(LAS u32x4*)(L + G2_V + p * XRS + ch * 16) = rv[it]; }
}
__device__ __forceinline__ void quarter_cols1(GC& G) {
    const int ck = G.wg >> 1, dk = ((G.wg & 1) << 6) + G.lane; LAS unsigned char* L = G.L;
    float b = 0.f; LAS unsigned char* kt = L + G2_KT + (32 * ck) * XRS + dk * 2;
    bf16_t lfr[32];
#pragma unroll
    for (int i = 0; i < 32; ++i) lfr[i] = *(const LAS bf16_t*)(kt + i * XRS);
    __builtin_amdgcn_sched_barrier(0);
#pragma unroll
    for (int i = 0; i < 32; ++i) { const float lf = bf2f(lfr[i]); b += lf;
        *(LAS bf16_t*)(kt + i * XRS) = (bf16_t)f2bf((1.0f - __expf(lf)) * __expf(fminf(-b, 80.0f))); }
    ((LAS float*)(L + G2_EB))[ck * 128 + dk] = __expf(b);
    ((LAS float*)(L + G2_EBL))[ck * 128 + dk] = b;
}
template <bool NEEDQ>
__device__ __forceinline__ void quarter_prep(GC& G, const bf16_t* P5, size_t hrow, bool rev, int h, int dir) {
    const int tid = G.tid, ck = G.wg >> 1, dk = ((G.wg & 1) << 6) + G.lane; LAS unsigned char* L = G.L;
    {
        u32x4 rk_[4], rq_[4], rv_[4];
#pragma unroll
        for (int it = 0; it < 4; ++it) { const int idx = tid + 256 * it, p = idx >> 4, ch = idx & 15; const size_t r = hrow + (rev ? 63 - p : p); const bf16_t* rp = P5 + ((size_t)h * MT + r) * 640 + ch * 8;
            rk_[it] = *(const u32x4*)(rp + (2 + dir) * 128); if (NEEDQ) rq_[it] = *(const u32x4*)(rp); rv_[it] = *(const u32x4*)(rp + 4 * 128); }
        __builtin_amdgcn_sched_barrier(0);
#pragma unroll
        for (int it = 0; it < 4; ++it) { const int idx = tid + 256 * it, p = idx >> 4, ch = idx & 15;
            *(LAS u32x4*)(L + G2_KT + p * XRS + ch * 16) = rk_[it]; if (NEEDQ) *(LAS u32x4*)(L + G2_QT + p * XRS + ch * 16) = rq_[it]; *(LAS u32x4*)(L + G2_V + p * XRS + ch * 16) = rv_[it]; }
    }
    gsync(G);
    float b = 0.f; LAS unsigned char* kt = L + G2_KT + (32 * ck) * XRS + dk * 2; LAS unsigned char* qt = L + G2_QT + (32 * ck) * XRS + dk * 2;
    bf16_t lfr[32], qr[32];
#pragma unroll
    for (int i = 0; i < 32; ++i) { lfr[i] = *(const LAS bf16_t*)(kt + i * XRS); if (NEEDQ) qr[i] = *(const LAS bf16_t*)(qt + i * XRS); }
    __builtin_amdgcn_sched_barrier(0);
#pragma unroll
    for (int i = 0; i < 32; ++i) { const float lf = bf2f(lfr[i]); b += lf;
        *(LAS bf16_t*)(kt + i * XRS) = (bf16_t)f2bf((1.0f - __expf(lf)) * __expf(fminf(-b, 80.0f)));
        if (NEEDQ) *(LAS bf16_t*)(qt + i * XRS) = (bf16_t)f2bf(bf2f(qr[i]) * __expf(b)); }
    ((LAS float*)(L + G2_EB))[ck * 128 + dk] = __expf(b);
    ((LAS float*)(L + G2_EBL))[ck * 128 + dk] = b;
}
__device__ __forceinline__ void state_update_g(const GC& G, f32x4 (&st)[2][8], int ck) {
    LAS unsigned char* L = G.L; const int lane = G.lane, i16 = lane & 15, q = lane >> 4, wg = G.wg;
    const int roff = (32 * ck + 8 * q + (i16 >> 2)) * XRS + 8 * (i16 & 3);
    bf16x8 vf[2];
#pragma unroll
    for (int ct = 0; ct < 2; ++ct) { const s16x4 vlo = __builtin_amdgcn_ds_read_tr16_b64_v4i16((LAS s16x4*)(L + G2_V + roff + (2 * wg + ct) * 32));
        const s16x4 vhi = __builtin_amdgcn_ds_read_tr16_b64_v4i16((LAS s16x4*)(L + G2_V + roff + (2 * wg + ct) * 32 + 4 * XRS)); vf[ct] = __builtin_shufflevector(vlo, vhi, 0, 1, 2, 3, 4, 5, 6, 7); }
#pragma unroll
    for (int hb = 0; hb < 2; ++hb) {
        s16x4 klo[4], khi[4]; f32x4 eb[4];
#pragma unroll
        for (int k4 = 0; k4 < 4; ++k4) { const int kb = 4 * hb + k4;
            klo[k4] = __builtin_amdgcn_ds_read_tr16_b64_v4i16((LAS s16x4*)(L + G2_KT + roff + kb * 32));
            khi[k4] = __builtin_amdgcn_ds_read_tr16_b64_v4i16((LAS s16x4*)(L + G2_KT + roff + kb * 32 + 4 * XRS)); }
#pragma unroll
        for (int k4 = 0; k4 < 4; ++k4) eb[k4] = *(const LAS f32x4*)(L + G2_EB + (ck * 128 + 16 * (4 * hb + k4) + 4 * q) * 4);
        __builtin_amdgcn_sched_barrier(0);
#pragma unroll
        for (int k4 = 0; k4 < 4; ++k4) { const bf16x8 kf = __builtin_shufflevector(klo[k4], khi[k4], 0, 1, 2, 3, 4, 5, 6, 7);
#pragma unroll
            for (int ct = 0; ct < 2; ++ct) st[ct][4 * hb + k4] = __builtin_amdgcn_mfma_f32_16x16x32_bf16(kf, vf[ct], st[ct][4 * hb + k4], 0, 0, 0); }
#pragma unroll
        for (int k4 = 0; k4 < 4; ++k4)
#pragma unroll
            for (int ct = 0; ct < 2; ++ct) st[ct][4 * hb + k4] = st[ct][4 * hb + k4] * eb[k4];
        __builtin_amdgcn_sched_barrier(0);
    }
}
__device__ __forceinline__ void state_load_g(const float* src, f32x4 (&st)[2][8], int wg, int lane) {
#pragma unroll
    for (int ct = 0; ct < 2; ++ct) { const float* p0 = src + (2 * wg + ct) * 2048 + lane; const float* p1 = p0 + 1024;
#pragma unroll
        for (int kb = 0; kb < 8; ++kb)
#pragma unroll
            for (int rg = 0; rg < 4; ++rg) st[ct][kb][rg] = src ? (kb < 4 ? p0[(kb * 4 + rg) * 64] : p1[((kb - 4) * 4 + rg) * 64]) : 0.f; }
}
__device__ __forceinline__ void state_store_g(float* dst, const f32x4 (&st)[2][8], int wg, int lane) {
#pragma unroll
    for (int ct = 0; ct < 2; ++ct) { float* p0 = dst + (2 * wg + ct) * 2048 + lane; float* p1 = p0 + 1024;
#pragma unroll
        for (int kb = 0; kb < 8; ++kb)
#pragma unroll
            for (int rg = 0; rg < 4; ++rg) { if (kb < 4) p0[(kb * 4 + rg) * 64] = st[ct][kb][rg]; else p1[((kb - 4) * 4 + rg) * 64] = st[ct][kb][rg]; } }
}
__device__ __forceinline__ void quarter_scores(const GC& G) {
    LAS unsigned char* L = G.L; const int lane = G.lane, i16 = lane & 15, q = lane >> 4, ck = G.wg >> 1, u = G.wg & 1;
#pragma unroll
    for (int tt = 0; tt < 2; ++tt) {
        const int ti = u == 0 ? tt : 1 - tt, si = tt;
        f32x4 sc = (f32x4){0.f, 0.f, 0.f, 0.f};
        if (si <= ti) {
#pragma unroll
            for (int ks = 0; ks < 4; ++ks) { const bf16x8 a = *(const LAS bf16x8*)(L + G2_QT + (32 * ck + 16 * ti + i16) * XRS + (32 * ks + 8 * q) * 2); const bf16x8 bb = *(const LAS bf16x8*)(L + G2_KT + (32 * ck + 16 * si + i16) * XRS + (32 * ks + 8 * q) * 2);
                sc = __builtin_amdgcn_mfma_f32_16x16x32_bf16(a, bb, sc, 0, 0, 0); }
        }
#pragma unroll
        for (int rg = 0; rg < 4; ++rg) { const int t = 16 * ti + 4 * q + rg, sidx = 16 * si + i16; *(LAS bf16_t*)(L + G2_SC + (32 * ck + t) * SCRS + sidx * 2) = (bf16_t)f2bf(sidx <= t ? sc[rg] : 0.f); }
    }
}
__device__ __forceinline__ void chunk_out_g(const GC& G, const f32x4 (&st)[2][8], int ck, f32x4 (&o)[2][2]) {
    LAS unsigned char* L = G.L; const int lane = G.lane, i16 = lane & 15, q = lane >> 4, wg = G.wg;
    const int roff = (32 * ck + 8 * q + (i16 >> 2)) * XRS + 8 * (i16 & 3);
#pragma unroll
    for (int ct = 0; ct < 2; ++ct) { o[ct][0] = (f32x4){0.f, 0.f, 0.f, 0.f}; o[ct][1] = (f32x4){0.f, 0.f, 0.f, 0.f}; }
    bf16x8 vf[2], pf[2];
#pragma unroll
    for (int ct = 0; ct < 2; ++ct) { const s16x4 vlo = __builtin_amdgcn_ds_read_tr16_b64_v4i16((LAS s16x4*)(L + G2_V + roff + (2 * wg + ct) * 32));
        const s16x4 vhi = __builtin_amdgcn_ds_read_tr16_b64_v4i16((LAS s16x4*)(L + G2_V + roff + (2 * wg + ct) * 32 + 4 * XRS)); vf[ct] = __builtin_shufflevector(vlo, vhi, 0, 1, 2, 3, 4, 5, 6, 7); }
#pragma unroll
    for (int ti = 0; ti < 2; ++ti) pf[ti] = *(const LAS bf16x8*)(L + G2_SC + (32 * ck + 16 * ti + i16) * SCRS + (8 * q) * 2);
#pragma unroll
    for (int kh = 0; kh < 2; ++kh) {
        u32x2 qlo[2][2], qhi[2][2]; bf16x8 sf[2][2];
#pragma unroll
        for (int k2 = 0; k2 < 2; ++k2) { const int ks = 2 * kh + k2;
#pragma unroll
            for (int ti = 0; ti < 2; ++ti) { const LAS unsigned char* qrow = L + G2_QT + (32 * ck + 16 * ti + i16) * XRS + (32 * ks + 4 * q) * 2; qlo[k2][ti] = *(const LAS u32x2*)(qrow); qhi[k2][ti] = *(const LAS u32x2*)(qrow + 32); }
#pragma unroll
            for (int ct = 0; ct < 2; ++ct) { u32x4 sp; sp.x = pk2(st[ct][2 * ks][0], st[ct][2 * ks][1]); sp.y = pk2(st[ct][2 * ks][2], st[ct][2 * ks][3]); sp.z = pk2(st[ct][2 * ks + 1][0], st[ct][2 * ks + 1][1]); sp.w = pk2(st[ct][2 * ks + 1][2], st[ct][2 * ks + 1][3]); sf[k2][ct] = __builtin_bit_cast(bf16x8, sp); } }
        __builtin_amdgcn_sched_barrier(0);
#pragma unroll
        for (int k2 = 0; k2 < 2; ++k2)
#pragma unroll
            for (int ti = 0; ti < 2; ++ti) { u32x4 qp; qp.x = qlo[k2][ti].x; qp.y = qlo[k2][ti].y; qp.z = qhi[k2][ti].x; qp.w = qhi[k2][ti].y;
#pragma unroll
                for (int ct = 0; ct < 2; ++ct) o[ct][ti] = __builtin_amdgcn_mfma_f32_16x16x32_bf16(sf[k2][ct], __builtin_bit_cast(bf16x8, qp), o[ct][ti], 0, 0, 0); }
        __builtin_amdgcn_sched_barrier(0);
    }
#pragma unroll
    for (int ct = 0; ct < 2; ++ct)
#pragma unroll
        for (int ti = 0; ti < 2; ++ti) o[ct][ti] = __builtin_amdgcn_mfma_f32_16x16x32_bf16(vf[ct], pf[ti], o[ct][ti], 0, 0, 0);
}
__device__ __forceinline__ void rows_g2l_g(const bf16_t* g, size_t row0, int rstep, int c0, LAS unsigned char* T, int tid) {
    u32x4 r_[4];
#pragma unroll
    for (int it = 0; it < 4; ++it) { const int idx = tid + 256 * it, p = idx >> 4, ch = idx & 15; r_[it] = *(const u32x4*)(g + (size_t)((long)row0 + (long)rstep * p) * D + c0 + ch * 8); }
    __builtin_amdgcn_sched_barrier(0);
#pragma unroll
    for (int it = 0; it < 4; ++it) { const int idx = tid + 256 * it, p = idx >> 4, ch = idx & 15; *(LAS u32x4*)(T + p * XRS + ch * 16) = r_[it]; }
}
__device__ __forceinline__ void rows_l2g_g(bf16_t* g, size_t row0, int rstep, int c0, const LAS unsigned char* T, int tid) {
#pragma unroll
    for (int it = 0; it < 4; ++it) { const int idx = tid + 256 * it, p = idx >> 4, ch = idx & 15; *(u32x4*)(g + (size_t)((long)row0 + (long)rstep * p) * D + c0 + ch * 8) = *(const LAS u32x4*)(T + p * XRS + ch * 16); }
}
__device__ __forceinline__ void scan_pass1_item_g(GC& G, const bf16_t* P5, int b, int h, int dir, int seg, float* SST, float* EG) {
    const int chain = (b * 8 + h) * 2 + dir; const size_t rowb = (size_t)b * TL + (size_t)seg * SEGL;
    f32x4 st[2][8]; state_load_g(nullptr, st, G.wg, G.lane);
    float gacc = 0.f;
    u32x4 rk[4], rv[4];
    quarter_load1(G, P5, rowb + 64 * (dir ? 3 : 0), dir != 0, h, dir, rk, rv);
    for (int hs = 0; hs < 4; ++hs) {
        asm volatile("s_waitcnt vmcnt(0)" ::: "memory");
        quarter_prep1(G, rk, rv);
        __builtin_amdgcn_sched_barrier(0);
        if (hs < 3) quarter_load1(G, P5, rowb + 64 * (dir ? 2 - hs : hs + 1), dir != 0, h, dir, rk, rv);
        gsync_l(G);
        quarter_cols1(G);
        gsync_l(G);
        if (G.tid < 128) { const LAS float* ebl = (const LAS float*)(G.L + G2_EBL); gacc += ebl[G.tid] + ebl[128 + G.tid]; }
#pragma unroll 1
        for (int ck = 0; ck < 2; ++ck) { state_update_g(G, st, ck); __builtin_amdgcn_sched_barrier(0); }
        gsync_l(G);
    }
    state_store_g(SST + ((size_t)chain * NSEG + seg) * 16384, st, G.wg, G.lane);
    if (G.tid < 128) EG[((size_t)chain * NSEG + seg) * 128 + G.tid] = __expf(gacc);
}
__device__ __forceinline__ void scan_pass3_item_g(GC& G, const bf16_t* P5, size_t rowb, int h, const float* sin_f, const float* sin_b, float* fin_f, float* fin_b, const float* gain, bf16_t* OFT, bf16_t* Y, bool writey) {
    LAS unsigned char* L = G.L; const int lane = G.lane, i16 = lane & 15, q = lane >> 4, wg = G.wg;
    f32x4 st[2][8];
    state_load_g(sin_f, st, wg, lane);
    for (int hs = 0; hs < 4; ++hs) {
        const size_t hrow = rowb + 64 * hs;
        quarter_prep<true>(G, P5, hrow, false, h, 0);
        gsync(G);
        quarter_scores(G);
        gsync(G);
        u32x2 of[2][2][2];
#pragma unroll
        for (int ck = 0; ck < 2; ++ck) { f32x4 o[2][2]; chunk_out_g(G, st, ck, o);
#pragma unroll
            for (int ct = 0; ct < 2; ++ct)
#pragma unroll
                for (int ti = 0; ti < 2; ++ti) { of[ck][ct][ti].x = pk2(o[ct][ti][0], o[ct][ti][1]); of[ck][ct][ti].y = pk2(o[ct][ti][2], o[ct][ti][3]); }
            __builtin_amdgcn_sched_barrier(0);
            state_update_g(G, st, ck);
            __builtin_amdgcn_sched_barrier(0); }
        gsync(G);
#pragma unroll
        for (int ck = 0; ck < 2; ++ck)
#pragma unroll
            for (int ct = 0; ct < 2; ++ct)
#pragma unroll
                for (int ti = 0; ti < 2; ++ti) *(LAS u32x2*)(L + G2_QT + (32 * ck + 16 * ti + i16) * XRS + (32 * wg + 16 * ct + 4 * q) * 2) = of[ck][ct][ti];
        gsync(G);
        rows_l2g_g(OFT, hrow, 1, h * 128, L + G2_QT, G.tid);
        gsync(G);
    }
    if (fin_f) state_store_g(fin_f, st, wg, lane);
    state_load_g(sin_b, st, wg, lane);
    f32x4 gv[2];
#pragma unroll
    for (int ct = 0; ct < 2; ++ct) gv[ct] = *(const f32x4*)(gain + h * 128 + 32 * wg + 16 * ct + 4 * q);
    for (int hs = 0; hs < 4; ++hs) {
        const size_t hrow = rowb + 64 * (3 - hs);
        quarter_prep<true>(G, P5, hrow, true, h, 1);
        gsync(G);
        quarter_scores(G);
        gsync(G);
        LAS float* RED = (LAS float*)(L + G2_RED);
        f32x4 oa[2][2][2];
#pragma unroll
        for (int ck = 0; ck < 2; ++ck) { chunk_out_g(G, st, ck, oa[ck]);
            __builtin_amdgcn_sched_barrier(0);
            state_update_g(G, st, ck);
            __builtin_amdgcn_sched_barrier(0); }
        gsync(G);
        rows_g2l_g(OFT, hrow + 63, -1, h * 128, L + G2_QT, G.tid);
        if (writey) { u32x4 gr_[4];
#pragma unroll
            for (int it = 0; it < 4; ++it) { const int idx = G.tid + 256 * it, p = idx >> 4, ch = idx & 15; gr_[it] = *(const u32x4*)(P5 + ((size_t)h * MT + (hrow + 63 - p)) * 640 + 128 + ch * 8); }
            __builtin_amdgcn_sched_barrier(0);
#pragma unroll
            for (int it = 0; it < 4; ++it) { const int idx = G.tid + 256 * it, p = idx >> 4, ch = idx & 15; *(LAS u32x4*)(L + G2_KT + p * XRS + ch * 16) = gr_[it]; } }
        gsync(G);
#pragma unroll
        for (int ck = 0; ck < 2; ++ck)
#pragma unroll
            for (int ti = 0; ti < 2; ++ti) { const int p = 32 * ck + 16 * ti + i16; float ss = 0.f;
#pragma unroll
                for (int ct = 0; ct < 2; ++ct) { const u32x2 f = *(const LAS u32x2*)(L + G2_QT + p * XRS + (32 * wg + 16 * ct + 4 * q) * 2);
                    oa[ck][ct][ti][0] += bflo(f.x); oa[ck][ct][ti][1] += bfhi(f.x); oa[ck][ct][ti][2] += bflo(f.y); oa[ck][ct][ti][3] += bfhi(f.y);
                    ss += (oa[ck][ct][ti][0] * oa[ck][ct][ti][0] + oa[ck][ct][ti][1] * oa[ck][ct][ti][1]) + (oa[ck][ct][ti][2] * oa[ck][ct][ti][2] + oa[ck][ct][ti][3] * oa[ck][ct][ti][3]); }
                ss += shfl_x(ss, 16, lane); ss += shfl_x(ss, 32, lane);
                if (q == 0) RED[wg * 64 + p] = ss; }
        gsync(G);
        if (writey) {
#pragma unroll
            for (int ck = 0; ck < 2; ++ck)
#pragma unroll
                for (int ti = 0; ti < 2; ++ti) { const int p = 32 * ck + 16 * ti + i16; const float tot = (RED[p] + RED[64 + p]) + (RED[128 + p] + RED[192 + p]);
                    const float rs = rsqrtf(tot * (1.0f / 128.0f) + EPS);
#pragma unroll
                    for (int ct = 0; ct < 2; ++ct) { const u32x2 sg = *(const LAS u32x2*)(L + G2_KT + p * XRS + (32 * wg + 16 * ct + 4 * q) * 2);
                        u32x2 y; y.x = pk2(oa[ck][ct][ti][0] * rs * gv[ct][0] * bflo(sg.x), oa[ck][ct][ti][1] * rs * gv[ct][1] * bfhi(sg.x)); y.y = pk2(oa[ck][ct][ti][2] * rs * gv[ct][2] * bflo(sg.y), oa[ck][ct][ti][3] * rs * gv[ct][3] * bfhi(sg.y));
                        *(LAS u32x2*)(L + G2_V + p * XRS + (32 * wg + 16 * ct + 4 * q) * 2) = y; } }
            gsync(G);
            rows_l2g_g(Y, hrow + 63, -1, h * 128, L + G2_V, G.tid);
        }
        gsync(G);
    }
    if (fin_b) state_store_g(fin_b, st, wg, lane);
}
__device__ __forceinline__ int gq_next(GC& G, unsigned* ctr, unsigned ngroups) {
    LAS unsigned* slot = (LAS unsigned*)(G.L + G2_SLOT);
    gsync(G);
    if (G.tid == 0) *slot = ngroups + __hip_atomic_fetch_add(ctr, 1u, __ATOMIC_RELAXED, __HIP_MEMORY_SCOPE_AGENT);
    gsync(G);
    return (int)*slot;
}

__device__ __forceinline__ void scan_carry(const Ctx& F) {
    float* SST = (float*)(F.ws + WS_SST); const float* EG = (const float*)(F.ws + WS_EG); const float* S0 = (const float*)(F.ws + WS_S0);
    const int gt = F.bid * 512 + F.tid, NGT = F.G * 512;
    for (int idx = gt; idx < NCHAIN * 16384; idx += NGT) {
        const int chain = idx >> 14, e = idx & 16383, dir = chain & 1;
        const int lanee = e & 63, rg = (e >> 6) & 3, kb = (e >> 8) & 7; const int dk = 16 * kb + 4 * (lanee >> 4) + rg;
        float cur = S0[(size_t)chain * 16384 + e];
        float* base = SST + (size_t)chain * NSEG * 16384 + e; const float* eg = EG + (size_t)chain * NSEG * 128 + dk;
        for (int s0 = 0; s0 < NSEG; s0 += 8) {
            float tmp[8], gg[8];
#pragma unroll
            for (int i = 0; i < 8; ++i) { const int seg = dir ? NSEG - 1 - (s0 + i) : s0 + i; tmp[i] = base[(size_t)seg * 16384]; gg[i] = eg[seg * 128]; }
#pragma unroll
            for (int i = 0; i < 8; ++i) { const int seg = dir ? NSEG - 1 - (s0 + i) : s0 + i; base[(size_t)seg * 16384] = cur; cur = gg[i] * cur + tmp[i]; }
        }
    }
}

__device__ __forceinline__ void moe_slots(const Ctx& F, int nrows) {
    const int tid = F.tid; const int nitems = F.NGW;
    const RowPart rp = row_part(F.NGW, nrows);
    const int* cnt = (const int*)(F.ws + WS_CNT); const int* tope = (const int*)(F.ws + WS_TOPE); const int* rank = (const int*)(F.ws + WS_RANK);
    int* slotrow = (int*)(F.ws + WS_SLOTROW); int* slotdst = (int*)(F.ws + WS_SLOTDST); int* tilex = (int*)(F.ws + WS_TILEX); int* slotof = (int*)(F.ws + WS_SLOTOF);
    LAS int* pre = (LAS int*)F.lds;
    LAS int* tsum = (LAS int*)(F.lds + 69632);
    LAS int* ebase = (LAS int*)(F.lds + 69632 + 16384);
    const int IPT = (nitems + 511) / 512;
    int loc[8] = {0, 0, 0, 0, 0, 0, 0, 0};
    for (int i = 0; i < IPT; ++i) { const int it = tid * IPT + i; if (it < nitems) {
#pragma unroll
        for (int e = 0; e < 8; ++e) loc[e] += cnt[it * 8 + e]; } }
    {
        const int lane = F.lane, wv = F.wave; LAS int* wsum = ebase + 32;
        int inc[8];
#pragma unroll
        for (int e = 0; e < 8; ++e) { int v = loc[e];
#pragma unroll
            for (int o = 1; o < 64; o <<= 1) { const int u = __builtin_amdgcn_ds_bpermute(((lane - o) & 63) << 2, v); if (lane >= o) v += u; }
            inc[e] = v; }
        if (lane == 63) {
#pragma unroll
            for (int e = 0; e < 8; ++e) wsum[wv * 8 + e] = inc[e]; }
        __syncthreads();
#pragma unroll
        for (int e = 0; e < 8; ++e) { int below = 0, tot = 0;
#pragma unroll
            for (int w2 = 0; w2 < 8; ++w2) { const int t_ = wsum[w2 * 8 + e]; tot += t_; if (w2 < wv) below += t_; }
            tsum[tid * 8 + e] = below + inc[e] - loc[e];
            if (tid == 0) ebase[8 + e] = tot; }
    }
    __syncthreads();
    if (tid == 0) { int b = 0; for (int e = 0; e < 8; ++e) { ebase[e] = b; b += (ebase[8 + e] + 255) & ~255; } ebase[16] = b / 256; }
    { int run[8];
#pragma unroll
      for (int e = 0; e < 8; ++e) run[e] = tsum[tid * 8 + e];
      for (int i = 0; i < IPT; ++i) { const int it = tid * IPT + i; if (it < nitems) {
#pragma unroll
          for (int e = 0; e < 8; ++e) { pre[it * 8 + e] = run[e]; run[e] += cnt[it * 8 + e]; } } } }
    __syncthreads();
    for (int r = F.bid * 512 + tid; r < nrows; r += F.G * 512) {
        const int ch = row_chunk_of(rp, r);
#pragma unroll
        for (int kk = 0; kk < 2; ++kk) { const int e = tope[2 * r + kk]; const int slot = ebase[e] + pre[ch * 8 + e] + rank[2 * r + kk]; slotrow[slot] = r; slotdst[slot] = 2 * r + kk; slotof[2 * r + kk] = slot; }
    }
    if (F.bid == 0) {
        const int ntiles = ebase[16];
        if (tid == 0) tilex[0] = ntiles;
        for (int e = 0; e < 8; ++e) { const int b0 = ebase[e], tot = ebase[8 + e], pad = (tot + 255) & ~255;
            for (int s = b0 + tot + tid; s < b0 + pad; s += 512) { slotrow[s] = 0; slotdst[s] = -1; }
            for (int t = b0 / 256 + tid; t < (b0 + pad) / 256; t += 512) tilex[16 + t] = e; }
    }
}

__global__ void __launch_bounds__(512, 2) fwd_kernel(Args args) {
    extern __shared__ __attribute__((aligned(16))) unsigned char lds_raw[];
    Ctx F;
    F.lds = (LAS unsigned char*)lds_raw; F.tid = threadIdx.x; F.lane = F.tid & 63; F.wave = __builtin_amdgcn_readfirstlane(F.tid >> 6);
    F.G = gridDim.x; F.bid = blockIdx.x; F.gw = F.bid * 8 + F.wave; F.NGW = F.G * 8;
    F.in = args.in; F.out = args.out; F.ws = args.ws;
    volatile LAS unsigned* MISC = (volatile LAS unsigned*)(F.lds + MISC_OFF);
    if (F.tid < 64) MISC[F.tid] = 0u;
    __syncthreads();
    const int lo = args.ph_lo, hi = args.ph_hi;
    XcdBarrier bar; bar.bar = (unsigned*)(F.ws + WS_CTL) + 4096; bar.x = 0; bar.st = nullptr;
    const bool multi = (hi - lo) > 1;
    if (multi) bar = xcd_barrier_post((unsigned*)(F.ws + WS_CTL) + 4096, MISC + 8);
#define IN(k) (lo <= (k) && (k) < hi)
#if defined(PROBE_TMASK)
    unsigned long long pt_last = __builtin_amdgcn_s_memrealtime(), pt_acc = 0ull;
#define PROBE_T(k) do { const unsigned long long now_ = __builtin_amdgcn_s_memrealtime(); if ((((unsigned long long)(PROBE_TMASK)) >> (k)) & 1ull) pt_acc += now_ - pt_last; pt_last = now_; } while (0)
#else
#define PROBE_T(k) do { } while (0)
#endif
#define SEAM(k) do { if (IN(k) && IN((k) + 1)) xcd_barrier(bar); PROBE_T(k); asm volatile("" : "+v"(F.tid), "+s"(F.G)); LAUNDER_WS_OUT(); F.NGW = F.G * 8; F.lane = F.tid & 63; F.wave = __builtin_amdgcn_readfirstlane(F.tid >> 6); F.gw = F.bid * 8 + F.wave; } while (0)

#define MODS_ ((float*)(F.ws + WS_MODS))
#define XB_ ((bf16_t*)(F.ws + WS_XB))
#define H_ ((bf16_t*)(F.ws + WS_H))
#define YE_ ((bf16_t*)(F.ws + WS_YE))

    if (IN(PH_P0)) for (int rep_ = 0; rep_ < NREP(18); ++rep_) { p0_prologue(F); }
#if defined(PROBE_SLEEP)
    if (IN(PH_P0)) { const unsigned long long t0 = __builtin_amdgcn_s_memrealtime(); while (__builtin_amdgcn_s_memrealtime() - t0 < (unsigned long long)PROBE_SLEEP * 100ull) __builtin_amdgcn_s_sleep(32); }
#endif
    SEAM(PH_P0);

#if defined(PROBE_GEMM)
    if (IN(PH_P0)) {
        pg8::Gemm g{H_, (const bf16_t*)(F.ws + WS_WINE), ML, NEIN, D, nullptr, nullptr, 0}; pg8::StaticOrder S; S.init(ML, NEIN, D, F.G, F.bid);
#if PROBE_GEMM == 1
        pg8::EpiEvenIn E{(bf16_t*)(F.ws + WS_UP)}; pg8::gemm_phase<pg8::EpiEvenIn, pg8::StaticOrder, true, false>(F.lds, g, S, E, F.tid);
#elif PROBE_GEMM == 2
        pg8::EpiNull E{(float*)(F.ws + WS_UP)}; pg8::gemm_phase<pg8::EpiNull, pg8::StaticOrder, true, false>(F.lds, g, S, E, F.tid);
#endif
        xcd_barrier(bar);
    }
#endif

    for (int lp = 0; lp < 2; ++lp) {
        const int pb = PH_PAIR0 + lp * NPL;
        const int le = 2 * lp, lo_ = 2 * lp + 1;
        const float* modE = MODS_ + (size_t)le * 3 * 6144; const float* modO = MODS_ + (size_t)lo_ * 3 * 6144;
        if (IN(pb + E1_NORM)) for (int rep_ = 0; rep_ < NREP(E1_NORM); ++rep_) {
            RowPass P{}; P.sl = FIN(I_X); P.sc = FIN(I_CTX); P.xb = XB_; P.gain = FIN(I_NMIX) + le * D; P.shift = modE + 0 * D; P.scale = modE + 1 * D; P.H = H_; P.nrows = MT;
            if (lp == 0) row_pass<false, false, false, false>(F, P);
            else { P.YE = YE_; P.topp = (const float*)(F.ws + WS_TOPP); P.gatef = MODS_ + (size_t)(le - 1) * 3 * 6144 + 5 * D; P.slotof = (const int*)(F.ws + WS_SLOTOF); P.partm = (const float*)(F.ws + WS_PARTM); row_pass_b<true, false, false, 2>(F, P); }
        }
        SEAM(pb + E1_NORM);
        if (IN(pb + E2_GIN)) for (int rep_ = 0; rep_ < NREP(E2_GIN); ++rep_) {
            pg8::Gemm g{H_, (const bf16_t*)(F.ws + WS_WINE) + (size_t)lp * NEIN * D, MT, NEIN, D, nullptr, nullptr, 0}; pg8::StaticOrder S; S.init(MT, NEIN, D, F.G, F.bid);
            pg8::EpiEvenIn E{(bf16_t*)(F.ws + WS_PZUV)};
            pg8::gemm_phase<pg8::EpiEvenIn, pg8::StaticOrder, true, false>(F.lds, g, S, E, F.tid);
        }
        SEAM(pb + E2_GIN);
        if (IN(pb + E3_FFTA)) for (int rep_ = 0; rep_ < NREP(E3_FFTA); ++rep_) fft_stage_a(F, (unsigned*)(F.ws + WS_CTL) + 8192 + 64 * (pb + E3_FFTA));
        SEAM(pb + E3_FFTA);
        if (IN(pb + E3_FFTC)) for (int rep_ = 0; rep_ < NREP(E3_FFTC); ++rep_) fft_stage_c_gmlp(F, lp, (unsigned*)(F.ws + WS_CTL) + 8192 + 64 * (pb + E3_FFTC));
        SEAM(pb + E3_FFTC);
        if (IN(pb + E4_GOUT)) for (int rep_ = 0; rep_ < NREP(E4_GOUT); ++rep_) {
            pg8::Gemm g{H_, (const bf16_t*)(F.ws + WS_WOUTE) + (size_t)lp * D * D, MT, D, D, nullptr, nullptr, 0}; pg8::ResOrder S; S.init(D, F.G, F.bid, true);
            if (lp == 0) { pg8::EpiRes<true> E{FIN(I_X), XB_, modE + 2 * D, (float*)(F.ws + WS_PARTC)}; pg8::gemm_phase<pg8::EpiRes<true>, pg8::ResOrder, false, false>(F.lds, g, S, E, F.tid); }
            else { pg8::EpiRes<false> E{nullptr, XB_, modE + 2 * D, (float*)(F.ws + WS_PARTC)}; pg8::gemm_phase<pg8::EpiRes<false>, pg8::ResOrder, false, false>(F.lds, g, S, E, F.tid); }
        }
        SEAM(pb + E4_GOUT);
        if (IN(pb + E5_NORM)) for (int rep_ = 0; rep_ < NREP(E5_NORM); ++rep_) {
            RowPass P{}; P.xb = XB_; P.csrc32 = lp == 0 ? FIN(I_CTX) : nullptr; P.gain = FIN(I_NFFN) + le * D; P.shift = modE + 3 * D; P.scale = modE + 4 * D; P.H = H_; P.nrows = MT;
            P.part = (const float*)(F.ws + WS_PARTC); P.kpn = CTX_KP; P.pgate = modE + 2 * D;
            row_pass_b<false, false, false, 4>(F, P);
        }
        SEAM(pb + E5_NORM);
        if (IN(pb + E6_UP)) for (int rep_ = 0; rep_ < NREP(E6_UP); ++rep_) {
            pg8::Gemm g{H_, (const bf16_t*)(F.ws + WS_W13) + (size_t)lp * NFF2 * D, MT, NFF2, D, nullptr, nullptr, 0}; pg8::StaticOrder S; S.init(MT, NFF2, D, F.G, F.bid);
            pg8::EpiSwiglu E{(bf16_t*)(F.ws + WS_HID), DFF};
            pg8::gemm_phase<pg8::EpiSwiglu, pg8::StaticOrder, true, false>(F.lds, g, S, E, F.tid);
        }
        SEAM(pb + E6_UP);
        if (IN(pb + E7_DOWN)) for (int rep_ = 0; rep_ < NREP(E7_DOWN); ++rep_) {
            pg8::Gemm g{(const bf16_t*)(F.ws + WS_HID), (const bf16_t*)(F.ws + WS_W2) + (size_t)lp * D * DFF, MT, D, DFF, nullptr, nullptr, 0}; pg8::ResOrder S; S.init(DFF, F.G, F.bid, true);
            pg8::EpiRes<false> E{nullptr, XB_, modE + 5 * D, (float*)(F.ws + WS_PARTC)};
            pg8::gemm_phase<pg8::EpiRes<false>, pg8::ResOrder, false, false>(F.lds, g, S, E, F.tid);
        }
        SEAM(pb + E7_DOWN);
        const bool lastl = lp == 1;
        if (IN(pb + O1_NORM)) for (int rep_ = 0; rep_ < NREP(O1_NORM); ++rep_) {
            RowPass P{}; P.xb = XB_; P.gain = FIN(I_NMIX) + lo_ * D; P.shift = modO + 0 * D; P.scale = modO + 1 * D; P.H = H_; P.nrows = MT;
            P.part = (const float*)(F.ws + WS_PARTC); P.kpn = CTX_KP; P.pgate = modE + 5 * D;
            row_pass_b<false, false, false, 4>(F, P);
        }
        SEAM(pb + O1_NORM);
        if (IN(pb + O2_GIN)) for (int rep_ = 0; rep_ < NREP(O2_GIN); ++rep_) {
            pg8::Gemm g{H_, (const bf16_t*)(F.ws + WS_WINO) + (size_t)lp * NREC * D, MT, NREC, D, nullptr, nullptr, 0}; pg8::StaticOrder S; S.init(MT, NREC, D, F.G, F.bid);
            pg8::EpiOddIn E{(bf16_t*)(F.ws + WS_P5), (const float*)(F.ws + WS_LB) + lp * 2048};
            pg8::gemm_phase<pg8::EpiOddIn, pg8::StaticOrder, true, false>(F.lds, g, S, E, F.tid);
        }
        SEAM(pb + O2_GIN);
        if (IN(pb + O3_SCAN1)) {
            const int grp = F.wave >> 2; const int NG = F.G * 2, gid = F.bid * 2 + grp;
            GC G; G.L = F.lds + grp * G2_BYTES; G.wg = F.wave & 3; G.tid = F.tid & 255; G.lane = F.lane; G.bar = (LAS unsigned*)(F.lds + MISC_OFF + 128 + 4 * grp);
            __syncthreads(); G.epoch = __hip_atomic_load(G.bar, __ATOMIC_RELAXED, __HIP_MEMORY_SCOPE_WORKGROUP);
            constexpr int NCONV = MOE_CONV_ITEMS / 4, NITEMS = 16 + 4096 + (NCONV - 2048);
            for (int it = gid; it < NITEMS; ) {
                { int t_ = F.tid; asm volatile("" : "+v"(t_)); LAUNDER_WS_OUT(); G.tid = t_ & 255; G.lane = t_ & 63; F.lane = G.lane; }
                const bf16_t* P5 = (const bf16_t*)(F.ws + WS_P5); float* SST = (float*)(F.ws + WS_SST); float* EG = (float*)(F.ws + WS_EG); float* S0 = (float*)(F.ws + WS_S0);
                const float* gain = FIN(I_RNORM) + lp * D; unsigned* wq = (unsigned*)(F.ws + WS_CTL) + 8192 + 64 * (pb + O3_SCAN1);
                int it2 = it, cv = -1;
                if (it >= 16) { const int y = it - 16; if (y < 4096) { if (y & 1) cv = y >> 1; else it2 = 16 + (y >> 1); } else cv = 2048 + (y - 4096); }
                if (cv >= 0) moe_convert_item(F, lp, cv * 4 + G.wg);
                else if (it2 < 16) { const int b = it2 >> 3, h = it2 & 7;
                    scan_pass3_item_g(G, P5, (size_t)ML + b * TCX, h, nullptr, nullptr, S0 + (size_t)((b * 8 + h) * 2 + 0) * 16384, S0 + (size_t)((b * 8 + h) * 2 + 1) * 16384, gain, YE_, H_, !lastl);
                } else { const int i2 = it2 - 16, seg = i2 & 63, dir = (i2 >> 6) & 1, h = (i2 >> 7) & 7, b = i2 >> 10;
                    scan_pass1_item_g(G, P5, b, h, dir, seg, SST, EG); }
                it = gq_next(G, wq, (unsigned)NG);
            }
        }
        SEAM(pb + O3_SCAN1);
        if (IN(pb + O4_CARRY)) for (int rep_ = 0; rep_ < NREP(O4_CARRY); ++rep_) { scan_carry(F); }
        SEAM(pb + O4_CARRY);
        if (IN(pb + O5_SCAN3)) {
            const int grp = F.wave >> 2; const int NG = F.G * 2, gid = F.bid * 2 + grp;
            GC G; G.L = F.lds + grp * G2_BYTES; G.wg = F.wave & 3; G.tid = F.tid & 255; G.lane = F.lane; G.bar = (LAS unsigned*)(F.lds + MISC_OFF + 128 + 4 * grp);
            __syncthreads(); G.epoch = __hip_atomic_load(G.bar, __ATOMIC_RELAXED, __HIP_MEMORY_SCOPE_WORKGROUP);
            for (int it = gid; it < 1024; it += NG) { const int seg = it & 63, h = (it >> 6) & 7, b = it >> 9; const int ch0 = (b * 8 + h) * 2;
                { int t_ = F.tid; asm volatile("" : "+v"(t_)); LAUNDER_WS_OUT(); G.tid = t_ & 255; G.lane = t_ & 63; }
                const bf16_t* P5 = (const bf16_t*)(F.ws + WS_P5); const float* SST = (const float*)(F.ws + WS_SST); const float* gain = FIN(I_RNORM) + lp * D;
                scan_pass3_item_g(G, P5, (size_t)b * TL + (size_t)seg * SEGL, h, SST + ((size_t)ch0 * NSEG + seg) * 16384, SST + ((size_t)(ch0 + 1) * NSEG + seg) * 16384, nullptr, nullptr, gain, YE_, H_, true); }
        }
        SEAM(pb + O5_SCAN3);
        if (IN(pb + O6_GOUT)) for (int rep_ = 0; rep_ < NREP(O6_GOUT); ++rep_) {
            pg8::Gemm g{H_, (const bf16_t*)(F.ws + WS_WOUTO) + (size_t)lp * D * D, MT, D, D, nullptr, nullptr, 0}; pg8::ResOrder S; S.init(D, F.G, F.bid, !lastl);
            pg8::EpiRes<false> E{nullptr, XB_, modO + 2 * D, (float*)(F.ws + WS_PARTC)};
            pg8::gemm_phase<pg8::EpiRes<false>, pg8::ResOrder, false, false>(F.lds, g, S, E, F.tid);
        }
        SEAM(pb + O6_GOUT);
        const int nrm = lastl ? ML : MT;
        if (IN(pb + O7_NORM)) for (int rep_ = 0; rep_ < NREP(O7_NORM); ++rep_) {
            RowPass P{}; P.xb = XB_; P.gain = FIN(I_NFFN) + lo_ * D; P.shift = modO + 3 * D; P.scale = modO + 4 * D; P.H = H_; P.nrows = nrm;
            P.part = lastl ? nullptr : (const float*)(F.ws + WS_PARTC); P.kpn = CTX_KP; P.pgate = modO + 2 * D;
            P.rw = FIN(I_RW) + (size_t)lp * D * NE; P.tope = (int*)(F.ws + WS_TOPE); P.toppo = (float*)(F.ws + WS_TOPP); P.rank = (int*)(F.ws + WS_RANK); P.cnt = (int*)(F.ws + WS_CNT);
            row_pass_b<false, true, false, 2>(F, P);
        }
        SEAM(pb + O7_NORM);
        if (IN(pb + O8_SLOTS)) for (int rep_ = 0; rep_ < NREP(O8_SLOTS); ++rep_) moe_slots(F, nrm);
        SEAM(pb + O8_SLOTS);
        if (IN(pb + O9_MUP)) for (int rep_ = 0; rep_ < NREP(O9_MUP); ++rep_) {
            const int* tilex = (const int*)(F.ws + WS_TILEX); const int ntiles = __builtin_amdgcn_readfirstlane(tilex[0]);
            pg8::Gemm g{H_, (const bf16_t*)(F.ws + WS_W13M), ntiles * 256, NEX2, D, (const int*)(F.ws + WS_SLOTROW), tilex + 16, (size_t)NEX2 * D}; pg8::StaticOrder S; S.init(ntiles * 256, NEX2, D, F.G, F.bid);
            pg8::EpiSwiglu E{(bf16_t*)(F.ws + WS_HIDM), DEX};
            pg8::gemm_phase<pg8::EpiSwiglu, pg8::StaticOrder, true, true>(F.lds, g, S, E, F.tid);
        }
        SEAM(pb + O9_MUP);
        if (IN(pb + O10_MDOWN)) for (int rep_ = 0; rep_ < NREP(O10_MDOWN); ++rep_) {
            const int* tilex = (const int*)(F.ws + WS_TILEX); const int ntiles = __builtin_amdgcn_readfirstlane(tilex[0]);
            pg8::Gemm g{(const bf16_t*)(F.ws + WS_HIDM), (const bf16_t*)(F.ws + WS_W2M), ntiles * 256, D, DEX, nullptr, tilex + 16, (size_t)D * DEX}; pg8::MoeDownOrder S; S.init(ntiles, F.G, F.bid);
            pg8::EpiMoeDown E{YE_, (const int*)(F.ws + WS_SLOTDST), (float*)(F.ws + WS_PARTM)};
            pg8::gemm_phase<pg8::EpiMoeDown, pg8::MoeDownOrder, true, false>(F.lds, g, S, E, F.tid);
        }
        SEAM(pb + O10_MDOWN);
    }
    if (IN(PH_FINAL)) {
        RowPass P{}; P.xb = XB_; P.gain = FIN(I_NOUT); P.nrows = ML; P.YE = YE_; P.topp = (const float*)(F.ws + WS_TOPP); P.gatef = MODS_ + (size_t)3 * 3 * 6144 + 5 * D; P.fout = F.out; P.slotof = (const int*)(F.ws + WS_SLOTOF); P.partm = (const float*)(F.ws + WS_PARTM);
        row_pass_b<true, false, true, 2>(F, P);
    }
    PROBE_T(PH_FINAL);
#if defined(PROBE_TMASK)
    if (F.bid == 0 && F.tid == 0) { const unsigned long long t0 = __builtin_amdgcn_s_memrealtime(); while (__builtin_amdgcn_s_memrealtime() - t0 < pt_acc * 4ull) __builtin_amdgcn_s_sleep(32); }
#endif
#undef IN
#undef SEAM
#undef MODS_
#undef XB_
#undef H_
#undef YE_
}

extern "C" void kernel_launch(void* const* d_in, const int* in_sizes, int n_in, void* d_out, int out_size, void* d_ws, size_t ws_size, hipStream_t stream) {
    static int grid = 0;
    if (grid == 0) {
        if (n_in != 24 || out_size != ML * D || ws_size < WS_END) { fprintf(stderr, "kernel_launch: unexpected problem (n_in %d, out %d, ws %zu < %zu)\n", n_in, out_size, ws_size, (size_t)WS_END); grid = -1; return; }
        int dev = 0, cus = 0, per_cu = 0;
        if (hipGetDevice(&dev) != hipSuccess || hipDeviceGetAttribute(&cus, hipDeviceAttributeMultiprocessorCount, dev) != hipSuccess) { grid = -1; return; }
        if (hipFuncSetAttribute((const void*)fwd_kernel, hipFuncAttributeMaxDynamicSharedMemorySize, LDS_BYTES) != hipSuccess) { fprintf(stderr, "kernel_launch: hipFuncSetAttribute failed\n"); grid = -1; return; }
        if (hipOccupancyMaxActiveBlocksPerMultiprocessor(&per_cu, (const void*)fwd_kernel, 512, LDS_BYTES) != hipSuccess || per_cu < 1) fprintf(stderr, "kernel_launch: occupancy query says %d\n", per_cu);
        (void)hipGetLastError();
        grid = cus;
    }
    if (grid < 0) return;
    (void)hipMemsetAsync((char*)d_ws + WS_CTL, 0, CTL_BYTES, stream);
    Args a{};
    for (int i = 0; i < 24; ++i) a.in[i] = (const float*)d_in[i];
    a.out = (float*)d_out; a.ws = (unsigned char*)d_ws;
#if PER_PHASE_LAUNCH
    for (int p = 0; p < NPHASE && p < PHASE_LIMIT; ++p) { a.ph_lo = p; a.ph_hi = p + 1; hipLaunchKernelGGL(fwd_kernel, dim3(grid), dim3(512), LDS_BYTES, stream, a); }
#else
    a.ph_lo = 0; a.ph_hi = NPHASE; hipLaunchKernelGGL(fwd_kernel, dim3(grid), dim3(512), LDS_BYTES, stream, a);
#endif
}
```

```cpp
#include <hip/hip_runtime.h>
#include <cstdio>
#include <cstdint>

#ifndef PER_PHASE_LAUNCH
#define PER_PHASE_LAUNCH 0
#endif
#ifndef CTX_KP
#define CTX_KP 4
#endif
#ifndef REP_MASK
#define REP_MASK 0
#endif
#define NREP(x) (((REP_MASK >> (x)) & 1) ? 2 : 1)
#ifndef PHASE_LIMIT
#define PHASE_LIMIT 100
#endif
#ifndef P0_MASK
#define P0_MASK 63
#endif
#ifndef P0_T
#define P0_T 127
#endif

#define LAS __attribute__((address_space(3)))
typedef unsigned short bf16_t;
typedef short bf16x8 __attribute__((ext_vector_type(8)));
typedef short s16x4 __attribute__((ext_vector_type(4)));
typedef float f32x4 __attribute__((ext_vector_type(4)));
typedef float f32x2 __attribute__((ext_vector_type(2)));
typedef unsigned u32x4 __attribute__((ext_vector_type(4)));
typedef unsigned u32x2 __attribute__((ext_vector_type(2)));

constexpr int D = 1024, TL = 16384, ML = 32768, TCX = 256, MC = 512, MT = 33280;
constexpr int NEIN = 2048, DFF = 2816, NFF2 = 5632, NREC = 5120, DEX = 3584, NEX2 = 7168, NE = 8;
constexpr int NSEG = 64, SEGL = 256, CH = 32, NCHAIN = 32;
constexpr int MAXTILES = 268, NITEM16 = MT / 16;
constexpr float EPS = 1e-6f;

constexpr size_t MiB = 1u << 20, KiB = 1u << 10;
constexpr size_t WS_CTL = 0, CTL_BYTES = 1 * MiB;
constexpr size_t WS_MODS = 1 * MiB, WS_LB = 1 * MiB + 512 * KiB;
constexpr size_t WS_FA = 2 * MiB, WS_FC = 2 * MiB + 128 * KiB, WS_FX = 2 * MiB + 256 * KiB, WS_GW = 2 * MiB + 512 * KiB;
constexpr size_t WS_XC = 3 * MiB;
constexpr size_t WS_TOPE = 5 * MiB, WS_TOPP = 5 * MiB + 512 * KiB, WS_RANK = 6 * MiB, WS_CNT = 6 * MiB + 512 * KiB, WS_TILEX = 6 * MiB + 768 * KiB, WS_SLOTROW = 7 * MiB, WS_SLOTDST = 7 * MiB + 512 * KiB;
constexpr size_t WS_WINE = 8 * MiB, WS_WOUTE = 16 * MiB, WS_WINO = 20 * MiB, WS_WOUTO = 40 * MiB, WS_W13 = 44 * MiB, WS_W2 = 66 * MiB;
constexpr size_t WS_W13M = 77 * MiB, WS_W2M = 189 * MiB;
constexpr size_t WS_H = 245 * MiB, WS_YE = 310 * MiB, WS_BIG = 440 * MiB;
constexpr size_t WS_PZUV = WS_BIG, WS_UP = WS_BIG + 130 * MiB, WS_HID = WS_BIG, WS_P5 = WS_BIG, WS_SST = WS_BIG + 325 * MiB, WS_EG = WS_BIG + 453 * MiB, WS_S0 = WS_BIG + 454 * MiB, WS_HIDM = WS_BIG;
constexpr size_t WS_PARTC = WS_BIG + 469 * MiB, WS_PARTM = WS_PARTC + 8 * MiB;
constexpr size_t WS_SLOTOF = 1 * MiB + 576 * KiB;
constexpr size_t WS_XB = WS_PARTM + 48 * MiB;
constexpr size_t WS_END = WS_XB + 65 * MiB;
static_assert(WS_END <= (size_t)1032 * MiB, "workspace must stay below the sum of the input sizes (1032.7 MiB)");
static_assert(WS_W2 + (size_t)2 * D * DFF * 2 <= WS_W13M, "static weights");
static_assert(WS_W2M + (size_t)NE * D * DEX * 2 <= WS_H && WS_H + (size_t)MT * D * 2 <= WS_YE && WS_YE + (size_t)MT * 2 * D * 2 <= WS_BIG, "ws map");
static_assert((size_t)MAXTILES * 256 * DEX * 2 <= 469 * MiB && (size_t)MT * NREC * 2 <= 325 * MiB && (size_t)MT * NEIN * 2 <= 130 * MiB, "big region");

constexpr int LDS_BYTES = 147456, MISC_OFF = 147456 - 256;
constexpr int XRS = 288;

typedef __bf16 bf16x2_t __attribute__((ext_vector_type(2)));
__device__ __forceinline__ unsigned f2bf(float f) { return (unsigned)__builtin_bit_cast(unsigned short, (__bf16)f); }
__device__ __forceinline__ unsigned pk2(float lo, float hi) { return __builtin_bit_cast(unsigned, __builtin_convertvector((f32x2){lo, hi}, bf16x2_t)); }
__device__ __forceinline__ float bf2f(unsigned short b) { return __builtin_bit_cast(float, (unsigned)b << 16); }
__device__ __forceinline__ float bflo(unsigned w) { return __builtin_bit_cast(float, w << 16); }
__device__ __forceinline__ float bfhi(unsigned w) { return __builtin_bit_cast(float, w & 0xffff0000u); }
__device__ __forceinline__ float shfl_x(float v, int o, int lane) { return __builtin_bit_cast(float, __builtin_amdgcn_ds_bpermute((lane ^ o) << 2, __builtin_bit_cast(int, v))); }
__device__ __forceinline__ float wave_sum(float v, int lane) {
#pragma unroll
    for (int o = 1; o < 64; o <<= 1) v += shfl_x(v, o, lane);
    return v;
}
__device__ __forceinline__ float siluf(float a) { return a * __builtin_amdgcn_rcpf(1.0f + __expf(-a)); }
#define WQ_NEXT(it, ctr, slot, G) do { __syncthreads(); if (threadIdx.x == 0) *(slot) = (unsigned)(G) + __hip_atomic_fetch_add((ctr), 1u, __ATOMIC_RELAXED, __HIP_MEMORY_SCOPE_AGENT); __syncthreads(); (it) = (int)*(slot); } while (0)
#define LDS_WAIT() asm volatile("s_waitcnt lgkmcnt(0)" ::: "memory")
#define VM_WAIT() asm volatile("s_waitcnt vmcnt(0)" ::: "memory")

#define XB_TMO      128
#define XB_XCNT(j)  (256  + 64 * (j))
#define XB_XSUB(j)  (1280 + 64 * (j))
#define XB_XGEN(j)  (2304 + 64 * (j))
#define XB_TOP      3328
#define XB_TOPGEN   3392
#define XCD_BAR_WORDS 3456
#define XB_SPIN_CAP (1u << 18)
__device__ __forceinline__ unsigned xb_ld(unsigned* p)              { return __hip_atomic_load(p, __ATOMIC_RELAXED, __HIP_MEMORY_SCOPE_AGENT); }
__device__ __forceinline__ unsigned xb_add(unsigned* p, unsigned v) { return __hip_atomic_fetch_add(p, v, __ATOMIC_RELAXED, __HIP_MEMORY_SCOPE_AGENT); }
__device__ __forceinline__ unsigned xb_xcc_id() { return (unsigned)__builtin_amdgcn_s_getreg((3 << 11) | 20) & 0xFu; }
#define XB_SPIN(cond, bar) do { unsigned _sp = 0; while (cond) { __builtin_amdgcn_s_sleep(1); \
    if ((++_sp & 255u) == 0u) { if (xb_ld(&(bar)[XB_TMO])) break; if (_sp > XB_SPIN_CAP) { atomicAdd(&(bar)[XB_TMO], 1u); break; } } } } while (0)
struct XcdBarrier { unsigned* bar; unsigned x; volatile LAS unsigned* st; };
__device__ __forceinline__ XcdBarrier xcd_barrier_post(unsigned* bar, volatile LAS unsigned* st) {
    XcdBarrier b; b.bar = bar; b.x = xb_xcc_id(); b.st = st;
    if (threadIdx.x == 0) (void)xb_add(&bar[XB_XCNT(b.x)], 1u);
    return b;
}
__device__ __forceinline__ void xcd_barrier_complete(unsigned* bar, unsigned x, unsigned& nloc, unsigned& nx) {
    const unsigned G = gridDim.x * gridDim.y * gridDim.z;
    unsigned sum, cnt, mine, sp = 0u;
    for (;;) {
        sum = 0u; cnt = 0u; mine = 0u;
#pragma unroll
        for (unsigned j = 0; j < 16; ++j) { const unsigned c = xb_ld(&bar[XB_XCNT(j)]); sum += c; cnt += (c > 0u) ? 1u : 0u; mine = (j == x) ? c : mine; }
        if (sum == G) break;
        __builtin_amdgcn_s_sleep(1);
        if ((++sp & 255u) == 0u) { if (xb_ld(&bar[XB_TMO])) break; if (sp > XB_SPIN_CAP) { atomicAdd(&bar[XB_TMO], 1u); break; } }
    }
    nloc = mine > 0u ? mine : 1u; nx = cnt > 0u ? cnt : 1u;
}
__device__ __forceinline__ void xcd_barrier(const XcdBarrier& b) {
    asm volatile("s_waitcnt vmcnt(0)" ::: "memory");
    __syncthreads();
    if (threadIdx.x == 0) {
        unsigned* bar = b.bar;
        __builtin_amdgcn_s_waitcnt(0);
        unsigned nloc = b.st[0], nx = b.st[1];
        if (nloc == 0u) { xcd_barrier_complete(bar, b.x, nloc, nx); b.st[0] = nloc; b.st[1] = nx; }
        const unsigned old = xb_add(&bar[XB_XSUB(b.x)], 1u);
        const unsigned gen = old / nloc;
        if (old + 1u == (gen + 1u) * nloc) {
            __builtin_amdgcn_fence(__ATOMIC_RELEASE, "agent");
            asm volatile("s_waitcnt vmcnt(0)" ::: "memory");
            const unsigned og = xb_add(&bar[XB_TOP], 1u);
            const unsigned tg = og / nx;
            if (og + 1u == (tg + 1u) * nx) xb_add(&bar[XB_TOPGEN], 1u);
            else XB_SPIN(xb_ld(&bar[XB_TOPGEN]) == tg, bar);
            __builtin_amdgcn_fence(__ATOMIC_ACQUIRE, "agent");
            xb_add(&bar[XB_XGEN(b.x)], 1u);
            asm volatile("s_waitcnt vmcnt(0)" ::: "memory");
        } else {
            XB_SPIN(xb_ld(&bar[XB_XGEN(b.x)]) == gen, bar);
            __builtin_amdgcn_fence(__ATOMIC_ACQUIRE, "agent");
            asm volatile("s_waitcnt vmcnt(0)" ::: "memory");
        }
    }
    __syncthreads();
}

namespace pg8 {
constexpr int BM = 256, BK = 64, HALF = 128, HTB = HALF * BK * 2, STAGE_BYTES = 8 * HTB, NXCD = 8, WGM = 4;
__host__ __device__ __forceinline__ int lds_byte(int r, int c) { const int st = (r >> 4) * 2 + (c >> 5), rr = r & 15, cc = c & 31, ob = rr * 64 + cc * 2; return st * 1024 + (ob ^ (((ob >> 9) & 1) << 5)); }
__host__ __device__ __forceinline__ void stage_rc(int b, int& R, int& C) { const int st = b / 1024, sb = b % 1024, swz = sb ^ (((sb >> 9) & 1) << 5); R = (st >> 1) * 16 + swz / 64; C = (st & 1) * 32 + (swz % 64) / 2; }
__host__ __device__ __forceinline__ int perm32(int rho) { const int n = rho >> 4, i = rho & 15; return 8 * (i >> 2) + 4 * n + (i & 3); }
struct Unit { int pm, pn, kt0, nt, kp; };
struct Gemm { const bf16_t* A; const bf16_t* Bt; int M, N, K; const int* arow; const int* grp; size_t gstride; };
struct StaticOrder {
    int nM, nN, nwg, G, c, ntk;
    __host__ __device__ void init(int M, int N, int K, int G_, int c_) { nM = M / BM; nN = N / BM; nwg = nM * nN; G = G_; c = c_; ntk = K / BK; }
    __host__ __device__ bool next(int i, Unit& u) const {
        const long L = (long)i * G + c; if (L >= nwg) return false;
        int wgid = (int)L; { const int q = nwg / NXCD, r = nwg % NXCD, xcd = wgid % NXCD, off = wgid / NXCD; wgid = (xcd < r ? xcd * (q + 1) : r * (q + 1) + (xcd - r) * q) + off; }
        const int nig = WGM * nN, gid = wgid / nig, fm = gid * WGM, gsz = (nM - fm) < WGM ? (nM - fm) : WGM;
        u.pm = fm + ((wgid % nig) % gsz); u.pn = (wgid % nig) / gsz; u.kt0 = 0; u.nt = ntk; u.kp = 0; return true;
    }
};
struct ResOrder {
    StaticOrder S; int nlat, npieces, q0, q1, G, c;
    __host__ __device__ void init(int K, int G_, int c_, bool with_ctx) { S.init(ML, D, K, G_, c_); nlat = S.nwg; const int ntk = K / BK; q1 = (ntk / 8) * 2; q0 = (ntk - 2 * q1) / 2; npieces = with_ctx ? 2 * 4 * CTX_KP : 0; if (CTX_KP == 1) { q0 = ntk; q1 = 0; } G = G_; c = c_; }
    __host__ __device__ bool next(int i, Unit& u) const {
        const long L = (long)i * G + c; if (L < nlat) return S.next(i, u);
        const int idx = (int)(L - nlat); if (idx >= npieces) return false;
        const int kp = idx % CTX_KP, rest = idx / CTX_KP; u.kp = kp; u.kt0 = kp < 2 ? kp * q0 : 2 * q0 + (kp - 2) * q1; u.nt = kp < 2 ? q0 : q1; u.pn = rest & 3; u.pm = 128 + (rest >> 2); return true;
    }
};
struct MoeDownOrder {
    StaticOrder S; int nfull, ntail, G, c;
    __host__ __device__ void init(int ntiles, int G_, int c_) { const int pf = ntiles < 256 ? ntiles : 256; S.init(pf * BM, D, DEX, G_, c_); nfull = pf * 4; ntail = (ntiles - pf) * 16; G = G_; c = c_; }
    __host__ __device__ bool next(int i, Unit& u) const {
        const long L = (long)i * G + c; if (L < nfull) return S.next(i, u);
        const int idx = (int)(L - nfull); if (idx >= ntail) return false;
        u.kp = idx & 3; u.kt0 = 14 * (idx & 3); u.nt = 14; u.pn = (idx >> 2) & 3; u.pm = 256 + (idx >> 4); return true;
    }
};
__device__ __forceinline__ unsigned cvt_pk_bf16(float lo, float hi) { unsigned r; asm volatile("v_cvt_pk_bf16_f32 %0, %1, %2" : "=v"(r) : "v"(lo), "v"(hi)); return r; }
__device__ __forceinline__ f32x2 gelu_pk(f32x2 v) {
    const f32x2 av = __builtin_elementwise_abs(v), d = av * 0.2316418882f + 1.0f;
    f32x2 t; t.x = __builtin_amdgcn_rcpf(d.x); t.y = __builtin_amdgcn_rcpf(d.y);
    f32x2 q = t * 0.5307027145f + (-0.7265760135f); q = q * t + 0.7107068705f; q = q * t + (-0.142248368f); q = q * t + 0.127414796f; q = q * t;
    const f32x2 s = (v * v) * (-0.72134752044f);
    f32x2 e; e.x = __builtin_amdgcn_exp2f(s.x); e.y = __builtin_amdgcn_exp2f(s.y);
    const f32x2 m = v * (q * e), r = v - m;
    f32x2 o; o.x = v.x < 0.f ? m.x : r.x; o.y = v.y < 0.f ? m.y : r.y; return o;
}
template <class Epi, class Sched, bool ALIGN_EPI, bool GATHER>
__device__ __forceinline__ void gemm_phase(LAS unsigned char* lds, const Gemm g, const Sched& S, const Epi& E, const int tid) {
    const int wid = __builtin_amdgcn_readfirstlane(tid >> 6), lane = tid & 63, wr = wid >> 2, wc = wid & 3, fr = lane & 15, fq = lane >> 4;
    const int K = g.K;
    unsigned voffA[2], voffB[2];
    unsigned voffA1[2];
#pragma unroll
    for (int i = 0; i < 2; ++i) { int R, C; stage_rc(tid * 16 + i * 8192, R, C); const int Rb = Epi::PERM == 2 ? (64 * (R >> 5) + perm32(R & 31)) : Epi::PERM ? ((R & ~31) + perm32(R & 31)) : R;
        voffA[i] = (unsigned)(R * K + C) * 2u; voffA1[i] = voffA[i]; voffB[i] = (unsigned)(Rb * K + C) * 2u; }
    const size_t kstep = (size_t)(BK * 2);
    const size_t hstep = (size_t)HALF * K * 2;
    const size_t tstep = 2 * hstep;
    const size_t hstepB = Epi::PERM == 2 ? (size_t)32 * K * 2 : hstep;
    const unsigned ldsw = (unsigned)wid * 1024u;
    const int aoff = lds_byte(wr * 64 + fr, fq * 8), boff = lds_byte(wc * 32 + fr, fq * 8);
#define PG8_SA(b, h) (((b) * 2 + (h)) * HTB)
#define PG8_SB(b, h) ((4 + (b) * 2 + (h)) * HTB)
#define PG8_STAGE(bufoff, gbase, voff) do { _Pragma("unroll") for (int _i = 0; _i < 2; ++_i) \
        __builtin_amdgcn_global_load_lds((const unsigned*)((const char*)(gbase) + (voff)[_i]), (LAS unsigned*)(lds + (bufoff) + ldsw + _i * 8192), 16, 0, 0); } while (0)
#define PG8_LDA(dst, b, h) do { _Pragma("unroll") for (int m = 0; m < 4; ++m) _Pragma("unroll") for (int k = 0; k < 2; ++k) dst[m][k] = *(const LAS bf16x8*)(lds + PG8_SA(b, h) + aoff + m * 2048 + k * 1024); } while (0)
#define PG8_LDB(dst, b, h) do { _Pragma("unroll") for (int n = 0; n < 2; ++n) _Pragma("unroll") for (int k = 0; k < 2; ++k) dst[n][k] = *(const LAS bf16x8*)(lds + PG8_SB(b, h) + boff + n * 2048 + k * 1024); } while (0)
#define PG8_MMA(ai, bj, At, Bt) do { __builtin_amdgcn_s_setprio(1); _Pragma("unroll") for (int m = 0; m < 4; ++m) _Pragma("unroll") for (int n = 0; n < 2; ++n) _Pragma("unroll") for (int k = 0; k < 2; ++k) \
        acc[ai][bj][m][n] = __builtin_amdgcn_mfma_f32_16x16x32_bf16(Bt[n][k], At[m][k], acc[ai][bj][m][n], 0, 0, 0); __builtin_amdgcn_s_setprio(0); } while (0)
#define PG8_WAIT_V(n) asm volatile("s_waitcnt vmcnt(" #n ")" ::: "memory")
#define PG8_WAIT_L(n) asm volatile("s_waitcnt lgkmcnt(" #n ")" ::: "memory")
#define PG8_BAR __builtin_amdgcn_s_barrier()
#define PG8_SCHED __builtin_amdgcn_sched_barrier(0)
#define PG8_VA1 (GATHER ? voffA1 : voffA)
#define PG8_GOFF(u, v0, v1) do { _Pragma("unroll") for (int _i = 0; _i < 2; ++_i) { int R_, C_; stage_rc(tid * 16 + _i * 8192, R_, C_); \
        const int r0_ = g.arow[(u).pm * BM + R_], r1_ = g.arow[(u).pm * BM + HALF + R_]; v0[_i] = (unsigned)(r0_ * K + C_) * 2u; v1[_i] = (unsigned)(r1_ * K + C_) * 2u; } } while (0)
#define PG8_GROWS(u, q0, q1) do { _Pragma("unroll") for (int _i = 0; _i < 2; ++_i) { int R_, C_; stage_rc(tid * 16 + _i * 8192, R_, C_); q0[_i] = g.arow[(u).pm * BM + R_]; q1[_i] = g.arow[(u).pm * BM + HALF + R_]; } } while (0)
#define PG8_GOFFR(q0, q1, v0, v1) do { _Pragma("unroll") for (int _i = 0; _i < 2; ++_i) { int R_, C_; stage_rc(tid * 16 + _i * 8192, R_, C_); v0[_i] = (unsigned)(q0[_i] * K + C_) * 2u; v1[_i] = (unsigned)(q1[_i] * K + C_) * 2u; } } while (0)
#define PG8_BBASE(u) ((const char*)g.Bt + (g.grp ? (size_t)g.grp[(u).pm] * g.gstride * 2 : (size_t)0) + (size_t)(u).pn * tstep + (size_t)(u).kt0 * kstep)
    Unit cur, nxt; int ui = 0;
    if (!S.next(0, cur)) return;
    f32x4 acc[2][2][4][2];
#pragma unroll
    for (int a = 0; a < 2; ++a)
#pragma unroll
        for (int b = 0; b < 2; ++b)
#pragma unroll
            for (int m = 0; m < 4; ++m)
#pragma unroll
                for (int n = 0; n < 2; ++n) acc[a][b][m][n] = (f32x4){0.f, 0.f, 0.f, 0.f};
    bf16x8 At[4][2], B0[2][2], B1[2][2];
    const char* cA = (GATHER ? (const char*)g.A : (const char*)g.A + (size_t)cur.pm * tstep) + (size_t)cur.kt0 * kstep;
    const size_t ah = GATHER ? (size_t)0 : hstep;
    int gq0[2] = {0, 0}, gq1[2] = {0, 0};
    if constexpr (GATHER) { PG8_GOFF(cur, voffA, voffA1); Unit n1_; if (S.next(1, n1_)) PG8_GROWS(n1_, gq0, gq1); asm volatile("" : "+v"(gq0[0]), "+v"(gq0[1]), "+v"(gq1[0]), "+v"(gq1[1])); }
    const char* cB = PG8_BBASE(cur);
    PG8_STAGE(PG8_SB(0, 0), cB, voffB); PG8_STAGE(PG8_SA(0, 0), cA, voffA); PG8_STAGE(PG8_SB(0, 1), cB + hstepB, voffB); PG8_STAGE(PG8_SA(0, 1), cA + ah, PG8_VA1);
    if (wr == 1) PG8_BAR;
    PG8_WAIT_V(4); PG8_BAR;
    PG8_STAGE(PG8_SB(1, 0), cB + kstep, voffB); PG8_STAGE(PG8_SA(1, 0), cA + kstep, voffA); PG8_STAGE(PG8_SB(1, 1), cB + hstepB + kstep, voffB);
    PG8_WAIT_V(6); PG8_BAR;
    for (;;) {
        const bool has_next = S.next(ui + 1, nxt);
        const char* nA = !has_next ? cA : (GATHER ? (const char*)g.A : (const char*)g.A + (size_t)nxt.pm * tstep) + (size_t)nxt.kt0 * kstep; const char* nB = has_next ? PG8_BBASE(nxt) : cB;
        const int nt = cur.nt;
        for (int t = 0; t < nt; t += 2) {
            const bool last = (t == nt - 2);
            const char* a1 = cA + (size_t)(t + 1) * kstep;
            const char* a2 = last ? nA : cA + (size_t)(t + 2) * kstep; const char* b2 = last ? nB : cB + (size_t)(t + 2) * kstep;
            const char* a3 = a2 + kstep; const char* b3 = b2 + kstep;
            PG8_LDB(B0, 0, 0); PG8_SCHED; PG8_LDA(At, 0, 0); PG8_STAGE(PG8_SA(1, 1), a1 + ah, PG8_VA1);
            if constexpr (GATHER) { if (last && has_next) PG8_GOFFR(gq0, gq1, voffA, voffA1); }
            PG8_WAIT_L(8); PG8_BAR; PG8_WAIT_L(0); PG8_MMA(0, 0, At, B0); PG8_BAR; PG8_SCHED;
            PG8_LDB(B1, 0, 1); PG8_STAGE(PG8_SB(0, 0), b2, voffB);
            PG8_BAR; PG8_WAIT_L(0); PG8_MMA(0, 1, At, B1); PG8_BAR;
            PG8_LDA(At, 0, 1); PG8_STAGE(PG8_SA(0, 0), a2, voffA);
            PG8_BAR; PG8_WAIT_L(0); PG8_MMA(1, 0, At, B0); PG8_BAR; PG8_SCHED;
            PG8_STAGE(PG8_SB(0, 1), b2 + hstepB, voffB);
            PG8_WAIT_V(6); PG8_BAR; PG8_MMA(1, 1, At, B1); PG8_BAR;
            PG8_LDB(B0, 1, 0); PG8_SCHED; PG8_LDA(At, 1, 0); PG8_STAGE(PG8_SA(0, 1), a2 + ah, PG8_VA1);
            PG8_WAIT_L(8); PG8_BAR; PG8_WAIT_L(0); PG8_MMA(0, 0, At, B0); PG8_BAR; PG8_SCHED;
            PG8_LDB(B1, 1, 1); PG8_STAGE(PG8_SB(1, 0), b3, voffB);
            PG8_BAR; PG8_WAIT_L(0); PG8_MMA(0, 1, At, B1); PG8_BAR;
            PG8_LDA(At, 1, 1); PG8_STAGE(PG8_SA(1, 0), a3, voffA);
            PG8_BAR; PG8_WAIT_L(0); PG8_MMA(1, 0, At, B0); PG8_BAR; PG8_SCHED;
            PG8_STAGE(PG8_SB(1, 1), b3 + hstepB, voffB);
            PG8_WAIT_V(6); PG8_BAR; PG8_MMA(1, 1, At, B1); PG8_BAR;
        }
        if constexpr (ALIGN_EPI) { if (wr == 0) PG8_BAR; }
        int gt0[2] = {0, 0}, gt1[2] = {0, 0};
        if constexpr (GATHER) { Unit n2_; if (S.next(ui + 2, n2_)) PG8_GROWS(n2_, gt0, gt1); }
        E(acc, cur, wr, wc, fr, fq);
        if constexpr (GATHER) { asm volatile("" : "+v"(gt0[0]), "+v"(gt0[1]), "+v"(gt1[0]), "+v"(gt1[1])); gq0[0] = gt0[0]; gq0[1] = gt0[1]; gq1[0] = gt1[0]; gq1[1] = gt1[1]; }
        if (!has_next) break;
#pragma unroll
        for (int a = 0; a < 2; ++a)
#pragma unroll
            for (int b = 0; b < 2; ++b)
#pragma unroll
                for (int m = 0; m < 4; ++m)
#pragma unroll
                    for (int n = 0; n < 2; ++n) acc[a][b][m][n] = (f32x4){0.f, 0.f, 0.f, 0.f};
        cur = nxt; cA = nA; cB = nB; ++ui;
        if constexpr (ALIGN_EPI) { if (wr == 1) PG8_BAR; }
    }
    PG8_WAIT_V(0);
    if constexpr (!ALIGN_EPI) { if (wr == 0) PG8_BAR; }
    PG8_BAR;
#undef PG8_SA
#undef PG8_SB
#undef PG8_STAGE
#undef PG8_LDA
#undef PG8_LDB
#undef PG8_MMA
#undef PG8_WAIT_V
#undef PG8_WAIT_L
#undef PG8_BAR
#undef PG8_SCHED
#undef PG8_VA1
#undef PG8_GOFF
#undef PG8_GROWS
#undef PG8_GOFFR
#undef PG8_BBASE
}

struct EpiEvenIn {
    static constexpr bool PERM = true;
    bf16_t* O;
    template <bool ACT> __device__ __forceinline__ void run(const f32x4 (&acc)[2][2][4][2], const Unit& u, int wr, int wc, int fr, int fq) const {
        const int row0 = u.pm * BM + wr * 64 + fr, col0 = u.pn * BM + wc * 32 + 8 * fq;
#pragma unroll
        for (int ai = 0; ai < 2; ++ai)
#pragma unroll
            for (int m = 0; m < 4; ++m) { bf16_t* rowp = O + (size_t)(row0 + ai * HALF + m * 16) * NEIN + col0;
#pragma unroll
                for (int bj = 0; bj < 2; ++bj) { f32x4 v0 = acc[ai][bj][m][0], v1 = acc[ai][bj][m][1];
                    if (ACT) { f32x2 a = gelu_pk((f32x2){v0[0], v0[1]}), b = gelu_pk((f32x2){v0[2], v0[3]}), c = gelu_pk((f32x2){v1[0], v1[1]}), d = gelu_pk((f32x2){v1[2], v1[3]});
                        v0 = (f32x4){a.x, a.y, b.x, b.y}; v1 = (f32x4){c.x, c.y, d.x, d.y}; }
                    u32x4 w; w.x = cvt_pk_bf16(v0[0], v0[1]); w.y = cvt_pk_bf16(v0[2], v0[3]); w.z = cvt_pk_bf16(v1[0], v1[1]); w.w = cvt_pk_bf16(v1[2], v1[3]);
                    *(u32x4*)(rowp + bj * HALF) = w; } }
    }
    __device__ __forceinline__ void operator()(const f32x4 (&acc)[2][2][4][2], const Unit& u, int wr, int wc, int fr, int fq) const {
        if (u.pn >= 4) run<true>(acc, u, wr, wc, fr, fq); else run<false>(acc, u, wr, wc, fr, fq);
    }
};
template <bool SRC_F32> struct EpiRes {
    static constexpr bool PERM = true;
    const float* sl32; bf16_t* xb; const float* gate; float* part;
    __device__ __forceinline__ void operator()(const f32x4 (&acc)[2][2][4][2], const Unit& u, int wr, int wc, int fr, int fq) const {
        const int col0 = u.pn * BM + wc * 32 + 8 * fq;
        typedef __attribute__((address_space(1))) const char gcc_t; typedef __attribute__((address_space(1))) char gc_t;
        if (u.pm >= 128) {
            gc_t* dst = (gc_t*)(part + ((size_t)u.kp * MC + (size_t)(u.pm - 128) * BM) * D);
#pragma unroll
            for (int ai = 0; ai < 2; ++ai)
#pragma unroll
                for (int m = 0; m < 4; ++m) { const unsigned off = (unsigned)((ai * HALF + wr * 64 + m * 16 + fr) * D + col0) * 4u;
#pragma unroll
                    for (int bj = 0; bj < 2; ++bj) { *(__attribute__((address_space(1))) f32x4*)(dst + off + (unsigned)(bj * HALF) * 4u) = acc[ai][bj][m][0]; *(__attribute__((address_space(1))) f32x4*)(dst + off + (unsigned)(bj * HALF + 4) * 4u) = acc[ai][bj][m][1]; } }
            return;
        }
        const int ms = u.pm >= 64 ? 1 : 0;
        const size_t rbase = (size_t)u.pm * BM;
        gcc_t* src32 = (gcc_t*)(sl32 + rbase * D); gc_t* xbp = (gc_t*)(xb + rbase * D); gcc_t* gp = (gcc_t*)(gate + ms * 6144);
        f32x4 gv[2][2];
#pragma unroll
        for (int bj = 0; bj < 2; ++bj)
#pragma unroll
            for (int n = 0; n < 2; ++n) gv[bj][n] = *(__attribute__((address_space(1))) const f32x4*)(gp + (unsigned)(col0 + bj * HALF + 4 * n) * 4u);
        if (SRC_F32) {
#pragma unroll
            for (int ai = 0; ai < 2; ++ai)
#pragma unroll
                for (int mh = 0; mh < 2; ++mh) {
                    f32x4 xr[2][2][2];
#pragma unroll
                    for (int mm = 0; mm < 2; ++mm) { const unsigned eo = (unsigned)((ai * HALF + wr * 64 + (2 * mh + mm) * 16 + fr) * D + col0);
#pragma unroll
                        for (int bj = 0; bj < 2; ++bj) { xr[mm][bj][0] = *(__attribute__((address_space(1))) const f32x4*)(src32 + (eo + bj * HALF) * 4u); xr[mm][bj][1] = *(__attribute__((address_space(1))) const f32x4*)(src32 + (eo + bj * HALF + 4) * 4u); } }
                    __builtin_amdgcn_sched_barrier(0);
#pragma unroll
                    for (int mm = 0; mm < 2; ++mm) { const int m = 2 * mh + mm; const unsigned eo = (unsigned)((ai * HALF + wr * 64 + m * 16 + fr) * D + col0);
#pragma unroll
                        for (int bj = 0; bj < 2; ++bj) { const f32x4 y0 = xr[mm][bj][0] + gv[bj][0] * acc[ai][bj][m][0], y1 = xr[mm][bj][1] + gv[bj][1] * acc[ai][bj][m][1];
                            u32x4 w; w.x = cvt_pk_bf16(y0[0], y0[1]); w.y = cvt_pk_bf16(y0[2], y0[3]); w.z = cvt_pk_bf16(y1[0], y1[1]); w.w = cvt_pk_bf16(y1[2], y1[3]);
                            *(__attribute__((address_space(1))) u32x4*)(xbp + (eo + bj * HALF) * 2u) = w; } }
                    __builtin_amdgcn_sched_barrier(0);
                }
        } else {
#pragma unroll
            for (int ai = 0; ai < 2; ++ai) {
                u32x4 raw[4][2];
#pragma unroll
                for (int m = 0; m < 4; ++m) { const unsigned eo = (unsigned)((ai * HALF + wr * 64 + m * 16 + fr) * D + col0);
#pragma unroll
                    for (int bj = 0; bj < 2; ++bj) raw[m][bj] = *(__attribute__((address_space(1))) const u32x4*)(xbp + (eo + bj * HALF) * 2u); }
                __builtin_amdgcn_sched_barrier(0);
#pragma unroll
                for (int m = 0; m < 4; ++m) { const unsigned eo = (unsigned)((ai * HALF + wr * 64 + m * 16 + fr) * D + col0);
#pragma unroll
                    for (int bj = 0; bj < 2; ++bj) { const u32x4 r = raw[m][bj];
                        const f32x4 x0 = (f32x4){bflo(r.x), bfhi(r.x), bflo(r.y), bfhi(r.y)}, x1 = (f32x4){bflo(r.z), bfhi(r.z), bflo(r.w), bfhi(r.w)};
                        const f32x4 y0 = x0 + gv[bj][0] * acc[ai][bj][m][0], y1 = x1 + gv[bj][1] * acc[ai][bj][m][1];
                        u32x4 w; w.x = cvt_pk_bf16(y0[0], y0[1]); w.y = cvt_pk_bf16(y0[2], y0[3]); w.z = cvt_pk_bf16(y1[0], y1[1]); w.w = cvt_pk_bf16(y1[2], y1[3]);
                        *(__attribute__((address_space(1))) u32x4*)(xbp + (eo + bj * HALF) * 2u) = w; } }
                __builtin_amdgcn_sched_barrier(0);
            }
        }
    }
};
struct EpiSwiglu {
    static constexpr bool PERM = true;
    bf16_t* O; int ldc;
    __device__ __forceinline__ void operator()(const f32x4 (&acc)[2][2][4][2], const Unit& u, int wr, int wc, int fr, int fq) const {
        const int row0 = u.pm * BM + wr * 64 + fr, col0 = u.pn * 128 + wc * 32 + 8 * fq;
#pragma unroll
        for (int ai = 0; ai < 2; ++ai)
#pragma unroll
            for (int m = 0; m < 4; ++m) { bf16_t* rowp = O + (size_t)(row0 + ai * HALF + m * 16) * ldc + col0;
                float y[8];
#pragma unroll
                for (int n = 0; n < 2; ++n)
#pragma unroll
                    for (int i = 0; i < 4; ++i) { const float a = acc[ai][0][m][n][i], b = acc[ai][1][m][n][i]; y[4 * n + i] = (a * b) * __builtin_amdgcn_rcpf(1.0f + __builtin_amdgcn_exp2f(a * -1.44269504089f)); }
                u32x4 w; w.x = cvt_pk_bf16(y[0], y[1]); w.y = cvt_pk_bf16(y[2], y[3]); w.z = cvt_pk_bf16(y[4], y[5]); w.w = cvt_pk_bf16(y[6], y[7]);
                *(u32x4*)rowp = w;
                if (m & 1) __builtin_amdgcn_sched_barrier(0); }
    }
};
struct EpiOddIn {
    static constexpr int PERM = 2;
    bf16_t* O; const float* lb;
    template <int MODE> __device__ __forceinline__ void run(const f32x4 (&acc)[2][2][4][2], const Unit& u, int wr, int wc, int fr, int fq, float c) const {
        const int row0 = u.pm * BM + wr * 64 + fr, col0 = u.pn * BM + wc * 64 + 8 * fq; const int seg = u.pn >> 2;
        f32x4 lbv[2][2];
        if (MODE == 1) {
#pragma unroll
            for (int bj = 0; bj < 2; ++bj)
#pragma unroll
                for (int n = 0; n < 2; ++n) lbv[bj][n] = *(const f32x4*)(lb + (col0 - 2048) + bj * 32 + 4 * n); }
#pragma unroll
        for (int ai = 0; ai < 2; ++ai)
#pragma unroll
            for (int m = 0; m < 4; ++m) { bf16_t* rowp = O + ((size_t)((u.pn & 3) * 2 + (wc >> 1)) * MT + (size_t)(row0 + ai * HALF + m * 16)) * 640 + seg * 128 + (wc & 1) * 64 + 8 * fq;
#pragma unroll
                for (int bj = 0; bj < 2; ++bj) { f32x4 v[2] = {acc[ai][bj][m][0], acc[ai][bj][m][1]};
#pragma unroll
                    for (int n = 0; n < 2; ++n)
#pragma unroll
                        for (int i = 0; i < 4; ++i) { float x = v[n][i];
                            if (MODE == 0) x = (x * c) * __builtin_amdgcn_rcpf(1.0f + __builtin_amdgcn_exp2f(x * -1.44269504089f));
                            else if (MODE == 1) { const float l = lbv[bj][n][i]; const float s = __builtin_amdgcn_rcpf(1.0f + __builtin_amdgcn_exp2f(x * -1.44269504089f)); const float f = l + (1.0f - l) * s; x = __builtin_amdgcn_logf(fmaxf(f, 1e-30f)) * 0.69314718056f; }
                            v[n][i] = x; }
                    u32x4 w; w.x = cvt_pk_bf16(v[0][0], v[0][1]); w.y = cvt_pk_bf16(v[0][2], v[0][3]); w.z = cvt_pk_bf16(v[1][0], v[1][1]); w.w = cvt_pk_bf16(v[1][2], v[1][3]);
                    *(u32x4*)(rowp + bj * 32) = w; } }
    }
    __device__ __forceinline__ void operator()(const f32x4 (&acc)[2][2][4][2], const Unit& u, int wr, int wc, int fr, int fq) const {
        const int seg = u.pn >> 2;
        if (seg == 0) run<0>(acc, u, wr, wc, fr, fq, 0.08838834764831845f);
        else if (seg == 1) run<0>(acc, u, wr, wc, fr, fq, 1.0f);
        else if (seg == 4) run<2>(acc, u, wr, wc, fr, fq, 1.0f);
        else run<1>(acc, u, wr, wc, fr, fq, 1.0f);
    }
};
struct EpiNull { static constexpr bool PERM = true; float* sink;
    __device__ __forceinline__ void operator()(const f32x4 (&acc)[2][2][4][2], const Unit& u, int wr, int wc, int fr, int fq) const {
        float s = 0.f;
#pragma unroll
        for (int ai = 0; ai < 2; ++ai)
#pragma unroll
            for (int bj = 0; bj < 2; ++bj)
#pragma unroll
                for (int m = 0; m < 4; ++m)
#pragma unroll
                    for (int n = 0; n < 2; ++n) s += acc[ai][bj][m][n][0] + acc[ai][bj][m][n][1] + acc[ai][bj][m][n][2] + acc[ai][bj][m][n][3];
        if (s == 123.456f) sink[0] = s; } };
struct EpiMoeDown {
    static constexpr bool PERM = true;
    bf16_t* O; const int* dst; float* partm;
    __device__ __forceinline__ void operator()(const f32x4 (&acc)[2][2][4][2], const Unit& u, int wr, int wc, int fr, int fq) const {
        const int row0 = u.pm * BM + wr * 64 + fr, col0 = u.pn * BM + wc * 32 + 8 * fq;
        if (u.pm >= 256) {
            float* base = partm + ((size_t)u.kp * 3072 + (size_t)(row0 - 65536)) * D + col0;
#pragma unroll
            for (int ai = 0; ai < 2; ++ai)
#pragma unroll
                for (int m = 0; m < 4; ++m) { float* rowp = base + (size_t)(ai * HALF + m * 16) * D;
#pragma unroll
                    for (int bj = 0; bj < 2; ++bj) { *(f32x4*)(rowp + bj * HALF) = acc[ai][bj][m][0]; *(f32x4*)(rowp + bj * HALF + 4) = acc[ai][bj][m][1]; } }
            return;
        }
        bf16_t* base = O + (size_t)row0 * D + col0;
#pragma unroll
        for (int ai = 0; ai < 2; ++ai)
#pragma unroll
            for (int m = 0; m < 4; ++m) { bf16_t* rowp = base + (size_t)(ai * HALF + m * 16) * D;
#pragma unroll
                for (int bj = 0; bj < 2; ++bj) { const f32x4 v0 = acc[ai][bj][m][0], v1 = acc[ai][bj][m][1];
                    u32x4 w; w.x = cvt_pk_bf16(v0[0], v0[1]); w.y = cvt_pk_bf16(v0[2], v0[3]); w.z = cvt_pk_bf16(v1[0], v1[1]); w.w = cvt_pk_bf16(v1[2], v1[3]);
                    *(u32x4*)(rowp + bj * HALF) = w; } }
    }
};
}

struct Args { const float* in[24]; float* out; unsigned char* ws; int ph_lo, ph_hi; };
enum { I_X = 0, I_C, I_CTX, I_CCTX, I_WADA, I_BADA, I_NMIX, I_NFFN, I_NOUT, I_WINE, I_GW, I_GB, I_WOUTE, I_WINO, I_RLB, I_RNORM, I_WOUTO, I_F1, I_F3, I_F2, I_RW, I_M1, I_M3, I_M2 };
enum { PH_P0 = 0, PH_PAIR0 = 1, NPL = 18, PH_FINAL = 1 + 2 * NPL, NPHASE = PH_FINAL + 1 };
enum { E1_NORM = 0, E2_GIN, E3_FFTA, E3_FFTC, E4_GOUT, E5_NORM, E6_UP, E7_DOWN, O1_NORM, O2_GIN, O3_SCAN1, O4_CARRY, O5_SCAN3, O6_GOUT, O7_NORM, O8_SLOTS, O9_MUP, O10_MDOWN };

#define LAUNDER_WS_OUT(extra_) do { auto w_ = (__attribute__((address_space(1))) unsigned char*)F.ws; auto o_ = (__attribute__((address_space(1))) float*)F.out; \
        asm volatile("" : "+s"(w_), "+s"(o_) extra_); F.ws = (unsigned char*)w_; F.out = (float*)o_; } while (0)
#define FIN(i) (F.in[i])
struct Ctx {
    LAS unsigned char* lds; int tid, lane, wave, G, bid, gw, NGW;
    const float* const* in; float* out; unsigned char* ws;
};

__device__ __forceinline__ void transpose_item(const float* W, int ld, int K, int N, bf16_t* WT, int mode, int roff, int item, int lane) {
    const int nblk = N / 64, kb = item / nblk, nb = item % nblk, k0 = 64 * kb, n0 = 64 * nb;
    const int c = lane & 15, kg = lane >> 4;
    const float* src = W + (size_t)(k0 + 8 * kg) * ld + n0 + 4 * c;
    f32x4 v[2][8];
#pragma unroll
    for (int hf = 0; hf < 2; ++hf)
#pragma unroll
        for (int i = 0; i < 8; ++i) v[hf][i] = __builtin_nontemporal_load((const f32x4*)(src + (size_t)(32 * hf + i) * ld));
    __builtin_amdgcn_sched_barrier(0);
#pragma unroll
    for (int i = 0; i < 4; ++i) { const int ng = n0 + 4 * c + i; const int drow = mode == 0 ? (roff + ng) : (((ng >> 7) << 8) + (ng & 127) + roff);
#pragma unroll
        for (int hf = 0; hf < 2; ++hf) { u32x4 o; o.x = pk2(v[hf][0][i], v[hf][1][i]); o.y = pk2(v[hf][2][i], v[hf][3][i]); o.z = pk2(v[hf][4][i], v[hf][5][i]); o.w = pk2(v[hf][6][i], v[hf][7][i]);
            *(u32x4*)(WT + (size_t)drow * K + k0 + 32 * hf + 8 * kg) = o; } }
}

constexpr int DENSE_PER_J = 16 * 16 + 16 * 16 + 16 * 80 + 16 * 16 + 2 * 16 * 44 + 44 * 16;
__device__ __forceinline__ void dense_convert_item(const Ctx& F, int j, int r) {
    constexpr int NI_UV = 16 * 16, NI_SQ = 16 * 16, NI_INO = 16 * 80, NI_F13 = 16 * 44;
    unsigned char* ws = F.ws; bf16_t* WinE = (bf16_t*)(ws + WS_WINE);
    const float* W; int ld, K, N, mode = 0, roff = 0; bf16_t* WT;
    if (r < NI_UV) { W = FIN(I_WINE) + (size_t)j * D * 1536 + 512; ld = 1536; K = D; N = 1024; WT = WinE + (size_t)j * NEIN * D; roff = 1024; }
    else if ((r -= NI_UV) < NI_SQ) { W = FIN(I_WOUTE) + (size_t)j * D * D; ld = D; K = D; N = D; WT = (bf16_t*)(ws + WS_WOUTE) + (size_t)j * D * D; }
    else if ((r -= NI_SQ) < NI_INO) { W = FIN(I_WINO) + (size_t)j * D * NREC; ld = NREC; K = D; N = NREC; WT = (bf16_t*)(ws + WS_WINO) + (size_t)j * NREC * D; }
    else if ((r -= NI_INO) < NI_SQ) { W = FIN(I_WOUTO) + (size_t)j * D * D; ld = D; K = D; N = D; WT = (bf16_t*)(ws + WS_WOUTO) + (size_t)j * D * D; }
    else if ((r -= NI_SQ) < NI_F13) { W = FIN(I_F1) + (size_t)j * D * DFF; ld = DFF; K = D; N = DFF; WT = (bf16_t*)(ws + WS_W13) + (size_t)j * NFF2 * D; mode = 1; }
    else if ((r -= NI_F13) < NI_F13) { W = FIN(I_F3) + (size_t)j * D * DFF; ld = DFF; K = D; N = DFF; WT = (bf16_t*)(ws + WS_W13) + (size_t)j * NFF2 * D; mode = 1; roff = 128; }
    else { r -= NI_F13; W = FIN(I_F2) + (size_t)j * DFF * D; ld = D; K = DFF; N = D; WT = (bf16_t*)(ws + WS_W2) + (size_t)j * D * DFF; }
    transpose_item(W, ld, K, N, WT, mode, roff, r, F.lane);
}
__device__ __forceinline__ void dense_fill(const Ctx& F, int lo, int hi) {
    if (F.G <= 32 || F.bid < 32) return;
#pragma unroll 1
    for (int idx = lo + (F.bid - 32) * 8 + F.wave; idx < hi; idx += (F.G - 32) * 8) dense_convert_item(F, 1, idx);
}

__device__ __forceinline__ void p0_prologue(const Ctx& F) {
    const int tid = F.tid, lane = F.lane, wave = F.wave;
    unsigned char* ws = F.ws;
    LAS float* scond = (LAS float*)(F.lds);
    LAS float* part = (LAS float*)(F.lds + 16384);
    LAS float* ctab = (LAS float*)(F.lds + 32768);
    for (int i = tid; i < 3 * D; i += 512) { const int v = i / D, k = i % D; const float c = v < 2 ? FIN(I_C)[v * D + k] : FIN(I_CCTX)[k]; scond[i] = c / (1.0f + expf(-c)); }
    if (tid < 128) ctab[tid] = cosf(6.283185307179586f * (float)tid / 128.0f);
    __syncthreads();
    float* mods = (float*)(ws + WS_MODS);
    if (P0_MASK & 1)
    for (int it = F.bid; it < 4 * 48; it += F.G) {
        const int l = it / 48, cg = it % 48; const float* W = FIN(I_WADA) + (size_t)l * D * 6144 + cg * 128 + 2 * lane;
        float a0[2] = {0.f, 0.f}, a1[2] = {0.f, 0.f}, a2[2] = {0.f, 0.f};
#pragma unroll 16
        for (int kk = 0; kk < 128; ++kk) { const int k = wave * 128 + kk; const f32x2 w = __builtin_nontemporal_load((const f32x2*)(W + (size_t)k * 6144)); const float s0 = scond[k], s1 = scond[D + k], s2 = scond[2 * D + k];
            a0[0] += s0 * w.x; a0[1] += s0 * w.y; a1[0] += s1 * w.x; a1[1] += s1 * w.y; a2[0] += s2 * w.x; a2[1] += s2 * w.y; }
        part[(wave * 3 + 0) * 128 + 2 * lane] = a0[0]; part[(wave * 3 + 0) * 128 + 2 * lane + 1] = a0[1];
        part[(wave * 3 + 1) * 128 + 2 * lane] = a1[0]; part[(wave * 3 + 1) * 128 + 2 * lane + 1] = a1[1];
        part[(wave * 3 + 2) * 128 + 2 * lane] = a2[0]; part[(wave * 3 + 2) * 128 + 2 * lane + 1] = a2[1];
        __syncthreads();
        if (tid < 384) { const int v = tid / 128, c = tid % 128; float sum = 0.f;
#pragma unroll
            for (int w = 0; w < 8; ++w) sum += part[(w * 3 + v) * 128 + c];
            mods[((size_t)l * 3 + v) * 6144 + cg * 128 + c] = sum + FIN(I_BADA)[l * 6144 + cg * 128 + c]; }
        __syncthreads();
    }
    const int gt = F.bid * 512 + tid, NGT = F.G * 512;
    float* LB = (float*)(ws + WS_LB);
    if (P0_MASK & 2)
    for (int i = gt; i < 4096; i += NGT) { const int j = i >> 11, r = i & 2047; float v = 0.f; if (j == 1) { const float r0 = FIN(I_RLB)[r], r1 = FIN(I_RLB)[2048 + r]; v = 1.0f / (1.0f + expf(r0 - r1)); v = fminf(fmaxf(v, 0.f), 1.f); } LB[i] = v; }
    bf16_t* FA = (bf16_t*)(ws + WS_FA); bf16_t* FC = (bf16_t*)(ws + WS_FC); bf16_t* FX = (bf16_t*)(ws + WS_FX); bf16_t* GW = (bf16_t*)(ws + WS_GW);
    if (P0_MASK & 4)
    for (int i = gt; i < 256 * 256; i += NGT) { const int r = i >> 8, c = i & 255, k1 = r & 127, t1 = c & 127; const float ang = 6.283185307179586f * (float)((k1 * t1) & 127) / 128.0f; float sn, cs; sincosf(ang, &sn, &cs);
        const int rr = r >> 7, cc = c >> 7; const float v = (rr == cc) ? cs : (rr == 0 ? -sn : sn); FA[i] = (bf16_t)f2bf(v); }
    if (P0_MASK & 4)
    for (int i = gt; i < 128 * 256; i += NGT) { const int k2 = i >> 8, c = i & 255, t2 = c & 127; const float ang = 6.283185307179586f * (float)((k2 * t2) & 127) / 128.0f; float sn, cs; sincosf(ang, &sn, &cs); FC[i] = (bf16_t)f2bf(c < 128 ? cs : -sn); }
    if (P0_MASK & 4)
    for (int i = gt; i < 256 * 512; i += NGT) { const int k = i >> 9, c = i & 511, t = c & 255; const float ang = 6.283185307179586f * (float)((k * t) & 255) / 256.0f; float sn, cs; sincosf(ang, &sn, &cs); FX[i] = (bf16_t)f2bf(c < 256 ? cs : -sn); }
    if (P0_MASK & 8)
    for (int i = gt; i < 2 * 4 * 128 * 128; i += NGT) GW[i] = (bf16_t)f2bf(FIN(I_GW)[i]);
    bf16_t* WinE = (bf16_t*)(ws + WS_WINE);
    if (P0_MASK & 16)
    for (int it = F.gw; it < 2 * 4 * 16 * 32; it += F.NGW) {
        const int mg = it & 31, kb = (it >> 5) & 15, g = (it >> 9) & 3, j = it >> 11; const int k = kb * 64 + lane, m0 = mg * 4;
        const float* Wr = FIN(I_WINE) + (size_t)j * D * 1536 + (size_t)k * 1536 + g * 128;
        float aP[4] = {0.f, 0.f, 0.f, 0.f}, aQ[4] = {0.f, 0.f, 0.f, 0.f};
        f32x4 wq_[32];
#pragma unroll
        for (int c4 = 0; c4 < 32; ++c4) wq_[c4] = *(const f32x4*)(Wr + 4 * c4);
        __builtin_amdgcn_sched_barrier(0);
#pragma unroll
        for (int c4 = 0; c4 < 32; ++c4) { const f32x4 w = wq_[c4];
#pragma unroll
            for (int ci = 0; ci < 4; ++ci) { const int c = 4 * c4 + ci;
#pragma unroll
                for (int mm = 0; mm < 4; ++mm) { const int idx = (c * (m0 + mm)) & 127; aP[mm] += w[ci] * ctab[idx]; aQ[mm] += w[ci] * ctab[(idx - 32) & 127]; } } }
#pragma unroll
        for (int mm = 0; mm < 4; ++mm) { bf16_t* o = WinE + (size_t)j * NEIN * D; o[(size_t)(g * 128 + m0 + mm) * D + k] = (bf16_t)f2bf(aP[mm]); o[(size_t)(512 + g * 128 + m0 + mm) * D + k] = (bf16_t)f2bf(aQ[mm]); }
    }
    if (P0_MASK & 32)
    for (int it = F.gw; it < (F.G > 32 ? 1 : 2) * DENSE_PER_J; it += F.NGW) dense_convert_item(F, it / DENSE_PER_J, it % DENSE_PER_J);
}
constexpr int MOE_CONV_ITEMS = NE * (2 * 16 * 56 + 56 * 16);
__device__ __forceinline__ void moe_convert_item(const Ctx& F, int j, int it) {
    constexpr int I_13 = 16 * 56, I_2 = 56 * 16, PER_E = 2 * I_13 + I_2;
    const int e = it / PER_E; int r = it % PER_E; const size_t eo = (size_t)(j * NE + e);
    const float* W; int ld, K, N, mode = 0, roff = 0; bf16_t* WT;
    if (r < I_13) { W = FIN(I_M1) + eo * D * DEX; ld = DEX; K = D; N = DEX; WT = (bf16_t*)(F.ws + WS_W13M) + (size_t)e * NEX2 * D; mode = 1; }
    else if ((r -= I_13) < I_13) { W = FIN(I_M3) + eo * D * DEX; ld = DEX; K = D; N = DEX; WT = (bf16_t*)(F.ws + WS_W13M) + (size_t)e * NEX2 * D; mode = 1; roff = 128; }
    else { r -= I_13; W = FIN(I_M2) + eo * DEX * D; ld = D; K = DEX; N = D; WT = (bf16_t*)(F.ws + WS_W2M) + (size_t)e * D * DEX; }
    transpose_item(W, ld, K, N, WT, mode, roff, r, F.lane);
}

struct RowPass {
    const float* sl; const float* sc;
    bf16_t* xb;
    const float* gain;
    const float* shift; const float* scale;
    bf16_t* H;
    int nrows;
    const bf16_t* YE; const float* topp; const float* gatef;
    const float* rw; int* tope; float* toppo; int* rank; int* cnt;
    float* fout;
    const float* part; int kpn; const float* pgate; const float* csrc32;
    const int* slotof; const float* partm;
};
struct RowPart { int WB, WC; };
__device__ __forceinline__ RowPart row_part(int NW, int nrows) { RowPart q; q.WC = nrows > ML ? NW / 32 : 0; q.WB = (NW - q.WC) / 2; return q; }
__device__ __forceinline__ void row_chunk(const RowPart& q, int gw, int& r0, int& r1) {
    if (gw < 2 * q.WB) { const int b = gw / q.WB, i = gw % q.WB; r0 = b * TL + (int)(((long)i * TL) / q.WB); r1 = b * TL + (int)(((long)(i + 1) * TL) / q.WB); }
    else { const int i = gw - 2 * q.WB; r0 = ML + (i * MC) / q.WC; r1 = ML + ((i + 1) * MC) / q.WC; }
}
__device__ __forceinline__ int row_chunk_of(const RowPart& q, int r) {
    if (r < ML) { const int b = r >> 14, lr = r & (TL - 1); return b * q.WB + (int)(((long)q.WB * (lr + 1) - 1) / TL); }
    return 2 * q.WB + ((r - ML + 1) * q.WC - 1) / MC;
}
__device__ __forceinline__ f32x4 bf4(u32x2 r) { return (f32x4){bflo(r.x), bfhi(r.x), bflo(r.y), bfhi(r.y)}; }
template <bool COMBINE, bool ROUTER, bool FINAL, bool SRCB>
__device__ __forceinline__ void row_pass(const Ctx& F, const RowPass& P) {
    const int lane = F.lane;
    f32x4 rwr[16][2];
    if (ROUTER) {
#pragma unroll
        for (int j = 0; j < 4; ++j)
#pragma unroll
            for (int i = 0; i < 4; ++i) { const int col = 4 * lane + 256 * j + i; rwr[4 * j + i][0] = *(const f32x4*)(P.rw + col * 8); rwr[4 * j + i][1] = *(const f32x4*)(P.rw + col * 8 + 4); } }
    f32x4 gn[4];
#pragma unroll
    for (int j = 0; j < 4; ++j) gn[j] = *(const f32x4*)(P.gain + 4 * lane + 256 * j);
    const RowPart rp = row_part(F.NGW, P.nrows);
    int r0, r1; row_chunk(rp, F.gw, r0, r1);
    {
        int rc0 = 0, rc1 = 0, rc2 = 0, rc3 = 0, rc4 = 0, rc5 = 0, rc6 = 0, rc7 = 0;
        const bool isc = r0 >= ML; const int ms = isc ? 2 : (r0 >= TL ? 1 : 0);
        const float* xs32 = SRCB ? nullptr : (isc ? P.sc + (size_t)(r0 - ML) * D : P.sl + (size_t)r0 * D);
        bf16_t* xb0 = P.xb + (size_t)r0 * D;
        if (SRCB && !COMBINE && !FINAL) { if (isc && P.part) {
            const float* c32 = P.csrc32 ? P.csrc32 + (size_t)(r0 - ML) * D : nullptr;
#pragma unroll 1
            for (int rr = 0; rr < r1 - r0; ++rr) {
#pragma unroll 2
                for (int j = 0; j < 4; ++j) { f32x4 a[4];
#pragma unroll
                    for (int kp = 0; kp < 4; ++kp) a[kp] = kp < P.kpn ? *(const f32x4*)(P.part + ((size_t)kp * MC + (size_t)(r0 - ML + rr)) * D + 4 * lane + 256 * j) : (f32x4){0.f, 0.f, 0.f, 0.f};
                    const f32x4 x0 = c32 ? *(const f32x4*)(c32 + (size_t)rr * D + 4 * lane + 256 * j) : bf4(*(const u32x2*)(xb0 + (size_t)rr * D + 4 * lane + 256 * j));
                    const f32x4 y = x0 + *(const f32x4*)(P.pgate + 2 * 6144 + 4 * lane + 256 * j) * ((a[0] + a[1]) + (a[2] + a[3]));
                    u32x2 w; w.x = pk2(y[0], y[1]); w.y = pk2(y[2], y[3]); *(u32x2*)(xb0 + (size_t)rr * D + 4 * lane + 256 * j) = w; } }
            asm volatile("s_waitcnt vmcnt(0)" ::: "memory"); } }
        f32x4 sh[4], scl[4], gf[4];
#pragma unroll
        for (int j = 0; j < 4; ++j) {
            if (!FINAL && !COMBINE && !ROUTER) { sh[j] = *(const f32x4*)(P.shift + ms * 6144 + 4 * lane + 256 * j); scl[j] = *(const f32x4*)(P.scale + ms * 6144 + 4 * lane + 256 * j) + 1.0f; }
            if (COMBINE) gf[j] = *(const f32x4*)(P.gatef + ms * 6144 + 4 * lane + 256 * j); }
        f32x4 v[4]; f32x4 v32n[4]; u32x2 vbn[4]; u32x2 ya[4], yb[4]; float p0 = 0.f, p1 = 0.f;
#pragma unroll
        for (int j = 0; j < 4; ++j) v[j] = SRCB ? bf4(*(const u32x2*)(xb0 + 4 * lane + 256 * j)) : *(const f32x4*)(xs32 + 4 * lane + 256 * j);
        if (COMBINE) { p0 = P.topp[2 * r0]; p1 = P.topp[2 * r0 + 1];
#pragma unroll
            for (int j = 0; j < 4; ++j) { ya[j] = *(const u32x2*)(P.YE + (size_t)(2 * r0) * D + 4 * lane + 256 * j); yb[j] = *(const u32x2*)(P.YE + (size_t)(2 * r0 + 1) * D + 4 * lane + 256 * j); } }
        for (int r = r0; r < r1; ++r) {
            const int rr = r - r0; const bool more = r + 1 < r1;
            u32x2 yan[4], ybn[4]; float p0n = 0.f, p1n = 0.f;
            if (more) {
#pragma unroll
                for (int j = 0; j < 4; ++j) { if (SRCB) vbn[j] = *(const u32x2*)(xb0 + (size_t)(rr + 1) * D + 4 * lane + 256 * j); else v32n[j] = *(const f32x4*)(xs32 + (size_t)(rr + 1) * D + 4 * lane + 256 * j); }
                if (COMBINE) { p0n = P.topp[2 * r + 2]; p1n = P.topp[2 * r + 3];
#pragma unroll
                    for (int j = 0; j < 4; ++j) { yan[j] = *(const u32x2*)(P.YE + (size_t)(2 * r + 2) * D + 4 * lane + 256 * j); ybn[j] = *(const u32x2*)(P.YE + (size_t)(2 * r + 3) * D + 4 * lane + 256 * j); } }
            }
            if (COMBINE) {
                const int sl0 = P.slotof[2 * r], sl1 = P.slotof[2 * r + 1];
#pragma unroll
                for (int j = 0; j < 4; ++j) { f32x4 y0 = bf4(ya[j]), y1 = bf4(yb[j]);
                    if (sl0 >= 65536) { y0 = (f32x4){0.f, 0.f, 0.f, 0.f}; for (int kp = 0; kp < 4; ++kp) y0 = y0 + *(const f32x4*)(P.partm + ((size_t)kp * 3072 + (size_t)(sl0 - 65536)) * D + 4 * lane + 256 * j); }
                    if (sl1 >= 65536) { y1 = (f32x4){0.f, 0.f, 0.f, 0.f}; for (int kp = 0; kp < 4; ++kp) y1 = y1 + *(const f32x4*)(P.partm + ((size_t)kp * 3072 + (size_t)(sl1 - 65536)) * D + 4 * lane + 256 * j); }
                    v[j] = v[j] + gf[j] * (y0 * p0 + y1 * p1);
                    if (!FINAL) { u32x2 w; w.x = pk2(v[j][0], v[j][1]); w.y = pk2(v[j][2], v[j][3]); *(u32x2*)(xb0 + (size_t)rr * D + 4 * lane + 256 * j) = w; } }
            }
            float ss = 0.f;
#pragma unroll
            for (int j = 0; j < 4; ++j) ss += (v[j][0] * v[j][0] + v[j][1] * v[j][1]) + (v[j][2] * v[j][2] + v[j][3] * v[j][3]);
            const float rstd = rsqrtf(wave_sum(ss, lane) * (1.0f / D) + EPS);
            if (FINAL) {
#pragma unroll
                for (int j = 0; j < 4; ++j) *(f32x4*)(P.fout + (size_t)r * D + 4 * lane + 256 * j) = v[j] * rstd * gn[j];
            } else {
                f32x4 h[4];
#pragma unroll
                for (int j = 0; j < 4; ++j) { if (COMBINE || ROUTER) { sh[j] = *(const f32x4*)(P.shift + ms * 6144 + 4 * lane + 256 * j); scl[j] = *(const f32x4*)(P.scale + ms * 6144 + 4 * lane + 256 * j) + 1.0f; }
                    h[j] = (v[j] * rstd * gn[j]) * scl[j] + sh[j];
                    u32x2 w; w.x = pk2(h[j][0], h[j][1]); w.y = pk2(h[j][2], h[j][3]);
                    *(u32x2*)(P.H + (size_t)r * D + 4 * lane + 256 * j) = w; }
                if (ROUTER) {
                    float lg[8] = {0.f, 0.f, 0.f, 0.f, 0.f, 0.f, 0.f, 0.f};
#pragma unroll
                    for (int j = 0; j < 4; ++j) {
#pragma unroll
                        for (int i = 0; i < 4; ++i) { const f32x4 w0 = rwr[4 * j + i][0], w1 = rwr[4 * j + i][1]; const float hv = h[j][i];
                            lg[0] += hv * w0[0]; lg[1] += hv * w0[1]; lg[2] += hv * w0[2]; lg[3] += hv * w0[3]; lg[4] += hv * w1[0]; lg[5] += hv * w1[1]; lg[6] += hv * w1[2]; lg[7] += hv * w1[3]; }
                        __builtin_amdgcn_sched_barrier(0); }
                    {
                        const bool b5 = (lane & 32) != 0, b4 = (lane & 16) != 0, b3 = (lane & 8) != 0;
                        float a4[4], a2[2];
#pragma unroll
                        for (int i = 0; i < 4; ++i) { const float snd = b5 ? lg[i] : lg[4 + i], kp_ = b5 ? lg[4 + i] : lg[i]; a4[i] = kp_ + shfl_x(snd, 32, lane); }
#pragma unroll
                        for (int i = 0; i < 2; ++i) { const float snd = b4 ? a4[i] : a4[2 + i], kp_ = b4 ? a4[2 + i] : a4[i]; a2[i] = kp_ + shfl_x(snd, 16, lane); }
                        float c1; { const float snd = b3 ? a2[0] : a2[1], kp_ = b3 ? a2[1] : a2[0]; c1 = kp_ + shfl_x(snd, 8, lane); }
                        c1 += shfl_x(c1, 4, lane); c1 += shfl_x(c1, 2, lane); c1 += shfl_x(c1, 1, lane);
#pragma unroll
                        for (int e = 0; e < 8; ++e) lg[e] = __builtin_bit_cast(float, __builtin_amdgcn_readlane(__builtin_bit_cast(int, c1), 8 * e));
                    }
                    int e0 = 0; float v0 = lg[0];
#pragma unroll
                    for (int e = 1; e < 8; ++e) if (lg[e] > v0) { v0 = lg[e]; e0 = e; }
                    int e1 = -1; float v1 = -3.0e38f;
#pragma unroll
                    for (int e = 0; e < 8; ++e) if (e != e0 && lg[e] > v1) { v1 = lg[e]; e1 = e; }
                    const float ex = expf(v1 - v0); const float q0 = 1.0f / (1.0f + ex), q1 = ex / (1.0f + ex);
                    const int rk0 = e0 == 0 ? rc0 : e0 == 1 ? rc1 : e0 == 2 ? rc2 : e0 == 3 ? rc3 : e0 == 4 ? rc4 : e0 == 5 ? rc5 : e0 == 6 ? rc6 : rc7;
                    const int rk1 = e1 == 0 ? rc0 : e1 == 1 ? rc1 : e1 == 2 ? rc2 : e1 == 3 ? rc3 : e1 == 4 ? rc4 : e1 == 5 ? rc5 : e1 == 6 ? rc6 : rc7;
                    rc0 += (e0 == 0) + (e1 == 0); rc1 += (e0 == 1) + (e1 == 1); rc2 += (e0 == 2) + (e1 == 2); rc3 += (e0 == 3) + (e1 == 3);
                    rc4 += (e0 == 4) + (e1 == 4); rc5 += (e0 == 5) + (e1 == 5); rc6 += (e0 == 6) + (e1 == 6); rc7 += (e0 == 7) + (e1 == 7);
                    if (lane == 0) { P.tope[2 * r] = e0; P.tope[2 * r + 1] = e1; P.toppo[2 * r] = q0; P.toppo[2 * r + 1] = q1; P.rank[2 * r] = rk0; P.rank[2 * r + 1] = rk1; }
                }
            }
            if (more) {
#pragma unroll
                for (int j = 0; j < 4; ++j) { v[j] = SRCB ? bf4(vbn[j]) : v32n[j]; if (COMBINE) { ya[j] = yan[j]; yb[j] = ybn[j]; } }
                if (COMBINE) { p0 = p0n; p1 = p1n; }
            }
        }
        if (ROUTER && lane == 0) { int* c = P.cnt + F.gw * 8; c[0] = rc0; c[1] = rc1; c[2] = rc2; c[3] = rc3; c[4] = rc4; c[5] = rc5; c[6] = rc6; c[7] = rc7; }
    }
}

template <bool COMBINE, bool ROUTER, bool FINAL, int RB>
__device__ __forceinline__ void row_pass_b(const Ctx& F, const RowPass& P) {
    const int lane = F.lane;
    f32x4 rwr[16][2];
    if (ROUTER) {
#pragma unroll
        for (int j = 0; j < 4; ++j)
#pragma unroll
            for (int i = 0; i < 4; ++i) { const int col = 4 * lane + 256 * j + i; rwr[4 * j + i][0] = *(const f32x4*)(P.rw + col * 8); rwr[4 * j + i][1] = *(const f32x4*)(P.rw + col * 8 + 4); } }
    f32x4 gn[4];
    if (!ROUTER) {
#pragma unroll
        for (int j = 0; j < 4; ++j) gn[j] = *(const f32x4*)(P.gain + 4 * lane + 256 * j); }
    const RowPart rp = row_part(F.NGW, P.nrows);
    int r0, r1; row_chunk(rp, F.gw, r0, r1);
    int rc0 = 0, rc1 = 0, rc2 = 0, rc3 = 0, rc4 = 0, rc5 = 0, rc6 = 0, rc7 = 0;
    const bool isc = r0 >= ML; const int ms = isc ? 2 : (r0 >= TL ? 1 : 0);
    bf16_t* xb0 = P.xb + (size_t)r0 * D;
    if (!COMBINE && !FINAL) { if (isc && P.part) {
        const float* c32 = P.csrc32 ? P.csrc32 + (size_t)(r0 - ML) * D : nullptr;
#pragma unroll 1
        for (int rr = 0; rr < r1 - r0; ++rr) {
#pragma unroll 2
            for (int j = 0; j < 4; ++j) { f32x4 a[4];
#pragma unroll
                for (int kp = 0; kp < 4; ++kp) a[kp] = kp < P.kpn ? *(const f32x4*)(P.part + ((size_t)kp * MC + (size_t)(r0 - ML + rr)) * D + 4 * lane + 256 * j) : (f32x4){0.f, 0.f, 0.f, 0.f};
                const f32x4 x0 = c32 ? *(const f32x4*)(c32 + (size_t)rr * D + 4 * lane + 256 * j) : bf4(*(const u32x2*)(xb0 + (size_t)rr * D + 4 * lane + 256 * j));
                const f32x4 y = x0 + *(const f32x4*)(P.pgate + 2 * 6144 + 4 * lane + 256 * j) * ((a[0] + a[1]) + (a[2] + a[3]));
                u32x2 w; w.x = pk2(y[0], y[1]); w.y = pk2(y[2], y[3]); *(u32x2*)(xb0 + (size_t)rr * D + 4 * lane + 256 * j) = w; } }
        asm volatile("s_waitcnt vmcnt(0)" ::: "memory"); } }
    f32x4 sh[4], scl[4], gf[4];
#pragma unroll
    for (int j = 0; j < 4; ++j) {
        if (!FINAL && !ROUTER) { sh[j] = *(const f32x4*)(P.shift + ms * 6144 + 4 * lane + 256 * j); scl[j] = *(const f32x4*)(P.scale + ms * 6144 + 4 * lane + 256 * j) + 1.0f; }
        if (COMBINE) gf[j] = *(const f32x4*)(P.gatef + ms * 6144 + 4 * lane + 256 * j); }
    const int nr = r1 - r0;
    u32x2 cur[RB][4], nxt[RB][4], ya[RB][4], yb[RB][4], yan[RB][4], ybn[RB][4];
#define RPB_LOAD(X, YA, YB, base_) do { _Pragma("unroll") for (int k = 0; k < RB; ++k) { const int rk_ = ((base_) + k < nr) ? (base_) + k : nr - 1; \
        int sa_ = 0, sb_ = 0; if (COMBINE) { sa_ = P.slotof[2 * (r0 + rk_)]; sb_ = P.slotof[2 * (r0 + rk_) + 1]; sa_ = sa_ < 65536 ? sa_ : 65535; sb_ = sb_ < 65536 ? sb_ : 65535; }     \
        _Pragma("unroll") for (int j = 0; j < 4; ++j) { X[k][j] = *(const u32x2*)(xb0 + (size_t)rk_ * D + 4 * lane + 256 * j); \
            if (COMBINE) { YA[k][j] = *(const u32x2*)(P.YE + (size_t)sa_ * D + 4 * lane + 256 * j); YB[k][j] = *(const u32x2*)(P.YE + (size_t)sb_ * D + 4 * lane + 256 * j); } } } } while (0)
    const int ng = (nr + RB - 1) / RB; int gi = F.gw % ng;
    RPB_LOAD(cur, ya, yb, gi * RB);
    for (int it = 0; it < ng; ++it) {
        const int rb = gi * RB; gi = gi + 1 == ng ? 0 : gi + 1;
        if (it + 1 < ng) RPB_LOAD(nxt, yan, ybn, gi * RB);
        f32x4 v[RB][4]; float ss[RB];
#pragma unroll
        for (int k = 0; k < RB; ++k) {
            const int rk = (rb + k < nr) ? rb + k : nr - 1; const int r = r0 + rk;
#pragma unroll
            for (int j = 0; j < 4; ++j) v[k][j] = bf4(cur[k][j]);
            if (COMBINE) {
                const float p0 = P.topp[2 * r], p1 = P.topp[2 * r + 1]; const int sl0 = P.slotof[2 * r], sl1 = P.slotof[2 * r + 1];
#pragma unroll
                for (int j = 0; j < 4; ++j) { f32x4 y0 = bf4(ya[k][j]), y1 = bf4(yb[k][j]);
                    if (sl0 >= 65536) { y0 = (f32x4){0.f, 0.f, 0.f, 0.f}; for (int kp = 0; kp < 4; ++kp) y0 = y0 + *(const f32x4*)(P.partm + ((size_t)kp * 3072 + (size_t)(sl0 - 65536)) * D + 4 * lane + 256 * j); }
                    if (sl1 >= 65536) { y1 = (f32x4){0.f, 0.f, 0.f, 0.f}; for (int kp = 0; kp < 4; ++kp) y1 = y1 + *(const f32x4*)(P.partm + ((size_t)kp * 3072 + (size_t)(sl1 - 65536)) * D + 4 * lane + 256 * j); }
                    v[k][j] = v[k][j] + gf[j] * (y0 * p0 + y1 * p1);
                    if (!FINAL && rb + k < nr) { u32x2 w; w.x = pk2(v[k][j][0], v[k][j][1]); w.y = pk2(v[k][j][2], v[k][j][3]); *(u32x2*)(xb0 + (size_t)rk * D + 4 * lane + 256 * j) = w; } }
            }
            float s_ = 0.f;
#pragma unroll
            for (int j = 0; j < 4; ++j) s_ += (v[k][j][0] * v[k][j][0] + v[k][j][1] * v[k][j][1]) + (v[k][j][2] * v[k][j][2] + v[k][j][3] * v[k][j][3]);
            ss[k] = s_;
        }
#pragma unroll
        for (int o = 1; o < 64; o <<= 1)
#pragma unroll
            for (int k = 0; k < RB; ++k) ss[k] += shfl_x(ss[k], o, lane);
#pragma unroll
        for (int k = 0; k < RB; ++k) {
            if (rb + k < nr) {
                const int r = r0 + rb + k; const float rstd = rsqrtf(ss[k] * (1.0f / D) + EPS);
                if (FINAL) {
#pragma unroll
                    for (int j = 0; j < 4; ++j) *(f32x4*)(P.fout + (size_t)r * D + 4 * lane + 256 * j) = v[k][j] * rstd * gn[j];
                } else {
                    f32x4 h[4];
#pragma unroll
                    for (int j = 0; j < 4; ++j) {
                        if (ROUTER) { const f32x4 g_ = *(const f32x4*)(P.gain + 4 * lane + 256 * j), s_ = *(const f32x4*)(P.scale + ms * 6144 + 4 * lane + 256 * j) + 1.0f, t_ = *(const f32x4*)(P.shift + ms * 6144 + 4 * lane + 256 * j);
                            h[j] = (bf4(cur[k][j]) * rstd * g_) * s_ + t_; }
                        else h[j] = (v[k][j] * rstd * gn[j]) * scl[j] + sh[j];
                        u32x2 w; w.x = pk2(h[j][0], h[j][1]); w.y = pk2(h[j][2], h[j][3]);
                        *(u32x2*)(P.H + (size_t)r * D + 4 * lane + 256 * j) = w; }
                    if (ROUTER) {
                        float lg[8] = {0.f, 0.f, 0.f, 0.f, 0.f, 0.f, 0.f, 0.f};
#pragma unroll
                        for (int j = 0; j < 4; ++j)
#pragma unroll
                            for (int i = 0; i < 4; ++i) { const f32x4 w0 = rwr[4 * j + i][0], w1 = rwr[4 * j + i][1]; const float hv = h[j][i];
                                lg[0] += hv * w0[0]; lg[1] += hv * w0[1]; lg[2] += hv * w0[2]; lg[3] += hv * w0[3]; lg[4] += hv * w1[0]; lg[5] += hv * w1[1]; lg[6] += hv * w1[2]; lg[7] += hv * w1[3]; }
                        {
                            const bool b5 = (lane & 32) != 0, b4 = (lane & 16) != 0, b3 = (lane & 8) != 0;
                            float a4[4], a2[2];
#pragma unroll
                            for (int i = 0; i < 4; ++i) { const float snd = b5 ? lg[i] : lg[4 + i], kp_ = b5 ? lg[4 + i] : lg[i]; a4[i] = kp_ + shfl_x(snd, 32, lane); }
#pragma unroll
                            for (int i = 0; i < 2; ++i) { const float snd = b4 ? a4[i] : a4[2 + i], kp_ = b4 ? a4[2 + i] : a4[i]; a2[i] = kp_ + shfl_x(snd, 16, lane); }
                            float c1; { const float snd = b3 ? a2[0] : a2[1], kp_ = b3 ? a2[1] : a2[0]; c1 = kp_ + shfl_x(snd, 8, lane); }
                            c1 += shfl_x(c1, 4, lane); c1 += shfl_x(c1, 2, lane); c1 += shfl_x(c1, 1, lane);
#pragma unroll
                            for (int e = 0; e < 8; ++e) lg[e] = __builtin_bit_cast(float, __builtin_amdgcn_readlane(__builtin_bit_cast(int, c1), 8 * e));
                        }
                        int e0 = 0; float v0 = lg[0];
#pragma unroll
                        for (int e = 1; e < 8; ++e) if (lg[e] > v0) { v0 = lg[e]; e0 = e; }
                        int e1 = -1; float v1 = -3.0e38f;
#pragma unroll
                        for (int e = 0; e < 8; ++e) if (e != e0 && lg[e] > v1) { v1 = lg[e]; e1 = e; }
                        const float ex = expf(v1 - v0); const float q0 = 1.0f / (1.0f + ex), q1 = ex / (1.0f + ex);
                        const int rk0 = e0 == 0 ? rc0 : e0 == 1 ? rc1 : e0 == 2 ? rc2 : e0 == 3 ? rc3 : e0 == 4 ? rc4 : e0 == 5 ? rc5 : e0 == 6 ? rc6 : rc7;
                        const int rk1 = e1 == 0 ? rc0 : e1 == 1 ? rc1 : e1 == 2 ? rc2 : e1 == 3 ? rc3 : e1 == 4 ? rc4 : e1 == 5 ? rc5 : e1 == 6 ? rc6 : rc7;
                        rc0 += (e0 == 0) + (e1 == 0); rc1 += (e0 == 1) + (e1 == 1); rc2 += (e0 == 2) + (e1 == 2); rc3 += (e0 == 3) + (e1 == 3);
                        rc4 += (e0 == 4) + (e1 == 4); rc5 += (e0 == 5) + (e1 == 5); rc6 += (e0 == 6) + (e1 == 6); rc7 += (e0 == 7) + (e1 == 7);
                        if (lane == 0) { P.tope[2 * r] = e0; P.tope[2 * r + 1] = e1; P.toppo[2 * r] = q0; P.toppo[2 * r + 1] = q1; P.rank[2 * r] = rk0; P.rank[2 * r + 1] = rk1; }
                    }
                }
            }
        }
        if (it + 1 < ng) {
#pragma unroll
            for (int k = 0; k < RB; ++k)
#pragma unroll
                for (int j = 0; j < 4; ++j) { cur[k][j] = nxt[k][j]; if (COMBINE) { ya[k][j] = yan[k][j]; yb[k][j] = ybn[k][j]; } }
        }
    }
#undef RPB_LOAD
    if (ROUTER && lane == 0) { int* c = P.cnt + F.gw * 8; c[0] = rc0; c[1] = rc1; c[2] = rc2; c[3] = rc3; c[4] = rc4; c[5] = rc5; c[6] = rc6; c[7] = rc7; }
}

template <int NB, int NKS>
__device__ __forceinline__ void lm_load_a(const bf16_t* A, int lda, const int (&i0)[NB], int kc0, bf16x8 (&ap)[NB][NKS], int lane) {
    const int i16 = lane & 15, q = lane >> 4;
#pragma unroll
    for (int b = 0; b < NB; ++b)
#pragma unroll
        for (int ks = 0; ks < NKS; ++ks) ap[b][ks] = *(const bf16x8*)(A + (size_t)(i0[b] + i16) * lda + kc0 + ks * 32 + 8 * q);
}
template <int NB, int NKS>
__device__ __forceinline__ void lm_core(const bf16x8 (&ap)[NB][NKS], LAS unsigned char* X, f32x4 (&acc)[NB][8], int lane) {
    const int i16 = lane & 15, q = lane >> 4;
    const int xoff = (8 * q + (i16 >> 2)) * XRS + 8 * (i16 & 3);
#pragma unroll
    for (int ks = 0; ks < NKS; ++ks) {
        s16x4 lo[8], hi[8];
#pragma unroll
        for (int nt = 0; nt < 8; ++nt) {
            lo[nt] = __builtin_amdgcn_ds_read_tr16_b64_v4i16((LAS s16x4*)(X + ks * 32 * XRS + xoff + nt * 32));
            hi[nt] = __builtin_amdgcn_ds_read_tr16_b64_v4i16((LAS s16x4*)(X + ks * 32 * XRS + xoff + nt * 32 + 4 * XRS)); }
        __builtin_amdgcn_sched_barrier(0);
#pragma unroll
        for (int nt = 0; nt < 8; ++nt) { const bf16x8 xf = __builtin_shufflevector(lo[nt], hi[nt], 0, 1, 2, 3, 4, 5, 6, 7);
#pragma unroll
            for (int b = 0; b < NB; ++b) acc[b][nt] = __builtin_amdgcn_mfma_f32_16x16x32_bf16(xf, ap[b][ks], acc[b][nt], 0, 0, 0); }
    }
}
template <int NB> __device__ __forceinline__ void zero_acc(f32x4 (&acc)[NB][8]) {
#pragma unroll
    for (int b = 0; b < NB; ++b)
#pragma unroll
        for (int nt = 0; nt < 8; ++nt) acc[b][nt] = (f32x4){0.f, 0.f, 0.f, 0.f};
}
__device__ __forceinline__ void stage_rows(const bf16_t* src, size_t sstride, int nrows, LAS unsigned char* X, int xr0, int tid) {
    for (int i = tid; i < nrows * 16; i += 512) { const int r = i >> 4, ch = i & 15; *(LAS u32x4*)(X + (xr0 + r) * XRS + ch * 16) = *(const u32x4*)(src + (size_t)r * sstride + ch * 8); }
}

__device__ __forceinline__ void fft_stage_a(const Ctx& F, unsigned* wq) {
    const bf16_t* PZ = (const bf16_t*)(F.ws + WS_PZUV); bf16_t* UP = (bf16_t*)(F.ws + WS_UP); bf16_t* Y = (bf16_t*)(F.ws + WS_H);
    const bf16_t* FA = (const bf16_t*)(F.ws + WS_FA); const bf16_t* FX = (const bf16_t*)(F.ws + WS_FX);
    LAS unsigned char* X = F.lds; const int lane = F.lane, w = F.wave, i16 = lane & 15, q = lane >> 4;
    volatile LAS unsigned* slot = (volatile LAS unsigned*)(F.lds + MISC_OFF + 64);
    bf16x8 apA[2][8]; { const int i0[2] = {16 * w, 128 + 16 * w}; lm_load_a<2, 8>(FA, 256, i0, 0, apA, lane); }
    for (int it0 = F.bid; it0 < 1024 + 16; ) {
        const int it = it0 < 16 ? 1024 + it0 : it0 - 16;
        if (it < 1024) {
            const int t2 = it & 127, g = (it >> 7) & 3, b = it >> 9;
            const bf16_t* src = PZ + ((size_t)b * TL + t2) * NEIN + g * 128;
            stage_rows(src, (size_t)128 * NEIN, 128, X, 0, F.tid);
            stage_rows(src + 512, (size_t)128 * NEIN, 128, X, 128, F.tid);
            __syncthreads();
            f32x4 acc[2][8]; zero_acc<2>(acc);
            lm_core<2, 8>(apA, X, acc, lane);
            const int k1 = 16 * w + i16; float sw, cw; sincosf(6.283185307179586f * (float)((k1 * t2) & 16383) / 16384.0f, &sw, &cw);
            bf16_t* orow = UP + ((size_t)((b * 4 + g) * 128 + k1) * 128 + t2) * 256;
#pragma unroll
            for (int nt = 0; nt < 8; ++nt) { const f32x4 ur = acc[0][nt], ui = acc[1][nt]; const int n = 16 * nt + 4 * q;
                u32x2 wr_, wi_; wr_.x = pk2(ur[0] * cw - ui[0] * sw, ur[1] * cw - ui[1] * sw); wr_.y = pk2(ur[2] * cw - ui[2] * sw, ur[3] * cw - ui[3] * sw);
                wi_.x = pk2(ur[0] * sw + ui[0] * cw, ur[1] * sw + ui[1] * cw); wi_.y = pk2(ur[2] * sw + ui[2] * cw, ur[3] * sw + ui[3] * cw);
                *(u32x2*)(orow + n) = wr_; *(u32x2*)(orow + 128 + n) = wi_; }
            __syncthreads();
        } else {
            const int ci = it - 1024, kh = ci & 1, g = (ci >> 1) & 3, b = ci >> 3;
            f32x4 acc[1][8]; zero_acc<1>(acc); const int i0[1] = {128 * kh + 16 * w};
            for (int c = 0; c < 2; ++c) {
                bf16x8 apx[1][8]; lm_load_a<1, 8>(FX, 512, i0, c * 256, apx, lane);
                stage_rows(PZ + ((size_t)ML + b * TCX) * NEIN + c * 512 + g * 128, NEIN, 256, X, 0, F.tid);
                __syncthreads();
                lm_core<1, 8>(apx, X, acc, lane);
                __syncthreads();
            }
            const int k = 128 * kh + 16 * w + i16; bf16_t* orow = Y + ((size_t)ML + b * TCX + k) * D + g * 128; const float nrm = 0.005524271728019903f;
#pragma unroll
            for (int nt = 0; nt < 8; ++nt) { const f32x4 a = acc[0][nt] * nrm; u32x2 o; o.x = pk2(a[0], a[1]); o.y = pk2(a[2], a[3]); *(u32x2*)(orow + 16 * nt + 4 * q) = o; }
        }
        WQ_NEXT(it0, wq, slot, F.G);
    }
}
__device__ __forceinline__ void fft_stage_c_gmlp(const Ctx& F, int j, unsigned* wq) {
    const bf16_t* PZ = (const bf16_t*)(F.ws + WS_PZUV); const bf16_t* UP = (const bf16_t*)(F.ws + WS_UP); bf16_t* Y = (bf16_t*)(F.ws + WS_H);
    const bf16_t* FC = (const bf16_t*)(F.ws + WS_FC); const bf16_t* GW = (const bf16_t*)(F.ws + WS_GW) + (size_t)j * 4 * 128 * 128;
    const float* gb = FIN(I_GB) + j * 512;
    LAS unsigned char* X = F.lds; const int lane = F.lane, w = F.wave, i16 = lane & 15, q = lane >> 4, tid = F.tid;
    volatile LAS unsigned* slot = (volatile LAS unsigned*)(F.lds + MISC_OFF + 64);
    bf16x8 apC[1][8]; { const int i0[1] = {16 * w}; lm_load_a<1, 8>(FC, 256, i0, 0, apC, lane); }
    for (int it = F.bid; it < 1024 + 1040; ) {
        if (it < 1024) {
            const int k1 = it & 127, g = (it >> 7) & 3, b = it >> 9;
            const bf16_t* src = UP + (size_t)((b * 4 + g) * 128 + k1) * 128 * 256;
            stage_rows(src, 256, 128, X, 0, tid);
            stage_rows(src + 128, 256, 128, X, 128, tid);
            __syncthreads();
            f32x4 acc[1][8]; zero_acc<1>(acc);
            lm_core<1, 8>(apC, X, acc, lane);
            const int k2 = 16 * w + i16; bf16_t* orow = Y + ((size_t)b * TL + k1 + 128 * k2) * D + g * 128; const float nrm = 0.0006905339660024878f;
#pragma unroll
            for (int nt = 0; nt < 8; ++nt) { const f32x4 a = acc[0][nt] * nrm; u32x2 o; o.x = pk2(a[0], a[1]); o.y = pk2(a[2], a[3]); *(u32x2*)(orow + 16 * nt + 4 * q) = o; }
            __syncthreads();
        } else {
            const int gi = it - 1024, h = gi & 3, ck = gi >> 2; const size_t r0 = (size_t)ck * 128;
            bf16x8 apg[1][4]; { const int i0[1] = {16 * w}; lm_load_a<1, 4>(GW + (size_t)h * 128 * 128, 128, i0, 0, apg, lane); }
            u32x4 raw4[4];
#pragma unroll
            for (int i4 = 0; i4 < 4; ++i4) { const int i = tid + 512 * i4, r = i >> 4, ch = i & 15; raw4[i4] = *(const u32x4*)(PZ + (r0 + r) * NEIN + 1536 + h * 128 + ch * 8); }
            __builtin_amdgcn_sched_barrier(0);
#pragma unroll
            for (int i4 = 0; i4 < 4; ++i4) { const int i = tid + 512 * i4, r = i >> 4, ch = i & 15; const u32x4 raw = raw4[i4];
                float x[8] = {bflo(raw.x), bfhi(raw.x), bflo(raw.y), bfhi(raw.y), bflo(raw.z), bfhi(raw.z), bflo(raw.w), bfhi(raw.w)};
                float s = 0.f;
#pragma unroll
                for (int e = 0; e < 8; ++e) s += x[e];
                s += shfl_x(s, 1, lane); s += shfl_x(s, 2, lane); s += shfl_x(s, 4, lane); s += shfl_x(s, 8, lane);
                const float mean = s * (1.0f / 128.0f); float qq = 0.f;
#pragma unroll
                for (int e = 0; e < 8; ++e) { x[e] -= mean; qq += x[e] * x[e]; }
                qq += shfl_x(qq, 1, lane); qq += shfl_x(qq, 2, lane); qq += shfl_x(qq, 4, lane); qq += shfl_x(qq, 8, lane);
                const float rs = rsqrtf(qq * (1.0f / 128.0f) + EPS);
                u32x4 o; o.x = pk2(x[0] * rs, x[1] * rs); o.y = pk2(x[2] * rs, x[3] * rs); o.z = pk2(x[4] * rs, x[5] * rs); o.w = pk2(x[6] * rs, x[7] * rs);
                *(LAS u32x4*)(X + r * XRS + ch * 16) = o; }
            const int t = 16 * w + i16; const float bias = gb[h * 128 + t];
            const bf16_t* urow = PZ + (r0 + t) * NEIN + 1024 + h * 128; bf16_t* orow = Y + (r0 + t) * D + 512 + h * 128;
            u32x2 uu8[8];
#pragma unroll
            for (int nt = 0; nt < 8; ++nt) uu8[nt] = *(const u32x2*)(urow + 16 * nt + 4 * q);
            __syncthreads();
            f32x4 acc[1][8]; zero_acc<1>(acc);
            lm_core<1, 4>(apg, X, acc, lane);
            __builtin_amdgcn_sched_barrier(0);
#pragma unroll
            for (int nt = 0; nt < 8; ++nt) { const int n = 16 * nt + 4 * q; const u32x2 uu = uu8[nt]; const f32x4 a = acc[0][nt];
                u32x2 o; o.x = pk2(bflo(uu.x) * (a[0] + bias), bfhi(uu.x) * (a[1] + bias)); o.y = pk2(bflo(uu.y) * (a[2] + bias), bfhi(uu.y) * (a[3] + bias)); *(u32x2*)(orow + n) = o; }
            __syncthreads();
        }
        WQ_NEXT(it, wq, slot, F.G);
    }
}

constexpr int S2_KT = 0, S2_QT = 36864, S2_V = 73728, S2_SC = 110592, S2_EB = 120832, S2_EBL = 122880, S2_RED = 124928, S2_END = 129024;
static_assert(S2_END <= MISC_OFF, "scan LDS");
constexpr int SCRS = 80;
template <bool NEEDQ>
__device__ __forceinline__ void half_prep(const Ctx& F, const bf16_t* P5, size_t hrow, bool rev, int h, int dir) {
    const int tid = F.tid, ck = F.wave >> 1, dk = ((F.wave & 1) << 6) + F.lane; LAS unsigned char* L = F.lds;
#pragma unroll
    for (int it = 0; it < 4; ++it) { const int idx = tid + 512 * it, p = idx >> 4, ch = idx & 15; const size_t r = hrow + (rev ? 127 - p : p); const bf16_t* rp = P5 + ((size_t)h * MT + r) * 640 + ch * 8;
        *(LAS u32x4*)(L + S2_KT + p * XRS + ch * 16) = *(const u32x4*)(rp + (2 + dir) * 128);
        if (NEEDQ) *(LAS u32x4*)(L + S2_QT + p * XRS + ch * 16) = *(const u32x4*)(rp);
        *(LAS u32x4*)(L + S2_V + p * XRS + ch * 16) = *(const u32x4*)(rp + 4 * 128); }
    __syncthreads();
    float b = 0.f; LAS unsigned char* kt = L + S2_KT + (32 * ck) * XRS + dk * 2; LAS unsigned char* qt = L + S2_QT + (32 * ck) * XRS + dk * 2;
    bf16_t lfr[32], qr[32];
#pragma unroll
    for (int i = 0; i < 32; ++i) { lfr[i] = *(const LAS bf16_t*)(kt + i * XRS); if (NEEDQ) qr[i] = *(const LAS bf16_t*)(qt + i * XRS); }
    __builtin_amdgcn_sched_barrier(0);
#pragma unroll
    for (int i = 0; i < 32; ++i) { const float lf = bf2f(lfr[i]); b += lf;
        const float kk = (1.0f - __expf(lf)) * __expf(fminf(-b, 80.0f));
        *(LAS bf16_t*)(kt + i * XRS) = (bf16_t)f2bf(kk);
        if (NEEDQ) *(LAS bf16_t*)(qt + i * XRS) = (bf16_t)f2bf(bf2f(qr[i]) * __expf(b)); }
    ((LAS float*)(L + S2_EB))[ck * 128 + dk] = __expf(b);
    ((LAS float*)(L + S2_EBL))[ck * 128 + dk] = b;
}
__device__ __forceinline__ void prep1_issue(const Ctx& F, const bf16_t* P5, size_t hrow, bool rev, int h, int dir, u32x4 (&pf)[8]) {
    const int tid = F.tid;
#pragma unroll
    for (int it = 0; it < 4; ++it) { const int idx = tid + 512 * it, p = idx >> 4, ch = idx & 15; const size_t r = hrow + (rev ? 127 - p : p); const bf16_t* rp = P5 + ((size_t)h * MT + r) * 640 + ch * 8;
        pf[2 * it] = *(const u32x4*)(rp + (2 + dir) * 128); pf[2 * it + 1] = *(const u32x4*)(rp + 4 * 128); }
}
__device__ __forceinline__ void prep1_commit(const Ctx& F, const u32x4 (&pf)[8]) {
    const int tid = F.tid, ck = F.wave >> 1, dk = ((F.wave & 1) << 6) + F.lane; LAS unsigned char* L = F.lds;
#pragma unroll
    for (int it = 0; it < 4; ++it) { const int idx = tid + 512 * it, p = idx >> 4, ch = idx & 15;
        *(LAS u32x4*)(L + S2_KT + p * XRS + ch * 16) = pf[2 * it]; *(LAS u32x4*)(L + S2_V + p * XRS + ch * 16) = pf[2 * it + 1]; }
    __syncthreads();
    float b = 0.f; LAS unsigned char* kt = L + S2_KT + (32 * ck) * XRS + dk * 2;
    bf16_t lfr[32];
#pragma unroll
    for (int i = 0; i < 32; ++i) lfr[i] = *(const LAS bf16_t*)(kt + i * XRS);
    __builtin_amdgcn_sched_barrier(0);
#pragma unroll
    for (int i = 0; i < 32; ++i) { const float lf = bf2f(lfr[i]); b += lf; *(LAS bf16_t*)(kt + i * XRS) = (bf16_t)f2bf((1.0f - __expf(lf)) * __expf(fminf(-b, 80.0f))); }
    ((LAS float*)(L + S2_EB))[ck * 128 + dk] = __expf(b);
    ((LAS float*)(L + S2_EBL))[ck * 128 + dk] = b;
}
__device__ __forceinline__ void state_update(const Ctx& F, f32x4 (&st)[8], int ck) {
    LAS unsigned char* L = F.lds; const int lane = F.lane, i16 = lane & 15, q = lane >> 4, w = F.wave;
    const int roff = (32 * ck + 8 * q + (i16 >> 2)) * XRS + 8 * (i16 & 3);
    s16x4 vlo = __builtin_amdgcn_ds_read_tr16_b64_v4i16((LAS s16x4*)(L + S2_V + roff + w * 32));
    s16x4 vhi = __builtin_amdgcn_ds_read_tr16_b64_v4i16((LAS s16x4*)(L + S2_V + roff + w * 32 + 4 * XRS));
    const bf16x8 vf = __builtin_shufflevector(vlo, vhi, 0, 1, 2, 3, 4, 5, 6, 7);
#pragma unroll
    for (int hb = 0; hb < 2; ++hb) {
        s16x4 klo[4], khi[4]; f32x4 eb[4];
#pragma unroll
        for (int k4 = 0; k4 < 4; ++k4) { const int kb = 4 * hb + k4;
            klo[k4] = __builtin_amdgcn_ds_read_tr16_b64_v4i16((LAS s16x4*)(L + S2_KT + roff + kb * 32));
            khi[k4] = __builtin_amdgcn_ds_read_tr16_b64_v4i16((LAS s16x4*)(L + S2_KT + roff + kb * 32 + 4 * XRS)); }
#pragma unroll
        for (int k4 = 0; k4 < 4; ++k4) eb[k4] = *(const LAS f32x4*)(L + S2_EB + (ck * 128 + 16 * (4 * hb + k4) + 4 * q) * 4);
        __builtin_amdgcn_sched_barrier(0);
#pragma unroll
        for (int k4 = 0; k4 < 4; ++k4) st[4 * hb + k4] = __builtin_amdgcn_mfma_f32_16x16x32_bf16(__builtin_shufflevector(klo[k4], khi[k4], 0, 1, 2, 3, 4, 5, 6, 7), vf, st[4 * hb + k4], 0, 0, 0);
#pragma unroll
        for (int k4 = 0; k4 < 4; ++k4) st[4 * hb + k4] = st[4 * hb + k4] * eb[k4];
        __builtin_amdgcn_sched_barrier(0);
    }
}
__device__ __forceinline__ void state_load(const float* src, f32x4 (&st)[8], int w, int lane) {
    const float* p0 = src + w * 2048 + lane; const float* p1 = p0 + 1024;
#pragma unroll
    for (int kb = 0; kb < 8; ++kb)
#pragma unroll
        for (int rg = 0; rg < 4; ++rg) st[kb][rg] = src ? (kb < 4 ? p0[(kb * 4 + rg) * 64] : p1[((kb - 4) * 4 + rg) * 64]) : 0.f;
}
__device__ __forceinline__ void state_store(float* dst, const f32x4 (&st)[8], int w, int lane) {
    float* p0 = dst + w * 2048 + lane; float* p1 = p0 + 1024;
#pragma unroll
    for (int kb = 0; kb < 8; ++kb)
#pragma unroll
        for (int rg = 0; rg < 4; ++rg) { if (kb < 4) p0[(kb * 4 + rg) * 64] = st[kb][rg]; else p1[((kb - 4) * 4 + rg) * 64] = st[kb][rg]; }
}
__device__ __forceinline__ void scan_pass1_item(const Ctx& F, const bf16_t* P5, int b, int h, int dir, int seg, float* SST, float* EG) {
    const int chain = (b * 8 + h) * 2 + dir; const size_t rowb = (size_t)b * TL + (size_t)seg * SEGL;
    f32x4 st[8]; state_load(nullptr, st, F.wave, F.lane);
    float gacc = 0.f;
    u32x4 pf[8];
    prep1_issue(F, P5, rowb + 128 * (dir ? 1 : 0), dir != 0, h, dir, pf);
    for (int hs = 0; hs < 2; ++hs) {
        prep1_commit(F, pf);
        __syncthreads();
        if (hs == 0) prep1_issue(F, P5, rowb + 128 * (dir ? 0 : 1), dir != 0, h, dir, pf);
        if (F.tid < 128) { const LAS float* ebl = (const LAS float*)(F.lds + S2_EBL); gacc += (ebl[F.tid] + ebl[128 + F.tid]) + (ebl[256 + F.tid] + ebl[384 + F.tid]); }
#pragma unroll 1
        for (int ck = 0; ck < 4; ++ck) { state_update(F, st, ck); __builtin_amdgcn_sched_barrier(0); }
        __syncthreads();
    }
    state_store(SST + ((size_t)chain * NSEG + seg) * 16384, st, F.wave, F.lane);
    if (F.tid < 128) EG[((size_t)chain * NSEG + seg) * 128 + F.tid] = __expf(gacc);
}
__device__ __forceinline__ void half_scores(const Ctx& F) {
    LAS unsigned char* L = F.lds; const int lane = F.lane, i16 = lane & 15, q = lane >> 4, w = F.wave, ck = w >> 1, u = w & 1;
#pragma unroll
    for (int tt = 0; tt < 2; ++tt) {
        const int ti = u == 0 ? tt : 1 - tt, si = u == 0 ? tt : tt;
        f32x4 sc = (f32x4){0.f, 0.f, 0.f, 0.f};
        if (si <= ti) {
#pragma unroll
            for (int ks = 0; ks < 4; ++ks) { const bf16x8 a = *(const LAS bf16x8*)(L + S2_QT + (32 * ck + 16 * ti + i16) * XRS + (32 * ks + 8 * q) * 2); const bf16x8 bb = *(const LAS bf16x8*)(L + S2_KT + (32 * ck + 16 * si + i16) * XRS + (32 * ks + 8 * q) * 2);
                sc = __builtin_amdgcn_mfma_f32_16x16x32_bf16(a, bb, sc, 0, 0, 0); }
        }
#pragma unroll
        for (int rg = 0; rg < 4; ++rg) { const int t = 16 * ti + 4 * q + rg, sidx = 16 * si + i16; *(LAS bf16_t*)(L + S2_SC + (32 * ck + t) * SCRS + sidx * 2) = (bf16_t)f2bf(sidx <= t ? sc[rg] : 0.f); }
    }
}
__device__ __forceinline__ void chunk_out(const Ctx& F, const f32x4 (&st)[8], int ck, f32x4 (&o)[2]) {
    LAS unsigned char* L = F.lds; const int lane = F.lane, i16 = lane & 15, q = lane >> 4, w = F.wave;
    const int roff = (32 * ck + 8 * q + (i16 >> 2)) * XRS + 8 * (i16 & 3);
    o[0] = (f32x4){0.f, 0.f, 0.f, 0.f}; o[1] = (f32x4){0.f, 0.f, 0.f, 0.f};
    s16x4 vlo = __builtin_amdgcn_ds_read_tr16_b64_v4i16((LAS s16x4*)(L + S2_V + roff + w * 32));
    s16x4 vhi = __builtin_amdgcn_ds_read_tr16_b64_v4i16((LAS s16x4*)(L + S2_V + roff + w * 32 + 4 * XRS));
    bf16x8 pf[2];
#pragma unroll
    for (int ti = 0; ti < 2; ++ti) pf[ti] = *(const LAS bf16x8*)(L + S2_SC + (32 * ck + 16 * ti + i16) * SCRS + (8 * q) * 2);
#pragma unroll
    for (int kh = 0; kh < 2; ++kh) {
        u32x2 qlo[2][2], qhi[2][2]; bf16x8 sf[2];
#pragma unroll
        for (int k2 = 0; k2 < 2; ++k2) { const int ks = 2 * kh + k2;
#pragma unroll
            for (int ti = 0; ti < 2; ++ti) { const LAS unsigned char* qrow = L + S2_QT + (32 * ck + 16 * ti + i16) * XRS + (32 * ks + 4 * q) * 2; qlo[k2][ti] = *(const LAS u32x2*)(qrow); qhi[k2][ti] = *(const LAS u32x2*)(qrow + 32); }
            u32x4 sp; sp.x = pk2(st[2 * ks][0], st[2 * ks][1]); sp.y = pk2(st[2 * ks][2], st[2 * ks][3]); sp.z = pk2(st[2 * ks + 1][0], st[2 * ks + 1][1]); sp.w = pk2(st[2 * ks + 1][2], st[2 * ks + 1][3]); sf[k2] = __builtin_bit_cast(bf16x8, sp); }
        __builtin_amdgcn_sched_barrier(0);
#pragma unroll
        for (int k2 = 0; k2 < 2; ++k2)
#pragma unroll
            for (int ti = 0; ti < 2; ++ti) { u32x4 qp; qp.x = qlo[k2][ti].x; qp.y = qlo[k2][ti].y; qp.z = qhi[k2][ti].x; qp.w = qhi[k2][ti].y;
                o[ti] = __builtin_amdgcn_mfma_f32_16x16x32_bf16(sf[k2], __builtin_bit_cast(bf16x8, qp), o[ti], 0, 0, 0); }
        __builtin_amdgcn_sched_barrier(0);
    }
    const bf16x8 vf = __builtin_shufflevector(vlo, vhi, 0, 1, 2, 3, 4, 5, 6, 7);
#pragma unroll
    for (int ti = 0; ti < 2; ++ti) o[ti] = __builtin_amdgcn_mfma_f32_16x16x32_bf16(vf, pf[ti], o[ti], 0, 0, 0);
}
__device__ __forceinline__ void rows_g2l(const bf16_t* g, size_t row0, int rstep, int c0, LAS unsigned char* T, int tid) {
#pragma unroll
    for (int it = 0; it < 4; ++it) { const int idx = tid + 512 * it, p = idx >> 4, ch = idx & 15; *(LAS u32x4*)(T + p * XRS + ch * 16) = *(const u32x4*)(g + (size_t)((long)row0 + (long)rstep * p) * D + c0 + ch * 8); }
}
__device__ __forceinline__ void rows_l2g(bf16_t* g, size_t row0, int rstep, int c0, const LAS unsigned char* T, int tid) {
#pragma unroll
    for (int it = 0; it < 4; ++it) { const int idx = tid + 512 * it, p = idx >> 4, ch = idx & 15; *(u32x4*)(g + (size_t)((long)row0 + (long)rstep * p) * D + c0 + ch * 8) = *(const LAS u32x4*)(T + p * XRS + ch * 16); }
}
__device__ __forceinline__ void scan_pass3_item(const Ctx& F, const bf16_t* P5, size_t rowb, int h, const float* sin_f, const float* sin_b, float* fin_f, float* fin_b, const float* gain, bf16_t* OFT, bf16_t* Y, bool writey) {
    LAS unsigned char* L = F.lds; int lane = F.lane; asm volatile("" : "+v"(lane));
    const int i16 = lane & 15, q = lane >> 4, w = F.wave;
    const int colo = h * 128 + 16 * w + 4 * q;
    f32x4 st[8];
    state_load(sin_f, st, w, lane);
    for (int hs = 0; hs < 2; ++hs) {
        const size_t hrow = rowb + 128 * hs;
        half_prep<true>(F, P5, hrow, false, h, 0);
        __syncthreads();
        half_scores(F);
        __syncthreads();
        u32x2 of[4][2];
#pragma unroll
        for (int ck = 0; ck < 4; ++ck) { f32x4 o[2]; chunk_out(F, st, ck, o);
#pragma unroll
            for (int ti = 0; ti < 2; ++ti) { of[ck][ti].x = pk2(o[ti][0], o[ti][1]); of[ck][ti].y = pk2(o[ti][2], o[ti][3]); }
            __builtin_amdgcn_sched_barrier(0);
            state_update(F, st, ck);
            __builtin_amdgcn_sched_barrier(0); }
        __syncthreads();
#pragma unroll
        for (int ck = 0; ck < 4; ++ck)
#pragma unroll
            for (int ti = 0; ti < 2; ++ti) *(LAS u32x2*)(L + S2_QT + (32 * ck + 16 * ti + i16) * XRS + (16 * w + 4 * q) * 2) = of[ck][ti];
        __syncthreads();
        rows_l2g(OFT, hrow, 1, h * 128, L + S2_QT, F.tid);
        __syncthreads();
    }
    if (fin_f) state_store(fin_f, st, w, lane);
    state_load(sin_b, st, w, lane);
    const f32x4 gv = *(const f32x4*)(gain + colo);
    for (int hs = 0; hs < 2; ++hs) {
        const size_t hrow = rowb + 128 * (1 - hs);
        half_prep<true>(F, P5, hrow, true, h, 1);
        __syncthreads();
        half_scores(F);
        __syncthreads();
        LAS float* RED = (LAS float*)(L + S2_RED);
        f32x4 oa[4][2];
#pragma unroll
        for (int ck = 0; ck < 4; ++ck) { chunk_out(F, st, ck, oa[ck]);
            __builtin_amdgcn_sched_barrier(0);
            state_update(F, st, ck);
            __builtin_amdgcn_sched_barrier(0); }
        __syncthreads();
        rows_g2l(OFT, hrow + 127, -1, h * 128, L + S2_QT, F.tid);
        if (writey) {
#pragma unroll
            for (int it = 0; it < 4; ++it) { const int idx = F.tid + 512 * it, p = idx >> 4, ch = idx & 15; *(LAS u32x4*)(L + S2_KT + p * XRS + ch * 16) = *(const u32x4*)(P5 + ((size_t)h * MT + (hrow + 127 - p)) * 640 + 128 + ch * 8); } }
        __syncthreads();
#pragma unroll
        for (int ck = 0; ck < 4; ++ck)
#pragma unroll
            for (int ti = 0; ti < 2; ++ti) { const int p = 32 * ck + 16 * ti + i16; const u32x2 f = *(const LAS u32x2*)(L + S2_QT + p * XRS + (16 * w + 4 * q) * 2);
                oa[ck][ti][0] += bflo(f.x); oa[ck][ti][1] += bfhi(f.x); oa[ck][ti][2] += bflo(f.y); oa[ck][ti][3] += bfhi(f.y);
                float ss = (oa[ck][ti][0] * oa[ck][ti][0] + oa[ck][ti][1] * oa[ck][ti][1]) + (oa[ck][ti][2] * oa[ck][ti][2] + oa[ck][ti][3] * oa[ck][ti][3]);
                ss += shfl_x(ss, 16, lane); ss += shfl_x(ss, 32, lane);
                if (q == 0) RED[w * 128 + p] = ss; __builtin_amdgcn_sched_barrier(0); }
        __syncthreads();
        if (writey) {
#pragma unroll
            for (int ck = 0; ck < 4; ++ck)
#pragma unroll
                for (int ti = 0; ti < 2; ++ti) { __builtin_amdgcn_sched_barrier(0); const int p = 32 * ck + 16 * ti + i16; float tot = 0.f;
#pragma unroll
                    for (int ww = 0; ww < 8; ++ww) tot += RED[ww * 128 + p];
                    const float rs = rsqrtf(tot * (1.0f / 128.0f) + EPS);
                    const u32x2 sg = *(const LAS u32x2*)(L + S2_KT + p * XRS + (16 * w + 4 * q) * 2);
                    u32x2 y; y.x = pk2(oa[ck][ti][0] * rs * gv[0] * bflo(sg.x), oa[ck][ti][1] * rs * gv[1] * bfhi(sg.x)); y.y = pk2(oa[ck][ti][2] * rs * gv[2] * bflo(sg.y), oa[ck][ti][3] * rs * gv[3] * bfhi(sg.y));
                    *(LAS u32x2*)(L + S2_V + p * XRS + (16 * w + 4 * q) * 2) = y; }
            __syncthreads();
            rows_l2g(Y, hrow + 127, -1, h * 128, L + S2_V, F.tid);
        }
        __syncthreads();
    }
    if (fin_b) state_store(fin_b, st, w, lane);
}
constexpr int G2_KT = 0, G2_QT = 18432, G2_V = 36864, G2_SC = 55296, G2_EB = 60416, G2_EBL = 61440, G2_RED = 62464, G2_SLOT = 63488, G2_BYTES = 65536;
static_assert(2 * G2_BYTES <= MISC_OFF, "two-group scan LDS");
struct GC { LAS unsigned char* L; int tid, lane, wg; LAS unsigned* bar; unsigned epoch; };
__device__ __forceinline__ void gsync(GC& G) {
    asm volatile("s_waitcnt vmcnt(0) lgkmcnt(0)" ::: "memory");
    G.epoch += 4u;
    if (G.lane == 0) (void)__hip_atomic_fetch_add(G.bar, 1u, __ATOMIC_RELAXED, __HIP_MEMORY_SCOPE_WORKGROUP);
    while (__hip_atomic_load(G.bar, __ATOMIC_RELAXED, __HIP_MEMORY_SCOPE_WORKGROUP) < G.epoch) { }
    asm volatile("" ::: "memory");
}
__device__ __forceinline__ void gsync_l(GC& G) {
    asm volatile("s_waitcnt lgkmcnt(0)" ::: "memory");
    G.epoch += 4u;
    if (G.lane == 0) (void)__hip_atomic_fetch_add(G.bar, 1u, __ATOMIC_RELAXED, __HIP_MEMORY_SCOPE_WORKGROUP);
    while (__hip_atomic_load(G.bar, __ATOMIC_RELAXED, __HIP_MEMORY_SCOPE_WORKGROUP) < G.epoch) { }
    asm volatile("" ::: "memory");
}
__device__ __forceinline__ void quarter_load1(const GC& G, const bf16_t* P5, size_t hrow, bool rev, int h, int dir, u32x4 (&rk)[4], u32x4 (&rv)[4]) {
#pragma unroll
    for (int it = 0; it < 4; ++it) { const int idx = G.tid + 256 * it, p = idx >> 4, ch = idx & 15; const size_t r = hrow + (rev ? 63 - p : p); const bf16_t* rp = P5 + ((size_t)h * MT + r) * 640 + ch * 8;
        rk[it] = *(const u32x4*)(rp + (2 + dir) * 128); rv[it] = *(const u32x4*)(rp + 4 * 128); }
}
__device__ __forceinline__ void quarter_prep1(GC& G, const u32x4 (&rk)[4], const u32x4 (&rv)[4]) {
    const int tid = G.tid, ck = G.wg >> 1, dk = ((G.wg & 1) << 6) + G.lane; LAS unsigned char* L = G.L;
#pragma unroll
    for (int it = 0; it < 4; ++it) { const int idx = tid + 256 * it, p = idx >> 4, ch = idx & 15;
        *(LAS u32x4*)(L + G2_KT + p * XRS + ch * 16) = rk[it]; *(LAS u32x4*)(L + G2_V + p * XRS + ch * 16) = rv[it]; }
}
__device__ __forceinline__ void quarter_cols1(GC& G) {
    const int ck = G.wg >> 1, dk = ((G.wg & 1) << 6) + G.lane; LAS unsigned char* L = G.L;
    float b = 0.f; LAS unsigned char* kt = L + G2_KT + (32 * ck) * XRS + dk * 2;
    bf16_t lfr[32];
#pragma unroll
    for (int i = 0; i < 32; ++i) lfr[i] = *(const LAS bf16_t*)(kt + i * XRS);
    __builtin_amdgcn_sched_barrier(0);
#pragma unroll
    for (int i = 0; i < 32; ++i) { const float lf = bf2f(lfr[i]); b += lf;
        *(LAS bf16_t*)(kt + i * XRS) = (bf16_t)f2bf((1.0f - __expf(lf)) * __expf(fminf(-b, 80.0f))); }
    ((LAS float*)(L + G2_EB))[ck * 128 + dk] = __expf(b);
    ((LAS float*)(L + G2_EBL))[ck * 128 + dk] = b;
}
template <bool NEEDQ>
__device__ __forceinline__ void quarter_prep(GC& G, const bf16_t* P5, size_t hrow, bool rev, int h, int dir) {
    const int tid = G.tid, ck = G.wg >> 1, dk = ((G.wg & 1) << 6) + G.lane; LAS unsigned char* L = G.L;
    {
        u32x4 rk_[4], rq_[4], rv_[4];
#pragma unroll
        for (int it = 0; it < 4; ++it) { const int idx = tid + 256 * it, p = idx >> 4, ch = idx & 15; const size_t r = hrow + (rev ? 63 - p : p); const bf16_t* rp = P5 + ((size_t)h * MT + r) * 640 + ch * 8;
            rk_[it] = *(const u32x4*)(rp + (2 + dir) * 128); if (NEEDQ) rq_[it] = *(const u32x4*)(rp); rv_[it] = *(const u32x4*)(rp + 4 * 128); }
        __builtin_amdgcn_sched_barrier(0);
#pragma unroll
        for (int it = 0; it < 4; ++it) { const int idx = tid + 256 * it, p = idx >> 4, ch = idx & 15;
            *(LAS u32x4*)(L + G2_KT + p * XRS + ch * 16) = rk_[it]; if (NEEDQ) *(LAS u32x4*)(L + G2_QT + p * XRS + ch * 16) = rq_[it]; *(LAS u32x4*)(L + G2_V + p * XRS + ch * 16) = rv_[it]; }
    }
    gsync(G);
    float b = 0.f; LAS unsigned char* kt = L + G2_KT + (32 * ck) * XRS + dk * 2; LAS unsigned char* qt = L + G2_QT + (32 * ck) * XRS + dk * 2;
    bf16_t lfr[32], qr[32];
#pragma unroll
    for (int i = 0; i < 32; ++i) { lfr[i] = *(const LAS bf16_t*)(kt + i * XRS); if (NEEDQ) qr[i] = *(const LAS bf16_t*)(qt + i * XRS); }
    __builtin_amdgcn_sched_barrier(0);
    float E = 1.0f;
#pragma unroll
    for (int i = 0; i < 32; ++i) { const float lf = bf2f(lfr[i]); b += lf; const float fi = __expf(lf); E *= fi;
        *(LAS bf16_t*)(kt + i * XRS) = (bf16_t)f2bf((1.0f - fi) * fminf(__builtin_amdgcn_rcpf(E), 5.5406224e34f));
        if (NEEDQ) *(LAS bf16_t*)(qt + i * XRS) = (bf16_t)f2bf(bf2f(qr[i]) * E); }
    ((LAS float*)(L + G2_EB))[ck * 128 + dk] = E;
    ((LAS float*)(L + G2_EBL))[ck * 128 + dk] = b;
}
__device__ __forceinline__ void state_update_g(const GC& G, f32x4 (&st)[2][8], int ck) {
    LAS unsigned char* L = G.L; const int lane = G.lane, i16 = lane & 15, q = lane >> 4, wg = G.wg;
    const int roff = (32 * ck + 8 * q + (i16 >> 2)) * XRS + 8 * (i16 & 3);
    bf16x8 vf[2];
#pragma unroll
    for (int ct = 0; ct < 2; ++ct) { const s16x4 vlo = __builtin_amdgcn_ds_read_tr16_b64_v4i16((LAS s16x4*)(L + G2_V + roff + (2 * wg + ct) * 32));
        const s16x4 vhi = __builtin_amdgcn_ds_read_tr16_b64_v4i16((LAS s16x4*)(L + G2_V + roff + (2 * wg + ct) * 32 + 4 * XRS)); vf[ct] = __builtin_shufflevector(vlo, vhi, 0, 1, 2, 3, 4, 5, 6, 7); }
#pragma unroll
    for (int hb = 0; hb < 2; ++hb) {
        s16x4 klo[4], khi[4]; f32x4 eb[4];
#pragma unroll
        for (int k4 = 0; k4 < 4; ++k4) { const int kb = 4 * hb + k4;
            klo[k4] = __builtin_amdgcn_ds_read_tr16_b64_v4i16((LAS s16x4*)(L + G2_KT + roff + kb * 32));
            khi[k4] = __builtin_amdgcn_ds_read_tr16_b64_v4i16((LAS s16x4*)(L + G2_KT + roff + kb * 32 + 4 * XRS)); }
#pragma unroll
        for (int k4 = 0; k4 < 4; ++k4) eb[k4] = *(const LAS f32x4*)(L + G2_EB + (ck * 128 + 16 * (4 * hb + k4) + 4 * q) * 4);
        __builtin_amdgcn_sched_barrier(0);
#pragma unroll
        for (int k4 = 0; k4 < 4; ++k4) { const bf16x8 kf = __builtin_shufflevector(klo[k4], khi[k4], 0, 1, 2, 3, 4, 5, 6, 7);
#pragma unroll
            for (int ct = 0; ct < 2; ++ct) st[ct][4 * hb + k4] = __builtin_amdgcn_mfma_f32_16x16x32_bf16(kf, vf[ct], st[ct][4 * hb + k4], 0, 0, 0); }
#pragma unroll
        for (int k4 = 0; k4 < 4; ++k4)
#pragma unroll
            for (int ct = 0; ct < 2; ++ct) st[ct][4 * hb + k4] = st[ct][4 * hb + k4] * eb[k4];
        __builtin_amdgcn_sched_barrier(0);
    }
}
__device__ __forceinline__ void state_load_g(const float* src, f32x4 (&st)[2][8], int wg, int lane) {
#pragma unroll
    for (int ct = 0; ct < 2; ++ct) { const float* p0 = src + (2 * wg + ct) * 2048 + lane; const float* p1 = p0 + 1024;
#pragma unroll
        for (int kb = 0; kb < 8; ++kb)
#pragma unroll
            for (int rg = 0; rg < 4; ++rg) st[ct][kb][rg] = src ? (kb < 4 ? p0[(kb * 4 + rg) * 64] : p1[((kb - 4) * 4 + rg) * 64]) : 0.f; }
}
__device__ __forceinline__ void state_store_g(float* dst, const f32x4 (&st)[2][8], int wg, int lane) {
#pragma unroll
    for (int ct = 0; ct < 2; ++ct) { float* p0 = dst + (2 * wg + ct) * 2048 + lane; float* p1 = p0 + 1024;
#pragma unroll
        for (int kb = 0; kb < 8; ++kb)
#pragma unroll
            for (int rg = 0; rg < 4; ++rg) { if (kb < 4) p0[(kb * 4 + rg) * 64] = st[ct][kb][rg]; else p1[((kb - 4) * 4 + rg) * 64] = st[ct][kb][rg]; } }
}
__device__ __forceinline__ void quarter_scores(const GC& G) {
    LAS unsigned char* L = G.L; const int lane = G.lane, i16 = lane & 15, q = lane >> 4, ck = G.wg >> 1, u = G.wg & 1;
#pragma unroll
    for (int tt = 0; tt < 2; ++tt) {
        const int ti = u == 0 ? tt : 1 - tt, si = tt;
        f32x4 sc = (f32x4){0.f, 0.f, 0.f, 0.f};
        if (si <= ti) {
#pragma unroll
            for (int ks = 0; ks < 4; ++ks) { const bf16x8 a = *(const LAS bf16x8*)(L + G2_QT + (32 * ck + 16 * ti + i16) * XRS + (32 * ks + 8 * q) * 2); const bf16x8 bb = *(const LAS bf16x8*)(L + G2_KT + (32 * ck + 16 * si + i16) * XRS + (32 * ks + 8 * q) * 2);
                sc = __builtin_amdgcn_mfma_f32_16x16x32_bf16(a, bb, sc, 0, 0, 0); }
        }
#pragma unroll
        for (int rg = 0; rg < 4; ++rg) { const int t = 16 * ti + 4 * q + rg, sidx = 16 * si + i16; *(LAS bf16_t*)(L + G2_SC + (32 * ck + t) * SCRS + sidx * 2) = (bf16_t)f2bf(sidx <= t ? sc[rg] : 0.f); }
    }
}
__device__ __forceinline__ void chunk_out_g(const GC& G, const f32x4 (&st)[2][8], int ck, f32x4 (&o)[2][2]) {
    LAS unsigned char* L = G.L; const int lane = G.lane, i16 = lane & 15, q = lane >> 4, wg = G.wg;
    const int roff = (32 * ck + 8 * q + (i16 >> 2)) * XRS + 8 * (i16 & 3);
#pragma unroll
    for (int ct = 0; ct < 2; ++ct) { o[ct][0] = (f32x4){0.f, 0.f, 0.f, 0.f}; o[ct][1] = (f32x4){0.f, 0.f, 0.f, 0.f}; }
    bf16x8 vf[2], pf[2];
#pragma unroll
    for (int ct = 0; ct < 2; ++ct) { const s16x4 vlo = __builtin_amdgcn_ds_read_tr16_b64_v4i16((LAS s16x4*)(L + G2_V + roff + (2 * wg + ct) * 32));
        const s16x4 vhi = __builtin_amdgcn_ds_read_tr16_b64_v4i16((LAS s16x4*)(L + G2_V + roff + (2 * wg + ct) * 32 + 4 * XRS)); vf[ct] = __builtin_shufflevector(vlo, vhi, 0, 1, 2, 3, 4, 5, 6, 7); }
#pragma unroll
    for (int ti = 0; ti < 2; ++ti) pf[ti] = *(const LAS bf16x8*)(L + G2_SC + (32 * ck + 16 * ti + i16) * SCRS + (8 * q) * 2);
#pragma unroll
    for (int kh = 0; kh < 2; ++kh) {
        u32x2 qlo[2][2], qhi[2][2]; bf16x8 sf[2][2];
#pragma unroll
        for (int k2 = 0; k2 < 2; ++k2) { const int ks = 2 * kh + k2;
#pragma unroll
            for (int ti = 0; ti < 2; ++ti) { const LAS unsigned char* qrow = L + G2_QT + (32 * ck + 16 * ti + i16) * XRS + (32 * ks + 4 * q) * 2; qlo[k2][ti] = *(const LAS u32x2*)(qrow); qhi[k2][ti] = *(const LAS u32x2*)(qrow + 32); }
#pragma unroll
            for (int ct = 0; ct < 2; ++ct) { u32x4 sp; sp.x = pk2(st[ct][2 * ks][0], st[ct][2 * ks][1]); sp.y = pk2(st[ct][2 * ks][2], st[ct][2 * ks][3]); sp.z = pk2(st[ct][2 * ks + 1][0], st[ct][2 * ks + 1][1]); sp.w = pk2(st[ct][2 * ks + 1][2], st[ct][2 * ks + 1][3]); sf[k2][ct] = __builtin_bit_cast(bf16x8, sp); } }
        __builtin_amdgcn_sched_barrier(0);
#pragma unroll
        for (int k2 = 0; k2 < 2; ++k2)
#pragma unroll
            for (int ti = 0; ti < 2; ++ti) { u32x4 qp; qp.x = qlo[k2][ti].x; qp.y = qlo[k2][ti].y; qp.z = qhi[k2][ti].x; qp.w = qhi[k2][ti].y;
#pragma unroll
                for (int ct = 0; ct < 2; ++ct) o[ct][ti] = __builtin_amdgcn_mfma_f32_16x16x32_bf16(sf[k2][ct], __builtin_bit_cast(bf16x8, qp), o[ct][ti], 0, 0, 0); }
        __builtin_amdgcn_sched_barrier(0);
    }
#pragma unroll
    for (int ct = 0; ct < 2; ++ct)
#pragma unroll
        for (int ti = 0; ti < 2; ++ti) o[ct][ti] = __builtin_amdgcn_mfma_f32_16x16x32_bf16(vf[ct], pf[ti], o[ct][ti], 0, 0, 0);
}
__device__ __forceinline__ void rows_g2l_g(const bf16_t* g, size_t row0, int rstep, int c0, LAS unsigned char* T, int tid) {
    u32x4 r_[4];
#pragma unroll
    for (int it = 0; it < 4; ++it) { const int idx = tid + 256 * it, p = idx >> 4, ch = idx & 15; r_[it] = *(const u32x4*)(g + (size_t)((long)row0 + (long)rstep * p) * D + c0 + ch * 8); }
    __builtin_amdgcn_sched_barrier(0);
#pragma unroll
    for (int it = 0; it < 4; ++it) { const int idx = tid + 256 * it, p = idx >> 4, ch = idx & 15; *(LAS u32x4*)(T + p * XRS + ch * 16) = r_[it]; }
}
__device__ __forceinline__ void rows_l2g_g(bf16_t* g, size_t row0, int rstep, int c0, const LAS unsigned char* T, int tid) {
#pragma unroll
    for (int it = 0; it < 4; ++it) { const int idx = tid + 256 * it, p = idx >> 4, ch = idx & 15; *(u32x4*)(g + (size_t)((long)row0 + (long)rstep * p) * D + c0 + ch * 8) = *(const LAS u32x4*)(T + p * XRS + ch * 16); }
}
__device__ __forceinline__ void scan_pass1_item_g(GC& G, const bf16_t* P5, int b, int h, int dir, int seg, float* SST, float* EG) {
    const int chain = (b * 8 + h) * 2 + dir; const size_t rowb = (size_t)b * TL + (size_t)seg * SEGL;
    f32x4 st[2][8]; state_load_g(nullptr, st, G.wg, G.lane);
    float gacc = 0.f;
    u32x4 rk[4], rv[4];
    quarter_load1(G, P5, rowb + 64 * (dir ? 3 : 0), dir != 0, h, dir, rk, rv);
    for (int hs = 0; hs < 4; ++hs) {
        asm volatile("s_waitcnt vmcnt(0)" ::: "memory");
        quarter_prep1(G, rk, rv);
        __builtin_amdgcn_sched_barrier(0);
        if (hs < 3) quarter_load1(G, P5, rowb + 64 * (dir ? 2 - hs : hs + 1), dir != 0, h, dir, rk, rv);
        gsync_l(G);
        quarter_cols1(G);
        gsync_l(G);
        if (G.tid < 128) { const LAS float* ebl = (const LAS float*)(G.L + G2_EBL); gacc += ebl[G.tid] + ebl[128 + G.tid]; }
#pragma unroll 1
        for (int ck = 0; ck < 2; ++ck) { state_update_g(G, st, ck); __builtin_amdgcn_sched_barrier(0); }
        gsync_l(G);
    }
    state_store_g(SST + ((size_t)chain * NSEG + seg) * 16384, st, G.wg, G.lane);
    if (G.tid < 128) EG[((size_t)chain * NSEG + seg) * 128 + G.tid] = __expf(gacc);
}
__device__ __forceinline__ void scan_pass3_item_g(GC& G, const bf16_t* P5, size_t rowb, int h, const float* sin_f, const float* sin_b, float* fin_f, float* fin_b, const float* gain, bf16_t* OFT, bf16_t* Y, bool writey) {
    LAS unsigned char* L = G.L; const int lane = G.lane, i16 = lane & 15, q = lane >> 4, wg = G.wg;
    f32x4 st[2][8];
    state_load_g(sin_f, st, wg, lane);
    for (int hs = 0; hs < 4; ++hs) {
        const size_t hrow = rowb + 64 * hs;
        quarter_prep<true>(G, P5, hrow, false, h, 0);
        gsync(G);
        quarter_scores(G);
        gsync(G);
        u32x2 of[2][2][2];
#pragma unroll
        for (int ck = 0; ck < 2; ++ck) { f32x4 o[2][2]; chunk_out_g(G, st, ck, o);
#pragma unroll
            for (int ct = 0; ct < 2; ++ct)
#pragma unroll
                for (int ti = 0; ti < 2; ++ti) { of[ck][ct][ti].x = pk2(o[ct][ti][0], o[ct][ti][1]); of[ck][ct][ti].y = pk2(o[ct][ti][2], o[ct][ti][3]); }
            __builtin_amdgcn_sched_barrier(0);
            state_update_g(G, st, ck);
            __builtin_amdgcn_sched_barrier(0); }
        gsync(G);
#pragma unroll
        for (int ck = 0; ck < 2; ++ck)
#pragma unroll
            for (int ct = 0; ct < 2; ++ct)
#pragma unroll
                for (int ti = 0; ti < 2; ++ti) *(LAS u32x2*)(L + G2_QT + (32 * ck + 16 * ti + i16) * XRS + (32 * wg + 16 * ct + 4 * q) * 2) = of[ck][ct][ti];
        gsync(G);
        rows_l2g_g(OFT, hrow, 1, h * 128, L + G2_QT, G.tid);
        gsync(G);
    }
    if (fin_f) state_store_g(fin_f, st, wg, lane);
    state_load_g(sin_b, st, wg, lane);
    f32x4 gv[2];
#pragma unroll
    for (int ct = 0; ct < 2; ++ct) gv[ct] = *(const f32x4*)(gain + h * 128 + 32 * wg + 16 * ct + 4 * q);
    for (int hs = 0; hs < 4; ++hs) {
        const size_t hrow = rowb + 64 * (3 - hs);
        quarter_prep<true>(G, P5, hrow, true, h, 1);
        gsync(G);
        quarter_scores(G);
        gsync(G);
        LAS float* RED = (LAS float*)(L + G2_RED);
        f32x4 oa[2][2][2];
#pragma unroll
        for (int ck = 0; ck < 2; ++ck) { chunk_out_g(G, st, ck, oa[ck]);
            __builtin_amdgcn_sched_barrier(0);
            state_update_g(G, st, ck);
            __builtin_amdgcn_sched_barrier(0); }
        gsync(G);
        rows_g2l_g(OFT, hrow + 63, -1, h * 128, L + G2_QT, G.tid);
        if (writey) { u32x4 gr_[4];
#pragma unroll
            for (int it = 0; it < 4; ++it) { const int idx = G.tid + 256 * it, p = idx >> 4, ch = idx & 15; gr_[it] = *(const u32x4*)(P5 + ((size_t)h * MT + (hrow + 63 - p)) * 640 + 128 + ch * 8); }
            __builtin_amdgcn_sched_barrier(0);
#pragma unroll
            for (int it = 0; it < 4; ++it) { const int idx = G.tid + 256 * it, p = idx >> 4, ch = idx & 15; *(LAS u32x4*)(L + G2_KT + p * XRS + ch * 16) = gr_[it]; } }
        gsync(G);
#pragma unroll
        for (int ck = 0; ck < 2; ++ck)
#pragma unroll
            for (int ti = 0; ti < 2; ++ti) { const int p = 32 * ck + 16 * ti + i16; float ss = 0.f;
#pragma unroll
                for (int ct = 0; ct < 2; ++ct) { const u32x2 f = *(const LAS u32x2*)(L + G2_QT + p * XRS + (32 * wg + 16 * ct + 4 * q) * 2);
                    oa[ck][ct][ti][0] += bflo(f.x); oa[ck][ct][ti][1] += bfhi(f.x); oa[ck][ct][ti][2] += bflo(f.y); oa[ck][ct][ti][3] += bfhi(f.y);
                    ss += (oa[ck][ct][ti][0] * oa[ck][ct][ti][0] + oa[ck][ct][ti][1] * oa[ck][ct][ti][1]) + (oa[ck][ct][ti][2] * oa[ck][ct][ti][2] + oa[ck][ct][ti][3] * oa[ck][ct][ti][3]); }
                ss += shfl_x(ss, 16, lane); ss += shfl_x(ss, 32, lane);
                if (q == 0) RED[wg * 64 + p] = ss; }
        gsync(G);
        if (writey) {
#pragma unroll
            for (int ck = 0; ck < 2; ++ck)
#pragma unroll
                for (int ti = 0; ti < 2; ++ti) { const int p = 32 * ck + 16 * ti + i16; const float tot = (RED[p] + RED[64 + p]) + (RED[128 + p] + RED[192 + p]);
                    const float rs = rsqrtf(tot * (1.0f / 128.0f) + EPS);
#pragma unroll
                    for (int ct = 0; ct < 2; ++ct) { const u32x2 sg = *(const LAS u32x2*)(L + G2_KT + p * XRS + (32 * wg + 16 * ct + 4 * q) * 2);
                        u32x2 y; y.x = pk2(oa[ck][ct][ti][0] * rs * gv[ct][0] * bflo(sg.x), oa[ck][ct][ti][1] * rs * gv[ct][1] * bfhi(sg.x)); y.y = pk2(oa[ck][ct][ti][2] * rs * gv[ct][2] * bflo(sg.y), oa[ck][ct][ti][3] * rs * gv[ct][3] * bfhi(sg.y));
                        *(LAS u32x2*)(L + G2_V + p * XRS + (32 * wg + 16 * ct + 4 * q) * 2) = y; } }
            gsync(G);
            rows_l2g_g(Y, hrow + 63, -1, h * 128, L + G2_V, G.tid);
        }
        gsync(G);
    }
    if (fin_b) state_store_g(fin_b, st, wg, lane);
}
__device__ __forceinline__ int gq_next(GC& G, unsigned* ctr, unsigned ngroups) {
    LAS unsigned* slot = (LAS unsigned*)(G.L + G2_SLOT);
    gsync(G);
    if (G.tid == 0) *slot = ngroups + __hip_atomic_fetch_add(ctr, 1u, __ATOMIC_RELAXED, __HIP_MEMORY_SCOPE_AGENT);
    gsync(G);
    return (int)*slot;
}

__device__ __forceinline__ void scan_carry(const Ctx& F) {
    float* SST = (float*)(F.ws + WS_SST); const float* EG = (const float*)(F.ws + WS_EG); const float* S0 = (const float*)(F.ws + WS_S0);
    const int gt = F.bid * 512 + F.tid, NGT = F.G * 512;
    for (int idx = gt; idx < NCHAIN * 16384; idx += NGT) {
        const int chain = idx >> 14, e = idx & 16383, dir = chain & 1;
        const int lanee = e & 63, rg = (e >> 6) & 3, kb = (e >> 8) & 7; const int dk = 16 * kb + 4 * (lanee >> 4) + rg;
        float cur = S0[(size_t)chain * 16384 + e];
        float* base = SST + (size_t)chain * NSEG * 16384 + e; const float* eg = EG + (size_t)chain * NSEG * 128 + dk;
        for (int s0 = 0; s0 < NSEG; s0 += 8) {
            float tmp[8], gg[8];
#pragma unroll
            for (int i = 0; i < 8; ++i) { const int seg = dir ? NSEG - 1 - (s0 + i) : s0 + i; tmp[i] = base[(size_t)seg * 16384]; gg[i] = eg[seg * 128]; }
#pragma unroll
            for (int i = 0; i < 8; ++i) { const int seg = dir ? NSEG - 1 - (s0 + i) : s0 + i; base[(size_t)seg * 16384] = cur; cur = gg[i] * cur + tmp[i]; }
        }
    }
}

__device__ __forceinline__ void moe_slots(const Ctx& F, int nrows) {
    const int tid = F.tid; const int nitems = F.NGW;
    const RowPart rp = row_part(F.NGW, nrows);
    const int* cnt = (const int*)(F.ws + WS_CNT); const int* tope = (const int*)(F.ws + WS_TOPE); const int* rank = (const int*)(F.ws + WS_RANK);
    int* slotrow = (int*)(F.ws + WS_SLOTROW); int* slotdst = (int*)(F.ws + WS_SLOTDST); int* tilex = (int*)(F.ws + WS_TILEX); int* slotof = (int*)(F.ws + WS_SLOTOF);
    LAS int* pre = (LAS int*)F.lds;
    LAS int* tsum = (LAS int*)(F.lds + 69632);
    LAS int* ebase = (LAS int*)(F.lds + 69632 + 16384);
    const int IPT = (nitems + 511) / 512;
    int loc[8] = {0, 0, 0, 0, 0, 0, 0, 0};
    for (int i = 0; i < IPT; ++i) { const int it = tid * IPT + i; if (it < nitems) {
#pragma unroll
        for (int e = 0; e < 8; ++e) loc[e] += cnt[it * 8 + e]; } }
    {
        const int lane = F.lane, wv = F.wave; LAS int* wsum = ebase + 32;
        int inc[8];
#pragma unroll
        for (int e = 0; e < 8; ++e) { int v = loc[e];
#pragma unroll
            for (int o = 1; o < 64; o <<= 1) { const int u = __builtin_amdgcn_ds_bpermute(((lane - o) & 63) << 2, v); if (lane >= o) v += u; }
            inc[e] = v; }
        if (lane == 63) {
#pragma unroll
            for (int e = 0; e < 8; ++e) wsum[wv * 8 + e] = inc[e]; }
        __syncthreads();
#pragma unroll
        for (int e = 0; e < 8; ++e) { int below = 0, tot = 0;
#pragma unroll
            for (int w2 = 0; w2 < 8; ++w2) { const int t_ = wsum[w2 * 8 + e]; tot += t_; if (w2 < wv) below += t_; }
            tsum[tid * 8 + e] = below + inc[e] - loc[e];
            if (tid == 0) ebase[8 + e] = tot; }
    }
    __syncthreads();
    if (tid == 0) { int b = 0; for (int e = 0; e < 8; ++e) { ebase[e] = b; b += (ebase[8 + e] + 255) & ~255; } ebase[16] = b / 256; }
    { int run[8];
#pragma unroll
      for (int e = 0; e < 8; ++e) run[e] = tsum[tid * 8 + e];
      for (int i = 0; i < IPT; ++i) { const int it = tid * IPT + i; if (it < nitems) {
#pragma unroll
          for (int e = 0; e < 8; ++e) { pre[it * 8 + e] = run[e]; run[e] += cnt[it * 8 + e]; } } } }
    __syncthreads();
    for (int r = F.bid * 512 + tid; r < nrows; r += F.G * 512) {
        const int ch = row_chunk_of(rp, r);
#pragma unroll
        for (int kk = 0; kk < 2; ++kk) { const int e = tope[2 * r + kk]; const int slot = ebase[e] + pre[ch * 8 + e] + rank[2 * r + kk]; slotrow[slot] = r; slotdst[slot] = 2 * r + kk; slotof[2 * r + kk] = slot; }
    }
    if (F.bid == 0) {
        const int ntiles = ebase[16];
        if (tid == 0) tilex[0] = ntiles;
        for (int e = 0; e < 8; ++e) { const int b0 = ebase[e], tot = ebase[8 + e], pad = (tot + 255) & ~255;
            for (int s = b0 + tot + tid; s < b0 + pad; s += 512) { slotrow[s] = 0; slotdst[s] = -1; }
            for (int t = b0 / 256 + tid; t < (b0 + pad) / 256; t += 512) tilex[16 + t] = e; }
    }
}

constexpr int FILL_R = 2;
__device__ __forceinline__ int fill_count(int nwg, int G) { const int rem = nwg % G; return rem > 0 ? (G - rem) * FILL_R * 8 : 0; }
__device__ __forceinline__ void tail_fill(const Ctx& F, int lp, int nwg, int base) {
    const int rem = nwg % F.G; if (rem == 0 || F.bid < rem) return;
#pragma unroll 1
    for (int r = 0; r < FILL_R; ++r) { const int idx = base + ((F.bid - rem) * FILL_R + r) * 8 + F.wave; if (idx < MOE_CONV_ITEMS) moe_convert_item(F, lp, idx); }
}
constexpr int NWG_E2 = (MT / 256) * (NEIN / 256), NWG_E6 = (MT / 256) * (NFF2 / 256), NWG_O2 = (MT / 256) * (NREC / 256);
__global__ void __launch_bounds__(512, 2) fwd_kernel(Args args) {
    extern __shared__ __attribute__((aligned(16))) unsigned char lds_raw[];
    Ctx F;
    F.lds = (LAS unsigned char*)lds_raw; F.tid = threadIdx.x; F.lane = F.tid & 63; F.wave = __builtin_amdgcn_readfirstlane(F.tid >> 6);
    F.G = gridDim.x; F.bid = blockIdx.x; F.gw = F.bid * 8 + F.wave; F.NGW = F.G * 8;
    F.in = args.in; F.out = args.out; F.ws = args.ws;
    volatile LAS unsigned* MISC = (volatile LAS unsigned*)(F.lds + MISC_OFF);
    if (F.tid < 64) MISC[F.tid] = 0u;
    __syncthreads();
    const int lo = args.ph_lo, hi = args.ph_hi;
    XcdBarrier bar; bar.bar = (unsigned*)(F.ws + WS_CTL) + 4096; bar.x = 0; bar.st = nullptr;
    const bool multi = (hi - lo) > 1;
    if (multi) bar = xcd_barrier_post((unsigned*)(F.ws + WS_CTL) + 4096, MISC + 8);
#define IN(k) (lo <= (k) && (k) < hi)
#if defined(PROBE_TMASK)
    unsigned long long pt_last = __builtin_amdgcn_s_memrealtime(), pt_acc = 0ull;
#define PROBE_T(k) do { const unsigned long long now_ = __builtin_amdgcn_s_memrealtime(); if ((((unsigned long long)(PROBE_TMASK)) >> (k)) & 1ull) pt_acc += now_ - pt_last; pt_last = now_; } while (0)
#else
#define PROBE_T(k) do { } while (0)
#endif
#define SEAM(k) do { if (IN(k) && IN((k) + 1)) xcd_barrier(bar); PROBE_T(k); asm volatile("" : "+v"(F.tid), "+s"(F.G)); LAUNDER_WS_OUT(); F.NGW = F.G * 8; F.lane = F.tid & 63; F.wave = __builtin_amdgcn_readfirstlane(F.tid >> 6); F.gw = F.bid * 8 + F.wave; } while (0)

#define MODS_ ((float*)(F.ws + WS_MODS))
#define XB_ ((bf16_t*)(F.ws + WS_XB))
#define H_ ((bf16_t*)(F.ws + WS_H))
#define YE_ ((bf16_t*)(F.ws + WS_YE))

    if (IN(PH_P0)) for (int rep_ = 0; rep_ < NREP(18); ++rep_) { p0_prologue(F); }
#if defined(PROBE_SLEEP)
    if (IN(PH_P0)) { const unsigned long long t0 = __builtin_amdgcn_s_memrealtime(); while (__builtin_amdgcn_s_memrealtime() - t0 < (unsigned long long)PROBE_SLEEP * 100ull) __builtin_amdgcn_s_sleep(32); }
#endif
    SEAM(PH_P0);

#if defined(PROBE_GEMM)
    if (IN(PH_P0)) {
        pg8::Gemm g{H_, (const bf16_t*)(F.ws + WS_WINE), ML, NEIN, D, nullptr, nullptr, 0}; pg8::StaticOrder S; S.init(ML, NEIN, D, F.G, F.bid);
#if PROBE_GEMM == 1
        pg8::EpiEvenIn E{(bf16_t*)(F.ws + WS_UP)}; pg8::gemm_phase<pg8::EpiEvenIn, pg8::StaticOrder, true, false>(F.lds, g, S, E, F.tid);
#elif PROBE_GEMM == 2
        pg8::EpiNull E{(float*)(F.ws + WS_UP)}; pg8::gemm_phase<pg8::EpiNull, pg8::StaticOrder, true, false>(F.lds, g, S, E, F.tid);
#endif
        xcd_barrier(bar);
    }
#endif

    for (int lp = 0; lp < 2; ++lp) {
        const int pb = PH_PAIR0 + lp * NPL;
        const int le = 2 * lp, lo_ = 2 * lp + 1;
        const float* modE = MODS_ + (size_t)le * 3 * 6144; const float* modO = MODS_ + (size_t)lo_ * 3 * 6144;
        if (IN(pb + E1_NORM)) for (int rep_ = 0; rep_ < NREP(E1_NORM); ++rep_) {
            RowPass P{}; P.sl = FIN(I_X); P.sc = FIN(I_CTX); P.xb = XB_; P.gain = FIN(I_NMIX) + le * D; P.shift = modE + 0 * D; P.scale = modE + 1 * D; P.H = H_; P.nrows = MT;
            if (lp == 0) row_pass<false, false, false, false>(F, P);
            else { P.YE = YE_; P.topp = (const float*)(F.ws + WS_TOPP); P.gatef = MODS_ + (size_t)(le - 1) * 3 * 6144 + 5 * D; P.slotof = (const int*)(F.ws + WS_SLOTOF); P.partm = (const float*)(F.ws + WS_PARTM); row_pass_b<true, false, false, 2>(F, P); }
        }
        SEAM(pb + E1_NORM);
        if (IN(pb + E2_GIN)) for (int rep_ = 0; rep_ < NREP(E2_GIN); ++rep_) {
            pg8::Gemm g{H_, (const bf16_t*)(F.ws + WS_WINE) + (size_t)lp * NEIN * D, MT, NEIN, D, nullptr, nullptr, 0}; pg8::StaticOrder S; S.init(MT, NEIN, D, F.G, F.bid);
            pg8::EpiEvenIn E{(bf16_t*)(F.ws + WS_PZUV)};
            pg8::gemm_phase<pg8::EpiEvenIn, pg8::StaticOrder, true, false>(F.lds, g, S, E, F.tid);
            tail_fill(F, lp, NWG_E2, 0);
        }
        SEAM(pb + E2_GIN);
        if (IN(pb + E3_FFTA)) for (int rep_ = 0; rep_ < NREP(E3_FFTA); ++rep_) fft_stage_a(F, (unsigned*)(F.ws + WS_CTL) + 8192 + 64 * (pb + E3_FFTA));
        SEAM(pb + E3_FFTA);
        if (IN(pb + E3_FFTC)) for (int rep_ = 0; rep_ < NREP(E3_FFTC); ++rep_) fft_stage_c_gmlp(F, lp, (unsigned*)(F.ws + WS_CTL) + 8192 + 64 * (pb + E3_FFTC));
        SEAM(pb + E3_FFTC);
        if (IN(pb + E4_GOUT)) for (int rep_ = 0; rep_ < NREP(E4_GOUT); ++rep_) {
            pg8::Gemm g{H_, (const bf16_t*)(F.ws + WS_WOUTE) + (size_t)lp * D * D, MT, D, D, nullptr, nullptr, 0}; pg8::ResOrder S; S.init(D, F.G, F.bid, true);
            if (lp == 0) { pg8::EpiRes<true> E{FIN(I_X), XB_, modE + 2 * D, (float*)(F.ws + WS_PARTC)}; pg8::gemm_phase<pg8::EpiRes<true>, pg8::ResOrder, false, false>(F.lds, g, S, E, F.tid); dense_fill(F, 0, 1792); }
            else { pg8::EpiRes<false> E{nullptr, XB_, modE + 2 * D, (float*)(F.ws + WS_PARTC)}; pg8::gemm_phase<pg8::EpiRes<false>, pg8::ResOrder, false, false>(F.lds, g, S, E, F.tid); }
        }
        SEAM(pb + E4_GOUT);
        if (IN(pb + E5_NORM)) for (int rep_ = 0; rep_ < NREP(E5_NORM); ++rep_) {
            RowPass P{}; P.xb = XB_; P.csrc32 = lp == 0 ? FIN(I_CTX) : nullptr; P.gain = FIN(I_NFFN) + le * D; P.shift = modE + 3 * D; P.scale = modE + 4 * D; P.H = H_; P.nrows = MT;
            P.part = (const float*)(F.ws + WS_PARTC); P.kpn = CTX_KP; P.pgate = modE + 2 * D;
            row_pass_b<false, false, false, 4>(F, P);
        }
        SEAM(pb + E5_NORM);
        if (IN(pb + E6_UP)) for (int rep_ = 0; rep_ < NREP(E6_UP); ++rep_) {
            pg8::Gemm g{H_, (const bf16_t*)(F.ws + WS_W13) + (size_t)lp * NFF2 * D, MT, NFF2, D, nullptr, nullptr, 0}; pg8::StaticOrder S; S.init(MT, NFF2, D, F.G, F.bid);
            pg8::EpiSwiglu E{(bf16_t*)(F.ws + WS_HID), DFF};
            pg8::gemm_phase<pg8::EpiSwiglu, pg8::StaticOrder, true, false>(F.lds, g, S, E, F.tid);
            tail_fill(F, lp, NWG_E6, fill_count(NWG_E2, F.G));
        }
        SEAM(pb + E6_UP);
        if (IN(pb + E7_DOWN)) for (int rep_ = 0; rep_ < NREP(E7_DOWN); ++rep_) {
            pg8::Gemm g{(const bf16_t*)(F.ws + WS_HID), (const bf16_t*)(F.ws + WS_W2) + (size_t)lp * D * DFF, MT, D, DFF, nullptr, nullptr, 0}; pg8::ResOrder S; S.init(DFF, F.G, F.bid, true);
            pg8::EpiRes<false> E{nullptr, XB_, modE + 5 * D, (float*)(F.ws + WS_PARTC)};
            pg8::gemm_phase<pg8::EpiRes<false>, pg8::ResOrder, false, false>(F.lds, g, S, E, F.tid);
            if (lp == 0) dense_fill(F, 1792, 3584);
        }
        SEAM(pb + E7_DOWN);
        const bool lastl = lp == 1;
        if (IN(pb + O1_NORM)) for (int rep_ = 0; rep_ < NREP(O1_NORM); ++rep_) {
            RowPass P{}; P.xb = XB_; P.gain = FIN(I_NMIX) + lo_ * D; P.shift = modO + 0 * D; P.scale = modO + 1 * D; P.H = H_; P.nrows = MT;
            P.part = (const float*)(F.ws + WS_PARTC); P.kpn = CTX_KP; P.pgate = modE + 5 * D;
            row_pass_b<false, false, false, 4>(F, P);
        }
        SEAM(pb + O1_NORM);
        if (IN(pb + O2_GIN)) for (int rep_ = 0; rep_ < NREP(O2_GIN); ++rep_) {
            pg8::Gemm g{H_, (const bf16_t*)(F.ws + WS_WINO) + (size_t)lp * NREC * D, MT, NREC, D, nullptr, nullptr, 0}; pg8::StaticOrder S; S.init(MT, NREC, D, F.G, F.bid);
            pg8::EpiOddIn E{(bf16_t*)(F.ws + WS_P5), (const float*)(F.ws + WS_LB) + lp * 2048};
            pg8::gemm_phase<pg8::EpiOddIn, pg8::StaticOrder, true, false>(F.lds, g, S, E, F.tid);
            tail_fill(F, lp, NWG_O2, fill_count(NWG_E2, F.G) + fill_count(NWG_E6, F.G));
        }
        SEAM(pb + O2_GIN);
        if (IN(pb + O3_SCAN1)) {
            const int grp = F.wave >> 2; const int NG = F.G * 2, gid = F.bid * 2 + grp;
            GC G; G.L = F.lds + grp * G2_BYTES; G.wg = F.wave & 3; G.tid = F.tid & 255; G.lane = F.lane; G.bar = (LAS unsigned*)(F.lds + MISC_OFF + 128 + 4 * grp);
            __syncthreads(); G.epoch = __hip_atomic_load(G.bar, __ATOMIC_RELAXED, __HIP_MEMORY_SCOPE_WORKGROUP);
            int C0 = fill_count(NWG_E2, F.G) + fill_count(NWG_E6, F.G) + fill_count(NWG_O2, F.G); C0 = C0 < MOE_CONV_ITEMS ? C0 : MOE_CONV_ITEMS;
            const int NC = (MOE_CONV_ITEMS - C0) / 4, NI = NC < 2048 ? NC : 2048, NITEMS = 16 + 2048 + NC;
            for (int it = gid; it < NITEMS; ) {
                { int t_ = F.tid; asm volatile("" : "+v"(t_)); LAUNDER_WS_OUT(); G.tid = t_ & 255; G.lane = t_ & 63; F.lane = G.lane; }
                const bf16_t* P5 = (const bf16_t*)(F.ws + WS_P5); float* SST = (float*)(F.ws + WS_SST); float* EG = (float*)(F.ws + WS_EG); float* S0 = (float*)(F.ws + WS_S0);
                const float* gain = FIN(I_RNORM) + lp * D; unsigned* wq = (unsigned*)(F.ws + WS_CTL) + 8192 + 64 * (pb + O3_SCAN1);
                int it2 = it, cv = -1;
                if (it >= 16) { const int y = it - 16;
                    if (y < 2 * NI) { if (y & 1) cv = y >> 1; else it2 = 16 + (y >> 1); }
                    else { const int z = y - 2 * NI; if (z < 2048 - NI) it2 = 16 + NI + z; else cv = NI + (z - (2048 - NI)); } }
                if (cv >= 0) moe_convert_item(F, lp, C0 + cv * 4 + G.wg);
                else if (it2 < 16) { const int b = it2 >> 3, h = it2 & 7;
                    scan_pass3_item_g(G, P5, (size_t)ML + b * TCX, h, nullptr, nullptr, S0 + (size_t)((b * 8 + h) * 2 + 0) * 16384, S0 + (size_t)((b * 8 + h) * 2 + 1) * 16384, gain, YE_, H_, !lastl);
                } else { const int i2 = it2 - 16, seg = i2 & 63, dir = (i2 >> 6) & 1, h = (i2 >> 7) & 7, b = i2 >> 10;
                    scan_pass1_item_g(G, P5, b, h, dir, seg, SST, EG); }
                it = gq_next(G, wq, (unsigned)NG);
            }
        }
        SEAM(pb + O3_SCAN1);
        if (IN(pb + O4_CARRY)) for (int rep_ = 0; rep_ < NREP(O4_CARRY); ++rep_) { scan_carry(F); }
        SEAM(pb + O4_CARRY);
        if (IN(pb + O5_SCAN3)) {
            const int grp = F.wave >> 2; const int NG = F.G * 2, gid = F.bid * 2 + grp;
            GC G; G.L = F.lds + grp * G2_BYTES; G.wg = F.wave & 3; G.tid = F.tid & 255; G.lane = F.lane; G.bar = (LAS unsigned*)(F.lds + MISC_OFF + 128 + 4 * grp);
            __syncthreads(); G.epoch = __hip_atomic_load(G.bar, __ATOMIC_RELAXED, __HIP_MEMORY_SCOPE_WORKGROUP);
            for (int it = gid; it < 1024; it += NG) { const int seg = it & 63, h = (it >> 6) & 7, b = it >> 9; const int ch0 = (b * 8 + h) * 2;
                { int t_ = F.tid; asm volatile("" : "+v"(t_)); LAUNDER_WS_OUT(); G.tid = t_ & 255; G.lane = t_ & 63; }
                const bf16_t* P5 = (const bf16_t*)(F.ws + WS_P5); const float* SST = (const float*)(F.ws + WS_SST); const float* gain = FIN(I_RNORM) + lp * D;
                scan_pass3_item_g(G, P5, (size_t)b * TL + (size_t)seg * SEGL, h, SST + ((size_t)ch0 * NSEG + seg) * 16384, SST + ((size_t)(ch0 + 1) * NSEG + seg) * 16384, nullptr, nullptr, gain, YE_, H_, true); }
        }
        SEAM(pb + O5_SCAN3);
        if (IN(pb + O6_GOUT)) for (int rep_ = 0; rep_ < NREP(O6_GOUT); ++rep_) {
            pg8::Gemm g{H_, (const bf16_t*)(F.ws + WS_WOUTO) + (size_t)lp * D * D, MT, D, D, nullptr, nullptr, 0}; pg8::ResOrder S; S.init(D, F.G, F.bid, !lastl);
            pg8::EpiRes<false> E{nullptr, XB_, modO + 2 * D, (float*)(F.ws + WS_PARTC)};
            pg8::gemm_phase<pg8::EpiRes<false>, pg8::ResOrder, false, false>(F.lds, g, S, E, F.tid);
            if (lp == 0) dense_fill(F, 3584, DENSE_PER_J);
        }
        SEAM(pb + O6_GOUT);
        const int nrm = lastl ? ML : MT;
        if (IN(pb + O7_NORM)) for (int rep_ = 0; rep_ < NREP(O7_NORM); ++rep_) {
            RowPass P{}; P.xb = XB_; P.gain = FIN(I_NFFN) + lo_ * D; P.shift = modO + 3 * D; P.scale = modO + 4 * D; P.H = H_; P.nrows = nrm;
            P.part = lastl ? nullptr : (const float*)(F.ws + WS_PARTC); P.kpn = CTX_KP; P.pgate = modO + 2 * D;
            P.rw = FIN(I_RW) + (size_t)lp * D * NE; P.tope = (int*)(F.ws + WS_TOPE); P.toppo = (float*)(F.ws + WS_TOPP); P.rank = (int*)(F.ws + WS_RANK); P.cnt = (int*)(F.ws + WS_CNT);
            row_pass_b<false, true, false, 2>(F, P);
        }
        SEAM(pb + O7_NORM);
        if (IN(pb + O8_SLOTS)) for (int rep_ = 0; rep_ < NREP(O8_SLOTS); ++rep_) moe_slots(F, nrm);
        SEAM(pb + O8_SLOTS);
        if (IN(pb + O9_MUP)) for (int rep_ = 0; rep_ < NREP(O9_MUP); ++rep_) {
            const int* tilex = (const int*)(F.ws + WS_TILEX); const int ntiles = __builtin_amdgcn_readfirstlane(tilex[0]);
            pg8::Gemm g{H_, (const bf16_t*)(F.ws + WS_W13M), ntiles * 256, NEX2, D, (const int*)(F.ws + WS_SLOTROW), tilex + 16, (size_t)NEX2 * D}; pg8::StaticOrder S; S.init(ntiles * 256, NEX2, D, F.G, F.bid);
            pg8::EpiSwiglu E{(bf16_t*)(F.ws + WS_HIDM), DEX};
            pg8::gemm_phase<pg8::EpiSwiglu, pg8::StaticOrder, true, true>(F.lds, g, S, E, F.tid);
        }
        SEAM(pb + O9_MUP);
        if (IN(pb + O10_MDOWN)) for (int rep_ = 0; rep_ < NREP(O10_MDOWN); ++rep_) {
            const int* tilex = (const int*)(F.ws + WS_TILEX); const int ntiles = __builtin_amdgcn_readfirstlane(tilex[0]);
            pg8::Gemm g{(const bf16_t*)(F.ws + WS_HIDM), (const bf16_t*)(F.ws + WS_W2M), ntiles * 256, D, DEX, nullptr, tilex + 16, (size_t)D * DEX}; pg8::MoeDownOrder S; S.init(ntiles, F.G, F.bid);
            pg8::EpiMoeDown E{YE_, (const int*)(F.ws + WS_SLOTDST), (float*)(F.ws + WS_PARTM)};
            pg8::gemm_phase<pg8::EpiMoeDown, pg8::MoeDownOrder, true, false>(F.lds, g, S, E, F.tid);
        }
        SEAM(pb + O10_MDOWN);
    }
    if (IN(PH_FINAL)) {
        RowPass P{}; P.xb = XB_; P.gain = FIN(I_NOUT); P.nrows = ML; P.YE = YE_; P.topp = (const float*)(F.ws + WS_TOPP); P.gatef = MODS_ + (size_t)3 * 3 * 6144 + 5 * D; P.fout = F.out; P.slotof = (const int*)(F.ws + WS_SLOTOF); P.partm = (const float*)(F.ws + WS_PARTM);
        row_pass_b<true, false, true, 2>(F, P);
    }
    PROBE_T(PH_FINAL);
#if defined(PROBE_TMASK)
    if (F.bid == 0 && F.tid == 0) { const unsigned long long t0 = __builtin_amdgcn_s_memrealtime(); while (__builtin_amdgcn_s_memrealtime() - t0 < pt_acc * 4ull) __builtin_amdgcn_s_sleep(32); }
#endif
#undef IN
#undef SEAM
#undef MODS_
#undef XB_
#undef H_
#undef YE_
}

extern "C" void kernel_launch(void* const* d_in, const int* in_sizes, int n_in, void* d_out, int out_size, void* d_ws, size_t ws_size, hipStream_t stream) {
    static int grid = 0;
    if (grid == 0) {
        if (n_in != 24 || out_size != ML * D || ws_size < WS_END) { fprintf(stderr, "kernel_launch: unexpected problem (n_in %d, out %d, ws %zu < %zu)\n", n_in, out_size, ws_size, (size_t)WS_END); grid = -1; return; }
        int dev = 0, cus = 0, per_cu = 0;
        if (hipGetDevice(&dev) != hipSuccess || hipDeviceGetAttribute(&cus, hipDeviceAttributeMultiprocessorCount, dev) != hipSuccess) { grid = -1; return; }
        if (hipFuncSetAttribute((const void*)fwd_kernel, hipFuncAttributeMaxDynamicSharedMemorySize, LDS_BYTES) != hipSuccess) { fprintf(stderr, "kernel_launch: hipFuncSetAttribute failed\n"); grid = -1; return; }
        if (hipOccupancyMaxActiveBlocksPerMultiprocessor(&per_cu, (const void*)fwd_kernel, 512, LDS_BYTES) != hipSuccess || per_cu < 1) fprintf(stderr, "kernel_launch: occupancy query says %d\n", per_cu);
        (void)hipGetLastError();
        grid = cus;
    }
    if (grid < 0) return;
    (void)hipMemsetAsync((char*)d_ws + WS_CTL, 0, CTL_BYTES, stream);
    Args a{};
    for (int i = 0; i < 24; ++i) a.in[i] = (const float*)d_in[i];
    a.out = (float*)d_out; a.ws = (unsigned char*)d_ws;
#if PER_PHASE_LAUNCH
    for (int p = 0; p < NPHASE && p < PHASE_LIMIT; ++p) { a.ph_lo = p; a.ph_hi = p + 1; hipLaunchKernelGGL(fwd_kernel, dim3(grid), dim3(512), LDS_BYTES, stream, a); }
#else
    a.ph_lo = 0; a.ph_hi = NPHASE; hipLaunchKernelGGL(fwd_kernel, dim3(grid), dim3(512), LDS_BYTES, stream, a);
#endif
}
```
